# Optimizing an MI355X kernel written in HIP

```python
import jax
import jax.numpy as jnp
from jax import lax
import numpy as np

D_MODEL = 1024
BATCH = 1
SEQ = 16384
DEPTH = 2

MEM_LEN = 256
CONV_WIDTH = 512
CONV_K = 3
SG_WIDTH = 512
SG_GROUPS = 4
SG_GROUP_DIM = SG_WIDTH // SG_GROUPS
CHUNK = 128
FOX_HEADS = 8
FOX_HEAD_DIM = 64
FOX_WIDTH = FOX_HEADS * FOX_HEAD_DIM
Q_BLOCK = 128
FORGET_BIAS_CENTER = 3.0
N_BRANCH = 3
BRANCH_WIDTH = 512
XA_HEADS = 4
XA_HEAD_DIM = D_MODEL // XA_HEADS
D_FF = 2816
RMS_EPS = 1e-6
SPLIT_SIZES = (CONV_WIDTH, CONV_WIDTH, CONV_WIDTH, SG_WIDTH, SG_WIDTH,
               FOX_WIDTH, FOX_WIDTH, FOX_WIDTH, FOX_HEADS, N_BRANCH * D_MODEL)
D_IN_PROJ = sum(SPLIT_SIZES)

kernel_name = "hybrid_conv_gmlp_fox_macaron"


def rmsnorm(x, g):
    xf = x.astype(jnp.float32)
    y = xf * lax.rsqrt(jnp.mean(xf * xf, axis=-1, keepdims=True) + RMS_EPS)
    return (y * g.astype(jnp.float32)).astype(x.dtype)


def swiglu(h, w_gate, w_up, w_down):
    return (jax.nn.silu(h @ w_gate) * (h @ w_up)) @ w_down


def short_conv_mixer(b_gate, c_gate, h, conv_w):
    z = c_gate * h
    s = z.shape[1]
    zp = jnp.pad(z, ((0, 0), (CONV_K - 1, 0), (0, 0)))
    y = sum(conv_w[k] * zp[:, k:k + s] for k in range(CONV_K))
    return b_gate * y


def spatial_gating_mixer(u, v, v_norm_g, w_s, b_s):
    bsz, s, _ = v.shape
    u = jax.nn.gelu(u)
    v = rmsnorm(jax.nn.gelu(v), v_norm_g)
    vc = v.reshape(bsz, s // CHUNK, CHUNK, SG_GROUPS, SG_GROUP_DIM)
    causal = jnp.tril(jnp.ones((CHUNK, CHUNK), dtype=bool))
    w = jnp.where(causal[None], w_s, 0.0).astype(v.dtype)
    sv = jnp.einsum('gts,bnsgc->bntgc', w, vc) + b_s.T[:, :, None].astype(v.dtype)
    return u * sv.reshape(bsz, s, SG_WIDTH)


def forgetting_attention(q, k, v, f_logit, b_f):
    bsz, s, _ = q.shape
    q = q.reshape(bsz, s, FOX_HEADS, FOX_HEAD_DIM)
    k = k.reshape(bsz, s, FOX_HEADS, FOX_HEAD_DIM)
    v = v.reshape(bsz, s, FOX_HEADS, FOX_HEAD_DIM)
    log_f = jax.nn.log_sigmoid(f_logit.astype(jnp.float32) + b_f.astype(jnp.float32))
    c = jnp.cumsum(log_f, axis=1).transpose(0, 2, 1)
    scale = FOX_HEAD_DIM ** -0.5
    kpos = jnp.arange(s)

    def block(i):
        start = i * Q_BLOCK
        qb = lax.dynamic_slice_in_dim(q, start, Q_BLOCK, axis=1)
        cq = lax.dynamic_slice_in_dim(c, start, Q_BLOCK, axis=2)
        logits = jnp.einsum('bqhd,bkhd->bhqk', qb, k,
                            preferred_element_type=jnp.float32) * scale
        logits = logits + cq[..., :, None] - c[..., None, :]
        qpos = start + jnp.arange(Q_BLOCK)
        logits = jnp.where(kpos[None, :] <= qpos[:, None], logits, -jnp.inf)
        p = jax.nn.softmax(logits, axis=-1)
        return jnp.einsum('bhqk,bkhd->bqhd', p.astype(v.dtype), v)

    out = lax.map(block, jnp.arange(s // Q_BLOCK))
    return out.transpose(1, 0, 2, 3, 4).reshape(bsz, s, FOX_WIDTH)


def memory_cross_attention(h, m, wq, wk, wv, wo):
    bsz, s, _ = h.shape
    q = (h @ wq).reshape(bsz, s, XA_HEADS, XA_HEAD_DIM)
    k = (m @ wk).reshape(bsz, m.shape[1], XA_HEADS, XA_HEAD_DIM)
    v = (m @ wv).reshape(bsz, m.shape[1], XA_HEADS, XA_HEAD_DIM)
    logits = jnp.einsum('bqhd,bkhd->bhqk', q, k,
                        preferred_element_type=jnp.float32) * (XA_HEAD_DIM ** -0.5)
    p = jax.nn.softmax(logits, axis=-1)
    o = jnp.einsum('bhqk,bkhd->bqhd', p.astype(v.dtype), v).reshape(bsz, s, D_MODEL)
    return o @ wo


def setup_inputs(seed: int = 0) -> dict:
    key = jax.random.key(seed)
    ks = jax.random.split(key, 32)
    f32 = jnp.float32
    L, D = DEPTH, D_MODEL

    def nrm(k, shape, scale):
        return jax.random.normal(k, shape, f32) * scale

    def gain(k, shape):
        return 1.0 + 0.05 * jax.random.normal(k, shape, f32)

    return {
        "x": nrm(ks[0], (BATCH, SEQ, D), 1.0),
        "mem": nrm(ks[1], (BATCH, MEM_LEN, D), 1.0),
        "ffn1_norm": gain(ks[2], (L, D)),
        "ffn1_w_gate": nrm(ks[3], (L, D, D_FF), D ** -0.5),
        "ffn1_w_up": nrm(ks[4], (L, D, D_FF), D ** -0.5),
        "ffn1_w_down": nrm(ks[5], (L, D_FF, D), D_FF ** -0.5),
        "mix_norm": gain(ks[6], (L, D)),
        "w_in": nrm(ks[7], (L, D, D_IN_PROJ), D ** -0.5),
        "conv_w": nrm(ks[8], (L, CONV_K, CONV_WIDTH), CONV_K ** -0.5),
        "sg_norm": gain(ks[9], (L, SG_WIDTH)),
        "sg_w": nrm(ks[10], (L, SG_GROUPS, CHUNK, CHUNK), CHUNK ** -0.5),
        "sg_b": 1.0 + nrm(ks[11], (L, SG_GROUPS, CHUNK), 0.1),
        "fox_b_f": FORGET_BIAS_CENTER + nrm(ks[12], (L, FOX_HEADS), 1.0),
        "w_branch": nrm(ks[13], (L, N_BRANCH, BRANCH_WIDTH, D), BRANCH_WIDTH ** -0.5),
        "w_out": nrm(ks[14], (L, D, D), D ** -0.5),
        "xa_norm": gain(ks[15], (L, D)),
        "mem_norm": gain(ks[16], (L, D)),
        "xa_wq": nrm(ks[17], (L, D, D), D ** -0.5),
        "xa_wk": nrm(ks[18], (L, D, D), D ** -0.5),
        "xa_wv": nrm(ks[19], (L, D, D), D ** -0.5),
        "xa_wo": nrm(ks[20], (L, D, D), D ** -0.5),
        "ffn2_norm": gain(ks[21], (L, D)),
        "ffn2_w_gate": nrm(ks[22], (L, D, D_FF), D ** -0.5),
        "ffn2_w_up": nrm(ks[23], (L, D, D_FF), D ** -0.5),
        "ffn2_w_down": nrm(ks[24], (L, D_FF, D), D_FF ** -0.5),
        "final_norm": gain(ks[25], (D,)),
    }


def reference(x, mem, ffn1_norm, ffn1_w_gate, ffn1_w_up, ffn1_w_down, mix_norm, w_in,
              conv_w, sg_norm, sg_w, sg_b, fox_b_f, w_branch, w_out, xa_norm, mem_norm,
              xa_wq, xa_wk, xa_wv, xa_wo, ffn2_norm, ffn2_w_gate, ffn2_w_up, ffn2_w_down,
              final_norm):
    bsz, s, _ = x.shape
    split_idx = np.cumsum(SPLIT_SIZES)[:-1].tolist()
    for l in range(DEPTH):
        h = rmsnorm(x, ffn1_norm[l])
        x = x + 0.5 * swiglu(h, ffn1_w_gate[l], ffn1_w_up[l], ffn1_w_down[l])

        h = rmsnorm(x, mix_norm[l])
        proj = h @ w_in[l]
        (a_b, a_c, a_h, sg_u, sg_v, fq, fk, fv, f_logit, gate_logits) = jnp.split(
            proj, split_idx, axis=-1)
        y_a = short_conv_mixer(a_b, a_c, a_h, conv_w[l])
        y_b = spatial_gating_mixer(sg_u, sg_v, sg_norm[l], sg_w[l], sg_b[l])
        y_c = forgetting_attention(fq, fk, fv, f_logit, fox_b_f[l])
        branches = jnp.stack([y_a, y_b, y_c], axis=2)
        branches = jnp.einsum('bsnc,ncd->bsnd', branches, w_branch[l])
        gates = jax.nn.sigmoid(gate_logits.reshape(bsz, s, N_BRANCH, D_MODEL))
        merged = jnp.einsum('bsnd,bsnd->bsd', gates, branches)
        x = x + merged @ w_out[l]

        h = rmsnorm(x, xa_norm[l])
        m = rmsnorm(mem, mem_norm[l])
        x = x + memory_cross_attention(h, m, xa_wq[l], xa_wk[l], xa_wv[l], xa_wo[l])

        h = rmsnorm(x, ffn2_norm[l])
        x = x + 0.5 * swiglu(h, ffn2_w_gate[l], ffn2_w_up[l], ffn2_w_down[l])
    return rmsnorm(x, final_norm)
```

```cpp
#include <hip/hip_runtime.h>
#include <hip/hip_cooperative_groups.h>
#include <cstdio>
#include <cstdint>
namespace cg = cooperative_groups;

namespace pg8 {
#define PG8_LAS __attribute__((address_space(3)))
typedef unsigned short bf16_t;
typedef short bf16x8 __attribute__((ext_vector_type(8)));
typedef float f32x4 __attribute__((ext_vector_type(4)));
typedef unsigned u32x4 __attribute__((ext_vector_type(4)));
constexpr int BM = 256, BK = 64, HALF = 128, HTB = HALF * BK * 2  , STAGE_BYTES = 8 * HTB, NXCD = 8, WGM = 8;

__host__ __device__ __forceinline__ int lds_byte(int r, int c) { const int st = (r >> 4) * 2 + (c >> 5), rr = r & 15, cc = c & 31, ob = rr * 64 + cc * 2; return st * 1024 + (ob ^ (((ob >> 9) & 1) << 5)); }
__host__ __device__ __forceinline__ void stage_rc(int b, int& R, int& C) { const int st = b / 1024, sb = b % 1024, swz = sb ^ (((sb >> 9) & 1) << 5); R = (st >> 1) * 16 + swz / 64; C = (st & 1) * 32 + (swz % 64) / 2; }
__host__ __device__ __forceinline__ int perm32(int rho) { const int n = rho >> 4, i = rho & 15; return 8 * (i >> 2) + 4 * n + (i & 3); }

struct Unit { int pm, pn, z; };
typedef float f32x2 __attribute__((ext_vector_type(2))); typedef __bf16 bf16x2_cv __attribute__((ext_vector_type(2)));
__device__ __forceinline__ unsigned cvt_pk_bf16(float lo, float hi) { const f32x2 v = {lo, hi}; const bf16x2_cv b = __builtin_convertvector(v, bf16x2_cv); return __builtin_bit_cast(unsigned, b); }
struct Gemm { const bf16_t* A; const bf16_t* Bt; int K, lda, ldb; size_t zA, zB; };

struct StaticOrder {
    int nM, nN, nwg, G, c;
    __host__ __device__ void init(int nM_, int nN_, int G_, int c_) { nM = nM_; nN = nN_; nwg = nM * nN; G = G_; c = c_; }
    __host__ __device__ void map(int wgid, Unit& u) const {
        { const int q = nwg / NXCD, r = nwg % NXCD, xcd = wgid % NXCD, off = wgid / NXCD; wgid = (xcd < r ? xcd * (q + 1) : r * (q + 1) + (xcd - r) * q) + off; }
        const int nig = WGM * nN, gid = wgid / nig, fm = gid * WGM, gsz = (nM - fm) < WGM ? (nM - fm) : WGM;
        u.pm = fm + ((wgid % nig) % gsz); u.pn = (wgid % nig) / gsz; u.z = 0;
    }
    __host__ __device__ bool next(int i, Unit& u) const { const long L = (long)i * G + c; if (L >= nwg) return false; map((int)L, u); return true; }
    __device__ __forceinline__ void a_ready(const Unit&) const {}
    __device__ __forceinline__ void done(const Unit&) const {}
};
template <int NZ> struct ZOrder {
    StaticOrder S;
    __host__ __device__ bool next(int i, Unit& u) const { const long L = (long)(i / NZ) * S.G + S.c; if (L >= S.nwg) return false; S.map((int)L, u); u.z = i % NZ; return true; }
    __device__ __forceinline__ void a_ready(const Unit&) const {}
    __device__ __forceinline__ void done(const Unit&) const {}
};
struct OneUnit {
    Unit u0;
    __host__ __device__ bool next(int i, Unit& u) const { if (i > 0) return false; u = u0; return true; }
    __device__ __forceinline__ void a_ready(const Unit&) const {}
    __device__ __forceinline__ void done(const Unit&) const {}
};

typedef unsigned u32x2 __attribute__((ext_vector_type(2)));
constexpr float LOG2E = 1.4426950408889634f;
__device__ __forceinline__ float bf2f(unsigned short b) { return __uint_as_float((unsigned)b << 16); }
__device__ __forceinline__ float bflo(unsigned w) { return __uint_as_float(w << 16); }
__device__ __forceinline__ float bfhi(unsigned w) { return __uint_as_float(w & 0xffff0000u); }
__device__ __forceinline__ float sigmoidf_(float v) { return __builtin_amdgcn_rcpf(1.0f + __builtin_amdgcn_exp2f(-v * LOG2E)); }
__device__ __forceinline__ float gelu_tanh(float v) { const float z = 0.7978845608028654f * (v + 0.044715f * v * v * v); return v * sigmoidf_(2.0f * z); }
__device__ __forceinline__ u32x4 pack8(const f32x4 a, const f32x4 b) { u32x4 w; w.x = cvt_pk_bf16(a[0], a[1]); w.y = cvt_pk_bf16(a[2], a[3]); w.z = cvt_pk_bf16(b[0], b[1]); w.w = cvt_pk_bf16(b[2], b[3]); return w; }
__device__ __forceinline__ void row_rstd(const float* SS, int rowbase, int fq, float (&rs)[2][4]) {
#pragma unroll
    for (int ai = 0; ai < 2; ++ai)
#pragma unroll
        for (int m = 0; m < 4; ++m) { const f32x4 v = *(const f32x4*)(SS + (size_t)(rowbase + ai * HALF + m * 16) * 16 + 4 * fq);
            float s = (v[0] + v[1]) + (v[2] + v[3]); s += __shfl_xor(s, 16); s += __shfl_xor(s, 32); rs[ai][m] = rsqrtf(s * (1.0f / 1024.0f) + 1e-6f); }
}
__device__ __forceinline__ float row_rstd1(const float* SS, int row, int fq) { const f32x4 v = *(const f32x4*)(SS + (size_t)row * 16 + 4 * fq);
    float s = (v[0] + v[1]) + (v[2] + v[3]); s += __shfl_xor(s, 16); s += __shfl_xor(s, 32); return rsqrtf(s * (1.0f / 1024.0f) + 1e-6f); }
#define EPI_ARGS const f32x4 (&acc)[2][2][4][2], const Unit& u, int wr, int wc, int fr, int fq
struct EpiSwiGLU { static constexpr bool PERM = true, AFTER_DRAIN = false; const float* SS; bf16_t* O;
    __device__ __forceinline__ void operator()(EPI_ARGS) const {
        float rs[2][4]; row_rstd(SS, u.pm * BM + wr * 64 + fr, fq, rs);
        const int col0 = u.pn * 128 + wc * 32 + 8 * fq;
#pragma unroll
        for (int ai = 0; ai < 2; ++ai)
#pragma unroll
            for (int m = 0; m < 4; ++m) { const float r = rs[ai][m]; f32x4 o[2];
#pragma unroll
                for (int n = 0; n < 2; ++n)
#pragma unroll
                    for (int j = 0; j < 4; ++j) { const float g = acc[ai][0][m][n][j] * r, up = acc[ai][1][m][n][j] * r; o[n][j] = g * sigmoidf_(g) * up; }
                *(u32x4*)(O + (size_t)(u.pm * BM + ai * HALF + wr * 64 + m * 16 + fr) * 2816 + col0) = pack8(o[0], o[1]); }
    }
};
struct EpiResid { static constexpr bool PERM = false, AFTER_DRAIN = false; bf16_t* XB; float* SS; float scale;
    __device__ __forceinline__ void operator()(EPI_ARGS) const {
        const int col0 = u.pn * BM + wc * 32 + 4 * fq;
#pragma unroll
        for (int ai = 0; ai < 2; ++ai)
#pragma unroll
            for (int m = 0; m < 4; ++m) { const int row = u.pm * BM + ai * HALF + wr * 64 + m * 16 + fr; float ssq = 0.f;
#pragma unroll
                for (int bj = 0; bj < 2; ++bj)
#pragma unroll
                    for (int n = 0; n < 2; ++n) { const size_t off = (size_t)row * 1024 + col0 + bj * HALF + n * 16;
                        const u32x2 xw = *(const u32x2*)(XB + off);
                        f32x4 x = {bflo(xw.x), bfhi(xw.x), bflo(xw.y), bfhi(xw.y)}; x = x + acc[ai][bj][m][n] * scale;
                        u32x2 w; w.x = cvt_pk_bf16(x[0], x[1]); w.y = cvt_pk_bf16(x[2], x[3]); *(u32x2*)(XB + off) = w;
                        ssq += (x[0] * x[0] + x[1] * x[1]) + (x[2] * x[2] + x[3] * x[3]); }
                ssq += __shfl_xor(ssq, 16); ssq += __shfl_xor(ssq, 32);
                if (fq == 0) SS[(size_t)row * 16 + u.pn * 4 + wc] = ssq; }
    }
};
struct EpiWin { static constexpr bool PERM = true, AFTER_DRAIN = false; const float* SS; bf16_t* P; float* SSV; float qscale;
    __device__ __forceinline__ void operator()(EPI_ARGS) const {
        const int piece = u.pn >> 1;
        const int slot = piece == 0 ? 0 : piece == 1 ? 3 : piece == 2 ? 4 : piece == 3 ? 1 : piece == 4 ? 5 : piece == 5 ? 8 : piece;
        bf16_t* base = P + (size_t)slot * (16384u * 512u);
        const int col0 = (u.pn & 1) * 256 + wc * 32 + 8 * fq;
        const float sc = piece == 5 ? qscale : 1.0f;
#pragma unroll
        for (int ai = 0; ai < 2; ++ai)
#pragma unroll
            for (int m = 0; m < 4; ++m) { const int row = u.pm * BM + ai * HALF + wr * 64 + m * 16 + fr; const float r = row_rstd1(SS, row, fq) * sc; float ssq = 0.f;
#pragma unroll
                for (int bj = 0; bj < 2; ++bj) { f32x4 v0 = acc[ai][bj][m][0] * r, v1 = acc[ai][bj][m][1] * r;
                    if (piece == 3 || piece == 4) {
#pragma unroll
                        for (int j = 0; j < 4; ++j) { v0[j] = gelu_tanh(v0[j]); v1[j] = gelu_tanh(v1[j]); }
                        ssq += (v0[0] * v0[0] + v0[1] * v0[1]) + (v0[2] * v0[2] + v0[3] * v0[3]) + (v1[0] * v1[0] + v1[1] * v1[1]) + (v1[2] * v1[2] + v1[3] * v1[3]); }
                    *(u32x4*)(base + (size_t)row * 512 + col0 + bj * HALF) = pack8(v0, v1); }
                if (piece == 4) { ssq += __shfl_xor(ssq, 16); ssq += __shfl_xor(ssq, 32); if (fq == 0) SSV[(size_t)row * 8 + (u.pn & 1) * 4 + wc] = ssq; }
                asm volatile("" ::: "memory"); }
    }
};
struct EpiGates { static constexpr bool PERM = true, AFTER_DRAIN = false; const float* SS; bf16_t* G;
    __device__ __forceinline__ void operator()(EPI_ARGS) const {
        float rs[2][4]; row_rstd(SS, u.pm * BM + wr * 64 + fr, fq, rs);
        bf16_t* base = G + (size_t)(u.pn >> 2) * (16384u * 1024u);
        const int col0 = (u.pn & 3) * 256 + wc * 32 + 8 * fq;
#pragma unroll
        for (int ai = 0; ai < 2; ++ai)
#pragma unroll
            for (int m = 0; m < 4; ++m) { const int row = u.pm * BM + ai * HALF + wr * 64 + m * 16 + fr; const float r = rs[ai][m];
#pragma unroll
                for (int bj = 0; bj < 2; ++bj) { f32x4 v0 = acc[ai][bj][m][0] * r, v1 = acc[ai][bj][m][1] * r;
#pragma unroll
                    for (int j = 0; j < 4; ++j) { v0[j] = sigmoidf_(v0[j]); v1[j] = sigmoidf_(v1[j]); }
                    *(u32x4*)(base + (size_t)row * 1024 + col0 + bj * HALF) = pack8(v0, v1); } }
    }
};
struct EpiMerge { static constexpr bool PERM = true, AFTER_DRAIN = false; bf16_t* G;
    __device__ __forceinline__ void operator()(EPI_ARGS) const {
        const bf16_t* gz = G + (size_t)u.z * (16384u * 1024u);
        const int col0 = u.pn * 256 + wc * 32 + 8 * fq;
#pragma unroll
        for (int ai = 0; ai < 2; ++ai)
#pragma unroll
            for (int m = 0; m < 4; ++m) { const int row = u.pm * BM + ai * HALF + wr * 64 + m * 16 + fr;
#pragma unroll
                for (int bj = 0; bj < 2; ++bj) { const size_t off = (size_t)row * 1024 + col0 + bj * HALF;
                    const u32x4 gw = *(const u32x4*)(gz + off);
                    f32x4 g0 = {bflo(gw.x), bfhi(gw.x), bflo(gw.y), bfhi(gw.y)}, g1 = {bflo(gw.z), bfhi(gw.z), bflo(gw.w), bfhi(gw.w)};
                    f32x4 v0 = acc[ai][bj][m][0] * g0, v1 = acc[ai][bj][m][1] * g1;
#ifdef MK_DBG_Z
                    if (u.z != MK_DBG_Z) { v0 = v0 * 0.f; v1 = v1 * 0.f; }
#endif
                    if (u.z != 0) { u32x4 pw; { const unsigned long long a_ = __hip_atomic_load((const unsigned long long*)(G + off), __ATOMIC_RELAXED, __HIP_MEMORY_SCOPE_AGENT), b_ = __hip_atomic_load((const unsigned long long*)(G + off) + 1, __ATOMIC_RELAXED, __HIP_MEMORY_SCOPE_AGENT);
                            pw.x = (unsigned)a_; pw.y = (unsigned)(a_ >> 32); pw.z = (unsigned)b_; pw.w = (unsigned)(b_ >> 32); }
                        v0 = v0 + (f32x4){bflo(pw.x), bfhi(pw.x), bflo(pw.y), bfhi(pw.y)}; v1 = v1 + (f32x4){bflo(pw.z), bfhi(pw.z), bflo(pw.w), bfhi(pw.w)}; }
                    *(u32x4*)(G + off) = pack8(v0, v1); } }
    }
};
template <int MODE> struct EpiScale { static constexpr bool PERM = true, AFTER_DRAIN = false; const float* S; bf16_t* O; int ldc; float scale;
    __device__ __forceinline__ void operator()(EPI_ARGS) const {
        float rs[2][4];
        if (MODE == 1) row_rstd(S, u.pm * BM + wr * 64 + fr, fq, rs);
        const int col0 = (u.pn + u.z) * 256 + wc * 32 + 8 * fq;
#pragma unroll
        for (int ai = 0; ai < 2; ++ai)
#pragma unroll
            for (int m = 0; m < 4; ++m) { const int row = u.pm * BM + ai * HALF + wr * 64 + m * 16 + fr;
                float r = scale; if (MODE == 1) r *= rs[ai][m]; if (MODE == 2) r *= S[row];
#pragma unroll
                for (int bj = 0; bj < 2; ++bj) { f32x4 v0 = acc[ai][bj][m][0] * r, v1 = acc[ai][bj][m][1] * r;
                    if (MODE == 3) { v0 = v0 * *(const f32x4*)(S + col0 + bj * HALF); v1 = v1 * *(const f32x4*)(S + col0 + bj * HALF + 4); }
                    *(u32x4*)(O + (size_t)row * ldc + col0 + bj * HALF) = pack8(v0, v1); } }
    }
};
struct EpiSoftmax { static constexpr bool PERM = true, AFTER_DRAIN = true; bf16_t* O;
    __device__ __forceinline__ void fused(f32x4 (&acc)[2][2][4][2], const Unit& u, int wr, int wc, int fr, int fq, PG8_LAS unsigned char* lds, int wid, int lane) const {
        PG8_LAS float* T1 = (PG8_LAS float*)lds; PG8_LAS float* T2 = (PG8_LAS float*)(lds + 4096);
#pragma unroll
        for (int ai = 0; ai < 2; ++ai)
#pragma unroll
            for (int m = 0; m < 4; ++m) { float mx = -3.0e38f;
#pragma unroll
                for (int bj = 0; bj < 2; ++bj)
#pragma unroll
                    for (int n = 0; n < 2; ++n)
#pragma unroll
                        for (int j = 0; j < 4; ++j) mx = fmaxf(mx, acc[ai][bj][m][n][j]);
                mx = fmaxf(mx, __shfl_xor(mx, 16)); mx = fmaxf(mx, __shfl_xor(mx, 32));
                if (fq == 0) T1[(ai * HALF + wr * 64 + m * 16 + fr) * 4 + wc] = mx; }
        asm volatile("s_waitcnt lgkmcnt(0)" ::: "memory"); __builtin_amdgcn_s_barrier(); asm volatile("" ::: "memory");
#pragma unroll
        for (int ai = 0; ai < 2; ++ai)
#pragma unroll
            for (int m = 0; m < 4; ++m) { const int rl = ai * HALF + wr * 64 + m * 16 + fr; const f32x4 t = *(const PG8_LAS f32x4*)(T1 + rl * 4);
                const float mx = fmaxf(fmaxf(t[0], t[1]), fmaxf(t[2], t[3])); float s = 0.f;
#pragma unroll
                for (int bj = 0; bj < 2; ++bj)
#pragma unroll
                    for (int n = 0; n < 2; ++n)
#pragma unroll
                        for (int j = 0; j < 4; ++j) { const float p = __builtin_amdgcn_exp2f(acc[ai][bj][m][n][j] - mx); acc[ai][bj][m][n][j] = p; s += p; }
                s += __shfl_xor(s, 16); s += __shfl_xor(s, 32);
                if (fq == 0) T2[rl * 4 + wc] = s; }
        asm volatile("s_waitcnt lgkmcnt(0)" ::: "memory"); __builtin_amdgcn_s_barrier(); asm volatile("" ::: "memory");
        const int col0 = u.z * 256 + wc * 32 + 8 * fq;
#pragma unroll
        for (int ai = 0; ai < 2; ++ai)
#pragma unroll
            for (int m = 0; m < 4; ++m) { const int rl = ai * HALF + wr * 64 + m * 16 + fr; const f32x4 t = *(const PG8_LAS f32x4*)(T2 + rl * 4);
                const float inv = 1.0f / ((t[0] + t[1]) + (t[2] + t[3]));
#pragma unroll
                for (int bj = 0; bj < 2; ++bj) *(u32x4*)(O + (size_t)(u.pm * BM + rl) * 1024 + col0 + bj * HALF) = pack8(acc[ai][bj][m][0] * inv, acc[ai][bj][m][1] * inv); }
        asm volatile("s_waitcnt lgkmcnt(0)" ::: "memory"); __builtin_amdgcn_s_barrier(); asm volatile("" ::: "memory");
    }
};

template <class Epi, class Sched, bool ALIGN_EPI = false, bool SP2 = false>
__device__ __forceinline__ void gemm_phase(PG8_LAS unsigned char* lds, const Gemm g, const Sched& S, const Epi& E) {
    int tid_o = threadIdx.x; asm volatile("" : "+v"(tid_o)); const int tid = tid_o, wid = __builtin_amdgcn_readfirstlane(tid >> 6), lane = tid & 63, wr = wid >> 2, wc = wid & 3, fr = lane & 15, fq = lane >> 4;
    const int nt = g.K / BK; const char* gA_ = reinterpret_cast<const char*>(g.A); const char* gB_ = reinterpret_cast<const char*>(g.Bt); asm volatile("" : "+s"(gA_), "+s"(gB_));
    unsigned voffA[2], voffB[2];
#pragma unroll
    for (int i = 0; i < 2; ++i) { int R, C; stage_rc(tid * 16 + i * 8192, R, C); const int Rb = Epi::PERM ? ((R & ~31) + perm32(R & 31)) : R;
        voffA[i] = (unsigned)(R * g.lda + C) * 2u; voffB[i] = (unsigned)(Rb * g.ldb + C) * 2u; }
    const size_t kstep = (size_t)(BK * 2);
    const size_t hstepA = (size_t)HALF * g.lda * 2, hstepB = (size_t)HALF * g.ldb * 2;

    const unsigned ldsw = (unsigned)wid * 1024u;
    const int aoff = lds_byte(wr * 64 + fr, fq * 8), boff = lds_byte(wc * 32 + fr, fq * 8);
#define PG8_SA(b, h) (((b) * 2 + (h)) * HTB)
#define PG8_SB(b, h) ((4 + (b) * 2 + (h)) * HTB)
#define PG8_STAGE(bufoff, gbase, voff) do { _Pragma("unroll") for (int _i = 0; _i < 2; ++_i) \
        __builtin_amdgcn_global_load_lds((const unsigned*)((const char*)(gbase) + (voff)[_i]), (PG8_LAS unsigned*)(lds + (bufoff) + ldsw + _i * 8192), 16, 0, 0); } while (0)
#define PG8_LDA(dst, b, h) do { _Pragma("unroll") for (int m = 0; m < 4; ++m) _Pragma("unroll") for (int k = 0; k < 2; ++k) dst[m][k] = *(const PG8_LAS bf16x8*)(lds + PG8_SA(b, h) + aoff + m * 2048 + k * 1024); } while (0)
#define PG8_LDB(dst, b, h) do { _Pragma("unroll") for (int n = 0; n < 2; ++n) _Pragma("unroll") for (int k = 0; k < 2; ++k) dst[n][k] = *(const PG8_LAS bf16x8*)(lds + PG8_SB(b, h) + boff + n * 2048 + k * 1024); } while (0)
#define PG8_MMA(ai, bj, At, Bt) do { __builtin_amdgcn_s_setprio(1); _Pragma("unroll") for (int m = 0; m < 4; ++m) _Pragma("unroll") for (int n = 0; n < 2; ++n) _Pragma("unroll") for (int k = 0; k < 2; ++k) \
        acc[ai][bj][m][n] = __builtin_amdgcn_mfma_f32_16x16x32_bf16(Bt[n][k], At[m][k], acc[ai][bj][m][n], 0, 0, 0); __builtin_amdgcn_s_setprio(0); } while (0)
#define PG8_WAIT_V(n) asm volatile("s_waitcnt vmcnt(" #n ")" ::: "memory")
#define PG8_WAIT_L(n) asm volatile("s_waitcnt lgkmcnt(" #n ")" ::: "memory")
#define PG8_BAR __builtin_amdgcn_s_barrier()
#define PG8_SCHED __builtin_amdgcn_sched_barrier(0)
    Unit cur, nxt; int ui = 0;
    if (!S.next(0, cur)) return;
    f32x4 acc[2][2][4][2];
#pragma unroll
    for (int a = 0; a < 2; ++a)
#pragma unroll
        for (int b = 0; b < 2; ++b)
#pragma unroll
            for (int m = 0; m < 4; ++m)
#pragma unroll
                for (int n = 0; n < 2; ++n) acc[a][b][m][n] = (f32x4){0.f, 0.f, 0.f, 0.f};
    bf16x8 At[4][2], B0[2][2], B1[2][2];
    const char* cA = gA_ + (size_t)cur.pm * 2 * hstepA + (size_t)cur.z * g.zA; const char* cB = gB_ + (size_t)cur.pn * 2 * hstepB + (size_t)cur.z * g.zB;
    S.a_ready(cur);
    if constexpr (SP2) {
        PG8_STAGE(PG8_SB(0, 0), cB, voffB); PG8_STAGE(PG8_SB(0, 1), cB + hstepB, voffB); PG8_STAGE(PG8_SA(0, 0), cA, voffA); PG8_STAGE(PG8_SA(0, 1), cA + hstepA, voffA);
        if (wr == 1) PG8_BAR;
        PG8_WAIT_V(2); PG8_BAR;
        PG8_STAGE(PG8_SB(1, 0), cB + kstep, voffB); PG8_STAGE(PG8_SA(1, 0), cA + kstep, voffA); PG8_STAGE(PG8_SB(1, 1), cB + hstepB + kstep, voffB);
        PG8_WAIT_V(6); PG8_BAR;
    } else {
        PG8_STAGE(PG8_SB(0, 0), cB, voffB); PG8_STAGE(PG8_SA(0, 0), cA, voffA); PG8_STAGE(PG8_SB(0, 1), cB + hstepB, voffB); PG8_STAGE(PG8_SA(0, 1), cA + hstepA, voffA);
        if (wr == 1) PG8_BAR;
        PG8_WAIT_V(4); PG8_BAR;
        PG8_STAGE(PG8_SB(1, 0), cB + kstep, voffB); PG8_STAGE(PG8_SA(1, 0), cA + kstep, voffA); PG8_STAGE(PG8_SB(1, 1), cB + hstepB + kstep, voffB);
        PG8_WAIT_V(6); PG8_BAR;
    }
    for (;;) {
        const bool has_next = S.next(ui + 1, nxt);
        const char* nA = has_next ? gA_ + (size_t)nxt.pm * 2 * hstepA + (size_t)nxt.z * g.zA : cA; const char* nB = has_next ? gB_ + (size_t)nxt.pn * 2 * hstepB + (size_t)nxt.z * g.zB : cB;
_Pragma("nounroll")
        for (int t = 0; t < nt; t += 2) {
            const bool last = (t == nt - 2);
            const char* a1 = cA + (size_t)(t + 1) * kstep;
            const char* a2 = last ? nA : cA + (size_t)(t + 2) * kstep; const char* b2 = last ? nB : cB + (size_t)(t + 2) * kstep;
            const char* a3 = a2 + kstep; const char* b3 = b2 + kstep;
            if (last && has_next) S.a_ready(nxt);
            if constexpr (SP2) {
            PG8_LDB(B0, 0, 0); PG8_LDB(B1, 0, 1); PG8_SCHED; PG8_LDA(At, 0, 0); PG8_STAGE(PG8_SA(1, 1), a1 + hstepA, voffA);
            PG8_WAIT_V(8); PG8_WAIT_L(0); PG8_BAR; PG8_MMA(0, 0, At, B0); PG8_MMA(0, 1, At, B1); PG8_BAR; PG8_SCHED;
            PG8_LDA(At, 0, 1); PG8_STAGE(PG8_SB(0, 0), b2, voffB); PG8_STAGE(PG8_SB(0, 1), b2 + hstepB, voffB); PG8_STAGE(PG8_SA(0, 0), a2, voffA);
            PG8_WAIT_V(8); PG8_WAIT_L(0); PG8_BAR; PG8_MMA(1, 0, At, B0); PG8_MMA(1, 1, At, B1); PG8_BAR; PG8_SCHED;
            PG8_LDB(B0, 1, 0); PG8_LDB(B1, 1, 1); PG8_SCHED; PG8_LDA(At, 1, 0); PG8_STAGE(PG8_SA(0, 1), a2 + hstepA, voffA);
            PG8_WAIT_V(8); PG8_WAIT_L(0); PG8_BAR; PG8_MMA(0, 0, At, B0); PG8_MMA(0, 1, At, B1); PG8_BAR; PG8_SCHED;
            PG8_LDA(At, 1, 1); PG8_STAGE(PG8_SB(1, 0), b3, voffB); PG8_STAGE(PG8_SB(1, 1), b3 + hstepB, voffB); PG8_STAGE(PG8_SA(1, 0), a3, voffA);
            PG8_WAIT_V(8); PG8_WAIT_L(0); PG8_BAR; PG8_MMA(1, 0, At, B0); PG8_MMA(1, 1, At, B1); PG8_BAR; PG8_SCHED;
            } else {
            PG8_LDB(B0, 0, 0); PG8_SCHED; PG8_LDA(At, 0, 0); PG8_STAGE(PG8_SA(1, 1), a1 + hstepA, voffA);
            PG8_WAIT_L(8); PG8_BAR; PG8_WAIT_L(0); PG8_MMA(0, 0, At, B0); PG8_BAR; PG8_SCHED;
            PG8_LDB(B1, 0, 1); PG8_STAGE(PG8_SB(0, 0), b2, voffB);
            PG8_BAR; PG8_WAIT_L(0); PG8_MMA(0, 1, At, B1); PG8_BAR;
            PG8_LDA(At, 0, 1); PG8_STAGE(PG8_SA(0, 0), a2, voffA);
            PG8_BAR; PG8_WAIT_L(0); PG8_MMA(1, 0, At, B0); PG8_BAR; PG8_SCHED;
            PG8_STAGE(PG8_SB(0, 1), b2 + hstepB, voffB);
            PG8_WAIT_V(6); PG8_BAR; PG8_MMA(1, 1, At, B1); PG8_BAR;
            PG8_LDB(B0, 1, 0); PG8_SCHED; PG8_LDA(At, 1, 0); PG8_STAGE(PG8_SA(0, 1), a2 + hstepA, voffA);
            PG8_WAIT_L(8); PG8_BAR; PG8_WAIT_L(0); PG8_MMA(0, 0, At, B0); PG8_BAR; PG8_SCHED;
            PG8_LDB(B1, 1, 1); PG8_STAGE(PG8_SB(1, 0), b3, voffB);
            PG8_BAR; PG8_WAIT_L(0); PG8_MMA(0, 1, At, B1); PG8_BAR;
            PG8_LDA(At, 1, 1); PG8_STAGE(PG8_SA(1, 0), a3, voffA);
            PG8_BAR; PG8_WAIT_L(0); PG8_MMA(1, 0, At, B0); PG8_BAR; PG8_SCHED;
            PG8_STAGE(PG8_SB(1, 1), b3 + hstepB, voffB);
            PG8_WAIT_V(6); PG8_BAR; PG8_MMA(1, 1, At, B1); PG8_BAR;
            }
        }
        if constexpr (ALIGN_EPI) { if (wr == 0) PG8_BAR; }
        if constexpr (!Epi::AFTER_DRAIN) { E(acc, cur, wr, wc, fr, fq); S.done(cur); }
        if (!has_next) break;
#pragma unroll
        for (int a = 0; a < 2; ++a)
#pragma unroll
            for (int b = 0; b < 2; ++b)
#pragma unroll
                for (int m = 0; m < 4; ++m)
#pragma unroll
                    for (int n = 0; n < 2; ++n) acc[a][b][m][n] = (f32x4){0.f, 0.f, 0.f, 0.f};
        cur = nxt; cA = nA; cB = nB; ++ui;
        if constexpr (ALIGN_EPI) { if (wr == 1) PG8_BAR; }
    }
    PG8_WAIT_V(0);
    if constexpr (!ALIGN_EPI) { if (wr == 0) PG8_BAR; }
    PG8_BAR;
    if constexpr (Epi::AFTER_DRAIN) { E.fused(acc, cur, wr, wc, fr, fq, lds, wid, lane); S.done(cur); }
#undef PG8_SA
#undef PG8_SB
#undef PG8_STAGE
#undef PG8_LDA
#undef PG8_LDB
#undef PG8_MMA
#undef PG8_WAIT_V
#undef PG8_WAIT_L
#undef PG8_BAR
#undef PG8_SCHED
}
}
#include <hip/hip_bf16.h>
#include <cmath>
namespace attn_body {
using bf16=__hip_bfloat16;
using bf16x8=__attribute__((ext_vector_type(8)))short;
using s16x4=__attribute__((ext_vector_type(4)))short;
using f32x16=__attribute__((ext_vector_type(16)))float;
using u32x4=__attribute__((ext_vector_type(4)))unsigned;
using f32x4_t=__attribute__((ext_vector_type(4)))float;
constexpr int BATCH=1,NHEAD=8,SEQ=16384,D=64,DM=NHEAD*D;
constexpr int NW=8,QBLK=32,QB=QBLK*NW,KVBLK=64,NQB=SEQ/QB;
constexpr int ATTN_PITCH=DM, ATTN_UNIT_ROWS=QB;
__device__ __forceinline__ int crow(int r,int hi){return (r&3)+8*(r>>2)+4*hi;}
#define SBAR() __builtin_amdgcn_sched_barrier(0)
__device__ __forceinline__ void cmask(f32x16&p0,f32x16&p1,int jb,int qrel,int hi){
  const float NEG=-INFINITY; int kb=64*jb+4*hi;
  #pragma unroll
  for(int r=0;r<16;++r){int kv=kb+(r&3)+8*(r>>2); if(kv>qrel)p0[r]=NEG; if(kv+32>qrel)p1[r]=NEG;}
}

constexpr int NSLOT=3, SLOTB=8192;
constexpr int LDS_K=0, LDS_V=NSLOT*SLOTB, LDS_WS=2*NSLOT*SLOTB, LDS_OST=LDS_WS+NW*64*4, LDS_CK=LDS_OST+NW*4096, LDS_BYTES=LDS_CK+SEQ*4;
constexpr float C2=0.125f*1.4426950408889634f;
__device__ __forceinline__ void glds16(const void*gsrc,unsigned lds_dst){unsigned keep;
  asm volatile("s_mov_b32 %0, m0\n\ts_mov_b32 m0, %2\n\ts_nop 0\n\tglobal_load_lds_dwordx4 %1, off\n\ts_mov_b32 m0, %0":"=&s"(keep):"v"(gsrc),"s"(lds_dst):"memory");}
__device__ __forceinline__ float max3f(float a,float b,float c){float r;asm("v_max3_f32 %0, %1, %2, %3":"=v"(r):"v"(a),"v"(b),"v"(c));return r;}
__device__ __forceinline__ float max2f(float a,float b){float r;asm("v_max_f32_e32 %0, %1, %2":"=v"(r):"v"(a),"v"(b));return r;}
__device__ __forceinline__ float fadd_s(float a,float b){float r;asm("v_add_f32_e32 %0, %1, %2":"=v"(r):"v"(a),"v"(b));return r;}
__device__ __forceinline__ float fsub_s(float a,float b){float r;asm("v_sub_f32_e32 %0, %1, %2":"=v"(r):"v"(a),"v"(b));return r;}
typedef float f32x2_t __attribute__((ext_vector_type(2))); typedef __bf16 bf16x2_t __attribute__((ext_vector_type(2)));
__device__ __forceinline__ unsigned cvtpk_s(float lo,float hi){f32x2_t v={lo,hi};bf16x2_t b=__builtin_convertvector(v,bf16x2_t);return __builtin_bit_cast(unsigned,b);}
#define WAIT_BAR(N) asm volatile("s_waitcnt vmcnt(" #N ") lgkmcnt(0)\n\ts_barrier":::"memory")

__device__ __forceinline__ void qkt(f32x16&p0,f32x16&p1,const char*Kslot,const bf16x8*qr,const f32x16&negm,int r32,int hi){
  const char*kb=Kslot+hi*1024+r32*16;
  #pragma unroll
  for(int d0=0;d0<4;++d0){
    const bf16x8 b0=*reinterpret_cast<const bf16x8*>(kb+d0*2048);
    const bf16x8 b1=*reinterpret_cast<const bf16x8*>(kb+d0*2048+512);
    if(d0==0){p0=__builtin_amdgcn_mfma_f32_32x32x16_bf16(b0,qr[0],negm,0,0,0);p1=__builtin_amdgcn_mfma_f32_32x32x16_bf16(b1,qr[0],negm,0,0,0);}
    else{p0=__builtin_amdgcn_mfma_f32_32x32x16_bf16(b0,qr[d0],p0,0,0,0);p1=__builtin_amdgcn_mfma_f32_32x32x16_bf16(b1,qr[d0],p1,0,0,0);}}
}
typedef __attribute__((address_space(3))) const char* lds_cptr;
typedef short v4i16_t __attribute__((ext_vector_type(4)));
__device__ __forceinline__ void kload8(bf16x8*kf,lds_cptr kp){
  kf[0]=*(const __attribute__((address_space(3))) bf16x8*)(kp);      kf[1]=*(const __attribute__((address_space(3))) bf16x8*)(kp+512);
  kf[2]=*(const __attribute__((address_space(3))) bf16x8*)(kp+2048); kf[3]=*(const __attribute__((address_space(3))) bf16x8*)(kp+2560);
  kf[4]=*(const __attribute__((address_space(3))) bf16x8*)(kp+4096); kf[5]=*(const __attribute__((address_space(3))) bf16x8*)(kp+4608);
  kf[6]=*(const __attribute__((address_space(3))) bf16x8*)(kp+6144); kf[7]=*(const __attribute__((address_space(3))) bf16x8*)(kp+6656);
}
__device__ __forceinline__ void kload2(bf16x8*kf,lds_cptr kp,int j){ kf[2*j]=*(const __attribute__((address_space(3))) bf16x8*)(kp+j*2048); kf[2*j+1]=*(const __attribute__((address_space(3))) bf16x8*)(kp+j*2048+512); }
__device__ __forceinline__ s16x4 vtr(lds_cptr p){ return __builtin_bit_cast(s16x4,__builtin_amdgcn_ds_read_tr16_b64_v4i16((__attribute__((address_space(3))) v4i16_t*)p)); }
__device__ __forceinline__ float rowmax(const f32x16&p0,const f32x16&p1){
  float a=max3f(p0[0],p0[1],p1[0]),b=max3f(p0[2],p0[3],p1[1]);a=max3f(a,p1[2],p1[3]);
  #pragma unroll
  for(int r=4;r<16;r+=4){a=max3f(a,p0[r],p0[r+1]);b=max3f(b,p0[r+2],p0[r+3]);a=max3f(a,p1[r],p1[r+1]);b=max3f(b,p1[r+2],p1[r+3]);}
  const float m=max2f(a,b);
  auto rr=__builtin_amdgcn_permlane32_swap(__float_as_uint(m),__float_as_uint(m),false,false);
  return max2f(__uint_as_float(rr[0]),__uint_as_float(rr[1]));
}
__device__ __forceinline__ void pv(f32x16*o,int vb,bf16x8 pa0,bf16x8 pa1,bf16x8 pa2,bf16x8 pa3){
  #pragma unroll
  for(int d0=0;d0<2;++d0){s16x4 lo[4],hi[4];
    #pragma unroll
    for(int ks=0;ks<4;++ks){
      asm volatile("ds_read_b64_tr_b16 %0,%1 offset:%c2":"=&v"(lo[ks]):"v"(vb),"i"(d0*4096+ks*1024):"memory");
      asm volatile("ds_read_b64_tr_b16 %0,%1 offset:%c2":"=&v"(hi[ks]):"v"(vb),"i"(d0*4096+ks*1024+512):"memory");}
    asm volatile("s_waitcnt lgkmcnt(0)":::"memory");SBAR();
    #define PK(k) (bf16x8){lo[k][0],lo[k][1],lo[k][2],lo[k][3],hi[k][0],hi[k][1],hi[k][2],hi[k][3]}
    o[d0]=__builtin_amdgcn_mfma_f32_32x32x16_bf16(pa0,PK(0),o[d0],0,0,0);
    o[d0]=__builtin_amdgcn_mfma_f32_32x32x16_bf16(pa1,PK(1),o[d0],0,0,0);
    o[d0]=__builtin_amdgcn_mfma_f32_32x32x16_bf16(pa2,PK(2),o[d0],0,0,0);
    o[d0]=__builtin_amdgcn_mfma_f32_32x32x16_bf16(pa3,PK(3),o[d0],0,0,0);
    #undef PK
  }
}

#ifndef ATTN_STORE16
#define ATTN_STORE16(p,v) (*(u32x4*)(p)=(v))
#endif
template<int THRL> __device__ __forceinline__ void attn_unit(int b,int h,int qb,const bf16*Q,const bf16*__restrict__ K,const bf16*__restrict__ V,bf16*O,const float*__restrict__ CSg,const unsigned*KMg,char*shm){
  int tid_o=threadIdx.x; asm volatile("":"+v"(tid_o)); const int tid=tid_o,lane=tid&63,r32=lane&31,hi=lane>>5; const int wid=__builtin_amdgcn_readfirstlane(tid>>6);
  const long rowbase=(long)b*SEQ; const int q0=qb*QB;
  const bf16*Qw=Q+(rowbase+q0+wid*QBLK)*DM+h*D;
  const bf16*Kh=K+rowbase*DM+h*D,*Vh=V+rowbase*DM+h*D;
  const unsigned lds0=(unsigned)(uintptr_t)shm;
  float*wsf=(float*)(shm+LDS_WS)+wid*64;
  const lds_cptr shm3=(lds_cptr)shm;
  const bf16*ksrc=Kh+(long)lane*DM+wid*8;
  const bf16*vsrc=Vh+(long)(16*(wid&3)+(lane>>2))*DM+(wid>>2)*32+(lane&3)*8;
  const unsigned kdst=lds0+LDS_K+wid*1024, vdst=lds0+LDS_V+wid*1024;
  #define DMA_K(t,slot) glds16(ksrc+(long)(t)*KVBLK*DM,(unsigned)__builtin_amdgcn_readfirstlane(kdst+(slot)))
  #define DMA_V(t,slot) glds16(vsrc+(long)(t)*KVBLK*DM,(unsigned)__builtin_amdgcn_readfirstlane(vdst+(slot)))
  const int vb0=(int)(lds0+LDS_V)+((lane>>4)&1)*32+(lane&3)*8+(4*hi+((lane&15)>>2))*64;
  const char*Kbase=shm+LDS_K; bf16x8 kf[8];
  const lds_cptr kp0=shm3+LDS_K+hi*1024+r32*16; const lds_cptr vp0=shm3+LDS_V+((lane>>4)&1)*32+(lane&3)*8+(4*hi+((lane&15)>>2))*64;
  const int NT=(q0+QB)/KVBLK;
  typedef __attribute__((address_space(3))) float* lds_fptr; typedef __attribute__((address_space(3))) f32x4_t* lds_f4ptr;
  const float*csh=CSg+(long)h*SEQ;
  { const lds_fptr ckw=(lds_fptr)(shm3+LDS_CK);
    for(int i=tid*4;i<q0+QB;i+=NW*64*4){ const f32x4_t v=*(const f32x4_t*)(csh+i); *(lds_f4ptr)(ckw+i)=v; }
  }
  const float cq=csh[q0+wid*QBLK+r32];
  asm volatile("s_waitcnt vmcnt(0) lgkmcnt(0)\n\ts_barrier":::"memory");
  const lds_fptr ckt=(lds_fptr)(shm3+LDS_CK)+4*hi;
  #define CKSUB(P0,P1,t) do{ const lds_fptr ckp_=ckt+64*(t); _Pragma("unroll") for(int j_=0;j_<4;++j_){ const f32x4_t a_=*(const lds_f4ptr)(ckp_+8*j_); const f32x4_t b_=*(const lds_f4ptr)(ckp_+32+8*j_); \
      P0[4*j_]-=a_[0];P0[4*j_+1]-=a_[1];P0[4*j_+2]-=a_[2];P0[4*j_+3]-=a_[3]; P1[4*j_]-=b_[0];P1[4*j_+1]-=b_[1];P1[4*j_+2]-=b_[2];P1[4*j_+3]-=b_[3]; SBAR(); } }while(0)
  DMA_K(0,0);DMA_V(0,0);DMA_K(1,SLOTB);
  bf16x8 qr[4];
  #pragma unroll
  for(int d0=0;d0<4;++d0)qr[d0]=*reinterpret_cast<const bf16x8*>(&Qw[(long)r32*DM+d0*16+hi*8]);
  float l_reg=0.f;f32x16 o[2];o[0]=f32x16{};o[1]=f32x16{};f32x16 negm;
  {
    float q2=0.f;
    _Pragma("unroll") for(int d0=0;d0<4;++d0) _Pragma("unroll") for(int e=0;e<8;++e){ const float v=__uint_as_float(((unsigned)(unsigned short)qr[d0][e])<<16); q2+=v*v; }
    { auto rr=__builtin_amdgcn_permlane32_swap(__float_as_uint(q2),__float_as_uint(q2),false,false); q2=__uint_as_float(rr[0])+__uint_as_float(rr[1]); }
    const float km2=__uint_as_float(__hip_atomic_load(KMg+h,__ATOMIC_RELAXED,__HIP_MEMORY_SCOPE_AGENT));
    const float Rq=sqrtf(q2*km2)*1.001f+0.01f;
    _Pragma("unroll") for(int r=0;r<16;++r)negm[r]=cq-Rq; asm volatile("":"+v"(negm)); }
  const int qrel=wid*QBLK+r32;
  #define CMASK(P0,P1,t) do{int jb_=(t)-(NT-4); if(jb_>=0)cmask(P0,P1,jb_,qrel,hi);}while(0)
  #define START(P0,P1) do{ const float rm=rowmax(P0,P1); resc=false; \
    { const float dl=rm; mhat=fadd_s(mhat,dl); \
      _Pragma("unroll") for(int r=0;r<16;++r){P0[r]=fsub_s(P0[r],dl);P1[r]=fsub_s(P1[r],dl);} \
      _Pragma("unroll") for(int r=0;r<16;++r)negm[r]=-mhat; asm volatile("":"+v"(negm)); } \
    _Pragma("unroll") for(int r=0;r<16;++r)P0[r]=__builtin_amdgcn_exp2f(P0[r]); }while(0)
  #define RESC() do{ if(resc){ asm volatile("s_waitcnt lgkmcnt(0)":::"memory"); \
      _Pragma("unroll") for(int d_=0;d_<2;++d_) _Pragma("unroll") for(int r=0;r<16;++r)o[d_][r]*=wsf[crow(r,hi)]; } }while(0)
  f32x16 pA0,pA1,pB0,pB1;
  int sl_prev=0,sl_cur=0,sl_next=SLOTB;
  #define ROT() do{sl_prev=sl_cur;sl_cur=sl_next;sl_next=(sl_next==(NSLOT-1)*SLOTB)?0:sl_next+SLOTB;}while(0)
  DMA_K(2,2*SLOTB);
  WAIT_BAR(3);
  qkt(pA0,pA1,Kbase,qr,negm,r32,hi);asm volatile("s_nop 15\n\ts_nop 7":"+v"(pA0),"+v"(pA1));CKSUB(pA0,pA1,0);CMASK(pA0,pA1,0);
  _Pragma("unroll") for(int r=0;r<16;++r)pA0[r]=__builtin_amdgcn_exp2f(pA0[r]);
  _Pragma("unroll") for(int r=0;r<16;++r)pA1[r]=__builtin_amdgcn_exp2f(pA1[r]);
  WAIT_BAR(0);
  DMA_K(3,0);DMA_V(1,SLOTB);
  ROT();
  kload8(kf,kp0+sl_cur);
  WAIT_BAR(2);
  s16x4 vlo[8],vhi[8]; u32x4 pw0,pw1,pw2,pw3;
  #define PKW(P,B) cvtpk_s(P[B],P[B+1])
  #define PAF(k) __builtin_bit_cast(bf16x8,pw##k)
  #define VFR(i) (bf16x8){vlo[i][0],vlo[i][1],vlo[i][2],vlo[i][3],vhi[i][0],vhi[i][1],vhi[i][2],vhi[i][3]}
  #define PIN(x) asm volatile("":"+v"(x))
  #define MX3(a,b,c) __builtin_fmaxf(__builtin_fmaxf((a),(b)),(c))
  #define GAPA(MF,A0,A1,A2,A3,W0,W1,PW) do{ MF; sacc+=A0; sacc+=A1; sacc+=A2; sacc+=A3; PIN(sacc); W0; W1; PIN(PW); SBAR(); }while(0)
  #define EX(v) __builtin_amdgcn_exp2f(v)
  #define GAPB(MF,X,B,CUR,NXT,NOFF) do{ MF; if((NOFF)>=0){ NXT=*(const lds_f4ptr)(ckp_+((NOFF)>=0?(NOFF):0)); } X[B]=EX(X[B]-CUR[0]); X[B+1]=EX(X[B+1]-CUR[1]); X[B+2]=EX(X[B+2]-CUR[2]); X[B+3]=EX(X[B+3]-CUR[3]); PIN(X); SBAR(); }while(0)
  #define VRD(i) do{ vlo[i]=vtr(vp_+(((i)>>2)*4096+((i)&3)*1024)); vhi[i]=vtr(vp_+(((i)>>2)*4096+((i)&3)*1024+512)); }while(0)
  #define KRD(G,j) do{ if(G){ kload2(kf,kp0+sl_next,j); SBAR(); } }while(0)
  #define STEP(C0,C1,P0,P1,t,GK,GV,GL) do{ SBAR(); \
    const lds_cptr vp_=vp0+sl_prev; \
    VRD(0); SBAR(); float sacc=(P0[0]+P0[1]); \
    GAPA(C0=__builtin_amdgcn_mfma_f32_32x32x16_bf16(kf[0],qr[0],negm,0,0,0), P0[2],P0[3],P0[4],P0[5],     pw0[0]=PKW(P0,0), pw0[1]=PKW(P0,2), pw0); \
    VRD(4); SBAR(); GAPA(C1=__builtin_amdgcn_mfma_f32_32x32x16_bf16(kf[1],qr[0],negm,0,0,0), P0[6],P0[7],P0[8],P0[9],     pw0[2]=PKW(P0,4), pw0[3]=PKW(P0,6), pw0); \
    VRD(1); SBAR(); GAPA(C0=__builtin_amdgcn_mfma_f32_32x32x16_bf16(kf[2],qr[1],C0,0,0,0),   P0[10],P0[11],P0[12],P0[13], pw1[0]=PKW(P0,8), pw1[1]=PKW(P0,10), pw1); \
    VRD(5); SBAR(); GAPA(C1=__builtin_amdgcn_mfma_f32_32x32x16_bf16(kf[3],qr[1],C1,0,0,0),   P0[14],P0[15],P1[0],P1[1],   pw1[2]=PKW(P0,12),pw1[3]=PKW(P0,14), pw1); \
    VRD(2); SBAR(); GAPA(C0=__builtin_amdgcn_mfma_f32_32x32x16_bf16(kf[4],qr[2],C0,0,0,0),   P1[2],P1[3],P1[4],P1[5],     pw2[0]=PKW(P1,0), pw2[1]=PKW(P1,2), pw2); \
    VRD(6); SBAR(); GAPA(C1=__builtin_amdgcn_mfma_f32_32x32x16_bf16(kf[5],qr[2],C1,0,0,0),   P1[6],P1[7],P1[8],P1[9],     pw2[2]=PKW(P1,4), pw2[3]=PKW(P1,6), pw2); \
    VRD(3); SBAR(); GAPA(C0=__builtin_amdgcn_mfma_f32_32x32x16_bf16(kf[6],qr[3],C0,0,0,0),   P1[10],P1[11],P1[12],P1[13], pw3[0]=PKW(P1,8), pw3[1]=PKW(P1,10), pw3); \
    VRD(7); SBAR(); GAPA(C1=__builtin_amdgcn_mfma_f32_32x32x16_bf16(kf[7],qr[3],C1,0,0,0),   P1[14],P1[15],0.f,0.f,       pw3[2]=PKW(P1,12),pw3[3]=PKW(P1,14), pw3); \
    l_reg+=sacc; \
    if(GK){DMA_K((t)+3,sl_cur);} if(GV){DMA_V((t)+1,sl_next);} \
    CMASK(C0,C1,t); \
    const lds_fptr ckp_=ckt+64*(t); f32x4_t ckA_=*(const lds_f4ptr)(ckp_), ckB_; \
    SBAR(); \
    GAPB(o[0]=__builtin_amdgcn_mfma_f32_32x32x16_bf16(PAF(0),VFR(0),o[0],0,0,0), C0,0,ckA_,ckB_,8); \
    GAPB(o[1]=__builtin_amdgcn_mfma_f32_32x32x16_bf16(PAF(0),VFR(4),o[1],0,0,0), C0,4,ckB_,ckA_,16); \
    KRD(GL,0); GAPB(o[0]=__builtin_amdgcn_mfma_f32_32x32x16_bf16(PAF(1),VFR(1),o[0],0,0,0), C0,8,ckA_,ckB_,24); \
    KRD(GL,1); GAPB(o[1]=__builtin_amdgcn_mfma_f32_32x32x16_bf16(PAF(1),VFR(5),o[1],0,0,0), C0,12,ckB_,ckA_,32); \
    KRD(GL,2); GAPB(o[0]=__builtin_amdgcn_mfma_f32_32x32x16_bf16(PAF(2),VFR(2),o[0],0,0,0), C1,0,ckA_,ckB_,40); \
    KRD(GL,3); GAPB(o[1]=__builtin_amdgcn_mfma_f32_32x32x16_bf16(PAF(2),VFR(6),o[1],0,0,0), C1,4,ckB_,ckA_,48); \
    GAPB(o[0]=__builtin_amdgcn_mfma_f32_32x32x16_bf16(PAF(3),VFR(3),o[0],0,0,0), C1,8,ckA_,ckB_,56); \
    GAPB(o[1]=__builtin_amdgcn_mfma_f32_32x32x16_bf16(PAF(3),VFR(7),o[1],0,0,0), C1,12,ckB_,ckA_,-1); \
    }while(0)
  int t=1;
  #undef CMASK
  #define CMASK(P0,P1,t) do{}while(0)
  for(;t+5<NT;t+=2){
    STEP(pB0,pB1,pA0,pA1,t,true,true,true);     WAIT_BAR(2); ROT();
    STEP(pA0,pA1,pB0,pB1,t+1,true,true,true);   WAIT_BAR(2); ROT();
  }
  #undef CMASK
  #define CMASK(P0,P1,t) do{int jb_=(t)-(NT-4); if(jb_>=0)cmask(P0,P1,jb_,qrel,hi);}while(0)
  #define ENDW(tt) do{ if((tt)+3<NT){WAIT_BAR(2);} else if((tt)+2<NT){WAIT_BAR(1);} else {WAIT_BAR(0);} }while(0)
  for(;t+1<NT;t+=2){
    STEP(pB0,pB1,pA0,pA1,t,(t+3<NT),(t+1<NT),(t+1<NT));       ENDW(t); ROT();
    STEP(pA0,pA1,pB0,pB1,t+1,(t+4<NT),(t+2<NT),(t+2<NT));     ENDW(t+1); ROT();
  }
  STEP(pB0,pB1,pA0,pA1,NT-1,false,false,false);
  { float sacc=pB0[0]+pB0[1]; _Pragma("unroll") for(int r=2;r<16;++r)sacc+=pB0[r]; _Pragma("unroll") for(int r=0;r<16;++r)sacc+=pB1[r]; l_reg+=sacc;
    pw0=(u32x4){PKW(pB0,0),PKW(pB0,2),PKW(pB0,4),PKW(pB0,6)};pw1=(u32x4){PKW(pB0,8),PKW(pB0,10),PKW(pB0,12),PKW(pB0,14)};pw2=(u32x4){PKW(pB1,0),PKW(pB1,2),PKW(pB1,4),PKW(pB1,6)};pw3=(u32x4){PKW(pB1,8),PKW(pB1,10),PKW(pB1,12),PKW(pB1,14)};
    SBAR(); pv(o,vb0+sl_cur,PAF(0),PAF(1),PAF(2),PAF(3)); }
  #undef PKW
  #undef PAF
  #undef VFR
  #undef PIN
  #undef MX3
  #undef GAPA
  #undef GAPB
  #undef EX
  #undef VRD
  #undef KRD
  #undef STEP
  #undef ENDW
  {auto rr=__builtin_amdgcn_permlane32_swap(__float_as_uint(l_reg),__float_as_uint(l_reg),false,false);l_reg=__uint_as_float(rr[0])+__uint_as_float(rr[1]);}
  if(hi==0)wsf[32+r32]=l_reg;asm volatile("s_waitcnt lgkmcnt(0)":::"memory");
  float rli[16];
  #pragma unroll
  for(int r=0;r<16;++r)rli[r]=__builtin_amdgcn_rcpf(wsf[32+crow(r,hi)]);
  bf16*Ow=O+(rowbase+q0+wid*QBLK)*DM+h*D;
  { bf16*stg=(bf16*)(shm+LDS_OST)+wid*2048;
    #pragma unroll
    for(int r=0;r<16;++r){const int orow=crow(r,hi);
      #pragma unroll
      for(int d0=0;d0<2;++d0)stg[orow*64+d0*32+r32]=__float2bfloat16(o[d0][r]*rli[r]);}
    asm volatile("s_waitcnt lgkmcnt(0)":::"memory");
    #pragma unroll
    for(int i=0;i<4;++i){const int row=i*8+(lane>>3),ch=lane&7; const u32x4 v=*(const u32x4*)(stg+row*64+ch*8); ATTN_STORE16(Ow+(long)row*DM+ch*8,v);} }
  asm volatile("s_waitcnt lgkmcnt(0)\n\ts_barrier":::"memory");
  #undef CKSUB
  #undef DMA_K
  #undef DMA_V
  #undef CMASK
  #undef START
  #undef RESC
  #undef ROT
}
constexpr int ATTN_LDS_BYTES=LDS_BYTES;
struct AttnTensors { const bf16* Q; const bf16* K; const bf16* V; bf16* O; const float* CS; const unsigned* KM; };
struct AttnUnit { int bh; int qb; };
struct StaticOrder {
  int vcu,G;
  __device__ __forceinline__ explicit StaticOrder(int grid,int block):vcu((grid%8==0)?(block%8)*(grid/8)+block/8:block),G(grid){}
  __device__ __forceinline__ bool next(int i,AttnUnit&u)const{
    if(G==256){ if(i>=2)return false; const int s=vcu&31; u.bh=vcu>>5; u.qb=(i==0)?s:63-s; return true; }
    const int Lx=i*G+vcu; if(Lx>=NHEAD*NQB)return false; u.bh=Lx/NQB; u.qb=NQB-1-(Lx%NQB); return true; }
  __device__ __forceinline__ void a_ready(const AttnUnit&)const{}
  __device__ __forceinline__ void done(const AttnUnit&)const{}
};
template<class Sched,int THRL=8> __device__ __forceinline__ void attn_phase(char*lds,const AttnTensors&T,const Sched&S){
  AttnUnit u;
  for(int i=0;S.next(i,u);++i){ S.a_ready(u); attn_unit<THRL>(0,u.bh,u.qb,T.Q,T.K,T.V,T.O,T.CS,T.KM,lds); S.done(u); }
}
#undef SBAR
#undef WAIT_BAR
}
#define LAS __attribute__((address_space(3)))
typedef unsigned short bf16;
typedef unsigned v4u __attribute__((ext_vector_type(4)));
typedef unsigned v2u __attribute__((ext_vector_type(2)));
typedef float f32x4 __attribute__((ext_vector_type(4)));
typedef short bf16x8 __attribute__((ext_vector_type(8)));
constexpr int NWAVES = 8, NTHREADS = 512;
constexpr int M = 16384, D = 1024, FF = 2816, MEML = 256, DIN = 7176, NLAYER = 2;
constexpr float EPS = 1e-6f, LOG2E = 1.4426950408889634f;
constexpr int LDS_BYTES = 155648, XB_LDS_OFF = LDS_BYTES - 256;
static_assert(attn_body::ATTN_LDS_BYTES <= LDS_BYTES, "lds");
constexpr size_t MiB = 1u << 20;
constexpr size_t WS_SS = 1 * MiB, WS_SSV = 2 * MiB, WS_LF = 2 * MiB + 512 * 1024, WS_CS = 3 * MiB, WS_RSM = 3 * MiB + 512 * 1024, WS_MEMB = 4 * MiB, WS_KC = 4 * MiB + 512 * 1024, WS_VCT = 5 * MiB;
constexpr size_t WS_W = 6 * MiB, WS_XB = 68 * MiB, WS_SCR = 100 * MiB, WS_END = 244 * MiB;
constexpr size_t WO_GU1 = 0, WO_D1 = WO_GU1 + (size_t)5632 * 1024, WO_IN = WO_D1 + (size_t)1024 * 2816, WO_G = WO_IN + (size_t)4096 * 1024, WO_B = WO_G + (size_t)3072 * 1024,
                 WO_O = WO_B + (size_t)3 * 1024 * 512, WO_Q = WO_O + (size_t)1024 * 1024, WO_K = WO_Q + (size_t)1024 * 1024, WO_V = WO_K + (size_t)1024 * 1024, WO_XO = WO_V + (size_t)1024 * 1024,
                 WO_GU2 = WO_XO + (size_t)1024 * 1024, WO_D2 = WO_GU2 + (size_t)5632 * 1024, WO_END = WO_D2 + (size_t)1024 * 2816;
static_assert(WO_END * 2 <= WS_XB - WS_W, "weights fit");
constexpr size_t PIECE = (size_t)M * 512;

typedef __attribute__((address_space(1))) unsigned gu32;
#define RLX_AGENT __ATOMIC_RELAXED, __HIP_MEMORY_SCOPE_AGENT
#define XB_TMO      128
#define XB_XCNT(j)  (256  + 64 * (j))
#define XB_XSUB(j)  (1280 + 64 * (j))
#define XB_XGEN(j)  (2304 + 64 * (j))
#define XB_TOP      3328
#define XB_TOPGEN   3392
#define XCD_BAR_WORDS 3456
#define XB_SPIN_CAP (1u << 18)

__device__ __forceinline__ unsigned xb_ld(unsigned* p)              { return __hip_atomic_load(p, __ATOMIC_RELAXED, __HIP_MEMORY_SCOPE_AGENT); }
__device__ __forceinline__ unsigned xb_add(unsigned* p, unsigned v) { return __hip_atomic_fetch_add(p, v, __ATOMIC_RELAXED, __HIP_MEMORY_SCOPE_AGENT); }
__device__ __forceinline__ unsigned xb_xcc_id() { return (unsigned)__builtin_amdgcn_s_getreg((3 << 11) | 20) & 0xFu; }
#define XB_SPIN(cond, bar) do { unsigned _sp = 0; while (cond) { __builtin_amdgcn_s_sleep(1); \
    if ((++_sp & 255u) == 0u) { if (xb_ld(&(bar)[XB_TMO])) break; if (_sp > XB_SPIN_CAP) { atomicAdd(&(bar)[XB_TMO], 1u); break; } } } } while (0)

struct XcdBarrier {
    unsigned* bar; unsigned x;
    volatile LAS unsigned* st;
};

__device__ __forceinline__ XcdBarrier xcd_barrier_post(unsigned* bar, volatile LAS unsigned* st) {
    XcdBarrier b; b.bar = bar; b.x = xb_xcc_id(); b.st = st;
    if (threadIdx.x == 0) (void)xb_add(&bar[XB_XCNT(b.x)], 1u);
    return b;
}
__device__ __forceinline__ void xcd_barrier_complete(unsigned* bar, unsigned x, unsigned& nloc, unsigned& nx) {
    const unsigned G = gridDim.x * gridDim.y * gridDim.z;
    unsigned sum, cnt, mine, sp = 0u;
    for (;;) {
        sum = 0u; cnt = 0u; mine = 0u;
#pragma unroll
        for (unsigned j = 0; j < 16; ++j) { const unsigned c = xb_ld(&bar[XB_XCNT(j)]); sum += c; cnt += (c > 0u) ? 1u : 0u; mine = (j == x) ? c : mine; }
        if (sum == G) break;
        __builtin_amdgcn_s_sleep(1);
        if ((++sp & 255u) == 0u) { if (xb_ld(&bar[XB_TMO])) break; if (sp > XB_SPIN_CAP) { atomicAdd(&bar[XB_TMO], 1u); break; } }
    }
    nloc = mine > 0u ? mine : 1u; nx = cnt > 0u ? cnt : 1u;
}

__device__ __forceinline__ void xcd_barrier(const XcdBarrier& b) {
    asm volatile("s_waitcnt vmcnt(0)" ::: "memory");
    __syncthreads();
    if (threadIdx.x == 0) {
        unsigned* bar = b.bar;
        __builtin_amdgcn_s_waitcnt(0);
        unsigned nloc = b.st[0], nx = b.st[1];
        if (nloc == 0u) { xcd_barrier_complete(bar, b.x, nloc, nx); b.st[0] = nloc; b.st[1] = nx; }
        const unsigned old = xb_add(&bar[XB_XSUB(b.x)], 1u);
        const unsigned gen = old / nloc;
        if (old + 1u == (gen + 1u) * nloc) {
            __builtin_amdgcn_fence(__ATOMIC_RELEASE, "agent");
            asm volatile("s_waitcnt vmcnt(0)" ::: "memory");
            const unsigned og = xb_add(&bar[XB_TOP], 1u);
            const unsigned tg = og / nx;
            if (og + 1u == (tg + 1u) * nx) xb_add(&bar[XB_TOPGEN], 1u);
            else XB_SPIN(xb_ld(&bar[XB_TOPGEN]) == tg, bar);
            __builtin_amdgcn_fence(__ATOMIC_ACQUIRE, "agent");
            xb_add(&bar[XB_XGEN(b.x)], 1u);
            asm volatile("s_waitcnt vmcnt(0)" ::: "memory");
        } else {
            XB_SPIN(xb_ld(&bar[XB_XGEN(b.x)]) == gen, bar);
            __builtin_amdgcn_fence(__ATOMIC_ACQUIRE, "agent");
            asm volatile("s_waitcnt vmcnt(0)" ::: "memory");
        }
    }
    __syncthreads();
}
struct Args { const float* in[26]; float* out; unsigned char* ws; int ph_lo, ph_hi; };

__device__ __forceinline__ unsigned f2bf(float f) { unsigned u = __builtin_bit_cast(unsigned, f); return (u + 0x7fffu + ((u >> 16) & 1u)) >> 16; }
__device__ __forceinline__ unsigned pk2(float lo, float hi) { return f2bf(lo) | (f2bf(hi) << 16); }
__device__ __forceinline__ float b2f(unsigned short b) { return __uint_as_float((unsigned)b << 16); }
__device__ __forceinline__ float wave_sum(float v) {
#pragma unroll
    for (int o = 1; o < 64; o <<= 1) v += __shfl_xor(v, o);
    return v;
}
#define LDS_WAIT() asm volatile("s_waitcnt lgkmcnt(0)" ::: "memory")
__device__ __forceinline__ void conv_item(const float* W, int spitch, int k0, int n0, bf16* WT, int dpitch, int drow0, const float* gain, LAS float* scr, int lane) {
#pragma unroll
    for (int i = 0; i < 32; ++i) { const int kk = 2 * i + (lane >> 5); float v = W[(size_t)(k0 + kk) * spitch + n0 + (lane & 31)]; if (gain) v *= gain[k0 + kk]; scr[kk * 33 + (lane & 31)] = v; }
    LDS_WAIT(); asm volatile("" ::: "memory");
    const int c = lane & 7;
#pragma unroll
    for (int j = 0; j < 4; ++j) { const int n = (lane >> 3) + 8 * j; const LAS float* s = scr + (8 * c) * 33 + n;
        v4u o; o.x = pk2(s[0 * 33], s[1 * 33]); o.y = pk2(s[2 * 33], s[3 * 33]); o.z = pk2(s[4 * 33], s[5 * 33]); o.w = pk2(s[6 * 33], s[7 * 33]);
        *(v4u*)(WT + (size_t)(drow0 + n) * dpitch + k0 + 8 * c) = o; }
    LDS_WAIT(); asm volatile("" ::: "memory");
}
__device__ __forceinline__ void conv_job(int& it, int& base, int NGW, const float* W, int spitch, int K, int scol0, int ncols, bf16* WT, int doff, bool ilv, const float* gain, LAS float* scr, int lane) {
    const int nblk = ncols / 32, nitems = (K / 64) * nblk;
    for (; it < base + nitems; it += NGW) { const int r = it - base, kb = r / nblk, nb = r % nblk, nl = 32 * nb;
        const int drow0 = ilv ? (256 * (nl / 128) + (nl % 128) + doff) : (doff + nl);
        conv_item(W, spitch, 64 * kb, scol0 + nl, WT, K, drow0, gain, scr, lane); }
    base += nitems;
}

__global__ void __launch_bounds__(NTHREADS, 2) mk_fwd(Args args) {
    __builtin_assume(__builtin_amdgcn_workitem_id_y() == 0); __builtin_assume(__builtin_amdgcn_workitem_id_z() == 0);
    extern __shared__ __attribute__((aligned(16))) unsigned char lds[];
    cg::grid_group grid = cg::this_grid();
    LAS unsigned char* ldsp = (LAS unsigned char*)lds;
    if (threadIdx.x < 2) ((volatile LAS unsigned*)(ldsp + XB_LDS_OFF))[threadIdx.x] = 0u;
    __syncthreads();
    const XcdBarrier xbar = xcd_barrier_post((unsigned*)args.ws, (volatile LAS unsigned*)(ldsp + XB_LDS_OFF));
    const int G = gridDim.x, bx = blockIdx.x;
    const int vcu = (G % 8 == 0) ? (bx % 8) * (G / 8) + bx / 8 : bx;
    const int NGW = G * NWAVES;
#define TIDS() int tid_o = threadIdx.x; asm volatile("" : "+v"(tid_o)); const int tid = tid_o, lane = tid & 63, wave = __builtin_amdgcn_readfirstlane(tid >> 6), gw = vcu * NWAVES + wave; (void)gw; (void)lane; (void)tid
#define KARGS() const __attribute__((address_space(4))) Args* ap_ = (const __attribute__((address_space(4))) Args*)__builtin_amdgcn_kernarg_segment_ptr(); asm volatile("" : "+s"(ap_))
#define ws (ap_->ws)
#define X (ap_->out)
#define SS ((float*)(ws + WS_SS))
#define SSV ((float*)(ws + WS_SSV))
#define LF ((float*)(ws + WS_LF))
#define CS ((float*)(ws + WS_CS))
#define RSM ((float*)(ws + WS_RSM))
#define MEMB ((bf16*)(ws + WS_MEMB))
#define KC ((bf16*)(ws + WS_KC))
#define VCT ((bf16*)(ws + WS_VCT))
#define Wt ((bf16*)(ws + WS_W))
#define XB ((bf16*)(ws + WS_XB))
#define SCR ((bf16*)(ws + WS_SCR))
#define ACT SCR
#define PROJ SCR
#define GT (SCR + 3 * PIECE)
#define XQ SCR
#define PB (SCR + (size_t)M * 1024)
#define OB (SCR + (size_t)2 * M * 1024)
    const int lo = args.ph_lo, hi = args.ph_hi;
#ifndef PHMASK
#define PHMASK 0xffff
#endif
#define IN(k) (((PHMASK >> (((k) == 30) ? 15 : ((k) - pb == 13 || (k) - pb == 14) ? (k) - pb - 12 : (k) - pb)) & 1) && lo <= (k) && (k) < hi)
#define GRID_SYNC() do { asm volatile("s_waitcnt vmcnt(0) lgkmcnt(0)" ::: "memory"); grid.sync(); } while (0)
#define WG_SEAM() do { asm volatile("s_waitcnt vmcnt(0) lgkmcnt(0)" ::: "memory"); __syncthreads(); __builtin_amdgcn_fence(__ATOMIC_ACQUIRE, "agent"); asm volatile("s_waitcnt vmcnt(0)" ::: "memory"); __syncthreads(); } while (0)
#define SEAM_LOCAL(k) do { if (lo <= (k) && (k) + 1 < hi) { if (G == 256) WG_SEAM(); else xcd_barrier(xbar); } } while (0)
#define SEAM(k) do { if (lo <= (k) && (k) + 1 < hi) { if ((k) == 0) GRID_SYNC(); else xcd_barrier(xbar); } } while (0)
#define in (ap_->in)
int pb = 0;
#pragma nounroll
    for (int l = 0; l < NLAYER; ++l) {
        pb = 15 * l;
        if (IN(pb + 0)) { KARGS(); TIDS();
            LAS float* scr = (LAS float*)(ldsp + wave * 16384);
            const size_t l1 = (size_t)l * 1024, lff = (size_t)l * 1024 * 2816, ldd = (size_t)l * 1024 * 1024;
            constexpr int NB_FF = FF / 32, I_UP = 16 * NB_FF, I_DN = (FF / 64) * 32, I_IN = 16 * 128, I_G = 16 * 96, I_B = 8 * 32, I_SQ = 16 * 32;
            constexpr int NIT = 4 * I_UP + 2 * I_DN + I_IN + I_G + 3 * I_B + 5 * I_SQ;
#pragma nounroll
            for (int it = gw; it < NIT; it += NGW) {
                int r = it; const float* W; const float* gain = nullptr; bf16* WT; int spitch, K, scol0 = 0, nblk, doff = 0; bool ilv = false;
                if (r < 2 * I_UP) { const int w = r / I_UP; r -= w * I_UP; W = in[3 + w] + lff; gain = in[2] + l1; WT = Wt + WO_GU1; spitch = FF; K = 1024; nblk = NB_FF; doff = 128 * w; ilv = true; }
                else if ((r -= 2 * I_UP) < I_DN) { W = in[5] + lff; WT = Wt + WO_D1; spitch = 1024; K = FF; nblk = 32; }
                else if ((r -= I_DN) < I_IN) { W = in[7] + (size_t)l * 1024 * DIN; gain = in[6] + l1; WT = Wt + WO_IN; spitch = DIN; K = 1024; nblk = 128; }
                else if ((r -= I_IN) < I_G) { W = in[7] + (size_t)l * 1024 * DIN; gain = in[6] + l1; WT = Wt + WO_G; spitch = DIN; K = 1024; nblk = 96; scol0 = 4104; }
                else if ((r -= I_G) < 3 * I_B) { const int w = r / I_B; r -= w * I_B; W = in[13] + ((size_t)l * 3 + w) * 512 * 1024; WT = Wt + WO_B + (size_t)w * 1024 * 512; spitch = 1024; K = 512; nblk = 32; }
                else if ((r -= 3 * I_B) < I_SQ) { W = in[14] + ldd; WT = Wt + WO_O; spitch = 1024; K = 1024; nblk = 32; }
                else if ((r -= I_SQ) < I_SQ) { W = in[17] + ldd; gain = in[15] + l1; WT = Wt + WO_Q; spitch = 1024; K = 1024; nblk = 32; }
                else if ((r -= I_SQ) < 2 * I_SQ) { const int w = r / I_SQ; r -= w * I_SQ; W = in[18 + w] + ldd; gain = in[16] + l1; WT = Wt + WO_K + (size_t)w * 1024 * 1024; spitch = 1024; K = 1024; nblk = 32; }
                else if ((r -= 2 * I_SQ) < I_SQ) { W = in[20] + ldd; WT = Wt + WO_XO; spitch = 1024; K = 1024; nblk = 32; }
                else if ((r -= I_SQ) < 2 * I_UP) { const int w = r / I_UP; r -= w * I_UP; W = in[22 + w] + lff; gain = in[21] + l1; WT = Wt + WO_GU2; spitch = FF; K = 1024; nblk = NB_FF; doff = 128 * w; ilv = true; }
                else { r -= 2 * I_UP; W = in[24] + lff; WT = Wt + WO_D2; spitch = 1024; K = FF; nblk = 32; }
                const int kb = r / nblk, nl = 32 * (r % nblk);
                const int drow0 = ilv ? (256 * (nl / 128) + (nl % 128) + doff) : (doff + nl);
                conv_item(W, spitch, 64 * kb, scol0 + nl, WT, K, drow0, gain, scr, lane);
            }
            if (l == 0) {
                for (int m = gw; m < M + MEML; m += NGW) {
                    const bool ism = m >= M; const int r = ism ? m - M : m;
                    const f32x4* xr = (const f32x4*)((ism ? in[1] : in[0]) + (size_t)r * D) + lane;
                    f32x4 v[4]; float s = 0.f;
#pragma unroll
                    for (int j = 0; j < 4; ++j) { v[j] = xr[64 * j]; s += (v[j][0] * v[j][0] + v[j][1] * v[j][1]) + (v[j][2] * v[j][2] + v[j][3] * v[j][3]); }
                    s = wave_sum(s);
                    v2u* ob = (v2u*)((ism ? MEMB : XB) + (size_t)r * D) + lane;
#pragma unroll
                    for (int j = 0; j < 4; ++j) { v2u w; w.x = pk2(v[j][0], v[j][1]); w.y = pk2(v[j][2], v[j][3]); ob[64 * j] = w; }
                    if (!ism) {
                        if (lane < 16) SS[(size_t)r * 16 + lane] = lane == 0 ? s : 0.f;
                    } else if (lane == 0) RSM[r] = rsqrtf(s * (1.0f / D) + EPS);
                }
            }
        }
        SEAM(pb + 0);
#pragma nounroll
        for (int f = 0; f < 2; ++f) {
            const int pu = pb + (f == 0 ? 1 : 13), pd = pu + 1;
            if (IN(pu)) { KARGS();
                { pg8::Gemm g{XB, Wt + (f == 0 ? WO_GU1 : WO_GU2), 1024, 1024, 1024, 0, 0}; pg8::StaticOrder S; S.init(M / 256, 22, G, bx);
                  pg8::EpiSwiGLU E{SS, ACT};
#ifndef MK_REP_UP
#define MK_REP_UP 1
#endif
_Pragma("nounroll")
                  for (int rep = 0; rep < MK_REP_UP; ++rep) pg8::gemm_phase<pg8::EpiSwiGLU, pg8::StaticOrder, true, true>(ldsp, g, S, E); }
                if (f == 0) {
                    { pg8::Gemm g{MEMB, Wt + WO_K, 1024, 1024, 1024, 0, 0}; pg8::StaticOrder S; S.init(1, 4, G, bx);
                      pg8::EpiScale<2> E{RSM, KC, 1024, 1.0f}; pg8::gemm_phase<pg8::EpiScale<2>, pg8::StaticOrder, true, true>(ldsp, g, S, E); }
                    { pg8::Gemm g{Wt + WO_V, MEMB, 1024, 1024, 1024, 0, 0}; pg8::StaticOrder S; S.init(4, 1, G, bx);
                      pg8::EpiScale<3> E{RSM, VCT, 256, 1.0f}; pg8::gemm_phase<pg8::EpiScale<3>, pg8::StaticOrder, true, true>(ldsp, g, S, E); }
                }
            }
            SEAM(pu);
            if (IN(pd)) { KARGS();
                pg8::Gemm g{ACT, Wt + (f == 0 ? WO_D1 : WO_D2), FF, FF, FF, 0, 0}; pg8::StaticOrder S; S.init(M / 256, 4, G, bx);
                pg8::EpiResid E{XB, SS, 0.5f}; pg8::gemm_phase<pg8::EpiResid, pg8::StaticOrder, true, true>(ldsp, g, S, E);
            }
            SEAM(pd);
            if (f == 1) break;
            if (IN(pb + 3)) { KARGS();
                { TIDS();
                    const float* gn = in[6] + (size_t)l * 1024; const float* bfp = in[12] + l * 8;
#pragma nounroll
                    for (int hh = 0; hh < 2; ++hh) {
                        const float* win = in[7] + (size_t)l * 1024 * DIN + 4096 + 4 * hh;
                        f32x4 wa[4][4];
#pragma unroll
                        for (int j = 0; j < 4; ++j)
#pragma unroll
                            for (int e = 0; e < 4; ++e) { const int k = 256 * j + 4 * lane + e; wa[j][e] = *(const f32x4*)(win + (size_t)k * DIN) * gn[k]; }
#pragma nounroll
                        for (int m = gw; m < M; m += NGW) {
                            const v2u* xr = (const v2u*)(XB + (size_t)m * D) + lane; float s = 0.f; f32x4 da = {0.f, 0.f, 0.f, 0.f};
#pragma unroll
                            for (int j = 0; j < 4; ++j) { const v2u xw = xr[64 * j]; const f32x4 v = {pg8::bflo(xw.x), pg8::bfhi(xw.x), pg8::bflo(xw.y), pg8::bfhi(xw.y)}; s += (v[0] * v[0] + v[1] * v[1]) + (v[2] * v[2] + v[3] * v[3]);
#pragma unroll
                                for (int e = 0; e < 4; ++e) da = da + wa[j][e] * v[e]; }
                            s = wave_sum(s);
#pragma unroll
                            for (int e = 0; e < 4; ++e) da[e] = wave_sum(da[e]);
                            float dsel = da[0]; dsel = lane == 1 ? da[1] : dsel; dsel = lane == 2 ? da[2] : dsel; dsel = lane == 3 ? da[3] : dsel;
                            if (lane < 4) { const float z = dsel * rsqrtf(s * (1.0f / D) + EPS) + bfp[4 * hh + lane]; LF[(size_t)(4 * hh + lane) * M + m] = fminf(z, 0.f) - log1pf(expf(-fabsf(z))); }
                        }
                    }
                }
                pg8::Gemm g{XB, Wt + WO_IN, 1024, 1024, 1024, 0, 0}; pg8::StaticOrder S; S.init(M / 256, 16, G, bx);
                pg8::EpiWin E{SS, PROJ, SSV, 0.125f * LOG2E}; pg8::gemm_phase<pg8::EpiWin, pg8::StaticOrder, true, true>(ldsp, g, S, E);
            }
            SEAM(pb + 3);
            if (IN(pb + 4)) { KARGS(); TIDS();
                if (bx < 8) {
                    const float* lf = LF + (size_t)bx * M + tid * 32; float* cs = CS + (size_t)bx * M + tid * 32;
                    f32x4 v[8]; float run = 0.f;
#pragma unroll
                    for (int i = 0; i < 8; ++i) { v[i] = *(const f32x4*)(lf + 4 * i);
#pragma unroll
                        for (int e = 0; e < 4; ++e) { run += v[i][e]; v[i][e] = run; } }
                    const double tot = (double)run; double incl = tot;
#pragma unroll
                    for (int o = 1; o < 64; o <<= 1) { const double t = __shfl_up(incl, o); if (lane >= o) incl += t; }
                    LAS double* wsum = (LAS double*)ldsp;
                    if (lane == 63) wsum[wave] = incl;
                    __syncthreads();
                    double bsum = 0.0;
                    for (int w = 0; w < wave; ++w) bsum += wsum[w];
                    const double excl = bsum + incl - tot;
#pragma unroll
                    for (int i = 0; i < 8; ++i) { f32x4 o;
#pragma unroll
                        for (int e = 0; e < 4; ++e) o[e] = (float)((excl + (double)v[i][e]) * 1.4426950408889634);
                        *(f32x4*)(cs + 4 * i) = o; }
                    __syncthreads();
                }
                {
                    const bf16* Kp = PROJ + 6 * PIECE; unsigned* KM = (unsigned*)(ws + 32768) + 8 * l;
                    for (int idx = vcu * NTHREADS + tid; idx < M * 8; idx += G * NTHREADS) {
                        const v4u* kp = (const v4u*)(Kp + (size_t)(idx >> 3) * 512 + (idx & 7) * 64); float s = 0.f;
#pragma unroll
                        for (int q = 0; q < 8; ++q) { const v4u w = kp[q];
#pragma unroll
                            for (int e = 0; e < 4; ++e) { const float a = pg8::bflo(w[e]), b = pg8::bfhi(w[e]); s += a * a + b * b; } }
                        s = fmaxf(s, __shfl_xor(s, 8)); s = fmaxf(s, __shfl_xor(s, 16)); s = fmaxf(s, __shfl_xor(s, 32));
                        if (lane < 8) atomicMax(KM + lane, __float_as_uint(s));
                    }
                }
                {
                    bf16* AB = PROJ; const bf16* AC = PROJ + 3 * PIECE; const bf16* AH = PROJ + 4 * PIECE; const float* cw = in[8] + (size_t)l * 3 * 512;
                    for (int idx = vcu * NTHREADS + tid; idx < M * 64; idx += G * NTHREADS) {
                        const int t = idx >> 6, c8 = (idx & 63) * 8; const size_t off = (size_t)t * 512 + c8;
                        const v4u bw = *(const v4u*)(AB + off);
                        float zz[3][8];
#pragma unroll
                        for (int d = 0; d < 3; ++d) {
                            if (t - d >= 0) { const v4u cv = *(const v4u*)(AC + off - (size_t)d * 512), hv = *(const v4u*)(AH + off - (size_t)d * 512);
#pragma unroll
                                for (int e = 0; e < 4; ++e) { zz[d][2 * e] = pg8::bflo(cv[e]) * pg8::bflo(hv[e]); zz[d][2 * e + 1] = pg8::bfhi(cv[e]) * pg8::bfhi(hv[e]); } }
                            else {
#pragma unroll
                                for (int e = 0; e < 8; ++e) zz[d][e] = 0.f; }
                        }
                        float y[8];
#pragma unroll
                        for (int e = 0; e < 8; ++e) { const float b = (e & 1) ? pg8::bfhi(bw[e >> 1]) : pg8::bflo(bw[e >> 1]);
                            y[e] = b * (cw[c8 + e] * zz[2][e] + cw[512 + c8 + e] * zz[1][e] + cw[1024 + c8 + e] * zz[0][e]); }
                        v4u o; o.x = pk2(y[0], y[1]); o.y = pk2(y[2], y[3]); o.z = pk2(y[4], y[5]); o.w = pk2(y[6], y[7]);
                        *(v4u*)(AB + off) = o;
                    }
                }
                {
                    bf16* UU = PROJ + 1 * PIECE; const bf16* VV = PROJ + 5 * PIECE; const float* sgn = in[9] + (size_t)l * 512; const float* sgw = in[10] + (size_t)l * 4 * 128 * 128; const float* sgb = in[11] + (size_t)l * 4 * 128;
                    LAS bf16* T = (LAS bf16*)ldsp;
                    const int fr = lane & 15, fq = lane >> 4;
                    for (int unit = vcu; unit < 512; unit += G) {
                        const int n = unit >> 2, gI = unit & 3;
                        { const int s = tid >> 2, cg0 = (tid & 3) * 32, row = 128 * n + s;
                          const f32x4 p0 = *(const f32x4*)(SSV + (size_t)row * 8), p1 = *(const f32x4*)(SSV + (size_t)row * 8 + 4);
                          const float rv = rsqrtf(((p0[0] + p0[1]) + (p0[2] + p0[3]) + (p1[0] + p1[1]) + (p1[2] + p1[3])) * (1.0f / 512.0f) + EPS);
#pragma unroll
                          for (int q = 0; q < 4; ++q) { const int c = cg0 + 8 * q; const v4u vw = *(const v4u*)(VV + (size_t)row * 512 + 128 * gI + c);
                              const f32x4 ga = *(const f32x4*)(sgn + 128 * gI + c), gb = *(const f32x4*)(sgn + 128 * gI + c + 4);
#pragma unroll
                              for (int e = 0; e < 4; ++e) { const float g0 = e < 2 ? ga[2 * e] : gb[2 * e - 4], g1 = e < 2 ? ga[2 * e + 1] : gb[2 * e - 3];
                                  T[(c + 2 * e) * 136 + s] = (bf16)f2bf(pg8::bflo(vw[e]) * rv * g0); T[(c + 2 * e + 1) * 136 + s] = (bf16)f2bf(pg8::bfhi(vw[e]) * rv * g1); } } }
                        __syncthreads();
                        f32x4 acc[8];
#pragma unroll
                        for (int j = 0; j < 8; ++j) acc[j] = (f32x4){0.f, 0.f, 0.f, 0.f};
                        const int t = 16 * wave + fr;
                        for (int kk = 0; kk <= (wave >> 1); ++kk) {
                            const int s0 = 32 * kk + 8 * fq; const float* wp = sgw + ((size_t)gI * 128 + t) * 128 + s0;
                            const f32x4 w0 = *(const f32x4*)wp, w1 = *(const f32x4*)(wp + 4);
                            float wv[8] = {w0[0], w0[1], w0[2], w0[3], w1[0], w1[1], w1[2], w1[3]};
#pragma unroll
                            for (int e = 0; e < 8; ++e) if (s0 + e > t) wv[e] = 0.f;
                            v4u aw; aw.x = pk2(wv[0], wv[1]); aw.y = pk2(wv[2], wv[3]); aw.z = pk2(wv[4], wv[5]); aw.w = pk2(wv[6], wv[7]);
                            const bf16x8 afr = __builtin_bit_cast(bf16x8, aw);
#pragma unroll
                            for (int j = 0; j < 8; ++j) { const bf16x8 bfr = *(const LAS bf16x8*)(T + (16 * j + fr) * 136 + s0); acc[j] = __builtin_amdgcn_mfma_f32_16x16x32_bf16(bfr, afr, acc[j], 0, 0, 0); }
                        }
                        const float bias = sgb[gI * 128 + t]; const size_t rowoff = (size_t)(128 * n + t) * 512 + 128 * gI;
#pragma unroll
                        for (int j = 0; j < 8; ++j) { const int c = 16 * j + 4 * fq; const v2u uw = *(const v2u*)(UU + rowoff + c);
                            v2u o; o.x = pk2(pg8::bflo(uw.x) * (acc[j][0] + bias), pg8::bfhi(uw.x) * (acc[j][1] + bias)); o.y = pk2(pg8::bflo(uw.y) * (acc[j][2] + bias), pg8::bfhi(uw.y) * (acc[j][3] + bias));
                            *(v2u*)(UU + rowoff + c) = o; }
                        __syncthreads();
                    }
                }
            }
            SEAM(pb + 4);
            if (IN(pb + 5)) { KARGS();
                const attn_body::AttnTensors AT{(const attn_body::bf16*)(PROJ + 8 * PIECE), (const attn_body::bf16*)(PROJ + 6 * PIECE), (const attn_body::bf16*)(PROJ + 7 * PIECE), (attn_body::bf16*)(PROJ + 2 * PIECE), CS, (const unsigned*)(ws + 32768) + 8 * l};
                const attn_body::StaticOrder S(G, bx);
#ifndef MK_REP_ATT
#define MK_REP_ATT 1
#endif
_Pragma("nounroll")
                for (int rep = 0; rep < MK_REP_ATT; ++rep) attn_body::attn_phase<attn_body::StaticOrder>((char*)lds, AT, S);
            }
            SEAM(pb + 5);
            if (IN(pb + 6)) { KARGS();
                pg8::Gemm g{XB, Wt + WO_G, 1024, 1024, 1024, 0, 0}; pg8::StaticOrder S; S.init(M / 256, 12, G, bx);
                pg8::EpiGates E{SS, GT}; pg8::gemm_phase<pg8::EpiGates, pg8::StaticOrder, true, true>(ldsp, g, S, E);
            }
            SEAM_LOCAL(pb + 6);
            if (IN(pb + 7)) { KARGS();
                pg8::Gemm g{PROJ, Wt + WO_B, 512, 512, 512, PIECE * 2, (size_t)1024 * 512 * 2}; pg8::ZOrder<3> S; S.S.init(M / 256, 4, G, bx);
                pg8::EpiMerge E{GT}; pg8::gemm_phase<pg8::EpiMerge, pg8::ZOrder<3>, true, true>(ldsp, g, S, E);
            }
            SEAM(pb + 7);
            if (IN(pb + 8)) { KARGS();
                pg8::Gemm g{GT, Wt + WO_O, 1024, 1024, 1024, 0, 0}; pg8::StaticOrder S; S.init(M / 256, 4, G, bx);
                pg8::EpiResid E{XB, SS, 1.0f}; pg8::gemm_phase<pg8::EpiResid, pg8::StaticOrder, true, true>(ldsp, g, S, E);
            }
            SEAM(pb + 8);
            if (IN(pb + 9)) { KARGS();
                pg8::Gemm g{XB, Wt + WO_Q, 1024, 1024, 1024, 0, 0}; pg8::EpiScale<1> E{SS, XQ, 1024, 0.0625f * LOG2E};
                for (int Lx = vcu; Lx < 256; Lx += G) { pg8::OneUnit S; S.u0.pm = Lx >> 2; S.u0.pn = Lx & 3; S.u0.z = 0; pg8::gemm_phase<pg8::EpiScale<1>, pg8::OneUnit, true, true>(ldsp, g, S, E); }
            }
            SEAM_LOCAL(pb + 9);
            if (IN(pb + 10)) { KARGS();
                pg8::Gemm g{XQ, KC, 256, 1024, 1024, 512, 512}; pg8::EpiSoftmax E{PB};
                for (int Lx = vcu; Lx < 256; Lx += G) { pg8::OneUnit S; S.u0.pm = Lx >> 2; S.u0.pn = 0; S.u0.z = Lx & 3; pg8::gemm_phase<pg8::EpiSoftmax, pg8::OneUnit, false, true>(ldsp, g, S, E); }
            }
            SEAM_LOCAL(pb + 10);
            if (IN(pb + 11)) { KARGS();
                pg8::Gemm g{PB, VCT, 256, 1024, 256, 512, (size_t)256 * 256 * 2}; pg8::EpiScale<0> E{nullptr, OB, 1024, 1.0f};
                for (int Lx = vcu; Lx < 256; Lx += G) { pg8::OneUnit S; S.u0.pm = Lx >> 2; S.u0.pn = 0; S.u0.z = Lx & 3; pg8::gemm_phase<pg8::EpiScale<0>, pg8::OneUnit, true, true>(ldsp, g, S, E); }
            }
            SEAM(pb + 11);
            if (IN(pb + 12)) { KARGS();
                pg8::Gemm g{OB, Wt + WO_XO, 1024, 1024, 1024, 0, 0}; pg8::StaticOrder S; S.init(M / 256, 4, G, bx);
                pg8::EpiResid E{XB, SS, 1.0f}; pg8::gemm_phase<pg8::EpiResid, pg8::StaticOrder, true, true>(ldsp, g, S, E);
            }
            SEAM(pb + 12);
        }
    }
#ifdef MK_DUMP_OFF
    {
        GRID_SYNC(); KARGS(); int t_ = threadIdx.x; asm volatile("" : "+v"(t_));
        const bf16* src = SCR + (size_t)(MK_DUMP_OFF);
        for (unsigned i = blockIdx.x * 512u + (unsigned)t_; i < (unsigned)M * 1024u; i += gridDim.x * 512u) { const unsigned m = i >> 10, c = i & 1023u;
            X[i] = c < (unsigned)(MK_DUMP_LD) ? b2f(src[(size_t)m * (MK_DUMP_LD) + c]) : 0.f; }
    }
#endif
    if (IN(30)) { KARGS(); TIDS();
        const float* gf = in[25];
        for (int m = gw; m < M; m += NGW) {
            const v2u* xb = (const v2u*)(XB + (size_t)m * D) + lane; f32x4* xr = (f32x4*)(X + (size_t)m * D) + lane; f32x4 v[4]; float s = 0.f;
#pragma unroll
            for (int j = 0; j < 4; ++j) { const v2u xw = xb[64 * j]; v[j] = (f32x4){pg8::bflo(xw.x), pg8::bfhi(xw.x), pg8::bflo(xw.y), pg8::bfhi(xw.y)}; s += (v[j][0] * v[j][0] + v[j][1] * v[j][1]) + (v[j][2] * v[j][2] + v[j][3] * v[j][3]); }
            const float r = rsqrtf(wave_sum(s) * (1.0f / D) + EPS);
#pragma unroll
            for (int j = 0; j < 4; ++j) xr[64 * j] = v[j] * r * *((const f32x4*)gf + lane + 64 * j);
        }
    }
#undef IN
#undef SEAM
#undef ws
#undef X
#undef SS
#undef SSV
#undef LF
#undef CS
#undef RSM
#undef MEMB
#undef KC
#undef VCT
#undef Wt
#undef XB
#undef SCR
#undef ACT
#undef PROJ
#undef GT
#undef XQ
#undef PB
#undef OB
#undef in
}

#ifndef MK_PER_PHASE
#define MK_PER_PHASE 0
#endif
extern "C" void kernel_launch(void* const* d_in, const int* in_sizes, int n_in, void* d_out, int out_size, void* d_ws, size_t ws_size, hipStream_t stream) {
    static int grid = 0;
    if (grid == 0) {
        if (n_in != 26 || out_size != M * D || ws_size < WS_END) { fprintf(stderr, "kernel_launch: unexpected shapes (n_in %d out %d ws %zu)\n", n_in, out_size, ws_size); grid = -1; return; }
        int dev = 0, cus = 0, per_cu = 0;
        (void)hipGetDevice(&dev); (void)hipDeviceGetAttribute(&cus, hipDeviceAttributeMultiprocessorCount, dev);
        if (hipFuncSetAttribute((const void*)mk_fwd, hipFuncAttributeMaxDynamicSharedMemorySize, LDS_BYTES) != hipSuccess) { fprintf(stderr, "kernel_launch: hipFuncSetAttribute failed\n"); grid = -1; return; }
        if (hipOccupancyMaxActiveBlocksPerMultiprocessor(&per_cu, (const void*)mk_fwd, NTHREADS, LDS_BYTES) != hipSuccess || per_cu < 1) { fprintf(stderr, "kernel_launch: occupancy query says %d\n", per_cu); per_cu = 1; }
        (void)hipGetLastError();
        grid = cus > 0 ? cus : 256;
    }
    if (grid < 0) return;
    (void)hipMemsetAsync(d_ws, 0, 65536, stream);
    Args a{};
    for (int i = 0; i < 26; ++i) a.in[i] = (const float*)d_in[i];
    a.out = (float*)d_out; a.ws = (unsigned char*)d_ws;
#if MK_PER_PHASE
    for (int p = 0; p < 31; ++p) { a.ph_lo = p; a.ph_hi = p + 1; void* kargs[] = {&a};
        hipError_t e = hipLaunchCooperativeKernel((const void*)mk_fwd, dim3(grid), dim3(NTHREADS), kargs, LDS_BYTES, stream);
        if (e != hipSuccess) { fprintf(stderr, "launch %d failed: %s\n", p, hipGetErrorString(e)); break; } }
#else
#ifndef MK_PH_HI
#define MK_PH_HI 31
#endif
    a.ph_lo = 0; a.ph_hi = MK_PH_HI; void* kargs[] = {&a};
    hipError_t e = hipLaunchCooperativeKernel((const void*)mk_fwd, dim3(grid), dim3(NTHREADS), kargs, LDS_BYTES, stream);
    if (e != hipSuccess) fprintf(stderr, "cooperative launch failed: %s (grid %d)\n", hipGetErrorString(e), grid);
#endif
}
```

```cpp
#include <hip/hip_runtime.h>
#include <hip/hip_cooperative_groups.h>
#include <cstdio>
#include <cstdint>
namespace cg = cooperative_groups;

namespace pg8 {
#define PG8_LAS __attribute__((address_space(3)))
typedef unsigned short bf16_t;
typedef short bf16x8 __attribute__((ext_vector_type(8)));
typedef float f32x4 __attribute__((ext_vector_type(4)));
typedef unsigned u32x4 __attribute__((ext_vector_type(4)));
constexpr int BM = 256, BK = 64, HALF = 128, HTB = HALF * BK * 2  , STAGE_BYTES = 8 * HTB, NXCD = 8, WGM = 8;

__host__ __device__ __forceinline__ int lds_byte(int r, int c) { const int st = (r >> 4) * 2 + (c >> 5), rr = r & 15, cc = c & 31, ob = rr * 64 + cc * 2; return st * 1024 + (ob ^ (((ob >> 9) & 1) << 5)); }
__host__ __device__ __forceinline__ void stage_rc(int b, int& R, int& C) { const int st = b / 1024, sb = b % 1024, swz = sb ^ (((sb >> 9) & 1) << 5); R = (st >> 1) * 16 + swz / 64; C = (st & 1) * 32 + (swz % 64) / 2; }
__host__ __device__ __forceinline__ int perm32(int rho) { const int n = rho >> 4, i = rho & 15; return 8 * (i >> 2) + 4 * n + (i & 3); }

struct Unit { int pm, pn, z; };
typedef float f32x2 __attribute__((ext_vector_type(2))); typedef __bf16 bf16x2_cv __attribute__((ext_vector_type(2)));
__device__ __forceinline__ unsigned cvt_pk_bf16(float lo, float hi) { const f32x2 v = {lo, hi}; const bf16x2_cv b = __builtin_convertvector(v, bf16x2_cv); return __builtin_bit_cast(unsigned, b); }
struct Gemm { const bf16_t* A; const bf16_t* Bt; int K, lda, ldb; size_t zA, zB; };

struct StaticOrder {
    int nM, nN, nwg, G, c;
    __host__ __device__ void init(int nM_, int nN_, int G_, int c_) { nM = nM_; nN = nN_; nwg = nM * nN; G = G_; c = c_; }
    __host__ __device__ void map(int wgid, Unit& u) const {
        { const int q = nwg / NXCD, r = nwg % NXCD, xcd = wgid % NXCD, off = wgid / NXCD; wgid = (xcd < r ? xcd * (q + 1) : r * (q + 1) + (xcd - r) * q) + off; }
        const int nig = WGM * nN, gid = wgid / nig, fm = gid * WGM, gsz = (nM - fm) < WGM ? (nM - fm) : WGM;
        u.pm = fm + ((wgid % nig) % gsz); u.pn = (wgid % nig) / gsz; u.z = 0;
    }
    __host__ __device__ bool next(int i, Unit& u) const { const long L = (long)i * G + c; if (L >= nwg) return false; map((int)L, u); return true; }
    __device__ __forceinline__ void a_ready(const Unit&) const {}
    __device__ __forceinline__ void done(const Unit&) const {}
};
template <int NZ> struct ZOrder {
    StaticOrder S;
    __host__ __device__ bool next(int i, Unit& u) const { const long L = (long)(i / NZ) * S.G + S.c; if (L >= S.nwg) return false; S.map((int)L, u); u.z = i % NZ; return true; }
    __device__ __forceinline__ void a_ready(const Unit&) const {}
    __device__ __forceinline__ void done(const Unit&) const {}
};
struct OneUnit {
    Unit u0;
    __host__ __device__ bool next(int i, Unit& u) const { if (i > 0) return false; u = u0; return true; }
    __device__ __forceinline__ void a_ready(const Unit&) const {}
    __device__ __forceinline__ void done(const Unit&) const {}
};

typedef unsigned u32x2 __attribute__((ext_vector_type(2)));
constexpr float LOG2E = 1.4426950408889634f;
__device__ __forceinline__ float bf2f(unsigned short b) { return __uint_as_float((unsigned)b << 16); }
__device__ __forceinline__ float bflo(unsigned w) { return __uint_as_float(w << 16); }
__device__ __forceinline__ float bfhi(unsigned w) { return __uint_as_float(w & 0xffff0000u); }
__device__ __forceinline__ float sigmoidf_(float v) { return __builtin_amdgcn_rcpf(1.0f + __builtin_amdgcn_exp2f(-v * LOG2E)); }
__device__ __forceinline__ float gelu_tanh(float v) { const float z = 0.7978845608028654f * (v + 0.044715f * v * v * v); return v * sigmoidf_(2.0f * z); }
__device__ __forceinline__ u32x4 pack8(const f32x4 a, const f32x4 b) { u32x4 w; w.x = cvt_pk_bf16(a[0], a[1]); w.y = cvt_pk_bf16(a[2], a[3]); w.z = cvt_pk_bf16(b[0], b[1]); w.w = cvt_pk_bf16(b[2], b[3]); return w; }
__device__ __forceinline__ void row_rstd(const float* SS, int rowbase, int fq, float (&rs)[2][4]) {
#pragma unroll
    for (int ai = 0; ai < 2; ++ai)
#pragma unroll
        for (int m = 0; m < 4; ++m) { const f32x4 v = *(const f32x4*)(SS + (size_t)(rowbase + ai * HALF + m * 16) * 16 + 4 * fq);
            float s = (v[0] + v[1]) + (v[2] + v[3]); s += __shfl_xor(s, 16); s += __shfl_xor(s, 32); rs[ai][m] = rsqrtf(s * (1.0f / 1024.0f) + 1e-6f); }
}
__device__ __forceinline__ float row_rstd1(const float* SS, int row, int fq) { const f32x4 v = *(const f32x4*)(SS + (size_t)row * 16 + 4 * fq);
    float s = (v[0] + v[1]) + (v[2] + v[3]); s += __shfl_xor(s, 16); s += __shfl_xor(s, 32); return rsqrtf(s * (1.0f / 1024.0f) + 1e-6f); }
#define EPI_ARGS const f32x4 (&acc)[2][2][4][2], const Unit& u, int wr, int wc, int fr, int fq
struct EpiSwiGLU { static constexpr bool PERM = true, AFTER_DRAIN = false; const float* SS; bf16_t* O;
    __device__ __forceinline__ void operator()(EPI_ARGS) const {
        float rs[2][4]; row_rstd(SS, u.pm * BM + wr * 64 + fr, fq, rs);
        const int col0 = u.pn * 128 + wc * 32 + 8 * fq;
#pragma unroll
        for (int ai = 0; ai < 2; ++ai)
#pragma unroll
            for (int m = 0; m < 4; ++m) { const float r = rs[ai][m]; f32x4 o[2];
#pragma unroll
                for (int n = 0; n < 2; ++n)
#pragma unroll
                    for (int j = 0; j < 4; ++j) { const float g = acc[ai][0][m][n][j] * r, up = acc[ai][1][m][n][j] * r; o[n][j] = g * sigmoidf_(g) * up; }
                *(u32x4*)(O + (size_t)(u.pm * BM + ai * HALF + wr * 64 + m * 16 + fr) * 2816 + col0) = pack8(o[0], o[1]); }
    }
};
struct EpiResid { static constexpr bool PERM = false, AFTER_DRAIN = false; bf16_t* XB; float* SS; float scale;
    __device__ __forceinline__ void operator()(EPI_ARGS) const {
        const int col0 = u.pn * BM + wc * 32 + 4 * fq;
#pragma unroll
        for (int ai = 0; ai < 2; ++ai)
#pragma unroll
            for (int m = 0; m < 4; ++m) { const int row = u.pm * BM + ai * HALF + wr * 64 + m * 16 + fr; float ssq = 0.f;
#pragma unroll
                for (int bj = 0; bj < 2; ++bj)
#pragma unroll
                    for (int n = 0; n < 2; ++n) { const size_t off = (size_t)row * 1024 + col0 + bj * HALF + n * 16;
                        const u32x2 xw = *(const u32x2*)(XB + off);
                        f32x4 x = {bflo(xw.x), bfhi(xw.x), bflo(xw.y), bfhi(xw.y)}; x = x + acc[ai][bj][m][n] * scale;
                        u32x2 w; w.x = cvt_pk_bf16(x[0], x[1]); w.y = cvt_pk_bf16(x[2], x[3]); *(u32x2*)(XB + off) = w;
                        ssq += (x[0] * x[0] + x[1] * x[1]) + (x[2] * x[2] + x[3] * x[3]); }
                ssq += __shfl_xor(ssq, 16); ssq += __shfl_xor(ssq, 32);
                if (fq == 0) SS[(size_t)row * 16 + u.pn * 4 + wc] = ssq; }
    }
};
struct EpiWin { static constexpr bool PERM = true, AFTER_DRAIN = false; const float* SS; bf16_t* P; float* SSV; float qscale;
    __device__ __forceinline__ void operator()(EPI_ARGS) const {
        const int piece = u.pn >> 1;
        const int slot = piece == 0 ? 0 : piece == 1 ? 3 : piece == 2 ? 4 : piece == 3 ? 1 : piece == 4 ? 5 : piece == 5 ? 8 : piece;
        bf16_t* base = P + (size_t)slot * (16384u * 512u);
        const int col0 = (u.pn & 1) * 256 + wc * 32 + 8 * fq;
        const float sc = piece == 5 ? qscale : 1.0f;
#pragma unroll
        for (int ai = 0; ai < 2; ++ai)
#pragma unroll
            for (int m = 0; m < 4; ++m) { const int row = u.pm * BM + ai * HALF + wr * 64 + m * 16 + fr; const float r = row_rstd1(SS, row, fq) * sc; float ssq = 0.f;
#pragma unroll
                for (int bj = 0; bj < 2; ++bj) { f32x4 v0 = acc[ai][bj][m][0] * r, v1 = acc[ai][bj][m][1] * r;
                    if (piece == 3 || piece == 4) {
#pragma unroll
                        for (int j = 0; j < 4; ++j) { v0[j] = gelu_tanh(v0[j]); v1[j] = gelu_tanh(v1[j]); }
                        ssq += (v0[0] * v0[0] + v0[1] * v0[1]) + (v0[2] * v0[2] + v0[3] * v0[3]) + (v1[0] * v1[0] + v1[1] * v1[1]) + (v1[2] * v1[2] + v1[3] * v1[3]); }
                    *(u32x4*)(base + (size_t)row * 512 + col0 + bj * HALF) = pack8(v0, v1); }
                if (piece == 4) { ssq += __shfl_xor(ssq, 16); ssq += __shfl_xor(ssq, 32); if (fq == 0) SSV[(size_t)row * 8 + (u.pn & 1) * 4 + wc] = ssq; }
                asm volatile("" ::: "memory"); }
    }
};
struct EpiGates { static constexpr bool PERM = true, AFTER_DRAIN = false; const float* SS; bf16_t* G;
    __device__ __forceinline__ void operator()(EPI_ARGS) const {
        float rs[2][4]; row_rstd(SS, u.pm * BM + wr * 64 + fr, fq, rs);
        bf16_t* base = G + (size_t)(u.pn >> 2) * (16384u * 1024u);
        const int col0 = (u.pn & 3) * 256 + wc * 32 + 8 * fq;
#pragma unroll
        for (int ai = 0; ai < 2; ++ai)
#pragma unroll
            for (int m = 0; m < 4; ++m) { const int row = u.pm * BM + ai * HALF + wr * 64 + m * 16 + fr; const float r = rs[ai][m];
#pragma unroll
                for (int bj = 0; bj < 2; ++bj) { f32x4 v0 = acc[ai][bj][m][0] * r, v1 = acc[ai][bj][m][1] * r;
#pragma unroll
                    for (int j = 0; j < 4; ++j) { v0[j] = sigmoidf_(v0[j]); v1[j] = sigmoidf_(v1[j]); }
                    *(u32x4*)(base + (size_t)row * 1024 + col0 + bj * HALF) = pack8(v0, v1); } }
    }
};
struct EpiMerge { static constexpr bool PERM = true, AFTER_DRAIN = false; bf16_t* G;
    __device__ __forceinline__ void operator()(EPI_ARGS) const {
        const bf16_t* gz = G + (size_t)u.z * (16384u * 1024u);
        const int col0 = u.pn * 256 + wc * 32 + 8 * fq;
#pragma unroll
        for (int ai = 0; ai < 2; ++ai)
#pragma unroll
            for (int m = 0; m < 4; ++m) { const int row = u.pm * BM + ai * HALF + wr * 64 + m * 16 + fr;
#pragma unroll
                for (int bj = 0; bj < 2; ++bj) { const size_t off = (size_t)row * 1024 + col0 + bj * HALF;
                    const u32x4 gw = *(const u32x4*)(gz + off);
                    f32x4 g0 = {bflo(gw.x), bfhi(gw.x), bflo(gw.y), bfhi(gw.y)}, g1 = {bflo(gw.z), bfhi(gw.z), bflo(gw.w), bfhi(gw.w)};
                    f32x4 v0 = acc[ai][bj][m][0] * g0, v1 = acc[ai][bj][m][1] * g1;
#ifdef MK_DBG_Z
                    if (u.z != MK_DBG_Z) { v0 = v0 * 0.f; v1 = v1 * 0.f; }
#endif
                    if (u.z != 0) { u32x4 pw; { const unsigned long long a_ = __hip_atomic_load((const unsigned long long*)(G + off), __ATOMIC_RELAXED, __HIP_MEMORY_SCOPE_AGENT), b_ = __hip_atomic_load((const unsigned long long*)(G + off) + 1, __ATOMIC_RELAXED, __HIP_MEMORY_SCOPE_AGENT);
                            pw.x = (unsigned)a_; pw.y = (unsigned)(a_ >> 32); pw.z = (unsigned)b_; pw.w = (unsigned)(b_ >> 32); }
                        v0 = v0 + (f32x4){bflo(pw.x), bfhi(pw.x), bflo(pw.y), bfhi(pw.y)}; v1 = v1 + (f32x4){bflo(pw.z), bfhi(pw.z), bflo(pw.w), bfhi(pw.w)}; }
                    *(u32x4*)(G + off) = pack8(v0, v1); } }
    }
};
template <int MODE> struct EpiScale { static constexpr bool PERM = true, AFTER_DRAIN = false; const float* S; bf16_t* O; int ldc; float scale;
    __device__ __forceinline__ void operator()(EPI_ARGS) const {
        float rs[2][4];
        if (MODE == 1) row_rstd(S, u.pm * BM + wr * 64 + fr, fq, rs);
        const int col0 = (u.pn + u.z) * 256 + wc * 32 + 8 * fq;
#pragma unroll
        for (int ai = 0; ai < 2; ++ai)
#pragma unroll
            for (int m = 0; m < 4; ++m) { const int row = u.pm * BM + ai * HALF + wr * 64 + m * 16 + fr;
                float r = scale; if (MODE == 1) r *= rs[ai][m]; if (MODE == 2) r *= S[row];
#pragma unroll
                for (int bj = 0; bj < 2; ++bj) { f32x4 v0 = acc[ai][bj][m][0] * r, v1 = acc[ai][bj][m][1] * r;
                    if (MODE == 3) { v0 = v0 * *(const f32x4*)(S + col0 + bj * HALF); v1 = v1 * *(const f32x4*)(S + col0 + bj * HALF + 4); }
                    *(u32x4*)(O + (size_t)row * ldc + col0 + bj * HALF) = pack8(v0, v1); } }
    }
};
struct EpiSoftmax { static constexpr bool PERM = true, AFTER_DRAIN = true; bf16_t* O;
    __device__ __forceinline__ void fused(f32x4 (&acc)[2][2][4][2], const Unit& u, int wr, int wc, int fr, int fq, PG8_LAS unsigned char* lds, int wid, int lane) const {
        PG8_LAS float* T1 = (PG8_LAS float*)lds; PG8_LAS float* T2 = (PG8_LAS float*)(lds + 4096);
#pragma unroll
        for (int ai = 0; ai < 2; ++ai)
#pragma unroll
            for (int m = 0; m < 4; ++m) { float mx = -3.0e38f;
#pragma unroll
                for (int bj = 0; bj < 2; ++bj)
#pragma unroll
                    for (int n = 0; n < 2; ++n)
#pragma unroll
                        for (int j = 0; j < 4; ++j) mx = fmaxf(mx, acc[ai][bj][m][n][j]);
                mx = fmaxf(mx, __shfl_xor(mx, 16)); mx = fmaxf(mx, __shfl_xor(mx, 32));
                if (fq == 0) T1[(ai * HALF + wr * 64 + m * 16 + fr) * 4 + wc] = mx; }
        asm volatile("s_waitcnt lgkmcnt(0)" ::: "memory"); __builtin_amdgcn_s_barrier(); asm volatile("" ::: "memory");
#pragma unroll
        for (int ai = 0; ai < 2; ++ai)
#pragma unroll
            for (int m = 0; m < 4; ++m) { const int rl = ai * HALF + wr * 64 + m * 16 + fr; const f32x4 t = *(const PG8_LAS f32x4*)(T1 + rl * 4);
                const float mx = fmaxf(fmaxf(t[0], t[1]), fmaxf(t[2], t[3])); float s = 0.f;
#pragma unroll
                for (int bj = 0; bj < 2; ++bj)
#pragma unroll
                    for (int n = 0; n < 2; ++n)
#pragma unroll
                        for (int j = 0; j < 4; ++j) { const float p = __builtin_amdgcn_exp2f(acc[ai][bj][m][n][j] - mx); acc[ai][bj][m][n][j] = p; s += p; }
                s += __shfl_xor(s, 16); s += __shfl_xor(s, 32);
                if (fq == 0) T2[rl * 4 + wc] = s; }
        asm volatile("s_waitcnt lgkmcnt(0)" ::: "memory"); __builtin_amdgcn_s_barrier(); asm volatile("" ::: "memory");
        const int col0 = u.z * 256 + wc * 32 + 8 * fq;
#pragma unroll
        for (int ai = 0; ai < 2; ++ai)
#pragma unroll
            for (int m = 0; m < 4; ++m) { const int rl = ai * HALF + wr * 64 + m * 16 + fr; const f32x4 t = *(const PG8_LAS f32x4*)(T2 + rl * 4);
                const float inv = 1.0f / ((t[0] + t[1]) + (t[2] + t[3]));
#pragma unroll
                for (int bj = 0; bj < 2; ++bj) *(u32x4*)(O + (size_t)(u.pm * BM + rl) * 1024 + col0 + bj * HALF) = pack8(acc[ai][bj][m][0] * inv, acc[ai][bj][m][1] * inv); }
        asm volatile("s_waitcnt lgkmcnt(0)" ::: "memory"); __builtin_amdgcn_s_barrier(); asm volatile("" ::: "memory");
    }
};

template <class Epi, class Sched, bool ALIGN_EPI = false, bool SP2 = false>
__device__ __forceinline__ void gemm_phase(PG8_LAS unsigned char* lds, const Gemm g, const Sched& S, const Epi& E) {
    int tid_o = threadIdx.x; asm volatile("" : "+v"(tid_o)); const int tid = tid_o, wid = __builtin_amdgcn_readfirstlane(tid >> 6), lane = tid & 63, wr = wid >> 2, wc = wid & 3, fr = lane & 15, fq = lane >> 4;
    const int nt = g.K / BK; const char* gA_ = reinterpret_cast<const char*>(g.A); const char* gB_ = reinterpret_cast<const char*>(g.Bt); asm volatile("" : "+s"(gA_), "+s"(gB_));
    unsigned voffA[2], voffB[2];
#pragma unroll
    for (int i = 0; i < 2; ++i) { int R, C; stage_rc(tid * 16 + i * 8192, R, C); const int Rb = Epi::PERM ? ((R & ~31) + perm32(R & 31)) : R;
        voffA[i] = (unsigned)(R * g.lda + C) * 2u; voffB[i] = (unsigned)(Rb * g.ldb + C) * 2u; }
    const size_t kstep = (size_t)(BK * 2);
    const size_t hstepA = (size_t)HALF * g.lda * 2, hstepB = (size_t)HALF * g.ldb * 2;

    const unsigned ldsw = (unsigned)wid * 1024u;
    const int aoff = lds_byte(wr * 64 + fr, fq * 8), boff = lds_byte(wc * 32 + fr, fq * 8);
#define PG8_SA(b, h) (((b) * 2 + (h)) * HTB)
#define PG8_SB(b, h) ((4 + (b) * 2 + (h)) * HTB)
#define PG8_STAGE(bufoff, gbase, voff) do { _Pragma("unroll") for (int _i = 0; _i < 2; ++_i) \
        __builtin_amdgcn_global_load_lds((const unsigned*)((const char*)(gbase) + (voff)[_i]), (PG8_LAS unsigned*)(lds + (bufoff) + ldsw + _i * 8192), 16, 0, 0); } while (0)
#define PG8_LDA(dst, b, h) do { _Pragma("unroll") for (int m = 0; m < 4; ++m) _Pragma("unroll") for (int k = 0; k < 2; ++k) dst[m][k] = *(const PG8_LAS bf16x8*)(lds + PG8_SA(b, h) + aoff + m * 2048 + k * 1024); } while (0)
#define PG8_LDB(dst, b, h) do { _Pragma("unroll") for (int n = 0; n < 2; ++n) _Pragma("unroll") for (int k = 0; k < 2; ++k) dst[n][k] = *(const PG8_LAS bf16x8*)(lds + PG8_SB(b, h) + boff + n * 2048 + k * 1024); } while (0)
#define PG8_MMA(ai, bj, At, Bt) do { __builtin_amdgcn_s_setprio(1); _Pragma("unroll") for (int m = 0; m < 4; ++m) _Pragma("unroll") for (int n = 0; n < 2; ++n) _Pragma("unroll") for (int k = 0; k < 2; ++k) \
        acc[ai][bj][m][n] = __builtin_amdgcn_mfma_f32_16x16x32_bf16(Bt[n][k], At[m][k], acc[ai][bj][m][n], 0, 0, 0); __builtin_amdgcn_s_setprio(0); } while (0)
#define PG8_WAIT_V(n) asm volatile("s_waitcnt vmcnt(" #n ")" ::: "memory")
#define PG8_WAIT_L(n) asm volatile("s_waitcnt lgkmcnt(" #n ")" ::: "memory")
#define PG8_BAR __builtin_amdgcn_s_barrier()
#define PG8_SCHED __builtin_amdgcn_sched_barrier(0)
    Unit cur, nxt; int ui = 0;
    if (!S.next(0, cur)) return;
    f32x4 acc[2][2][4][2];
#pragma unroll
    for (int a = 0; a < 2; ++a)
#pragma unroll
        for (int b = 0; b < 2; ++b)
#pragma unroll
            for (int m = 0; m < 4; ++m)
#pragma unroll
                for (int n = 0; n < 2; ++n) acc[a][b][m][n] = (f32x4){0.f, 0.f, 0.f, 0.f};
    bf16x8 At[4][2], B0[2][2], B1[2][2];
    const char* cA = gA_ + (size_t)cur.pm * 2 * hstepA + (size_t)cur.z * g.zA; const char* cB = gB_ + (size_t)cur.pn * 2 * hstepB + (size_t)cur.z * g.zB;
    S.a_ready(cur);
    if constexpr (SP2) {
        PG8_STAGE(PG8_SB(0, 0), cB, voffB); PG8_STAGE(PG8_SB(0, 1), cB + hstepB, voffB); PG8_STAGE(PG8_SA(0, 0), cA, voffA); PG8_STAGE(PG8_SA(0, 1), cA + hstepA, voffA);
        if (wr == 1) PG8_BAR;
        PG8_WAIT_V(2); PG8_BAR;
        PG8_STAGE(PG8_SB(1, 0), cB + kstep, voffB); PG8_STAGE(PG8_SA(1, 0), cA + kstep, voffA); PG8_STAGE(PG8_SB(1, 1), cB + hstepB + kstep, voffB);
        PG8_WAIT_V(6); PG8_BAR;
    } else {
        PG8_STAGE(PG8_SB(0, 0), cB, voffB); PG8_STAGE(PG8_SA(0, 0), cA, voffA); PG8_STAGE(PG8_SB(0, 1), cB + hstepB, voffB); PG8_STAGE(PG8_SA(0, 1), cA + hstepA, voffA);
        if (wr == 1) PG8_BAR;
        PG8_WAIT_V(4); PG8_BAR;
        PG8_STAGE(PG8_SB(1, 0), cB + kstep, voffB); PG8_STAGE(PG8_SA(1, 0), cA + kstep, voffA); PG8_STAGE(PG8_SB(1, 1), cB + hstepB + kstep, voffB);
        PG8_WAIT_V(6); PG8_BAR;
    }
    for (;;) {
        const bool has_next = S.next(ui + 1, nxt);
        const char* nA = has_next ? gA_ + (size_t)nxt.pm * 2 * hstepA + (size_t)nxt.z * g.zA : cA; const char* nB = has_next ? gB_ + (size_t)nxt.pn * 2 * hstepB + (size_t)nxt.z * g.zB : cB;
_Pragma("nounroll")
        for (int t = 0; t < nt; t += 2) {
            const bool last = (t == nt - 2);
            const char* a1 = cA + (size_t)(t + 1) * kstep;
            const char* a2 = last ? nA : cA + (size_t)(t + 2) * kstep; const char* b2 = last ? nB : cB + (size_t)(t + 2) * kstep;
            const char* a3 = a2 + kstep; const char* b3 = b2 + kstep;
            if (last && has_next) S.a_ready(nxt);
            if constexpr (SP2) {
            PG8_LDB(B0, 0, 0); PG8_LDB(B1, 0, 1); PG8_SCHED; PG8_LDA(At, 0, 0); PG8_STAGE(PG8_SA(1, 1), a1 + hstepA, voffA);
            PG8_WAIT_V(8); PG8_WAIT_L(0); PG8_BAR; PG8_MMA(0, 0, At, B0); PG8_MMA(0, 1, At, B1); PG8_BAR; PG8_SCHED;
            PG8_LDA(At, 0, 1); PG8_STAGE(PG8_SB(0, 0), b2, voffB); PG8_STAGE(PG8_SB(0, 1), b2 + hstepB, voffB); PG8_STAGE(PG8_SA(0, 0), a2, voffA);
            PG8_WAIT_V(8); PG8_WAIT_L(0); PG8_BAR; PG8_MMA(1, 0, At, B0); PG8_MMA(1, 1, At, B1); PG8_BAR; PG8_SCHED;
            PG8_LDB(B0, 1, 0); PG8_LDB(B1, 1, 1); PG8_SCHED; PG8_LDA(At, 1, 0); PG8_STAGE(PG8_SA(0, 1), a2 + hstepA, voffA);
            PG8_WAIT_V(8); PG8_WAIT_L(0); PG8_BAR; PG8_MMA(0, 0, At, B0); PG8_MMA(0, 1, At, B1); PG8_BAR; PG8_SCHED;
            PG8_LDA(At, 1, 1); PG8_STAGE(PG8_SB(1, 0), b3, voffB); PG8_STAGE(PG8_SB(1, 1), b3 + hstepB, voffB); PG8_STAGE(PG8_SA(1, 0), a3, voffA);
            PG8_WAIT_V(8); PG8_WAIT_L(0); PG8_BAR; PG8_MMA(1, 0, At, B0); PG8_MMA(1, 1, At, B1); PG8_BAR; PG8_SCHED;
            } else {
            PG8_LDB(B0, 0, 0); PG8_SCHED; PG8_LDA(At, 0, 0); PG8_STAGE(PG8_SA(1, 1), a1 + hstepA, voffA);
            PG8_WAIT_L(8); PG8_BAR; PG8_WAIT_L(0); PG8_MMA(0, 0, At, B0); PG8_BAR; PG8_SCHED;
            PG8_LDB(B1, 0, 1); PG8_STAGE(PG8_SB(0, 0), b2, voffB);
            PG8_BAR; PG8_WAIT_L(0); PG8_MMA(0, 1, At, B1); PG8_BAR;
            PG8_LDA(At, 0, 1); PG8_STAGE(PG8_SA(0, 0), a2, voffA);
            PG8_BAR; PG8_WAIT_L(0); PG8_MMA(1, 0, At, B0); PG8_BAR; PG8_SCHED;
            PG8_STAGE(PG8_SB(0, 1), b2 + hstepB, voffB);
            PG8_WAIT_V(6); PG8_BAR; PG8_MMA(1, 1, At, B1); PG8_BAR;
            PG8_LDB(B0, 1, 0); PG8_SCHED; PG8_LDA(At, 1, 0); PG8_STAGE(PG8_SA(0, 1), a2 + hstepA, voffA);
            PG8_WAIT_L(8); PG8_BAR; PG8_WAIT_L(0); PG8_MMA(0, 0, At, B0); PG8_BAR; PG8_SCHED;
            PG8_LDB(B1, 1, 1); PG8_STAGE(PG8_SB(1, 0), b3, voffB);
            PG8_BAR; PG8_WAIT_L(0); PG8_MMA(0, 1, At, B1); PG8_BAR;
            PG8_LDA(At, 1, 1); PG8_STAGE(PG8_SA(1, 0), a3, voffA);
            PG8_BAR; PG8_WAIT_L(0); PG8_MMA(1, 0, At, B0); PG8_BAR; PG8_SCHED;
            PG8_STAGE(PG8_SB(1, 1), b3 + hstepB, voffB);
            PG8_WAIT_V(6); PG8_BAR; PG8_MMA(1, 1, At, B1); PG8_BAR;
            }
        }
        if constexpr (ALIGN_EPI) { if (wr == 0) PG8_BAR; }
        if constexpr (!Epi::AFTER_DRAIN) { E(acc, cur, wr, wc, fr, fq); S.done(cur); }
        if (!has_next) break;
#pragma unroll
        for (int a = 0; a < 2; ++a)
#pragma unroll
            for (int b = 0; b < 2; ++b)
#pragma unroll
                for (int m = 0; m < 4; ++m)
#pragma unroll
                    for (int n = 0; n < 2; ++n) acc[a][b][m][n] = (f32x4){0.f, 0.f, 0.f, 0.f};
        cur = nxt; cA = nA; cB = nB; ++ui;
        if constexpr (ALIGN_EPI) { if (wr == 1) PG8_BAR; }
    }
    PG8_WAIT_V(0);
    if constexpr (!ALIGN_EPI) { if (wr == 0) PG8_BAR; }
    PG8_BAR;
    if constexpr (Epi::AFTER_DRAIN) { E.fused(acc, cur, wr, wc, fr, fq, lds, wid, lane); S.done(cur); }
#undef PG8_SA
#undef PG8_SB
#undef PG8_STAGE
#undef PG8_LDA
#undef PG8_LDB
#undef PG8_MMA
#undef PG8_WAIT_V
#undef PG8_WAIT_L
#undef PG8_BAR
#undef PG8_SCHED
}
}
#include <hip/hip_bf16.h>
#include <cmath>
namespace attn_body {
using bf16=__hip_bfloat16;
using bf16x8=__attribute__((ext_vector_type(8)))short;
using s16x4=__attribute__((ext_vector_type(4)))short;
using f32x16=__attribute__((ext_vector_type(16)))float;
using u32x4=__attribute__((ext_vector_type(4)))unsigned;
using f32x4_t=__attribute__((ext_vector_type(4)))float;
constexpr int BATCH=1,NHEAD=8,SEQ=16384,D=64,DM=NHEAD*D;
constexpr int NW=8,QBLK=32,QB=QBLK*NW,KVBLK=64,NQB=SEQ/QB;
constexpr int ATTN_PITCH=DM, ATTN_UNIT_ROWS=QB;
__device__ __forceinline__ int crow(int r,int hi){return (r&3)+8*(r>>2)+4*hi;}
#define SBAR() __builtin_amdgcn_sched_barrier(0)
__device__ __forceinline__ void cmask(f32x16&p0,f32x16&p1,int jb,int qrel,int hi){
  const float NEG=-INFINITY; int kb=64*jb+4*hi;
  #pragma unroll
  for(int r=0;r<16;++r){int kv=kb+(r&3)+8*(r>>2); if(kv>qrel)p0[r]=NEG; if(kv+32>qrel)p1[r]=NEG;}
}

constexpr int NSLOT=3, SLOTB=8192;
constexpr int LDS_K=0, LDS_V=NSLOT*SLOTB, LDS_WS=2*NSLOT*SLOTB, LDS_OST=LDS_WS+NW*64*4, LDS_CK=LDS_OST+NW*4096, LDS_BYTES=LDS_CK+SEQ*4;
constexpr float C2=0.125f*1.4426950408889634f;
__device__ __forceinline__ void glds16(const void*gsrc,unsigned lds_dst){unsigned keep;
  asm volatile("s_mov_b32 %0, m0\n\ts_mov_b32 m0, %2\n\ts_nop 0\n\tglobal_load_lds_dwordx4 %1, off\n\ts_mov_b32 m0, %0":"=&s"(keep):"v"(gsrc),"s"(lds_dst):"memory");}
__device__ __forceinline__ float max3f(float a,float b,float c){float r;asm("v_max3_f32 %0, %1, %2, %3":"=v"(r):"v"(a),"v"(b),"v"(c));return r;}
__device__ __forceinline__ float max2f(float a,float b){float r;asm("v_max_f32_e32 %0, %1, %2":"=v"(r):"v"(a),"v"(b));return r;}
__device__ __forceinline__ float fadd_s(float a,float b){float r;asm("v_add_f32_e32 %0, %1, %2":"=v"(r):"v"(a),"v"(b));return r;}
__device__ __forceinline__ float fsub_s(float a,float b){float r;asm("v_sub_f32_e32 %0, %1, %2":"=v"(r):"v"(a),"v"(b));return r;}
typedef float f32x2_t __attribute__((ext_vector_type(2))); typedef __bf16 bf16x2_t __attribute__((ext_vector_type(2)));
__device__ __forceinline__ unsigned cvtpk_s(float lo,float hi){f32x2_t v={lo,hi};bf16x2_t b=__builtin_convertvector(v,bf16x2_t);return __builtin_bit_cast(unsigned,b);}
#define WAIT_BAR(N) asm volatile("s_waitcnt vmcnt(" #N ") lgkmcnt(0)\n\ts_barrier":::"memory")

__device__ __forceinline__ void qkt(f32x16&p0,f32x16&p1,const char*Kslot,const bf16x8*qr,const f32x16&negm,int r32,int hi){
  const char*kb=Kslot+hi*1024+r32*16;
  #pragma unroll
  for(int d0=0;d0<4;++d0){
    const bf16x8 b0=*reinterpret_cast<const bf16x8*>(kb+d0*2048);
    const bf16x8 b1=*reinterpret_cast<const bf16x8*>(kb+d0*2048+512);
    if(d0==0){p0=__builtin_amdgcn_mfma_f32_32x32x16_bf16(b0,qr[0],negm,0,0,0);p1=__builtin_amdgcn_mfma_f32_32x32x16_bf16(b1,qr[0],negm,0,0,0);}
    else{p0=__builtin_amdgcn_mfma_f32_32x32x16_bf16(b0,qr[d0],p0,0,0,0);p1=__builtin_amdgcn_mfma_f32_32x32x16_bf16(b1,qr[d0],p1,0,0,0);}}
}
typedef __attribute__((address_space(3))) const char* lds_cptr;
typedef short v4i16_t __attribute__((ext_vector_type(4)));
__device__ __forceinline__ void kload8(bf16x8*kf,lds_cptr kp){
  kf[0]=*(const __attribute__((address_space(3))) bf16x8*)(kp);      kf[1]=*(const __attribute__((address_space(3))) bf16x8*)(kp+512);
  kf[2]=*(const __attribute__((address_space(3))) bf16x8*)(kp+2048); kf[3]=*(const __attribute__((address_space(3))) bf16x8*)(kp+2560);
  kf[4]=*(const __attribute__((address_space(3))) bf16x8*)(kp+4096); kf[5]=*(const __attribute__((address_space(3))) bf16x8*)(kp+4608);
  kf[6]=*(const __attribute__((address_space(3))) bf16x8*)(kp+6144); kf[7]=*(const __attribute__((address_space(3))) bf16x8*)(kp+6656);
}
__device__ __forceinline__ void kload2(bf16x8*kf,lds_cptr kp,int j){ kf[2*j]=*(const __attribute__((address_space(3))) bf16x8*)(kp+j*2048); kf[2*j+1]=*(const __attribute__((address_space(3))) bf16x8*)(kp+j*2048+512); }
__device__ __forceinline__ s16x4 vtr(lds_cptr p){ return __builtin_bit_cast(s16x4,__builtin_amdgcn_ds_read_tr16_b64_v4i16((__attribute__((address_space(3))) v4i16_t*)p)); }
__device__ __forceinline__ float rowmax(const f32x16&p0,const f32x16&p1){
  float a=max3f(p0[0],p0[1],p1[0]),b=max3f(p0[2],p0[3],p1[1]);a=max3f(a,p1[2],p1[3]);
  #pragma unroll
  for(int r=4;r<16;r+=4){a=max3f(a,p0[r],p0[r+1]);b=max3f(b,p0[r+2],p0[r+3]);a=max3f(a,p1[r],p1[r+1]);b=max3f(b,p1[r+2],p1[r+3]);}
  const float m=max2f(a,b);
  auto rr=__builtin_amdgcn_permlane32_swap(__float_as_uint(m),__float_as_uint(m),false,false);
  return max2f(__uint_as_float(rr[0]),__uint_as_float(rr[1]));
}
__device__ __forceinline__ void pv(f32x16*o,int vb,bf16x8 pa0,bf16x8 pa1,bf16x8 pa2,bf16x8 pa3){
  #pragma unroll
  for(int d0=0;d0<2;++d0){s16x4 lo[4],hi[4];
    #pragma unroll
    for(int ks=0;ks<4;++ks){
      asm volatile("ds_read_b64_tr_b16 %0,%1 offset:%c2":"=&v"(lo[ks]):"v"(vb),"i"(d0*4096+ks*1024):"memory");
      asm volatile("ds_read_b64_tr_b16 %0,%1 offset:%c2":"=&v"(hi[ks]):"v"(vb),"i"(d0*4096+ks*1024+512):"memory");}
    asm volatile("s_waitcnt lgkmcnt(0)":::"memory");SBAR();
    #define PK(k) (bf16x8){lo[k][0],lo[k][1],lo[k][2],lo[k][3],hi[k][0],hi[k][1],hi[k][2],hi[k][3]}
    o[d0]=__builtin_amdgcn_mfma_f32_32x32x16_bf16(pa0,PK(0),o[d0],0,0,0);
    o[d0]=__builtin_amdgcn_mfma_f32_32x32x16_bf16(pa1,PK(1),o[d0],0,0,0);
    o[d0]=__builtin_amdgcn_mfma_f32_32x32x16_bf16(pa2,PK(2),o[d0],0,0,0);
    o[d0]=__builtin_amdgcn_mfma_f32_32x32x16_bf16(pa3,PK(3),o[d0],0,0,0);
    #undef PK
  }
}

#ifndef ATTN_STORE16
#define ATTN_STORE16(p,v) (*(u32x4*)(p)=(v))
#endif
template<int THRL> __device__ __forceinline__ void attn_unit(int b,int h,int qb,const bf16*Q,const bf16*__restrict__ K,const bf16*__restrict__ V,bf16*O,const float*__restrict__ CSg,const unsigned*KMg,char*shm){
  int tid_o=threadIdx.x; asm volatile("":"+v"(tid_o)); const int tid=tid_o,lane=tid&63,r32=lane&31,hi=lane>>5; const int wid=__builtin_amdgcn_readfirstlane(tid>>6);
  const long rowbase=(long)b*SEQ; const int q0=qb*QB;
  const bf16*Qw=Q+(rowbase+q0+wid*QBLK)*DM+h*D;
  const bf16*Kh=K+rowbase*DM+h*D,*Vh=V+rowbase*DM+h*D;
  const unsigned lds0=(unsigned)(uintptr_t)shm;
  float*wsf=(float*)(shm+LDS_WS)+wid*64;
  const lds_cptr shm3=(lds_cptr)shm;
  const bf16*ksrc=Kh+(long)lane*DM+wid*8;
  const bf16*vsrc=Vh+(long)(16*(wid&3)+(lane>>2))*DM+(wid>>2)*32+(lane&3)*8;
  const unsigned kdst=lds0+LDS_K+wid*1024, vdst=lds0+LDS_V+wid*1024;
  #define DMA_K(t,slot) glds16(ksrc+(long)(t)*KVBLK*DM,(unsigned)__builtin_amdgcn_readfirstlane(kdst+(slot)))
  #define DMA_V(t,slot) glds16(vsrc+(long)(t)*KVBLK*DM,(unsigned)__builtin_amdgcn_readfirstlane(vdst+(slot)))
  const int vb0=(int)(lds0+LDS_V)+((lane>>4)&1)*32+(lane&3)*8+(4*hi+((lane&15)>>2))*64;
  const char*Kbase=shm+LDS_K; bf16x8 kf[8];
  const lds_cptr kp0=shm3+LDS_K+hi*1024+r32*16; const lds_cptr vp0=shm3+LDS_V+((lane>>4)&1)*32+(lane&3)*8+(4*hi+((lane&15)>>2))*64;
  const int NT=(q0+QB)/KVBLK;
  typedef __attribute__((address_space(3))) float* lds_fptr; typedef __attribute__((address_space(3))) f32x4_t* lds_f4ptr;
  const float*csh=CSg+(long)h*SEQ;
  { const lds_fptr ckw=(lds_fptr)(shm3+LDS_CK);
    for(int i=tid*4;i<q0+QB;i+=NW*64*4){ const f32x4_t v=*(const f32x4_t*)(csh+i); *(lds_f4ptr)(ckw+i)=v; }
  }
  const float cq=csh[q0+wid*QBLK+r32];
  asm volatile("s_waitcnt vmcnt(0) lgkmcnt(0)\n\ts_barrier":::"memory");
  const lds_fptr ckt=(lds_fptr)(shm3+LDS_CK)+4*hi;
  #define CKSUB(P0,P1,t) do{ const lds_fptr ckp_=ckt+64*(t); _Pragma("unroll") for(int j_=0;j_<4;++j_){ const f32x4_t a_=*(const lds_f4ptr)(ckp_+8*j_); const f32x4_t b_=*(const lds_f4ptr)(ckp_+32+8*j_); \
      P0[4*j_]-=a_[0];P0[4*j_+1]-=a_[1];P0[4*j_+2]-=a_[2];P0[4*j_+3]-=a_[3]; P1[4*j_]-=b_[0];P1[4*j_+1]-=b_[1];P1[4*j_+2]-=b_[2];P1[4*j_+3]-=b_[3]; SBAR(); } }while(0)
  DMA_K(0,0);DMA_V(0,0);DMA_K(1,SLOTB);
  bf16x8 qr[4];
  #pragma unroll
  for(int d0=0;d0<4;++d0)qr[d0]=*reinterpret_cast<const bf16x8*>(&Qw[(long)r32*DM+d0*16+hi*8]);
  float l_reg=0.f;f32x16 o[2];o[0]=f32x16{};o[1]=f32x16{};f32x16 negm;
  {
    float q2=0.f;
    _Pragma("unroll") for(int d0=0;d0<4;++d0) _Pragma("unroll") for(int e=0;e<8;++e){ const float v=__uint_as_float(((unsigned)(unsigned short)qr[d0][e])<<16); q2+=v*v; }
    { auto rr=__builtin_amdgcn_permlane32_swap(__float_as_uint(q2),__float_as_uint(q2),false,false); q2=__uint_as_float(rr[0])+__uint_as_float(rr[1]); }
    const float km2=__uint_as_float(__hip_atomic_load(KMg+h,__ATOMIC_RELAXED,__HIP_MEMORY_SCOPE_AGENT));
    const float Rq=sqrtf(q2*km2)*1.001f+0.01f;
    _Pragma("unroll") for(int r=0;r<16;++r)negm[r]=cq-Rq; asm volatile("":"+v"(negm)); }
  const int qrel=wid*QBLK+r32;
  #define CMASK(P0,P1,t) do{int jb_=(t)-(NT-4); if(jb_>=0)cmask(P0,P1,jb_,qrel,hi);}while(0)
  #define START(P0,P1) do{ const float rm=rowmax(P0,P1); resc=false; \
    { const float dl=rm; mhat=fadd_s(mhat,dl); \
      _Pragma("unroll") for(int r=0;r<16;++r){P0[r]=fsub_s(P0[r],dl);P1[r]=fsub_s(P1[r],dl);} \
      _Pragma("unroll") for(int r=0;r<16;++r)negm[r]=-mhat; asm volatile("":"+v"(negm)); } \
    _Pragma("unroll") for(int r=0;r<16;++r)P0[r]=__builtin_amdgcn_exp2f(P0[r]); }while(0)
  #define RESC() do{ if(resc){ asm volatile("s_waitcnt lgkmcnt(0)":::"memory"); \
      _Pragma("unroll") for(int d_=0;d_<2;++d_) _Pragma("unroll") for(int r=0;r<16;++r)o[d_][r]*=wsf[crow(r,hi)]; } }while(0)
  f32x16 pA0,pA1,pB0,pB1;
  int sl_prev=0,sl_cur=0,sl_next=SLOTB;
  #define ROT() do{sl_prev=sl_cur;sl_cur=sl_next;sl_next=(sl_next==(NSLOT-1)*SLOTB)?0:sl_next+SLOTB;}while(0)
  DMA_K(2,2*SLOTB);
  WAIT_BAR(3);
  qkt(pA0,pA1,Kbase,qr,negm,r32,hi);asm volatile("s_nop 15\n\ts_nop 7":"+v"(pA0),"+v"(pA1));CKSUB(pA0,pA1,0);CMASK(pA0,pA1,0);
  _Pragma("unroll") for(int r=0;r<16;++r)pA0[r]=__builtin_amdgcn_exp2f(pA0[r]);
  _Pragma("unroll") for(int r=0;r<16;++r)pA1[r]=__builtin_amdgcn_exp2f(pA1[r]);
  WAIT_BAR(0);
  DMA_K(3,0);DMA_V(1,SLOTB);
  ROT();
  kload8(kf,kp0+sl_cur);
  WAIT_BAR(2);
  s16x4 vlo[8],vhi[8]; u32x4 pw0,pw1,pw2,pw3;
  #define PKW(P,B) cvtpk_s(P[B],P[B+1])
  #define PAF(k) __builtin_bit_cast(bf16x8,pw##k)
  #define VFR(i) (bf16x8){vlo[i][0],vlo[i][1],vlo[i][2],vlo[i][3],vhi[i][0],vhi[i][1],vhi[i][2],vhi[i][3]}
  #define PIN(x) asm volatile("":"+v"(x))
  #define MX3(a,b,c) __builtin_fmaxf(__builtin_fmaxf((a),(b)),(c))
  #define GAPA(MF,A0,A1,A2,A3,W0,W1,PW) do{ MF; sacc+=A0; sacc+=A1; sacc+=A2; sacc+=A3; PIN(sacc); W0; W1; PIN(PW); SBAR(); }while(0)
  #define EX(v) __builtin_amdgcn_exp2f(v)
  #define GAPB(MF,X,B,CUR,NXT,NOFF) do{ MF; if((NOFF)>=0){ NXT=*(const lds_f4ptr)(ckp_+((NOFF)>=0?(NOFF):0)); } X[B]=EX(X[B]-CUR[0]); X[B+1]=EX(X[B+1]-CUR[1]); X[B+2]=EX(X[B+2]-CUR[2]); X[B+3]=EX(X[B+3]-CUR[3]); PIN(X); SBAR(); }while(0)
  #define VRD(i) do{ vlo[i]=vtr(vp_+(((i)>>2)*4096+((i)&3)*1024)); vhi[i]=vtr(vp_+(((i)>>2)*4096+((i)&3)*1024+512)); }while(0)
  #define KRD(G,j) do{ if(G){ kload2(kf,kp0+sl_next,j); SBAR(); } }while(0)
  #define STEP(C0,C1,P0,P1,t,GK,GV,GL) do{ SBAR(); \
    const lds_cptr vp_=vp0+sl_prev; \
    VRD(0); SBAR(); float sacc=(P0[0]+P0[1]); \
    GAPA(C0=__builtin_amdgcn_mfma_f32_32x32x16_bf16(kf[0],qr[0],negm,0,0,0), P0[2],P0[3],P0[4],P0[5],     pw0[0]=PKW(P0,0), pw0[1]=PKW(P0,2), pw0); \
    VRD(4); SBAR(); GAPA(C1=__builtin_amdgcn_mfma_f32_32x32x16_bf16(kf[1],qr[0],negm,0,0,0), P0[6],P0[7],P0[8],P0[9],     pw0[2]=PKW(P0,4), pw0[3]=PKW(P0,6), pw0); \
    VRD(1); SBAR(); GAPA(C0=__builtin_amdgcn_mfma_f32_32x32x16_bf16(kf[2],qr[1],C0,0,0,0),   P0[10],P0[11],P0[12],P0[13], pw1[0]=PKW(P0,8), pw1[1]=PKW(P0,10), pw1); \
    VRD(5); SBAR(); GAPA(C1=__builtin_amdgcn_mfma_f32_32x32x16_bf16(kf[3],qr[1],C1,0,0,0),   P0[14],P0[15],P1[0],P1[1],   pw1[2]=PKW(P0,12),pw1[3]=PKW(P0,14), pw1); \
    VRD(2); SBAR(); GAPA(C0=__builtin_amdgcn_mfma_f32_32x32x16_bf16(kf[4],qr[2],C0,0,0,0),   P1[2],P1[3],P1[4],P1[5],     pw2[0]=PKW(P1,0), pw2[1]=PKW(P1,2), pw2); \
    VRD(6); SBAR(); GAPA(C1=__builtin_amdgcn_mfma_f32_32x32x16_bf16(kf[5],qr[2],C1,0,0,0),   P1[6],P1[7],P1[8],P1[9],     pw2[2]=PKW(P1,4), pw2[3]=PKW(P1,6), pw2); \
    VRD(3); SBAR(); GAPA(C0=__builtin_amdgcn_mfma_f32_32x32x16_bf16(kf[6],qr[3],C0,0,0,0),   P1[10],P1[11],P1[12],P1[13], pw3[0]=PKW(P1,8), pw3[1]=PKW(P1,10), pw3); \
    VRD(7); SBAR(); GAPA(C1=__builtin_amdgcn_mfma_f32_32x32x16_bf16(kf[7],qr[3],C1,0,0,0),   P1[14],P1[15],0.f,0.f,       pw3[2]=PKW(P1,12),pw3[3]=PKW(P1,14), pw3); \
    l_reg+=sacc; \
    if(GK){DMA_K((t)+3,sl_cur);} if(GV){DMA_V((t)+1,sl_next);} \
    CMASK(C0,C1,t); \
    const lds_fptr ckp_=ckt+64*(t); f32x4_t ckA_=*(const lds_f4ptr)(ckp_), ckB_; \
    SBAR(); \
    GAPB(o[0]=__builtin_amdgcn_mfma_f32_32x32x16_bf16(PAF(0),VFR(0),o[0],0,0,0), C0,0,ckA_,ckB_,8); \
    GAPB(o[1]=__builtin_amdgcn_mfma_f32_32x32x16_bf16(PAF(0),VFR(4),o[1],0,0,0), C0,4,ckB_,ckA_,16); \
    KRD(GL,0); GAPB(o[0]=__builtin_amdgcn_mfma_f32_32x32x16_bf16(PAF(1),VFR(1),o[0],0,0,0), C0,8,ckA_,ckB_,24); \
    KRD(GL,1); GAPB(o[1]=__builtin_amdgcn_mfma_f32_32x32x16_bf16(PAF(1),VFR(5),o[1],0,0,0), C0,12,ckB_,ckA_,32); \
    KRD(GL,2); GAPB(o[0]=__builtin_amdgcn_mfma_f32_32x32x16_bf16(PAF(2),VFR(2),o[0],0,0,0), C1,0,ckA_,ckB_,40); \
    KRD(GL,3); GAPB(o[1]=__builtin_amdgcn_mfma_f32_32x32x16_bf16(PAF(2),VFR(6),o[1],0,0,0), C1,4,ckB_,ckA_,48); \
    GAPB(o[0]=__builtin_amdgcn_mfma_f32_32x32x16_bf16(PAF(3),VFR(3),o[0],0,0,0), C1,8,ckA_,ckB_,56); \
    GAPB(o[1]=__builtin_amdgcn_mfma_f32_32x32x16_bf16(PAF(3),VFR(7),o[1],0,0,0), C1,12,ckB_,ckA_,-1); \
    }while(0)
  int t=1;
  #undef CMASK
  #define CMASK(P0,P1,t) do{}while(0)
  for(;t+5<NT;t+=2){
    STEP(pB0,pB1,pA0,pA1,t,true,true,true);     WAIT_BAR(2); ROT();
    STEP(pA0,pA1,pB0,pB1,t+1,true,true,true);   WAIT_BAR(2); ROT();
  }
  #undef CMASK
  #define CMASK(P0,P1,t) do{int jb_=(t)-(NT-4); if(jb_>=0)cmask(P0,P1,jb_,qrel,hi);}while(0)
  #define ENDW(tt) do{ if((tt)+3<NT){WAIT_BAR(2);} else if((tt)+2<NT){WAIT_BAR(1);} else {WAIT_BAR(0);} }while(0)
  for(;t+1<NT;t+=2){
    STEP(pB0,pB1,pA0,pA1,t,(t+3<NT),(t+1<NT),(t+1<NT));       ENDW(t); ROT();
    STEP(pA0,pA1,pB0,pB1,t+1,(t+4<NT),(t+2<NT),(t+2<NT));     ENDW(t+1); ROT();
  }
  STEP(pB0,pB1,pA0,pA1,NT-1,false,false,false);
  { float sacc=pB0[0]+pB0[1]; _Pragma("unroll") for(int r=2;r<16;++r)sacc+=pB0[r]; _Pragma("unroll") for(int r=0;r<16;++r)sacc+=pB1[r]; l_reg+=sacc;
    pw0=(u32x4){PKW(pB0,0),PKW(pB0,2),PKW(pB0,4),PKW(pB0,6)};pw1=(u32x4){PKW(pB0,8),PKW(pB0,10),PKW(pB0,12),PKW(pB0,14)};pw2=(u32x4){PKW(pB1,0),PKW(pB1,2),PKW(pB1,4),PKW(pB1,6)};pw3=(u32x4){PKW(pB1,8),PKW(pB1,10),PKW(pB1,12),PKW(pB1,14)};
    SBAR(); pv(o,vb0+sl_cur,PAF(0),PAF(1),PAF(2),PAF(3)); }
  #undef PKW
  #undef PAF
  #undef VFR
  #undef PIN
  #undef MX3
  #undef GAPA
  #undef GAPB
  #undef EX
  #undef VRD
  #undef KRD
  #undef STEP
  #undef ENDW
  {auto rr=__builtin_amdgcn_permlane32_swap(__float_as_uint(l_reg),__float_as_uint(l_reg),false,false);l_reg=__uint_as_float(rr[0])+__uint_as_float(rr[1]);}
  if(hi==0)wsf[32+r32]=l_reg;asm volatile("s_waitcnt lgkmcnt(0)":::"memory");
  float rli[16];
  #pragma unroll
  for(int r=0;r<16;++r)rli[r]=__builtin_amdgcn_rcpf(wsf[32+crow(r,hi)]);
  bf16*Ow=O+(rowbase+q0+wid*QBLK)*DM+h*D;
  { bf16*stg=(bf16*)(shm+LDS_OST)+wid*2048;
    #pragma unroll
    for(int r=0;r<16;++r){const int orow=crow(r,hi);
      #pragma unroll
      for(int d0=0;d0<2;++d0)stg[orow*64+d0*32+r32]=__float2bfloat16(o[d0][r]*rli[r]);}
    asm volatile("s_waitcnt lgkmcnt(0)":::"memory");
    #pragma unroll
    for(int i=0;i<4;++i){const int row=i*8+(lane>>3),ch=lane&7; const u32x4 v=*(const u32x4*)(stg+row*64+ch*8); ATTN_STORE16(Ow+(long)row*DM+ch*8,v);} }
  asm volatile("s_waitcnt lgkmcnt(0)\n\ts_barrier":::"memory");
  #undef CKSUB
  #undef DMA_K
  #undef DMA_V
  #undef CMASK
  #undef START
  #undef RESC
  #undef ROT
}
constexpr int ATTN_LDS_BYTES=LDS_BYTES;
struct AttnTensors { const bf16* Q; const bf16* K; const bf16* V; bf16* O; const float* CS; const unsigned* KM; };
struct AttnUnit { int bh; int qb; };
struct StaticOrder {
  int vcu,G;
  __device__ __forceinline__ explicit StaticOrder(int grid,int block):vcu((grid%8==0)?(block%8)*(grid/8)+block/8:block),G(grid){}
  __device__ __forceinline__ bool next(int i,AttnUnit&u)const{
    if(G==256){ if(i>=2)return false; const int s=vcu&31; u.bh=vcu>>5; u.qb=(i==0)?s:63-s; return true; }
    const int Lx=i*G+vcu; if(Lx>=NHEAD*NQB)return false; u.bh=Lx/NQB; u.qb=NQB-1-(Lx%NQB); return true; }
  __device__ __forceinline__ void a_ready(const AttnUnit&)const{}
  __device__ __forceinline__ void done(const AttnUnit&)const{}
};
template<class Sched,int THRL=8> __device__ __forceinline__ void attn_phase(char*lds,const AttnTensors&T,const Sched&S){
  AttnUnit u;
  for(int i=0;S.next(i,u);++i){ S.a_ready(u); attn_unit<THRL>(0,u.bh,u.qb,T.Q,T.K,T.V,T.O,T.CS,T.KM,lds); S.done(u); }
}
#undef SBAR
#undef WAIT_BAR
}
#define LAS __attribute__((address_space(3)))
typedef unsigned short bf16;
typedef unsigned v4u __attribute__((ext_vector_type(4)));
typedef unsigned v2u __attribute__((ext_vector_type(2)));
typedef float f32x4 __attribute__((ext_vector_type(4)));
typedef short bf16x8 __attribute__((ext_vector_type(8)));
constexpr int NWAVES = 8, NTHREADS = 512;
constexpr int M = 16384, D = 1024, FF = 2816, MEML = 256, DIN = 7176, NLAYER = 2;
constexpr float EPS = 1e-6f, LOG2E = 1.4426950408889634f;
constexpr int LDS_BYTES = 155648, XB_LDS_OFF = LDS_BYTES - 256;
static_assert(attn_body::ATTN_LDS_BYTES <= LDS_BYTES, "lds");
constexpr size_t MiB = 1u << 20;
constexpr size_t WS_SS = 1 * MiB, WS_SSV = 2 * MiB, WS_LF = 2 * MiB + 512 * 1024, WS_CS = 3 * MiB, WS_RSM = 3 * MiB + 512 * 1024, WS_MEMB = 4 * MiB, WS_KC = 4 * MiB + 512 * 1024, WS_VCT = 5 * MiB;
constexpr size_t WS_W = 6 * MiB, WS_XB = 68 * MiB, WS_SCR = 100 * MiB, WS_END = 244 * MiB;
constexpr size_t WO_GU1 = 0, WO_D1 = WO_GU1 + (size_t)5632 * 1024, WO_IN = WO_D1 + (size_t)1024 * 2816, WO_G = WO_IN + (size_t)4096 * 1024, WO_B = WO_G + (size_t)3072 * 1024,
                 WO_O = WO_B + (size_t)3 * 1024 * 512, WO_Q = WO_O + (size_t)1024 * 1024, WO_K = WO_Q + (size_t)1024 * 1024, WO_V = WO_K + (size_t)1024 * 1024, WO_XO = WO_V + (size_t)1024 * 1024,
                 WO_GU2 = WO_XO + (size_t)1024 * 1024, WO_D2 = WO_GU2 + (size_t)5632 * 1024, WO_END = WO_D2 + (size_t)1024 * 2816;
static_assert(WO_END * 2 <= WS_XB - WS_W, "weights fit");
constexpr size_t PIECE = (size_t)M * 512;

typedef __attribute__((address_space(1))) unsigned gu32;
#define RLX_AGENT __ATOMIC_RELAXED, __HIP_MEMORY_SCOPE_AGENT
#define XB_TMO      128
#define XB_XCNT(j)  (256  + 64 * (j))
#define XB_XSUB(j)  (1280 + 64 * (j))
#define XB_XGEN(j)  (2304 + 64 * (j))
#define XB_TOP      3328
#define XB_TOPGEN   3392
#define XCD_BAR_WORDS 3456
#define XB_SPIN_CAP (1u << 18)

__device__ __forceinline__ unsigned xb_ld(unsigned* p)              { return __hip_atomic_load(p, __ATOMIC_RELAXED, __HIP_MEMORY_SCOPE_AGENT); }
__device__ __forceinline__ unsigned xb_add(unsigned* p, unsigned v) { return __hip_atomic_fetch_add(p, v, __ATOMIC_RELAXED, __HIP_MEMORY_SCOPE_AGENT); }
__device__ __forceinline__ unsigned xb_xcc_id() { return (unsigned)__builtin_amdgcn_s_getreg((3 << 11) | 20) & 0xFu; }
#define XB_SPIN(cond, bar) do { unsigned _sp = 0; while (cond) { __builtin_amdgcn_s_sleep(1); \
    if ((++_sp & 255u) == 0u) { if (xb_ld(&(bar)[XB_TMO])) break; if (_sp > XB_SPIN_CAP) { atomicAdd(&(bar)[XB_TMO], 1u); break; } } } } while (0)

struct XcdBarrier {
    unsigned* bar; unsigned x;
    volatile LAS unsigned* st;
};

__device__ __forceinline__ XcdBarrier xcd_barrier_post(unsigned* bar, volatile LAS unsigned* st) {
    XcdBarrier b; b.bar = bar; b.x = xb_xcc_id(); b.st = st;
    if (threadIdx.x == 0) (void)xb_add(&bar[XB_XCNT(b.x)], 1u);
    return b;
}
__device__ __forceinline__ void xcd_barrier_complete(unsigned* bar, unsigned x, unsigned& nloc, unsigned& nx) {
    const unsigned G = gridDim.x * gridDim.y * gridDim.z;
    unsigned sum, cnt, mine, sp = 0u;
    for (;;) {
        sum = 0u; cnt = 0u; mine = 0u;
#pragma unroll
        for (unsigned j = 0; j < 16; ++j) { const unsigned c = xb_ld(&bar[XB_XCNT(j)]); sum += c; cnt += (c > 0u) ? 1u : 0u; mine = (j == x) ? c : mine; }
        if (sum == G) break;
        __builtin_amdgcn_s_sleep(1);
        if ((++sp & 255u) == 0u) { if (xb_ld(&bar[XB_TMO])) break; if (sp > XB_SPIN_CAP) { atomicAdd(&bar[XB_TMO], 1u); break; } }
    }
    nloc = mine > 0u ? mine : 1u; nx = cnt > 0u ? cnt : 1u;
}

__device__ __forceinline__ void xcd_barrier(const XcdBarrier& b) {
    asm volatile("s_waitcnt vmcnt(0)" ::: "memory");
    __syncthreads();
    if (threadIdx.x == 0) {
        unsigned* bar = b.bar;
        __builtin_amdgcn_s_waitcnt(0);
        unsigned nloc = b.st[0], nx = b.st[1];
        if (nloc == 0u) { xcd_barrier_complete(bar, b.x, nloc, nx); b.st[0] = nloc; b.st[1] = nx; }
        const unsigned old = xb_add(&bar[XB_XSUB(b.x)], 1u);
        const unsigned gen = old / nloc;
        if (old + 1u == (gen + 1u) * nloc) {
            __builtin_amdgcn_fence(__ATOMIC_RELEASE, "agent");
            asm volatile("s_waitcnt vmcnt(0)" ::: "memory");
            const unsigned og = xb_add(&bar[XB_TOP], 1u);
            const unsigned tg = og / nx;
            if (og + 1u == (tg + 1u) * nx) xb_add(&bar[XB_TOPGEN], 1u);
            else XB_SPIN(xb_ld(&bar[XB_TOPGEN]) == tg, bar);
            __builtin_amdgcn_fence(__ATOMIC_ACQUIRE, "agent");
            xb_add(&bar[XB_XGEN(b.x)], 1u);
            asm volatile("s_waitcnt vmcnt(0)" ::: "memory");
        } else {
            XB_SPIN(xb_ld(&bar[XB_XGEN(b.x)]) == gen, bar);
            __builtin_amdgcn_fence(__ATOMIC_ACQUIRE, "agent");
            asm volatile("s_waitcnt vmcnt(0)" ::: "memory");
        }
    }
    __syncthreads();
}
struct Args { const float* in[26]; float* out; unsigned char* ws; int ph_lo, ph_hi; };

__device__ __forceinline__ unsigned f2bf(float f) { unsigned u = __builtin_bit_cast(unsigned, f); return (u + 0x7fffu + ((u >> 16) & 1u)) >> 16; }
__device__ __forceinline__ unsigned pk2(float lo, float hi) { return f2bf(lo) | (f2bf(hi) << 16); }
__device__ __forceinline__ float b2f(unsigned short b) { return __uint_as_float((unsigned)b << 16); }
__device__ __forceinline__ float wave_sum(float v) {
#pragma unroll
    for (int o = 1; o < 64; o <<= 1) v += __shfl_xor(v, o);
    return v;
}
#define LDS_WAIT() asm volatile("s_waitcnt lgkmcnt(0)" ::: "memory")
__device__ __forceinline__ void conv_item(const float* W, int spitch, int k0, int n0, bf16* WT, int dpitch, int drow0, const float* gain, LAS float* scr, int lane) {
#pragma unroll
    for (int i = 0; i < 32; ++i) { const int kk = 2 * i + (lane >> 5); float v = W[(size_t)(k0 + kk) * spitch + n0 + (lane & 31)]; if (gain) v *= gain[k0 + kk]; scr[kk * 33 + (lane & 31)] = v; }
    LDS_WAIT(); asm volatile("" ::: "memory");
    const int c = lane & 7;
#pragma unroll
    for (int j = 0; j < 4; ++j) { const int n = (lane >> 3) + 8 * j; const LAS float* s = scr + (8 * c) * 33 + n;
        v4u o; o.x = pk2(s[0 * 33], s[1 * 33]); o.y = pk2(s[2 * 33], s[3 * 33]); o.z = pk2(s[4 * 33], s[5 * 33]); o.w = pk2(s[6 * 33], s[7 * 33]);
        *(v4u*)(WT + (size_t)(drow0 + n) * dpitch + k0 + 8 * c) = o; }
    LDS_WAIT(); asm volatile("" ::: "memory");
}
__device__ __forceinline__ void conv_job(int& it, int& base, int NGW, const float* W, int spitch, int K, int scol0, int ncols, bf16* WT, int doff, bool ilv, const float* gain, LAS float* scr, int lane) {
    const int nblk = ncols / 32, nitems = (K / 64) * nblk;
    for (; it < base + nitems; it += NGW) { const int r = it - base, kb = r / nblk, nb = r % nblk, nl = 32 * nb;
        const int drow0 = ilv ? (256 * (nl / 128) + (nl % 128) + doff) : (doff + nl);
        conv_item(W, spitch, 64 * kb, scol0 + nl, WT, K, drow0, gain, scr, lane); }
    base += nitems;
}

__global__ void __launch_bounds__(NTHREADS, 2) mk_fwd(Args args) {
    __builtin_assume(__builtin_amdgcn_workitem_id_y() == 0); __builtin_assume(__builtin_amdgcn_workitem_id_z() == 0);
    extern __shared__ __attribute__((aligned(16))) unsigned char lds[];
    cg::grid_group grid = cg::this_grid();
    LAS unsigned char* ldsp = (LAS unsigned char*)lds;
    if (threadIdx.x < 2) ((volatile LAS unsigned*)(ldsp + XB_LDS_OFF))[threadIdx.x] = 0u;
    __syncthreads();
    const XcdBarrier xbar = xcd_barrier_post((unsigned*)args.ws, (volatile LAS unsigned*)(ldsp + XB_LDS_OFF));
    const int G = gridDim.x, bx = blockIdx.x;
    const int vcu = (G % 8 == 0) ? (bx % 8) * (G / 8) + bx / 8 : bx;
    const int NGW = G * NWAVES;
#define TIDS() int tid_o = threadIdx.x; asm volatile("" : "+v"(tid_o)); const int tid = tid_o, lane = tid & 63, wave = __builtin_amdgcn_readfirstlane(tid >> 6), gw = vcu * NWAVES + wave; (void)gw; (void)lane; (void)tid
#define KARGS() const __attribute__((address_space(4))) Args* ap_ = (const __attribute__((address_space(4))) Args*)__builtin_amdgcn_kernarg_segment_ptr(); asm volatile("" : "+s"(ap_))
#define ws (ap_->ws)
#define X (ap_->out)
#define SS ((float*)(ws + WS_SS))
#define SSV ((float*)(ws + WS_SSV))
#define LF ((float*)(ws + WS_LF))
#define CS ((float*)(ws + WS_CS))
#define RSM ((float*)(ws + WS_RSM))
#define MEMB ((bf16*)(ws + WS_MEMB))
#define KC ((bf16*)(ws + WS_KC))
#define VCT ((bf16*)(ws + WS_VCT))
#define Wt ((bf16*)(ws + WS_W))
#define XB ((bf16*)(ws + WS_XB))
#define SCR ((bf16*)(ws + WS_SCR))
#define ACT SCR
#define PROJ SCR
#define GT (SCR + 3 * PIECE)
#define XQ SCR
#define PB (SCR + (size_t)M * 1024)
#define OB (SCR + (size_t)2 * M * 1024)
    const int lo = args.ph_lo, hi = args.ph_hi;
#ifndef PHMASK
#define PHMASK 0xffff
#endif
#define IN(k) (((PHMASK >> (((k) == 30) ? 15 : ((k) - pb == 13 || (k) - pb == 14) ? (k) - pb - 12 : (k) - pb)) & 1) && lo <= (k) && (k) < hi)
#define GRID_SYNC() do { asm volatile("s_waitcnt vmcnt(0) lgkmcnt(0)" ::: "memory"); grid.sync(); } while (0)
#define WG_SEAM() do { asm volatile("s_waitcnt vmcnt(0) lgkmcnt(0)" ::: "memory"); __syncthreads(); } while (0)
#define SEAM_LOCAL(k) do { if (lo <= (k) && (k) + 1 < hi) { if (G == 256) WG_SEAM(); else xcd_barrier(xbar); } } while (0)
#define SEAM(k) do { if (lo <= (k) && (k) + 1 < hi) { if ((k) == 0) GRID_SYNC(); else xcd_barrier(xbar); } } while (0)
#define in (ap_->in)
int pb = 0;
#pragma nounroll
    for (int l = 0; l < NLAYER; ++l) {
        pb = 15 * l;
        if (IN(pb + 0)) { KARGS(); TIDS();
            LAS float* scr = (LAS float*)(ldsp + wave * 16384);
            const size_t l1 = (size_t)l * 1024, lff = (size_t)l * 1024 * 2816, ldd = (size_t)l * 1024 * 1024;
            constexpr int NB_FF = FF / 32, I_UP = 16 * NB_FF, I_DN = (FF / 64) * 32, I_IN = 16 * 128, I_G = 16 * 96, I_B = 8 * 32, I_SQ = 16 * 32;
            constexpr int NIT = 4 * I_UP + 2 * I_DN + I_IN + I_G + 3 * I_B + 5 * I_SQ;
#pragma nounroll
            for (int it = gw; it < NIT; it += NGW) {
                int r = it; const float* W; const float* gain = nullptr; bf16* WT; int spitch, K, scol0 = 0, nblk, doff = 0; bool ilv = false;
                if (r < 2 * I_UP) { const int w = r / I_UP; r -= w * I_UP; W = in[3 + w] + lff; gain = in[2] + l1; WT = Wt + WO_GU1; spitch = FF; K = 1024; nblk = NB_FF; doff = 128 * w; ilv = true; }
                else if ((r -= 2 * I_UP) < I_DN) { W = in[5] + lff; WT = Wt + WO_D1; spitch = 1024; K = FF; nblk = 32; }
                else if ((r -= I_DN) < I_IN) { W = in[7] + (size_t)l * 1024 * DIN; gain = in[6] + l1; WT = Wt + WO_IN; spitch = DIN; K = 1024; nblk = 128; }
                else if ((r -= I_IN) < I_G) { W = in[7] + (size_t)l * 1024 * DIN; gain = in[6] + l1; WT = Wt + WO_G; spitch = DIN; K = 1024; nblk = 96; scol0 = 4104; }
                else if ((r -= I_G) < 3 * I_B) { const int w = r / I_B; r -= w * I_B; W = in[13] + ((size_t)l * 3 + w) * 512 * 1024; WT = Wt + WO_B + (size_t)w * 1024 * 512; spitch = 1024; K = 512; nblk = 32; }
                else if ((r -= 3 * I_B) < I_SQ) { W = in[14] + ldd; WT = Wt + WO_O; spitch = 1024; K = 1024; nblk = 32; }
                else if ((r -= I_SQ) < I_SQ) { W = in[17] + ldd; gain = in[15] + l1; WT = Wt + WO_Q; spitch = 1024; K = 1024; nblk = 32; }
                else if ((r -= I_SQ) < 2 * I_SQ) { const int w = r / I_SQ; r -= w * I_SQ; W = in[18 + w] + ldd; gain = in[16] + l1; WT = Wt + WO_K + (size_t)w * 1024 * 1024; spitch = 1024; K = 1024; nblk = 32; }
                else if ((r -= 2 * I_SQ) < I_SQ) { W = in[20] + ldd; WT = Wt + WO_XO; spitch = 1024; K = 1024; nblk = 32; }
                else if ((r -= I_SQ) < 2 * I_UP) { const int w = r / I_UP; r -= w * I_UP; W = in[22 + w] + lff; gain = in[21] + l1; WT = Wt + WO_GU2; spitch = FF; K = 1024; nblk = NB_FF; doff = 128 * w; ilv = true; }
                else { r -= 2 * I_UP; W = in[24] + lff; WT = Wt + WO_D2; spitch = 1024; K = FF; nblk = 32; }
                const int kb = r / nblk, nl = 32 * (r % nblk);
                const int drow0 = ilv ? (256 * (nl / 128) + (nl % 128) + doff) : (doff + nl);
                conv_item(W, spitch, 64 * kb, scol0 + nl, WT, K, drow0, gain, scr, lane);
            }
            if (l == 0) {
                for (int m = gw; m < M + MEML; m += NGW) {
                    const bool ism = m >= M; const int r = ism ? m - M : m;
                    const f32x4* xr = (const f32x4*)((ism ? in[1] : in[0]) + (size_t)r * D) + lane;
                    f32x4 v[4]; float s = 0.f;
#pragma unroll
                    for (int j = 0; j < 4; ++j) { v[j] = xr[64 * j]; s += (v[j][0] * v[j][0] + v[j][1] * v[j][1]) + (v[j][2] * v[j][2] + v[j][3] * v[j][3]); }
                    s = wave_sum(s);
                    v2u* ob = (v2u*)((ism ? MEMB : XB) + (size_t)r * D) + lane;
#pragma unroll
                    for (int j = 0; j < 4; ++j) { v2u w; w.x = pk2(v[j][0], v[j][1]); w.y = pk2(v[j][2], v[j][3]); ob[64 * j] = w; }
                    if (!ism) {
                        if (lane < 16) SS[(size_t)r * 16 + lane] = lane == 0 ? s : 0.f;
                    } else if (lane == 0) RSM[r] = rsqrtf(s * (1.0f / D) + EPS);
                }
            }
        }
        SEAM(pb + 0);
#pragma nounroll
        for (int f = 0; f < 2; ++f) {
            const int pu = pb + (f == 0 ? 1 : 13), pd = pu + 1;
            if (IN(pu)) { KARGS();
                { pg8::Gemm g{XB, Wt + (f == 0 ? WO_GU1 : WO_GU2), 1024, 1024, 1024, 0, 0}; pg8::StaticOrder S; S.init(M / 256, 22, G, bx);
                  pg8::EpiSwiGLU E{SS, ACT};
#ifndef MK_REP_UP
#define MK_REP_UP 1
#endif
_Pragma("nounroll")
                  for (int rep = 0; rep < MK_REP_UP; ++rep) pg8::gemm_phase<pg8::EpiSwiGLU, pg8::StaticOrder, true, true>(ldsp, g, S, E); }
                if (f == 0) {
                    { pg8::Gemm g{MEMB, Wt + WO_K, 1024, 1024, 1024, 0, 0}; pg8::StaticOrder S; S.init(1, 4, G, bx);
                      pg8::EpiScale<2> E{RSM, KC, 1024, 1.0f}; pg8::gemm_phase<pg8::EpiScale<2>, pg8::StaticOrder, true, true>(ldsp, g, S, E); }
                    { pg8::Gemm g{Wt + WO_V, MEMB, 1024, 1024, 1024, 0, 0}; pg8::StaticOrder S; S.init(4, 1, G, bx);
                      pg8::EpiScale<3> E{RSM, VCT, 256, 1.0f}; pg8::gemm_phase<pg8::EpiScale<3>, pg8::StaticOrder, true, true>(ldsp, g, S, E); }
                }
            }
            SEAM(pu);
            if (IN(pd)) { KARGS();
                pg8::Gemm g{ACT, Wt + (f == 0 ? WO_D1 : WO_D2), FF, FF, FF, 0, 0}; pg8::StaticOrder S; S.init(M / 256, 4, G, bx);
                pg8::EpiResid E{XB, SS, 0.5f}; pg8::gemm_phase<pg8::EpiResid, pg8::StaticOrder, true, true>(ldsp, g, S, E);
            }
            SEAM(pd);
            if (f == 1) break;
            if (IN(pb + 3)) { KARGS();
                { TIDS();
                    const float* gn = in[6] + (size_t)l * 1024; const float* bfp = in[12] + l * 8;
#pragma nounroll
                    for (int hh = 0; hh < 2; ++hh) {
                        const float* win = in[7] + (size_t)l * 1024 * DIN + 4096 + 4 * hh;
                        f32x4 wa[4][4];
#pragma unroll
                        for (int j = 0; j < 4; ++j)
#pragma unroll
                            for (int e = 0; e < 4; ++e) { const int k = 256 * j + 4 * lane + e; wa[j][e] = *(const f32x4*)(win + (size_t)k * DIN) * gn[k]; }
#pragma nounroll
                        for (int m = gw; m < M; m += NGW) {
                            const v2u* xr = (const v2u*)(XB + (size_t)m * D) + lane; float s = 0.f; f32x4 da = {0.f, 0.f, 0.f, 0.f};
#pragma unroll
                            for (int j = 0; j < 4; ++j) { const v2u xw = xr[64 * j]; const f32x4 v = {pg8::bflo(xw.x), pg8::bfhi(xw.x), pg8::bflo(xw.y), pg8::bfhi(xw.y)}; s += (v[0] * v[0] + v[1] * v[1]) + (v[2] * v[2] + v[3] * v[3]);
#pragma unroll
                                for (int e = 0; e < 4; ++e) da = da + wa[j][e] * v[e]; }
                            s = wave_sum(s);
#pragma unroll
                            for (int e = 0; e < 4; ++e) da[e] = wave_sum(da[e]);
                            float dsel = da[0]; dsel = lane == 1 ? da[1] : dsel; dsel = lane == 2 ? da[2] : dsel; dsel = lane == 3 ? da[3] : dsel;
                            if (lane < 4) { const float z = dsel * rsqrtf(s * (1.0f / D) + EPS) + bfp[4 * hh + lane]; LF[(size_t)(4 * hh + lane) * M + m] = fminf(z, 0.f) - log1pf(expf(-fabsf(z))); }
                        }
                    }
                }
                pg8::Gemm g{XB, Wt + WO_IN, 1024, 1024, 1024, 0, 0}; pg8::StaticOrder S; S.init(M / 256, 16, G, bx);
                pg8::EpiWin E{SS, PROJ, SSV, 0.125f * LOG2E}; pg8::gemm_phase<pg8::EpiWin, pg8::StaticOrder, true, true>(ldsp, g, S, E);
            }
            SEAM(pb + 3);
            if (IN(pb + 4)) { KARGS(); TIDS();
                if (bx < 8) {
                    const float* lf = LF + (size_t)bx * M + tid * 32; float* cs = CS + (size_t)bx * M + tid * 32;
                    f32x4 v[8]; float run = 0.f;
#pragma unroll
                    for (int i = 0; i < 8; ++i) { v[i] = *(const f32x4*)(lf + 4 * i);
#pragma unroll
                        for (int e = 0; e < 4; ++e) { run += v[i][e]; v[i][e] = run; } }
                    const double tot = (double)run; double incl = tot;
#pragma unroll
                    for (int o = 1; o < 64; o <<= 1) { const double t = __shfl_up(incl, o); if (lane >= o) incl += t; }
                    LAS double* wsum = (LAS double*)ldsp;
                    if (lane == 63) wsum[wave] = incl;
                    __syncthreads();
                    double bsum = 0.0;
                    for (int w = 0; w < wave; ++w) bsum += wsum[w];
                    const double excl = bsum + incl - tot;
#pragma unroll
                    for (int i = 0; i < 8; ++i) { f32x4 o;
#pragma unroll
                        for (int e = 0; e < 4; ++e) o[e] = (float)((excl + (double)v[i][e]) * 1.4426950408889634);
                        *(f32x4*)(cs + 4 * i) = o; }
                    __syncthreads();
                }
                {
                    const bf16* Kp = PROJ + 6 * PIECE; unsigned* KM = (unsigned*)(ws + 32768) + 8 * l;
                    for (int idx = vcu * NTHREADS + tid; idx < M * 8; idx += G * NTHREADS) {
                        const v4u* kp = (const v4u*)(Kp + (size_t)(idx >> 3) * 512 + (idx & 7) * 64); float s = 0.f;
#pragma unroll
                        for (int q = 0; q < 8; ++q) { const v4u w = kp[q];
#pragma unroll
                            for (int e = 0; e < 4; ++e) { const float a = pg8::bflo(w[e]), b = pg8::bfhi(w[e]); s += a * a + b * b; } }
                        s = fmaxf(s, __shfl_xor(s, 8)); s = fmaxf(s, __shfl_xor(s, 16)); s = fmaxf(s, __shfl_xor(s, 32));
                        if (lane < 8) atomicMax(KM + lane, __float_as_uint(s));
                    }
                }
                {
                    bf16* AB = PROJ; const bf16* AC = PROJ + 3 * PIECE; const bf16* AH = PROJ + 4 * PIECE; const float* cw = in[8] + (size_t)l * 3 * 512;
                    for (int idx = vcu * NTHREADS + tid; idx < M * 64; idx += G * NTHREADS) {
                        const int t = idx >> 6, c8 = (idx & 63) * 8; const size_t off = (size_t)t * 512 + c8;
                        const v4u bw = *(const v4u*)(AB + off);
                        float zz[3][8];
#pragma unroll
                        for (int d = 0; d < 3; ++d) {
                            if (t - d >= 0) { const v4u cv = *(const v4u*)(AC + off - (size_t)d * 512), hv = *(const v4u*)(AH + off - (size_t)d * 512);
#pragma unroll
                                for (int e = 0; e < 4; ++e) { zz[d][2 * e] = pg8::bflo(cv[e]) * pg8::bflo(hv[e]); zz[d][2 * e + 1] = pg8::bfhi(cv[e]) * pg8::bfhi(hv[e]); } }
                            else {
#pragma unroll
                                for (int e = 0; e < 8; ++e) zz[d][e] = 0.f; }
                        }
                        float y[8];
#pragma unroll
                        for (int e = 0; e < 8; ++e) { const float b = (e & 1) ? pg8::bfhi(bw[e >> 1]) : pg8::bflo(bw[e >> 1]);
                            y[e] = b * (cw[c8 + e] * zz[2][e] + cw[512 + c8 + e] * zz[1][e] + cw[1024 + c8 + e] * zz[0][e]); }
                        v4u o; o.x = pk2(y[0], y[1]); o.y = pk2(y[2], y[3]); o.z = pk2(y[4], y[5]); o.w = pk2(y[6], y[7]);
                        *(v4u*)(AB + off) = o;
                    }
                }
                {
                    bf16* UU = PROJ + 1 * PIECE; const bf16* VV = PROJ + 5 * PIECE; const float* sgn = in[9] + (size_t)l * 512; const float* sgw = in[10] + (size_t)l * 4 * 128 * 128; const float* sgb = in[11] + (size_t)l * 4 * 128;
                    LAS bf16* T = (LAS bf16*)ldsp;
                    const int fr = lane & 15, fq = lane >> 4;
                    for (int unit = vcu; unit < 512; unit += G) {
                        const int n = unit >> 2, gI = unit & 3;
                        { const int s = tid >> 2, cg0 = (tid & 3) * 32, row = 128 * n + s;
                          const f32x4 p0 = *(const f32x4*)(SSV + (size_t)row * 8), p1 = *(const f32x4*)(SSV + (size_t)row * 8 + 4);
                          const float rv = rsqrtf(((p0[0] + p0[1]) + (p0[2] + p0[3]) + (p1[0] + p1[1]) + (p1[2] + p1[3])) * (1.0f / 512.0f) + EPS);
#pragma unroll
                          for (int q = 0; q < 4; ++q) { const int c = cg0 + 8 * q; const v4u vw = *(const v4u*)(VV + (size_t)row * 512 + 128 * gI + c);
                              const f32x4 ga = *(const f32x4*)(sgn + 128 * gI + c), gb = *(const f32x4*)(sgn + 128 * gI + c + 4);
#pragma unroll
                              for (int e = 0; e < 4; ++e) { const float g0 = e < 2 ? ga[2 * e] : gb[2 * e - 4], g1 = e < 2 ? ga[2 * e + 1] : gb[2 * e - 3];
                                  T[(c + 2 * e) * 136 + s] = (bf16)f2bf(pg8::bflo(vw[e]) * rv * g0); T[(c + 2 * e + 1) * 136 + s] = (bf16)f2bf(pg8::bfhi(vw[e]) * rv * g1); } } }
                        __syncthreads();
                        f32x4 acc[8];
#pragma unroll
                        for (int j = 0; j < 8; ++j) acc[j] = (f32x4){0.f, 0.f, 0.f, 0.f};
                        const int t = 16 * wave + fr;
                        for (int kk = 0; kk <= (wave >> 1); ++kk) {
                            const int s0 = 32 * kk + 8 * fq; const float* wp = sgw + ((size_t)gI * 128 + t) * 128 + s0;
                            const f32x4 w0 = *(const f32x4*)wp, w1 = *(const f32x4*)(wp + 4);
                            float wv[8] = {w0[0], w0[1], w0[2], w0[3], w1[0], w1[1], w1[2], w1[3]};
#pragma unroll
                            for (int e = 0; e < 8; ++e) if (s0 + e > t) wv[e] = 0.f;
                            v4u aw; aw.x = pk2(wv[0], wv[1]); aw.y = pk2(wv[2], wv[3]); aw.z = pk2(wv[4], wv[5]); aw.w = pk2(wv[6], wv[7]);
                            const bf16x8 afr = __builtin_bit_cast(bf16x8, aw);
#pragma unroll
                            for (int j = 0; j < 8; ++j) { const bf16x8 bfr = *(const LAS bf16x8*)(T + (16 * j + fr) * 136 + s0); acc[j] = __builtin_amdgcn_mfma_f32_16x16x32_bf16(bfr, afr, acc[j], 0, 0, 0); }
                        }
                        const float bias = sgb[gI * 128 + t]; const size_t rowoff = (size_t)(128 * n + t) * 512 + 128 * gI;
#pragma unroll
                        for (int j = 0; j < 8; ++j) { const int c = 16 * j + 4 * fq; const v2u uw = *(const v2u*)(UU + rowoff + c);
                            v2u o; o.x = pk2(pg8::bflo(uw.x) * (acc[j][0] + bias), pg8::bfhi(uw.x) * (acc[j][1] + bias)); o.y = pk2(pg8::bflo(uw.y) * (acc[j][2] + bias), pg8::bfhi(uw.y) * (acc[j][3] + bias));
                            *(v2u*)(UU + rowoff + c) = o; }
                        __syncthreads();
                    }
                }
            }
            SEAM(pb + 4);
            if (IN(pb + 5)) { KARGS();
                const attn_body::AttnTensors AT{(const attn_body::bf16*)(PROJ + 8 * PIECE), (const attn_body::bf16*)(PROJ + 6 * PIECE), (const attn_body::bf16*)(PROJ + 7 * PIECE), (attn_body::bf16*)(PROJ + 2 * PIECE), CS, (const unsigned*)(ws + 32768) + 8 * l};
                const attn_body::StaticOrder S(G, bx);
#ifndef MK_REP_ATT
#define MK_REP_ATT 1
#endif
_Pragma("nounroll")
                for (int rep = 0; rep < MK_REP_ATT; ++rep) attn_body::attn_phase<attn_body::StaticOrder>((char*)lds, AT, S);
            }
            SEAM(pb + 5);
            if (IN(pb + 6)) { KARGS();
                pg8::Gemm g{XB, Wt + WO_G, 1024, 1024, 1024, 0, 0}; pg8::StaticOrder S; S.init(M / 256, 12, G, bx);
                pg8::EpiGates E{SS, GT}; pg8::gemm_phase<pg8::EpiGates, pg8::StaticOrder, true, true>(ldsp, g, S, E);
            }
            SEAM_LOCAL(pb + 6);
            if (IN(pb + 7)) { KARGS();
                pg8::Gemm g{PROJ, Wt + WO_B, 512, 512, 512, PIECE * 2, (size_t)1024 * 512 * 2}; pg8::ZOrder<3> S; S.S.init(M / 256, 4, G, bx);
                pg8::EpiMerge E{GT}; pg8::gemm_phase<pg8::EpiMerge, pg8::ZOrder<3>, true, true>(ldsp, g, S, E);
            }
            SEAM(pb + 7);
            if (IN(pb + 8)) { KARGS();
                pg8::Gemm g{GT, Wt + WO_O, 1024, 1024, 1024, 0, 0}; pg8::StaticOrder S; S.init(M / 256, 4, G, bx);
                pg8::EpiResid E{XB, SS, 1.0f}; pg8::gemm_phase<pg8::EpiResid, pg8::StaticOrder, true, true>(ldsp, g, S, E);
            }
            SEAM(pb + 8);
            if (IN(pb + 9)) { KARGS();
                pg8::Gemm g{XB, Wt + WO_Q, 1024, 1024, 1024, 0, 0}; pg8::EpiScale<1> E{SS, XQ, 1024, 0.0625f * LOG2E};
                for (int Lx = vcu; Lx < 256; Lx += G) { pg8::OneUnit S; S.u0.pm = Lx >> 2; S.u0.pn = Lx & 3; S.u0.z = 0; pg8::gemm_phase<pg8::EpiScale<1>, pg8::OneUnit, true, true>(ldsp, g, S, E); }
            }
            SEAM_LOCAL(pb + 9);
            if (IN(pb + 10)) { KARGS();
                pg8::Gemm g{XQ, KC, 256, 1024, 1024, 512, 512}; pg8::EpiSoftmax E{PB};
                for (int Lx = vcu; Lx < 256; Lx += G) { pg8::OneUnit S; S.u0.pm = Lx >> 2; S.u0.pn = 0; S.u0.z = Lx & 3; pg8::gemm_phase<pg8::EpiSoftmax, pg8::OneUnit, false, true>(ldsp, g, S, E); }
            }
            SEAM_LOCAL(pb + 10);
            if (IN(pb + 11)) { KARGS();
                pg8::Gemm g{PB, VCT, 256, 1024, 256, 512, (size_t)256 * 256 * 2}; pg8::EpiScale<0> E{nullptr, OB, 1024, 1.0f};
                for (int Lx = vcu; Lx < 256; Lx += G) { pg8::OneUnit S; S.u0.pm = Lx >> 2; S.u0.pn = 0; S.u0.z = Lx & 3; pg8::gemm_phase<pg8::EpiScale<0>, pg8::OneUnit, true, true>(ldsp, g, S, E); }
            }
            SEAM(pb + 11);
            if (IN(pb + 12)) { KARGS();
                pg8::Gemm g{OB, Wt + WO_XO, 1024, 1024, 1024, 0, 0}; pg8::StaticOrder S; S.init(M / 256, 4, G, bx);
                pg8::EpiResid E{XB, SS, 1.0f}; pg8::gemm_phase<pg8::EpiResid, pg8::StaticOrder, true, true>(ldsp, g, S, E);
            }
            SEAM(pb + 12);
        }
    }
#ifdef MK_DUMP_OFF
    {
        GRID_SYNC(); KARGS(); int t_ = threadIdx.x; asm volatile("" : "+v"(t_));
        const bf16* src = SCR + (size_t)(MK_DUMP_OFF);
        for (unsigned i = blockIdx.x * 512u + (unsigned)t_; i < (unsigned)M * 1024u; i += gridDim.x * 512u) { const unsigned m = i >> 10, c = i & 1023u;
            X[i] = c < (unsigned)(MK_DUMP_LD) ? b2f(src[(size_t)m * (MK_DUMP_LD) + c]) : 0.f; }
    }
#endif
    if (IN(30)) { KARGS(); TIDS();
        const float* gf = in[25];
        for (int m = gw; m < M; m += NGW) {
            const v2u* xb = (const v2u*)(XB + (size_t)m * D) + lane; f32x4* xr = (f32x4*)(X + (size_t)m * D) + lane; f32x4 v[4]; float s = 0.f;
#pragma unroll
            for (int j = 0; j < 4; ++j) { const v2u xw = xb[64 * j]; v[j] = (f32x4){pg8::bflo(xw.x), pg8::bfhi(xw.x), pg8::bflo(xw.y), pg8::bfhi(xw.y)}; s += (v[j][0] * v[j][0] + v[j][1] * v[j][1]) + (v[j][2] * v[j][2] + v[j][3] * v[j][3]); }
            const float r = rsqrtf(wave_sum(s) * (1.0f / D) + EPS);
#pragma unroll
            for (int j = 0; j < 4; ++j) xr[64 * j] = v[j] * r * *((const f32x4*)gf + lane + 64 * j);
        }
    }
#undef IN
#undef SEAM
#undef ws
#undef X
#undef SS
#undef SSV
#undef LF
#undef CS
#undef RSM
#undef MEMB
#undef KC
#undef VCT
#undef Wt
#undef XB
#undef SCR
#undef ACT
#undef PROJ
#undef GT
#undef XQ
#undef PB
#undef OB
#undef in
}

#ifndef MK_PER_PHASE
#define MK_PER_PHASE 0
#endif
extern "C" void kernel_launch(void* const* d_in, const int* in_sizes, int n_in, void* d_out, int out_size, void* d_ws, size_t ws_size, hipStream_t stream) {
    static int grid = 0;
    if (grid == 0) {
        if (n_in != 26 || out_size != M * D || ws_size < WS_END) { fprintf(stderr, "kernel_launch: unexpected shapes (n_in %d out %d ws %zu)\n", n_in, out_size, ws_size); grid = -1; return; }
        int dev = 0, cus = 0, per_cu = 0;
        (void)hipGetDevice(&dev); (void)hipDeviceGetAttribute(&cus, hipDeviceAttributeMultiprocessorCount, dev);
        if (hipFuncSetAttribute((const void*)mk_fwd, hipFuncAttributeMaxDynamicSharedMemorySize, LDS_BYTES) != hipSuccess) { fprintf(stderr, "kernel_launch: hipFuncSetAttribute failed\n"); grid = -1; return; }
        if (hipOccupancyMaxActiveBlocksPerMultiprocessor(&per_cu, (const void*)mk_fwd, NTHREADS, LDS_BYTES) != hipSuccess || per_cu < 1) { fprintf(stderr, "kernel_launch: occupancy query says %d\n", per_cu); per_cu = 1; }
        (void)hipGetLastError();
        grid = cus > 0 ? cus : 256;
    }
    if (grid < 0) return;
    (void)hipMemsetAsync(d_ws, 0, 65536, stream);
    Args a{};
    for (int i = 0; i < 26; ++i) a.in[i] = (const float*)d_in[i];
    a.out = (float*)d_out; a.ws = (unsigned char*)d_ws;
#if MK_PER_PHASE
    for (int p = 0; p < 31; ++p) { a.ph_lo = p; a.ph_hi = p + 1; void* kargs[] = {&a};
        hipError_t e = hipLaunchCooperativeKernel((const void*)mk_fwd, dim3(grid), dim3(NTHREADS), kargs, LDS_BYTES, stream);
        if (e != hipSuccess) { fprintf(stderr, "launch %d failed: %s\n", p, hipGetErrorString(e)); break; } }
#else
#ifndef MK_PH_HI
#define MK_PH_HI 31
#endif
    a.ph_lo = 0; a.ph_hi = MK_PH_HI; void* kargs[] = {&a};
    hipError_t e = hipLaunchCooperativeKernel((const void*)mk_fwd, dim3(grid), dim3(NTHREADS), kargs, LDS_BYTES, stream);
    if (e != hipSuccess) fprintf(stderr, "cooperative launch failed: %s (grid %d)\n", hipGetErrorString(e), grid);
#endif
}
```

```cpp
#include <hip/hip_runtime.h>
#include <hip/hip_cooperative_groups.h>
#include <cstdio>
#include <cstdint>
namespace cg = cooperative_groups;

namespace pg8 {
#define PG8_LAS __attribute__((address_space(3)))
typedef unsigned short bf16_t;
typedef short bf16x8 __attribute__((ext_vector_type(8)));
typedef float f32x4 __attribute__((ext_vector_type(4)));
typedef unsigned u32x4 __attribute__((ext_vector_type(4)));
constexpr int BM = 256, BK = 64, HALF = 128, HTB = HALF * BK * 2  , STAGE_BYTES = 8 * HTB, NXCD = 8, WGM = 8;

__host__ __device__ __forceinline__ int lds_byte(int r, int c) { const int st = (r >> 4) * 2 + (c >> 5), rr = r & 15, cc = c & 31, ob = rr * 64 + cc * 2; return st * 1024 + (ob ^ (((ob >> 9) & 1) << 5)); }
__host__ __device__ __forceinline__ void stage_rc(int b, int& R, int& C) { const int st = b / 1024, sb = b % 1024, swz = sb ^ (((sb >> 9) & 1) << 5); R = (st >> 1) * 16 + swz / 64; C = (st & 1) * 32 + (swz % 64) / 2; }
__host__ __device__ __forceinline__ int perm32(int rho) { const int n = rho >> 4, i = rho & 15; return 8 * (i >> 2) + 4 * n + (i & 3); }

struct Unit { int pm, pn, z; };
typedef float f32x2 __attribute__((ext_vector_type(2))); typedef __bf16 bf16x2_cv __attribute__((ext_vector_type(2)));
__device__ __forceinline__ unsigned cvt_pk_bf16(float lo, float hi) { const f32x2 v = {lo, hi}; const bf16x2_cv b = __builtin_convertvector(v, bf16x2_cv); return __builtin_bit_cast(unsigned, b); }
struct Gemm { const bf16_t* A; const bf16_t* Bt; int K, lda, ldb; size_t zA, zB; };

struct StaticOrder {
    int nM, nN, nwg, G, c;
    __host__ __device__ void init(int nM_, int nN_, int G_, int c_) { nM = nM_; nN = nN_; nwg = nM * nN; G = G_; c = c_; }
    __host__ __device__ void map(int wgid, Unit& u) const {
        { const int q = nwg / NXCD, r = nwg % NXCD, xcd = wgid % NXCD, off = wgid / NXCD; wgid = (xcd < r ? xcd * (q + 1) : r * (q + 1) + (xcd - r) * q) + off; }
        const int nig = WGM * nN, gid = wgid / nig, fm = gid * WGM, gsz = (nM - fm) < WGM ? (nM - fm) : WGM;
        u.pm = fm + ((wgid % nig) % gsz); u.pn = (wgid % nig) / gsz; u.z = 0;
    }
    __host__ __device__ bool next(int i, Unit& u) const { const long L = (long)i * G + c; if (L >= nwg) return false; map((int)L, u); return true; }
    __device__ __forceinline__ void a_ready(const Unit&) const {}
    __device__ __forceinline__ void done(const Unit&) const {}
};
template <int NZ> struct ZOrder {
    StaticOrder S;
    __host__ __device__ bool next(int i, Unit& u) const { const long L = (long)(i / NZ) * S.G + S.c; if (L >= S.nwg) return false; S.map((int)L, u); u.z = i % NZ; return true; }
    __device__ __forceinline__ void a_ready(const Unit&) const {}
    __device__ __forceinline__ void done(const Unit&) const {}
};
struct OneUnit {
    Unit u0;
    __host__ __device__ bool next(int i, Unit& u) const { if (i > 0) return false; u = u0; return true; }
    __device__ __forceinline__ void a_ready(const Unit&) const {}
    __device__ __forceinline__ void done(const Unit&) const {}
};

typedef unsigned u32x2 __attribute__((ext_vector_type(2)));
constexpr float LOG2E = 1.4426950408889634f;
__device__ __forceinline__ float bf2f(unsigned short b) { return __uint_as_float((unsigned)b << 16); }
__device__ __forceinline__ float bflo(unsigned w) { return __uint_as_float(w << 16); }
__device__ __forceinline__ float bfhi(unsigned w) { return __uint_as_float(w & 0xffff0000u); }
__device__ __forceinline__ float sigmoidf_(float v) { return __builtin_amdgcn_rcpf(1.0f + __builtin_amdgcn_exp2f(-v * LOG2E)); }
__device__ __forceinline__ float gelu_tanh(float v) { const float z = 0.7978845608028654f * (v + 0.044715f * v * v * v); return v * sigmoidf_(2.0f * z); }
__device__ __forceinline__ u32x4 pack8(const f32x4 a, const f32x4 b) { u32x4 w; w.x = cvt_pk_bf16(a[0], a[1]); w.y = cvt_pk_bf16(a[2], a[3]); w.z = cvt_pk_bf16(b[0], b[1]); w.w = cvt_pk_bf16(b[2], b[3]); return w; }
__device__ __forceinline__ void row_rstd(const float* SS, int rowbase, int fq, float (&rs)[2][4]) {
#pragma unroll
    for (int ai = 0; ai < 2; ++ai)
#pragma unroll
        for (int m = 0; m < 4; ++m) { const f32x4 v = *(const f32x4*)(SS + (size_t)(rowbase + ai * HALF + m * 16) * 16 + 4 * fq);
            float s = (v[0] + v[1]) + (v[2] + v[3]); s += __shfl_xor(s, 16); s += __shfl_xor(s, 32); rs[ai][m] = rsqrtf(s * (1.0f / 1024.0f) + 1e-6f); }
}
__device__ __forceinline__ float row_rstd1(const float* SS, int row, int fq) { const f32x4 v = *(const f32x4*)(SS + (size_t)row * 16 + 4 * fq);
    float s = (v[0] + v[1]) + (v[2] + v[3]); s += __shfl_xor(s, 16); s += __shfl_xor(s, 32); return rsqrtf(s * (1.0f / 1024.0f) + 1e-6f); }
#define EPI_ARGS const f32x4 (&acc)[2][2][4][2], const Unit& u, int wr, int wc, int fr, int fq
struct EpiSwiGLU { static constexpr bool PERM = true, AFTER_DRAIN = false; const float* SS; bf16_t* O;
    __device__ __forceinline__ void operator()(EPI_ARGS) const {
        float rs[2][4]; row_rstd(SS, u.pm * BM + wr * 64 + fr, fq, rs);
        const int col0 = u.pn * 128 + wc * 32 + 8 * fq;
#pragma unroll
        for (int ai = 0; ai < 2; ++ai)
#pragma unroll
            for (int m = 0; m < 4; ++m) { const float r = rs[ai][m]; f32x4 o[2];
#pragma unroll
                for (int n = 0; n < 2; ++n)
#pragma unroll
                    for (int j = 0; j < 4; ++j) { const float g = acc[ai][0][m][n][j] * r, up = acc[ai][1][m][n][j] * r; o[n][j] = g * sigmoidf_(g) * up; }
                *(u32x4*)(O + (size_t)(u.pm * BM + ai * HALF + wr * 64 + m * 16 + fr) * 2816 + col0) = pack8(o[0], o[1]); }
    }
};
struct EpiResid { static constexpr bool PERM = false, AFTER_DRAIN = false; bf16_t* XB; float* SS; float scale;
    __device__ __forceinline__ void operator()(EPI_ARGS) const {
        const int col0 = u.pn * BM + wc * 32 + 4 * fq;
#pragma unroll
        for (int ai = 0; ai < 2; ++ai)
#pragma unroll
            for (int m = 0; m < 4; ++m) { const int row = u.pm * BM + ai * HALF + wr * 64 + m * 16 + fr; float ssq = 0.f;
#pragma unroll
                for (int bj = 0; bj < 2; ++bj)
#pragma unroll
                    for (int n = 0; n < 2; ++n) { const size_t off = (size_t)row * 1024 + col0 + bj * HALF + n * 16;
                        const u32x2 xw = *(const u32x2*)(XB + off);
                        f32x4 x = {bflo(xw.x), bfhi(xw.x), bflo(xw.y), bfhi(xw.y)}; x = x + acc[ai][bj][m][n] * scale;
                        u32x2 w; w.x = cvt_pk_bf16(x[0], x[1]); w.y = cvt_pk_bf16(x[2], x[3]); *(u32x2*)(XB + off) = w;
                        ssq += (x[0] * x[0] + x[1] * x[1]) + (x[2] * x[2] + x[3] * x[3]); }
                ssq += __shfl_xor(ssq, 16); ssq += __shfl_xor(ssq, 32);
                if (fq == 0) SS[(size_t)row * 16 + u.pn * 4 + wc] = ssq; }
    }
};
struct EpiWin { static constexpr bool PERM = true, AFTER_DRAIN = false; const float* SS; bf16_t* P; float* SSV; float qscale;
    __device__ __forceinline__ void operator()(EPI_ARGS) const {
        const int piece = u.pn >> 1;
        const int slot = piece == 0 ? 0 : piece == 1 ? 3 : piece == 2 ? 4 : piece == 3 ? 1 : piece == 4 ? 5 : piece == 5 ? 8 : piece;
        bf16_t* base = P + (size_t)slot * (16384u * 512u);
        const int col0 = (u.pn & 1) * 256 + wc * 32 + 8 * fq;
        const float sc = piece == 5 ? qscale : 1.0f;
#pragma unroll
        for (int ai = 0; ai < 2; ++ai)
#pragma unroll
            for (int m = 0; m < 4; ++m) { const int row = u.pm * BM + ai * HALF + wr * 64 + m * 16 + fr; const float r = row_rstd1(SS, row, fq) * sc; float ssq = 0.f;
#pragma unroll
                for (int bj = 0; bj < 2; ++bj) { f32x4 v0 = acc[ai][bj][m][0] * r, v1 = acc[ai][bj][m][1] * r;
                    if (piece == 3 || piece == 4) {
#pragma unroll
                        for (int j = 0; j < 4; ++j) { v0[j] = gelu_tanh(v0[j]); v1[j] = gelu_tanh(v1[j]); }
                        ssq += (v0[0] * v0[0] + v0[1] * v0[1]) + (v0[2] * v0[2] + v0[3] * v0[3]) + (v1[0] * v1[0] + v1[1] * v1[1]) + (v1[2] * v1[2] + v1[3] * v1[3]); }
                    *(u32x4*)(base + (size_t)row * 512 + col0 + bj * HALF) = pack8(v0, v1); }
                if (piece == 4) { ssq += __shfl_xor(ssq, 16); ssq += __shfl_xor(ssq, 32); if (fq == 0) SSV[(size_t)row * 8 + (u.pn & 1) * 4 + wc] = ssq; }
                asm volatile("" ::: "memory"); }
    }
};
struct EpiGates { static constexpr bool PERM = true, AFTER_DRAIN = false; const float* SS; bf16_t* G;
    __device__ __forceinline__ void operator()(EPI_ARGS) const {
        float rs[2][4]; row_rstd(SS, u.pm * BM + wr * 64 + fr, fq, rs);
        bf16_t* base = G + (size_t)(u.pn >> 2) * (16384u * 1024u);
        const int col0 = (u.pn & 3) * 256 + wc * 32 + 8 * fq;
#pragma unroll
        for (int ai = 0; ai < 2; ++ai)
#pragma unroll
            for (int m = 0; m < 4; ++m) { const int row = u.pm * BM + ai * HALF + wr * 64 + m * 16 + fr; const float r = rs[ai][m];
#pragma unroll
                for (int bj = 0; bj < 2; ++bj) { f32x4 v0 = acc[ai][bj][m][0] * r, v1 = acc[ai][bj][m][1] * r;
#pragma unroll
                    for (int j = 0; j < 4; ++j) { v0[j] = sigmoidf_(v0[j]); v1[j] = sigmoidf_(v1[j]); }
                    *(u32x4*)(base + (size_t)row * 1024 + col0 + bj * HALF) = pack8(v0, v1); } }
    }
};
struct EpiMerge { static constexpr bool PERM = true, AFTER_DRAIN = false; bf16_t* G;
    __device__ __forceinline__ void operator()(EPI_ARGS) const {
        const bf16_t* gz = G + (size_t)u.z * (16384u * 1024u);
        const int col0 = u.pn * 256 + wc * 32 + 8 * fq;
#pragma unroll
        for (int ai = 0; ai < 2; ++ai)
#pragma unroll
            for (int m = 0; m < 4; ++m) { const int row = u.pm * BM + ai * HALF + wr * 64 + m * 16 + fr;
#pragma unroll
                for (int bj = 0; bj < 2; ++bj) { const size_t off = (size_t)row * 1024 + col0 + bj * HALF;
                    const u32x4 gw = *(const u32x4*)(gz + off);
                    f32x4 g0 = {bflo(gw.x), bfhi(gw.x), bflo(gw.y), bfhi(gw.y)}, g1 = {bflo(gw.z), bfhi(gw.z), bflo(gw.w), bfhi(gw.w)};
                    f32x4 v0 = acc[ai][bj][m][0] * g0, v1 = acc[ai][bj][m][1] * g1;
#ifdef MK_DBG_Z
                    if (u.z != MK_DBG_Z) { v0 = v0 * 0.f; v1 = v1 * 0.f; }
#endif
                    if (u.z != 0) { u32x4 pw; { const unsigned long long a_ = __hip_atomic_load((const unsigned long long*)(G + off), __ATOMIC_RELAXED, __HIP_MEMORY_SCOPE_AGENT), b_ = __hip_atomic_load((const unsigned long long*)(G + off) + 1, __ATOMIC_RELAXED, __HIP_MEMORY_SCOPE_AGENT);
                            pw.x = (unsigned)a_; pw.y = (unsigned)(a_ >> 32); pw.z = (unsigned)b_; pw.w = (unsigned)(b_ >> 32); }
                        v0 = v0 + (f32x4){bflo(pw.x), bfhi(pw.x), bflo(pw.y), bfhi(pw.y)}; v1 = v1 + (f32x4){bflo(pw.z), bfhi(pw.z), bflo(pw.w), bfhi(pw.w)}; }
                    *(u32x4*)(G + off) = pack8(v0, v1); } }
    }
};
template <int MODE> struct EpiScale { static constexpr bool PERM = true, AFTER_DRAIN = false; const float* S; bf16_t* O; int ldc; float scale;
    __device__ __forceinline__ void operator()(EPI_ARGS) const {
        float rs[2][4];
        if (MODE == 1) row_rstd(S, u.pm * BM + wr * 64 + fr, fq, rs);
        const int col0 = (u.pn + u.z) * 256 + wc * 32 + 8 * fq;
#pragma unroll
        for (int ai = 0; ai < 2; ++ai)
#pragma unroll
            for (int m = 0; m < 4; ++m) { const int row = u.pm * BM + ai * HALF + wr * 64 + m * 16 + fr;
                float r = scale; if (MODE == 1) r *= rs[ai][m]; if (MODE == 2) r *= S[row];
#pragma unroll
                for (int bj = 0; bj < 2; ++bj) { f32x4 v0 = acc[ai][bj][m][0] * r, v1 = acc[ai][bj][m][1] * r;
                    if (MODE == 3) { v0 = v0 * *(const f32x4*)(S + col0 + bj * HALF); v1 = v1 * *(const f32x4*)(S + col0 + bj * HALF + 4); }
                    *(u32x4*)(O + (size_t)row * ldc + col0 + bj * HALF) = pack8(v0, v1); } }
    }
};
struct EpiSoftmax { static constexpr bool PERM = true, AFTER_DRAIN = true; bf16_t* O;
    __device__ __forceinline__ void fused(f32x4 (&acc)[2][2][4][2], const Unit& u, int wr, int wc, int fr, int fq, PG8_LAS unsigned char* lds, int wid, int lane) const {
        PG8_LAS float* T1 = (PG8_LAS float*)lds; PG8_LAS float* T2 = (PG8_LAS float*)(lds + 4096);
#pragma unroll
        for (int ai = 0; ai < 2; ++ai)
#pragma unroll
            for (int m = 0; m < 4; ++m) { float mx = -3.0e38f;
#pragma unroll
                for (int bj = 0; bj < 2; ++bj)
#pragma unroll
                    for (int n = 0; n < 2; ++n)
#pragma unroll
                        for (int j = 0; j < 4; ++j) mx = fmaxf(mx, acc[ai][bj][m][n][j]);
                mx = fmaxf(mx, __shfl_xor(mx, 16)); mx = fmaxf(mx, __shfl_xor(mx, 32));
                if (fq == 0) T1[(ai * HALF + wr * 64 + m * 16 + fr) * 4 + wc] = mx; }
        asm volatile("s_waitcnt lgkmcnt(0)" ::: "memory"); __builtin_amdgcn_s_barrier(); asm volatile("" ::: "memory");
#pragma unroll
        for (int ai = 0; ai < 2; ++ai)
#pragma unroll
            for (int m = 0; m < 4; ++m) { const int rl = ai * HALF + wr * 64 + m * 16 + fr; const f32x4 t = *(const PG8_LAS f32x4*)(T1 + rl * 4);
                const float mx = fmaxf(fmaxf(t[0], t[1]), fmaxf(t[2], t[3])); float s = 0.f;
#pragma unroll
                for (int bj = 0; bj < 2; ++bj)
#pragma unroll
                    for (int n = 0; n < 2; ++n)
#pragma unroll
                        for (int j = 0; j < 4; ++j) { const float p = __builtin_amdgcn_exp2f(acc[ai][bj][m][n][j] - mx); acc[ai][bj][m][n][j] = p; s += p; }
                s += __shfl_xor(s, 16); s += __shfl_xor(s, 32);
                if (fq == 0) T2[rl * 4 + wc] = s; }
        asm volatile("s_waitcnt lgkmcnt(0)" ::: "memory"); __builtin_amdgcn_s_barrier(); asm volatile("" ::: "memory");
        const int col0 = u.z * 256 + wc * 32 + 8 * fq;
#pragma unroll
        for (int ai = 0; ai < 2; ++ai)
#pragma unroll
            for (int m = 0; m < 4; ++m) { const int rl = ai * HALF + wr * 64 + m * 16 + fr; const f32x4 t = *(const PG8_LAS f32x4*)(T2 + rl * 4);
                const float inv = 1.0f / ((t[0] + t[1]) + (t[2] + t[3]));
#pragma unroll
                for (int bj = 0; bj < 2; ++bj) *(u32x4*)(O + (size_t)(u.pm * BM + rl) * 1024 + col0 + bj * HALF) = pack8(acc[ai][bj][m][0] * inv, acc[ai][bj][m][1] * inv); }
        asm volatile("s_waitcnt lgkmcnt(0)" ::: "memory"); __builtin_amdgcn_s_barrier(); asm volatile("" ::: "memory");
    }
};

template <class Epi, class Sched, bool ALIGN_EPI = false, bool SP2 = false>
__device__ __forceinline__ void gemm_phase(PG8_LAS unsigned char* lds, const Gemm g, const Sched& S, const Epi& E) {
    int tid_o = threadIdx.x; asm volatile("" : "+v"(tid_o)); const int tid = tid_o, wid = __builtin_amdgcn_readfirstlane(tid >> 6), lane = tid & 63, wr = wid >> 2, wc = wid & 3, fr = lane & 15, fq = lane >> 4;
    const int nt = g.K / BK; const char* gA_ = reinterpret_cast<const char*>(g.A); const char* gB_ = reinterpret_cast<const char*>(g.Bt); asm volatile("" : "+s"(gA_), "+s"(gB_));
    unsigned voffA[2], voffB[2];
#pragma unroll
    for (int i = 0; i < 2; ++i) { int R, C; stage_rc(tid * 16 + i * 8192, R, C); const int Rb = Epi::PERM ? ((R & ~31) + perm32(R & 31)) : R;
        voffA[i] = (unsigned)(R * g.lda + C) * 2u; voffB[i] = (unsigned)(Rb * g.ldb + C) * 2u; }
    const size_t kstep = (size_t)(BK * 2);
    const size_t hstepA = (size_t)HALF * g.lda * 2, hstepB = (size_t)HALF * g.ldb * 2;

    const unsigned ldsw = (unsigned)wid * 1024u;
    const int aoff = lds_byte(wr * 64 + fr, fq * 8), boff = lds_byte(wc * 32 + fr, fq * 8);
#define PG8_SA(b, h) (((b) * 2 + (h)) * HTB)
#define PG8_SB(b, h) ((4 + (b) * 2 + (h)) * HTB)
#define PG8_STAGE(bufoff, gbase, voff) do { _Pragma("unroll") for (int _i = 0; _i < 2; ++_i) \
        __builtin_amdgcn_global_load_lds((const unsigned*)((const char*)(gbase) + (voff)[_i]), (PG8_LAS unsigned*)(lds + (bufoff) + ldsw + _i * 8192), 16, 0, 0); } while (0)
#define PG8_LDA(dst, b, h) do { _Pragma("unroll") for (int m = 0; m < 4; ++m) _Pragma("unroll") for (int k = 0; k < 2; ++k) dst[m][k] = *(const PG8_LAS bf16x8*)(lds + PG8_SA(b, h) + aoff + m * 2048 + k * 1024); } while (0)
#define PG8_LDB(dst, b, h) do { _Pragma("unroll") for (int n = 0; n < 2; ++n) _Pragma("unroll") for (int k = 0; k < 2; ++k) dst[n][k] = *(const PG8_LAS bf16x8*)(lds + PG8_SB(b, h) + boff + n * 2048 + k * 1024); } while (0)
#define PG8_MMA(ai, bj, At, Bt) do { __builtin_amdgcn_s_setprio(1); _Pragma("unroll") for (int m = 0; m < 4; ++m) _Pragma("unroll") for (int n = 0; n < 2; ++n) _Pragma("unroll") for (int k = 0; k < 2; ++k) \
        acc[ai][bj][m][n] = __builtin_amdgcn_mfma_f32_16x16x32_bf16(Bt[n][k], At[m][k], acc[ai][bj][m][n], 0, 0, 0); __builtin_amdgcn_s_setprio(0); } while (0)
#define PG8_WAIT_V(n) asm volatile("s_waitcnt vmcnt(" #n ")" ::: "memory")
#define PG8_WAIT_L(n) asm volatile("s_waitcnt lgkmcnt(" #n ")" ::: "memory")
#define PG8_BAR __builtin_amdgcn_s_barrier()
#define PG8_SCHED __builtin_amdgcn_sched_barrier(0)
    Unit cur, nxt; int ui = 0;
    if (!S.next(0, cur)) return;
    f32x4 acc[2][2][4][2];
#pragma unroll
    for (int a = 0; a < 2; ++a)
#pragma unroll
        for (int b = 0; b < 2; ++b)
#pragma unroll
            for (int m = 0; m < 4; ++m)
#pragma unroll
                for (int n = 0; n < 2; ++n) acc[a][b][m][n] = (f32x4){0.f, 0.f, 0.f, 0.f};
    bf16x8 At[4][2], B0[2][2], B1[2][2];
    const char* cA = gA_ + (size_t)cur.pm * 2 * hstepA + (size_t)cur.z * g.zA; const char* cB = gB_ + (size_t)cur.pn * 2 * hstepB + (size_t)cur.z * g.zB;
    S.a_ready(cur);
    if constexpr (SP2) {
        PG8_STAGE(PG8_SB(0, 0), cB, voffB); PG8_STAGE(PG8_SB(0, 1), cB + hstepB, voffB); PG8_STAGE(PG8_SA(0, 0), cA, voffA); PG8_STAGE(PG8_SA(0, 1), cA + hstepA, voffA);
        if (wr == 1) PG8_BAR;
        PG8_WAIT_V(2); PG8_BAR;
        PG8_STAGE(PG8_SB(1, 0), cB + kstep, voffB); PG8_STAGE(PG8_SA(1, 0), cA + kstep, voffA); PG8_STAGE(PG8_SB(1, 1), cB + hstepB + kstep, voffB);
        PG8_WAIT_V(6); PG8_BAR;
    } else {
        PG8_STAGE(PG8_SB(0, 0), cB, voffB); PG8_STAGE(PG8_SA(0, 0), cA, voffA); PG8_STAGE(PG8_SB(0, 1), cB + hstepB, voffB); PG8_STAGE(PG8_SA(0, 1), cA + hstepA, voffA);
        if (wr == 1) PG8_BAR;
        PG8_WAIT_V(4); PG8_BAR;
        PG8_STAGE(PG8_SB(1, 0), cB + kstep, voffB); PG8_STAGE(PG8_SA(1, 0), cA + kstep, voffA); PG8_STAGE(PG8_SB(1, 1), cB + hstepB + kstep, voffB);
        PG8_WAIT_V(6); PG8_BAR;
    }
    for (;;) {
        const bool has_next = S.next(ui + 1, nxt);
        const char* nA = has_next ? gA_ + (size_t)nxt.pm * 2 * hstepA + (size_t)nxt.z * g.zA : cA; const char* nB = has_next ? gB_ + (size_t)nxt.pn * 2 * hstepB + (size_t)nxt.z * g.zB : cB;
_Pragma("nounroll")
        for (int t = 0; t < nt; t += 2) {
            const bool last = (t == nt - 2);
            const char* a1 = cA + (size_t)(t + 1) * kstep;
            const char* a2 = last ? nA : cA + (size_t)(t + 2) * kstep; const char* b2 = last ? nB : cB + (size_t)(t + 2) * kstep;
            const char* a3 = a2 + kstep; const char* b3 = b2 + kstep;
            if (last && has_next) S.a_ready(nxt);
            if constexpr (SP2) {
            PG8_LDB(B0, 0, 0); PG8_LDB(B1, 0, 1); PG8_SCHED; PG8_LDA(At, 0, 0); PG8_STAGE(PG8_SA(1, 1), a1 + hstepA, voffA);
            PG8_WAIT_V(8); PG8_WAIT_L(0); PG8_BAR; PG8_MMA(0, 0, At, B0); PG8_MMA(0, 1, At, B1); PG8_BAR; PG8_SCHED;
            PG8_LDA(At, 0, 1); PG8_STAGE(PG8_SB(0, 0), b2, voffB); PG8_STAGE(PG8_SB(0, 1), b2 + hstepB, voffB); PG8_STAGE(PG8_SA(0, 0), a2, voffA);
            PG8_WAIT_V(8); PG8_WAIT_L(0); PG8_BAR; PG8_MMA(1, 0, At, B0); PG8_MMA(1, 1, At, B1); PG8_BAR; PG8_SCHED;
            PG8_LDB(B0, 1, 0); PG8_LDB(B1, 1, 1); PG8_SCHED; PG8_LDA(At, 1, 0); PG8_STAGE(PG8_SA(0, 1), a2 + hstepA, voffA);
            PG8_WAIT_V(8); PG8_WAIT_L(0); PG8_BAR; PG8_MMA(0, 0, At, B0); PG8_MMA(0, 1, At, B1); PG8_BAR; PG8_SCHED;
            PG8_LDA(At, 1, 1); PG8_STAGE(PG8_SB(1, 0), b3, voffB); PG8_STAGE(PG8_SB(1, 1), b3 + hstepB, voffB); PG8_STAGE(PG8_SA(1, 0), a3, voffA);
            PG8_WAIT_V(8); PG8_WAIT_L(0); PG8_BAR; PG8_MMA(1, 0, At, B0); PG8_MMA(1, 1, At, B1); PG8_BAR; PG8_SCHED;
            } else {
            PG8_LDB(B0, 0, 0); PG8_SCHED; PG8_LDA(At, 0, 0); PG8_STAGE(PG8_SA(1, 1), a1 + hstepA, voffA);
            PG8_WAIT_L(8); PG8_BAR; PG8_WAIT_L(0); PG8_MMA(0, 0, At, B0); PG8_BAR; PG8_SCHED;
            PG8_LDB(B1, 0, 1); PG8_STAGE(PG8_SB(0, 0), b2, voffB);
            PG8_BAR; PG8_WAIT_L(0); PG8_MMA(0, 1, At, B1); PG8_BAR;
            PG8_LDA(At, 0, 1); PG8_STAGE(PG8_SA(0, 0), a2, voffA);
            PG8_BAR; PG8_WAIT_L(0); PG8_MMA(1, 0, At, B0); PG8_BAR; PG8_SCHED;
            PG8_STAGE(PG8_SB(0, 1), b2 + hstepB, voffB);
            PG8_WAIT_V(6); PG8_BAR; PG8_MMA(1, 1, At, B1); PG8_BAR;
            PG8_LDB(B0, 1, 0); PG8_SCHED; PG8_LDA(At, 1, 0); PG8_STAGE(PG8_SA(0, 1), a2 + hstepA, voffA);
            PG8_WAIT_L(8); PG8_BAR; PG8_WAIT_L(0); PG8_MMA(0, 0, At, B0); PG8_BAR; PG8_SCHED;
            PG8_LDB(B1, 1, 1); PG8_STAGE(PG8_SB(1, 0), b3, voffB);
            PG8_BAR; PG8_WAIT_L(0); PG8_MMA(0, 1, At, B1); PG8_BAR;
            PG8_LDA(At, 1, 1); PG8_STAGE(PG8_SA(1, 0), a3, voffA);
            PG8_BAR; PG8_WAIT_L(0); PG8_MMA(1, 0, At, B0); PG8_BAR; PG8_SCHED;
            PG8_STAGE(PG8_SB(1, 1), b3 + hstepB, voffB);
            PG8_WAIT_V(6); PG8_BAR; PG8_MMA(1, 1, At, B1); PG8_BAR;
            }
        }
        if constexpr (ALIGN_EPI) { if (wr == 0) PG8_BAR; }
        if constexpr (!Epi::AFTER_DRAIN) { E(acc, cur, wr, wc, fr, fq); S.done(cur); }
        if (!has_next) break;
#pragma unroll
        for (int a = 0; a < 2; ++a)
#pragma unroll
            for (int b = 0; b < 2; ++b)
#pragma unroll
                for (int m = 0; m < 4; ++m)
#pragma unroll
                    for (int n = 0; n < 2; ++n) acc[a][b][m][n] = (f32x4){0.f, 0.f, 0.f, 0.f};
        cur = nxt; cA = nA; cB = nB; ++ui;
        if constexpr (ALIGN_EPI) { if (wr == 1) PG8_BAR; }
    }
    PG8_WAIT_V(0);
    if constexpr (!ALIGN_EPI) { if (wr == 0) PG8_BAR; }
    PG8_BAR;
    if constexpr (Epi::AFTER_DRAIN) { E.fused(acc, cur, wr, wc, fr, fq, lds, wid, lane); S.done(cur); }
#undef PG8_SA
#undef PG8_SB
#undef PG8_STAGE
#undef PG8_LDA
#undef PG8_LDB
#undef PG8_MMA
#undef PG8_WAIT_V
#undef PG8_WAIT_L
#undef PG8_BAR
#undef PG8_SCHED
}
}
#include <hip/hip_bf16.h>
#include <cmath>
namespace attn_body {
using bf16=__hip_bfloat16;
using bf16x8=__attribute__((ext_vector_type(8)))short;
using s16x4=__attribute__((ext_vector_type(4)))short;
using f32x16=__attribute__((ext_vector_type(16)))float;
using u32x4=__attribute__((ext_vector_type(4)))unsigned;
using f32x4_t=__attribute__((ext_vector_type(4)))float;
constexpr int BATCH=1,NHEAD=8,SEQ=16384,D=64,DM=NHEAD*D;
constexpr int NW=8,QBLK=32,QB=QBLK*NW,KVBLK=64,NQB=SEQ/QB;
constexpr int ATTN_PITCH=DM, ATTN_UNIT_ROWS=QB;
__device__ __forceinline__ int crow(int r,int hi){return (r&3)+8*(r>>2)+4*hi;}
#define SBAR() __builtin_amdgcn_sched_barrier(0)
__device__ __forceinline__ void cmask(f32x16&p0,f32x16&p1,int jb,int qrel,int hi){
  const float NEG=-INFINITY; int kb=64*jb+4*hi;
  #pragma unroll
  for(int r=0;r<16;++r){int kv=kb+(r&3)+8*(r>>2); if(kv>qrel)p0[r]=NEG; if(kv+32>qrel)p1[r]=NEG;}
}

constexpr int NSLOT=3, SLOTB=8192;
constexpr int LDS_K=0, LDS_V=NSLOT*SLOTB, LDS_WS=2*NSLOT*SLOTB, LDS_OST=LDS_WS+NW*64*4, LDS_CK=LDS_OST+NW*4096, LDS_BYTES=LDS_CK+SEQ*4;
constexpr float C2=0.125f*1.4426950408889634f;
__device__ __forceinline__ void glds16(const void*gsrc,unsigned lds_dst){unsigned keep;
  asm volatile("s_mov_b32 %0, m0\n\ts_mov_b32 m0, %2\n\ts_nop 0\n\tglobal_load_lds_dwordx4 %1, off\n\ts_mov_b32 m0, %0":"=&s"(keep):"v"(gsrc),"s"(lds_dst):"memory");}
__device__ __forceinline__ float max3f(float a,float b,float c){float r;asm("v_max3_f32 %0, %1, %2, %3":"=v"(r):"v"(a),"v"(b),"v"(c));return r;}
__device__ __forceinline__ float max2f(float a,float b){float r;asm("v_max_f32_e32 %0, %1, %2":"=v"(r):"v"(a),"v"(b));return r;}
__device__ __forceinline__ float fadd_s(float a,float b){float r;asm("v_add_f32_e32 %0, %1, %2":"=v"(r):"v"(a),"v"(b));return r;}
__device__ __forceinline__ float fsub_s(float a,float b){float r;asm("v_sub_f32_e32 %0, %1, %2":"=v"(r):"v"(a),"v"(b));return r;}
typedef float f32x2_t __attribute__((ext_vector_type(2))); typedef __bf16 bf16x2_t __attribute__((ext_vector_type(2)));
__device__ __forceinline__ unsigned cvtpk_s(float lo,float hi){f32x2_t v={lo,hi};bf16x2_t b=__builtin_convertvector(v,bf16x2_t);return __builtin_bit_cast(unsigned,b);}
#define WAIT_BAR(N) asm volatile("s_waitcnt vmcnt(" #N ") lgkmcnt(0)\n\ts_barrier":::"memory")

__device__ __forceinline__ void qkt(f32x16&p0,f32x16&p1,const char*Kslot,const bf16x8*qr,const f32x16&negm,int r32,int hi){
  const char*kb=Kslot+hi*1024+r32*16;
  #pragma unroll
  for(int d0=0;d0<4;++d0){
    const bf16x8 b0=*reinterpret_cast<const bf16x8*>(kb+d0*2048);
    const bf16x8 b1=*reinterpret_cast<const bf16x8*>(kb+d0*2048+512);
    if(d0==0){p0=__builtin_amdgcn_mfma_f32_32x32x16_bf16(b0,qr[0],negm,0,0,0);p1=__builtin_amdgcn_mfma_f32_32x32x16_bf16(b1,qr[0],negm,0,0,0);}
    else{p0=__builtin_amdgcn_mfma_f32_32x32x16_bf16(b0,qr[d0],p0,0,0,0);p1=__builtin_amdgcn_mfma_f32_32x32x16_bf16(b1,qr[d0],p1,0,0,0);}}
}
typedef __attribute__((address_space(3))) const char* lds_cptr;
typedef short v4i16_t __attribute__((ext_vector_type(4)));
__device__ __forceinline__ void kload8(bf16x8*kf,lds_cptr kp){
  kf[0]=*(const __attribute__((address_space(3))) bf16x8*)(kp);      kf[1]=*(const __attribute__((address_space(3))) bf16x8*)(kp+512);
  kf[2]=*(const __attribute__((address_space(3))) bf16x8*)(kp+2048); kf[3]=*(const __attribute__((address_space(3))) bf16x8*)(kp+2560);
  kf[4]=*(const __attribute__((address_space(3))) bf16x8*)(kp+4096); kf[5]=*(const __attribute__((address_space(3))) bf16x8*)(kp+4608);
  kf[6]=*(const __attribute__((address_space(3))) bf16x8*)(kp+6144); kf[7]=*(const __attribute__((address_space(3))) bf16x8*)(kp+6656);
}
__device__ __forceinline__ void kload2(bf16x8*kf,lds_cptr kp,int j){ kf[2*j]=*(const __attribute__((address_space(3))) bf16x8*)(kp+j*2048); kf[2*j+1]=*(const __attribute__((address_space(3))) bf16x8*)(kp+j*2048+512); }
__device__ __forceinline__ s16x4 vtr(lds_cptr p){ return __builtin_bit_cast(s16x4,__builtin_amdgcn_ds_read_tr16_b64_v4i16((__attribute__((address_space(3))) v4i16_t*)p)); }
__device__ __forceinline__ float rowmax(const f32x16&p0,const f32x16&p1){
  float a=max3f(p0[0],p0[1],p1[0]),b=max3f(p0[2],p0[3],p1[1]);a=max3f(a,p1[2],p1[3]);
  #pragma unroll
  for(int r=4;r<16;r+=4){a=max3f(a,p0[r],p0[r+1]);b=max3f(b,p0[r+2],p0[r+3]);a=max3f(a,p1[r],p1[r+1]);b=max3f(b,p1[r+2],p1[r+3]);}
  const float m=max2f(a,b);
  auto rr=__builtin_amdgcn_permlane32_swap(__float_as_uint(m),__float_as_uint(m),false,false);
  return max2f(__uint_as_float(rr[0]),__uint_as_float(rr[1]));
}
__device__ __forceinline__ void pv(f32x16*o,int vb,bf16x8 pa0,bf16x8 pa1,bf16x8 pa2,bf16x8 pa3){
  #pragma unroll
  for(int d0=0;d0<2;++d0){s16x4 lo[4],hi[4];
    #pragma unroll
    for(int ks=0;ks<4;++ks){
      asm volatile("ds_read_b64_tr_b16 %0,%1 offset:%c2":"=&v"(lo[ks]):"v"(vb),"i"(d0*4096+ks*1024):"memory");
      asm volatile("ds_read_b64_tr_b16 %0,%1 offset:%c2":"=&v"(hi[ks]):"v"(vb),"i"(d0*4096+ks*1024+512):"memory");}
    asm volatile("s_waitcnt lgkmcnt(0)":::"memory");SBAR();
    #define PK(k) (bf16x8){lo[k][0],lo[k][1],lo[k][2],lo[k][3],hi[k][0],hi[k][1],hi[k][2],hi[k][3]}
    o[d0]=__builtin_amdgcn_mfma_f32_32x32x16_bf16(pa0,PK(0),o[d0],0,0,0);
    o[d0]=__builtin_amdgcn_mfma_f32_32x32x16_bf16(pa1,PK(1),o[d0],0,0,0);
    o[d0]=__builtin_amdgcn_mfma_f32_32x32x16_bf16(pa2,PK(2),o[d0],0,0,0);
    o[d0]=__builtin_amdgcn_mfma_f32_32x32x16_bf16(pa3,PK(3),o[d0],0,0,0);
    #undef PK
  }
}

#ifndef ATTN_STORE16
#define ATTN_STORE16(p,v) (*(u32x4*)(p)=(v))
#endif
template<int THRL> __device__ __forceinline__ void attn_unit(int b,int h,int qb,const bf16*Q,const bf16*__restrict__ K,const bf16*__restrict__ V,bf16*O,const float*__restrict__ CSg,const unsigned*KMg,char*shm){
  int tid_o=threadIdx.x; asm volatile("":"+v"(tid_o)); const int tid=tid_o,lane=tid&63,r32=lane&31,hi=lane>>5; const int wid=__builtin_amdgcn_readfirstlane(tid>>6);
  const long rowbase=(long)b*SEQ; const int q0=qb*QB;
  const bf16*Qw=Q+(rowbase+q0+wid*QBLK)*DM+h*D;
  const bf16*Kh=K+rowbase*DM+h*D,*Vh=V+rowbase*DM+h*D;
  const unsigned lds0=(unsigned)(uintptr_t)shm;
  float*wsf=(float*)(shm+LDS_WS)+wid*64;
  const lds_cptr shm3=(lds_cptr)shm;
  const bf16*ksrc=Kh+(long)lane*DM+wid*8;
  const bf16*vsrc=Vh+(long)(16*(wid&3)+(lane>>2))*DM+(wid>>2)*32+(lane&3)*8;
  const unsigned kdst=lds0+LDS_K+wid*1024, vdst=lds0+LDS_V+wid*1024;
  #define DMA_K(t,slot) glds16(ksrc+(long)(t)*KVBLK*DM,(unsigned)__builtin_amdgcn_readfirstlane(kdst+(slot)))
  #define DMA_V(t,slot) glds16(vsrc+(long)(t)*KVBLK*DM,(unsigned)__builtin_amdgcn_readfirstlane(vdst+(slot)))
  const int vb0=(int)(lds0+LDS_V)+((lane>>4)&1)*32+(lane&3)*8+(4*hi+((lane&15)>>2))*64;
  const char*Kbase=shm+LDS_K; bf16x8 kf[8];
  const lds_cptr kp0=shm3+LDS_K+hi*1024+r32*16; const lds_cptr vp0=shm3+LDS_V+((lane>>4)&1)*32+(lane&3)*8+(4*hi+((lane&15)>>2))*64;
  const int NT=(q0+QB)/KVBLK;
  typedef __attribute__((address_space(3))) float* lds_fptr; typedef __attribute__((address_space(3))) f32x4_t* lds_f4ptr;
  const float*csh=CSg+(long)h*SEQ;
  { const lds_fptr ckw=(lds_fptr)(shm3+LDS_CK);
    for(int i=tid*4;i<q0+QB;i+=NW*64*4){ const f32x4_t v=*(const f32x4_t*)(csh+i); *(lds_f4ptr)(ckw+i)=v; }
  }
  const float cq=csh[q0+wid*QBLK+r32];
  asm volatile("s_waitcnt vmcnt(0) lgkmcnt(0)\n\ts_barrier":::"memory");
  const lds_fptr ckt=(lds_fptr)(shm3+LDS_CK)+4*hi;
  #define CKSUB(P0,P1,t) do{ const lds_fptr ckp_=ckt+64*(t); _Pragma("unroll") for(int j_=0;j_<4;++j_){ const f32x4_t a_=*(const lds_f4ptr)(ckp_+8*j_); const f32x4_t b_=*(const lds_f4ptr)(ckp_+32+8*j_); \
      P0[4*j_]-=a_[0];P0[4*j_+1]-=a_[1];P0[4*j_+2]-=a_[2];P0[4*j_+3]-=a_[3]; P1[4*j_]-=b_[0];P1[4*j_+1]-=b_[1];P1[4*j_+2]-=b_[2];P1[4*j_+3]-=b_[3]; SBAR(); } }while(0)
  DMA_K(0,0);DMA_V(0,0);DMA_K(1,SLOTB);
  bf16x8 qr[4];
  #pragma unroll
  for(int d0=0;d0<4;++d0)qr[d0]=*reinterpret_cast<const bf16x8*>(&Qw[(long)r32*DM+d0*16+hi*8]);
  float l_reg=0.f;f32x16 o[2];o[0]=f32x16{};o[1]=f32x16{};f32x16 negm;
  {
    float q2=0.f;
    _Pragma("unroll") for(int d0=0;d0<4;++d0) _Pragma("unroll") for(int e=0;e<8;++e){ const float v=__uint_as_float(((unsigned)(unsigned short)qr[d0][e])<<16); q2+=v*v; }
    { auto rr=__builtin_amdgcn_permlane32_swap(__float_as_uint(q2),__float_as_uint(q2),false,false); q2=__uint_as_float(rr[0])+__uint_as_float(rr[1]); }
    const float km2=__uint_as_float(__hip_atomic_load(KMg+h,__ATOMIC_RELAXED,__HIP_MEMORY_SCOPE_AGENT));
    const float Rq=sqrtf(q2*km2)*1.001f+0.01f;
    _Pragma("unroll") for(int r=0;r<16;++r)negm[r]=cq-Rq; asm volatile("":"+v"(negm)); }
  const int qrel=wid*QBLK+r32;
  #define CMASK(P0,P1,t) do{int jb_=(t)-(NT-4); if(jb_>=0)cmask(P0,P1,jb_,qrel,hi);}while(0)
  #define START(P0,P1) do{ const float rm=rowmax(P0,P1); resc=false; \
    { const float dl=rm; mhat=fadd_s(mhat,dl); \
      _Pragma("unroll") for(int r=0;r<16;++r){P0[r]=fsub_s(P0[r],dl);P1[r]=fsub_s(P1[r],dl);} \
      _Pragma("unroll") for(int r=0;r<16;++r)negm[r]=-mhat; asm volatile("":"+v"(negm)); } \
    _Pragma("unroll") for(int r=0;r<16;++r)P0[r]=__builtin_amdgcn_exp2f(P0[r]); }while(0)
  #define RESC() do{ if(resc){ asm volatile("s_waitcnt lgkmcnt(0)":::"memory"); \
      _Pragma("unroll") for(int d_=0;d_<2;++d_) _Pragma("unroll") for(int r=0;r<16;++r)o[d_][r]*=wsf[crow(r,hi)]; } }while(0)
  f32x16 pA0,pA1,pB0,pB1;
  int sl_prev=0,sl_cur=0,sl_next=SLOTB;
  #define ROT() do{sl_prev=sl_cur;sl_cur=sl_next;sl_next=(sl_next==(NSLOT-1)*SLOTB)?0:sl_next+SLOTB;}while(0)
  DMA_K(2,2*SLOTB);
  WAIT_BAR(3);
  qkt(pA0,pA1,Kbase,qr,negm,r32,hi);asm volatile("s_nop 15\n\ts_nop 7":"+v"(pA0),"+v"(pA1));CKSUB(pA0,pA1,0);CMASK(pA0,pA1,0);
  _Pragma("unroll") for(int r=0;r<16;++r)pA0[r]=__builtin_amdgcn_exp2f(pA0[r]);
  _Pragma("unroll") for(int r=0;r<16;++r)pA1[r]=__builtin_amdgcn_exp2f(pA1[r]);
  WAIT_BAR(0);
  DMA_K(3,0);DMA_V(1,SLOTB);
  ROT();
  kload8(kf,kp0+sl_cur);
  WAIT_BAR(2);
  s16x4 vlo[8],vhi[8]; u32x4 pw0,pw1,pw2,pw3;
  #define PKW(P,B) cvtpk_s(P[B],P[B+1])
  #define PAF(k) __builtin_bit_cast(bf16x8,pw##k)
  #define VFR(i) (bf16x8){vlo[i][0],vlo[i][1],vlo[i][2],vlo[i][3],vhi[i][0],vhi[i][1],vhi[i][2],vhi[i][3]}
  #define PIN(x) asm volatile("":"+v"(x))
  #define MX3(a,b,c) __builtin_fmaxf(__builtin_fmaxf((a),(b)),(c))
  #define GAPA(MF,A0,A1,A2,A3,W0,W1,PW) do{ MF; sacc+=A0; sacc+=A1; sacc+=A2; sacc+=A3; PIN(sacc); W0; W1; PIN(PW); SBAR(); }while(0)
  #define EX(v) __builtin_amdgcn_exp2f(v)
  #define GAPB(MF,X,B,CUR,NXT,NOFF) do{ MF; if((NOFF)>=0){ NXT=*(const lds_f4ptr)(ckp_+((NOFF)>=0?(NOFF):0)); } X[B]=EX(X[B]-CUR[0]); X[B+1]=EX(X[B+1]-CUR[1]); X[B+2]=EX(X[B+2]-CUR[2]); X[B+3]=EX(X[B+3]-CUR[3]); PIN(X); SBAR(); }while(0)
  #define VRD(i) do{ vlo[i]=vtr(vp_+(((i)>>2)*4096+((i)&3)*1024)); vhi[i]=vtr(vp_+(((i)>>2)*4096+((i)&3)*1024+512)); }while(0)
  #define KRD(G,j) do{ if(G){ kload2(kf,kp0+sl_next,j); SBAR(); } }while(0)
  #define STEP(C0,C1,P0,P1,t,GK,GV,GL) do{ SBAR(); \
    const lds_cptr vp_=vp0+sl_prev; \
    VRD(0); SBAR(); float sacc=(P0[0]+P0[1]); \
    GAPA(C0=__builtin_amdgcn_mfma_f32_32x32x16_bf16(kf[0],qr[0],negm,0,0,0), P0[2],P0[3],P0[4],P0[5],     pw0[0]=PKW(P0,0), pw0[1]=PKW(P0,2), pw0); \
    VRD(4); SBAR(); GAPA(C1=__builtin_amdgcn_mfma_f32_32x32x16_bf16(kf[1],qr[0],negm,0,0,0), P0[6],P0[7],P0[8],P0[9],     pw0[2]=PKW(P0,4), pw0[3]=PKW(P0,6), pw0); \
    VRD(1); SBAR(); GAPA(C0=__builtin_amdgcn_mfma_f32_32x32x16_bf16(kf[2],qr[1],C0,0,0,0),   P0[10],P0[11],P0[12],P0[13], pw1[0]=PKW(P0,8), pw1[1]=PKW(P0,10), pw1); \
    VRD(5); SBAR(); GAPA(C1=__builtin_amdgcn_mfma_f32_32x32x16_bf16(kf[3],qr[1],C1,0,0,0),   P0[14],P0[15],P1[0],P1[1],   pw1[2]=PKW(P0,12),pw1[3]=PKW(P0,14), pw1); \
    VRD(2); SBAR(); GAPA(C0=__builtin_amdgcn_mfma_f32_32x32x16_bf16(kf[4],qr[2],C0,0,0,0),   P1[2],P1[3],P1[4],P1[5],     pw2[0]=PKW(P1,0), pw2[1]=PKW(P1,2), pw2); \
    VRD(6); SBAR(); GAPA(C1=__builtin_amdgcn_mfma_f32_32x32x16_bf16(kf[5],qr[2],C1,0,0,0),   P1[6],P1[7],P1[8],P1[9],     pw2[2]=PKW(P1,4), pw2[3]=PKW(P1,6), pw2); \
    VRD(3); SBAR(); GAPA(C0=__builtin_amdgcn_mfma_f32_32x32x16_bf16(kf[6],qr[3],C0,0,0,0),   P1[10],P1[11],P1[12],P1[13], pw3[0]=PKW(P1,8), pw3[1]=PKW(P1,10), pw3); \
    VRD(7); SBAR(); GAPA(C1=__builtin_amdgcn_mfma_f32_32x32x16_bf16(kf[7],qr[3],C1,0,0,0),   P1[14],P1[15],0.f,0.f,       pw3[2]=PKW(P1,12),pw3[3]=PKW(P1,14), pw3); \
    l_reg+=sacc; \
    if(GK){DMA_K((t)+3,sl_cur);} if(GV){DMA_V((t)+1,sl_next);} \
    CMASK(C0,C1,t); \
    const lds_fptr ckp_=ckt+64*(t); f32x4_t ckA_=*(const lds_f4ptr)(ckp_), ckB_; \
    SBAR(); \
    GAPB(o[0]=__builtin_amdgcn_mfma_f32_32x32x16_bf16(PAF(0),VFR(0),o[0],0,0,0), C0,0,ckA_,ckB_,8); \
    GAPB(o[1]=__builtin_amdgcn_mfma_f32_32x32x16_bf16(PAF(0),VFR(4),o[1],0,0,0), C0,4,ckB_,ckA_,16); \
    KRD(GL,0); GAPB(o[0]=__builtin_amdgcn_mfma_f32_32x32x16_bf16(PAF(1),VFR(1),o[0],0,0,0), C0,8,ckA_,ckB_,24); \
    KRD(GL,1); GAPB(o[1]=__builtin_amdgcn_mfma_f32_32x32x16_bf16(PAF(1),VFR(5),o[1],0,0,0), C0,12,ckB_,ckA_,32); \
    KRD(GL,2); GAPB(o[0]=__builtin_amdgcn_mfma_f32_32x32x16_bf16(PAF(2),VFR(2),o[0],0,0,0), C1,0,ckA_,ckB_,40); \
    KRD(GL,3); GAPB(o[1]=__builtin_amdgcn_mfma_f32_32x32x16_bf16(PAF(2),VFR(6),o[1],0,0,0), C1,4,ckB_,ckA_,48); \
    GAPB(o[0]=__builtin_amdgcn_mfma_f32_32x32x16_bf16(PAF(3),VFR(3),o[0],0,0,0), C1,8,ckA_,ckB_,56); \
    GAPB(o[1]=__builtin_amdgcn_mfma_f32_32x32x16_bf16(PAF(3),VFR(7),o[1],0,0,0), C1,12,ckB_,ckA_,-1); \
    }while(0)
  int t=1;
  #undef CMASK
  #define CMASK(P0,P1,t) do{}while(0)
  for(;t+5<NT;t+=2){
    STEP(pB0,pB1,pA0,pA1,t,true,true,true);     WAIT_BAR(2); ROT();
    STEP(pA0,pA1,pB0,pB1,t+1,true,true,true);   WAIT_BAR(2); ROT();
  }
  #undef CMASK
  #define CMASK(P0,P1,t) do{int jb_=(t)-(NT-4); if(jb_>=0)cmask(P0,P1,jb_,qrel,hi);}while(0)
  #define ENDW(tt) do{ if((tt)+3<NT){WAIT_BAR(2);} else if((tt)+2<NT){WAIT_BAR(1);} else {WAIT_BAR(0);} }while(0)
  for(;t+1<NT;t+=2){
    STEP(pB0,pB1,pA0,pA1,t,(t+3<NT),(t+1<NT),(t+1<NT));       ENDW(t); ROT();
    STEP(pA0,pA1,pB0,pB1,t+1,(t+4<NT),(t+2<NT),(t+2<NT));     ENDW(t+1); ROT();
  }
  STEP(pB0,pB1,pA0,pA1,NT-1,false,false,false);
  { float sacc=pB0[0]+pB0[1]; _Pragma("unroll") for(int r=2;r<16;++r)sacc+=pB0[r]; _Pragma("unroll") for(int r=0;r<16;++r)sacc+=pB1[r]; l_reg+=sacc;
    pw0=(u32x4){PKW(pB0,0),PKW(pB0,2),PKW(pB0,4),PKW(pB0,6)};pw1=(u32x4){PKW(pB0,8),PKW(pB0,10),PKW(pB0,12),PKW(pB0,14)};pw2=(u32x4){PKW(pB1,0),PKW(pB1,2),PKW(pB1,4),PKW(pB1,6)};pw3=(u32x4){PKW(pB1,8),PKW(pB1,10),PKW(pB1,12),PKW(pB1,14)};
    SBAR(); pv(o,vb0+sl_cur,PAF(0),PAF(1),PAF(2),PAF(3)); }
  #undef PKW
  #undef PAF
  #undef VFR
  #undef PIN
  #undef MX3
  #undef GAPA
  #undef GAPB
  #undef EX
  #undef VRD
  #undef KRD
  #undef STEP
  #undef ENDW
  {auto rr=__builtin_amdgcn_permlane32_swap(__float_as_uint(l_reg),__float_as_uint(l_reg),false,false);l_reg=__uint_as_float(rr[0])+__uint_as_float(rr[1]);}
  if(hi==0)wsf[32+r32]=l_reg;asm volatile("s_waitcnt lgkmcnt(0)":::"memory");
  float rli[16];
  #pragma unroll
  for(int r=0;r<16;++r)rli[r]=__builtin_amdgcn_rcpf(wsf[32+crow(r,hi)]);
  bf16*Ow=O+(rowbase+q0+wid*QBLK)*DM+h*D;
  { bf16*stg=(bf16*)(shm+LDS_OST)+wid*2048;
    #pragma unroll
    for(int r=0;r<16;++r){const int orow=crow(r,hi);
      #pragma unroll
      for(int d0=0;d0<2;++d0)stg[orow*64+d0*32+r32]=__float2bfloat16(o[d0][r]*rli[r]);}
    asm volatile("s_waitcnt lgkmcnt(0)":::"memory");
    #pragma unroll
    for(int i=0;i<4;++i){const int row=i*8+(lane>>3),ch=lane&7; const u32x4 v=*(const u32x4*)(stg+row*64+ch*8); ATTN_STORE16(Ow+(long)row*DM+ch*8,v);} }
  asm volatile("s_waitcnt lgkmcnt(0)\n\ts_barrier":::"memory");
  #undef CKSUB
  #undef DMA_K
  #undef DMA_V
  #undef CMASK
  #undef START
  #undef RESC
  #undef ROT
}
constexpr int ATTN_LDS_BYTES=LDS_BYTES;
struct AttnTensors { const bf16* Q; const bf16* K; const bf16* V; bf16* O; const float* CS; const unsigned* KM; };
struct AttnUnit { int bh; int qb; };
struct StaticOrder {
  int vcu,G;
  __device__ __forceinline__ explicit StaticOrder(int grid,int block):vcu((grid%8==0)?(block%8)*(grid/8)+block/8:block),G(grid){}
  __device__ __forceinline__ bool next(int i,AttnUnit&u)const{
    if(G==256){ if(i>=2)return false; const int s=vcu&31; u.bh=vcu>>5; u.qb=(i==0)?s:63-s; return true; }
    const int Lx=i*G+vcu; if(Lx>=NHEAD*NQB)return false; u.bh=Lx/NQB; u.qb=NQB-1-(Lx%NQB); return true; }
  __device__ __forceinline__ void a_ready(const AttnUnit&)const{}
  __device__ __forceinline__ void done(const AttnUnit&)const{}
};
template<class Sched,int THRL=8> __device__ __forceinline__ void attn_phase(char*lds,const AttnTensors&T,const Sched&S){
  AttnUnit u;
  for(int i=0;S.next(i,u);++i){ S.a_ready(u); attn_unit<THRL>(0,u.bh,u.qb,T.Q,T.K,T.V,T.O,T.CS,T.KM,lds); S.done(u); }
}
#undef SBAR
#undef WAIT_BAR
}
#define LAS __attribute__((address_space(3)))
typedef unsigned short bf16;
typedef unsigned v4u __attribute__((ext_vector_type(4)));
typedef unsigned v2u __attribute__((ext_vector_type(2)));
typedef float f32x4 __attribute__((ext_vector_type(4)));
typedef short bf16x8 __attribute__((ext_vector_type(8)));
constexpr int NWAVES = 8, NTHREADS = 512;
constexpr int M = 16384, D = 1024, FF = 2816, MEML = 256, DIN = 7176, NLAYER = 2;
constexpr float EPS = 1e-6f, LOG2E = 1.4426950408889634f;
constexpr int LDS_BYTES = 155648, XB_LDS_OFF = LDS_BYTES - 256;
static_assert(attn_body::ATTN_LDS_BYTES <= LDS_BYTES, "lds");
constexpr size_t MiB = 1u << 20;
constexpr size_t WS_SS = 1 * MiB, WS_SSV = 2 * MiB, WS_LF = 2 * MiB + 512 * 1024, WS_CS = 3 * MiB, WS_RSM = 3 * MiB + 512 * 1024, WS_MEMB = 4 * MiB, WS_KC = 4 * MiB + 512 * 1024, WS_VCT = 5 * MiB;
constexpr size_t WS_W = 6 * MiB, WS_XB = 68 * MiB, WS_SCR = 100 * MiB, WS_END = 244 * MiB;
constexpr size_t WO_GU1 = 0, WO_D1 = WO_GU1 + (size_t)5632 * 1024, WO_IN = WO_D1 + (size_t)1024 * 2816, WO_G = WO_IN + (size_t)4096 * 1024, WO_B = WO_G + (size_t)3072 * 1024,
                 WO_O = WO_B + (size_t)3 * 1024 * 512, WO_Q = WO_O + (size_t)1024 * 1024, WO_K = WO_Q + (size_t)1024 * 1024, WO_V = WO_K + (size_t)1024 * 1024, WO_XO = WO_V + (size_t)1024 * 1024,
                 WO_GU2 = WO_XO + (size_t)1024 * 1024, WO_D2 = WO_GU2 + (size_t)5632 * 1024, WO_END = WO_D2 + (size_t)1024 * 2816;
static_assert((WO_END + 16 * 1024) * 2 <= WS_XB - WS_W, "weights fit");
constexpr size_t PIECE = (size_t)M * 512;

typedef __attribute__((address_space(1))) unsigned gu32;
#define RLX_AGENT __ATOMIC_RELAXED, __HIP_MEMORY_SCOPE_AGENT
#define XB_TMO      128
#define XB_XCNT(j)  (256  + 64 * (j))
#define XB_XSUB(j)  (1280 + 64 * (j))
#define XB_XGEN(j)  (2304 + 64 * (j))
#define XB_TOP      3328
#define XB_TOPGEN   3392
#define XCD_BAR_WORDS 3456
#define XB_SPIN_CAP (1u << 18)

__device__ __forceinline__ unsigned xb_ld(unsigned* p)              { return __hip_atomic_load(p, __ATOMIC_RELAXED, __HIP_MEMORY_SCOPE_AGENT); }
__device__ __forceinline__ unsigned xb_add(unsigned* p, unsigned v) { return __hip_atomic_fetch_add(p, v, __ATOMIC_RELAXED, __HIP_MEMORY_SCOPE_AGENT); }
__device__ __forceinline__ unsigned xb_xcc_id() { return (unsigned)__builtin_amdgcn_s_getreg((3 << 11) | 20) & 0xFu; }
#define XB_SPIN(cond, bar) do { unsigned _sp = 0; while (cond) { __builtin_amdgcn_s_sleep(1); \
    if ((++_sp & 255u) == 0u) { if (xb_ld(&(bar)[XB_TMO])) break; if (_sp > XB_SPIN_CAP) { atomicAdd(&(bar)[XB_TMO], 1u); break; } } } } while (0)

struct XcdBarrier {
    unsigned* bar; unsigned x;
    volatile LAS unsigned* st;
};

__device__ __forceinline__ XcdBarrier xcd_barrier_post(unsigned* bar, volatile LAS unsigned* st) {
    XcdBarrier b; b.bar = bar; b.x = xb_xcc_id(); b.st = st;
    if (threadIdx.x == 0) (void)xb_add(&bar[XB_XCNT(b.x)], 1u);
    return b;
}
__device__ __forceinline__ void xcd_barrier_complete(unsigned* bar, unsigned x, unsigned& nloc, unsigned& nx) {
    const unsigned G = gridDim.x * gridDim.y * gridDim.z;
    unsigned sum, cnt, mine, sp = 0u;
    for (;;) {
        sum = 0u; cnt = 0u; mine = 0u;
#pragma unroll
        for (unsigned j = 0; j < 16; ++j) { const unsigned c = xb_ld(&bar[XB_XCNT(j)]); sum += c; cnt += (c > 0u) ? 1u : 0u; mine = (j == x) ? c : mine; }
        if (sum == G) break;
        __builtin_amdgcn_s_sleep(1);
        if ((++sp & 255u) == 0u) { if (xb_ld(&bar[XB_TMO])) break; if (sp > XB_SPIN_CAP) { atomicAdd(&bar[XB_TMO], 1u); break; } }
    }
    nloc = mine > 0u ? mine : 1u; nx = cnt > 0u ? cnt : 1u;
}

__device__ __forceinline__ void xcd_barrier(const XcdBarrier& b) {
    asm volatile("s_waitcnt vmcnt(0)" ::: "memory");
    __syncthreads();
    if (threadIdx.x == 0) {
        unsigned* bar = b.bar;
        __builtin_amdgcn_s_waitcnt(0);
        unsigned nloc = b.st[0], nx = b.st[1];
        if (nloc == 0u) { xcd_barrier_complete(bar, b.x, nloc, nx); b.st[0] = nloc; b.st[1] = nx; }
        const unsigned old = xb_add(&bar[XB_XSUB(b.x)], 1u);
        const unsigned gen = old / nloc;
        if (old + 1u == (gen + 1u) * nloc) {
            __builtin_amdgcn_fence(__ATOMIC_RELEASE, "agent");
            asm volatile("s_waitcnt vmcnt(0)" ::: "memory");
            const unsigned og = xb_add(&bar[XB_TOP], 1u);
            const unsigned tg = og / nx;
            if (og + 1u == (tg + 1u) * nx) xb_add(&bar[XB_TOPGEN], 1u);
            else XB_SPIN(xb_ld(&bar[XB_TOPGEN]) == tg, bar);
            __builtin_amdgcn_fence(__ATOMIC_ACQUIRE, "agent");
            xb_add(&bar[XB_XGEN(b.x)], 1u);
            asm volatile("s_waitcnt vmcnt(0)" ::: "memory");
        } else {
            XB_SPIN(xb_ld(&bar[XB_XGEN(b.x)]) == gen, bar);
            __builtin_amdgcn_fence(__ATOMIC_ACQUIRE, "agent");
            asm volatile("s_waitcnt vmcnt(0)" ::: "memory");
        }
    }
    __syncthreads();
}
struct Args { const float* in[26]; float* out; unsigned char* ws; int ph_lo, ph_hi; };

__device__ __forceinline__ unsigned f2bf(float f) { unsigned u = __builtin_bit_cast(unsigned, f); return (u + 0x7fffu + ((u >> 16) & 1u)) >> 16; }
__device__ __forceinline__ unsigned pk2(float lo, float hi) { return f2bf(lo) | (f2bf(hi) << 16); }
__device__ __forceinline__ float b2f(unsigned short b) { return __uint_as_float((unsigned)b << 16); }
__device__ __forceinline__ float wave_sum(float v) {
#pragma unroll
    for (int o = 1; o < 64; o <<= 1) v += __shfl_xor(v, o);
    return v;
}
#define LDS_WAIT() asm volatile("s_waitcnt lgkmcnt(0)" ::: "memory")
__device__ __forceinline__ void conv_item(const float* W, int spitch, int k0, int n0, bf16* WT, int dpitch, int drow0, const float* gain, LAS float* scr, int lane) {
#pragma unroll
    for (int i = 0; i < 32; ++i) { const int kk = 2 * i + (lane >> 5); float v = W[(size_t)(k0 + kk) * spitch + n0 + (lane & 31)]; if (gain) v *= gain[k0 + kk]; scr[kk * 33 + (lane & 31)] = v; }
    LDS_WAIT(); asm volatile("" ::: "memory");
    const int c = lane & 7;
#pragma unroll
    for (int j = 0; j < 4; ++j) { const int n = (lane >> 3) + 8 * j; const LAS float* s = scr + (8 * c) * 33 + n;
        v4u o; o.x = pk2(s[0 * 33], s[1 * 33]); o.y = pk2(s[2 * 33], s[3 * 33]); o.z = pk2(s[4 * 33], s[5 * 33]); o.w = pk2(s[6 * 33], s[7 * 33]);
        *(v4u*)(WT + (size_t)(drow0 + n) * dpitch + k0 + 8 * c) = o; }
    LDS_WAIT(); asm volatile("" ::: "memory");
}
__device__ __forceinline__ void conv_job(int& it, int& base, int NGW, const float* W, int spitch, int K, int scol0, int ncols, bf16* WT, int doff, bool ilv, const float* gain, LAS float* scr, int lane) {
    const int nblk = ncols / 32, nitems = (K / 64) * nblk;
    for (; it < base + nitems; it += NGW) { const int r = it - base, kb = r / nblk, nb = r % nblk, nl = 32 * nb;
        const int drow0 = ilv ? (256 * (nl / 128) + (nl % 128) + doff) : (doff + nl);
        conv_item(W, spitch, 64 * kb, scol0 + nl, WT, K, drow0, gain, scr, lane); }
    base += nitems;
}

__global__ void __launch_bounds__(NTHREADS, 2) mk_fwd(Args args) {
    __builtin_assume(__builtin_amdgcn_workitem_id_y() == 0); __builtin_assume(__builtin_amdgcn_workitem_id_z() == 0);
    extern __shared__ __attribute__((aligned(16))) unsigned char lds[];
    cg::grid_group grid = cg::this_grid();
    LAS unsigned char* ldsp = (LAS unsigned char*)lds;
    if (threadIdx.x < 2) ((volatile LAS unsigned*)(ldsp + XB_LDS_OFF))[threadIdx.x] = 0u;
    __syncthreads();
    const XcdBarrier xbar = xcd_barrier_post((unsigned*)args.ws, (volatile LAS unsigned*)(ldsp + XB_LDS_OFF));
    const int G = gridDim.x, bx = blockIdx.x;
    const int vcu = (G % 8 == 0) ? (bx % 8) * (G / 8) + bx / 8 : bx;
    const int NGW = G * NWAVES;
#define TIDS() int tid_o = threadIdx.x; asm volatile("" : "+v"(tid_o)); const int tid = tid_o, lane = tid & 63, wave = __builtin_amdgcn_readfirstlane(tid >> 6), gw = vcu * NWAVES + wave; (void)gw; (void)lane; (void)tid
#define KARGS() const __attribute__((address_space(4))) Args* ap_ = (const __attribute__((address_space(4))) Args*)__builtin_amdgcn_kernarg_segment_ptr(); asm volatile("" : "+s"(ap_))
#define ws (ap_->ws)
#define X (ap_->out)
#define SS ((float*)(ws + WS_SS))
#define SSV ((float*)(ws + WS_SSV))
#define LF ((float*)(ws + WS_LF))
#define CS ((float*)(ws + WS_CS))
#define RSM ((float*)(ws + WS_RSM))
#define MEMB ((bf16*)(ws + WS_MEMB))
#define KC ((bf16*)(ws + WS_KC))
#define VCT ((bf16*)(ws + WS_VCT))
#define Wt ((bf16*)(ws + WS_W))
#define XB ((bf16*)(ws + WS_XB))
#define SCR ((bf16*)(ws + WS_SCR))
#define ACT SCR
#define PROJ SCR
#define GT (SCR + 3 * PIECE)
#define XQ SCR
#define PB (SCR + (size_t)M * 1024)
#define OB (SCR + (size_t)2 * M * 1024)
    const int lo = args.ph_lo, hi = args.ph_hi;
#ifndef PHMASK
#define PHMASK 0xffff
#endif
#define IN(k) (((PHMASK >> (((k) == 30) ? 15 : ((k) - pb == 13 || (k) - pb == 14) ? (k) - pb - 12 : (k) - pb)) & 1) && lo <= (k) && (k) < hi)
#define GRID_SYNC() do { asm volatile("s_waitcnt vmcnt(0) lgkmcnt(0)" ::: "memory"); grid.sync(); } while (0)
#define WG_SEAM() do { asm volatile("s_waitcnt vmcnt(0) lgkmcnt(0)" ::: "memory"); __syncthreads(); } while (0)
#define SEAM_LOCAL(k) do { if (lo <= (k) && (k) + 1 < hi) { if (G == 256) WG_SEAM(); else xcd_barrier(xbar); } } while (0)
#define SEAM(k) do { if (lo <= (k) && (k) + 1 < hi) { if ((k) == 0) GRID_SYNC(); else xcd_barrier(xbar); } } while (0)
#define in (ap_->in)
int pb = 0;
#pragma nounroll
    for (int l = 0; l < NLAYER; ++l) {
        pb = 15 * l;
        if (IN(pb + 0)) { KARGS(); TIDS();
            LAS float* scr = (LAS float*)(ldsp + wave * 16384);
            const size_t l1 = (size_t)l * 1024, lff = (size_t)l * 1024 * 2816, ldd = (size_t)l * 1024 * 1024;
            constexpr int NB_FF = FF / 32, I_UP = 16 * NB_FF, I_DN = (FF / 64) * 32, I_IN = 16 * 128, I_G = 16 * 96, I_B = 8 * 32, I_SQ = 16 * 32;
            constexpr int NIT = 4 * I_UP + 2 * I_DN + I_IN + I_G + 3 * I_B + 5 * I_SQ;
#pragma nounroll
            for (int it = gw; it < NIT; it += NGW) {
                int r = it; const float* W; const float* gain = nullptr; bf16* WT; int spitch, K, scol0 = 0, nblk, doff = 0; bool ilv = false;
                if (r < 2 * I_UP) { const int w = r / I_UP; r -= w * I_UP; W = in[3 + w] + lff; gain = in[2] + l1; WT = Wt + WO_GU1; spitch = FF; K = 1024; nblk = NB_FF; doff = 128 * w; ilv = true; }
                else if ((r -= 2 * I_UP) < I_DN) { W = in[5] + lff; WT = Wt + WO_D1; spitch = 1024; K = FF; nblk = 32; }
                else if ((r -= I_DN) < I_IN) { W = in[7] + (size_t)l * 1024 * DIN; gain = in[6] + l1; WT = Wt + WO_IN; spitch = DIN; K = 1024; nblk = 128; }
                else if ((r -= I_IN) < I_G) { W = in[7] + (size_t)l * 1024 * DIN; gain = in[6] + l1; WT = Wt + WO_G; spitch = DIN; K = 1024; nblk = 96; scol0 = 4104; }
                else if ((r -= I_G) < 3 * I_B) { const int w = r / I_B; r -= w * I_B; W = in[13] + ((size_t)l * 3 + w) * 512 * 1024; WT = Wt + WO_B + (size_t)w * 1024 * 512; spitch = 1024; K = 512; nblk = 32; }
                else if ((r -= 3 * I_B) < I_SQ) { W = in[14] + ldd; WT = Wt + WO_O; spitch = 1024; K = 1024; nblk = 32; }
                else if ((r -= I_SQ) < I_SQ) { W = in[17] + ldd; gain = in[15] + l1; WT = Wt + WO_Q; spitch = 1024; K = 1024; nblk = 32; }
                else if ((r -= I_SQ) < 2 * I_SQ) { const int w = r / I_SQ; r -= w * I_SQ; W = in[18 + w] + ldd; gain = in[16] + l1; WT = Wt + WO_K + (size_t)w * 1024 * 1024; spitch = 1024; K = 1024; nblk = 32; }
                else if ((r -= 2 * I_SQ) < I_SQ) { W = in[20] + ldd; WT = Wt + WO_XO; spitch = 1024; K = 1024; nblk = 32; }
                else if ((r -= I_SQ) < 2 * I_UP) { const int w = r / I_UP; r -= w * I_UP; W = in[22 + w] + lff; gain = in[21] + l1; WT = Wt + WO_GU2; spitch = FF; K = 1024; nblk = NB_FF; doff = 128 * w; ilv = true; }
                else { r -= 2 * I_UP; W = in[24] + lff; WT = Wt + WO_D2; spitch = 1024; K = FF; nblk = 32; }
                const int kb = r / nblk, nl = 32 * (r % nblk);
                const int drow0 = ilv ? (256 * (nl / 128) + (nl % 128) + doff) : (doff + nl);
                conv_item(W, spitch, 64 * kb, scol0 + nl, WT, K, drow0, gain, scr, lane);
            }
            {
                const float* wf = in[7] + (size_t)l * 1024 * DIN + 4096; const float* gn = in[6] + l1; bf16* WF = Wt + WO_END;
                for (int idx = vcu * NTHREADS + tid; idx < 8192; idx += G * NTHREADS) { const int k = idx >> 3, hd = idx & 7;
                    const float v = wf[(size_t)k * DIN + hd] * gn[k]; const unsigned hb = f2bf(v); const float lo = v - __uint_as_float(hb << 16);
                    WF[(size_t)hd * 1024 + k] = (bf16)hb; WF[(size_t)(8 + hd) * 1024 + k] = (bf16)f2bf(lo); }
            }
            if (l == 0) {
                for (int m = gw; m < M + MEML; m += NGW) {
                    const bool ism = m >= M; const int r = ism ? m - M : m;
                    const f32x4* xr = (const f32x4*)((ism ? in[1] : in[0]) + (size_t)r * D) + lane;
                    f32x4 v[4]; float s = 0.f;
#pragma unroll
                    for (int j = 0; j < 4; ++j) { v[j] = xr[64 * j]; s += (v[j][0] * v[j][0] + v[j][1] * v[j][1]) + (v[j][2] * v[j][2] + v[j][3] * v[j][3]); }
                    s = wave_sum(s);
                    v2u* ob = (v2u*)((ism ? MEMB : XB) + (size_t)r * D) + lane;
#pragma unroll
                    for (int j = 0; j < 4; ++j) { v2u w; w.x = pk2(v[j][0], v[j][1]); w.y = pk2(v[j][2], v[j][3]); ob[64 * j] = w; }
                    if (!ism) {
                        if (lane < 16) SS[(size_t)r * 16 + lane] = lane == 0 ? s : 0.f;
                    } else if (lane == 0) RSM[r] = rsqrtf(s * (1.0f / D) + EPS);
                }
            }
        }
        SEAM(pb + 0);
#pragma nounroll
        for (int f = 0; f < 2; ++f) {
            const int pu = pb + (f == 0 ? 1 : 13), pd = pu + 1;
            if (IN(pu)) { KARGS();
                { pg8::Gemm g{XB, Wt + (f == 0 ? WO_GU1 : WO_GU2), 1024, 1024, 1024, 0, 0}; pg8::StaticOrder S; S.init(M / 256, 22, G, bx);
                  pg8::EpiSwiGLU E{SS, ACT};
#ifndef MK_REP_UP
#define MK_REP_UP 1
#endif
_Pragma("nounroll")
                  for (int rep = 0; rep < MK_REP_UP; ++rep) pg8::gemm_phase<pg8::EpiSwiGLU, pg8::StaticOrder, true, true>(ldsp, g, S, E); }
                if (f == 0) {
                    { pg8::Gemm g{MEMB, Wt + WO_K, 1024, 1024, 1024, 0, 0}; pg8::StaticOrder S; S.init(1, 4, G, bx);
                      pg8::EpiScale<2> E{RSM, KC, 1024, 1.0f}; pg8::gemm_phase<pg8::EpiScale<2>, pg8::StaticOrder, true, true>(ldsp, g, S, E); }
                    { pg8::Gemm g{Wt + WO_V, MEMB, 1024, 1024, 1024, 0, 0}; pg8::StaticOrder S; S.init(4, 1, G, bx);
                      pg8::EpiScale<3> E{RSM, VCT, 256, 1.0f}; pg8::gemm_phase<pg8::EpiScale<3>, pg8::StaticOrder, true, true>(ldsp, g, S, E); }
                }
            }
            SEAM(pu);
            if (IN(pd)) { KARGS();
                pg8::Gemm g{ACT, Wt + (f == 0 ? WO_D1 : WO_D2), FF, FF, FF, 0, 0}; pg8::StaticOrder S; S.init(M / 256, 4, G, bx);
                pg8::EpiResid E{XB, SS, 0.5f}; pg8::gemm_phase<pg8::EpiResid, pg8::StaticOrder, true, true>(ldsp, g, S, E);
            }
            SEAM(pd);
            if (f == 1) break;
            if (IN(pb + 3)) { KARGS();
                { TIDS();
                    const float* bfp = in[12] + l * 8; const bf16* WF = Wt + WO_END; const int fr = lane & 15, fq = lane >> 4;
                    for (int tile = gw; tile < M / 16; tile += NGW) {
                        const int row = 16 * tile + fr;
                        const bf16* ap = XB + (size_t)row * D + 8 * fq; const bf16* bp = WF + (size_t)fr * D + 8 * fq;
                        f32x4 acc = {0.f, 0.f, 0.f, 0.f};
#pragma unroll 8
                        for (int ks = 0; ks < 32; ++ks) { const bf16x8 a = *(const bf16x8*)(ap + 32 * ks), b = *(const bf16x8*)(bp + 32 * ks); acc = __builtin_amdgcn_mfma_f32_16x16x32_bf16(b, a, acc, 0, 0, 0); }
                        const float rs = pg8::row_rstd1(SS, row, fq);
#pragma unroll
                        for (int j = 0; j < 4; ++j) { const float t = acc[j] + __shfl_xor(acc[j], 32);
                            if (fq < 2) { const int hd = 4 * fq + j; const float z = t * rs + bfp[hd]; LF[(size_t)hd * M + row] = fminf(z, 0.f) - log1pf(expf(-fabsf(z))); } }
                    }
                }
                pg8::Gemm g{XB, Wt + WO_IN, 1024, 1024, 1024, 0, 0}; pg8::StaticOrder S; S.init(M / 256, 16, G, bx);
                pg8::EpiWin E{SS, PROJ, SSV, 0.125f * LOG2E}; pg8::gemm_phase<pg8::EpiWin, pg8::StaticOrder, true, true>(ldsp, g, S, E);
            }
            SEAM(pb + 3);
            if (IN(pb + 4)) { KARGS(); TIDS();
                if (bx < 8) {
                    const float* lf = LF + (size_t)bx * M + tid * 32; float* cs = CS + (size_t)bx * M + tid * 32;
                    f32x4 v[8]; float run = 0.f;
#pragma unroll
                    for (int i = 0; i < 8; ++i) { v[i] = *(const f32x4*)(lf + 4 * i);
#pragma unroll
                        for (int e = 0; e < 4; ++e) { run += v[i][e]; v[i][e] = run; } }
                    const double tot = (double)run; double incl = tot;
#pragma unroll
                    for (int o = 1; o < 64; o <<= 1) { const double t = __shfl_up(incl, o); if (lane >= o) incl += t; }
                    LAS double* wsum = (LAS double*)ldsp;
                    if (lane == 63) wsum[wave] = incl;
                    __syncthreads();
                    double bsum = 0.0;
                    for (int w = 0; w < wave; ++w) bsum += wsum[w];
                    const double excl = bsum + incl - tot;
#pragma unroll
                    for (int i = 0; i < 8; ++i) { f32x4 o;
#pragma unroll
                        for (int e = 0; e < 4; ++e) o[e] = (float)((excl + (double)v[i][e]) * 1.4426950408889634);
                        *(f32x4*)(cs + 4 * i) = o; }
                    __syncthreads();
                }
                {
                    const bf16* Kp = PROJ + 6 * PIECE; unsigned* KM = (unsigned*)(ws + 32768) + 8 * l;
                    for (int idx = vcu * NTHREADS + tid; idx < M * 8; idx += G * NTHREADS) {
                        const v4u* kp = (const v4u*)(Kp + (size_t)(idx >> 3) * 512 + (idx & 7) * 64); float s = 0.f;
#pragma unroll
                        for (int q = 0; q < 8; ++q) { const v4u w = kp[q];
#pragma unroll
                            for (int e = 0; e < 4; ++e) { const float a = pg8::bflo(w[e]), b = pg8::bfhi(w[e]); s += a * a + b * b; } }
                        s = fmaxf(s, __shfl_xor(s, 8)); s = fmaxf(s, __shfl_xor(s, 16)); s = fmaxf(s, __shfl_xor(s, 32));
                        if (lane < 8) atomicMax(KM + lane, __float_as_uint(s));
                    }
                }
                {
                    bf16* AB = PROJ; const bf16* AC = PROJ + 3 * PIECE; const bf16* AH = PROJ + 4 * PIECE; const float* cw = in[8] + (size_t)l * 3 * 512;
                    for (int idx = vcu * NTHREADS + tid; idx < M * 64; idx += G * NTHREADS) {
                        const int t = idx >> 6, c8 = (idx & 63) * 8; const size_t off = (size_t)t * 512 + c8;
                        const v4u bw = *(const v4u*)(AB + off);
                        float zz[3][8];
#pragma unroll
                        for (int d = 0; d < 3; ++d) {
                            if (t - d >= 0) { const v4u cv = *(const v4u*)(AC + off - (size_t)d * 512), hv = *(const v4u*)(AH + off - (size_t)d * 512);
#pragma unroll
                                for (int e = 0; e < 4; ++e) { zz[d][2 * e] = pg8::bflo(cv[e]) * pg8::bflo(hv[e]); zz[d][2 * e + 1] = pg8::bfhi(cv[e]) * pg8::bfhi(hv[e]); } }
                            else {
#pragma unroll
                                for (int e = 0; e < 8; ++e) zz[d][e] = 0.f; }
                        }
                        float y[8];
#pragma unroll
                        for (int e = 0; e < 8; ++e) { const float b = (e & 1) ? pg8::bfhi(bw[e >> 1]) : pg8::bflo(bw[e >> 1]);
                            y[e] = b * (cw[c8 + e] * zz[2][e] + cw[512 + c8 + e] * zz[1][e] + cw[1024 + c8 + e] * zz[0][e]); }
                        v4u o; o.x = pk2(y[0], y[1]); o.y = pk2(y[2], y[3]); o.z = pk2(y[4], y[5]); o.w = pk2(y[6], y[7]);
                        *(v4u*)(AB + off) = o;
                    }
                }
                {
                    bf16* UU = PROJ + 1 * PIECE; const bf16* VV = PROJ + 5 * PIECE; const float* sgn = in[9] + (size_t)l * 512; const float* sgw = in[10] + (size_t)l * 4 * 128 * 128; const float* sgb = in[11] + (size_t)l * 4 * 128;
                    LAS bf16* T = (LAS bf16*)ldsp;
                    const int fr = lane & 15, fq = lane >> 4;
                    for (int unit = vcu; unit < 512; unit += G) {
                        const int n = unit >> 2, gI = unit & 3;
                        { const int s = tid >> 2, cg0 = (tid & 3) * 32, row = 128 * n + s;
                          const f32x4 p0 = *(const f32x4*)(SSV + (size_t)row * 8), p1 = *(const f32x4*)(SSV + (size_t)row * 8 + 4);
                          const float rv = rsqrtf(((p0[0] + p0[1]) + (p0[2] + p0[3]) + (p1[0] + p1[1]) + (p1[2] + p1[3])) * (1.0f / 512.0f) + EPS);
#pragma unroll
                          for (int q = 0; q < 4; ++q) { const int c = cg0 + 8 * q; const v4u vw = *(const v4u*)(VV + (size_t)row * 512 + 128 * gI + c);
                              const f32x4 ga = *(const f32x4*)(sgn + 128 * gI + c), gb = *(const f32x4*)(sgn + 128 * gI + c + 4);
#pragma unroll
                              for (int e = 0; e < 4; ++e) { const float g0 = e < 2 ? ga[2 * e] : gb[2 * e - 4], g1 = e < 2 ? ga[2 * e + 1] : gb[2 * e - 3];
                                  T[(c + 2 * e) * 136 + s] = (bf16)f2bf(pg8::bflo(vw[e]) * rv * g0); T[(c + 2 * e + 1) * 136 + s] = (bf16)f2bf(pg8::bfhi(vw[e]) * rv * g1); } } }
                        __syncthreads();
                        f32x4 acc[8];
#pragma unroll
                        for (int j = 0; j < 8; ++j) acc[j] = (f32x4){0.f, 0.f, 0.f, 0.f};
                        const int t = 16 * wave + fr;
                        for (int kk = 0; kk <= (wave >> 1); ++kk) {
                            const int s0 = 32 * kk + 8 * fq; const float* wp = sgw + ((size_t)gI * 128 + t) * 128 + s0;
                            const f32x4 w0 = *(const f32x4*)wp, w1 = *(const f32x4*)(wp + 4);
                            float wv[8] = {w0[0], w0[1], w0[2], w0[3], w1[0], w1[1], w1[2], w1[3]};
#pragma unroll
                            for (int e = 0; e < 8; ++e) if (s0 + e > t) wv[e] = 0.f;
                            v4u aw; aw.x = pk2(wv[0], wv[1]); aw.y = pk2(wv[2], wv[3]); aw.z = pk2(wv[4], wv[5]); aw.w = pk2(wv[6], wv[7]);
                            const bf16x8 afr = __builtin_bit_cast(bf16x8, aw);
#pragma unroll
                            for (int j = 0; j < 8; ++j) { const bf16x8 bfr = *(const LAS bf16x8*)(T + (16 * j + fr) * 136 + s0); acc[j] = __builtin_amdgcn_mfma_f32_16x16x32_bf16(bfr, afr, acc[j], 0, 0, 0); }
                        }
                        const float bias = sgb[gI * 128 + t]; const size_t rowoff = (size_t)(128 * n + t) * 512 + 128 * gI;
#pragma unroll
                        for (int j = 0; j < 8; ++j) { const int c = 16 * j + 4 * fq; const v2u uw = *(const v2u*)(UU + rowoff + c);
                            v2u o; o.x = pk2(pg8::bflo(uw.x) * (acc[j][0] + bias), pg8::bfhi(uw.x) * (acc[j][1] + bias)); o.y = pk2(pg8::bflo(uw.y) * (acc[j][2] + bias), pg8::bfhi(uw.y) * (acc[j][3] + bias));
                            *(v2u*)(UU + rowoff + c) = o; }
                        __syncthreads();
                    }
                }
            }
            SEAM(pb + 4);
            if (IN(pb + 5)) { KARGS();
                const attn_body::AttnTensors AT{(const attn_body::bf16*)(PROJ + 8 * PIECE), (const attn_body::bf16*)(PROJ + 6 * PIECE), (const attn_body::bf16*)(PROJ + 7 * PIECE), (attn_body::bf16*)(PROJ + 2 * PIECE), CS, (const unsigned*)(ws + 32768) + 8 * l};
                const attn_body::StaticOrder S(G, bx);
#ifndef MK_REP_ATT
#define MK_REP_ATT 1
#endif
_Pragma("nounroll")
                for (int rep = 0; rep < MK_REP_ATT; ++rep) attn_body::attn_phase<attn_body::StaticOrder>((char*)lds, AT, S);
            }
            SEAM(pb + 5);
            if (IN(pb + 6)) { KARGS();
                pg8::Gemm g{XB, Wt + WO_G, 1024, 1024, 1024, 0, 0}; pg8::StaticOrder S; S.init(M / 256, 12, G, bx);
                pg8::EpiGates E{SS, GT}; pg8::gemm_phase<pg8::EpiGates, pg8::StaticOrder, true, true>(ldsp, g, S, E);
            }
            SEAM_LOCAL(pb + 6);
            if (IN(pb + 7)) { KARGS();
                pg8::Gemm g{PROJ, Wt + WO_B, 512, 512, 512, PIECE * 2, (size_t)1024 * 512 * 2}; pg8::ZOrder<3> S; S.S.init(M / 256, 4, G, bx);
                pg8::EpiMerge E{GT}; pg8::gemm_phase<pg8::EpiMerge, pg8::ZOrder<3>, true, true>(ldsp, g, S, E);
            }
            SEAM(pb + 7);
            if (IN(pb + 8)) { KARGS();
                pg8::Gemm g{GT, Wt + WO_O, 1024, 1024, 1024, 0, 0}; pg8::StaticOrder S; S.init(M / 256, 4, G, bx);
                pg8::EpiResid E{XB, SS, 1.0f}; pg8::gemm_phase<pg8::EpiResid, pg8::StaticOrder, true, true>(ldsp, g, S, E);
            }
            SEAM(pb + 8);
            if (IN(pb + 9)) { KARGS();
                pg8::Gemm g{XB, Wt + WO_Q, 1024, 1024, 1024, 0, 0}; pg8::EpiScale<1> E{SS, XQ, 1024, 0.0625f * LOG2E};
                for (int Lx = vcu; Lx < 256; Lx += G) { pg8::OneUnit S; S.u0.pm = Lx >> 2; S.u0.pn = Lx & 3; S.u0.z = 0; pg8::gemm_phase<pg8::EpiScale<1>, pg8::OneUnit, true, true>(ldsp, g, S, E); }
            }
            SEAM_LOCAL(pb + 9);
            if (IN(pb + 10)) { KARGS();
                pg8::Gemm g{XQ, KC, 256, 1024, 1024, 512, 512}; pg8::EpiSoftmax E{PB};
                for (int Lx = vcu; Lx < 256; Lx += G) { pg8::OneUnit S; S.u0.pm = Lx >> 2; S.u0.pn = 0; S.u0.z = Lx & 3; pg8::gemm_phase<pg8::EpiSoftmax, pg8::OneUnit, false, true>(ldsp, g, S, E); }
            }
            SEAM_LOCAL(pb + 10);
            if (IN(pb + 11)) { KARGS();
                pg8::Gemm g{PB, VCT, 256, 1024, 256, 512, (size_t)256 * 256 * 2}; pg8::EpiScale<0> E{nullptr, OB, 1024, 1.0f};
                for (int Lx = vcu; Lx < 256; Lx += G) { pg8::OneUnit S; S.u0.pm = Lx >> 2; S.u0.pn = 0; S.u0.z = Lx & 3; pg8::gemm_phase<pg8::EpiScale<0>, pg8::OneUnit, true, true>(ldsp, g, S, E); }
            }
            SEAM(pb + 11);
            if (IN(pb + 12)) { KARGS();
                pg8::Gemm g{OB, Wt + WO_XO, 1024, 1024, 1024, 0, 0}; pg8::StaticOrder S; S.init(M / 256, 4, G, bx);
                pg8::EpiResid E{XB, SS, 1.0f}; pg8::gemm_phase<pg8::EpiResid, pg8::StaticOrder, true, true>(ldsp, g, S, E);
            }
            SEAM(pb + 12);
        }
    }
#ifdef MK_DUMP_OFF
    {
        GRID_SYNC(); KARGS(); int t_ = threadIdx.x; asm volatile("" : "+v"(t_));
        const bf16* src = SCR + (size_t)(MK_DUMP_OFF);
        for (unsigned i = blockIdx.x * 512u + (unsigned)t_; i < (unsigned)M * 1024u; i += gridDim.x * 512u) { const unsigned m = i >> 10, c = i & 1023u;
            X[i] = c < (unsigned)(MK_DUMP_LD) ? b2f(src[(size_t)m * (MK_DUMP_LD) + c]) : 0.f; }
    }
#endif
    if (IN(30)) { KARGS(); TIDS();
        const float* gf = in[25];
        for (int m = gw; m < M; m += NGW) {
            const v2u* xb = (const v2u*)(XB + (size_t)m * D) + lane; f32x4* xr = (f32x4*)(X + (size_t)m * D) + lane; f32x4 v[4]; float s = 0.f;
#pragma unroll
            for (int j = 0; j < 4; ++j) { const v2u xw = xb[64 * j]; v[j] = (f32x4){pg8::bflo(xw.x), pg8::bfhi(xw.x), pg8::bflo(xw.y), pg8::bfhi(xw.y)}; s += (v[j][0] * v[j][0] + v[j][1] * v[j][1]) + (v[j][2] * v[j][2] + v[j][3] * v[j][3]); }
            const float r = rsqrtf(wave_sum(s) * (1.0f / D) + EPS);
#pragma unroll
            for (int j = 0; j < 4; ++j) xr[64 * j] = v[j] * r * *((const f32x4*)gf + lane + 64 * j);
        }
    }
#undef IN
#undef SEAM
#undef ws
#undef X
#undef SS
#undef SSV
#undef LF
#undef CS
#undef RSM
#undef MEMB
#undef KC
#undef VCT
#undef Wt
#undef XB
#undef SCR
#undef ACT
#undef PROJ
#undef GT
#undef XQ
#undef PB
#undef OB
#undef in
}

#ifndef MK_PER_PHASE
#define MK_PER_PHASE 0
#endif
extern "C" void kernel_launch(void* const* d_in, const int* in_sizes, int n_in, void* d_out, int out_size, void* d_ws, size_t ws_size, hipStream_t stream) {
    static int grid = 0;
    if (grid == 0) {
        if (n_in != 26 || out_size != M * D || ws_size < WS_END) { fprintf(stderr, "kernel_launch: unexpected shapes (n_in %d out %d ws %zu)\n", n_in, out_size, ws_size); grid = -1; return; }
        int dev = 0, cus = 0, per_cu = 0;
        (void)hipGetDevice(&dev); (void)hipDeviceGetAttribute(&cus, hipDeviceAttributeMultiprocessorCount, dev);
        if (hipFuncSetAttribute((const void*)mk_fwd, hipFuncAttributeMaxDynamicSharedMemorySize, LDS_BYTES) != hipSuccess) { fprintf(stderr, "kernel_launch: hipFuncSetAttribute failed\n"); grid = -1; return; }
        if (hipOccupancyMaxActiveBlocksPerMultiprocessor(&per_cu, (const void*)mk_fwd, NTHREADS, LDS_BYTES) != hipSuccess || per_cu < 1) { fprintf(stderr, "kernel_launch: occupancy query says %d\n", per_cu); per_cu = 1; }
        (void)hipGetLastError();
        grid = cus > 0 ? cus : 256;
    }
    if (grid < 0) return;
    (void)hipMemsetAsync(d_ws, 0, 65536, stream);
    Args a{};
    for (int i = 0; i < 26; ++i) a.in[i] = (const float*)d_in[i];
    a.out = (float*)d_out; a.ws = (unsigned char*)d_ws;
#if MK_PER_PHASE
    for (int p = 0; p < 31; ++p) { a.ph_lo = p; a.ph_hi = p + 1; void* kargs[] = {&a};
        hipError_t e = hipLaunchCooperativeKernel((const void*)mk_fwd, dim3(grid), dim3(NTHREADS), kargs, LDS_BYTES, stream);
        if (e != hipSuccess) { fprintf(stderr, "launch %d failed: %s\n", p, hipGetErrorString(e)); break; } }
#else
#ifndef MK_PH_HI
#define MK_PH_HI 31
#endif
    a.ph_lo = 0; a.ph_hi = MK_PH_HI; void* kargs[] = {&a};
    hipError_t e = hipLaunchCooperativeKernel((const void*)mk_fwd, dim3(grid), dim3(NTHREADS), kargs, LDS_BYTES, stream);
    if (e != hipSuccess) fprintf(stderr, "cooperative launch failed: %s (grid %d)\n", hipGetErrorString(e), grid);
#endif
}
```

```cpp
#include <hip/hip_runtime.h>
#include <hip/hip_cooperative_groups.h>
#include <cstdio>
#include <cstdint>
namespace cg = cooperative_groups;

namespace pg8 {
#define PG8_LAS __attribute__((address_space(3)))
typedef unsigned short bf16_t;
typedef short bf16x8 __attribute__((ext_vector_type(8)));
typedef float f32x4 __attribute__((ext_vector_type(4)));
typedef unsigned u32x4 __attribute__((ext_vector_type(4)));
constexpr int BM = 256, BK = 64, HALF = 128, HTB = HALF * BK * 2  , STAGE_BYTES = 8 * HTB, NXCD = 8, WGM = 8;

__host__ __device__ __forceinline__ int lds_byte(int r, int c) { const int st = (r >> 4) * 2 + (c >> 5), rr = r & 15, cc = c & 31, ob = rr * 64 + cc * 2; return st * 1024 + (ob ^ (((ob >> 9) & 1) << 5)); }
__host__ __device__ __forceinline__ void stage_rc(int b, int& R, int& C) { const int st = b / 1024, sb = b % 1024, swz = sb ^ (((sb >> 9) & 1) << 5); R = (st >> 1) * 16 + swz / 64; C = (st & 1) * 32 + (swz % 64) / 2; }
__host__ __device__ __forceinline__ int perm32(int rho) { const int n = rho >> 4, i = rho & 15; return 8 * (i >> 2) + 4 * n + (i & 3); }

struct Unit { int pm, pn, z; };
typedef float f32x2 __attribute__((ext_vector_type(2))); typedef __bf16 bf16x2_cv __attribute__((ext_vector_type(2)));
__device__ __forceinline__ unsigned cvt_pk_bf16(float lo, float hi) { const f32x2 v = {lo, hi}; const bf16x2_cv b = __builtin_convertvector(v, bf16x2_cv); return __builtin_bit_cast(unsigned, b); }
struct Gemm { const bf16_t* A; const bf16_t* Bt; int K, lda, ldb; size_t zA, zB; };

struct StaticOrder {
    int nM, nN, nwg, G, c;
    __host__ __device__ void init(int nM_, int nN_, int G_, int c_) { nM = nM_; nN = nN_; nwg = nM * nN; G = G_; c = c_; }
    __host__ __device__ void map(int wgid, Unit& u) const {
        { const int q = nwg / NXCD, r = nwg % NXCD, xcd = wgid % NXCD, off = wgid / NXCD; wgid = (xcd < r ? xcd * (q + 1) : r * (q + 1) + (xcd - r) * q) + off; }
        const int nig = WGM * nN, gid = wgid / nig, fm = gid * WGM, gsz = (nM - fm) < WGM ? (nM - fm) : WGM;
        u.pm = fm + ((wgid % nig) % gsz); u.pn = (wgid % nig) / gsz; u.z = 0;
    }
    __host__ __device__ bool next(int i, Unit& u) const { const long L = (long)i * G + c; if (L >= nwg) return false; map((int)L, u); return true; }
    __device__ __forceinline__ void a_ready(const Unit&) const {}
    __device__ __forceinline__ void done(const Unit&) const {}
};
template <int NZ> struct ZOrder {
    StaticOrder S;
    __host__ __device__ bool next(int i, Unit& u) const { const long L = (long)(i / NZ) * S.G + S.c; if (L >= S.nwg) return false; S.map((int)L, u); u.z = i % NZ; return true; }
    __device__ __forceinline__ void a_ready(const Unit&) const {}
    __device__ __forceinline__ void done(const Unit&) const {}
};
struct OneUnit {
    Unit u0;
    __host__ __device__ bool next(int i, Unit& u) const { if (i > 0) return false; u = u0; return true; }
    __device__ __forceinline__ void a_ready(const Unit&) const {}
    __device__ __forceinline__ void done(const Unit&) const {}
};

typedef unsigned u32x2 __attribute__((ext_vector_type(2)));
constexpr float LOG2E = 1.4426950408889634f;
__device__ __forceinline__ float bf2f(unsigned short b) { return __uint_as_float((unsigned)b << 16); }
__device__ __forceinline__ float bflo(unsigned w) { return __uint_as_float(w << 16); }
__device__ __forceinline__ float bfhi(unsigned w) { return __uint_as_float(w & 0xffff0000u); }
__device__ __forceinline__ float sigmoidf_(float v) { return __builtin_amdgcn_rcpf(1.0f + __builtin_amdgcn_exp2f(-v * LOG2E)); }
__device__ __forceinline__ float gelu_tanh(float v) { const float z = 0.7978845608028654f * (v + 0.044715f * v * v * v); return v * sigmoidf_(2.0f * z); }
__device__ __forceinline__ u32x4 pack8(const f32x4 a, const f32x4 b) { u32x4 w; w.x = cvt_pk_bf16(a[0], a[1]); w.y = cvt_pk_bf16(a[2], a[3]); w.z = cvt_pk_bf16(b[0], b[1]); w.w = cvt_pk_bf16(b[2], b[3]); return w; }
__device__ __forceinline__ void row_rstd(const float* SS, int rowbase, int fq, float (&rs)[2][4]) {
#pragma unroll
    for (int ai = 0; ai < 2; ++ai)
#pragma unroll
        for (int m = 0; m < 4; ++m) { const f32x4 v = *(const f32x4*)(SS + (size_t)(rowbase + ai * HALF + m * 16) * 16 + 4 * fq);
            float s = (v[0] + v[1]) + (v[2] + v[3]); s += __shfl_xor(s, 16); s += __shfl_xor(s, 32); rs[ai][m] = rsqrtf(s * (1.0f / 1024.0f) + 1e-6f); }
}
__device__ __forceinline__ float row_rstd1(const float* SS, int row, int fq) { const f32x4 v = *(const f32x4*)(SS + (size_t)row * 16 + 4 * fq);
    float s = (v[0] + v[1]) + (v[2] + v[3]); s += __shfl_xor(s, 16); s += __shfl_xor(s, 32); return rsqrtf(s * (1.0f / 1024.0f) + 1e-6f); }
#define EPI_ARGS const f32x4 (&acc)[2][2][4][2], const Unit& u, int wr, int wc, int fr, int fq
struct EpiSwiGLU { static constexpr bool PERM = true, AFTER_DRAIN = false; const float* SS; bf16_t* O;
    __device__ __forceinline__ void operator()(EPI_ARGS) const {
        float rs[2][4]; row_rstd(SS, u.pm * BM + wr * 64 + fr, fq, rs);
        const int col0 = u.pn * 128 + wc * 32 + 8 * fq;
#pragma unroll
        for (int ai = 0; ai < 2; ++ai)
#pragma unroll
            for (int m = 0; m < 4; ++m) { const float r = rs[ai][m]; f32x4 o[2];
#pragma unroll
                for (int n = 0; n < 2; ++n)
#pragma unroll
                    for (int j = 0; j < 4; ++j) { const float g = acc[ai][0][m][n][j] * r, up = acc[ai][1][m][n][j] * r; o[n][j] = g * sigmoidf_(g) * up; }
                *(u32x4*)(O + (size_t)(u.pm * BM + ai * HALF + wr * 64 + m * 16 + fr) * 2816 + col0) = pack8(o[0], o[1]); }
    }
};
struct EpiResid { static constexpr bool PERM = false, AFTER_DRAIN = false; bf16_t* XB; float* SS; float scale;
    __device__ __forceinline__ void operator()(EPI_ARGS) const {
        const int col0 = u.pn * BM + wc * 32 + 4 * fq;
#pragma unroll
        for (int ai = 0; ai < 2; ++ai)
#pragma unroll
            for (int m = 0; m < 4; ++m) { const int row = u.pm * BM + ai * HALF + wr * 64 + m * 16 + fr; float ssq = 0.f;
#pragma unroll
                for (int bj = 0; bj < 2; ++bj)
#pragma unroll
                    for (int n = 0; n < 2; ++n) { const size_t off = (size_t)row * 1024 + col0 + bj * HALF + n * 16;
                        const u32x2 xw = *(const u32x2*)(XB + off);
                        f32x4 x = {bflo(xw.x), bfhi(xw.x), bflo(xw.y), bfhi(xw.y)}; x = x + acc[ai][bj][m][n] * scale;
                        u32x2 w; w.x = cvt_pk_bf16(x[0], x[1]); w.y = cvt_pk_bf16(x[2], x[3]); *(u32x2*)(XB + off) = w;
                        ssq += (x[0] * x[0] + x[1] * x[1]) + (x[2] * x[2] + x[3] * x[3]); }
                ssq += __shfl_xor(ssq, 16); ssq += __shfl_xor(ssq, 32);
                if (fq == 0) SS[(size_t)row * 16 + u.pn * 4 + wc] = ssq; }
    }
};
struct EpiWin { static constexpr bool PERM = true, AFTER_DRAIN = false; const float* SS; bf16_t* P; float* SSV; float qscale;
    __device__ __forceinline__ void operator()(EPI_ARGS) const {
        const int piece = u.pn >> 1;
        const int slot = piece == 0 ? 0 : piece == 1 ? 3 : piece == 2 ? 4 : piece == 3 ? 1 : piece == 4 ? 5 : piece == 5 ? 8 : piece;
        bf16_t* base = P + (size_t)slot * (16384u * 512u);
        const int col0 = (u.pn & 1) * 256 + wc * 32 + 8 * fq;
        const float sc = piece == 5 ? qscale : 1.0f;
#pragma unroll
        for (int ai = 0; ai < 2; ++ai)
#pragma unroll
            for (int m = 0; m < 4; ++m) { const int row = u.pm * BM + ai * HALF + wr * 64 + m * 16 + fr; const float r = row_rstd1(SS, row, fq) * sc; float ssq = 0.f;
#pragma unroll
                for (int bj = 0; bj < 2; ++bj) { f32x4 v0 = acc[ai][bj][m][0] * r, v1 = acc[ai][bj][m][1] * r;
                    if (piece == 3 || piece == 4) {
#pragma unroll
                        for (int j = 0; j < 4; ++j) { v0[j] = gelu_tanh(v0[j]); v1[j] = gelu_tanh(v1[j]); }
                        ssq += (v0[0] * v0[0] + v0[1] * v0[1]) + (v0[2] * v0[2] + v0[3] * v0[3]) + (v1[0] * v1[0] + v1[1] * v1[1]) + (v1[2] * v1[2] + v1[3] * v1[3]); }
                    *(u32x4*)(base + (size_t)row * 512 + col0 + bj * HALF) = pack8(v0, v1); }
                if (piece == 4) { ssq += __shfl_xor(ssq, 16); ssq += __shfl_xor(ssq, 32); if (fq == 0) SSV[(size_t)row * 8 + (u.pn & 1) * 4 + wc] = ssq; }
                asm volatile("" ::: "memory"); }
    }
};
struct EpiGates { static constexpr bool PERM = true, AFTER_DRAIN = false; const float* SS; bf16_t* G;
    __device__ __forceinline__ void operator()(EPI_ARGS) const {
        float rs[2][4]; row_rstd(SS, u.pm * BM + wr * 64 + fr, fq, rs);
        bf16_t* base = G + (size_t)(u.pn >> 2) * (16384u * 1024u);
        const int col0 = (u.pn & 3) * 256 + wc * 32 + 8 * fq;
#pragma unroll
        for (int ai = 0; ai < 2; ++ai)
#pragma unroll
            for (int m = 0; m < 4; ++m) { const int row = u.pm * BM + ai * HALF + wr * 64 + m * 16 + fr; const float r = rs[ai][m];
#pragma unroll
                for (int bj = 0; bj < 2; ++bj) { f32x4 v0 = acc[ai][bj][m][0] * r, v1 = acc[ai][bj][m][1] * r;
#pragma unroll
                    for (int j = 0; j < 4; ++j) { v0[j] = sigmoidf_(v0[j]); v1[j] = sigmoidf_(v1[j]); }
                    *(u32x4*)(base + (size_t)row * 1024 + col0 + bj * HALF) = pack8(v0, v1); } }
    }
};
struct EpiMerge { static constexpr bool PERM = true, AFTER_DRAIN = false; bf16_t* G;
    __device__ __forceinline__ void operator()(EPI_ARGS) const {
        const bf16_t* gz = G + (size_t)u.z * (16384u * 1024u);
        const int col0 = u.pn * 256 + wc * 32 + 8 * fq;
#pragma unroll
        for (int ai = 0; ai < 2; ++ai)
#pragma unroll
            for (int m = 0; m < 4; ++m) { const int row = u.pm * BM + ai * HALF + wr * 64 + m * 16 + fr;
#pragma unroll
                for (int bj = 0; bj < 2; ++bj) { const size_t off = (size_t)row * 1024 + col0 + bj * HALF;
                    const u32x4 gw = *(const u32x4*)(gz + off);
                    f32x4 g0 = {bflo(gw.x), bfhi(gw.x), bflo(gw.y), bfhi(gw.y)}, g1 = {bflo(gw.z), bfhi(gw.z), bflo(gw.w), bfhi(gw.w)};
                    f32x4 v0 = acc[ai][bj][m][0] * g0, v1 = acc[ai][bj][m][1] * g1;
#ifdef MK_DBG_Z
                    if (u.z != MK_DBG_Z) { v0 = v0 * 0.f; v1 = v1 * 0.f; }
#endif
                    if (u.z != 0) { u32x4 pw; { const unsigned long long a_ = __hip_atomic_load((const unsigned long long*)(G + off), __ATOMIC_RELAXED, __HIP_MEMORY_SCOPE_AGENT), b_ = __hip_atomic_load((const unsigned long long*)(G + off) + 1, __ATOMIC_RELAXED, __HIP_MEMORY_SCOPE_AGENT);
                            pw.x = (unsigned)a_; pw.y = (unsigned)(a_ >> 32); pw.z = (unsigned)b_; pw.w = (unsigned)(b_ >> 32); }
                        v0 = v0 + (f32x4){bflo(pw.x), bfhi(pw.x), bflo(pw.y), bfhi(pw.y)}; v1 = v1 + (f32x4){bflo(pw.z), bfhi(pw.z), bflo(pw.w), bfhi(pw.w)}; }
                    *(u32x4*)(G + off) = pack8(v0, v1); } }
    }
};
template <int MODE> struct EpiScale { static constexpr bool PERM = true, AFTER_DRAIN = false; const float* S; bf16_t* O; int ldc; float scale;
    __device__ __forceinline__ void operator()(EPI_ARGS) const {
        float rs[2][4];
        if (MODE == 1) row_rstd(S, u.pm * BM + wr * 64 + fr, fq, rs);
        const int col0 = (u.pn + u.z) * 256 + wc * 32 + 8 * fq;
#pragma unroll
        for (int ai = 0; ai < 2; ++ai)
#pragma unroll
            for (int m = 0; m < 4; ++m) { const int row = u.pm * BM + ai * HALF + wr * 64 + m * 16 + fr;
                float r = scale; if (MODE == 1) r *= rs[ai][m]; if (MODE == 2) r *= S[row];
#pragma unroll
                for (int bj = 0; bj < 2; ++bj) { f32x4 v0 = acc[ai][bj][m][0] * r, v1 = acc[ai][bj][m][1] * r;
                    if (MODE == 3) { v0 = v0 * *(const f32x4*)(S + col0 + bj * HALF); v1 = v1 * *(const f32x4*)(S + col0 + bj * HALF + 4); }
                    *(u32x4*)(O + (size_t)row * ldc + col0 + bj * HALF) = pack8(v0, v1); } }
    }
};
struct EpiSoftmax { static constexpr bool PERM = true, AFTER_DRAIN = true; bf16_t* O;
    __device__ __forceinline__ void fused(f32x4 (&acc)[2][2][4][2], const Unit& u, int wr, int wc, int fr, int fq, PG8_LAS unsigned char* lds, int wid, int lane) const {
        PG8_LAS float* T1 = (PG8_LAS float*)lds; PG8_LAS float* T2 = (PG8_LAS float*)(lds + 4096);
#pragma unroll
        for (int ai = 0; ai < 2; ++ai)
#pragma unroll
            for (int m = 0; m < 4; ++m) { float mx = -3.0e38f;
#pragma unroll
                for (int bj = 0; bj < 2; ++bj)
#pragma unroll
                    for (int n = 0; n < 2; ++n)
#pragma unroll
                        for (int j = 0; j < 4; ++j) mx = fmaxf(mx, acc[ai][bj][m][n][j]);
                mx = fmaxf(mx, __shfl_xor(mx, 16)); mx = fmaxf(mx, __shfl_xor(mx, 32));
                if (fq == 0) T1[(ai * HALF + wr * 64 + m * 16 + fr) * 4 + wc] = mx; }
        asm volatile("s_waitcnt lgkmcnt(0)" ::: "memory"); __builtin_amdgcn_s_barrier(); asm volatile("" ::: "memory");
#pragma unroll
        for (int ai = 0; ai < 2; ++ai)
#pragma unroll
            for (int m = 0; m < 4; ++m) { const int rl = ai * HALF + wr * 64 + m * 16 + fr; const f32x4 t = *(const PG8_LAS f32x4*)(T1 + rl * 4);
                const float mx = fmaxf(fmaxf(t[0], t[1]), fmaxf(t[2], t[3])); float s = 0.f;
#pragma unroll
                for (int bj = 0; bj < 2; ++bj)
#pragma unroll
                    for (int n = 0; n < 2; ++n)
#pragma unroll
                        for (int j = 0; j < 4; ++j) { const float p = __builtin_amdgcn_exp2f(acc[ai][bj][m][n][j] - mx); acc[ai][bj][m][n][j] = p; s += p; }
                s += __shfl_xor(s, 16); s += __shfl_xor(s, 32);
                if (fq == 0) T2[rl * 4 + wc] = s; }
        asm volatile("s_waitcnt lgkmcnt(0)" ::: "memory"); __builtin_amdgcn_s_barrier(); asm volatile("" ::: "memory");
        const int col0 = u.z * 256 + wc * 32 + 8 * fq;
#pragma unroll
        for (int ai = 0; ai < 2; ++ai)
#pragma unroll
            for (int m = 0; m < 4; ++m) { const int rl = ai * HALF + wr * 64 + m * 16 + fr; const f32x4 t = *(const PG8_LAS f32x4*)(T2 + rl * 4);
                const float inv = 1.0f / ((t[0] + t[1]) + (t[2] + t[3]));
#pragma unroll
                for (int bj = 0; bj < 2; ++bj) *(u32x4*)(O + (size_t)(u.pm * BM + rl) * 1024 + col0 + bj * HALF) = pack8(acc[ai][bj][m][0] * inv, acc[ai][bj][m][1] * inv); }
        asm volatile("s_waitcnt lgkmcnt(0)" ::: "memory"); __builtin_amdgcn_s_barrier(); asm volatile("" ::: "memory");
    }
};

template <class Epi, class Sched, bool ALIGN_EPI = false, bool SP2 = false>
__device__ __forceinline__ void gemm_phase(PG8_LAS unsigned char* lds, const Gemm g, const Sched& S, const Epi& E) {
    int tid_o = threadIdx.x; asm volatile("" : "+v"(tid_o)); const int tid = tid_o, wid = __builtin_amdgcn_readfirstlane(tid >> 6), lane = tid & 63, wr = wid >> 2, wc = wid & 3, fr = lane & 15, fq = lane >> 4;
    const int nt = g.K / BK; const char* gA_ = reinterpret_cast<const char*>(g.A); const char* gB_ = reinterpret_cast<const char*>(g.Bt); asm volatile("" : "+s"(gA_), "+s"(gB_));
    unsigned voffA[2], voffB[2];
#pragma unroll
    for (int i = 0; i < 2; ++i) { int R, C; stage_rc(tid * 16 + i * 8192, R, C); const int Rb = Epi::PERM ? ((R & ~31) + perm32(R & 31)) : R;
        voffA[i] = (unsigned)(R * g.lda + C) * 2u; voffB[i] = (unsigned)(Rb * g.ldb + C) * 2u; }
    const size_t kstep = (size_t)(BK * 2);
    const size_t hstepA = (size_t)HALF * g.lda * 2, hstepB = (size_t)HALF * g.ldb * 2;

    const unsigned ldsw = (unsigned)wid * 1024u;
    const int aoff = lds_byte(wr * 64 + fr, fq * 8), boff = lds_byte(wc * 32 + fr, fq * 8);
#define PG8_SA(b, h) (((b) * 2 + (h)) * HTB)
#define PG8_SB(b, h) ((4 + (b) * 2 + (h)) * HTB)
#define PG8_STAGE(bufoff, gbase, voff) do { _Pragma("unroll") for (int _i = 0; _i < 2; ++_i) \
        __builtin_amdgcn_global_load_lds((const unsigned*)((const char*)(gbase) + (voff)[_i]), (PG8_LAS unsigned*)(lds + (bufoff) + ldsw + _i * 8192), 16, 0, 0); } while (0)
#define PG8_LDA(dst, b, h) do { _Pragma("unroll") for (int m = 0; m < 4; ++m) _Pragma("unroll") for (int k = 0; k < 2; ++k) dst[m][k] = *(const PG8_LAS bf16x8*)(lds + PG8_SA(b, h) + aoff + m * 2048 + k * 1024); } while (0)
#define PG8_LDB(dst, b, h) do { _Pragma("unroll") for (int n = 0; n < 2; ++n) _Pragma("unroll") for (int k = 0; k < 2; ++k) dst[n][k] = *(const PG8_LAS bf16x8*)(lds + PG8_SB(b, h) + boff + n * 2048 + k * 1024); } while (0)
#define PG8_MMA(ai, bj, At, Bt) do { __builtin_amdgcn_s_setprio(1); _Pragma("unroll") for (int m = 0; m < 4; ++m) _Pragma("unroll") for (int n = 0; n < 2; ++n) _Pragma("unroll") for (int k = 0; k < 2; ++k) \
        acc[ai][bj][m][n] = __builtin_amdgcn_mfma_f32_16x16x32_bf16(Bt[n][k], At[m][k], acc[ai][bj][m][n], 0, 0, 0); __builtin_amdgcn_s_setprio(0); } while (0)
#define PG8_WAIT_V(n) asm volatile("s_waitcnt vmcnt(" #n ")" ::: "memory")
#define PG8_WAIT_L(n) asm volatile("s_waitcnt lgkmcnt(" #n ")" ::: "memory")
#define PG8_BAR __builtin_amdgcn_s_barrier()
#define PG8_SCHED __builtin_amdgcn_sched_barrier(0)
    Unit cur, nxt; int ui = 0;
    if (!S.next(0, cur)) return;
    f32x4 acc[2][2][4][2];
#pragma unroll
    for (int a = 0; a < 2; ++a)
#pragma unroll
        for (int b = 0; b < 2; ++b)
#pragma unroll
            for (int m = 0; m < 4; ++m)
#pragma unroll
                for (int n = 0; n < 2; ++n) acc[a][b][m][n] = (f32x4){0.f, 0.f, 0.f, 0.f};
    bf16x8 At[4][2], B0[2][2], B1[2][2];
    const char* cA = gA_ + (size_t)cur.pm * 2 * hstepA + (size_t)cur.z * g.zA; const char* cB = gB_ + (size_t)cur.pn * 2 * hstepB + (size_t)cur.z * g.zB;
    S.a_ready(cur);
    if constexpr (SP2) {
        PG8_STAGE(PG8_SB(0, 0), cB, voffB); PG8_STAGE(PG8_SB(0, 1), cB + hstepB, voffB); PG8_STAGE(PG8_SA(0, 0), cA, voffA); PG8_STAGE(PG8_SA(0, 1), cA + hstepA, voffA);
        if (wr == 1) PG8_BAR;
        PG8_WAIT_V(2); PG8_BAR;
        PG8_STAGE(PG8_SB(1, 0), cB + kstep, voffB); PG8_STAGE(PG8_SA(1, 0), cA + kstep, voffA); PG8_STAGE(PG8_SB(1, 1), cB + hstepB + kstep, voffB);
        PG8_WAIT_V(6); PG8_BAR;
    } else {
        PG8_STAGE(PG8_SB(0, 0), cB, voffB); PG8_STAGE(PG8_SA(0, 0), cA, voffA); PG8_STAGE(PG8_SB(0, 1), cB + hstepB, voffB); PG8_STAGE(PG8_SA(0, 1), cA + hstepA, voffA);
        if (wr == 1) PG8_BAR;
        PG8_WAIT_V(4); PG8_BAR;
        PG8_STAGE(PG8_SB(1, 0), cB + kstep, voffB); PG8_STAGE(PG8_SA(1, 0), cA + kstep, voffA); PG8_STAGE(PG8_SB(1, 1), cB + hstepB + kstep, voffB);
        PG8_WAIT_V(6); PG8_BAR;
    }
    for (;;) {
        const bool has_next = S.next(ui + 1, nxt);
        const char* nA = has_next ? gA_ + (size_t)nxt.pm * 2 * hstepA + (size_t)nxt.z * g.zA : cA; const char* nB = has_next ? gB_ + (size_t)nxt.pn * 2 * hstepB + (size_t)nxt.z * g.zB : cB;
_Pragma("nounroll")
        for (int t = 0; t < nt; t += 2) {
            const bool last = (t == nt - 2);
            const char* a1 = cA + (size_t)(t + 1) * kstep;
            const char* a2 = last ? nA : cA + (size_t)(t + 2) * kstep; const char* b2 = last ? nB : cB + (size_t)(t + 2) * kstep;
            const char* a3 = a2 + kstep; const char* b3 = b2 + kstep;
            if (last && has_next) S.a_ready(nxt);
            if constexpr (SP2) {
            PG8_LDB(B0, 0, 0); PG8_LDB(B1, 0, 1); PG8_SCHED; PG8_LDA(At, 0, 0); PG8_STAGE(PG8_SA(1, 1), a1 + hstepA, voffA);
            PG8_WAIT_V(8); PG8_WAIT_L(0); PG8_BAR; PG8_MMA(0, 0, At, B0); PG8_MMA(0, 1, At, B1); PG8_BAR; PG8_SCHED;
            PG8_LDA(At, 0, 1); PG8_STAGE(PG8_SB(0, 0), b2, voffB); PG8_STAGE(PG8_SB(0, 1), b2 + hstepB, voffB); PG8_STAGE(PG8_SA(0, 0), a2, voffA);
            PG8_WAIT_V(8); PG8_WAIT_L(0); PG8_BAR; PG8_MMA(1, 0, At, B0); PG8_MMA(1, 1, At, B1); PG8_BAR; PG8_SCHED;
            PG8_LDB(B0, 1, 0); PG8_LDB(B1, 1, 1); PG8_SCHED; PG8_LDA(At, 1, 0); PG8_STAGE(PG8_SA(0, 1), a2 + hstepA, voffA);
            PG8_WAIT_V(8); PG8_WAIT_L(0); PG8_BAR; PG8_MMA(0, 0, At, B0); PG8_MMA(0, 1, At, B1); PG8_BAR; PG8_SCHED;
            PG8_LDA(At, 1, 1); PG8_STAGE(PG8_SB(1, 0), b3, voffB); PG8_STAGE(PG8_SB(1, 1), b3 + hstepB, voffB); PG8_STAGE(PG8_SA(1, 0), a3, voffA);
            PG8_WAIT_V(8); PG8_WAIT_L(0); PG8_BAR; PG8_MMA(1, 0, At, B0); PG8_MMA(1, 1, At, B1); PG8_BAR; PG8_SCHED;
            } else {
            PG8_LDB(B0, 0, 0); PG8_SCHED; PG8_LDA(At, 0, 0); PG8_STAGE(PG8_SA(1, 1), a1 + hstepA, voffA);
            PG8_WAIT_L(8); PG8_BAR; PG8_WAIT_L(0); PG8_MMA(0, 0, At, B0); PG8_BAR; PG8_SCHED;
            PG8_LDB(B1, 0, 1); PG8_STAGE(PG8_SB(0, 0), b2, voffB);
            PG8_BAR; PG8_WAIT_L(0); PG8_MMA(0, 1, At, B1); PG8_BAR;
            PG8_LDA(At, 0, 1); PG8_STAGE(PG8_SA(0, 0), a2, voffA);
            PG8_BAR; PG8_WAIT_L(0); PG8_MMA(1, 0, At, B0); PG8_BAR; PG8_SCHED;
            PG8_STAGE(PG8_SB(0, 1), b2 + hstepB, voffB);
            PG8_WAIT_V(6); PG8_BAR; PG8_MMA(1, 1, At, B1); PG8_BAR;
            PG8_LDB(B0, 1, 0); PG8_SCHED; PG8_LDA(At, 1, 0); PG8_STAGE(PG8_SA(0, 1), a2 + hstepA, voffA);
            PG8_WAIT_L(8); PG8_BAR; PG8_WAIT_L(0); PG8_MMA(0, 0, At, B0); PG8_BAR; PG8_SCHED;
            PG8_LDB(B1, 1, 1); PG8_STAGE(PG8_SB(1, 0), b3, voffB);
            PG8_BAR; PG8_WAIT_L(0); PG8_MMA(0, 1, At, B1); PG8_BAR;
            PG8_LDA(At, 1, 1); PG8_STAGE(PG8_SA(1, 0), a3, voffA);
            PG8_BAR; PG8_WAIT_L(0); PG8_MMA(1, 0, At, B0); PG8_BAR; PG8_SCHED;
            PG8_STAGE(PG8_SB(1, 1), b3 + hstepB, voffB);
            PG8_WAIT_V(6); PG8_BAR; PG8_MMA(1, 1, At, B1); PG8_BAR;
            }
        }
        if constexpr (ALIGN_EPI) { if (wr == 0) PG8_BAR; }
        if constexpr (!Epi::AFTER_DRAIN) { E(acc, cur, wr, wc, fr, fq); S.done(cur); }
        if (!has_next) break;
#pragma unroll
        for (int a = 0; a < 2; ++a)
#pragma unroll
            for (int b = 0; b < 2; ++b)
#pragma unroll
                for (int m = 0; m < 4; ++m)
#pragma unroll
                    for (int n = 0; n < 2; ++n) acc[a][b][m][n] = (f32x4){0.f, 0.f, 0.f, 0.f};
        cur = nxt; cA = nA; cB = nB; ++ui;
        if constexpr (ALIGN_EPI) { if (wr == 1) PG8_BAR; }
    }
    PG8_WAIT_V(0);
    if constexpr (!ALIGN_EPI) { if (wr == 0) PG8_BAR; }
    PG8_BAR;
    if constexpr (Epi::AFTER_DRAIN) { E.fused(acc, cur, wr, wc, fr, fq, lds, wid, lane); S.done(cur); }
#undef PG8_SA
#undef PG8_SB
#undef PG8_STAGE
#undef PG8_LDA
#undef PG8_LDB
#undef PG8_MMA
#undef PG8_WAIT_V
#undef PG8_WAIT_L
#undef PG8_BAR
#undef PG8_SCHED
}
}
#include <hip/hip_bf16.h>
#include <cmath>
namespace attn_body {
using bf16=__hip_bfloat16;
using bf16x8=__attribute__((ext_vector_type(8)))short;
using s16x4=__attribute__((ext_vector_type(4)))short;
using f32x16=__attribute__((ext_vector_type(16)))float;
using u32x4=__attribute__((ext_vector_type(4)))unsigned;
using f32x4_t=__attribute__((ext_vector_type(4)))float;
constexpr int BATCH=1,NHEAD=8,SEQ=16384,D=64,DM=NHEAD*D;
constexpr int NW=8,QBLK=32,QB=QBLK*NW,KVBLK=64,NQB=SEQ/QB;
constexpr int ATTN_PITCH=DM, ATTN_UNIT_ROWS=QB;
__device__ __forceinline__ int crow(int r,int hi){return (r&3)+8*(r>>2)+4*hi;}
#define SBAR() __builtin_amdgcn_sched_barrier(0)
__device__ __forceinline__ void cmask(f32x16&p0,f32x16&p1,int jb,int qrel,int hi){
  const float NEG=-INFINITY; int kb=64*jb+4*hi;
  #pragma unroll
  for(int r=0;r<16;++r){int kv=kb+(r&3)+8*(r>>2); if(kv>qrel)p0[r]=NEG; if(kv+32>qrel)p1[r]=NEG;}
}

constexpr int NSLOT=3, SLOTB=8192;
constexpr int LDS_K=0, LDS_V=NSLOT*SLOTB, LDS_WS=2*NSLOT*SLOTB, LDS_OST=LDS_WS+NW*64*4, LDS_CK=LDS_OST+NW*4096, LDS_BYTES=LDS_CK+SEQ*4;
constexpr float C2=0.125f*1.4426950408889634f;
__device__ __forceinline__ void glds16(const void*gsrc,unsigned lds_dst){unsigned keep;
  asm volatile("s_mov_b32 %0, m0\n\ts_mov_b32 m0, %2\n\ts_nop 0\n\tglobal_load_lds_dwordx4 %1, off\n\ts_mov_b32 m0, %0":"=&s"(keep):"v"(gsrc),"s"(lds_dst):"memory");}
__device__ __forceinline__ float max3f(float a,float b,float c){float r;asm("v_max3_f32 %0, %1, %2, %3":"=v"(r):"v"(a),"v"(b),"v"(c));return r;}
__device__ __forceinline__ float max2f(float a,float b){float r;asm("v_max_f32_e32 %0, %1, %2":"=v"(r):"v"(a),"v"(b));return r;}
__device__ __forceinline__ float fadd_s(float a,float b){float r;asm("v_add_f32_e32 %0, %1, %2":"=v"(r):"v"(a),"v"(b));return r;}
__device__ __forceinline__ float fsub_s(float a,float b){float r;asm("v_sub_f32_e32 %0, %1, %2":"=v"(r):"v"(a),"v"(b));return r;}
typedef float f32x2_t __attribute__((ext_vector_type(2))); typedef __bf16 bf16x2_t __attribute__((ext_vector_type(2)));
__device__ __forceinline__ unsigned cvtpk_s(float lo,float hi){f32x2_t v={lo,hi};bf16x2_t b=__builtin_convertvector(v,bf16x2_t);return __builtin_bit_cast(unsigned,b);}
#define WAIT_BAR(N) asm volatile("s_waitcnt vmcnt(" #N ") lgkmcnt(0)\n\ts_barrier":::"memory")

__device__ __forceinline__ void qkt(f32x16&p0,f32x16&p1,const char*Kslot,const bf16x8*qr,const f32x16&negm,int r32,int hi){
  const char*kb=Kslot+hi*1024+r32*16;
  #pragma unroll
  for(int d0=0;d0<4;++d0){
    const bf16x8 b0=*reinterpret_cast<const bf16x8*>(kb+d0*2048);
    const bf16x8 b1=*reinterpret_cast<const bf16x8*>(kb+d0*2048+512);
    if(d0==0){p0=__builtin_amdgcn_mfma_f32_32x32x16_bf16(b0,qr[0],negm,0,0,0);p1=__builtin_amdgcn_mfma_f32_32x32x16_bf16(b1,qr[0],negm,0,0,0);}
    else{p0=__builtin_amdgcn_mfma_f32_32x32x16_bf16(b0,qr[d0],p0,0,0,0);p1=__builtin_amdgcn_mfma_f32_32x32x16_bf16(b1,qr[d0],p1,0,0,0);}}
}
typedef __attribute__((address_space(3))) const char* lds_cptr;
typedef short v4i16_t __attribute__((ext_vector_type(4)));
__device__ __forceinline__ void kload8(bf16x8*kf,lds_cptr kp){
  kf[0]=*(const __attribute__((address_space(3))) bf16x8*)(kp);      kf[1]=*(const __attribute__((address_space(3))) bf16x8*)(kp+512);
  kf[2]=*(const __attribute__((address_space(3))) bf16x8*)(kp+2048); kf[3]=*(const __attribute__((address_space(3))) bf16x8*)(kp+2560);
  kf[4]=*(const __attribute__((address_space(3))) bf16x8*)(kp+4096); kf[5]=*(const __attribute__((address_space(3))) bf16x8*)(kp+4608);
  kf[6]=*(const __attribute__((address_space(3))) bf16x8*)(kp+6144); kf[7]=*(const __attribute__((address_space(3))) bf16x8*)(kp+6656);
}
__device__ __forceinline__ void kload2(bf16x8*kf,lds_cptr kp,int j){ kf[2*j]=*(const __attribute__((address_space(3))) bf16x8*)(kp+j*2048); kf[2*j+1]=*(const __attribute__((address_space(3))) bf16x8*)(kp+j*2048+512); }
__device__ __forceinline__ s16x4 vtr(lds_cptr p){ return __builtin_bit_cast(s16x4,__builtin_amdgcn_ds_read_tr16_b64_v4i16((__attribute__((address_space(3))) v4i16_t*)p)); }
__device__ __forceinline__ float rowmax(const f32x16&p0,const f32x16&p1){
  float a=max3f(p0[0],p0[1],p1[0]),b=max3f(p0[2],p0[3],p1[1]);a=max3f(a,p1[2],p1[3]);
  #pragma unroll
  for(int r=4;r<16;r+=4){a=max3f(a,p0[r],p0[r+1]);b=max3f(b,p0[r+2],p0[r+3]);a=max3f(a,p1[r],p1[r+1]);b=max3f(b,p1[r+2],p1[r+3]);}
  const float m=max2f(a,b);
  auto rr=__builtin_amdgcn_permlane32_swap(__float_as_uint(m),__float_as_uint(m),false,false);
  return max2f(__uint_as_float(rr[0]),__uint_as_float(rr[1]));
}
__device__ __forceinline__ void pv(f32x16*o,int vb,bf16x8 pa0,bf16x8 pa1,bf16x8 pa2,bf16x8 pa3){
  #pragma unroll
  for(int d0=0;d0<2;++d0){s16x4 lo[4],hi[4];
    #pragma unroll
    for(int ks=0;ks<4;++ks){
      asm volatile("ds_read_b64_tr_b16 %0,%1 offset:%c2":"=&v"(lo[ks]):"v"(vb),"i"(d0*4096+ks*1024):"memory");
      asm volatile("ds_read_b64_tr_b16 %0,%1 offset:%c2":"=&v"(hi[ks]):"v"(vb),"i"(d0*4096+ks*1024+512):"memory");}
    asm volatile("s_waitcnt lgkmcnt(0)":::"memory");SBAR();
    #define PK(k) (bf16x8){lo[k][0],lo[k][1],lo[k][2],lo[k][3],hi[k][0],hi[k][1],hi[k][2],hi[k][3]}
    o[d0]=__builtin_amdgcn_mfma_f32_32x32x16_bf16(pa0,PK(0),o[d0],0,0,0);
    o[d0]=__builtin_amdgcn_mfma_f32_32x32x16_bf16(pa1,PK(1),o[d0],0,0,0);
    o[d0]=__builtin_amdgcn_mfma_f32_32x32x16_bf16(pa2,PK(2),o[d0],0,0,0);
    o[d0]=__builtin_amdgcn_mfma_f32_32x32x16_bf16(pa3,PK(3),o[d0],0,0,0);
    #undef PK
  }
}

#ifndef ATTN_STORE16
#define ATTN_STORE16(p,v) (*(u32x4*)(p)=(v))
#endif
template<int THRL> __device__ __forceinline__ void attn_unit(int b,int h,int qb,const bf16*Q,const bf16*__restrict__ K,const bf16*__restrict__ V,bf16*O,const float*__restrict__ CSg,const unsigned*KMg,char*shm,const int t0){
  int tid_o=threadIdx.x; asm volatile("":"+v"(tid_o)); const int tid=tid_o,lane=tid&63,r32=lane&31,hi=lane>>5; const int wid=__builtin_amdgcn_readfirstlane(tid>>6);
  const long rowbase=(long)b*SEQ; const int q0=qb*QB;
  const bf16*Qw=Q+(rowbase+q0+wid*QBLK)*DM+h*D;
  const bf16*Kh=K+(rowbase+(long)t0*KVBLK)*DM+h*D,*Vh=V+(rowbase+(long)t0*KVBLK)*DM+h*D;
  const unsigned lds0=(unsigned)(uintptr_t)shm;
  float*wsf=(float*)(shm+LDS_WS)+wid*64;
  const lds_cptr shm3=(lds_cptr)shm;
  const bf16*ksrc=Kh+(long)lane*DM+wid*8;
  const bf16*vsrc=Vh+(long)(16*(wid&3)+(lane>>2))*DM+(wid>>2)*32+(lane&3)*8;
  const unsigned kdst=lds0+LDS_K+wid*1024, vdst=lds0+LDS_V+wid*1024;
  #define DMA_K(t,slot) glds16(ksrc+(long)(t)*KVBLK*DM,(unsigned)__builtin_amdgcn_readfirstlane(kdst+(slot)))
  #define DMA_V(t,slot) glds16(vsrc+(long)(t)*KVBLK*DM,(unsigned)__builtin_amdgcn_readfirstlane(vdst+(slot)))
  const int vb0=(int)(lds0+LDS_V)+((lane>>4)&1)*32+(lane&3)*8+(4*hi+((lane&15)>>2))*64;
  const char*Kbase=shm+LDS_K; bf16x8 kf[8];
  const lds_cptr kp0=shm3+LDS_K+hi*1024+r32*16; const lds_cptr vp0=shm3+LDS_V+((lane>>4)&1)*32+(lane&3)*8+(4*hi+((lane&15)>>2))*64;
  const int NT=(q0+QB)/KVBLK-t0;
  typedef __attribute__((address_space(3))) float* lds_fptr; typedef __attribute__((address_space(3))) f32x4_t* lds_f4ptr;
  const float*csh=CSg+(long)h*SEQ;
  { const lds_fptr ckw=(lds_fptr)(shm3+LDS_CK);
    for(int i=tid*4;i<q0+QB-t0*KVBLK;i+=NW*64*4){ const f32x4_t v=*(const f32x4_t*)(csh+t0*KVBLK+i); *(lds_f4ptr)(ckw+i)=v; }
  }
  const float cq=csh[q0+wid*QBLK+r32];
  asm volatile("s_waitcnt vmcnt(0) lgkmcnt(0)\n\ts_barrier":::"memory");
  const lds_fptr ckt=(lds_fptr)(shm3+LDS_CK)+4*hi;
  #define CKSUB(P0,P1,t) do{ const lds_fptr ckp_=ckt+64*(t); _Pragma("unroll") for(int j_=0;j_<4;++j_){ const f32x4_t a_=*(const lds_f4ptr)(ckp_+8*j_); const f32x4_t b_=*(const lds_f4ptr)(ckp_+32+8*j_); \
      P0[4*j_]-=a_[0];P0[4*j_+1]-=a_[1];P0[4*j_+2]-=a_[2];P0[4*j_+3]-=a_[3]; P1[4*j_]-=b_[0];P1[4*j_+1]-=b_[1];P1[4*j_+2]-=b_[2];P1[4*j_+3]-=b_[3]; SBAR(); } }while(0)
  DMA_K(0,0);DMA_V(0,0);DMA_K(1,SLOTB);
  bf16x8 qr[4];
  #pragma unroll
  for(int d0=0;d0<4;++d0)qr[d0]=*reinterpret_cast<const bf16x8*>(&Qw[(long)r32*DM+d0*16+hi*8]);
  float l_reg=0.f;f32x16 o[2];o[0]=f32x16{};o[1]=f32x16{};f32x16 negm;
  {
    float q2=0.f;
    _Pragma("unroll") for(int d0=0;d0<4;++d0) _Pragma("unroll") for(int e=0;e<8;++e){ const float v=__uint_as_float(((unsigned)(unsigned short)qr[d0][e])<<16); q2+=v*v; }
    { auto rr=__builtin_amdgcn_permlane32_swap(__float_as_uint(q2),__float_as_uint(q2),false,false); q2=__uint_as_float(rr[0])+__uint_as_float(rr[1]); }
    const float km2=__uint_as_float(__hip_atomic_load(KMg+h,__ATOMIC_RELAXED,__HIP_MEMORY_SCOPE_AGENT));
    const float Rq=sqrtf(q2*km2)*1.001f+0.01f;
    _Pragma("unroll") for(int r=0;r<16;++r)negm[r]=cq-Rq; asm volatile("":"+v"(negm)); }
  const int qrel=wid*QBLK+r32;
  #define CMASK(P0,P1,t) do{int jb_=(t)-(NT-4); if(jb_>=0)cmask(P0,P1,jb_,qrel,hi);}while(0)
  #define START(P0,P1) do{ const float rm=rowmax(P0,P1); resc=false; \
    { const float dl=rm; mhat=fadd_s(mhat,dl); \
      _Pragma("unroll") for(int r=0;r<16;++r){P0[r]=fsub_s(P0[r],dl);P1[r]=fsub_s(P1[r],dl);} \
      _Pragma("unroll") for(int r=0;r<16;++r)negm[r]=-mhat; asm volatile("":"+v"(negm)); } \
    _Pragma("unroll") for(int r=0;r<16;++r)P0[r]=__builtin_amdgcn_exp2f(P0[r]); }while(0)
  #define RESC() do{ if(resc){ asm volatile("s_waitcnt lgkmcnt(0)":::"memory"); \
      _Pragma("unroll") for(int d_=0;d_<2;++d_) _Pragma("unroll") for(int r=0;r<16;++r)o[d_][r]*=wsf[crow(r,hi)]; } }while(0)
  f32x16 pA0,pA1,pB0,pB1;
  int sl_prev=0,sl_cur=0,sl_next=SLOTB;
  #define ROT() do{sl_prev=sl_cur;sl_cur=sl_next;sl_next=(sl_next==(NSLOT-1)*SLOTB)?0:sl_next+SLOTB;}while(0)
  DMA_K(2,2*SLOTB);
  WAIT_BAR(3);
  qkt(pA0,pA1,Kbase,qr,negm,r32,hi);asm volatile("s_nop 15\n\ts_nop 7":"+v"(pA0),"+v"(pA1));CKSUB(pA0,pA1,0);CMASK(pA0,pA1,0);
  _Pragma("unroll") for(int r=0;r<16;++r)pA0[r]=__builtin_amdgcn_exp2f(pA0[r]);
  _Pragma("unroll") for(int r=0;r<16;++r)pA1[r]=__builtin_amdgcn_exp2f(pA1[r]);
  WAIT_BAR(0);
  DMA_K(3,0);DMA_V(1,SLOTB);
  ROT();
  kload8(kf,kp0+sl_cur);
  WAIT_BAR(2);
  s16x4 vlo[8],vhi[8]; u32x4 pw0,pw1,pw2,pw3;
  #define PKW(P,B) cvtpk_s(P[B],P[B+1])
  #define PAF(k) __builtin_bit_cast(bf16x8,pw##k)
  #define VFR(i) (bf16x8){vlo[i][0],vlo[i][1],vlo[i][2],vlo[i][3],vhi[i][0],vhi[i][1],vhi[i][2],vhi[i][3]}
  #define PIN(x) asm volatile("":"+v"(x))
  #define MX3(a,b,c) __builtin_fmaxf(__builtin_fmaxf((a),(b)),(c))
  #define GAPA(MF,A0,A1,A2,A3,W0,W1,PW) do{ MF; sacc+=A0; sacc+=A1; sacc+=A2; sacc+=A3; PIN(sacc); W0; W1; PIN(PW); SBAR(); }while(0)
  #define EX(v) __builtin_amdgcn_exp2f(v)
  #define GAPB(MF,X,B,CUR,NXT,NOFF) do{ MF; if((NOFF)>=0){ NXT=*(const lds_f4ptr)(ckp_+((NOFF)>=0?(NOFF):0)); } X[B]=EX(X[B]-CUR[0]); X[B+1]=EX(X[B+1]-CUR[1]); X[B+2]=EX(X[B+2]-CUR[2]); X[B+3]=EX(X[B+3]-CUR[3]); PIN(X); SBAR(); }while(0)
  #define VRD(i) do{ vlo[i]=vtr(vp_+(((i)>>2)*4096+((i)&3)*1024)); vhi[i]=vtr(vp_+(((i)>>2)*4096+((i)&3)*1024+512)); }while(0)
  #define KRD(G,j) do{ if(G){ kload2(kf,kp0+sl_next,j); SBAR(); } }while(0)
  #define STEP(C0,C1,P0,P1,t,GK,GV,GL) do{ SBAR(); \
    const lds_cptr vp_=vp0+sl_prev; \
    VRD(0); SBAR(); float sacc=(P0[0]+P0[1]); \
    GAPA(C0=__builtin_amdgcn_mfma_f32_32x32x16_bf16(kf[0],qr[0],negm,0,0,0), P0[2],P0[3],P0[4],P0[5],     pw0[0]=PKW(P0,0), pw0[1]=PKW(P0,2), pw0); \
    VRD(4); SBAR(); GAPA(C1=__builtin_amdgcn_mfma_f32_32x32x16_bf16(kf[1],qr[0],negm,0,0,0), P0[6],P0[7],P0[8],P0[9],     pw0[2]=PKW(P0,4), pw0[3]=PKW(P0,6), pw0); \
    VRD(1); SBAR(); GAPA(C0=__builtin_amdgcn_mfma_f32_32x32x16_bf16(kf[2],qr[1],C0,0,0,0),   P0[10],P0[11],P0[12],P0[13], pw1[0]=PKW(P0,8), pw1[1]=PKW(P0,10), pw1); \
    VRD(5); SBAR(); GAPA(C1=__builtin_amdgcn_mfma_f32_32x32x16_bf16(kf[3],qr[1],C1,0,0,0),   P0[14],P0[15],P1[0],P1[1],   pw1[2]=PKW(P0,12),pw1[3]=PKW(P0,14), pw1); \
    VRD(2); SBAR(); GAPA(C0=__builtin_amdgcn_mfma_f32_32x32x16_bf16(kf[4],qr[2],C0,0,0,0),   P1[2],P1[3],P1[4],P1[5],     pw2[0]=PKW(P1,0), pw2[1]=PKW(P1,2), pw2); \
    VRD(6); SBAR(); GAPA(C1=__builtin_amdgcn_mfma_f32_32x32x16_bf16(kf[5],qr[2],C1,0,0,0),   P1[6],P1[7],P1[8],P1[9],     pw2[2]=PKW(P1,4), pw2[3]=PKW(P1,6), pw2); \
    VRD(3); SBAR(); GAPA(C0=__builtin_amdgcn_mfma_f32_32x32x16_bf16(kf[6],qr[3],C0,0,0,0),   P1[10],P1[11],P1[12],P1[13], pw3[0]=PKW(P1,8), pw3[1]=PKW(P1,10), pw3); \
    VRD(7); SBAR(); GAPA(C1=__builtin_amdgcn_mfma_f32_32x32x16_bf16(kf[7],qr[3],C1,0,0,0),   P1[14],P1[15],0.f,0.f,       pw3[2]=PKW(P1,12),pw3[3]=PKW(P1,14), pw3); \
    l_reg+=sacc; \
    if(GK){DMA_K((t)+3,sl_cur);} if(GV){DMA_V((t)+1,sl_next);} \
    CMASK(C0,C1,t); \
    const lds_fptr ckp_=ckt+64*(t); f32x4_t ckA_=*(const lds_f4ptr)(ckp_), ckB_; \
    SBAR(); \
    GAPB(o[0]=__builtin_amdgcn_mfma_f32_32x32x16_bf16(PAF(0),VFR(0),o[0],0,0,0), C0,0,ckA_,ckB_,8); \
    GAPB(o[1]=__builtin_amdgcn_mfma_f32_32x32x16_bf16(PAF(0),VFR(4),o[1],0,0,0), C0,4,ckB_,ckA_,16); \
    KRD(GL,0); GAPB(o[0]=__builtin_amdgcn_mfma_f32_32x32x16_bf16(PAF(1),VFR(1),o[0],0,0,0), C0,8,ckA_,ckB_,24); \
    KRD(GL,1); GAPB(o[1]=__builtin_amdgcn_mfma_f32_32x32x16_bf16(PAF(1),VFR(5),o[1],0,0,0), C0,12,ckB_,ckA_,32); \
    KRD(GL,2); GAPB(o[0]=__builtin_amdgcn_mfma_f32_32x32x16_bf16(PAF(2),VFR(2),o[0],0,0,0), C1,0,ckA_,ckB_,40); \
    KRD(GL,3); GAPB(o[1]=__builtin_amdgcn_mfma_f32_32x32x16_bf16(PAF(2),VFR(6),o[1],0,0,0), C1,4,ckB_,ckA_,48); \
    GAPB(o[0]=__builtin_amdgcn_mfma_f32_32x32x16_bf16(PAF(3),VFR(3),o[0],0,0,0), C1,8,ckA_,ckB_,56); \
    GAPB(o[1]=__builtin_amdgcn_mfma_f32_32x32x16_bf16(PAF(3),VFR(7),o[1],0,0,0), C1,12,ckB_,ckA_,-1); \
    }while(0)
  int t=1;
  #undef CMASK
  #define CMASK(P0,P1,t) do{}while(0)
  for(;t+5<NT;t+=2){
    STEP(pB0,pB1,pA0,pA1,t,true,true,true);     WAIT_BAR(2); ROT();
    STEP(pA0,pA1,pB0,pB1,t+1,true,true,true);   WAIT_BAR(2); ROT();
  }
  #undef CMASK
  #define CMASK(P0,P1,t) do{int jb_=(t)-(NT-4); if(jb_>=0)cmask(P0,P1,jb_,qrel,hi);}while(0)
  #define ENDW(tt) do{ if((tt)+3<NT){WAIT_BAR(2);} else if((tt)+2<NT){WAIT_BAR(1);} else {WAIT_BAR(0);} }while(0)
  for(;t+1<NT;t+=2){
    STEP(pB0,pB1,pA0,pA1,t,(t+3<NT),(t+1<NT),(t+1<NT));       ENDW(t); ROT();
    STEP(pA0,pA1,pB0,pB1,t+1,(t+4<NT),(t+2<NT),(t+2<NT));     ENDW(t+1); ROT();
  }
  STEP(pB0,pB1,pA0,pA1,NT-1,false,false,false);
  { float sacc=pB0[0]+pB0[1]; _Pragma("unroll") for(int r=2;r<16;++r)sacc+=pB0[r]; _Pragma("unroll") for(int r=0;r<16;++r)sacc+=pB1[r]; l_reg+=sacc;
    pw0=(u32x4){PKW(pB0,0),PKW(pB0,2),PKW(pB0,4),PKW(pB0,6)};pw1=(u32x4){PKW(pB0,8),PKW(pB0,10),PKW(pB0,12),PKW(pB0,14)};pw2=(u32x4){PKW(pB1,0),PKW(pB1,2),PKW(pB1,4),PKW(pB1,6)};pw3=(u32x4){PKW(pB1,8),PKW(pB1,10),PKW(pB1,12),PKW(pB1,14)};
    SBAR(); pv(o,vb0+sl_cur,PAF(0),PAF(1),PAF(2),PAF(3)); }
  #undef PKW
  #undef PAF
  #undef VFR
  #undef PIN
  #undef MX3
  #undef GAPA
  #undef GAPB
  #undef EX
  #undef VRD
  #undef KRD
  #undef STEP
  #undef ENDW
  {auto rr=__builtin_amdgcn_permlane32_swap(__float_as_uint(l_reg),__float_as_uint(l_reg),false,false);l_reg=__uint_as_float(rr[0])+__uint_as_float(rr[1]);}
  if(hi==0)wsf[32+r32]=l_reg;asm volatile("s_waitcnt lgkmcnt(0)":::"memory");
  float rli[16];
  #pragma unroll
  for(int r=0;r<16;++r)rli[r]=__builtin_amdgcn_rcpf(wsf[32+crow(r,hi)]);
  bf16*Ow=O+(rowbase+q0+wid*QBLK)*DM+h*D;
  { bf16*stg=(bf16*)(shm+LDS_OST)+wid*2048;
    #pragma unroll
    for(int r=0;r<16;++r){const int orow=crow(r,hi);
      #pragma unroll
      for(int d0=0;d0<2;++d0)stg[orow*64+d0*32+r32]=__float2bfloat16(o[d0][r]*rli[r]);}
    asm volatile("s_waitcnt lgkmcnt(0)":::"memory");
    #pragma unroll
    for(int i=0;i<4;++i){const int row=i*8+(lane>>3),ch=lane&7; const u32x4 v=*(const u32x4*)(stg+row*64+ch*8); ATTN_STORE16(Ow+(long)row*DM+ch*8,v);} }
  asm volatile("s_waitcnt lgkmcnt(0)\n\ts_barrier":::"memory");
  #undef CKSUB
  #undef DMA_K
  #undef DMA_V
  #undef CMASK
  #undef START
  #undef RESC
  #undef ROT
}
constexpr int ATTN_LDS_BYTES=LDS_BYTES;
struct AttnTensors { const bf16* Q; const bf16* K; const bf16* V; bf16* O; const float* CS; const unsigned* KM; };
struct AttnUnit { int bh; int qb; };
struct StaticOrder {
  int vcu,G;
  __device__ __forceinline__ explicit StaticOrder(int grid,int block):vcu((grid%8==0)?(block%8)*(grid/8)+block/8:block),G(grid){}
  __device__ __forceinline__ bool next(int i,AttnUnit&u)const{
    if(G==256){ if(i>=2)return false; const int s=vcu&31; u.bh=vcu>>5; u.qb=(i==0)?s:63-s; return true; }
    const int Lx=i*G+vcu; if(Lx>=NHEAD*NQB)return false; u.bh=Lx/NQB; u.qb=NQB-1-(Lx%NQB); return true; }
  __device__ __forceinline__ void a_ready(const AttnUnit&)const{}
  __device__ __forceinline__ void done(const AttnUnit&)const{}
};
template<class Sched,int THRL=8> __device__ __forceinline__ void attn_phase(char*lds,const AttnTensors&T,const Sched&S){
  AttnUnit u;
  for(int i=0;S.next(i,u);++i){ S.a_ready(u); attn_unit<THRL>(0,u.bh,u.qb,T.Q,T.K,T.V,T.O,T.CS,T.KM,lds,0); S.done(u); }
}
#undef SBAR
#undef WAIT_BAR
}
#define LAS __attribute__((address_space(3)))
typedef unsigned short bf16;
typedef unsigned v4u __attribute__((ext_vector_type(4)));
typedef unsigned v2u __attribute__((ext_vector_type(2)));
typedef float f32x4 __attribute__((ext_vector_type(4)));
typedef short bf16x8 __attribute__((ext_vector_type(8)));
constexpr int NWAVES = 8, NTHREADS = 512;
constexpr int M = 16384, D = 1024, FF = 2816, MEML = 256, DIN = 7176, NLAYER = 2;
constexpr float EPS = 1e-6f, LOG2E = 1.4426950408889634f;
constexpr int LDS_BYTES = 155648, XB_LDS_OFF = LDS_BYTES - 256;
static_assert(attn_body::ATTN_LDS_BYTES <= LDS_BYTES, "lds");
constexpr size_t MiB = 1u << 20;
constexpr size_t WS_SS = 1 * MiB, WS_SSV = 2 * MiB, WS_LF = 2 * MiB + 512 * 1024, WS_CS = 3 * MiB, WS_RSM = 3 * MiB + 512 * 1024, WS_MEMB = 4 * MiB, WS_KC = 4 * MiB + 512 * 1024, WS_VCT = 5 * MiB;
constexpr size_t WS_W = 6 * MiB, WS_XB = 68 * MiB, WS_SCR = 100 * MiB, WS_END = 244 * MiB;
constexpr size_t WO_GU1 = 0, WO_D1 = WO_GU1 + (size_t)5632 * 1024, WO_IN = WO_D1 + (size_t)1024 * 2816, WO_G = WO_IN + (size_t)4096 * 1024, WO_B = WO_G + (size_t)3072 * 1024,
                 WO_O = WO_B + (size_t)3 * 1024 * 512, WO_Q = WO_O + (size_t)1024 * 1024, WO_K = WO_Q + (size_t)1024 * 1024, WO_V = WO_K + (size_t)1024 * 1024, WO_XO = WO_V + (size_t)1024 * 1024,
                 WO_GU2 = WO_XO + (size_t)1024 * 1024, WO_D2 = WO_GU2 + (size_t)5632 * 1024, WO_END = WO_D2 + (size_t)1024 * 2816;
static_assert((WO_END + 16 * 1024) * 2 <= WS_XB - WS_W, "weights fit");
constexpr size_t PIECE = (size_t)M * 512;

typedef __attribute__((address_space(1))) unsigned gu32;
#define RLX_AGENT __ATOMIC_RELAXED, __HIP_MEMORY_SCOPE_AGENT
#define XB_TMO      128
#define XB_XCNT(j)  (256  + 64 * (j))
#define XB_XSUB(j)  (1280 + 64 * (j))
#define XB_XGEN(j)  (2304 + 64 * (j))
#define XB_TOP      3328
#define XB_TOPGEN   3392
#define XCD_BAR_WORDS 3456
#define XB_SPIN_CAP (1u << 18)

__device__ __forceinline__ unsigned xb_ld(unsigned* p)              { return __hip_atomic_load(p, __ATOMIC_RELAXED, __HIP_MEMORY_SCOPE_AGENT); }
__device__ __forceinline__ unsigned xb_add(unsigned* p, unsigned v) { return __hip_atomic_fetch_add(p, v, __ATOMIC_RELAXED, __HIP_MEMORY_SCOPE_AGENT); }
__device__ __forceinline__ unsigned xb_xcc_id() { return (unsigned)__builtin_amdgcn_s_getreg((3 << 11) | 20) & 0xFu; }
#define XB_SPIN(cond, bar) do { unsigned _sp = 0; while (cond) { __builtin_amdgcn_s_sleep(1); \
    if ((++_sp & 255u) == 0u) { if (xb_ld(&(bar)[XB_TMO])) break; if (_sp > XB_SPIN_CAP) { atomicAdd(&(bar)[XB_TMO], 1u); break; } } } } while (0)

struct XcdBarrier {
    unsigned* bar; unsigned x;
    volatile LAS unsigned* st;
};

__device__ __forceinline__ XcdBarrier xcd_barrier_post(unsigned* bar, volatile LAS unsigned* st) {
    XcdBarrier b; b.bar = bar; b.x = xb_xcc_id(); b.st = st;
    if (threadIdx.x == 0) (void)xb_add(&bar[XB_XCNT(b.x)], 1u);
    return b;
}
__device__ __forceinline__ void xcd_barrier_complete(unsigned* bar, unsigned x, unsigned& nloc, unsigned& nx) {
    const unsigned G = gridDim.x * gridDim.y * gridDim.z;
    unsigned sum, cnt, mine, sp = 0u;
    for (;;) {
        sum = 0u; cnt = 0u; mine = 0u;
#pragma unroll
        for (unsigned j = 0; j < 16; ++j) { const unsigned c = xb_ld(&bar[XB_XCNT(j)]); sum += c; cnt += (c > 0u) ? 1u : 0u; mine = (j == x) ? c : mine; }
        if (sum == G) break;
        __builtin_amdgcn_s_sleep(1);
        if ((++sp & 255u) == 0u) { if (xb_ld(&bar[XB_TMO])) break; if (sp > XB_SPIN_CAP) { atomicAdd(&bar[XB_TMO], 1u); break; } }
    }
    nloc = mine > 0u ? mine : 1u; nx = cnt > 0u ? cnt : 1u;
}

__device__ __forceinline__ void xcd_barrier(const XcdBarrier& b) {
    asm volatile("s_waitcnt vmcnt(0)" ::: "memory");
    __syncthreads();
    if (threadIdx.x == 0) {
        unsigned* bar = b.bar;
        __builtin_amdgcn_s_waitcnt(0);
        unsigned nloc = b.st[0], nx = b.st[1];
        if (nloc == 0u) { xcd_barrier_complete(bar, b.x, nloc, nx); b.st[0] = nloc; b.st[1] = nx; }
        const unsigned old = xb_add(&bar[XB_XSUB(b.x)], 1u);
        const unsigned gen = old / nloc;
        if (old + 1u == (gen + 1u) * nloc) {
            __builtin_amdgcn_fence(__ATOMIC_RELEASE, "agent");
            asm volatile("s_waitcnt vmcnt(0)" ::: "memory");
            const unsigned og = xb_add(&bar[XB_TOP], 1u);
            const unsigned tg = og / nx;
            if (og + 1u == (tg + 1u) * nx) xb_add(&bar[XB_TOPGEN], 1u);
            else XB_SPIN(xb_ld(&bar[XB_TOPGEN]) == tg, bar);
            __builtin_amdgcn_fence(__ATOMIC_ACQUIRE, "agent");
            xb_add(&bar[XB_XGEN(b.x)], 1u);
            asm volatile("s_waitcnt vmcnt(0)" ::: "memory");
        } else {
            XB_SPIN(xb_ld(&bar[XB_XGEN(b.x)]) == gen, bar);
            __builtin_amdgcn_fence(__ATOMIC_ACQUIRE, "agent");
            asm volatile("s_waitcnt vmcnt(0)" ::: "memory");
        }
    }
    __syncthreads();
}
struct Args { const float* in[26]; float* out; unsigned char* ws; int ph_lo, ph_hi; };

__device__ __forceinline__ unsigned f2bf(float f) { unsigned u = __builtin_bit_cast(unsigned, f); return (u + 0x7fffu + ((u >> 16) & 1u)) >> 16; }
__device__ __forceinline__ unsigned pk2(float lo, float hi) { return f2bf(lo) | (f2bf(hi) << 16); }
__device__ __forceinline__ float b2f(unsigned short b) { return __uint_as_float((unsigned)b << 16); }
__device__ __forceinline__ float wave_sum(float v) {
#pragma unroll
    for (int o = 1; o < 64; o <<= 1) v += __shfl_xor(v, o);
    return v;
}
#define LDS_WAIT() asm volatile("s_waitcnt lgkmcnt(0)" ::: "memory")
__device__ __forceinline__ void conv_item(const float* W, int spitch, int k0, int n0, bf16* WT, int dpitch, int drow0, const float* gain, LAS float* scr, int lane) {
#pragma unroll
    for (int i = 0; i < 32; ++i) { const int kk = 2 * i + (lane >> 5); float v = W[(size_t)(k0 + kk) * spitch + n0 + (lane & 31)]; if (gain) v *= gain[k0 + kk]; scr[kk * 33 + (lane & 31)] = v; }
    LDS_WAIT(); asm volatile("" ::: "memory");
    const int c = lane & 7;
#pragma unroll
    for (int j = 0; j < 4; ++j) { const int n = (lane >> 3) + 8 * j; const LAS float* s = scr + (8 * c) * 33 + n;
        v4u o; o.x = pk2(s[0 * 33], s[1 * 33]); o.y = pk2(s[2 * 33], s[3 * 33]); o.z = pk2(s[4 * 33], s[5 * 33]); o.w = pk2(s[6 * 33], s[7 * 33]);
        *(v4u*)(WT + (size_t)(drow0 + n) * dpitch + k0 + 8 * c) = o; }
    LDS_WAIT(); asm volatile("" ::: "memory");
}
__device__ __forceinline__ void conv_job(int& it, int& base, int NGW, const float* W, int spitch, int K, int scol0, int ncols, bf16* WT, int doff, bool ilv, const float* gain, LAS float* scr, int lane) {
    const int nblk = ncols / 32, nitems = (K / 64) * nblk;
    for (; it < base + nitems; it += NGW) { const int r = it - base, kb = r / nblk, nb = r % nblk, nl = 32 * nb;
        const int drow0 = ilv ? (256 * (nl / 128) + (nl % 128) + doff) : (doff + nl);
        conv_item(W, spitch, 64 * kb, scol0 + nl, WT, K, drow0, gain, scr, lane); }
    base += nitems;
}

__global__ void __launch_bounds__(NTHREADS, 2) mk_fwd(Args args) {
    __builtin_assume(__builtin_amdgcn_workitem_id_y() == 0); __builtin_assume(__builtin_amdgcn_workitem_id_z() == 0);
    extern __shared__ __attribute__((aligned(16))) unsigned char lds[];
    cg::grid_group grid = cg::this_grid();
    LAS unsigned char* ldsp = (LAS unsigned char*)lds;
    if (threadIdx.x < 2) ((volatile LAS unsigned*)(ldsp + XB_LDS_OFF))[threadIdx.x] = 0u;
    __syncthreads();
    const XcdBarrier xbar = xcd_barrier_post((unsigned*)args.ws, (volatile LAS unsigned*)(ldsp + XB_LDS_OFF));
    const int G = gridDim.x, bx = blockIdx.x;
    const int vcu = (G % 8 == 0) ? (bx % 8) * (G / 8) + bx / 8 : bx;
    const int NGW = G * NWAVES;
#define TIDS() int tid_o = threadIdx.x; asm volatile("" : "+v"(tid_o)); const int tid = tid_o, lane = tid & 63, wave = __builtin_amdgcn_readfirstlane(tid >> 6), gw = vcu * NWAVES + wave; (void)gw; (void)lane; (void)tid
#define KARGS() const __attribute__((address_space(4))) Args* ap_ = (const __attribute__((address_space(4))) Args*)__builtin_amdgcn_kernarg_segment_ptr(); asm volatile("" : "+s"(ap_))
#define ws (ap_->ws)
#define X (ap_->out)
#define SS ((float*)(ws + WS_SS))
#define SSV ((float*)(ws + WS_SSV))
#define LF ((float*)(ws + WS_LF))
#define CS ((float*)(ws + WS_CS))
#define RSM ((float*)(ws + WS_RSM))
#define MEMB ((bf16*)(ws + WS_MEMB))
#define KC ((bf16*)(ws + WS_KC))
#define VCT ((bf16*)(ws + WS_VCT))
#define Wt ((bf16*)(ws + WS_W))
#define XB ((bf16*)(ws + WS_XB))
#define SCR ((bf16*)(ws + WS_SCR))
#define ACT SCR
#define PROJ SCR
#define GT (SCR + 3 * PIECE)
#define XQ SCR
#define PB (SCR + (size_t)M * 1024)
#define OB (SCR + (size_t)2 * M * 1024)
    const int lo = args.ph_lo, hi = args.ph_hi;
#ifndef PHMASK
#define PHMASK 0xffff
#endif
#define IN(k) (((PHMASK >> (((k) == 30) ? 15 : ((k) - pb == 13 || (k) - pb == 14) ? (k) - pb - 12 : (k) - pb)) & 1) && lo <= (k) && (k) < hi)
#define GRID_SYNC() do { asm volatile("s_waitcnt vmcnt(0) lgkmcnt(0)" ::: "memory"); grid.sync(); } while (0)
#define WG_SEAM() do { asm volatile("s_waitcnt vmcnt(0) lgkmcnt(0)" ::: "memory"); __syncthreads(); } while (0)
#define SEAM_LOCAL(k) do { if (lo <= (k) && (k) + 1 < hi) { if (G == 256) WG_SEAM(); else xcd_barrier(xbar); } } while (0)
#define SEAM(k) do { if (lo <= (k) && (k) + 1 < hi) { if ((k) == 0) GRID_SYNC(); else xcd_barrier(xbar); } } while (0)
#define in (ap_->in)
int pb = 0;
#pragma nounroll
    for (int l = 0; l < NLAYER; ++l) {
        pb = 15 * l;
        if (IN(pb + 0)) { KARGS(); TIDS();
            LAS float* scr = (LAS float*)(ldsp + wave * 16384);
            const size_t l1 = (size_t)l * 1024, lff = (size_t)l * 1024 * 2816, ldd = (size_t)l * 1024 * 1024;
            constexpr int NB_FF = FF / 32, I_UP = 16 * NB_FF, I_DN = (FF / 64) * 32, I_IN = 16 * 128, I_G = 16 * 96, I_B = 8 * 32, I_SQ = 16 * 32;
            constexpr int NIT = 4 * I_UP + 2 * I_DN + I_IN + I_G + 3 * I_B + 5 * I_SQ;
#pragma nounroll
            for (int it = gw; it < NIT; it += NGW) {
                int r = it; const float* W; const float* gain = nullptr; bf16* WT; int spitch, K, scol0 = 0, nblk, doff = 0; bool ilv = false;
                if (r < 2 * I_UP) { const int w = r / I_UP; r -= w * I_UP; W = in[3 + w] + lff; gain = in[2] + l1; WT = Wt + WO_GU1; spitch = FF; K = 1024; nblk = NB_FF; doff = 128 * w; ilv = true; }
                else if ((r -= 2 * I_UP) < I_DN) { W = in[5] + lff; WT = Wt + WO_D1; spitch = 1024; K = FF; nblk = 32; }
                else if ((r -= I_DN) < I_IN) { W = in[7] + (size_t)l * 1024 * DIN; gain = in[6] + l1; WT = Wt + WO_IN; spitch = DIN; K = 1024; nblk = 128; }
                else if ((r -= I_IN) < I_G) { W = in[7] + (size_t)l * 1024 * DIN; gain = in[6] + l1; WT = Wt + WO_G; spitch = DIN; K = 1024; nblk = 96; scol0 = 4104; }
                else if ((r -= I_G) < 3 * I_B) { const int w = r / I_B; r -= w * I_B; W = in[13] + ((size_t)l * 3 + w) * 512 * 1024; WT = Wt + WO_B + (size_t)w * 1024 * 512; spitch = 1024; K = 512; nblk = 32; }
                else if ((r -= 3 * I_B) < I_SQ) { W = in[14] + ldd; WT = Wt + WO_O; spitch = 1024; K = 1024; nblk = 32; }
                else if ((r -= I_SQ) < I_SQ) { W = in[17] + ldd; gain = in[15] + l1; WT = Wt + WO_Q; spitch = 1024; K = 1024; nblk = 32; }
                else if ((r -= I_SQ) < 2 * I_SQ) { const int w = r / I_SQ; r -= w * I_SQ; W = in[18 + w] + ldd; gain = in[16] + l1; WT = Wt + WO_K + (size_t)w * 1024 * 1024; spitch = 1024; K = 1024; nblk = 32; }
                else if ((r -= 2 * I_SQ) < I_SQ) { W = in[20] + ldd; WT = Wt + WO_XO; spitch = 1024; K = 1024; nblk = 32; }
                else if ((r -= I_SQ) < 2 * I_UP) { const int w = r / I_UP; r -= w * I_UP; W = in[22 + w] + lff; gain = in[21] + l1; WT = Wt + WO_GU2; spitch = FF; K = 1024; nblk = NB_FF; doff = 128 * w; ilv = true; }
                else { r -= 2 * I_UP; W = in[24] + lff; WT = Wt + WO_D2; spitch = 1024; K = FF; nblk = 32; }
                const int kb = r / nblk, nl = 32 * (r % nblk);
                const int drow0 = ilv ? (256 * (nl / 128) + (nl % 128) + doff) : (doff + nl);
                conv_item(W, spitch, 64 * kb, scol0 + nl, WT, K, drow0, gain, scr, lane);
            }
            {
                const float* wf = in[7] + (size_t)l * 1024 * DIN + 4096; const float* gn = in[6] + l1; bf16* WF = Wt + WO_END;
                for (int idx = vcu * NTHREADS + tid; idx < 8192; idx += G * NTHREADS) { const int k = idx >> 3, hd = idx & 7;
                    const float v = wf[(size_t)k * DIN + hd] * gn[k]; const unsigned hb = f2bf(v); const float lo = v - __uint_as_float(hb << 16);
                    WF[(size_t)hd * 1024 + k] = (bf16)hb; WF[(size_t)(8 + hd) * 1024 + k] = (bf16)f2bf(lo); }
            }
            if (l == 0) {
                for (int m = gw; m < M + MEML; m += NGW) {
                    const bool ism = m >= M; const int r = ism ? m - M : m;
                    const f32x4* xr = (const f32x4*)((ism ? in[1] : in[0]) + (size_t)r * D) + lane;
                    f32x4 v[4]; float s = 0.f;
#pragma unroll
                    for (int j = 0; j < 4; ++j) { v[j] = xr[64 * j]; s += (v[j][0] * v[j][0] + v[j][1] * v[j][1]) + (v[j][2] * v[j][2] + v[j][3] * v[j][3]); }
                    s = wave_sum(s);
                    v2u* ob = (v2u*)((ism ? MEMB : XB) + (size_t)r * D) + lane;
#pragma unroll
                    for (int j = 0; j < 4; ++j) { v2u w; w.x = pk2(v[j][0], v[j][1]); w.y = pk2(v[j][2], v[j][3]); ob[64 * j] = w; }
                    if (!ism) {
                        if (lane < 16) SS[(size_t)r * 16 + lane] = lane == 0 ? s : 0.f;
                    } else if (lane == 0) RSM[r] = rsqrtf(s * (1.0f / D) + EPS);
                }
            }
        }
        SEAM(pb + 0);
#pragma nounroll
        for (int f = 0; f < 2; ++f) {
            const int pu = pb + (f == 0 ? 1 : 13), pd = pu + 1;
            if (IN(pu)) { KARGS();
                { pg8::Gemm g{XB, Wt + (f == 0 ? WO_GU1 : WO_GU2), 1024, 1024, 1024, 0, 0}; pg8::StaticOrder S; S.init(M / 256, 22, G, bx);
                  pg8::EpiSwiGLU E{SS, ACT};
#ifndef MK_REP_UP
#define MK_REP_UP 1
#endif
_Pragma("nounroll")
                  for (int rep = 0; rep < MK_REP_UP; ++rep) pg8::gemm_phase<pg8::EpiSwiGLU, pg8::StaticOrder, true, true>(ldsp, g, S, E); }
                if (f == 0) {
                    { pg8::Gemm g{MEMB, Wt + WO_K, 1024, 1024, 1024, 0, 0}; pg8::StaticOrder S; S.init(1, 4, G, bx);
                      pg8::EpiScale<2> E{RSM, KC, 1024, 1.0f}; pg8::gemm_phase<pg8::EpiScale<2>, pg8::StaticOrder, true, true>(ldsp, g, S, E); }
                    { pg8::Gemm g{Wt + WO_V, MEMB, 1024, 1024, 1024, 0, 0}; pg8::StaticOrder S; S.init(4, 1, G, bx);
                      pg8::EpiScale<3> E{RSM, VCT, 256, 1.0f}; pg8::gemm_phase<pg8::EpiScale<3>, pg8::StaticOrder, true, true>(ldsp, g, S, E); }
                }
            }
            SEAM(pu);
            if (IN(pd)) { KARGS();
                pg8::Gemm g{ACT, Wt + (f == 0 ? WO_D1 : WO_D2), FF, FF, FF, 0, 0}; pg8::StaticOrder S; S.init(M / 256, 4, G, bx);
                pg8::EpiResid E{XB, SS, 0.5f}; pg8::gemm_phase<pg8::EpiResid, pg8::StaticOrder, true, true>(ldsp, g, S, E);
            }
            SEAM(pd);
            if (f == 1) break;
            if (IN(pb + 3)) { KARGS();
                { TIDS();
                    const float* bfp = in[12] + l * 8; const bf16* WF = Wt + WO_END; const int fr = lane & 15, fq = lane >> 4;
                    for (int tile = gw; tile < M / 16; tile += NGW) {
                        const int row = 16 * tile + fr;
                        const bf16* ap = XB + (size_t)row * D + 8 * fq; const bf16* bp = WF + (size_t)fr * D + 8 * fq;
                        f32x4 acc = {0.f, 0.f, 0.f, 0.f};
#pragma unroll 8
                        for (int ks = 0; ks < 32; ++ks) { const bf16x8 a = *(const bf16x8*)(ap + 32 * ks), b = *(const bf16x8*)(bp + 32 * ks); acc = __builtin_amdgcn_mfma_f32_16x16x32_bf16(b, a, acc, 0, 0, 0); }
                        const float rs = pg8::row_rstd1(SS, row, fq);
#pragma unroll
                        for (int j = 0; j < 4; ++j) { const float t = acc[j] + __shfl_xor(acc[j], 32);
                            if (fq < 2) { const int hd = 4 * fq + j; const float z = t * rs + bfp[hd]; LF[(size_t)hd * M + row] = fminf(z, 0.f) - log1pf(expf(-fabsf(z))); } }
                    }
                }
                pg8::Gemm g{XB, Wt + WO_IN, 1024, 1024, 1024, 0, 0}; pg8::StaticOrder S; S.init(M / 256, 16, G, bx);
                pg8::EpiWin E{SS, PROJ, SSV, 0.125f * LOG2E}; pg8::gemm_phase<pg8::EpiWin, pg8::StaticOrder, true, true>(ldsp, g, S, E);
            }
            SEAM(pb + 3);
            if (IN(pb + 4)) { KARGS(); TIDS();
                if (bx < 8) {
                    const float* lf = LF + (size_t)bx * M + tid * 32; float* cs = CS + (size_t)bx * M + tid * 32;
                    f32x4 v[8]; float run = 0.f;
#pragma unroll
                    for (int i = 0; i < 8; ++i) { v[i] = *(const f32x4*)(lf + 4 * i);
#pragma unroll
                        for (int e = 0; e < 4; ++e) { run += v[i][e]; v[i][e] = run; } }
                    const double tot = (double)run; double incl = tot;
#pragma unroll
                    for (int o = 1; o < 64; o <<= 1) { const double t = __shfl_up(incl, o); if (lane >= o) incl += t; }
                    LAS double* wsum = (LAS double*)ldsp;
                    if (lane == 63) wsum[wave] = incl;
                    __syncthreads();
                    double bsum = 0.0;
                    for (int w = 0; w < wave; ++w) bsum += wsum[w];
                    const double excl = bsum + incl - tot;
#pragma unroll
                    for (int i = 0; i < 8; ++i) { f32x4 o;
#pragma unroll
                        for (int e = 0; e < 4; ++e) o[e] = (float)((excl + (double)v[i][e]) * 1.4426950408889634);
                        *(f32x4*)(cs + 4 * i) = o; }
                    __syncthreads();
                }
                {
                    unsigned* KM = (unsigned*)(ws + 32768) + 8 * l;
                    for (int idx = vcu * NTHREADS + tid; idx < 2 * M * 8; idx += G * NTHREADS) {
                        const int isq = idx >= M * 8, id2 = idx - isq * M * 8; const bf16* Kp = PROJ + (isq ? 8 : 6) * PIECE;
                        const v4u* kp = (const v4u*)(Kp + (size_t)(id2 >> 3) * 512 + (id2 & 7) * 64); float s = 0.f;
#pragma unroll
                        for (int q = 0; q < 8; ++q) { const v4u w = kp[q];
#pragma unroll
                            for (int e = 0; e < 4; ++e) { const float a = pg8::bflo(w[e]), b = pg8::bfhi(w[e]); s += a * a + b * b; } }
                        s = fmaxf(s, __shfl_xor(s, 8)); s = fmaxf(s, __shfl_xor(s, 16)); s = fmaxf(s, __shfl_xor(s, 32));
                        if (lane < 8) atomicMax(KM + 64 * isq + lane, __float_as_uint(s));
                    }
                }
                {
                    bf16* AB = PROJ; const bf16* AC = PROJ + 3 * PIECE; const bf16* AH = PROJ + 4 * PIECE; const float* cw = in[8] + (size_t)l * 3 * 512;
                    for (int idx = vcu * NTHREADS + tid; idx < M * 64; idx += G * NTHREADS) {
                        const int t = idx >> 6, c8 = (idx & 63) * 8; const size_t off = (size_t)t * 512 + c8;
                        const v4u bw = *(const v4u*)(AB + off);
                        float zz[3][8];
#pragma unroll
                        for (int d = 0; d < 3; ++d) {
                            if (t - d >= 0) { const v4u cv = *(const v4u*)(AC + off - (size_t)d * 512), hv = *(const v4u*)(AH + off - (size_t)d * 512);
#pragma unroll
                                for (int e = 0; e < 4; ++e) { zz[d][2 * e] = pg8::bflo(cv[e]) * pg8::bflo(hv[e]); zz[d][2 * e + 1] = pg8::bfhi(cv[e]) * pg8::bfhi(hv[e]); } }
                            else {
#pragma unroll
                                for (int e = 0; e < 8; ++e) zz[d][e] = 0.f; }
                        }
                        float y[8];
#pragma unroll
                        for (int e = 0; e < 8; ++e) { const float b = (e & 1) ? pg8::bfhi(bw[e >> 1]) : pg8::bflo(bw[e >> 1]);
                            y[e] = b * (cw[c8 + e] * zz[2][e] + cw[512 + c8 + e] * zz[1][e] + cw[1024 + c8 + e] * zz[0][e]); }
                        v4u o; o.x = pk2(y[0], y[1]); o.y = pk2(y[2], y[3]); o.z = pk2(y[4], y[5]); o.w = pk2(y[6], y[7]);
                        *(v4u*)(AB + off) = o;
                    }
                }
                {
                    bf16* UU = PROJ + 1 * PIECE; const bf16* VV = PROJ + 5 * PIECE; const float* sgn = in[9] + (size_t)l * 512; const float* sgw = in[10] + (size_t)l * 4 * 128 * 128; const float* sgb = in[11] + (size_t)l * 4 * 128;
                    LAS bf16* T = (LAS bf16*)ldsp;
                    const int fr = lane & 15, fq = lane >> 4;
                    for (int unit = vcu; unit < 512; unit += G) {
                        const int n = unit >> 2, gI = unit & 3;
                        { const int s = tid >> 2, cg0 = (tid & 3) * 32, row = 128 * n + s;
                          const f32x4 p0 = *(const f32x4*)(SSV + (size_t)row * 8), p1 = *(const f32x4*)(SSV + (size_t)row * 8 + 4);
                          const float rv = rsqrtf(((p0[0] + p0[1]) + (p0[2] + p0[3]) + (p1[0] + p1[1]) + (p1[2] + p1[3])) * (1.0f / 512.0f) + EPS);
#pragma unroll
                          for (int q = 0; q < 4; ++q) { const int c = cg0 + 8 * q; const v4u vw = *(const v4u*)(VV + (size_t)row * 512 + 128 * gI + c);
                              const f32x4 ga = *(const f32x4*)(sgn + 128 * gI + c), gb = *(const f32x4*)(sgn + 128 * gI + c + 4);
#pragma unroll
                              for (int e = 0; e < 4; ++e) { const float g0 = e < 2 ? ga[2 * e] : gb[2 * e - 4], g1 = e < 2 ? ga[2 * e + 1] : gb[2 * e - 3];
                                  T[(c + 2 * e) * 136 + s] = (bf16)f2bf(pg8::bflo(vw[e]) * rv * g0); T[(c + 2 * e + 1) * 136 + s] = (bf16)f2bf(pg8::bfhi(vw[e]) * rv * g1); } } }
                        __syncthreads();
                        f32x4 acc[8];
#pragma unroll
                        for (int j = 0; j < 8; ++j) acc[j] = (f32x4){0.f, 0.f, 0.f, 0.f};
                        const int t = 16 * wave + fr;
                        for (int kk = 0; kk <= (wave >> 1); ++kk) {
                            const int s0 = 32 * kk + 8 * fq; const float* wp = sgw + ((size_t)gI * 128 + t) * 128 + s0;
                            const f32x4 w0 = *(const f32x4*)wp, w1 = *(const f32x4*)(wp + 4);
                            float wv[8] = {w0[0], w0[1], w0[2], w0[3], w1[0], w1[1], w1[2], w1[3]};
#pragma unroll
                            for (int e = 0; e < 8; ++e) if (s0 + e > t) wv[e] = 0.f;
                            v4u aw; aw.x = pk2(wv[0], wv[1]); aw.y = pk2(wv[2], wv[3]); aw.z = pk2(wv[4], wv[5]); aw.w = pk2(wv[6], wv[7]);
                            const bf16x8 afr = __builtin_bit_cast(bf16x8, aw);
#pragma unroll
                            for (int j = 0; j < 8; ++j) { const bf16x8 bfr = *(const LAS bf16x8*)(T + (16 * j + fr) * 136 + s0); acc[j] = __builtin_amdgcn_mfma_f32_16x16x32_bf16(bfr, afr, acc[j], 0, 0, 0); }
                        }
                        const float bias = sgb[gI * 128 + t]; const size_t rowoff = (size_t)(128 * n + t) * 512 + 128 * gI;
#pragma unroll
                        for (int j = 0; j < 8; ++j) { const int c = 16 * j + 4 * fq; const v2u uw = *(const v2u*)(UU + rowoff + c);
                            v2u o; o.x = pk2(pg8::bflo(uw.x) * (acc[j][0] + bias), pg8::bfhi(uw.x) * (acc[j][1] + bias)); o.y = pk2(pg8::bflo(uw.y) * (acc[j][2] + bias), pg8::bfhi(uw.y) * (acc[j][3] + bias));
                            *(v2u*)(UU + rowoff + c) = o; }
                        __syncthreads();
                    }
                }
            }
            SEAM(pb + 4);
            if (IN(pb + 5)) { KARGS();
                TIDS();
                const attn_body::AttnTensors AT{(const attn_body::bf16*)(PROJ + 8 * PIECE), (const attn_body::bf16*)(PROJ + 6 * PIECE), (const attn_body::bf16*)(PROJ + 7 * PIECE), (attn_body::bf16*)(PROJ + 2 * PIECE), CS, (const unsigned*)(ws + 32768) + 8 * l};
                unsigned* qctr = (unsigned*)(ws + 40960) + 64 * l;
                volatile LAS unsigned* qw = (volatile LAS unsigned*)(ldsp + XB_LDS_OFF + 64);
#pragma nounroll
                for (;;) {
                    if (tid == 0) { qw[0] = __hip_atomic_fetch_add(qctr, 1u, __ATOMIC_RELAXED, __HIP_MEMORY_SCOPE_AGENT); qw[1] = 0u; }
                    __syncthreads();
                    const unsigned idx = qw[0];
                    if (idx >= 512u) break;
                    const int qb = 63 - (int)(idx >> 3), hd = (int)(idx & 7u), ntf = 4 * (qb + 1);
                    {
                        const float km2 = __uint_as_float(__hip_atomic_load(AT.KM + hd, __ATOMIC_RELAXED, __HIP_MEMORY_SCOPE_AGENT)), qm2 = __uint_as_float(__hip_atomic_load(AT.KM + 64 + hd, __ATOMIC_RELAXED, __HIP_MEMORY_SCOPE_AGENT));
                        const float R = sqrtf(km2 * qm2) * 1.001f + 0.01f; const float* csh = CS + (size_t)hd * M;
                        const float thr = csh[256 * qb] + 152.0f + 2.0f * R;
                        const bool sk = (tid < ntf - 4) && (csh[64 * tid + 63] > thr);
                        const unsigned long long bal = __ballot(sk);
                        if (lane == 0 && bal) atomicAdd((unsigned*)(lds + XB_LDS_OFF + 68), (unsigned)__popcll(bal));
                    }
                    __syncthreads();
                    int t0 = (int)qw[1]; t0 &= ~1; t0 = t0 > ntf - 4 ? ntf - 4 : t0;
                    attn_body::attn_unit<8>(0, hd, qb, AT.Q, AT.K, AT.V, AT.O, CS, AT.KM, (char*)lds, t0);
                }
                __syncthreads();
            }
            SEAM(pb + 5);
            if (IN(pb + 6)) { KARGS();
                pg8::Gemm g{XB, Wt + WO_G, 1024, 1024, 1024, 0, 0}; pg8::StaticOrder S; S.init(M / 256, 12, G, bx);
                pg8::EpiGates E{SS, GT}; pg8::gemm_phase<pg8::EpiGates, pg8::StaticOrder, true, true>(ldsp, g, S, E);
            }
            SEAM_LOCAL(pb + 6);
            if (IN(pb + 7)) { KARGS();
                pg8::Gemm g{PROJ, Wt + WO_B, 512, 512, 512, PIECE * 2, (size_t)1024 * 512 * 2}; pg8::ZOrder<3> S; S.S.init(M / 256, 4, G, bx);
                pg8::EpiMerge E{GT}; pg8::gemm_phase<pg8::EpiMerge, pg8::ZOrder<3>, true, true>(ldsp, g, S, E);
            }
            SEAM(pb + 7);
            if (IN(pb + 8)) { KARGS();
                pg8::Gemm g{GT, Wt + WO_O, 1024, 1024, 1024, 0, 0}; pg8::StaticOrder S; S.init(M / 256, 4, G, bx);
                pg8::EpiResid E{XB, SS, 1.0f}; pg8::gemm_phase<pg8::EpiResid, pg8::StaticOrder, true, true>(ldsp, g, S, E);
            }
            SEAM(pb + 8);
            if (IN(pb + 9)) { KARGS();
                pg8::Gemm g{XB, Wt + WO_Q, 1024, 1024, 1024, 0, 0}; pg8::EpiScale<1> E{SS, XQ, 1024, 0.0625f * LOG2E};
                for (int Lx = vcu; Lx < 256; Lx += G) { pg8::OneUnit S; S.u0.pm = Lx >> 2; S.u0.pn = Lx & 3; S.u0.z = 0; pg8::gemm_phase<pg8::EpiScale<1>, pg8::OneUnit, true, true>(ldsp, g, S, E); }
            }
            SEAM_LOCAL(pb + 9);
            if (IN(pb + 10)) { KARGS();
                pg8::Gemm g{XQ, KC, 256, 1024, 1024, 512, 512}; pg8::EpiSoftmax E{PB};
                for (int Lx = vcu; Lx < 256; Lx += G) { pg8::OneUnit S; S.u0.pm = Lx >> 2; S.u0.pn = 0; S.u0.z = Lx & 3; pg8::gemm_phase<pg8::EpiSoftmax, pg8::OneUnit, false, true>(ldsp, g, S, E); }
            }
            SEAM_LOCAL(pb + 10);
            if (IN(pb + 11)) { KARGS();
                pg8::Gemm g{PB, VCT, 256, 1024, 256, 512, (size_t)256 * 256 * 2}; pg8::EpiScale<0> E{nullptr, OB, 1024, 1.0f};
                for (int Lx = vcu; Lx < 256; Lx += G) { pg8::OneUnit S; S.u0.pm = Lx >> 2; S.u0.pn = 0; S.u0.z = Lx & 3; pg8::gemm_phase<pg8::EpiScale<0>, pg8::OneUnit, true, true>(ldsp, g, S, E); }
            }
            SEAM(pb + 11);
            if (IN(pb + 12)) { KARGS();
                pg8::Gemm g{OB, Wt + WO_XO, 1024, 1024, 1024, 0, 0}; pg8::StaticOrder S; S.init(M / 256, 4, G, bx);
                pg8::EpiResid E{XB, SS, 1.0f}; pg8::gemm_phase<pg8::EpiResid, pg8::StaticOrder, true, true>(ldsp, g, S, E);
            }
            SEAM(pb + 12);
        }
    }
#ifdef MK_DUMP_OFF
    {
        GRID_SYNC(); KARGS(); int t_ = threadIdx.x; asm volatile("" : "+v"(t_));
        const bf16* src = SCR + (size_t)(MK_DUMP_OFF);
        for (unsigned i = blockIdx.x * 512u + (unsigned)t_; i < (unsigned)M * 1024u; i += gridDim.x * 512u) { const unsigned m = i >> 10, c = i & 1023u;
            X[i] = c < (unsigned)(MK_DUMP_LD) ? b2f(src[(size_t)m * (MK_DUMP_LD) + c]) : 0.f; }
    }
#endif
    if (IN(30)) { KARGS(); TIDS();
        const float* gf = in[25];
        for (int m = gw; m < M; m += NGW) {
            const v2u* xb = (const v2u*)(XB + (size_t)m * D) + lane; f32x4* xr = (f32x4*)(X + (size_t)m * D) + lane; f32x4 v[4]; float s = 0.f;
#pragma unroll
            for (int j = 0; j < 4; ++j) { const v2u xw = xb[64 * j]; v[j] = (f32x4){pg8::bflo(xw.x), pg8::bfhi(xw.x), pg8::bflo(xw.y), pg8::bfhi(xw.y)}; s += (v[j][0] * v[j][0] + v[j][1] * v[j][1]) + (v[j][2] * v[j][2] + v[j][3] * v[j][3]); }
            const float r = rsqrtf(wave_sum(s) * (1.0f / D) + EPS);
#pragma unroll
            for (int j = 0; j < 4; ++j) xr[64 * j] = v[j] * r * *((const f32x4*)gf + lane + 64 * j);
        }
    }
#undef IN
#undef SEAM
#undef ws
#undef X
#undef SS
#undef SSV
#undef LF
#undef CS
#undef RSM
#undef MEMB
#undef KC
#undef VCT
#undef Wt
#undef XB
#undef SCR
#undef ACT
#undef PROJ
#undef GT
#undef XQ
#undef PB
#undef OB
#undef in
}

#ifndef MK_PER_PHASE
#define MK_PER_PHASE 0
#endif
extern "C" void kernel_launch(void* const* d_in, const int* in_sizes, int n_in, void* d_out, int out_size, void* d_ws, size_t ws_size, hipStream_t stream) {
    static int grid = 0;
    if (grid == 0) {
        if (n_in != 26 || out_size != M * D || ws_size < WS_END) { fprintf(stderr, "kernel_launch: unexpected shapes (n_in %d out %d ws %zu)\n", n_in, out_size, ws_size); grid = -1; return; }
        int dev = 0, cus = 0, per_cu = 0;
        (void)hipGetDevice(&dev); (void)hipDeviceGetAttribute(&cus, hipDeviceAttributeMultiprocessorCount, dev);
        if (hipFuncSetAttribute((const void*)mk_fwd, hipFuncAttributeMaxDynamicSharedMemorySize, LDS_BYTES) != hipSuccess) { fprintf(stderr, "kernel_launch: hipFuncSetAttribute failed\n"); grid = -1; return; }
        if (hipOccupancyMaxActiveBlocksPerMultiprocessor(&per_cu, (const void*)mk_fwd, NTHREADS, LDS_BYTES) != hipSuccess || per_cu < 1) { fprintf(stderr, "kernel_launch: occupancy query says %d\n", per_cu); per_cu = 1; }
        (void)hipGetLastError();
        grid = cus > 0 ? cus : 256;
    }
    if (grid < 0) return;
    (void)hipMemsetAsync(d_ws, 0, 65536, stream);
    Args a{};
    for (int i = 0; i < 26; ++i) a.in[i] = (const float*)d_in[i];
    a.out = (float*)d_out; a.ws = (unsigned char*)d_ws;
#if MK_PER_PHASE
    for (int p = 0; p < 31; ++p) { a.ph_lo = p; a.ph_hi = p + 1; void* kargs[] = {&a};
        hipError_t e = hipLaunchCooperativeKernel((const void*)mk_fwd, dim3(grid), dim3(NTHREADS), kargs, LDS_BYTES, stream);
        if (e != hipSuccess) { fprintf(stderr, "launch %d failed: %s\n", p, hipGetErrorString(e)); break; } }
#else
#ifndef MK_PH_HI
#define MK_PH_HI 31
#endif
    a.ph_lo = 0; a.ph_hi = MK_PH_HI; void* kargs[] = {&a};
    hipError_t e = hipLaunchCooperativeKernel((const void*)mk_fwd, dim3(grid), dim3(NTHREADS), kargs, LDS_BYTES, stream);
    if (e != hipSuccess) fprintf(stderr, "cooperative launch failed: %s (grid %d)\n", hipGetErrorString(e), grid);
#endif
}
```

```cpp
#include <hip/hip_runtime.h>
#include <hip/hip_cooperative_groups.h>
#include <cstdio>
#include <cstdint>
namespace cg = cooperative_groups;

namespace pg8 {
#define PG8_LAS __attribute__((address_space(3)))
typedef unsigned short bf16_t;
typedef short bf16x8 __attribute__((ext_vector_type(8)));
typedef float f32x4 __attribute__((ext_vector_type(4)));
typedef unsigned u32x4 __attribute__((ext_vector_type(4)));
constexpr int BM = 256, BK = 64, HALF = 128, HTB = HALF * BK * 2  , STAGE_BYTES = 8 * HTB, NXCD = 8, WGM = 8;

__host__ __device__ __forceinline__ int lds_byte(int r, int c) { const int st = (r >> 4) * 2 + (c >> 5), rr = r & 15, cc = c & 31, ob = rr * 64 + cc * 2; return st * 1024 + (ob ^ (((ob >> 9) & 1) << 5)); }
__host__ __device__ __forceinline__ void stage_rc(int b, int& R, int& C) { const int st = b / 1024, sb = b % 1024, swz = sb ^ (((sb >> 9) & 1) << 5); R = (st >> 1) * 16 + swz / 64; C = (st & 1) * 32 + (swz % 64) / 2; }
__host__ __device__ __forceinline__ int perm32(int rho) { const int n = rho >> 4, i = rho & 15; return 8 * (i >> 2) + 4 * n + (i & 3); }

struct Unit { int pm, pn, z; };
typedef float f32x2 __attribute__((ext_vector_type(2))); typedef __bf16 bf16x2_cv __attribute__((ext_vector_type(2)));
__device__ __forceinline__ unsigned cvt_pk_bf16(float lo, float hi) { const f32x2 v = {lo, hi}; const bf16x2_cv b = __builtin_convertvector(v, bf16x2_cv); return __builtin_bit_cast(unsigned, b); }
struct Gemm { const bf16_t* A; const bf16_t* Bt; int K, lda, ldb; size_t zA, zB; };

struct StaticOrder {
    int nM, nN, nwg, G, c;
    __host__ __device__ void init(int nM_, int nN_, int G_, int c_) { nM = nM_; nN = nN_; nwg = nM * nN; G = G_; c = c_; }
    __host__ __device__ void map(int wgid, Unit& u) const {
        { const int q = nwg / NXCD, r = nwg % NXCD, xcd = wgid % NXCD, off = wgid / NXCD; wgid = (xcd < r ? xcd * (q + 1) : r * (q + 1) + (xcd - r) * q) + off; }
        const int nig = WGM * nN, gid = wgid / nig, fm = gid * WGM, gsz = (nM - fm) < WGM ? (nM - fm) : WGM;
        u.pm = fm + ((wgid % nig) % gsz); u.pn = (wgid % nig) / gsz; u.z = 0;
    }
    __host__ __device__ bool next(int i, Unit& u) const { const long L = (long)i * G + c; if (L >= nwg) return false; map((int)L, u); return true; }
    __device__ __forceinline__ void a_ready(const Unit&) const {}
    __device__ __forceinline__ void done(const Unit&) const {}
};
template <int NZ> struct ZOrder {
    StaticOrder S;
    __host__ __device__ bool next(int i, Unit& u) const { const long L = (long)(i / NZ) * S.G + S.c; if (L >= S.nwg) return false; S.map((int)L, u); u.z = i % NZ; return true; }
    __device__ __forceinline__ void a_ready(const Unit&) const {}
    __device__ __forceinline__ void done(const Unit&) const {}
};
struct OneUnit {
    Unit u0;
    __host__ __device__ bool next(int i, Unit& u) const { if (i > 0) return false; u = u0; return true; }
    __device__ __forceinline__ void a_ready(const Unit&) const {}
    __device__ __forceinline__ void done(const Unit&) const {}
};

typedef unsigned u32x2 __attribute__((ext_vector_type(2)));
constexpr float LOG2E = 1.4426950408889634f;
__device__ __forceinline__ float bf2f(unsigned short b) { return __uint_as_float((unsigned)b << 16); }
__device__ __forceinline__ float bflo(unsigned w) { return __uint_as_float(w << 16); }
__device__ __forceinline__ float bfhi(unsigned w) { return __uint_as_float(w & 0xffff0000u); }
__device__ __forceinline__ float sigmoidf_(float v) { return __builtin_amdgcn_rcpf(1.0f + __builtin_amdgcn_exp2f(-v * LOG2E)); }
__device__ __forceinline__ float gelu_tanh(float v) { const float z = 0.7978845608028654f * (v + 0.044715f * v * v * v); return v * sigmoidf_(2.0f * z); }
__device__ __forceinline__ u32x4 pack8(const f32x4 a, const f32x4 b) { u32x4 w; w.x = cvt_pk_bf16(a[0], a[1]); w.y = cvt_pk_bf16(a[2], a[3]); w.z = cvt_pk_bf16(b[0], b[1]); w.w = cvt_pk_bf16(b[2], b[3]); return w; }
__device__ __forceinline__ void row_rstd(const float* SS, int rowbase, int fq, float (&rs)[2][4]) {
#pragma unroll
    for (int ai = 0; ai < 2; ++ai)
#pragma unroll
        for (int m = 0; m < 4; ++m) { const f32x4 v = *(const f32x4*)(SS + (size_t)(rowbase + ai * HALF + m * 16) * 16 + 4 * fq);
            float s = (v[0] + v[1]) + (v[2] + v[3]); s += __shfl_xor(s, 16); s += __shfl_xor(s, 32); rs[ai][m] = rsqrtf(s * (1.0f / 1024.0f) + 1e-6f); }
}
__device__ __forceinline__ float row_rstd1(const float* SS, int row, int fq) { const f32x4 v = *(const f32x4*)(SS + (size_t)row * 16 + 4 * fq);
    float s = (v[0] + v[1]) + (v[2] + v[3]); s += __shfl_xor(s, 16); s += __shfl_xor(s, 32); return rsqrtf(s * (1.0f / 1024.0f) + 1e-6f); }
#define EPI_ARGS const f32x4 (&acc)[2][2][4][2], const Unit& u, int wr, int wc, int fr, int fq
struct EpiSwiGLU { static constexpr bool PERM = true, AFTER_DRAIN = false; const float* SS; bf16_t* O;
    __device__ __forceinline__ void operator()(EPI_ARGS) const {
        float rs[2][4]; row_rstd(SS, u.pm * BM + wr * 64 + fr, fq, rs);
        const int col0 = u.pn * 128 + wc * 32 + 8 * fq;
#pragma unroll
        for (int ai = 0; ai < 2; ++ai)
#pragma unroll
            for (int m = 0; m < 4; ++m) { const float r = rs[ai][m]; f32x4 o[2];
#pragma unroll
                for (int n = 0; n < 2; ++n)
#pragma unroll
                    for (int j = 0; j < 4; ++j) { const float g = acc[ai][0][m][n][j] * r, up = acc[ai][1][m][n][j] * r; o[n][j] = g * sigmoidf_(g) * up; }
                *(u32x4*)(O + (size_t)(u.pm * BM + ai * HALF + wr * 64 + m * 16 + fr) * 2816 + col0) = pack8(o[0], o[1]); }
    }
};
struct EpiResid { static constexpr bool PERM = false, AFTER_DRAIN = false; bf16_t* XB; float* SS; float scale;
    __device__ __forceinline__ void operator()(EPI_ARGS) const {
        const int col0 = u.pn * BM + wc * 32 + 4 * fq;
#pragma unroll
        for (int ai = 0; ai < 2; ++ai)
#pragma unroll
            for (int m = 0; m < 4; ++m) { const int row = u.pm * BM + ai * HALF + wr * 64 + m * 16 + fr; float ssq = 0.f;
#pragma unroll
                for (int bj = 0; bj < 2; ++bj)
#pragma unroll
                    for (int n = 0; n < 2; ++n) { const size_t off = (size_t)row * 1024 + col0 + bj * HALF + n * 16;
                        const u32x2 xw = *(const u32x2*)(XB + off);
                        f32x4 x = {bflo(xw.x), bfhi(xw.x), bflo(xw.y), bfhi(xw.y)}; x = x + acc[ai][bj][m][n] * scale;
                        u32x2 w; w.x = cvt_pk_bf16(x[0], x[1]); w.y = cvt_pk_bf16(x[2], x[3]); *(u32x2*)(XB + off) = w;
                        ssq += (x[0] * x[0] + x[1] * x[1]) + (x[2] * x[2] + x[3] * x[3]); }
                ssq += __shfl_xor(ssq, 16); ssq += __shfl_xor(ssq, 32);
                if (fq == 0) SS[(size_t)row * 16 + u.pn * 4 + wc] = ssq; }
    }
};
struct EpiWin { static constexpr bool PERM = true, AFTER_DRAIN = false; const float* SS; bf16_t* P; float* SSV; float qscale;
    __device__ __forceinline__ void operator()(EPI_ARGS) const {
        const int piece = u.pn >> 1;
        const int slot = piece == 0 ? 0 : piece == 1 ? 3 : piece == 2 ? 4 : piece == 3 ? 1 : piece == 4 ? 5 : piece == 5 ? 8 : piece;
        bf16_t* base = P + (size_t)slot * (16384u * 512u);
        const int col0 = (u.pn & 1) * 256 + wc * 32 + 8 * fq;
        const float sc = piece == 5 ? qscale : 1.0f;
#pragma unroll
        for (int ai = 0; ai < 2; ++ai)
#pragma unroll
            for (int m = 0; m < 4; ++m) { const int row = u.pm * BM + ai * HALF + wr * 64 + m * 16 + fr; const float r = row_rstd1(SS, row, fq) * sc; float ssq = 0.f;
#pragma unroll
                for (int bj = 0; bj < 2; ++bj) { f32x4 v0 = acc[ai][bj][m][0] * r, v1 = acc[ai][bj][m][1] * r;
                    if (piece == 3 || piece == 4) {
#pragma unroll
                        for (int j = 0; j < 4; ++j) { v0[j] = gelu_tanh(v0[j]); v1[j] = gelu_tanh(v1[j]); }
                        ssq += (v0[0] * v0[0] + v0[1] * v0[1]) + (v0[2] * v0[2] + v0[3] * v0[3]) + (v1[0] * v1[0] + v1[1] * v1[1]) + (v1[2] * v1[2] + v1[3] * v1[3]); }
                    *(u32x4*)(base + (size_t)row * 512 + col0 + bj * HALF) = pack8(v0, v1); }
                if (piece == 4) { ssq += __shfl_xor(ssq, 16); ssq += __shfl_xor(ssq, 32); if (fq == 0) SSV[(size_t)row * 8 + (u.pn & 1) * 4 + wc] = ssq; }
                asm volatile("" ::: "memory"); }
    }
};
struct EpiGates { static constexpr bool PERM = true, AFTER_DRAIN = false; const float* SS; bf16_t* G;
    __device__ __forceinline__ void operator()(EPI_ARGS) const {
        float rs[2][4]; row_rstd(SS, u.pm * BM + wr * 64 + fr, fq, rs);
        bf16_t* base = G + (size_t)(u.pn >> 2) * (16384u * 1024u);
        const int col0 = (u.pn & 3) * 256 + wc * 32 + 8 * fq;
#pragma unroll
        for (int ai = 0; ai < 2; ++ai)
#pragma unroll
            for (int m = 0; m < 4; ++m) { const int row = u.pm * BM + ai * HALF + wr * 64 + m * 16 + fr; const float r = rs[ai][m];
#pragma unroll
                for (int bj = 0; bj < 2; ++bj) { f32x4 v0 = acc[ai][bj][m][0] * r, v1 = acc[ai][bj][m][1] * r;
#pragma unroll
                    for (int j = 0; j < 4; ++j) { v0[j] = sigmoidf_(v0[j]); v1[j] = sigmoidf_(v1[j]); }
                    *(u32x4*)(base + (size_t)row * 1024 + col0 + bj * HALF) = pack8(v0, v1); } }
    }
};
struct EpiMerge { static constexpr bool PERM = true, AFTER_DRAIN = false; bf16_t* G;
    __device__ __forceinline__ void operator()(EPI_ARGS) const {
        const bf16_t* gz = G + (size_t)u.z * (16384u * 1024u);
        const int col0 = u.pn * 256 + wc * 32 + 8 * fq;
#pragma unroll
        for (int ai = 0; ai < 2; ++ai)
#pragma unroll
            for (int m = 0; m < 4; ++m) { const int row = u.pm * BM + ai * HALF + wr * 64 + m * 16 + fr;
#pragma unroll
                for (int bj = 0; bj < 2; ++bj) { const size_t off = (size_t)row * 1024 + col0 + bj * HALF;
                    const u32x4 gw = *(const u32x4*)(gz + off);
                    f32x4 g0 = {bflo(gw.x), bfhi(gw.x), bflo(gw.y), bfhi(gw.y)}, g1 = {bflo(gw.z), bfhi(gw.z), bflo(gw.w), bfhi(gw.w)};
                    f32x4 v0 = acc[ai][bj][m][0] * g0, v1 = acc[ai][bj][m][1] * g1;
#ifdef MK_DBG_Z
                    if (u.z != MK_DBG_Z) { v0 = v0 * 0.f; v1 = v1 * 0.f; }
#endif
                    if (u.z != 0) { u32x4 pw; { const unsigned long long a_ = __hip_atomic_load((const unsigned long long*)(G + off), __ATOMIC_RELAXED, __HIP_MEMORY_SCOPE_AGENT), b_ = __hip_atomic_load((const unsigned long long*)(G + off) + 1, __ATOMIC_RELAXED, __HIP_MEMORY_SCOPE_AGENT);
                            pw.x = (unsigned)a_; pw.y = (unsigned)(a_ >> 32); pw.z = (unsigned)b_; pw.w = (unsigned)(b_ >> 32); }
                        v0 = v0 + (f32x4){bflo(pw.x), bfhi(pw.x), bflo(pw.y), bfhi(pw.y)}; v1 = v1 + (f32x4){bflo(pw.z), bfhi(pw.z), bflo(pw.w), bfhi(pw.w)}; }
                    *(u32x4*)(G + off) = pack8(v0, v1); } }
    }
};
template <int MODE> struct EpiScale { static constexpr bool PERM = true, AFTER_DRAIN = false; const float* S; bf16_t* O; int ldc; float scale;
    __device__ __forceinline__ void operator()(EPI_ARGS) const {
        float rs[2][4];
        if (MODE == 1) row_rstd(S, u.pm * BM + wr * 64 + fr, fq, rs);
        const int col0 = (u.pn + u.z) * 256 + wc * 32 + 8 * fq;
#pragma unroll
        for (int ai = 0; ai < 2; ++ai)
#pragma unroll
            for (int m = 0; m < 4; ++m) { const int row = u.pm * BM + ai * HALF + wr * 64 + m * 16 + fr;
                float r = scale; if (MODE == 1) r *= rs[ai][m]; if (MODE == 2) r *= S[row];
#pragma unroll
                for (int bj = 0; bj < 2; ++bj) { f32x4 v0 = acc[ai][bj][m][0] * r, v1 = acc[ai][bj][m][1] * r;
                    if (MODE == 3) { v0 = v0 * *(const f32x4*)(S + col0 + bj * HALF); v1 = v1 * *(const f32x4*)(S + col0 + bj * HALF + 4); }
                    *(u32x4*)(O + (size_t)row * ldc + col0 + bj * HALF) = pack8(v0, v1); } }
    }
};
struct EpiSoftmax { static constexpr bool PERM = true, AFTER_DRAIN = true; bf16_t* O;
    __device__ __forceinline__ void fused(f32x4 (&acc)[2][2][4][2], const Unit& u, int wr, int wc, int fr, int fq, PG8_LAS unsigned char* lds, int wid, int lane) const {
        PG8_LAS float* T1 = (PG8_LAS float*)lds; PG8_LAS float* T2 = (PG8_LAS float*)(lds + 4096);
#pragma unroll
        for (int ai = 0; ai < 2; ++ai)
#pragma unroll
            for (int m = 0; m < 4; ++m) { float mx = -3.0e38f;
#pragma unroll
                for (int bj = 0; bj < 2; ++bj)
#pragma unroll
                    for (int n = 0; n < 2; ++n)
#pragma unroll
                        for (int j = 0; j < 4; ++j) mx = fmaxf(mx, acc[ai][bj][m][n][j]);
                mx = fmaxf(mx, __shfl_xor(mx, 16)); mx = fmaxf(mx, __shfl_xor(mx, 32));
                if (fq == 0) T1[(ai * HALF + wr * 64 + m * 16 + fr) * 4 + wc] = mx; }
        asm volatile("s_waitcnt lgkmcnt(0)" ::: "memory"); __builtin_amdgcn_s_barrier(); asm volatile("" ::: "memory");
#pragma unroll
        for (int ai = 0; ai < 2; ++ai)
#pragma unroll
            for (int m = 0; m < 4; ++m) { const int rl = ai * HALF + wr * 64 + m * 16 + fr; const f32x4 t = *(const PG8_LAS f32x4*)(T1 + rl * 4);
                const float mx = fmaxf(fmaxf(t[0], t[1]), fmaxf(t[2], t[3])); float s = 0.f;
#pragma unroll
                for (int bj = 0; bj < 2; ++bj)
#pragma unroll
                    for (int n = 0; n < 2; ++n)
#pragma unroll
                        for (int j = 0; j < 4; ++j) { const float p = __builtin_amdgcn_exp2f(acc[ai][bj][m][n][j] - mx); acc[ai][bj][m][n][j] = p; s += p; }
                s += __shfl_xor(s, 16); s += __shfl_xor(s, 32);
                if (fq == 0) T2[rl * 4 + wc] = s; }
        asm volatile("s_waitcnt lgkmcnt(0)" ::: "memory"); __builtin_amdgcn_s_barrier(); asm volatile("" ::: "memory");
        const int col0 = u.z * 256 + wc * 32 + 8 * fq;
#pragma unroll
        for (int ai = 0; ai < 2; ++ai)
#pragma unroll
            for (int m = 0; m < 4; ++m) { const int rl = ai * HALF + wr * 64 + m * 16 + fr; const f32x4 t = *(const PG8_LAS f32x4*)(T2 + rl * 4);
                const float inv = 1.0f / ((t[0] + t[1]) + (t[2] + t[3]));
#pragma unroll
                for (int bj = 0; bj < 2; ++bj) *(u32x4*)(O + (size_t)(u.pm * BM + rl) * 1024 + col0 + bj * HALF) = pack8(acc[ai][bj][m][0] * inv, acc[ai][bj][m][1] * inv); }
        asm volatile("s_waitcnt lgkmcnt(0)" ::: "memory"); __builtin_amdgcn_s_barrier(); asm volatile("" ::: "memory");
    }
};

template <class Epi, class Sched, bool ALIGN_EPI = false, bool SP2 = false>
__device__ __forceinline__ void gemm_phase(PG8_LAS unsigned char* lds, const Gemm g, const Sched& S, const Epi& E) {
    int tid_o = threadIdx.x; asm volatile("" : "+v"(tid_o)); const int tid = tid_o, wid = __builtin_amdgcn_readfirstlane(tid >> 6), lane = tid & 63, wr = wid >> 2, wc = wid & 3, fr = lane & 15, fq = lane >> 4;
    const int nt = g.K / BK; const char* gA_ = reinterpret_cast<const char*>(g.A); const char* gB_ = reinterpret_cast<const char*>(g.Bt); asm volatile("" : "+s"(gA_), "+s"(gB_));
    unsigned voffA[2], voffB[2];
#pragma unroll
    for (int i = 0; i < 2; ++i) { int R, C; stage_rc(tid * 16 + i * 8192, R, C); const int Rb = Epi::PERM ? ((R & ~31) + perm32(R & 31)) : R;
        voffA[i] = (unsigned)(R * g.lda + C) * 2u; voffB[i] = (unsigned)(Rb * g.ldb + C) * 2u; }
    const size_t kstep = (size_t)(BK * 2);
    const size_t hstepA = (size_t)HALF * g.lda * 2, hstepB = (size_t)HALF * g.ldb * 2;

    const unsigned ldsw = (unsigned)wid * 1024u;
    const int aoff = lds_byte(wr * 64 + fr, fq * 8), boff = lds_byte(wc * 32 + fr, fq * 8);
#define PG8_SA(b, h) (((b) * 2 + (h)) * HTB)
#define PG8_SB(b, h) ((4 + (b) * 2 + (h)) * HTB)
#define PG8_STAGE(bufoff, gbase, voff) do { _Pragma("unroll") for (int _i = 0; _i < 2; ++_i) \
        __builtin_amdgcn_global_load_lds((const unsigned*)((const char*)(gbase) + (voff)[_i]), (PG8_LAS unsigned*)(lds + (bufoff) + ldsw + _i * 8192), 16, 0, 0); } while (0)
#define PG8_LDA(dst, b, h) do { _Pragma("unroll") for (int m = 0; m < 4; ++m) _Pragma("unroll") for (int k = 0; k < 2; ++k) dst[m][k] = *(const PG8_LAS bf16x8*)(lds + PG8_SA(b, h) + aoff + m * 2048 + k * 1024); } while (0)
#define PG8_LDB(dst, b, h) do { _Pragma("unroll") for (int n = 0; n < 2; ++n) _Pragma("unroll") for (int k = 0; k < 2; ++k) dst[n][k] = *(const PG8_LAS bf16x8*)(lds + PG8_SB(b, h) + boff + n * 2048 + k * 1024); } while (0)
#define PG8_MMA(ai, bj, At, Bt) do { __builtin_amdgcn_s_setprio(1); _Pragma("unroll") for (int m = 0; m < 4; ++m) _Pragma("unroll") for (int n = 0; n < 2; ++n) _Pragma("unroll") for (int k = 0; k < 2; ++k) \
        acc[ai][bj][m][n] = __builtin_amdgcn_mfma_f32_16x16x32_bf16(Bt[n][k], At[m][k], acc[ai][bj][m][n], 0, 0, 0); __builtin_amdgcn_s_setprio(0); } while (0)
#define PG8_WAIT_V(n) asm volatile("s_waitcnt vmcnt(" #n ")" ::: "memory")
#define PG8_WAIT_L(n) asm volatile("s_waitcnt lgkmcnt(" #n ")" ::: "memory")
#define PG8_BAR __builtin_amdgcn_s_barrier()
#define PG8_SCHED __builtin_amdgcn_sched_barrier(0)
    Unit cur, nxt; int ui = 0;
    if (!S.next(0, cur)) return;
    f32x4 acc[2][2][4][2];
#pragma unroll
    for (int a = 0; a < 2; ++a)
#pragma unroll
        for (int b = 0; b < 2; ++b)
#pragma unroll
            for (int m = 0; m < 4; ++m)
#pragma unroll
                for (int n = 0; n < 2; ++n) acc[a][b][m][n] = (f32x4){0.f, 0.f, 0.f, 0.f};
    bf16x8 At[4][2], B0[2][2], B1[2][2];
    const char* cA = gA_ + (size_t)cur.pm * 2 * hstepA + (size_t)cur.z * g.zA; const char* cB = gB_ + (size_t)cur.pn * 2 * hstepB + (size_t)cur.z * g.zB;
    S.a_ready(cur);
    if constexpr (SP2) {
        PG8_STAGE(PG8_SB(0, 0), cB, voffB); PG8_STAGE(PG8_SB(0, 1), cB + hstepB, voffB); PG8_STAGE(PG8_SA(0, 0), cA, voffA); PG8_STAGE(PG8_SA(0, 1), cA + hstepA, voffA);
        if (wr == 1) PG8_BAR;
        PG8_WAIT_V(2); PG8_BAR;
        PG8_STAGE(PG8_SB(1, 0), cB + kstep, voffB); PG8_STAGE(PG8_SA(1, 0), cA + kstep, voffA); PG8_STAGE(PG8_SB(1, 1), cB + hstepB + kstep, voffB);
        PG8_WAIT_V(6); PG8_BAR;
    } else {
        PG8_STAGE(PG8_SB(0, 0), cB, voffB); PG8_STAGE(PG8_SA(0, 0), cA, voffA); PG8_STAGE(PG8_SB(0, 1), cB + hstepB, voffB); PG8_STAGE(PG8_SA(0, 1), cA + hstepA, voffA);
        if (wr == 1) PG8_BAR;
        PG8_WAIT_V(4); PG8_BAR;
        PG8_STAGE(PG8_SB(1, 0), cB + kstep, voffB); PG8_STAGE(PG8_SA(1, 0), cA + kstep, voffA); PG8_STAGE(PG8_SB(1, 1), cB + hstepB + kstep, voffB);
        PG8_WAIT_V(6); PG8_BAR;
    }
    for (;;) {
        const bool has_next = S.next(ui + 1, nxt);
        const char* nA = has_next ? gA_ + (size_t)nxt.pm * 2 * hstepA + (size_t)nxt.z * g.zA : cA; const char* nB = has_next ? gB_ + (size_t)nxt.pn * 2 * hstepB + (size_t)nxt.z * g.zB : cB;
_Pragma("nounroll")
        for (int t = 0; t < nt; t += 2) {
            const bool last = (t == nt - 2);
            const char* a1 = cA + (size_t)(t + 1) * kstep;
            const char* a2 = last ? nA : cA + (size_t)(t + 2) * kstep; const char* b2 = last ? nB : cB + (size_t)(t + 2) * kstep;
            const char* a3 = a2 + kstep; const char* b3 = b2 + kstep;
            if (last && has_next) S.a_ready(nxt);
            if constexpr (SP2) {
            PG8_LDB(B0, 0, 0); PG8_LDB(B1, 0, 1); PG8_SCHED; PG8_LDA(At, 0, 0); PG8_STAGE(PG8_SA(1, 1), a1 + hstepA, voffA);
            PG8_WAIT_V(8); PG8_WAIT_L(0); PG8_BAR; PG8_MMA(0, 0, At, B0); PG8_MMA(0, 1, At, B1); PG8_BAR; PG8_SCHED;
            PG8_LDA(At, 0, 1); PG8_STAGE(PG8_SB(0, 0), b2, voffB); PG8_STAGE(PG8_SB(0, 1), b2 + hstepB, voffB); PG8_STAGE(PG8_SA(0, 0), a2, voffA);
            PG8_WAIT_V(8); PG8_WAIT_L(0); PG8_BAR; PG8_MMA(1, 0, At, B0); PG8_MMA(1, 1, At, B1); PG8_BAR; PG8_SCHED;
            PG8_LDB(B0, 1, 0); PG8_LDB(B1, 1, 1); PG8_SCHED; PG8_LDA(At, 1, 0); PG8_STAGE(PG8_SA(0, 1), a2 + hstepA, voffA);
            PG8_WAIT_V(8); PG8_WAIT_L(0); PG8_BAR; PG8_MMA(0, 0, At, B0); PG8_MMA(0, 1, At, B1); PG8_BAR; PG8_SCHED;
            PG8_LDA(At, 1, 1); PG8_STAGE(PG8_SB(1, 0), b3, voffB); PG8_STAGE(PG8_SB(1, 1), b3 + hstepB, voffB); PG8_STAGE(PG8_SA(1, 0), a3, voffA);
            PG8_WAIT_V(8); PG8_WAIT_L(0); PG8_BAR; PG8_MMA(1, 0, At, B0); PG8_MMA(1, 1, At, B1); PG8_BAR; PG8_SCHED;
            } else {
            PG8_LDB(B0, 0, 0); PG8_SCHED; PG8_LDA(At, 0, 0); PG8_STAGE(PG8_SA(1, 1), a1 + hstepA, voffA);
            PG8_WAIT_L(8); PG8_BAR; PG8_WAIT_L(0); PG8_MMA(0, 0, At, B0); PG8_BAR; PG8_SCHED;
            PG8_LDB(B1, 0, 1); PG8_STAGE(PG8_SB(0, 0), b2, voffB);
            PG8_BAR; PG8_WAIT_L(0); PG8_MMA(0, 1, At, B1); PG8_BAR;
            PG8_LDA(At, 0, 1); PG8_STAGE(PG8_SA(0, 0), a2, voffA);
            PG8_BAR; PG8_WAIT_L(0); PG8_MMA(1, 0, At, B0); PG8_BAR; PG8_SCHED;
            PG8_STAGE(PG8_SB(0, 1), b2 + hstepB, voffB);
            PG8_WAIT_V(6); PG8_BAR; PG8_MMA(1, 1, At, B1); PG8_BAR;
            PG8_LDB(B0, 1, 0); PG8_SCHED; PG8_LDA(At, 1, 0); PG8_STAGE(PG8_SA(0, 1), a2 + hstepA, voffA);
            PG8_WAIT_L(8); PG8_BAR; PG8_WAIT_L(0); PG8_MMA(0, 0, At, B0); PG8_BAR; PG8_SCHED;
            PG8_LDB(B1, 1, 1); PG8_STAGE(PG8_SB(1, 0), b3, voffB);
            PG8_BAR; PG8_WAIT_L(0); PG8_MMA(0, 1, At, B1); PG8_BAR;
            PG8_LDA(At, 1, 1); PG8_STAGE(PG8_SA(1, 0), a3, voffA);
            PG8_BAR; PG8_WAIT_L(0); PG8_MMA(1, 0, At, B0); PG8_BAR; PG8_SCHED;
            PG8_STAGE(PG8_SB(1, 1), b3 + hstepB, voffB);
            PG8_WAIT_V(6); PG8_BAR; PG8_MMA(1, 1, At, B1); PG8_BAR;
            }
        }
        if constexpr (ALIGN_EPI) { if (wr == 0) PG8_BAR; }
        if constexpr (!Epi::AFTER_DRAIN) { E(acc, cur, wr, wc, fr, fq); S.done(cur); }
        if (!has_next) break;
#pragma unroll
        for (int a = 0; a < 2; ++a)
#pragma unroll
            for (int b = 0; b < 2; ++b)
#pragma unroll
                for (int m = 0; m < 4; ++m)
#pragma unroll
                    for (int n = 0; n < 2; ++n) acc[a][b][m][n] = (f32x4){0.f, 0.f, 0.f, 0.f};
        cur = nxt; cA = nA; cB = nB; ++ui;
        if constexpr (ALIGN_EPI) { if (wr == 1) PG8_BAR; }
    }
    PG8_WAIT_V(0);
    if constexpr (!ALIGN_EPI) { if (wr == 0) PG8_BAR; }
    PG8_BAR;
    if constexpr (Epi::AFTER_DRAIN) { E.fused(acc, cur, wr, wc, fr, fq, lds, wid, lane); S.done(cur); }
#undef PG8_SA
#undef PG8_SB
#undef PG8_STAGE
#undef PG8_LDA
#undef PG8_LDB
#undef PG8_MMA
#undef PG8_WAIT_V
#undef PG8_WAIT_L
#undef PG8_BAR
#undef PG8_SCHED
}
}
#include <hip/hip_bf16.h>
#include <cmath>
namespace attn_body {
using bf16=__hip_bfloat16;
using bf16x8=__attribute__((ext_vector_type(8)))short;
using s16x4=__attribute__((ext_vector_type(4)))short;
using f32x16=__attribute__((ext_vector_type(16)))float;
using u32x4=__attribute__((ext_vector_type(4)))unsigned;
using f32x4_t=__attribute__((ext_vector_type(4)))float;
constexpr int BATCH=1,NHEAD=8,SEQ=16384,D=64,DM=NHEAD*D;
constexpr int NW=8,QBLK=32,QB=QBLK*NW,KVBLK=64,NQB=SEQ/QB;
constexpr int ATTN_PITCH=DM, ATTN_UNIT_ROWS=QB;
__device__ __forceinline__ int crow(int r,int hi){return (r&3)+8*(r>>2)+4*hi;}
#define SBAR() __builtin_amdgcn_sched_barrier(0)
__device__ __forceinline__ void cmask(f32x16&p0,f32x16&p1,int jb,int qrel,int hi){
  const float NEG=-INFINITY; int kb=64*jb+4*hi;
  #pragma unroll
  for(int r=0;r<16;++r){int kv=kb+(r&3)+8*(r>>2); if(kv>qrel)p0[r]=NEG; if(kv+32>qrel)p1[r]=NEG;}
}

constexpr int NSLOT=3, SLOTB=8192;
constexpr int LDS_K=0, LDS_V=NSLOT*SLOTB, LDS_WS=2*NSLOT*SLOTB, LDS_OST=LDS_WS+NW*64*4, LDS_CK=LDS_OST+NW*4096, LDS_BYTES=LDS_CK+SEQ*4;
constexpr float C2=0.125f*1.4426950408889634f;
__device__ __forceinline__ void glds16(const void*gsrc,unsigned lds_dst){unsigned keep;
  asm volatile("s_mov_b32 %0, m0\n\ts_mov_b32 m0, %2\n\ts_nop 0\n\tglobal_load_lds_dwordx4 %1, off\n\ts_mov_b32 m0, %0":"=&s"(keep):"v"(gsrc),"s"(lds_dst):"memory");}
__device__ __forceinline__ float max3f(float a,float b,float c){float r;asm("v_max3_f32 %0, %1, %2, %3":"=v"(r):"v"(a),"v"(b),"v"(c));return r;}
__device__ __forceinline__ float max2f(float a,float b){float r;asm("v_max_f32_e32 %0, %1, %2":"=v"(r):"v"(a),"v"(b));return r;}
__device__ __forceinline__ float fadd_s(float a,float b){float r;asm("v_add_f32_e32 %0, %1, %2":"=v"(r):"v"(a),"v"(b));return r;}
__device__ __forceinline__ float fsub_s(float a,float b){float r;asm("v_sub_f32_e32 %0, %1, %2":"=v"(r):"v"(a),"v"(b));return r;}
typedef float f32x2_t __attribute__((ext_vector_type(2))); typedef __bf16 bf16x2_t __attribute__((ext_vector_type(2)));
__device__ __forceinline__ unsigned cvtpk_s(float lo,float hi){f32x2_t v={lo,hi};bf16x2_t b=__builtin_convertvector(v,bf16x2_t);return __builtin_bit_cast(unsigned,b);}
#define WAIT_BAR(N) asm volatile("s_waitcnt vmcnt(" #N ") lgkmcnt(0)\n\ts_barrier":::"memory")

__device__ __forceinline__ void qkt(f32x16&p0,f32x16&p1,const char*Kslot,const bf16x8*qr,const f32x16&negm,int r32,int hi){
  const char*kb=Kslot+hi*1024+r32*16;
  #pragma unroll
  for(int d0=0;d0<4;++d0){
    const bf16x8 b0=*reinterpret_cast<const bf16x8*>(kb+d0*2048);
    const bf16x8 b1=*reinterpret_cast<const bf16x8*>(kb+d0*2048+512);
    if(d0==0){p0=__builtin_amdgcn_mfma_f32_32x32x16_bf16(b0,qr[0],negm,0,0,0);p1=__builtin_amdgcn_mfma_f32_32x32x16_bf16(b1,qr[0],negm,0,0,0);}
    else{p0=__builtin_amdgcn_mfma_f32_32x32x16_bf16(b0,qr[d0],p0,0,0,0);p1=__builtin_amdgcn_mfma_f32_32x32x16_bf16(b1,qr[d0],p1,0,0,0);}}
}
typedef __attribute__((address_space(3))) const char* lds_cptr;
typedef short v4i16_t __attribute__((ext_vector_type(4)));
__device__ __forceinline__ void kload8(bf16x8*kf,lds_cptr kp){
  kf[0]=*(const __attribute__((address_space(3))) bf16x8*)(kp);      kf[1]=*(const __attribute__((address_space(3))) bf16x8*)(kp+512);
  kf[2]=*(const __attribute__((address_space(3))) bf16x8*)(kp+2048); kf[3]=*(const __attribute__((address_space(3))) bf16x8*)(kp+2560);
  kf[4]=*(const __attribute__((address_space(3))) bf16x8*)(kp+4096); kf[5]=*(const __attribute__((address_space(3))) bf16x8*)(kp+4608);
  kf[6]=*(const __attribute__((address_space(3))) bf16x8*)(kp+6144); kf[7]=*(const __attribute__((address_space(3))) bf16x8*)(kp+6656);
}
__device__ __forceinline__ void kload2(bf16x8*kf,lds_cptr kp,int j){ kf[2*j]=*(const __attribute__((address_space(3))) bf16x8*)(kp+j*2048); kf[2*j+1]=*(const __attribute__((address_space(3))) bf16x8*)(kp+j*2048+512); }
__device__ __forceinline__ s16x4 vtr(lds_cptr p){ return __builtin_bit_cast(s16x4,__builtin_amdgcn_ds_read_tr16_b64_v4i16((__attribute__((address_space(3))) v4i16_t*)p)); }
__device__ __forceinline__ float rowmax(const f32x16&p0,const f32x16&p1){
  float a=max3f(p0[0],p0[1],p1[0]),b=max3f(p0[2],p0[3],p1[1]);a=max3f(a,p1[2],p1[3]);
  #pragma unroll
  for(int r=4;r<16;r+=4){a=max3f(a,p0[r],p0[r+1]);b=max3f(b,p0[r+2],p0[r+3]);a=max3f(a,p1[r],p1[r+1]);b=max3f(b,p1[r+2],p1[r+3]);}
  const float m=max2f(a,b);
  auto rr=__builtin_amdgcn_permlane32_swap(__float_as_uint(m),__float_as_uint(m),false,false);
  return max2f(__uint_as_float(rr[0]),__uint_as_float(rr[1]));
}
__device__ __forceinline__ void pv(f32x16*o,int vb,bf16x8 pa0,bf16x8 pa1,bf16x8 pa2,bf16x8 pa3){
  #pragma unroll
  for(int d0=0;d0<2;++d0){s16x4 lo[4],hi[4];
    #pragma unroll
    for(int ks=0;ks<4;++ks){
      asm volatile("ds_read_b64_tr_b16 %0,%1 offset:%c2":"=&v"(lo[ks]):"v"(vb),"i"(d0*4096+ks*1024):"memory");
      asm volatile("ds_read_b64_tr_b16 %0,%1 offset:%c2":"=&v"(hi[ks]):"v"(vb),"i"(d0*4096+ks*1024+512):"memory");}
    asm volatile("s_waitcnt lgkmcnt(0)":::"memory");SBAR();
    #define PK(k) (bf16x8){lo[k][0],lo[k][1],lo[k][2],lo[k][3],hi[k][0],hi[k][1],hi[k][2],hi[k][3]}
    o[d0]=__builtin_amdgcn_mfma_f32_32x32x16_bf16(pa0,PK(0),o[d0],0,0,0);
    o[d0]=__builtin_amdgcn_mfma_f32_32x32x16_bf16(pa1,PK(1),o[d0],0,0,0);
    o[d0]=__builtin_amdgcn_mfma_f32_32x32x16_bf16(pa2,PK(2),o[d0],0,0,0);
    o[d0]=__builtin_amdgcn_mfma_f32_32x32x16_bf16(pa3,PK(3),o[d0],0,0,0);
    #undef PK
  }
}

#ifndef ATTN_STORE16
#define ATTN_STORE16(p,v) (*(u32x4*)(p)=(v))
#endif
template<int THRL> __device__ __forceinline__ void attn_unit(int b,int h,int qb,const bf16*Q,const bf16*__restrict__ K,const bf16*__restrict__ V,bf16*O,const float*__restrict__ CSg,const unsigned*KMg,char*shm,const int t0,const int ntl,const bool masked,float*__restrict__ Lout){
  int tid_o=threadIdx.x; asm volatile("":"+v"(tid_o)); const int tid=tid_o,lane=tid&63,r32=lane&31,hi=lane>>5; const int wid=__builtin_amdgcn_readfirstlane(tid>>6);
  const long rowbase=(long)b*SEQ; const int q0=qb*QB;
  const bf16*Qw=Q+(rowbase+q0+wid*QBLK)*DM+h*D;
  const bf16*Kh=K+(rowbase+(long)t0*KVBLK)*DM+h*D,*Vh=V+(rowbase+(long)t0*KVBLK)*DM+h*D;
  const unsigned lds0=(unsigned)(uintptr_t)shm;
  float*wsf=(float*)(shm+LDS_WS)+wid*64;
  const lds_cptr shm3=(lds_cptr)shm;
  const bf16*ksrc=Kh+(long)lane*DM+wid*8;
  const bf16*vsrc=Vh+(long)(16*(wid&3)+(lane>>2))*DM+(wid>>2)*32+(lane&3)*8;
  const unsigned kdst=lds0+LDS_K+wid*1024, vdst=lds0+LDS_V+wid*1024;
  #define DMA_K(t,slot) glds16(ksrc+(long)(t)*KVBLK*DM,(unsigned)__builtin_amdgcn_readfirstlane(kdst+(slot)))
  #define DMA_V(t,slot) glds16(vsrc+(long)(t)*KVBLK*DM,(unsigned)__builtin_amdgcn_readfirstlane(vdst+(slot)))
  const int vb0=(int)(lds0+LDS_V)+((lane>>4)&1)*32+(lane&3)*8+(4*hi+((lane&15)>>2))*64;
  const char*Kbase=shm+LDS_K; bf16x8 kf[8];
  const lds_cptr kp0=shm3+LDS_K+hi*1024+r32*16; const lds_cptr vp0=shm3+LDS_V+((lane>>4)&1)*32+(lane&3)*8+(4*hi+((lane&15)>>2))*64;
  const int NT=ntl;
  typedef __attribute__((address_space(3))) float* lds_fptr; typedef __attribute__((address_space(3))) f32x4_t* lds_f4ptr;
  const float*csh=CSg+(long)h*SEQ;
  { const lds_fptr ckw=(lds_fptr)(shm3+LDS_CK);
    for(int i=tid*4;i<ntl*KVBLK;i+=NW*64*4){ const f32x4_t v=*(const f32x4_t*)(csh+t0*KVBLK+i); *(lds_f4ptr)(ckw+i)=v; }
  }
  const float cq=csh[q0+wid*QBLK+r32];
  asm volatile("s_waitcnt vmcnt(0) lgkmcnt(0)\n\ts_barrier":::"memory");
  const lds_fptr ckt=(lds_fptr)(shm3+LDS_CK)+4*hi;
  #define CKSUB(P0,P1,t) do{ const lds_fptr ckp_=ckt+64*(t); _Pragma("unroll") for(int j_=0;j_<4;++j_){ const f32x4_t a_=*(const lds_f4ptr)(ckp_+8*j_); const f32x4_t b_=*(const lds_f4ptr)(ckp_+32+8*j_); \
      P0[4*j_]-=a_[0];P0[4*j_+1]-=a_[1];P0[4*j_+2]-=a_[2];P0[4*j_+3]-=a_[3]; P1[4*j_]-=b_[0];P1[4*j_+1]-=b_[1];P1[4*j_+2]-=b_[2];P1[4*j_+3]-=b_[3]; SBAR(); } }while(0)
  DMA_K(0,0);DMA_V(0,0);DMA_K(1,SLOTB);
  bf16x8 qr[4];
  #pragma unroll
  for(int d0=0;d0<4;++d0)qr[d0]=*reinterpret_cast<const bf16x8*>(&Qw[(long)r32*DM+d0*16+hi*8]);
  float l_reg=0.f;f32x16 o[2];o[0]=f32x16{};o[1]=f32x16{};f32x16 negm;
  {
    float q2=0.f;
    _Pragma("unroll") for(int d0=0;d0<4;++d0) _Pragma("unroll") for(int e=0;e<8;++e){ const float v=__uint_as_float(((unsigned)(unsigned short)qr[d0][e])<<16); q2+=v*v; }
    { auto rr=__builtin_amdgcn_permlane32_swap(__float_as_uint(q2),__float_as_uint(q2),false,false); q2=__uint_as_float(rr[0])+__uint_as_float(rr[1]); }
    const float km2=__uint_as_float(__hip_atomic_load(KMg+h,__ATOMIC_RELAXED,__HIP_MEMORY_SCOPE_AGENT));
    const float Rq=sqrtf(q2*km2)*1.001f+0.01f;
    _Pragma("unroll") for(int r=0;r<16;++r)negm[r]=cq-Rq; asm volatile("":"+v"(negm)); }
  const int qrel=wid*QBLK+r32;
  #define CMASK(P0,P1,t) do{int jb_=(t)-(NT-4); if(masked&&jb_>=0)cmask(P0,P1,jb_,qrel,hi);}while(0)
  #define START(P0,P1) do{ const float rm=rowmax(P0,P1); resc=false; \
    { const float dl=rm; mhat=fadd_s(mhat,dl); \
      _Pragma("unroll") for(int r=0;r<16;++r){P0[r]=fsub_s(P0[r],dl);P1[r]=fsub_s(P1[r],dl);} \
      _Pragma("unroll") for(int r=0;r<16;++r)negm[r]=-mhat; asm volatile("":"+v"(negm)); } \
    _Pragma("unroll") for(int r=0;r<16;++r)P0[r]=__builtin_amdgcn_exp2f(P0[r]); }while(0)
  #define RESC() do{ if(resc){ asm volatile("s_waitcnt lgkmcnt(0)":::"memory"); \
      _Pragma("unroll") for(int d_=0;d_<2;++d_) _Pragma("unroll") for(int r=0;r<16;++r)o[d_][r]*=wsf[crow(r,hi)]; } }while(0)
  f32x16 pA0,pA1,pB0,pB1;
  int sl_prev=0,sl_cur=0,sl_next=SLOTB;
  #define ROT() do{sl_prev=sl_cur;sl_cur=sl_next;sl_next=(sl_next==(NSLOT-1)*SLOTB)?0:sl_next+SLOTB;}while(0)
  DMA_K(2,2*SLOTB);
  WAIT_BAR(3);
  qkt(pA0,pA1,Kbase,qr,negm,r32,hi);asm volatile("s_nop 15\n\ts_nop 7":"+v"(pA0),"+v"(pA1));CKSUB(pA0,pA1,0);CMASK(pA0,pA1,0);
  _Pragma("unroll") for(int r=0;r<16;++r)pA0[r]=__builtin_amdgcn_exp2f(pA0[r]);
  _Pragma("unroll") for(int r=0;r<16;++r)pA1[r]=__builtin_amdgcn_exp2f(pA1[r]);
  WAIT_BAR(0);
  DMA_K(3,0);DMA_V(1,SLOTB);
  ROT();
  kload8(kf,kp0+sl_cur);
  WAIT_BAR(2);
  s16x4 vlo[8],vhi[8]; u32x4 pw0,pw1,pw2,pw3;
  #define PKW(P,B) cvtpk_s(P[B],P[B+1])
  #define PAF(k) __builtin_bit_cast(bf16x8,pw##k)
  #define VFR(i) (bf16x8){vlo[i][0],vlo[i][1],vlo[i][2],vlo[i][3],vhi[i][0],vhi[i][1],vhi[i][2],vhi[i][3]}
  #define PIN(x) asm volatile("":"+v"(x))
  #define MX3(a,b,c) __builtin_fmaxf(__builtin_fmaxf((a),(b)),(c))
  #define GAPA(MF,A0,A1,A2,A3,W0,W1,PW) do{ MF; sacc+=A0; sacc+=A1; sacc+=A2; sacc+=A3; PIN(sacc); W0; W1; PIN(PW); SBAR(); }while(0)
  #define EX(v) __builtin_amdgcn_exp2f(v)
  #define GAPB(MF,X,B,CUR,NXT,NOFF) do{ MF; if((NOFF)>=0){ NXT=*(const lds_f4ptr)(ckp_+((NOFF)>=0?(NOFF):0)); } X[B]=EX(X[B]-CUR[0]); X[B+1]=EX(X[B+1]-CUR[1]); X[B+2]=EX(X[B+2]-CUR[2]); X[B+3]=EX(X[B+3]-CUR[3]); PIN(X); SBAR(); }while(0)
  #define VRD(i) do{ vlo[i]=vtr(vp_+(((i)>>2)*4096+((i)&3)*1024)); vhi[i]=vtr(vp_+(((i)>>2)*4096+((i)&3)*1024+512)); }while(0)
  #define KRD(G,j) do{ if(G){ kload2(kf,kp0+sl_next,j); SBAR(); } }while(0)
  #define STEP(C0,C1,P0,P1,t,GK,GV,GL) do{ SBAR(); \
    const lds_cptr vp_=vp0+sl_prev; \
    VRD(0); SBAR(); float sacc=(P0[0]+P0[1]); \
    GAPA(C0=__builtin_amdgcn_mfma_f32_32x32x16_bf16(kf[0],qr[0],negm,0,0,0), P0[2],P0[3],P0[4],P0[5],     pw0[0]=PKW(P0,0), pw0[1]=PKW(P0,2), pw0); \
    VRD(4); SBAR(); GAPA(C1=__builtin_amdgcn_mfma_f32_32x32x16_bf16(kf[1],qr[0],negm,0,0,0), P0[6],P0[7],P0[8],P0[9],     pw0[2]=PKW(P0,4), pw0[3]=PKW(P0,6), pw0); \
    VRD(1); SBAR(); GAPA(C0=__builtin_amdgcn_mfma_f32_32x32x16_bf16(kf[2],qr[1],C0,0,0,0),   P0[10],P0[11],P0[12],P0[13], pw1[0]=PKW(P0,8), pw1[1]=PKW(P0,10), pw1); \
    VRD(5); SBAR(); GAPA(C1=__builtin_amdgcn_mfma_f32_32x32x16_bf16(kf[3],qr[1],C1,0,0,0),   P0[14],P0[15],P1[0],P1[1],   pw1[2]=PKW(P0,12),pw1[3]=PKW(P0,14), pw1); \
    VRD(2); SBAR(); GAPA(C0=__builtin_amdgcn_mfma_f32_32x32x16_bf16(kf[4],qr[2],C0,0,0,0),   P1[2],P1[3],P1[4],P1[5],     pw2[0]=PKW(P1,0), pw2[1]=PKW(P1,2), pw2); \
    VRD(6); SBAR(); GAPA(C1=__builtin_amdgcn_mfma_f32_32x32x16_bf16(kf[5],qr[2],C1,0,0,0),   P1[6],P1[7],P1[8],P1[9],     pw2[2]=PKW(P1,4), pw2[3]=PKW(P1,6), pw2); \
    VRD(3); SBAR(); GAPA(C0=__builtin_amdgcn_mfma_f32_32x32x16_bf16(kf[6],qr[3],C0,0,0,0),   P1[10],P1[11],P1[12],P1[13], pw3[0]=PKW(P1,8), pw3[1]=PKW(P1,10), pw3); \
    VRD(7); SBAR(); GAPA(C1=__builtin_amdgcn_mfma_f32_32x32x16_bf16(kf[7],qr[3],C1,0,0,0),   P1[14],P1[15],0.f,0.f,       pw3[2]=PKW(P1,12),pw3[3]=PKW(P1,14), pw3); \
    l_reg+=sacc; \
    if(GK){DMA_K((t)+3,sl_cur);} if(GV){DMA_V((t)+1,sl_next);} \
    CMASK(C0,C1,t); \
    const lds_fptr ckp_=ckt+64*(t); f32x4_t ckA_=*(const lds_f4ptr)(ckp_), ckB_; \
    SBAR(); \
    GAPB(o[0]=__builtin_amdgcn_mfma_f32_32x32x16_bf16(PAF(0),VFR(0),o[0],0,0,0), C0,0,ckA_,ckB_,8); \
    GAPB(o[1]=__builtin_amdgcn_mfma_f32_32x32x16_bf16(PAF(0),VFR(4),o[1],0,0,0), C0,4,ckB_,ckA_,16); \
    KRD(GL,0); GAPB(o[0]=__builtin_amdgcn_mfma_f32_32x32x16_bf16(PAF(1),VFR(1),o[0],0,0,0), C0,8,ckA_,ckB_,24); \
    KRD(GL,1); GAPB(o[1]=__builtin_amdgcn_mfma_f32_32x32x16_bf16(PAF(1),VFR(5),o[1],0,0,0), C0,12,ckB_,ckA_,32); \
    KRD(GL,2); GAPB(o[0]=__builtin_amdgcn_mfma_f32_32x32x16_bf16(PAF(2),VFR(2),o[0],0,0,0), C1,0,ckA_,ckB_,40); \
    KRD(GL,3); GAPB(o[1]=__builtin_amdgcn_mfma_f32_32x32x16_bf16(PAF(2),VFR(6),o[1],0,0,0), C1,4,ckB_,ckA_,48); \
    GAPB(o[0]=__builtin_amdgcn_mfma_f32_32x32x16_bf16(PAF(3),VFR(3),o[0],0,0,0), C1,8,ckA_,ckB_,56); \
    GAPB(o[1]=__builtin_amdgcn_mfma_f32_32x32x16_bf16(PAF(3),VFR(7),o[1],0,0,0), C1,12,ckB_,ckA_,-1); \
    }while(0)
  int t=1;
  #undef CMASK
  #define CMASK(P0,P1,t) do{}while(0)
  for(;t+5<NT;t+=2){
    STEP(pB0,pB1,pA0,pA1,t,true,true,true);     WAIT_BAR(2); ROT();
    STEP(pA0,pA1,pB0,pB1,t+1,true,true,true);   WAIT_BAR(2); ROT();
  }
  #undef CMASK
  #define CMASK(P0,P1,t) do{int jb_=(t)-(NT-4); if(masked&&jb_>=0)cmask(P0,P1,jb_,qrel,hi);}while(0)
  #define ENDW(tt) do{ if((tt)+3<NT){WAIT_BAR(2);} else if((tt)+2<NT){WAIT_BAR(1);} else {WAIT_BAR(0);} }while(0)
  for(;t+1<NT;t+=2){
    STEP(pB0,pB1,pA0,pA1,t,(t+3<NT),(t+1<NT),(t+1<NT));       ENDW(t); ROT();
    STEP(pA0,pA1,pB0,pB1,t+1,(t+4<NT),(t+2<NT),(t+2<NT));     ENDW(t+1); ROT();
  }
  STEP(pB0,pB1,pA0,pA1,NT-1,false,false,false);
  { float sacc=pB0[0]+pB0[1]; _Pragma("unroll") for(int r=2;r<16;++r)sacc+=pB0[r]; _Pragma("unroll") for(int r=0;r<16;++r)sacc+=pB1[r]; l_reg+=sacc;
    pw0=(u32x4){PKW(pB0,0),PKW(pB0,2),PKW(pB0,4),PKW(pB0,6)};pw1=(u32x4){PKW(pB0,8),PKW(pB0,10),PKW(pB0,12),PKW(pB0,14)};pw2=(u32x4){PKW(pB1,0),PKW(pB1,2),PKW(pB1,4),PKW(pB1,6)};pw3=(u32x4){PKW(pB1,8),PKW(pB1,10),PKW(pB1,12),PKW(pB1,14)};
    SBAR(); pv(o,vb0+sl_cur,PAF(0),PAF(1),PAF(2),PAF(3)); }
  #undef PKW
  #undef PAF
  #undef VFR
  #undef PIN
  #undef MX3
  #undef GAPA
  #undef GAPB
  #undef EX
  #undef VRD
  #undef KRD
  #undef STEP
  #undef ENDW
  {auto rr=__builtin_amdgcn_permlane32_swap(__float_as_uint(l_reg),__float_as_uint(l_reg),false,false);l_reg=__uint_as_float(rr[0])+__uint_as_float(rr[1]);}
  if(hi==0){wsf[32+r32]=l_reg; Lout[(long)(q0+wid*QBLK+r32)*NHEAD+h]=l_reg;}asm volatile("s_waitcnt lgkmcnt(0)":::"memory");
  float rli[16];
  #pragma unroll
  for(int r=0;r<16;++r){const float lv_=wsf[32+crow(r,hi)]; rli[r]=lv_>1e-30f?__builtin_amdgcn_rcpf(lv_):0.f;}
  bf16*Ow=O+(rowbase+q0+wid*QBLK)*DM+h*D;
  { bf16*stg=(bf16*)(shm+LDS_OST)+wid*2048;
    #pragma unroll
    for(int r=0;r<16;++r){const int orow=crow(r,hi);
      #pragma unroll
      for(int d0=0;d0<2;++d0)stg[orow*64+d0*32+r32]=__float2bfloat16(o[d0][r]*rli[r]);}
    asm volatile("s_waitcnt lgkmcnt(0)":::"memory");
    #pragma unroll
    for(int i=0;i<4;++i){const int row=i*8+(lane>>3),ch=lane&7; const u32x4 v=*(const u32x4*)(stg+row*64+ch*8); ATTN_STORE16(Ow+(long)row*DM+ch*8,v);} }
  asm volatile("s_waitcnt lgkmcnt(0)\n\ts_barrier":::"memory");
  #undef CKSUB
  #undef DMA_K
  #undef DMA_V
  #undef CMASK
  #undef START
  #undef RESC
  #undef ROT
}
constexpr int ATTN_LDS_BYTES=LDS_BYTES;
struct AttnTensors { const bf16* Q; const bf16* K; const bf16* V; bf16* O; const float* CS; const unsigned* KM; };
struct AttnUnit { int bh; int qb; };
struct StaticOrder {
  int vcu,G;
  __device__ __forceinline__ explicit StaticOrder(int grid,int block):vcu((grid%8==0)?(block%8)*(grid/8)+block/8:block),G(grid){}
  __device__ __forceinline__ bool next(int i,AttnUnit&u)const{
    if(G==256){ if(i>=2)return false; const int s=vcu&31; u.bh=vcu>>5; u.qb=(i==0)?s:63-s; return true; }
    const int Lx=i*G+vcu; if(Lx>=NHEAD*NQB)return false; u.bh=Lx/NQB; u.qb=NQB-1-(Lx%NQB); return true; }
  __device__ __forceinline__ void a_ready(const AttnUnit&)const{}
  __device__ __forceinline__ void done(const AttnUnit&)const{}
};
template<class Sched,int THRL=8> __device__ __forceinline__ void attn_phase(char*lds,const AttnTensors&T,const Sched&S){
  AttnUnit u;
  for(int i=0;S.next(i,u);++i){ S.a_ready(u); attn_unit<THRL>(0,u.bh,u.qb,T.Q,T.K,T.V,T.O,T.CS,T.KM,lds,0,4*(u.qb+1),true,(float*)nullptr); S.done(u); }
}
#undef SBAR
#undef WAIT_BAR
}
#define LAS __attribute__((address_space(3)))
typedef unsigned short bf16;
typedef unsigned v4u __attribute__((ext_vector_type(4)));
typedef unsigned v2u __attribute__((ext_vector_type(2)));
typedef float f32x4 __attribute__((ext_vector_type(4)));
typedef short bf16x8 __attribute__((ext_vector_type(8)));
constexpr int NWAVES = 8, NTHREADS = 512;
constexpr int M = 16384, D = 1024, FF = 2816, MEML = 256, DIN = 7176, NLAYER = 2;
constexpr float EPS = 1e-6f, LOG2E = 1.4426950408889634f;
constexpr int LDS_BYTES = 155648, XB_LDS_OFF = LDS_BYTES - 256, T0_LDS_OFF = 149504;
static_assert(attn_body::ATTN_LDS_BYTES <= LDS_BYTES, "lds");
constexpr size_t MiB = 1u << 20;
constexpr size_t WS_SS = 1 * MiB, WS_SSV = 2 * MiB, WS_LF = 2 * MiB + 512 * 1024, WS_CS = 3 * MiB, WS_RSM = 3 * MiB + 512 * 1024, WS_MEMB = 4 * MiB, WS_KC = 4 * MiB + 512 * 1024, WS_VCT = 5 * MiB;
constexpr size_t WS_LPL = 5 * MiB + 512 * 1024, WS_LP = 66 * MiB + 256 * 1024;
constexpr size_t WS_W = 6 * MiB, WS_XB = 68 * MiB, WS_SCR = 100 * MiB, WS_END = 244 * MiB;
constexpr size_t WO_GU1 = 0, WO_D1 = WO_GU1 + (size_t)5632 * 1024, WO_IN = WO_D1 + (size_t)1024 * 2816, WO_G = WO_IN + (size_t)4096 * 1024, WO_B = WO_G + (size_t)3072 * 1024,
                 WO_O = WO_B + (size_t)3 * 1024 * 512, WO_Q = WO_O + (size_t)1024 * 1024, WO_K = WO_Q + (size_t)1024 * 1024, WO_V = WO_K + (size_t)1024 * 1024, WO_XO = WO_V + (size_t)1024 * 1024,
                 WO_GU2 = WO_XO + (size_t)1024 * 1024, WO_D2 = WO_GU2 + (size_t)5632 * 1024, WO_END = WO_D2 + (size_t)1024 * 2816;
static_assert(WS_W + (WO_END + 16 * 1024) * 2 <= WS_LP && WS_LP + 3 * 512 * 1024 <= WS_XB, "weights fit");
constexpr size_t PIECE = (size_t)M * 512;

typedef __attribute__((address_space(1))) unsigned gu32;
#define RLX_AGENT __ATOMIC_RELAXED, __HIP_MEMORY_SCOPE_AGENT
#define XB_TMO      128
#define XB_XCNT(j)  (256  + 64 * (j))
#define XB_XSUB(j)  (1280 + 64 * (j))
#define XB_XGEN(j)  (2304 + 64 * (j))
#define XB_TOP      3328
#define XB_TOPGEN   3392
#define XCD_BAR_WORDS 3456
#define XB_SPIN_CAP (1u << 18)

__device__ __forceinline__ unsigned xb_ld(unsigned* p)              { return __hip_atomic_load(p, __ATOMIC_RELAXED, __HIP_MEMORY_SCOPE_AGENT); }
__device__ __forceinline__ unsigned xb_add(unsigned* p, unsigned v) { return __hip_atomic_fetch_add(p, v, __ATOMIC_RELAXED, __HIP_MEMORY_SCOPE_AGENT); }
__device__ __forceinline__ unsigned xb_xcc_id() { return (unsigned)__builtin_amdgcn_s_getreg((3 << 11) | 20) & 0xFu; }
#define XB_SPIN(cond, bar) do { unsigned _sp = 0; while (cond) { __builtin_amdgcn_s_sleep(1); \
    if ((++_sp & 255u) == 0u) { if (xb_ld(&(bar)[XB_TMO])) break; if (_sp > XB_SPIN_CAP) { atomicAdd(&(bar)[XB_TMO], 1u); break; } } } } while (0)

struct XcdBarrier {
    unsigned* bar; unsigned x;
    volatile LAS unsigned* st;
};

__device__ __forceinline__ XcdBarrier xcd_barrier_post(unsigned* bar, volatile LAS unsigned* st) {
    XcdBarrier b; b.bar = bar; b.x = xb_xcc_id(); b.st = st;
    if (threadIdx.x == 0) (void)xb_add(&bar[XB_XCNT(b.x)], 1u);
    return b;
}
__device__ __forceinline__ void xcd_barrier_complete(unsigned* bar, unsigned x, unsigned& nloc, unsigned& nx) {
    const unsigned G = gridDim.x * gridDim.y * gridDim.z;
    unsigned sum, cnt, mine, sp = 0u;
    for (;;) {
        sum = 0u; cnt = 0u; mine = 0u;
#pragma unroll
        for (unsigned j = 0; j < 16; ++j) { const unsigned c = xb_ld(&bar[XB_XCNT(j)]); sum += c; cnt += (c > 0u) ? 1u : 0u; mine = (j == x) ? c : mine; }
        if (sum == G) break;
        __builtin_amdgcn_s_sleep(1);
        if ((++sp & 255u) == 0u) { if (xb_ld(&bar[XB_TMO])) break; if (sp > XB_SPIN_CAP) { atomicAdd(&bar[XB_TMO], 1u); break; } }
    }
    nloc = mine > 0u ? mine : 1u; nx = cnt > 0u ? cnt : 1u;
}

__device__ __forceinline__ void xcd_barrier(const XcdBarrier& b) {
    asm volatile("s_waitcnt vmcnt(0)" ::: "memory");
    __syncthreads();
    if (threadIdx.x == 0) {
        unsigned* bar = b.bar;
        __builtin_amdgcn_s_waitcnt(0);
        unsigned nloc = b.st[0], nx = b.st[1];
        if (nloc == 0u) { xcd_barrier_complete(bar, b.x, nloc, nx); b.st[0] = nloc; b.st[1] = nx; }
        const unsigned old = xb_add(&bar[XB_XSUB(b.x)], 1u);
        const unsigned gen = old / nloc;
        if (old + 1u == (gen + 1u) * nloc) {
            __builtin_amdgcn_fence(__ATOMIC_RELEASE, "agent");
            asm volatile("s_waitcnt vmcnt(0)" ::: "memory");
            const unsigned og = xb_add(&bar[XB_TOP], 1u);
            const unsigned tg = og / nx;
            if (og + 1u == (tg + 1u) * nx) xb_add(&bar[XB_TOPGEN], 1u);
            else XB_SPIN(xb_ld(&bar[XB_TOPGEN]) == tg, bar);
            __builtin_amdgcn_fence(__ATOMIC_ACQUIRE, "agent");
            xb_add(&bar[XB_XGEN(b.x)], 1u);
            asm volatile("s_waitcnt vmcnt(0)" ::: "memory");
        } else {
            XB_SPIN(xb_ld(&bar[XB_XGEN(b.x)]) == gen, bar);
            __builtin_amdgcn_fence(__ATOMIC_ACQUIRE, "agent");
            asm volatile("s_waitcnt vmcnt(0)" ::: "memory");
        }
    }
    __syncthreads();
}
struct Args { const float* in[26]; float* out; unsigned char* ws; int ph_lo, ph_hi; };

__device__ __forceinline__ unsigned f2bf(float f) { unsigned u = __builtin_bit_cast(unsigned, f); return (u + 0x7fffu + ((u >> 16) & 1u)) >> 16; }
__device__ __forceinline__ unsigned pk2(float lo, float hi) { return f2bf(lo) | (f2bf(hi) << 16); }
__device__ __forceinline__ float b2f(unsigned short b) { return __uint_as_float((unsigned)b << 16); }
__device__ __forceinline__ float wave_sum(float v) {
#pragma unroll
    for (int o = 1; o < 64; o <<= 1) v += __shfl_xor(v, o);
    return v;
}
#define LDS_WAIT() asm volatile("s_waitcnt lgkmcnt(0)" ::: "memory")
__device__ __forceinline__ void conv_item(const float* W, int spitch, int k0, int n0, bf16* WT, int dpitch, int drow0, const float* gain, LAS float* scr, int lane) {
#pragma unroll
    for (int i = 0; i < 32; ++i) { const int kk = 2 * i + (lane >> 5); float v = W[(size_t)(k0 + kk) * spitch + n0 + (lane & 31)]; if (gain) v *= gain[k0 + kk]; scr[kk * 33 + (lane & 31)] = v; }
    LDS_WAIT(); asm volatile("" ::: "memory");
    const int c = lane & 7;
#pragma unroll
    for (int j = 0; j < 4; ++j) { const int n = (lane >> 3) + 8 * j; const LAS float* s = scr + (8 * c) * 33 + n;
        v4u o; o.x = pk2(s[0 * 33], s[1 * 33]); o.y = pk2(s[2 * 33], s[3 * 33]); o.z = pk2(s[4 * 33], s[5 * 33]); o.w = pk2(s[6 * 33], s[7 * 33]);
        *(v4u*)(WT + (size_t)(drow0 + n) * dpitch + k0 + 8 * c) = o; }
    LDS_WAIT(); asm volatile("" ::: "memory");
}
__device__ __forceinline__ void conv_job(int& it, int& base, int NGW, const float* W, int spitch, int K, int scol0, int ncols, bf16* WT, int doff, bool ilv, const float* gain, LAS float* scr, int lane) {
    const int nblk = ncols / 32, nitems = (K / 64) * nblk;
    for (; it < base + nitems; it += NGW) { const int r = it - base, kb = r / nblk, nb = r % nblk, nl = 32 * nb;
        const int drow0 = ilv ? (256 * (nl / 128) + (nl % 128) + doff) : (doff + nl);
        conv_item(W, spitch, 64 * kb, scol0 + nl, WT, K, drow0, gain, scr, lane); }
    base += nitems;
}

__device__ __forceinline__ int attn_skip_tiles(const float* csh, int qb, float R) {
    const int ntf = 4 * (qb + 1); const float thr = csh[256 * qb] + 152.0f + 2.0f * R;
    int lo_ = 0, hi_ = ntf - 4;
    while (lo_ < hi_) { const int mid = (lo_ + hi_) >> 1; if (csh[64 * mid + 63] > thr) lo_ = mid + 1; else hi_ = mid; }
    return lo_ & ~1;
}
__device__ __forceinline__ int attn_chunks(int len) { int n = (len + 63) >> 6; if (n > 1 && len - 64 * (n - 1) < 4) --n; return n; }
__global__ void __launch_bounds__(NTHREADS, 2) mk_fwd(Args args) {
    __builtin_assume(__builtin_amdgcn_workitem_id_y() == 0); __builtin_assume(__builtin_amdgcn_workitem_id_z() == 0);
    extern __shared__ __attribute__((aligned(16))) unsigned char lds[];
    cg::grid_group grid = cg::this_grid();
    LAS unsigned char* ldsp = (LAS unsigned char*)lds;
    if (threadIdx.x < 2) ((volatile LAS unsigned*)(ldsp + XB_LDS_OFF))[threadIdx.x] = 0u;
    __syncthreads();
    const XcdBarrier xbar = xcd_barrier_post((unsigned*)args.ws, (volatile LAS unsigned*)(ldsp + XB_LDS_OFF));
    const int G = gridDim.x, bx = blockIdx.x;
    const int vcu = (G % 8 == 0) ? (bx % 8) * (G / 8) + bx / 8 : bx;
    const int NGW = G * NWAVES;
#define TIDS() int tid_o = threadIdx.x; asm volatile("" : "+v"(tid_o)); const int tid = tid_o, lane = tid & 63, wave = __builtin_amdgcn_readfirstlane(tid >> 6), gw = vcu * NWAVES + wave; (void)gw; (void)lane; (void)tid
#define KARGS() const __attribute__((address_space(4))) Args* ap_ = (const __attribute__((address_space(4))) Args*)__builtin_amdgcn_kernarg_segment_ptr(); asm volatile("" : "+s"(ap_))
#define ws (ap_->ws)
#define X (ap_->out)
#define SS ((float*)(ws + WS_SS))
#define SSV ((float*)(ws + WS_SSV))
#define LF ((float*)(ws + WS_LF))
#define CS ((float*)(ws + WS_CS))
#define RSM ((float*)(ws + WS_RSM))
#define MEMB ((bf16*)(ws + WS_MEMB))
#define KC ((bf16*)(ws + WS_KC))
#define VCT ((bf16*)(ws + WS_VCT))
#define Wt ((bf16*)(ws + WS_W))
#define XB ((bf16*)(ws + WS_XB))
#define SCR ((bf16*)(ws + WS_SCR))
#define ACT SCR
#define PROJ SCR
#define GT (SCR + 3 * PIECE)
#define XQ SCR
#define PB (SCR + (size_t)M * 1024)
#define OB (SCR + (size_t)2 * M * 1024)
    const int lo = args.ph_lo, hi = args.ph_hi;
#ifndef PHMASK
#define PHMASK 0xffff
#endif
#define IN(k) (((PHMASK >> (((k) == 30) ? 15 : ((k) - pb == 13 || (k) - pb == 14) ? (k) - pb - 12 : (k) - pb)) & 1) && lo <= (k) && (k) < hi)
#define GRID_SYNC() do { asm volatile("s_waitcnt vmcnt(0) lgkmcnt(0)" ::: "memory"); grid.sync(); } while (0)
#define WG_SEAM() do { asm volatile("s_waitcnt vmcnt(0) lgkmcnt(0)" ::: "memory"); __syncthreads(); } while (0)
#define SEAM_LOCAL(k) do { if (lo <= (k) && (k) + 1 < hi) { if (G == 256) WG_SEAM(); else xcd_barrier(xbar); } } while (0)
#define SEAM(k) do { if (lo <= (k) && (k) + 1 < hi) { if ((k) == 0) GRID_SYNC(); else xcd_barrier(xbar); } } while (0)
#define in (ap_->in)
int pb = 0;
#pragma nounroll
    for (int l = 0; l < NLAYER; ++l) {
        pb = 15 * l;
        if (IN(pb + 0)) { KARGS(); TIDS();
            LAS float* scr = (LAS float*)(ldsp + wave * 16384);
            const size_t l1 = (size_t)l * 1024, lff = (size_t)l * 1024 * 2816, ldd = (size_t)l * 1024 * 1024;
            constexpr int NB_FF = FF / 32, I_UP = 16 * NB_FF, I_DN = (FF / 64) * 32, I_IN = 16 * 128, I_G = 16 * 96, I_B = 8 * 32, I_SQ = 16 * 32;
            constexpr int NIT = 4 * I_UP + 2 * I_DN + I_IN + I_G + 3 * I_B + 5 * I_SQ;
#pragma nounroll
            for (int it = gw; it < NIT; it += NGW) {
                int r = it; const float* W; const float* gain = nullptr; bf16* WT; int spitch, K, scol0 = 0, nblk, doff = 0; bool ilv = false;
                if (r < 2 * I_UP) { const int w = r / I_UP; r -= w * I_UP; W = in[3 + w] + lff; gain = in[2] + l1; WT = Wt + WO_GU1; spitch = FF; K = 1024; nblk = NB_FF; doff = 128 * w; ilv = true; }
                else if ((r -= 2 * I_UP) < I_DN) { W = in[5] + lff; WT = Wt + WO_D1; spitch = 1024; K = FF; nblk = 32; }
                else if ((r -= I_DN) < I_IN) { W = in[7] + (size_t)l * 1024 * DIN; gain = in[6] + l1; WT = Wt + WO_IN; spitch = DIN; K = 1024; nblk = 128; }
                else if ((r -= I_IN) < I_G) { W = in[7] + (size_t)l * 1024 * DIN; gain = in[6] + l1; WT = Wt + WO_G; spitch = DIN; K = 1024; nblk = 96; scol0 = 4104; }
                else if ((r -= I_G) < 3 * I_B) { const int w = r / I_B; r -= w * I_B; W = in[13] + ((size_t)l * 3 + w) * 512 * 1024; WT = Wt + WO_B + (size_t)w * 1024 * 512; spitch = 1024; K = 512; nblk = 32; }
                else if ((r -= 3 * I_B) < I_SQ) { W = in[14] + ldd; WT = Wt + WO_O; spitch = 1024; K = 1024; nblk = 32; }
                else if ((r -= I_SQ) < I_SQ) { W = in[17] + ldd; gain = in[15] + l1; WT = Wt + WO_Q; spitch = 1024; K = 1024; nblk = 32; }
                else if ((r -= I_SQ) < 2 * I_SQ) { const int w = r / I_SQ; r -= w * I_SQ; W = in[18 + w] + ldd; gain = in[16] + l1; WT = Wt + WO_K + (size_t)w * 1024 * 1024; spitch = 1024; K = 1024; nblk = 32; }
                else if ((r -= 2 * I_SQ) < I_SQ) { W = in[20] + ldd; WT = Wt + WO_XO; spitch = 1024; K = 1024; nblk = 32; }
                else if ((r -= I_SQ) < 2 * I_UP) { const int w = r / I_UP; r -= w * I_UP; W = in[22 + w] + lff; gain = in[21] + l1; WT = Wt + WO_GU2; spitch = FF; K = 1024; nblk = NB_FF; doff = 128 * w; ilv = true; }
                else { r -= 2 * I_UP; W = in[24] + lff; WT = Wt + WO_D2; spitch = 1024; K = FF; nblk = 32; }
                const int kb = r / nblk, nl = 32 * (r % nblk);
                const int drow0 = ilv ? (256 * (nl / 128) + (nl % 128) + doff) : (doff + nl);
                conv_item(W, spitch, 64 * kb, scol0 + nl, WT, K, drow0, gain, scr, lane);
            }
            {
                const float* wf = in[7] + (size_t)l * 1024 * DIN + 4096; const float* gn = in[6] + l1; bf16* WF = Wt + WO_END;
                for (int idx = vcu * NTHREADS + tid; idx < 8192; idx += G * NTHREADS) { const int k = idx >> 3, hd = idx & 7;
                    const float v = wf[(size_t)k * DIN + hd] * gn[k]; const unsigned hb = f2bf(v); const float lo = v - __uint_as_float(hb << 16);
                    WF[(size_t)hd * 1024 + k] = (bf16)hb; WF[(size_t)(8 + hd) * 1024 + k] = (bf16)f2bf(lo); }
            }
            if (l == 0) {
                for (int m = gw; m < M + MEML; m += NGW) {
                    const bool ism = m >= M; const int r = ism ? m - M : m;
                    const f32x4* xr = (const f32x4*)((ism ? in[1] : in[0]) + (size_t)r * D) + lane;
                    f32x4 v[4]; float s = 0.f;
#pragma unroll
                    for (int j = 0; j < 4; ++j) { v[j] = xr[64 * j]; s += (v[j][0] * v[j][0] + v[j][1] * v[j][1]) + (v[j][2] * v[j][2] + v[j][3] * v[j][3]); }
                    s = wave_sum(s);
                    v2u* ob = (v2u*)((ism ? MEMB : XB) + (size_t)r * D) + lane;
#pragma unroll
                    for (int j = 0; j < 4; ++j) { v2u w; w.x = pk2(v[j][0], v[j][1]); w.y = pk2(v[j][2], v[j][3]); ob[64 * j] = w; }
                    if (!ism) {
                        if (lane < 16) SS[(size_t)r * 16 + lane] = lane == 0 ? s : 0.f;
                    } else if (lane == 0) RSM[r] = rsqrtf(s * (1.0f / D) + EPS);
                }
            }
        }
        SEAM(pb + 0);
#pragma nounroll
        for (int f = 0; f < 2; ++f) {
            const int pu = pb + (f == 0 ? 1 : 13), pd = pu + 1;
            if (IN(pu)) { KARGS();
                { pg8::Gemm g{XB, Wt + (f == 0 ? WO_GU1 : WO_GU2), 1024, 1024, 1024, 0, 0}; pg8::StaticOrder S; S.init(M / 256, 22, G, bx);
                  pg8::EpiSwiGLU E{SS, ACT};
#ifndef MK_REP_UP
#define MK_REP_UP 1
#endif
_Pragma("nounroll")
                  for (int rep = 0; rep < MK_REP_UP; ++rep) pg8::gemm_phase<pg8::EpiSwiGLU, pg8::StaticOrder, true, true>(ldsp, g, S, E); }
                if (f == 0) {
                    { pg8::Gemm g{MEMB, Wt + WO_K, 1024, 1024, 1024, 0, 0}; pg8::StaticOrder S; S.init(1, 4, G, bx);
                      pg8::EpiScale<2> E{RSM, KC, 1024, 1.0f}; pg8::gemm_phase<pg8::EpiScale<2>, pg8::StaticOrder, true, true>(ldsp, g, S, E); }
                    { pg8::Gemm g{Wt + WO_V, MEMB, 1024, 1024, 1024, 0, 0}; pg8::StaticOrder S; S.init(4, 1, G, bx);
                      pg8::EpiScale<3> E{RSM, VCT, 256, 1.0f}; pg8::gemm_phase<pg8::EpiScale<3>, pg8::StaticOrder, true, true>(ldsp, g, S, E); }
                }
            }
            SEAM(pu);
            if (IN(pd)) { KARGS();
                pg8::Gemm g{ACT, Wt + (f == 0 ? WO_D1 : WO_D2), FF, FF, FF, 0, 0}; pg8::StaticOrder S; S.init(M / 256, 4, G, bx);
                pg8::EpiResid E{XB, SS, 0.5f}; pg8::gemm_phase<pg8::EpiResid, pg8::StaticOrder, true, true>(ldsp, g, S, E);
            }
            SEAM(pd);
            if (f == 1) break;
            if (IN(pb + 3)) { KARGS();
                { TIDS();
                    const float* bfp = in[12] + l * 8; const bf16* WF = Wt + WO_END; const int fr = lane & 15, fq = lane >> 4;
                    for (int tile = gw; tile < M / 16; tile += NGW) {
                        const int row = 16 * tile + fr;
                        const bf16* ap = XB + (size_t)row * D + 8 * fq; const bf16* bp = WF + (size_t)fr * D + 8 * fq;
                        f32x4 acc = {0.f, 0.f, 0.f, 0.f};
#pragma unroll 8
                        for (int ks = 0; ks < 32; ++ks) { const bf16x8 a = *(const bf16x8*)(ap + 32 * ks), b = *(const bf16x8*)(bp + 32 * ks); acc = __builtin_amdgcn_mfma_f32_16x16x32_bf16(b, a, acc, 0, 0, 0); }
                        const float rs = pg8::row_rstd1(SS, row, fq);
#pragma unroll
                        for (int j = 0; j < 4; ++j) { const float t = acc[j] + __shfl_xor(acc[j], 32);
                            if (fq < 2) { const int hd = 4 * fq + j; const float z = t * rs + bfp[hd]; LF[(size_t)hd * M + row] = fminf(z, 0.f) - log1pf(expf(-fabsf(z))); } }
                    }
                }
                pg8::Gemm g{XB, Wt + WO_IN, 1024, 1024, 1024, 0, 0}; pg8::StaticOrder S; S.init(M / 256, 16, G, bx);
                pg8::EpiWin E{SS, PROJ, SSV, 0.125f * LOG2E}; pg8::gemm_phase<pg8::EpiWin, pg8::StaticOrder, true, true>(ldsp, g, S, E);
            }
            SEAM(pb + 3);
            if (IN(pb + 4)) { KARGS(); TIDS();
                if (bx < 8) {
                    const float* lf = LF + (size_t)bx * M + tid * 32; float* cs = CS + (size_t)bx * M + tid * 32;
                    f32x4 v[8]; float run = 0.f;
#pragma unroll
                    for (int i = 0; i < 8; ++i) { v[i] = *(const f32x4*)(lf + 4 * i);
#pragma unroll
                        for (int e = 0; e < 4; ++e) { run += v[i][e]; v[i][e] = run; } }
                    const double tot = (double)run; double incl = tot;
#pragma unroll
                    for (int o = 1; o < 64; o <<= 1) { const double t = __shfl_up(incl, o); if (lane >= o) incl += t; }
                    LAS double* wsum = (LAS double*)ldsp;
                    if (lane == 63) wsum[wave] = incl;
                    __syncthreads();
                    double bsum = 0.0;
                    for (int w = 0; w < wave; ++w) bsum += wsum[w];
                    const double excl = bsum + incl - tot;
#pragma unroll
                    for (int i = 0; i < 8; ++i) { f32x4 o;
#pragma unroll
                        for (int e = 0; e < 4; ++e) o[e] = (float)((excl + (double)v[i][e]) * 1.4426950408889634);
                        *(f32x4*)(cs + 4 * i) = o; }
                    __syncthreads();
                }
                {
                    unsigned* KM = (unsigned*)(ws + 32768) + 8 * l;
                    for (int idx = vcu * NTHREADS + tid; idx < 2 * M * 8; idx += G * NTHREADS) {
                        const int isq = idx >= M * 8, id2 = idx - isq * M * 8; const bf16* Kp = PROJ + (isq ? 8 : 6) * PIECE;
                        const v4u* kp = (const v4u*)(Kp + (size_t)(id2 >> 3) * 512 + (id2 & 7) * 64); float s = 0.f;
#pragma unroll
                        for (int q = 0; q < 8; ++q) { const v4u w = kp[q];
#pragma unroll
                            for (int e = 0; e < 4; ++e) { const float a = pg8::bflo(w[e]), b = pg8::bfhi(w[e]); s += a * a + b * b; } }
                        s = fmaxf(s, __shfl_xor(s, 8)); s = fmaxf(s, __shfl_xor(s, 16)); s = fmaxf(s, __shfl_xor(s, 32));
                        if (lane < 8) atomicMax(KM + 64 * isq + lane, __float_as_uint(s));
                    }
                }
                {
                    bf16* AB = PROJ; const bf16* AC = PROJ + 3 * PIECE; const bf16* AH = PROJ + 4 * PIECE; const float* cw = in[8] + (size_t)l * 3 * 512;
                    for (int idx = vcu * NTHREADS + tid; idx < M * 64; idx += G * NTHREADS) {
                        const int t = idx >> 6, c8 = (idx & 63) * 8; const size_t off = (size_t)t * 512 + c8;
                        const v4u bw = *(const v4u*)(AB + off);
                        float zz[3][8];
#pragma unroll
                        for (int d = 0; d < 3; ++d) {
                            if (t - d >= 0) { const v4u cv = *(const v4u*)(AC + off - (size_t)d * 512), hv = *(const v4u*)(AH + off - (size_t)d * 512);
#pragma unroll
                                for (int e = 0; e < 4; ++e) { zz[d][2 * e] = pg8::bflo(cv[e]) * pg8::bflo(hv[e]); zz[d][2 * e + 1] = pg8::bfhi(cv[e]) * pg8::bfhi(hv[e]); } }
                            else {
#pragma unroll
                                for (int e = 0; e < 8; ++e) zz[d][e] = 0.f; }
                        }
                        float y[8];
#pragma unroll
                        for (int e = 0; e < 8; ++e) { const float b = (e & 1) ? pg8::bfhi(bw[e >> 1]) : pg8::bflo(bw[e >> 1]);
                            y[e] = b * (cw[c8 + e] * zz[2][e] + cw[512 + c8 + e] * zz[1][e] + cw[1024 + c8 + e] * zz[0][e]); }
                        v4u o; o.x = pk2(y[0], y[1]); o.y = pk2(y[2], y[3]); o.z = pk2(y[4], y[5]); o.w = pk2(y[6], y[7]);
                        *(v4u*)(AB + off) = o;
                    }
                }
                {
                    bf16* UU = PROJ + 1 * PIECE; const bf16* VV = PROJ + 5 * PIECE; const float* sgn = in[9] + (size_t)l * 512; const float* sgw = in[10] + (size_t)l * 4 * 128 * 128; const float* sgb = in[11] + (size_t)l * 4 * 128;
                    LAS bf16* T = (LAS bf16*)ldsp;
                    const int fr = lane & 15, fq = lane >> 4;
                    for (int unit = vcu; unit < 512; unit += G) {
                        const int n = unit >> 2, gI = unit & 3;
                        { const int s = tid >> 2, cg0 = (tid & 3) * 32, row = 128 * n + s;
                          const f32x4 p0 = *(const f32x4*)(SSV + (size_t)row * 8), p1 = *(const f32x4*)(SSV + (size_t)row * 8 + 4);
                          const float rv = rsqrtf(((p0[0] + p0[1]) + (p0[2] + p0[3]) + (p1[0] + p1[1]) + (p1[2] + p1[3])) * (1.0f / 512.0f) + EPS);
#pragma unroll
                          for (int q = 0; q < 4; ++q) { const int c = cg0 + 8 * q; const v4u vw = *(const v4u*)(VV + (size_t)row * 512 + 128 * gI + c);
                              const f32x4 ga = *(const f32x4*)(sgn + 128 * gI + c), gb = *(const f32x4*)(sgn + 128 * gI + c + 4);
#pragma unroll
                              for (int e = 0; e < 4; ++e) { const float g0 = e < 2 ? ga[2 * e] : gb[2 * e - 4], g1 = e < 2 ? ga[2 * e + 1] : gb[2 * e - 3];
                                  T[(c + 2 * e) * 136 + s] = (bf16)f2bf(pg8::bflo(vw[e]) * rv * g0); T[(c + 2 * e + 1) * 136 + s] = (bf16)f2bf(pg8::bfhi(vw[e]) * rv * g1); } } }
                        __syncthreads();
                        f32x4 acc[8];
#pragma unroll
                        for (int j = 0; j < 8; ++j) acc[j] = (f32x4){0.f, 0.f, 0.f, 0.f};
                        const int t = 16 * wave + fr;
                        for (int kk = 0; kk <= (wave >> 1); ++kk) {
                            const int s0 = 32 * kk + 8 * fq; const float* wp = sgw + ((size_t)gI * 128 + t) * 128 + s0;
                            const f32x4 w0 = *(const f32x4*)wp, w1 = *(const f32x4*)(wp + 4);
                            float wv[8] = {w0[0], w0[1], w0[2], w0[3], w1[0], w1[1], w1[2], w1[3]};
#pragma unroll
                            for (int e = 0; e < 8; ++e) if (s0 + e > t) wv[e] = 0.f;
                            v4u aw; aw.x = pk2(wv[0], wv[1]); aw.y = pk2(wv[2], wv[3]); aw.z = pk2(wv[4], wv[5]); aw.w = pk2(wv[6], wv[7]);
                            const bf16x8 afr = __builtin_bit_cast(bf16x8, aw);
#pragma unroll
                            for (int j = 0; j < 8; ++j) { const bf16x8 bfr = *(const LAS bf16x8*)(T + (16 * j + fr) * 136 + s0); acc[j] = __builtin_amdgcn_mfma_f32_16x16x32_bf16(bfr, afr, acc[j], 0, 0, 0); }
                        }
                        const float bias = sgb[gI * 128 + t]; const size_t rowoff = (size_t)(128 * n + t) * 512 + 128 * gI;
#pragma unroll
                        for (int j = 0; j < 8; ++j) { const int c = 16 * j + 4 * fq; const v2u uw = *(const v2u*)(UU + rowoff + c);
                            v2u o; o.x = pk2(pg8::bflo(uw.x) * (acc[j][0] + bias), pg8::bfhi(uw.x) * (acc[j][1] + bias)); o.y = pk2(pg8::bflo(uw.y) * (acc[j][2] + bias), pg8::bfhi(uw.y) * (acc[j][3] + bias));
                            *(v2u*)(UU + rowoff + c) = o; }
                        __syncthreads();
                    }
                }
            }
            SEAM(pb + 4);
            if (IN(pb + 5)) { KARGS();
                TIDS();
                const attn_body::AttnTensors AT{(const attn_body::bf16*)(PROJ + 8 * PIECE), (const attn_body::bf16*)(PROJ + 6 * PIECE), (const attn_body::bf16*)(PROJ + 7 * PIECE), (attn_body::bf16*)(PROJ + 2 * PIECE), CS, (const unsigned*)(ws + 32768) + 8 * l};
                unsigned* qctr = (unsigned*)(ws + 40960) + 64 * l;
                volatile LAS unsigned* qw = (volatile LAS unsigned*)(ldsp + XB_LDS_OFF + 64);
                volatile LAS unsigned* T0 = (volatile LAS unsigned*)(ldsp + T0_LDS_OFF);
                {   const int hd = tid & 7, qb = 63 - (tid >> 3);
                    const float km2 = __uint_as_float(__hip_atomic_load(AT.KM + hd, __ATOMIC_RELAXED, __HIP_MEMORY_SCOPE_AGENT)), qm2 = __uint_as_float(__hip_atomic_load(AT.KM + 64 + hd, __ATOMIC_RELAXED, __HIP_MEMORY_SCOPE_AGENT));
                    T0[tid] = (unsigned)attn_skip_tiles(CS + (size_t)hd * M, qb, sqrtf(km2 * qm2) * 1.001f + 0.01f); }
                __syncthreads();
#pragma nounroll
                for (;;) {
                    if (tid == 0) qw[0] = __hip_atomic_fetch_add(qctr, 1u, __ATOMIC_RELAXED, __HIP_MEMORY_SCOPE_AGENT);
                    __syncthreads();
                    const unsigned idx = qw[0];
                    __syncthreads();
                    if (idx >= 2048u) break;
                    const int c = (int)(idx >> 9), un = (int)(idx & 511u), qb = 63 - (un >> 3), hd = un & 7, ntf = 4 * (qb + 1);
                    const int t0 = (int)T0[un], len = ntf - t0, n = attn_chunks(len);
                    if (c >= n) continue;
                    const bool last = (c == n - 1); const int tb = t0 + 64 * c, ntl = last ? ntf - tb : 64;
                    attn_body::bf16* Oc = (attn_body::bf16*)(PROJ + (last ? 2 : 3 + c) * PIECE);
                    float* Lc = last ? (float*)(ws + WS_LPL) : (float*)(ws + WS_LP) + (size_t)c * M * 8;
                    attn_body::attn_unit<8>(0, hd, qb, AT.Q, AT.K, AT.V, Oc, CS, AT.KM, (char*)lds, tb, ntl, last, Lc);
                }
                __syncthreads();
            }
            SEAM(pb + 5);
            if (IN(pb + 6)) { KARGS();
                {
                    TIDS(); const unsigned* KMp = (const unsigned*)(ws + 32768) + 8 * l;
                    for (int un = vcu; un < 512; un += G) {
                        const int qb = 63 - (un >> 3), hd = un & 7, ntf = 4 * (qb + 1);
                        const float km2 = __uint_as_float(__hip_atomic_load(KMp + hd, __ATOMIC_RELAXED, __HIP_MEMORY_SCOPE_AGENT)), qm2 = __uint_as_float(__hip_atomic_load(KMp + 64 + hd, __ATOMIC_RELAXED, __HIP_MEMORY_SCOPE_AGENT));
                        const int t0 = attn_skip_tiles(CS + (size_t)hd * M, qb, sqrtf(km2 * qm2) * 1.001f + 0.01f), n = attn_chunks(ntf - t0);
                        if (n <= 1) continue;
                        for (int it = tid; it < 2048; it += NTHREADS) { const int row = 256 * qb + (it >> 3); const size_t off = (size_t)row * 512 + hd * 64 + (it & 7) * 8;
                            float lw = ((const float*)(ws + WS_LPL))[(size_t)row * 8 + hd], ls = lw; const v4u yw = *(const v4u*)(PROJ + 2 * PIECE + off);
                            float y[8];
#pragma unroll
                            for (int e = 0; e < 4; ++e) { y[2 * e] = pg8::bflo(yw[e]) * lw; y[2 * e + 1] = pg8::bfhi(yw[e]) * lw; }
                            for (int c = 0; c < n - 1; ++c) { const float lc = ((const float*)(ws + WS_LP))[((size_t)c * M + row) * 8 + hd]; ls += lc; const v4u pw = *(const v4u*)(PROJ + (size_t)(3 + c) * PIECE + off);
#pragma unroll
                                for (int e = 0; e < 4; ++e) { y[2 * e] += pg8::bflo(pw[e]) * lc; y[2 * e + 1] += pg8::bfhi(pw[e]) * lc; } }
                            const float inv = 1.0f / ls; v4u o; o.x = pk2(y[0] * inv, y[1] * inv); o.y = pk2(y[2] * inv, y[3] * inv); o.z = pk2(y[4] * inv, y[5] * inv); o.w = pk2(y[6] * inv, y[7] * inv);
                            *(v4u*)(PROJ + 2 * PIECE + off) = o; }
                    }
                }
                pg8::Gemm g{XB, Wt + WO_G, 1024, 1024, 1024, 0, 0}; pg8::StaticOrder S; S.init(M / 256, 12, G, bx);
                pg8::EpiGates E{SS, GT}; pg8::gemm_phase<pg8::EpiGates, pg8::StaticOrder, true, true>(ldsp, g, S, E);
            }
            SEAM(pb + 6);
            if (IN(pb + 7)) { KARGS();
                pg8::Gemm g{PROJ, Wt + WO_B, 512, 512, 512, PIECE * 2, (size_t)1024 * 512 * 2}; pg8::ZOrder<3> S; S.S.init(M / 256, 4, G, bx);
                pg8::EpiMerge E{GT}; pg8::gemm_phase<pg8::EpiMerge, pg8::ZOrder<3>, true, true>(ldsp, g, S, E);
            }
            SEAM(pb + 7);
            if (IN(pb + 8)) { KARGS();
                pg8::Gemm g{GT, Wt + WO_O, 1024, 1024, 1024, 0, 0}; pg8::StaticOrder S; S.init(M / 256, 4, G, bx);
                pg8::EpiResid E{XB, SS, 1.0f}; pg8::gemm_phase<pg8::EpiResid, pg8::StaticOrder, true, true>(ldsp, g, S, E);
            }
            SEAM(pb + 8);
            if (IN(pb + 9)) { KARGS();
                pg8::Gemm g{XB, Wt + WO_Q, 1024, 1024, 1024, 0, 0}; pg8::EpiScale<1> E{SS, XQ, 1024, 0.0625f * LOG2E};
                for (int Lx = vcu; Lx < 256; Lx += G) { pg8::OneUnit S; S.u0.pm = Lx >> 2; S.u0.pn = Lx & 3; S.u0.z = 0; pg8::gemm_phase<pg8::EpiScale<1>, pg8::OneUnit, true, true>(ldsp, g, S, E); }
            }
            SEAM_LOCAL(pb + 9);
            if (IN(pb + 10)) { KARGS();
                pg8::Gemm g{XQ, KC, 256, 1024, 1024, 512, 512}; pg8::EpiSoftmax E{PB};
                for (int Lx = vcu; Lx < 256; Lx += G) { pg8::OneUnit S; S.u0.pm = Lx >> 2; S.u0.pn = 0; S.u0.z = Lx & 3; pg8::gemm_phase<pg8::EpiSoftmax, pg8::OneUnit, false, true>(ldsp, g, S, E); }
            }
            SEAM_LOCAL(pb + 10);
            if (IN(pb + 11)) { KARGS();
                pg8::Gemm g{PB, VCT, 256, 1024, 256, 512, (size_t)256 * 256 * 2}; pg8::EpiScale<0> E{nullptr, OB, 1024, 1.0f};
                for (int Lx = vcu; Lx < 256; Lx += G) { pg8::OneUnit S; S.u0.pm = Lx >> 2; S.u0.pn = 0; S.u0.z = Lx & 3; pg8::gemm_phase<pg8::EpiScale<0>, pg8::OneUnit, true, true>(ldsp, g, S, E); }
            }
            SEAM(pb + 11);
            if (IN(pb + 12)) { KARGS();
                pg8::Gemm g{OB, Wt + WO_XO, 1024, 1024, 1024, 0, 0}; pg8::StaticOrder S; S.init(M / 256, 4, G, bx);
                pg8::EpiResid E{XB, SS, 1.0f}; pg8::gemm_phase<pg8::EpiResid, pg8::StaticOrder, true, true>(ldsp, g, S, E);
            }
            SEAM(pb + 12);
        }
    }
#ifdef MK_DUMP_OFF
    {
        GRID_SYNC(); KARGS(); int t_ = threadIdx.x; asm volatile("" : "+v"(t_));
        const bf16* src = SCR + (size_t)(MK_DUMP_OFF);
        for (unsigned i = blockIdx.x * 512u + (unsigned)t_; i < (unsigned)M * 1024u; i += gridDim.x * 512u) { const unsigned m = i >> 10, c = i & 1023u;
            X[i] = c < (unsigned)(MK_DUMP_LD) ? b2f(src[(size_t)m * (MK_DUMP_LD) + c]) : 0.f; }
    }
#endif
    if (IN(30)) { KARGS(); TIDS();
        const float* gf = in[25];
        for (int m = gw; m < M; m += NGW) {
            const v2u* xb = (const v2u*)(XB + (size_t)m * D) + lane; f32x4* xr = (f32x4*)(X + (size_t)m * D) + lane; f32x4 v[4]; float s = 0.f;
#pragma unroll
            for (int j = 0; j < 4; ++j) { const v2u xw = xb[64 * j]; v[j] = (f32x4){pg8::bflo(xw.x), pg8::bfhi(xw.x), pg8::bflo(xw.y), pg8::bfhi(xw.y)}; s += (v[j][0] * v[j][0] + v[j][1] * v[j][1]) + (v[j][2] * v[j][2] + v[j][3] * v[j][3]); }
            const float r = rsqrtf(wave_sum(s) * (1.0f / D) + EPS);
#pragma unroll
            for (int j = 0; j < 4; ++j) xr[64 * j] = v[j] * r * *((const f32x4*)gf + lane + 64 * j);
        }
    }
#undef IN
#undef SEAM
#undef ws
#undef X
#undef SS
#undef SSV
#undef LF
#undef CS
#undef RSM
#undef MEMB
#undef KC
#undef VCT
#undef Wt
#undef XB
#undef SCR
#undef ACT
#undef PROJ
#undef GT
#undef XQ
#undef PB
#undef OB
#undef in
}

#ifndef MK_PER_PHASE
#define MK_PER_PHASE 0
#endif
extern "C" void kernel_launch(void* const* d_in, const int* in_sizes, int n_in, void* d_out, int out_size, void* d_ws, size_t ws_size, hipStream_t stream) {
    static int grid = 0;
    if (grid == 0) {
        if (n_in != 26 || out_size != M * D || ws_size < WS_END) { fprintf(stderr, "kernel_launch: unexpected shapes (n_in %d out %d ws %zu)\n", n_in, out_size, ws_size); grid = -1; return; }
        int dev = 0, cus = 0, per_cu = 0;
        (void)hipGetDevice(&dev); (void)hipDeviceGetAttribute(&cus, hipDeviceAttributeMultiprocessorCount, dev);
        if (hipFuncSetAttribute((const void*)mk_fwd, hipFuncAttributeMaxDynamicSharedMemorySize, LDS_BYTES) != hipSuccess) { fprintf(stderr, "kernel_launch: hipFuncSetAttribute failed\n"); grid = -1; return; }
        if (hipOccupancyMaxActiveBlocksPerMultiprocessor(&per_cu, (const void*)mk_fwd, NTHREADS, LDS_BYTES) != hipSuccess || per_cu < 1) { fprintf(stderr, "kernel_launch: occupancy query says %d\n", per_cu); per_cu = 1; }
        (void)hipGetLastError();
        grid = cus > 0 ? cus : 256;
    }
    if (grid < 0) return;
    (void)hipMemsetAsync(d_ws, 0, 65536, stream);
    Args a{};
    for (int i = 0; i < 26; ++i) a.in[i] = (const float*)d_in[i];
    a.out = (float*)d_out; a.ws = (unsigned char*)d_ws;
#if MK_PER_PHASE
    for (int p = 0; p < 31; ++p) { a.ph_lo = p; a.ph_hi = p + 1; void* kargs[] = {&a};
        hipError_t e = hipLaunchCooperativeKernel((const void*)mk_fwd, dim3(grid), dim3(NTHREADS), kargs, LDS_BYTES, stream);
        if (e != hipSuccess) { fprintf(stderr, "launch %d failed: %s\n", p, hipGetErrorString(e)); break; } }
#else
#ifndef MK_PH_HI
#define MK_PH_HI 31
#endif
    a.ph_lo = 0; a.ph_hi = MK_PH_HI; void* kargs[] = {&a};
    hipError_t e = hipLaunchCooperativeKernel((const void*)mk_fwd, dim3(grid), dim3(NTHREADS), kargs, LDS_BYTES, stream);
    if (e != hipSuccess) fprintf(stderr, "cooperative launch failed: %s (grid %d)\n", hipGetErrorString(e), grid);
#endif
}
```

```cpp
#include <hip/hip_runtime.h>
#include <hip/hip_cooperative_groups.h>
#include <cstdio>
#include <cstdint>
namespace cg = cooperative_groups;

namespace pg8 {
#define PG8_LAS __attribute__((address_space(3)))
typedef unsigned short bf16_t;
typedef short bf16x8 __attribute__((ext_vector_type(8)));
typedef float f32x4 __attribute__((ext_vector_type(4)));
typedef unsigned u32x4 __attribute__((ext_vector_type(4)));
constexpr int BM = 256, BK = 64, HALF = 128, HTB = HALF * BK * 2  , STAGE_BYTES = 8 * HTB, NXCD = 8, WGM = 8;

__host__ __device__ __forceinline__ int lds_byte(int r, int c) { const int st = (r >> 4) * 2 + (c >> 5), rr = r & 15, cc = c & 31, ob = rr * 64 + cc * 2; return st * 1024 + (ob ^ (((ob >> 9) & 1) << 5)); }
__host__ __device__ __forceinline__ void stage_rc(int b, int& R, int& C) { const int st = b / 1024, sb = b % 1024, swz = sb ^ (((sb >> 9) & 1) << 5); R = (st >> 1) * 16 + swz / 64; C = (st & 1) * 32 + (swz % 64) / 2; }
__host__ __device__ __forceinline__ int perm32(int rho) { const int n = rho >> 4, i = rho & 15; return 8 * (i >> 2) + 4 * n + (i & 3); }

struct Unit { int pm, pn, z; };
typedef float f32x2 __attribute__((ext_vector_type(2))); typedef __bf16 bf16x2_cv __attribute__((ext_vector_type(2)));
__device__ __forceinline__ unsigned cvt_pk_bf16(float lo, float hi) { const f32x2 v = {lo, hi}; const bf16x2_cv b = __builtin_convertvector(v, bf16x2_cv); return __builtin_bit_cast(unsigned, b); }
struct Gemm { const bf16_t* A; const bf16_t* Bt; int K, lda, ldb; size_t zA, zB; };

struct StaticOrder {
    int nM, nN, nwg, G, c;
    __host__ __device__ void init(int nM_, int nN_, int G_, int c_) { nM = nM_; nN = nN_; nwg = nM * nN; G = G_; c = c_; }
    __host__ __device__ void map(int wgid, Unit& u) const {
        { const int q = nwg / NXCD, r = nwg % NXCD, xcd = wgid % NXCD, off = wgid / NXCD; wgid = (xcd < r ? xcd * (q + 1) : r * (q + 1) + (xcd - r) * q) + off; }
        const int nig = WGM * nN, gid = wgid / nig, fm = gid * WGM, gsz = (nM - fm) < WGM ? (nM - fm) : WGM;
        u.pm = fm + ((wgid % nig) % gsz); u.pn = (wgid % nig) / gsz; u.z = 0;
    }
    __host__ __device__ bool next(int i, Unit& u) const { const long L = (long)i * G + c; if (L >= nwg) return false; map((int)L, u); return true; }
    __device__ __forceinline__ void a_ready(const Unit&) const {}
    __device__ __forceinline__ void done(const Unit&) const {}
};
template <int NZ> struct ZOrder {
    StaticOrder S;
    __host__ __device__ bool next(int i, Unit& u) const { const long L = (long)(i / NZ) * S.G + S.c; if (L >= S.nwg) return false; S.map((int)L, u); u.z = i % NZ; return true; }
    __device__ __forceinline__ void a_ready(const Unit&) const {}
    __device__ __forceinline__ void done(const Unit&) const {}
};
struct OneUnit {
    Unit u0;
    __host__ __device__ bool next(int i, Unit& u) const { if (i > 0) return false; u = u0; return true; }
    __device__ __forceinline__ void a_ready(const Unit&) const {}
    __device__ __forceinline__ void done(const Unit&) const {}
};

typedef unsigned u32x2 __attribute__((ext_vector_type(2)));
constexpr float LOG2E = 1.4426950408889634f;
__device__ __forceinline__ float bf2f(unsigned short b) { return __uint_as_float((unsigned)b << 16); }
__device__ __forceinline__ float bflo(unsigned w) { return __uint_as_float(w << 16); }
__device__ __forceinline__ float bfhi(unsigned w) { return __uint_as_float(w & 0xffff0000u); }
__device__ __forceinline__ float sigmoidf_(float v) { return __builtin_amdgcn_rcpf(1.0f + __builtin_amdgcn_exp2f(-v * LOG2E)); }
__device__ __forceinline__ float gelu_tanh(float v) { const float z = 0.7978845608028654f * (v + 0.044715f * v * v * v); return v * sigmoidf_(2.0f * z); }
__device__ __forceinline__ u32x4 pack8(const f32x4 a, const f32x4 b) { u32x4 w; w.x = cvt_pk_bf16(a[0], a[1]); w.y = cvt_pk_bf16(a[2], a[3]); w.z = cvt_pk_bf16(b[0], b[1]); w.w = cvt_pk_bf16(b[2], b[3]); return w; }
__device__ __forceinline__ void row_rstd(const float* SS, int rowbase, int fq, float (&rs)[2][4]) {
#pragma unroll
    for (int ai = 0; ai < 2; ++ai)
#pragma unroll
        for (int m = 0; m < 4; ++m) { const f32x4 v = *(const f32x4*)(SS + (size_t)(rowbase + ai * HALF + m * 16) * 16 + 4 * fq);
            float s = (v[0] + v[1]) + (v[2] + v[3]); s += __shfl_xor(s, 16); s += __shfl_xor(s, 32); rs[ai][m] = rsqrtf(s * (1.0f / 1024.0f) + 1e-6f); }
}
__device__ __forceinline__ float row_rstd1(const float* SS, int row, int fq) { const f32x4 v = *(const f32x4*)(SS + (size_t)row * 16 + 4 * fq);
    float s = (v[0] + v[1]) + (v[2] + v[3]); s += __shfl_xor(s, 16); s += __shfl_xor(s, 32); return rsqrtf(s * (1.0f / 1024.0f) + 1e-6f); }
#define EPI_ARGS const f32x4 (&acc)[2][2][4][2], const Unit& u, int wr, int wc, int fr, int fq
struct EpiSwiGLU { static constexpr bool PERM = true, AFTER_DRAIN = false; const float* SS; bf16_t* O;
    __device__ __forceinline__ void operator()(EPI_ARGS) const {
        float rs[2][4]; row_rstd(SS, u.pm * BM + wr * 64 + fr, fq, rs);
        const int col0 = u.pn * 128 + wc * 32 + 8 * fq;
#pragma unroll
        for (int ai = 0; ai < 2; ++ai)
#pragma unroll
            for (int m = 0; m < 4; ++m) { const float r = rs[ai][m]; f32x4 o[2];
#pragma unroll
                for (int n = 0; n < 2; ++n)
#pragma unroll
                    for (int j = 0; j < 4; ++j) { const float g = acc[ai][0][m][n][j] * r, up = acc[ai][1][m][n][j] * r; o[n][j] = g * sigmoidf_(g) * up; }
                *(u32x4*)(O + (size_t)(u.pm * BM + ai * HALF + wr * 64 + m * 16 + fr) * 2816 + col0) = pack8(o[0], o[1]); }
    }
};
struct EpiResid { static constexpr bool PERM = false, AFTER_DRAIN = false; bf16_t* XB; float* SS; float scale;
    __device__ __forceinline__ void operator()(EPI_ARGS) const {
        const int col0 = u.pn * BM + wc * 32 + 4 * fq;
#pragma unroll
        for (int ai = 0; ai < 2; ++ai)
#pragma unroll
            for (int m = 0; m < 4; ++m) { const int row = u.pm * BM + ai * HALF + wr * 64 + m * 16 + fr; float ssq = 0.f;
#pragma unroll
                for (int bj = 0; bj < 2; ++bj)
#pragma unroll
                    for (int n = 0; n < 2; ++n) { const size_t off = (size_t)row * 1024 + col0 + bj * HALF + n * 16;
                        const u32x2 xw = *(const u32x2*)(XB + off);
                        f32x4 x = {bflo(xw.x), bfhi(xw.x), bflo(xw.y), bfhi(xw.y)}; x = x + acc[ai][bj][m][n] * scale;
                        u32x2 w; w.x = cvt_pk_bf16(x[0], x[1]); w.y = cvt_pk_bf16(x[2], x[3]); *(u32x2*)(XB + off) = w;
                        ssq += (x[0] * x[0] + x[1] * x[1]) + (x[2] * x[2] + x[3] * x[3]); }
                ssq += __shfl_xor(ssq, 16); ssq += __shfl_xor(ssq, 32);
                if (fq == 0) SS[(size_t)row * 16 + u.pn * 4 + wc] = ssq; }
    }
};
struct EpiWin { static constexpr bool PERM = true, AFTER_DRAIN = false; const float* SS; bf16_t* P; float* SSV; float qscale;
    __device__ __forceinline__ void operator()(EPI_ARGS) const {
        const int piece = u.pn >> 1;
        const int slot = piece == 0 ? 0 : piece == 1 ? 3 : piece == 2 ? 4 : piece == 3 ? 1 : piece == 4 ? 5 : piece == 5 ? 8 : piece;
        bf16_t* base = P + (size_t)slot * (16384u * 512u);
        const int col0 = (u.pn & 1) * 256 + wc * 32 + 8 * fq;
        const float sc = piece == 5 ? qscale : 1.0f;
#pragma unroll
        for (int ai = 0; ai < 2; ++ai)
#pragma unroll
            for (int m = 0; m < 4; ++m) { const int row = u.pm * BM + ai * HALF + wr * 64 + m * 16 + fr; const float r = row_rstd1(SS, row, fq) * sc; float ssq = 0.f;
#pragma unroll
                for (int bj = 0; bj < 2; ++bj) { f32x4 v0 = acc[ai][bj][m][0] * r, v1 = acc[ai][bj][m][1] * r;
                    if (piece == 3 || piece == 4) {
#pragma unroll
                        for (int j = 0; j < 4; ++j) { v0[j] = gelu_tanh(v0[j]); v1[j] = gelu_tanh(v1[j]); }
                        ssq += (v0[0] * v0[0] + v0[1] * v0[1]) + (v0[2] * v0[2] + v0[3] * v0[3]) + (v1[0] * v1[0] + v1[1] * v1[1]) + (v1[2] * v1[2] + v1[3] * v1[3]); }
                    *(u32x4*)(base + (size_t)row * 512 + col0 + bj * HALF) = pack8(v0, v1); }
                if (piece == 4) { ssq += __shfl_xor(ssq, 16); ssq += __shfl_xor(ssq, 32); if (fq == 0) SSV[(size_t)row * 8 + (u.pn & 1) * 4 + wc] = ssq; }
                asm volatile("" ::: "memory"); }
    }
};
struct EpiGates { static constexpr bool PERM = true, AFTER_DRAIN = false; const float* SS; bf16_t* G;
    __device__ __forceinline__ void operator()(EPI_ARGS) const {
        float rs[2][4]; row_rstd(SS, u.pm * BM + wr * 64 + fr, fq, rs);
        bf16_t* base = G + (size_t)(u.pn >> 2) * (16384u * 1024u);
        const int col0 = (u.pn & 3) * 256 + wc * 32 + 8 * fq;
#pragma unroll
        for (int ai = 0; ai < 2; ++ai)
#pragma unroll
            for (int m = 0; m < 4; ++m) { const int row = u.pm * BM + ai * HALF + wr * 64 + m * 16 + fr; const float r = rs[ai][m];
#pragma unroll
                for (int bj = 0; bj < 2; ++bj) { f32x4 v0 = acc[ai][bj][m][0] * r, v1 = acc[ai][bj][m][1] * r;
#pragma unroll
                    for (int j = 0; j < 4; ++j) { v0[j] = sigmoidf_(v0[j]); v1[j] = sigmoidf_(v1[j]); }
                    *(u32x4*)(base + (size_t)row * 1024 + col0 + bj * HALF) = pack8(v0, v1); } }
    }
};
struct EpiMerge { static constexpr bool PERM = true, AFTER_DRAIN = false; bf16_t* G;
    __device__ __forceinline__ void operator()(EPI_ARGS) const {
        const bf16_t* gz = G + (size_t)u.z * (16384u * 1024u);
        const int col0 = u.pn * 256 + wc * 32 + 8 * fq;
#pragma unroll
        for (int ai = 0; ai < 2; ++ai)
#pragma unroll
            for (int m = 0; m < 4; ++m) { const int row = u.pm * BM + ai * HALF + wr * 64 + m * 16 + fr;
#pragma unroll
                for (int bj = 0; bj < 2; ++bj) { const size_t off = (size_t)row * 1024 + col0 + bj * HALF;
                    const u32x4 gw = *(const u32x4*)(gz + off);
                    f32x4 g0 = {bflo(gw.x), bfhi(gw.x), bflo(gw.y), bfhi(gw.y)}, g1 = {bflo(gw.z), bfhi(gw.z), bflo(gw.w), bfhi(gw.w)};
                    f32x4 v0 = acc[ai][bj][m][0] * g0, v1 = acc[ai][bj][m][1] * g1;
#ifdef MK_DBG_Z
                    if (u.z != MK_DBG_Z) { v0 = v0 * 0.f; v1 = v1 * 0.f; }
#endif
                    if (u.z != 0) { u32x4 pw; { const unsigned long long a_ = __hip_atomic_load((const unsigned long long*)(G + off), __ATOMIC_RELAXED, __HIP_MEMORY_SCOPE_AGENT), b_ = __hip_atomic_load((const unsigned long long*)(G + off) + 1, __ATOMIC_RELAXED, __HIP_MEMORY_SCOPE_AGENT);
                            pw.x = (unsigned)a_; pw.y = (unsigned)(a_ >> 32); pw.z = (unsigned)b_; pw.w = (unsigned)(b_ >> 32); }
                        v0 = v0 + (f32x4){bflo(pw.x), bfhi(pw.x), bflo(pw.y), bfhi(pw.y)}; v1 = v1 + (f32x4){bflo(pw.z), bfhi(pw.z), bflo(pw.w), bfhi(pw.w)}; }
                    *(u32x4*)(G + off) = pack8(v0, v1); } }
    }
};
template <int MODE> struct EpiScale { static constexpr bool PERM = true, AFTER_DRAIN = false; const float* S; bf16_t* O; int ldc; float scale;
    __device__ __forceinline__ void operator()(EPI_ARGS) const {
        float rs[2][4];
        if (MODE == 1) row_rstd(S, u.pm * BM + wr * 64 + fr, fq, rs);
        const int col0 = (u.pn + u.z) * 256 + wc * 32 + 8 * fq;
#pragma unroll
        for (int ai = 0; ai < 2; ++ai)
#pragma unroll
            for (int m = 0; m < 4; ++m) { const int row = u.pm * BM + ai * HALF + wr * 64 + m * 16 + fr;
                float r = scale; if (MODE == 1) r *= rs[ai][m]; if (MODE == 2) r *= S[row];
#pragma unroll
                for (int bj = 0; bj < 2; ++bj) { f32x4 v0 = acc[ai][bj][m][0] * r, v1 = acc[ai][bj][m][1] * r;
                    if (MODE == 3) { v0 = v0 * *(const f32x4*)(S + col0 + bj * HALF); v1 = v1 * *(const f32x4*)(S + col0 + bj * HALF + 4); }
                    *(u32x4*)(O + (size_t)row * ldc + col0 + bj * HALF) = pack8(v0, v1); } }
    }
};
struct EpiSoftmax { static constexpr bool PERM = true, AFTER_DRAIN = true; bf16_t* O;
    __device__ __forceinline__ void fused(f32x4 (&acc)[2][2][4][2], const Unit& u, int wr, int wc, int fr, int fq, PG8_LAS unsigned char* lds, int wid, int lane) const {
        PG8_LAS float* T1 = (PG8_LAS float*)lds; PG8_LAS float* T2 = (PG8_LAS float*)(lds + 4096);
#pragma unroll
        for (int ai = 0; ai < 2; ++ai)
#pragma unroll
            for (int m = 0; m < 4; ++m) { float mx = -3.0e38f;
#pragma unroll
                for (int bj = 0; bj < 2; ++bj)
#pragma unroll
                    for (int n = 0; n < 2; ++n)
#pragma unroll
                        for (int j = 0; j < 4; ++j) mx = fmaxf(mx, acc[ai][bj][m][n][j]);
                mx = fmaxf(mx, __shfl_xor(mx, 16)); mx = fmaxf(mx, __shfl_xor(mx, 32));
                if (fq == 0) T1[(ai * HALF + wr * 64 + m * 16 + fr) * 4 + wc] = mx; }
        asm volatile("s_waitcnt lgkmcnt(0)" ::: "memory"); __builtin_amdgcn_s_barrier(); asm volatile("" ::: "memory");
#pragma unroll
        for (int ai = 0; ai < 2; ++ai)
#pragma unroll
            for (int m = 0; m < 4; ++m) { const int rl = ai * HALF + wr * 64 + m * 16 + fr; const f32x4 t = *(const PG8_LAS f32x4*)(T1 + rl * 4);
                const float mx = fmaxf(fmaxf(t[0], t[1]), fmaxf(t[2], t[3])); float s = 0.f;
#pragma unroll
                for (int bj = 0; bj < 2; ++bj)
#pragma unroll
                    for (int n = 0; n < 2; ++n)
#pragma unroll
                        for (int j = 0; j < 4; ++j) { const float p = __builtin_amdgcn_exp2f(acc[ai][bj][m][n][j] - mx); acc[ai][bj][m][n][j] = p; s += p; }
                s += __shfl_xor(s, 16); s += __shfl_xor(s, 32);
                if (fq == 0) T2[rl * 4 + wc] = s; }
        asm volatile("s_waitcnt lgkmcnt(0)" ::: "memory"); __builtin_amdgcn_s_barrier(); asm volatile("" ::: "memory");
        const int col0 = u.z * 256 + wc * 32 + 8 * fq;
#pragma unroll
        for (int ai = 0; ai < 2; ++ai)
#pragma unroll
            for (int m = 0; m < 4; ++m) { const int rl = ai * HALF + wr * 64 + m * 16 + fr; const f32x4 t = *(const PG8_LAS f32x4*)(T2 + rl * 4);
                const float inv = 1.0f / ((t[0] + t[1]) + (t[2] + t[3]));
#pragma unroll
                for (int bj = 0; bj < 2; ++bj) *(u32x4*)(O + (size_t)(u.pm * BM + rl) * 1024 + col0 + bj * HALF) = pack8(acc[ai][bj][m][0] * inv, acc[ai][bj][m][1] * inv); }
        asm volatile("s_waitcnt lgkmcnt(0)" ::: "memory"); __builtin_amdgcn_s_barrier(); asm volatile("" ::: "memory");
    }
};

template <class Epi, class Sched, bool ALIGN_EPI = false, bool SP2 = false>
__device__ __forceinline__ void gemm_phase(PG8_LAS unsigned char* lds, const Gemm g, const Sched& S, const Epi& E) {
    int tid_o = threadIdx.x; asm volatile("" : "+v"(tid_o)); const int tid = tid_o, wid = __builtin_amdgcn_readfirstlane(tid >> 6), lane = tid & 63, wr = wid >> 2, wc = wid & 3, fr = lane & 15, fq = lane >> 4;
    const int nt = g.K / BK; const char* gA_ = reinterpret_cast<const char*>(g.A); const char* gB_ = reinterpret_cast<const char*>(g.Bt); asm volatile("" : "+s"(gA_), "+s"(gB_));
    unsigned voffA[2], voffB[2];
#pragma unroll
    for (int i = 0; i < 2; ++i) { int R, C; stage_rc(tid * 16 + i * 8192, R, C); const int Rb = Epi::PERM ? ((R & ~31) + perm32(R & 31)) : R;
        voffA[i] = (unsigned)(R * g.lda + C) * 2u; voffB[i] = (unsigned)(Rb * g.ldb + C) * 2u; }
    const size_t kstep = (size_t)(BK * 2);
    const size_t hstepA = (size_t)HALF * g.lda * 2, hstepB = (size_t)HALF * g.ldb * 2;

    const unsigned ldsw = (unsigned)wid * 1024u;
    const int aoff = lds_byte(wr * 64 + fr, fq * 8), boff = lds_byte(wc * 32 + fr, fq * 8);
#define PG8_SA(b, h) (((b) * 2 + (h)) * HTB)
#define PG8_SB(b, h) ((4 + (b) * 2 + (h)) * HTB)
#define PG8_STAGE(bufoff, gbase, voff) do { _Pragma("unroll") for (int _i = 0; _i < 2; ++_i) \
        __builtin_amdgcn_global_load_lds((const unsigned*)((const char*)(gbase) + (voff)[_i]), (PG8_LAS unsigned*)(lds + (bufoff) + ldsw + _i * 8192), 16, 0, 0); } while (0)
#define PG8_LDA(dst, b, h) do { _Pragma("unroll") for (int m = 0; m < 4; ++m) _Pragma("unroll") for (int k = 0; k < 2; ++k) dst[m][k] = *(const PG8_LAS bf16x8*)(lds + PG8_SA(b, h) + aoff + m * 2048 + k * 1024); } while (0)
#define PG8_LDB(dst, b, h) do { _Pragma("unroll") for (int n = 0; n < 2; ++n) _Pragma("unroll") for (int k = 0; k < 2; ++k) dst[n][k] = *(const PG8_LAS bf16x8*)(lds + PG8_SB(b, h) + boff + n * 2048 + k * 1024); } while (0)
#define PG8_MMA(ai, bj, At, Bt) do { __builtin_amdgcn_s_setprio(1); _Pragma("unroll") for (int m = 0; m < 4; ++m) _Pragma("unroll") for (int n = 0; n < 2; ++n) _Pragma("unroll") for (int k = 0; k < 2; ++k) \
        acc[ai][bj][m][n] = __builtin_amdgcn_mfma_f32_16x16x32_bf16(Bt[n][k], At[m][k], acc[ai][bj][m][n], 0, 0, 0); __builtin_amdgcn_s_setprio(0); } while (0)
#define PG8_WAIT_V(n) asm volatile("s_waitcnt vmcnt(" #n ")" ::: "memory")
#define PG8_WAIT_L(n) asm volatile("s_waitcnt lgkmcnt(" #n ")" ::: "memory")
#define PG8_BAR __builtin_amdgcn_s_barrier()
#define PG8_SCHED __builtin_amdgcn_sched_barrier(0)
    Unit cur, nxt; int ui = 0;
    if (!S.next(0, cur)) return;
    f32x4 acc[2][2][4][2];
#pragma unroll
    for (int a = 0; a < 2; ++a)
#pragma unroll
        for (int b = 0; b < 2; ++b)
#pragma unroll
            for (int m = 0; m < 4; ++m)
#pragma unroll
                for (int n = 0; n < 2; ++n) acc[a][b][m][n] = (f32x4){0.f, 0.f, 0.f, 0.f};
    bf16x8 At[4][2], B0[2][2], B1[2][2];
    const char* cA = gA_ + (size_t)cur.pm * 2 * hstepA + (size_t)cur.z * g.zA; const char* cB = gB_ + (size_t)cur.pn * 2 * hstepB + (size_t)cur.z * g.zB;
    S.a_ready(cur);
    if constexpr (SP2) {
        PG8_STAGE(PG8_SB(0, 0), cB, voffB); PG8_STAGE(PG8_SB(0, 1), cB + hstepB, voffB); PG8_STAGE(PG8_SA(0, 0), cA, voffA); PG8_STAGE(PG8_SA(0, 1), cA + hstepA, voffA);
        if (wr == 1) PG8_BAR;
        PG8_WAIT_V(2); PG8_BAR;
        PG8_STAGE(PG8_SB(1, 0), cB + kstep, voffB); PG8_STAGE(PG8_SA(1, 0), cA + kstep, voffA); PG8_STAGE(PG8_SB(1, 1), cB + hstepB + kstep, voffB);
        PG8_WAIT_V(6); PG8_BAR;
    } else {
        PG8_STAGE(PG8_SB(0, 0), cB, voffB); PG8_STAGE(PG8_SA(0, 0), cA, voffA); PG8_STAGE(PG8_SB(0, 1), cB + hstepB, voffB); PG8_STAGE(PG8_SA(0, 1), cA + hstepA, voffA);
        if (wr == 1) PG8_BAR;
        PG8_WAIT_V(4); PG8_BAR;
        PG8_STAGE(PG8_SB(1, 0), cB + kstep, voffB); PG8_STAGE(PG8_SA(1, 0), cA + kstep, voffA); PG8_STAGE(PG8_SB(1, 1), cB + hstepB + kstep, voffB);
        PG8_WAIT_V(6); PG8_BAR;
    }
    for (;;) {
        const bool has_next = S.next(ui + 1, nxt);
        const char* nA = has_next ? gA_ + (size_t)nxt.pm * 2 * hstepA + (size_t)nxt.z * g.zA : cA; const char* nB = has_next ? gB_ + (size_t)nxt.pn * 2 * hstepB + (size_t)nxt.z * g.zB : cB;
_Pragma("nounroll")
        for (int t = 0; t < nt; t += 2) {
            const bool last = (t == nt - 2);
            const char* a1 = cA + (size_t)(t + 1) * kstep;
            const char* a2 = last ? nA : cA + (size_t)(t + 2) * kstep; const char* b2 = last ? nB : cB + (size_t)(t + 2) * kstep;
            const char* a3 = a2 + kstep; const char* b3 = b2 + kstep;
            if (last && has_next) S.a_ready(nxt);
            if constexpr (SP2) {
            PG8_LDB(B0, 0, 0); PG8_LDB(B1, 0, 1); PG8_SCHED; PG8_LDA(At, 0, 0); PG8_STAGE(PG8_SA(1, 1), a1 + hstepA, voffA);
            PG8_WAIT_V(8); PG8_WAIT_L(0); PG8_BAR; PG8_MMA(0, 0, At, B0); PG8_MMA(0, 1, At, B1); PG8_BAR; PG8_SCHED;
            PG8_LDA(At, 0, 1); PG8_STAGE(PG8_SB(0, 0), b2, voffB); PG8_STAGE(PG8_SB(0, 1), b2 + hstepB, voffB); PG8_STAGE(PG8_SA(0, 0), a2, voffA);
            PG8_WAIT_V(8); PG8_WAIT_L(0); PG8_BAR; PG8_MMA(1, 0, At, B0); PG8_MMA(1, 1, At, B1); PG8_BAR; PG8_SCHED;
            PG8_LDB(B0, 1, 0); PG8_LDB(B1, 1, 1); PG8_SCHED; PG8_LDA(At, 1, 0); PG8_STAGE(PG8_SA(0, 1), a2 + hstepA, voffA);
            PG8_WAIT_V(8); PG8_WAIT_L(0); PG8_BAR; PG8_MMA(0, 0, At, B0); PG8_MMA(0, 1, At, B1); PG8_BAR; PG8_SCHED;
            PG8_LDA(At, 1, 1); PG8_STAGE(PG8_SB(1, 0), b3, voffB); PG8_STAGE(PG8_SB(1, 1), b3 + hstepB, voffB); PG8_STAGE(PG8_SA(1, 0), a3, voffA);
            PG8_WAIT_V(8); PG8_WAIT_L(0); PG8_BAR; PG8_MMA(1, 0, At, B0); PG8_MMA(1, 1, At, B1); PG8_BAR; PG8_SCHED;
            } else {
            PG8_LDB(B0, 0, 0); PG8_SCHED; PG8_LDA(At, 0, 0); PG8_STAGE(PG8_SA(1, 1), a1 + hstepA, voffA);
            PG8_WAIT_L(8); PG8_BAR; PG8_WAIT_L(0); PG8_MMA(0, 0, At, B0); PG8_BAR; PG8_SCHED;
            PG8_LDB(B1, 0, 1); PG8_STAGE(PG8_SB(0, 0), b2, voffB);
            PG8_BAR; PG8_WAIT_L(0); PG8_MMA(0, 1, At, B1); PG8_BAR;
            PG8_LDA(At, 0, 1); PG8_STAGE(PG8_SA(0, 0), a2, voffA);
            PG8_BAR; PG8_WAIT_L(0); PG8_MMA(1, 0, At, B0); PG8_BAR; PG8_SCHED;
            PG8_STAGE(PG8_SB(0, 1), b2 + hstepB, voffB);
            PG8_WAIT_V(6); PG8_BAR; PG8_MMA(1, 1, At, B1); PG8_BAR;
            PG8_LDB(B0, 1, 0); PG8_SCHED; PG8_LDA(At, 1, 0); PG8_STAGE(PG8_SA(0, 1), a2 + hstepA, voffA);
            PG8_WAIT_L(8); PG8_BAR; PG8_WAIT_L(0); PG8_MMA(0, 0, At, B0); PG8_BAR; PG8_SCHED;
            PG8_LDB(B1, 1, 1); PG8_STAGE(PG8_SB(1, 0), b3, voffB);
            PG8_BAR; PG8_WAIT_L(0); PG8_MMA(0, 1, At, B1); PG8_BAR;
            PG8_LDA(At, 1, 1); PG8_STAGE(PG8_SA(1, 0), a3, voffA);
            PG8_BAR; PG8_WAIT_L(0); PG8_MMA(1, 0, At, B0); PG8_BAR; PG8_SCHED;
            PG8_STAGE(PG8_SB(1, 1), b3 + hstepB, voffB);
            PG8_WAIT_V(6); PG8_BAR; PG8_MMA(1, 1, At, B1); PG8_BAR;
            }
        }
        if constexpr (ALIGN_EPI) { if (wr == 0) PG8_BAR; }
        if constexpr (!Epi::AFTER_DRAIN) { E(acc, cur, wr, wc, fr, fq); S.done(cur); }
        if (!has_next) break;
#pragma unroll
        for (int a = 0; a < 2; ++a)
#pragma unroll
            for (int b = 0; b < 2; ++b)
#pragma unroll
                for (int m = 0; m < 4; ++m)
#pragma unroll
                    for (int n = 0; n < 2; ++n) acc[a][b][m][n] = (f32x4){0.f, 0.f, 0.f, 0.f};
        cur = nxt; cA = nA; cB = nB; ++ui;
        if constexpr (ALIGN_EPI) { if (wr == 1) PG8_BAR; }
    }
    PG8_WAIT_V(0);
    if constexpr (!ALIGN_EPI) { if (wr == 0) PG8_BAR; }
    PG8_BAR;
    if constexpr (Epi::AFTER_DRAIN) { E.fused(acc, cur, wr, wc, fr, fq, lds, wid, lane); S.done(cur); }
#undef PG8_SA
#undef PG8_SB
#undef PG8_STAGE
#undef PG8_LDA
#undef PG8_LDB
#undef PG8_MMA
#undef PG8_WAIT_V
#undef PG8_WAIT_L
#undef PG8_BAR
#undef PG8_SCHED
}
}
#include <hip/hip_bf16.h>
#include <cmath>
namespace attn_body {
using bf16=__hip_bfloat16;
using bf16x8=__attribute__((ext_vector_type(8)))short;
using s16x4=__attribute__((ext_vector_type(4)))short;
using f32x16=__attribute__((ext_vector_type(16)))float;
using u32x4=__attribute__((ext_vector_type(4)))unsigned;
using f32x4_t=__attribute__((ext_vector_type(4)))float;
constexpr int BATCH=1,NHEAD=8,SEQ=16384,D=64,DM=NHEAD*D;
constexpr int NW=8,QBLK=32,QB=QBLK*NW,KVBLK=64,NQB=SEQ/QB;
constexpr int ATTN_PITCH=DM, ATTN_UNIT_ROWS=QB;
__device__ __forceinline__ int crow(int r,int hi){return (r&3)+8*(r>>2)+4*hi;}
#define SBAR() __builtin_amdgcn_sched_barrier(0)
__device__ __forceinline__ void cmask(f32x16&p0,f32x16&p1,int jb,int qrel,int hi){
  const float NEG=-INFINITY; int kb=64*jb+4*hi;
  #pragma unroll
  for(int r=0;r<16;++r){int kv=kb+(r&3)+8*(r>>2); if(kv>qrel)p0[r]=NEG; if(kv+32>qrel)p1[r]=NEG;}
}

constexpr int NSLOT=3, SLOTB=8192;
constexpr int LDS_K=0, LDS_V=NSLOT*SLOTB, LDS_WS=2*NSLOT*SLOTB, LDS_OST=LDS_WS+NW*64*4, LDS_CK=LDS_OST+NW*4096, LDS_BYTES=LDS_CK+SEQ*4;
constexpr float C2=0.125f*1.4426950408889634f;
__device__ __forceinline__ void glds16(const void*gsrc,unsigned lds_dst){unsigned keep;
  asm volatile("s_mov_b32 %0, m0\n\ts_mov_b32 m0, %2\n\ts_nop 0\n\tglobal_load_lds_dwordx4 %1, off\n\ts_mov_b32 m0, %0":"=&s"(keep):"v"(gsrc),"s"(lds_dst):"memory");}
__device__ __forceinline__ float max3f(float a,float b,float c){float r;asm("v_max3_f32 %0, %1, %2, %3":"=v"(r):"v"(a),"v"(b),"v"(c));return r;}
__device__ __forceinline__ float max2f(float a,float b){float r;asm("v_max_f32_e32 %0, %1, %2":"=v"(r):"v"(a),"v"(b));return r;}
__device__ __forceinline__ float fadd_s(float a,float b){float r;asm("v_add_f32_e32 %0, %1, %2":"=v"(r):"v"(a),"v"(b));return r;}
__device__ __forceinline__ float fsub_s(float a,float b){float r;asm("v_sub_f32_e32 %0, %1, %2":"=v"(r):"v"(a),"v"(b));return r;}
typedef float f32x2_t __attribute__((ext_vector_type(2))); typedef __bf16 bf16x2_t __attribute__((ext_vector_type(2)));
__device__ __forceinline__ unsigned cvtpk_s(float lo,float hi){f32x2_t v={lo,hi};bf16x2_t b=__builtin_convertvector(v,bf16x2_t);return __builtin_bit_cast(unsigned,b);}
#define WAIT_BAR(N) asm volatile("s_waitcnt vmcnt(" #N ") lgkmcnt(0)\n\ts_barrier":::"memory")

__device__ __forceinline__ void qkt(f32x16&p0,f32x16&p1,const char*Kslot,const bf16x8*qr,const f32x16&negm,int r32,int hi){
  const char*kb=Kslot+hi*1024+r32*16;
  #pragma unroll
  for(int d0=0;d0<4;++d0){
    const bf16x8 b0=*reinterpret_cast<const bf16x8*>(kb+d0*2048);
    const bf16x8 b1=*reinterpret_cast<const bf16x8*>(kb+d0*2048+512);
    if(d0==0){p0=__builtin_amdgcn_mfma_f32_32x32x16_bf16(b0,qr[0],negm,0,0,0);p1=__builtin_amdgcn_mfma_f32_32x32x16_bf16(b1,qr[0],negm,0,0,0);}
    else{p0=__builtin_amdgcn_mfma_f32_32x32x16_bf16(b0,qr[d0],p0,0,0,0);p1=__builtin_amdgcn_mfma_f32_32x32x16_bf16(b1,qr[d0],p1,0,0,0);}}
}
typedef __attribute__((address_space(3))) const char* lds_cptr;
typedef short v4i16_t __attribute__((ext_vector_type(4)));
__device__ __forceinline__ void kload8(bf16x8*kf,lds_cptr kp){
  kf[0]=*(const __attribute__((address_space(3))) bf16x8*)(kp);      kf[1]=*(const __attribute__((address_space(3))) bf16x8*)(kp+512);
  kf[2]=*(const __attribute__((address_space(3))) bf16x8*)(kp+2048); kf[3]=*(const __attribute__((address_space(3))) bf16x8*)(kp+2560);
  kf[4]=*(const __attribute__((address_space(3))) bf16x8*)(kp+4096); kf[5]=*(const __attribute__((address_space(3))) bf16x8*)(kp+4608);
  kf[6]=*(const __attribute__((address_space(3))) bf16x8*)(kp+6144); kf[7]=*(const __attribute__((address_space(3))) bf16x8*)(kp+6656);
}
__device__ __forceinline__ void kload2(bf16x8*kf,lds_cptr kp,int j){ kf[2*j]=*(const __attribute__((address_space(3))) bf16x8*)(kp+j*2048); kf[2*j+1]=*(const __attribute__((address_space(3))) bf16x8*)(kp+j*2048+512); }
__device__ __forceinline__ s16x4 vtr(lds_cptr p){ return __builtin_bit_cast(s16x4,__builtin_amdgcn_ds_read_tr16_b64_v4i16((__attribute__((address_space(3))) v4i16_t*)p)); }
__device__ __forceinline__ float rowmax(const f32x16&p0,const f32x16&p1){
  float a=max3f(p0[0],p0[1],p1[0]),b=max3f(p0[2],p0[3],p1[1]);a=max3f(a,p1[2],p1[3]);
  #pragma unroll
  for(int r=4;r<16;r+=4){a=max3f(a,p0[r],p0[r+1]);b=max3f(b,p0[r+2],p0[r+3]);a=max3f(a,p1[r],p1[r+1]);b=max3f(b,p1[r+2],p1[r+3]);}
  const float m=max2f(a,b);
  auto rr=__builtin_amdgcn_permlane32_swap(__float_as_uint(m),__float_as_uint(m),false,false);
  return max2f(__uint_as_float(rr[0]),__uint_as_float(rr[1]));
}
__device__ __forceinline__ void pv(f32x16*o,int vb,bf16x8 pa0,bf16x8 pa1,bf16x8 pa2,bf16x8 pa3){
  #pragma unroll
  for(int d0=0;d0<2;++d0){s16x4 lo[4],hi[4];
    #pragma unroll
    for(int ks=0;ks<4;++ks){
      asm volatile("ds_read_b64_tr_b16 %0,%1 offset:%c2":"=&v"(lo[ks]):"v"(vb),"i"(d0*4096+ks*1024):"memory");
      asm volatile("ds_read_b64_tr_b16 %0,%1 offset:%c2":"=&v"(hi[ks]):"v"(vb),"i"(d0*4096+ks*1024+512):"memory");}
    asm volatile("s_waitcnt lgkmcnt(0)":::"memory");SBAR();
    #define PK(k) (bf16x8){lo[k][0],lo[k][1],lo[k][2],lo[k][3],hi[k][0],hi[k][1],hi[k][2],hi[k][3]}
    o[d0]=__builtin_amdgcn_mfma_f32_32x32x16_bf16(pa0,PK(0),o[d0],0,0,0);
    o[d0]=__builtin_amdgcn_mfma_f32_32x32x16_bf16(pa1,PK(1),o[d0],0,0,0);
    o[d0]=__builtin_amdgcn_mfma_f32_32x32x16_bf16(pa2,PK(2),o[d0],0,0,0);
    o[d0]=__builtin_amdgcn_mfma_f32_32x32x16_bf16(pa3,PK(3),o[d0],0,0,0);
    #undef PK
  }
}

#ifndef ATTN_STORE16
#define ATTN_STORE16(p,v) (*(u32x4*)(p)=(v))
#endif
template<int THRL> __device__ __forceinline__ void attn_unit(int b,int h,int qb,const bf16*Q,const bf16*__restrict__ K,const bf16*__restrict__ V,bf16*O,const float*__restrict__ CSg,const unsigned*KMg,char*shm,const int t0,const int ntl,const bool masked,float*__restrict__ Lout){
  int tid_o=threadIdx.x; asm volatile("":"+v"(tid_o)); const int tid=tid_o,lane=tid&63,r32=lane&31,hi=lane>>5; const int wid=__builtin_amdgcn_readfirstlane(tid>>6);
  const long rowbase=(long)b*SEQ; const int q0=qb*QB;
  const bf16*Qw=Q+(rowbase+q0+wid*QBLK)*DM+h*D;
  const bf16*Kh=K+(rowbase+(long)t0*KVBLK)*DM+h*D,*Vh=V+(rowbase+(long)t0*KVBLK)*DM+h*D;
  const unsigned lds0=(unsigned)(uintptr_t)shm;
  float*wsf=(float*)(shm+LDS_WS)+wid*64;
  const lds_cptr shm3=(lds_cptr)shm;
  const bf16*ksrc=Kh+(long)lane*DM+wid*8;
  const bf16*vsrc=Vh+(long)(16*(wid&3)+(lane>>2))*DM+(wid>>2)*32+(lane&3)*8;
  const unsigned kdst=lds0+LDS_K+wid*1024, vdst=lds0+LDS_V+wid*1024;
  #define DMA_K(t,slot) glds16(ksrc+(long)(t)*KVBLK*DM,(unsigned)__builtin_amdgcn_readfirstlane(kdst+(slot)))
  #define DMA_V(t,slot) glds16(vsrc+(long)(t)*KVBLK*DM,(unsigned)__builtin_amdgcn_readfirstlane(vdst+(slot)))
  const int vb0=(int)(lds0+LDS_V)+((lane>>4)&1)*32+(lane&3)*8+(4*hi+((lane&15)>>2))*64;
  const char*Kbase=shm+LDS_K; bf16x8 kf[8];
  const lds_cptr kp0=shm3+LDS_K+hi*1024+r32*16; const lds_cptr vp0=shm3+LDS_V+((lane>>4)&1)*32+(lane&3)*8+(4*hi+((lane&15)>>2))*64;
  const int NT=ntl;
  typedef __attribute__((address_space(3))) float* lds_fptr; typedef __attribute__((address_space(3))) f32x4_t* lds_f4ptr;
  const float*csh=CSg+(long)h*SEQ;
  { const lds_fptr ckw=(lds_fptr)(shm3+LDS_CK);
    for(int i=tid*4;i<ntl*KVBLK;i+=NW*64*4){ const f32x4_t v=*(const f32x4_t*)(csh+t0*KVBLK+i); *(lds_f4ptr)(ckw+i)=v; }
  }
  const float cq=csh[q0+wid*QBLK+r32];
  asm volatile("s_waitcnt vmcnt(0) lgkmcnt(0)\n\ts_barrier":::"memory");
  const lds_fptr ckt=(lds_fptr)(shm3+LDS_CK)+4*hi;
  #define CKSUB(P0,P1,t) do{ const lds_fptr ckp_=ckt+64*(t); _Pragma("unroll") for(int j_=0;j_<4;++j_){ const f32x4_t a_=*(const lds_f4ptr)(ckp_+8*j_); const f32x4_t b_=*(const lds_f4ptr)(ckp_+32+8*j_); \
      P0[4*j_]-=a_[0];P0[4*j_+1]-=a_[1];P0[4*j_+2]-=a_[2];P0[4*j_+3]-=a_[3]; P1[4*j_]-=b_[0];P1[4*j_+1]-=b_[1];P1[4*j_+2]-=b_[2];P1[4*j_+3]-=b_[3]; SBAR(); } }while(0)
  DMA_K(0,0);DMA_V(0,0);DMA_K(1,SLOTB);
  bf16x8 qr[4];
  #pragma unroll
  for(int d0=0;d0<4;++d0)qr[d0]=*reinterpret_cast<const bf16x8*>(&Qw[(long)r32*DM+d0*16+hi*8]);
  float l_reg=0.f;f32x16 o[2];o[0]=f32x16{};o[1]=f32x16{};f32x16 negm;
  {
    float q2=0.f;
    _Pragma("unroll") for(int d0=0;d0<4;++d0) _Pragma("unroll") for(int e=0;e<8;++e){ const float v=__uint_as_float(((unsigned)(unsigned short)qr[d0][e])<<16); q2+=v*v; }
    { auto rr=__builtin_amdgcn_permlane32_swap(__float_as_uint(q2),__float_as_uint(q2),false,false); q2=__uint_as_float(rr[0])+__uint_as_float(rr[1]); }
    const float km2=__uint_as_float(__hip_atomic_load(KMg+h,__ATOMIC_RELAXED,__HIP_MEMORY_SCOPE_AGENT));
    const float Rq=sqrtf(q2*km2)*1.001f+0.01f;
    _Pragma("unroll") for(int r=0;r<16;++r)negm[r]=cq-Rq; asm volatile("":"+v"(negm)); }
  const int qrel=wid*QBLK+r32;
  #define CMASK(P0,P1,t) do{int jb_=(t)-(NT-4); if(masked&&jb_>=0)cmask(P0,P1,jb_,qrel,hi);}while(0)
  #define START(P0,P1) do{ const float rm=rowmax(P0,P1); resc=false; \
    { const float dl=rm; mhat=fadd_s(mhat,dl); \
      _Pragma("unroll") for(int r=0;r<16;++r){P0[r]=fsub_s(P0[r],dl);P1[r]=fsub_s(P1[r],dl);} \
      _Pragma("unroll") for(int r=0;r<16;++r)negm[r]=-mhat; asm volatile("":"+v"(negm)); } \
    _Pragma("unroll") for(int r=0;r<16;++r)P0[r]=__builtin_amdgcn_exp2f(P0[r]); }while(0)
  #define RESC() do{ if(resc){ asm volatile("s_waitcnt lgkmcnt(0)":::"memory"); \
      _Pragma("unroll") for(int d_=0;d_<2;++d_) _Pragma("unroll") for(int r=0;r<16;++r)o[d_][r]*=wsf[crow(r,hi)]; } }while(0)
  f32x16 pA0,pA1,pB0,pB1;
  int sl_prev=0,sl_cur=0,sl_next=SLOTB;
  #define ROT() do{sl_prev=sl_cur;sl_cur=sl_next;sl_next=(sl_next==(NSLOT-1)*SLOTB)?0:sl_next+SLOTB;}while(0)
  DMA_K(2,2*SLOTB);
  WAIT_BAR(3);
  qkt(pA0,pA1,Kbase,qr,negm,r32,hi);asm volatile("s_nop 15\n\ts_nop 7":"+v"(pA0),"+v"(pA1));CKSUB(pA0,pA1,0);CMASK(pA0,pA1,0);
  _Pragma("unroll") for(int r=0;r<16;++r)pA0[r]=__builtin_amdgcn_exp2f(pA0[r]);
  _Pragma("unroll") for(int r=0;r<16;++r)pA1[r]=__builtin_amdgcn_exp2f(pA1[r]);
  WAIT_BAR(0);
  DMA_K(3,0);DMA_V(1,SLOTB);
  ROT();
  kload8(kf,kp0+sl_cur);
  WAIT_BAR(2);
  s16x4 vlo[8],vhi[8]; u32x4 pw0,pw1,pw2,pw3;
  #define PKW(P,B) cvtpk_s(P[B],P[B+1])
  #define PAF(k) __builtin_bit_cast(bf16x8,pw##k)
  #define VFR(i) (bf16x8){vlo[i][0],vlo[i][1],vlo[i][2],vlo[i][3],vhi[i][0],vhi[i][1],vhi[i][2],vhi[i][3]}
  #define PIN(x) asm volatile("":"+v"(x))
  #define MX3(a,b,c) __builtin_fmaxf(__builtin_fmaxf((a),(b)),(c))
  #define GAPA(MF,A0,A1,A2,A3,W0,W1,PW) do{ MF; sacc+=A0; sacc+=A1; sacc+=A2; sacc+=A3; PIN(sacc); W0; W1; PIN(PW); SBAR(); }while(0)
  #define EX(v) __builtin_amdgcn_exp2f(v)
  #define GAPB(MF,X,B,CUR,NXT,NOFF) do{ MF; if((NOFF)>=0){ NXT=*(const lds_f4ptr)(ckp_+((NOFF)>=0?(NOFF):0)); } X[B]=EX(X[B]-CUR[0]); X[B+1]=EX(X[B+1]-CUR[1]); X[B+2]=EX(X[B+2]-CUR[2]); X[B+3]=EX(X[B+3]-CUR[3]); PIN(X); SBAR(); }while(0)
  #define VRD(i) do{ vlo[i]=vtr(vp_+(((i)>>2)*4096+((i)&3)*1024)); vhi[i]=vtr(vp_+(((i)>>2)*4096+((i)&3)*1024+512)); }while(0)
  #define KRD(G,j) do{ if(G){ kload2(kf,kp0+sl_next,j); SBAR(); } }while(0)
  #define STEP(C0,C1,P0,P1,t,GK,GV,GL) do{ SBAR(); \
    const lds_cptr vp_=vp0+sl_prev; \
    VRD(0); SBAR(); float sacc=(P0[0]+P0[1]); \
    GAPA(C0=__builtin_amdgcn_mfma_f32_32x32x16_bf16(kf[0],qr[0],negm,0,0,0), P0[2],P0[3],P0[4],P0[5],     pw0[0]=PKW(P0,0), pw0[1]=PKW(P0,2), pw0); \
    VRD(4); SBAR(); GAPA(C1=__builtin_amdgcn_mfma_f32_32x32x16_bf16(kf[1],qr[0],negm,0,0,0), P0[6],P0[7],P0[8],P0[9],     pw0[2]=PKW(P0,4), pw0[3]=PKW(P0,6), pw0); \
    VRD(1); SBAR(); GAPA(C0=__builtin_amdgcn_mfma_f32_32x32x16_bf16(kf[2],qr[1],C0,0,0,0),   P0[10],P0[11],P0[12],P0[13], pw1[0]=PKW(P0,8), pw1[1]=PKW(P0,10), pw1); \
    VRD(5); SBAR(); GAPA(C1=__builtin_amdgcn_mfma_f32_32x32x16_bf16(kf[3],qr[1],C1,0,0,0),   P0[14],P0[15],P1[0],P1[1],   pw1[2]=PKW(P0,12),pw1[3]=PKW(P0,14), pw1); \
    VRD(2); SBAR(); GAPA(C0=__builtin_amdgcn_mfma_f32_32x32x16_bf16(kf[4],qr[2],C0,0,0,0),   P1[2],P1[3],P1[4],P1[5],     pw2[0]=PKW(P1,0), pw2[1]=PKW(P1,2), pw2); \
    VRD(6); SBAR(); GAPA(C1=__builtin_amdgcn_mfma_f32_32x32x16_bf16(kf[5],qr[2],C1,0,0,0),   P1[6],P1[7],P1[8],P1[9],     pw2[2]=PKW(P1,4), pw2[3]=PKW(P1,6), pw2); \
    VRD(3); SBAR(); GAPA(C0=__builtin_amdgcn_mfma_f32_32x32x16_bf16(kf[6],qr[3],C0,0,0,0),   P1[10],P1[11],P1[12],P1[13], pw3[0]=PKW(P1,8), pw3[1]=PKW(P1,10), pw3); \
    VRD(7); SBAR(); GAPA(C1=__builtin_amdgcn_mfma_f32_32x32x16_bf16(kf[7],qr[3],C1,0,0,0),   P1[14],P1[15],0.f,0.f,       pw3[2]=PKW(P1,12),pw3[3]=PKW(P1,14), pw3); \
    l_reg+=sacc; \
    if(GK){DMA_K((t)+3,sl_cur);} if(GV){DMA_V((t)+1,sl_next);} \
    CMASK(C0,C1,t); \
    const lds_fptr ckp_=ckt+64*(t); f32x4_t ckA_=*(const lds_f4ptr)(ckp_), ckB_; \
    SBAR(); \
    GAPB(o[0]=__builtin_amdgcn_mfma_f32_32x32x16_bf16(PAF(0),VFR(0),o[0],0,0,0), C0,0,ckA_,ckB_,8); \
    GAPB(o[1]=__builtin_amdgcn_mfma_f32_32x32x16_bf16(PAF(0),VFR(4),o[1],0,0,0), C0,4,ckB_,ckA_,16); \
    KRD(GL,0); GAPB(o[0]=__builtin_amdgcn_mfma_f32_32x32x16_bf16(PAF(1),VFR(1),o[0],0,0,0), C0,8,ckA_,ckB_,24); \
    KRD(GL,1); GAPB(o[1]=__builtin_amdgcn_mfma_f32_32x32x16_bf16(PAF(1),VFR(5),o[1],0,0,0), C0,12,ckB_,ckA_,32); \
    KRD(GL,2); GAPB(o[0]=__builtin_amdgcn_mfma_f32_32x32x16_bf16(PAF(2),VFR(2),o[0],0,0,0), C1,0,ckA_,ckB_,40); \
    KRD(GL,3); GAPB(o[1]=__builtin_amdgcn_mfma_f32_32x32x16_bf16(PAF(2),VFR(6),o[1],0,0,0), C1,4,ckB_,ckA_,48); \
    GAPB(o[0]=__builtin_amdgcn_mfma_f32_32x32x16_bf16(PAF(3),VFR(3),o[0],0,0,0), C1,8,ckA_,ckB_,56); \
    GAPB(o[1]=__builtin_amdgcn_mfma_f32_32x32x16_bf16(PAF(3),VFR(7),o[1],0,0,0), C1,12,ckB_,ckA_,-1); \
    }while(0)
  int t=1;
  #undef CMASK
  #define CMASK(P0,P1,t) do{}while(0)
  for(;t+5<NT;t+=2){
    STEP(pB0,pB1,pA0,pA1,t,true,true,true);     WAIT_BAR(2); ROT();
    STEP(pA0,pA1,pB0,pB1,t+1,true,true,true);   WAIT_BAR(2); ROT();
  }
  #undef CMASK
  #define CMASK(P0,P1,t) do{int jb_=(t)-(NT-4); if(masked&&jb_>=0)cmask(P0,P1,jb_,qrel,hi);}while(0)
  #define ENDW(tt) do{ if((tt)+3<NT){WAIT_BAR(2);} else if((tt)+2<NT){WAIT_BAR(1);} else {WAIT_BAR(0);} }while(0)
  for(;t+1<NT;t+=2){
    STEP(pB0,pB1,pA0,pA1,t,(t+3<NT),(t+1<NT),(t+1<NT));       ENDW(t); ROT();
    STEP(pA0,pA1,pB0,pB1,t+1,(t+4<NT),(t+2<NT),(t+2<NT));     ENDW(t+1); ROT();
  }
  STEP(pB0,pB1,pA0,pA1,NT-1,false,false,false);
  { float sacc=pB0[0]+pB0[1]; _Pragma("unroll") for(int r=2;r<16;++r)sacc+=pB0[r]; _Pragma("unroll") for(int r=0;r<16;++r)sacc+=pB1[r]; l_reg+=sacc;
    pw0=(u32x4){PKW(pB0,0),PKW(pB0,2),PKW(pB0,4),PKW(pB0,6)};pw1=(u32x4){PKW(pB0,8),PKW(pB0,10),PKW(pB0,12),PKW(pB0,14)};pw2=(u32x4){PKW(pB1,0),PKW(pB1,2),PKW(pB1,4),PKW(pB1,6)};pw3=(u32x4){PKW(pB1,8),PKW(pB1,10),PKW(pB1,12),PKW(pB1,14)};
    SBAR(); pv(o,vb0+sl_cur,PAF(0),PAF(1),PAF(2),PAF(3)); }
  #undef PKW
  #undef PAF
  #undef VFR
  #undef PIN
  #undef MX3
  #undef GAPA
  #undef GAPB
  #undef EX
  #undef VRD
  #undef KRD
  #undef STEP
  #undef ENDW
  {auto rr=__builtin_amdgcn_permlane32_swap(__float_as_uint(l_reg),__float_as_uint(l_reg),false,false);l_reg=__uint_as_float(rr[0])+__uint_as_float(rr[1]);}
  if(hi==0){wsf[32+r32]=l_reg; Lout[(long)(q0+wid*QBLK+r32)*NHEAD+h]=l_reg;}asm volatile("s_waitcnt lgkmcnt(0)":::"memory");
  float rli[16];
  #pragma unroll
  for(int r=0;r<16;++r){const float lv_=wsf[32+crow(r,hi)]; rli[r]=lv_>1e-30f?__builtin_amdgcn_rcpf(lv_):0.f;}
  bf16*Ow=O+(rowbase+q0+wid*QBLK)*DM+h*D;
  { bf16*stg=(bf16*)(shm+LDS_OST)+wid*2048;
    #pragma unroll
    for(int r=0;r<16;++r){const int orow=crow(r,hi);
      #pragma unroll
      for(int d0=0;d0<2;++d0)stg[orow*64+d0*32+r32]=__float2bfloat16(o[d0][r]*rli[r]);}
    asm volatile("s_waitcnt lgkmcnt(0)":::"memory");
    #pragma unroll
    for(int i=0;i<4;++i){const int row=i*8+(lane>>3),ch=lane&7; const u32x4 v=*(const u32x4*)(stg+row*64+ch*8); ATTN_STORE16(Ow+(long)row*DM+ch*8,v);} }
  asm volatile("s_waitcnt lgkmcnt(0)\n\ts_barrier":::"memory");
  #undef CKSUB
  #undef DMA_K
  #undef DMA_V
  #undef CMASK
  #undef START
  #undef RESC
  #undef ROT
}
constexpr int ATTN_LDS_BYTES=LDS_BYTES;
struct AttnTensors { const bf16* Q; const bf16* K; const bf16* V; bf16* O; const float* CS; const unsigned* KM; };
struct AttnUnit { int bh; int qb; };
struct StaticOrder {
  int vcu,G;
  __device__ __forceinline__ explicit StaticOrder(int grid,int block):vcu((grid%8==0)?(block%8)*(grid/8)+block/8:block),G(grid){}
  __device__ __forceinline__ bool next(int i,AttnUnit&u)const{
    if(G==256){ if(i>=2)return false; const int s=vcu&31; u.bh=vcu>>5; u.qb=(i==0)?s:63-s; return true; }
    const int Lx=i*G+vcu; if(Lx>=NHEAD*NQB)return false; u.bh=Lx/NQB; u.qb=NQB-1-(Lx%NQB); return true; }
  __device__ __forceinline__ void a_ready(const AttnUnit&)const{}
  __device__ __forceinline__ void done(const AttnUnit&)const{}
};
template<class Sched,int THRL=8> __device__ __forceinline__ void attn_phase(char*lds,const AttnTensors&T,const Sched&S){
  AttnUnit u;
  for(int i=0;S.next(i,u);++i){ S.a_ready(u); attn_unit<THRL>(0,u.bh,u.qb,T.Q,T.K,T.V,T.O,T.CS,T.KM,lds,0,4*(u.qb+1),true,(float*)nullptr); S.done(u); }
}
#undef SBAR
#undef WAIT_BAR
}
#define LAS __attribute__((address_space(3)))
typedef unsigned short bf16;
typedef unsigned v4u __attribute__((ext_vector_type(4)));
typedef unsigned v2u __attribute__((ext_vector_type(2)));
typedef float f32x4 __attribute__((ext_vector_type(4)));
typedef short bf16x8 __attribute__((ext_vector_type(8)));
constexpr int NWAVES = 8, NTHREADS = 512;
constexpr int M = 16384, D = 1024, FF = 2816, MEML = 256, DIN = 7176, NLAYER = 2;
constexpr float EPS = 1e-6f, LOG2E = 1.4426950408889634f;
constexpr int LDS_BYTES = 155648, XB_LDS_OFF = LDS_BYTES - 256, T0_LDS_OFF = 149504;
static_assert(attn_body::ATTN_LDS_BYTES <= LDS_BYTES, "lds");
constexpr size_t MiB = 1u << 20;
constexpr size_t WS_SS = 1 * MiB, WS_SSV = 2 * MiB, WS_LF = 2 * MiB + 512 * 1024, WS_CS = 3 * MiB, WS_RSM = 3 * MiB + 512 * 1024, WS_MEMB = 4 * MiB, WS_KC = 4 * MiB + 512 * 1024, WS_VCT = 5 * MiB;
constexpr size_t WS_LPL = 5 * MiB + 512 * 1024, WS_LP = 66 * MiB + 256 * 1024;
constexpr size_t WS_W = 6 * MiB, WS_XB = 68 * MiB, WS_SCR = 100 * MiB, WS_END = 244 * MiB;
constexpr size_t WO_GU1 = 0, WO_D1 = WO_GU1 + (size_t)5632 * 1024, WO_IN = WO_D1 + (size_t)1024 * 2816, WO_G = WO_IN + (size_t)4096 * 1024, WO_B = WO_G + (size_t)3072 * 1024,
                 WO_O = WO_B + (size_t)3 * 1024 * 512, WO_Q = WO_O + (size_t)1024 * 1024, WO_K = WO_Q + (size_t)1024 * 1024, WO_V = WO_K + (size_t)1024 * 1024, WO_XO = WO_V + (size_t)1024 * 1024,
                 WO_GU2 = WO_XO + (size_t)1024 * 1024, WO_D2 = WO_GU2 + (size_t)5632 * 1024, WO_END = WO_D2 + (size_t)1024 * 2816;
static_assert(WS_W + (WO_END + 16 * 1024) * 2 <= WS_LP && WS_LP + 3 * 512 * 1024 <= WS_XB, "weights fit");
constexpr size_t PIECE = (size_t)M * 512;

typedef __attribute__((address_space(1))) unsigned gu32;
#define RLX_AGENT __ATOMIC_RELAXED, __HIP_MEMORY_SCOPE_AGENT
#define XB_TMO      128
#define XB_XCNT(j)  (256  + 64 * (j))
#define XB_XSUB(j)  (1280 + 64 * (j))
#define XB_XGEN(j)  (2304 + 64 * (j))
#define XB_TOP      3328
#define XB_TOPGEN   3392
#define XCD_BAR_WORDS 3456
#define XB_SPIN_CAP (1u << 18)

__device__ __forceinline__ unsigned xb_ld(unsigned* p)              { return __hip_atomic_load(p, __ATOMIC_RELAXED, __HIP_MEMORY_SCOPE_AGENT); }
__device__ __forceinline__ unsigned xb_add(unsigned* p, unsigned v) { return __hip_atomic_fetch_add(p, v, __ATOMIC_RELAXED, __HIP_MEMORY_SCOPE_AGENT); }
__device__ __forceinline__ unsigned xb_xcc_id() { return (unsigned)__builtin_amdgcn_s_getreg((3 << 11) | 20) & 0xFu; }
#define XB_SPIN(cond, bar) do { unsigned _sp = 0; while (cond) { __builtin_amdgcn_s_sleep(1); \
    if ((++_sp & 255u) == 0u) { if (xb_ld(&(bar)[XB_TMO])) break; if (_sp > XB_SPIN_CAP) { atomicAdd(&(bar)[XB_TMO], 1u); break; } } } } while (0)

struct XcdBarrier {
    unsigned* bar; unsigned x;
    volatile LAS unsigned* st;
};

__device__ __forceinline__ XcdBarrier xcd_barrier_post(unsigned* bar, volatile LAS unsigned* st) {
    XcdBarrier b; b.bar = bar; b.x = xb_xcc_id(); b.st = st;
    if (threadIdx.x == 0) (void)xb_add(&bar[XB_XCNT(b.x)], 1u);
    return b;
}
__device__ __forceinline__ void xcd_barrier_complete(unsigned* bar, unsigned x, unsigned& nloc, unsigned& nx) {
    const unsigned G = gridDim.x * gridDim.y * gridDim.z;
    unsigned sum, cnt, mine, sp = 0u;
    for (;;) {
        sum = 0u; cnt = 0u; mine = 0u;
#pragma unroll
        for (unsigned j = 0; j < 16; ++j) { const unsigned c = xb_ld(&bar[XB_XCNT(j)]); sum += c; cnt += (c > 0u) ? 1u : 0u; mine = (j == x) ? c : mine; }
        if (sum == G) break;
        __builtin_amdgcn_s_sleep(1);
        if ((++sp & 255u) == 0u) { if (xb_ld(&bar[XB_TMO])) break; if (sp > XB_SPIN_CAP) { atomicAdd(&bar[XB_TMO], 1u); break; } }
    }
    nloc = mine > 0u ? mine : 1u; nx = cnt > 0u ? cnt : 1u;
}

__device__ __forceinline__ void xcd_barrier(const XcdBarrier& b) {
    asm volatile("s_waitcnt vmcnt(0)" ::: "memory");
    __syncthreads();
    if (threadIdx.x == 0) {
        unsigned* bar = b.bar;
        __builtin_amdgcn_s_waitcnt(0);
        unsigned nloc = b.st[0], nx = b.st[1];
        if (nloc == 0u) { xcd_barrier_complete(bar, b.x, nloc, nx); b.st[0] = nloc; b.st[1] = nx; }
        const unsigned old = xb_add(&bar[XB_XSUB(b.x)], 1u);
        const unsigned gen = old / nloc;
        if (old + 1u == (gen + 1u) * nloc) {
            __builtin_amdgcn_fence(__ATOMIC_RELEASE, "agent");
            asm volatile("s_waitcnt vmcnt(0)" ::: "memory");
            const unsigned og = xb_add(&bar[XB_TOP], 1u);
            const unsigned tg = og / nx;
            if (og + 1u == (tg + 1u) * nx) xb_add(&bar[XB_TOPGEN], 1u);
            else XB_SPIN(xb_ld(&bar[XB_TOPGEN]) == tg, bar);
            __builtin_amdgcn_fence(__ATOMIC_ACQUIRE, "agent");
            xb_add(&bar[XB_XGEN(b.x)], 1u);
            asm volatile("s_waitcnt vmcnt(0)" ::: "memory");
        } else {
            XB_SPIN(xb_ld(&bar[XB_XGEN(b.x)]) == gen, bar);
            __builtin_amdgcn_fence(__ATOMIC_ACQUIRE, "agent");
            asm volatile("s_waitcnt vmcnt(0)" ::: "memory");
        }
    }
    __syncthreads();
}
struct Args { const float* in[26]; float* out; unsigned char* ws; int ph_lo, ph_hi; };

__device__ __forceinline__ unsigned f2bf(float f) { unsigned u = __builtin_bit_cast(unsigned, f); return (u + 0x7fffu + ((u >> 16) & 1u)) >> 16; }
__device__ __forceinline__ unsigned pk2(float lo, float hi) { return f2bf(lo) | (f2bf(hi) << 16); }
__device__ __forceinline__ float b2f(unsigned short b) { return __uint_as_float((unsigned)b << 16); }
__device__ __forceinline__ float wave_sum(float v) {
#pragma unroll
    for (int o = 1; o < 64; o <<= 1) v += __shfl_xor(v, o);
    return v;
}
#define LDS_WAIT() asm volatile("s_waitcnt lgkmcnt(0)" ::: "memory")
__device__ __forceinline__ void conv_item(const float* W, int spitch, int k0, int n0, bf16* WT, int dpitch, int drow0, const float* gain, LAS float* scr, int lane) {
#pragma unroll
    for (int i = 0; i < 32; ++i) { const int kk = 2 * i + (lane >> 5); float v = W[(size_t)(k0 + kk) * spitch + n0 + (lane & 31)]; if (gain) v *= gain[k0 + kk]; scr[kk * 33 + (lane & 31)] = v; }
    LDS_WAIT(); asm volatile("" ::: "memory");
    const int c = lane & 7;
#pragma unroll
    for (int j = 0; j < 4; ++j) { const int n = (lane >> 3) + 8 * j; const LAS float* s = scr + (8 * c) * 33 + n;
        v4u o; o.x = pk2(s[0 * 33], s[1 * 33]); o.y = pk2(s[2 * 33], s[3 * 33]); o.z = pk2(s[4 * 33], s[5 * 33]); o.w = pk2(s[6 * 33], s[7 * 33]);
        *(v4u*)(WT + (size_t)(drow0 + n) * dpitch + k0 + 8 * c) = o; }
    LDS_WAIT(); asm volatile("" ::: "memory");
}
__device__ __forceinline__ void conv_job(int& it, int& base, int NGW, const float* W, int spitch, int K, int scol0, int ncols, bf16* WT, int doff, bool ilv, const float* gain, LAS float* scr, int lane) {
    const int nblk = ncols / 32, nitems = (K / 64) * nblk;
    for (; it < base + nitems; it += NGW) { const int r = it - base, kb = r / nblk, nb = r % nblk, nl = 32 * nb;
        const int drow0 = ilv ? (256 * (nl / 128) + (nl % 128) + doff) : (doff + nl);
        conv_item(W, spitch, 64 * kb, scol0 + nl, WT, K, drow0, gain, scr, lane); }
    base += nitems;
}

__device__ __forceinline__ int attn_skip_tiles(const float* csh, int qb, float R) {
    const int ntf = 4 * (qb + 1); const float thr = csh[256 * qb] + 152.0f + 2.0f * R;
    int lo_ = 0, hi_ = ntf - 4;
    while (lo_ < hi_) { const int mid = (lo_ + hi_) >> 1; if (csh[64 * mid + 63] > thr) lo_ = mid + 1; else hi_ = mid; }
    return lo_ & ~1;
}
__device__ __forceinline__ int attn_chunks(int len) { int n = (len + 63) >> 6; if (n > 1 && len - 64 * (n - 1) < 4) --n; return n; }
__global__ void __launch_bounds__(NTHREADS, 2) mk_fwd(Args args) {
    __builtin_assume(__builtin_amdgcn_workitem_id_y() == 0); __builtin_assume(__builtin_amdgcn_workitem_id_z() == 0);
    extern __shared__ __attribute__((aligned(16))) unsigned char lds[];
    cg::grid_group grid = cg::this_grid();
    LAS unsigned char* ldsp = (LAS unsigned char*)lds;
    if (threadIdx.x < 2) ((volatile LAS unsigned*)(ldsp + XB_LDS_OFF))[threadIdx.x] = 0u;
    __syncthreads();
    const XcdBarrier xbar = xcd_barrier_post((unsigned*)args.ws, (volatile LAS unsigned*)(ldsp + XB_LDS_OFF));
    const int G = gridDim.x, bx = blockIdx.x;
    const int vcu = (G % 8 == 0) ? (bx % 8) * (G / 8) + bx / 8 : bx;
    const int NGW = G * NWAVES;
#define TIDS() int tid_o = threadIdx.x; asm volatile("" : "+v"(tid_o)); const int tid = tid_o, lane = tid & 63, wave = __builtin_amdgcn_readfirstlane(tid >> 6), gw = vcu * NWAVES + wave; (void)gw; (void)lane; (void)tid
#define KARGS() const __attribute__((address_space(4))) Args* ap_ = (const __attribute__((address_space(4))) Args*)__builtin_amdgcn_kernarg_segment_ptr(); asm volatile("" : "+s"(ap_))
#define ws (ap_->ws)
#define X (ap_->out)
#define SS ((float*)(ws + WS_SS))
#define SSV ((float*)(ws + WS_SSV))
#define LF ((float*)(ws + WS_LF))
#define CS ((float*)(ws + WS_CS))
#define RSM ((float*)(ws + WS_RSM))
#define MEMB ((bf16*)(ws + WS_MEMB))
#define KC ((bf16*)(ws + WS_KC))
#define VCT ((bf16*)(ws + WS_VCT))
#define Wt ((bf16*)(ws + WS_W))
#define XB ((bf16*)(ws + WS_XB))
#define SCR ((bf16*)(ws + WS_SCR))
#define ACT SCR
#define PROJ SCR
#define GT (SCR + 3 * PIECE)
#define XQ SCR
#define PB (SCR + (size_t)M * 1024)
#define OB (SCR + (size_t)2 * M * 1024)
    const int lo = args.ph_lo, hi = args.ph_hi;
#ifndef PHMASK
#define PHMASK 0xffff
#endif
#define IN(k) (((PHMASK >> (((k) == 30) ? 15 : ((k) - pb == 13 || (k) - pb == 14) ? (k) - pb - 12 : (k) - pb)) & 1) && lo <= (k) && (k) < hi)
#define GRID_SYNC() do { asm volatile("s_waitcnt vmcnt(0) lgkmcnt(0)" ::: "memory"); grid.sync(); } while (0)
#define WG_SEAM() do { asm volatile("s_waitcnt vmcnt(0) lgkmcnt(0)" ::: "memory"); __syncthreads(); } while (0)
#define SEAM_LOCAL(k) do { if (lo <= (k) && (k) + 1 < hi) { if (G == 256) WG_SEAM(); else xcd_barrier(xbar); } } while (0)
#define SEAM(k) do { if (lo <= (k) && (k) + 1 < hi) { if ((k) == 0) GRID_SYNC(); else xcd_barrier(xbar); } } while (0)
#define in (ap_->in)
int pb = 0;
#pragma nounroll
    for (int l = 0; l < NLAYER; ++l) {
        pb = 15 * l;
        if (IN(pb + 0)) { KARGS(); TIDS();
            LAS float* scr = (LAS float*)(ldsp + wave * 16384);
            const size_t l1 = (size_t)l * 1024, lff = (size_t)l * 1024 * 2816, ldd = (size_t)l * 1024 * 1024;
            constexpr int NB_FF = FF / 32, I_UP = 16 * NB_FF, I_DN = (FF / 64) * 32, I_IN = 16 * 128, I_G = 16 * 96, I_B = 8 * 32, I_SQ = 16 * 32;
            constexpr int NIT = 4 * I_UP + 2 * I_DN + I_IN + I_G + 3 * I_B + 5 * I_SQ;
#pragma nounroll
            for (int it = gw; it < NIT; it += NGW) {
                int r = it; const float* W; const float* gain = nullptr; bf16* WT; int spitch, K, scol0 = 0, nblk, doff = 0; bool ilv = false;
                if (r < 2 * I_UP) { const int w = r / I_UP; r -= w * I_UP; W = in[3 + w] + lff; gain = in[2] + l1; WT = Wt + WO_GU1; spitch = FF; K = 1024; nblk = NB_FF; doff = 128 * w; ilv = true; }
                else if ((r -= 2 * I_UP) < I_DN) { W = in[5] + lff; WT = Wt + WO_D1; spitch = 1024; K = FF; nblk = 32; }
                else if ((r -= I_DN) < I_IN) { W = in[7] + (size_t)l * 1024 * DIN; gain = in[6] + l1; WT = Wt + WO_IN; spitch = DIN; K = 1024; nblk = 128; }
                else if ((r -= I_IN) < I_G) { W = in[7] + (size_t)l * 1024 * DIN; gain = in[6] + l1; WT = Wt + WO_G; spitch = DIN; K = 1024; nblk = 96; scol0 = 4104; }
                else if ((r -= I_G) < 3 * I_B) { const int w = r / I_B; r -= w * I_B; W = in[13] + ((size_t)l * 3 + w) * 512 * 1024; WT = Wt + WO_B + (size_t)w * 1024 * 512; spitch = 1024; K = 512; nblk = 32; }
                else if ((r -= 3 * I_B) < I_SQ) { W = in[14] + ldd; WT = Wt + WO_O; spitch = 1024; K = 1024; nblk = 32; }
                else if ((r -= I_SQ) < I_SQ) { W = in[17] + ldd; gain = in[15] + l1; WT = Wt + WO_Q; spitch = 1024; K = 1024; nblk = 32; }
                else if ((r -= I_SQ) < 2 * I_SQ) { const int w = r / I_SQ; r -= w * I_SQ; W = in[18 + w] + ldd; gain = in[16] + l1; WT = Wt + WO_K + (size_t)w * 1024 * 1024; spitch = 1024; K = 1024; nblk = 32; }
                else if ((r -= 2 * I_SQ) < I_SQ) { W = in[20] + ldd; WT = Wt + WO_XO; spitch = 1024; K = 1024; nblk = 32; }
                else if ((r -= I_SQ) < 2 * I_UP) { const int w = r / I_UP; r -= w * I_UP; W = in[22 + w] + lff; gain = in[21] + l1; WT = Wt + WO_GU2; spitch = FF; K = 1024; nblk = NB_FF; doff = 128 * w; ilv = true; }
                else { r -= 2 * I_UP; W = in[24] + lff; WT = Wt + WO_D2; spitch = 1024; K = FF; nblk = 32; }
                const int kb = r / nblk, nl = 32 * (r % nblk);
                const int drow0 = ilv ? (256 * (nl / 128) + (nl % 128) + doff) : (doff + nl);
                conv_item(W, spitch, 64 * kb, scol0 + nl, WT, K, drow0, gain, scr, lane);
            }
            {
                const float* wf = in[7] + (size_t)l * 1024 * DIN + 4096; const float* gn = in[6] + l1; bf16* WF = Wt + WO_END;
                for (int idx = vcu * NTHREADS + tid; idx < 8192; idx += G * NTHREADS) { const int k = idx >> 3, hd = idx & 7;
                    const float v = wf[(size_t)k * DIN + hd] * gn[k]; const unsigned hb = f2bf(v); const float lo = v - __uint_as_float(hb << 16);
                    WF[(size_t)hd * 1024 + k] = (bf16)hb; WF[(size_t)(8 + hd) * 1024 + k] = (bf16)f2bf(lo); }
            }
            if (l == 0) {
                for (int m = gw; m < M + MEML; m += NGW) {
                    const bool ism = m >= M; const int r = ism ? m - M : m;
                    const f32x4* xr = (const f32x4*)((ism ? in[1] : in[0]) + (size_t)r * D) + lane;
                    f32x4 v[4]; float s = 0.f;
#pragma unroll
                    for (int j = 0; j < 4; ++j) { v[j] = xr[64 * j]; s += (v[j][0] * v[j][0] + v[j][1] * v[j][1]) + (v[j][2] * v[j][2] + v[j][3] * v[j][3]); }
                    s = wave_sum(s);
                    v2u* ob = (v2u*)((ism ? MEMB : XB) + (size_t)r * D) + lane;
#pragma unroll
                    for (int j = 0; j < 4; ++j) { v2u w; w.x = pk2(v[j][0], v[j][1]); w.y = pk2(v[j][2], v[j][3]); ob[64 * j] = w; }
                    if (!ism) {
                        if (lane < 16) SS[(size_t)r * 16 + lane] = lane == 0 ? s : 0.f;
                    } else if (lane == 0) RSM[r] = rsqrtf(s * (1.0f / D) + EPS);
                }
            }
        }
        SEAM(pb + 0);
#pragma nounroll
        for (int f = 0; f < 2; ++f) {
            const int pu = pb + (f == 0 ? 1 : 13), pd = pu + 1;
            if (IN(pu)) { KARGS();
                { pg8::Gemm g{XB, Wt + (f == 0 ? WO_GU1 : WO_GU2), 1024, 1024, 1024, 0, 0}; pg8::StaticOrder S; S.init(M / 256, 22, G, bx);
                  pg8::EpiSwiGLU E{SS, ACT};
#ifndef MK_REP_UP
#define MK_REP_UP 1
#endif
_Pragma("nounroll")
                  for (int rep = 0; rep < MK_REP_UP; ++rep) pg8::gemm_phase<pg8::EpiSwiGLU, pg8::StaticOrder, true, true>(ldsp, g, S, E); }
                if (f == 0) {
                    { pg8::Gemm g{MEMB, Wt + WO_K, 1024, 1024, 1024, 0, 0}; pg8::StaticOrder S; S.init(1, 4, G, bx);
                      pg8::EpiScale<2> E{RSM, KC, 1024, 1.0f}; pg8::gemm_phase<pg8::EpiScale<2>, pg8::StaticOrder, true, true>(ldsp, g, S, E); }
                    { pg8::Gemm g{Wt + WO_V, MEMB, 1024, 1024, 1024, 0, 0}; pg8::StaticOrder S; S.init(4, 1, G, bx);
                      pg8::EpiScale<3> E{RSM, VCT, 256, 1.0f}; pg8::gemm_phase<pg8::EpiScale<3>, pg8::StaticOrder, true, true>(ldsp, g, S, E); }
                }
            }
            SEAM(pu);
            if (IN(pd)) { KARGS();
                pg8::Gemm g{ACT, Wt + (f == 0 ? WO_D1 : WO_D2), FF, FF, FF, 0, 0}; pg8::StaticOrder S; S.init(M / 256, 4, G, bx);
                pg8::EpiResid E{XB, SS, 0.5f}; pg8::gemm_phase<pg8::EpiResid, pg8::StaticOrder, true, true>(ldsp, g, S, E);
            }
            SEAM(pd);
            if (f == 1) break;
            if (IN(pb + 3)) { KARGS();
                { TIDS();
                    const float* bfp = in[12] + l * 8; const bf16* WF = Wt + WO_END; const int fr = lane & 15, fq = lane >> 4;
                    for (int tile = gw; tile < M / 16; tile += NGW) {
                        const int row = 16 * tile + fr;
                        const bf16* ap = XB + (size_t)row * D + 8 * fq; const bf16* bp = WF + (size_t)fr * D + 8 * fq;
                        f32x4 acc = {0.f, 0.f, 0.f, 0.f};
#pragma unroll 8
                        for (int ks = 0; ks < 32; ++ks) { const bf16x8 a = *(const bf16x8*)(ap + 32 * ks), b = *(const bf16x8*)(bp + 32 * ks); acc = __builtin_amdgcn_mfma_f32_16x16x32_bf16(b, a, acc, 0, 0, 0); }
                        const float rs = pg8::row_rstd1(SS, row, fq);
#pragma unroll
                        for (int j = 0; j < 4; ++j) { const float t = acc[j] + __shfl_xor(acc[j], 32);
                            if (fq < 2) { const int hd = 4 * fq + j; const float z = t * rs + bfp[hd]; LF[(size_t)hd * M + row] = fminf(z, 0.f) - log1pf(expf(-fabsf(z))); } }
                    }
                }
                pg8::Gemm g{XB, Wt + WO_IN, 1024, 1024, 1024, 0, 0}; pg8::StaticOrder S; S.init(M / 256, 16, G, bx);
                pg8::EpiWin E{SS, PROJ, SSV, 0.125f * LOG2E}; pg8::gemm_phase<pg8::EpiWin, pg8::StaticOrder, true, true>(ldsp, g, S, E);
            }
            SEAM(pb + 3);
            if (IN(pb + 4)) { KARGS(); TIDS();
                if (bx < 8) {
                    const float* lf = LF + (size_t)bx * M + tid * 32; float* cs = CS + (size_t)bx * M + tid * 32;
                    f32x4 v[8]; float run = 0.f;
#pragma unroll
                    for (int i = 0; i < 8; ++i) { v[i] = *(const f32x4*)(lf + 4 * i);
#pragma unroll
                        for (int e = 0; e < 4; ++e) { run += v[i][e]; v[i][e] = run; } }
                    const double tot = (double)run; double incl = tot;
#pragma unroll
                    for (int o = 1; o < 64; o <<= 1) { const double t = __shfl_up(incl, o); if (lane >= o) incl += t; }
                    LAS double* wsum = (LAS double*)ldsp;
                    if (lane == 63) wsum[wave] = incl;
                    __syncthreads();
                    double bsum = 0.0;
                    for (int w = 0; w < wave; ++w) bsum += wsum[w];
                    const double excl = bsum + incl - tot;
#pragma unroll
                    for (int i = 0; i < 8; ++i) { f32x4 o;
#pragma unroll
                        for (int e = 0; e < 4; ++e) o[e] = (float)((excl + (double)v[i][e]) * 1.4426950408889634);
                        *(f32x4*)(cs + 4 * i) = o; }
                    __syncthreads();
                }
                {
                    unsigned* KM = (unsigned*)(ws + 32768) + 8 * l; unsigned* lmx = (unsigned*)(lds + XB_LDS_OFF + 128);
                    if (tid < 16) lmx[tid] = 0u;
                    __syncthreads();
                    for (int idx = vcu * NTHREADS + tid; idx < 2 * M * 8; idx += G * NTHREADS) {
                        const int isq = idx >= M * 8, id2 = idx - isq * M * 8; const bf16* Kp = PROJ + (isq ? 8 : 6) * PIECE;
                        const v4u* kp = (const v4u*)(Kp + (size_t)(id2 >> 3) * 512 + (id2 & 7) * 64); float s = 0.f;
#pragma unroll
                        for (int q = 0; q < 8; ++q) { const v4u w = kp[q];
#pragma unroll
                            for (int e = 0; e < 4; ++e) { const float a = pg8::bflo(w[e]), b = pg8::bfhi(w[e]); s += a * a + b * b; } }
                        s = fmaxf(s, __shfl_xor(s, 8)); s = fmaxf(s, __shfl_xor(s, 16)); s = fmaxf(s, __shfl_xor(s, 32));
                        if (lane < 8) atomicMax(lmx + 8 * isq + lane, __float_as_uint(s));
                    }
                    __syncthreads();
                    if (tid < 16) atomicMax(KM + 64 * (tid >> 3) + (tid & 7), lmx[tid]);
                }
                {
                    bf16* AB = PROJ; const bf16* AC = PROJ + 3 * PIECE; const bf16* AH = PROJ + 4 * PIECE; const float* cw = in[8] + (size_t)l * 3 * 512;
                    for (int idx = vcu * NTHREADS + tid; idx < M * 64; idx += G * NTHREADS) {
                        const int t = idx >> 6, c8 = (idx & 63) * 8; const size_t off = (size_t)t * 512 + c8;
                        const v4u bw = *(const v4u*)(AB + off);
                        float zz[3][8];
#pragma unroll
                        for (int d = 0; d < 3; ++d) {
                            if (t - d >= 0) { const v4u cv = *(const v4u*)(AC + off - (size_t)d * 512), hv = *(const v4u*)(AH + off - (size_t)d * 512);
#pragma unroll
                                for (int e = 0; e < 4; ++e) { zz[d][2 * e] = pg8::bflo(cv[e]) * pg8::bflo(hv[e]); zz[d][2 * e + 1] = pg8::bfhi(cv[e]) * pg8::bfhi(hv[e]); } }
                            else {
#pragma unroll
                                for (int e = 0; e < 8; ++e) zz[d][e] = 0.f; }
                        }
                        float y[8];
#pragma unroll
                        for (int e = 0; e < 8; ++e) { const float b = (e & 1) ? pg8::bfhi(bw[e >> 1]) : pg8::bflo(bw[e >> 1]);
                            y[e] = b * (cw[c8 + e] * zz[2][e] + cw[512 + c8 + e] * zz[1][e] + cw[1024 + c8 + e] * zz[0][e]); }
                        v4u o; o.x = pk2(y[0], y[1]); o.y = pk2(y[2], y[3]); o.z = pk2(y[4], y[5]); o.w = pk2(y[6], y[7]);
                        *(v4u*)(AB + off) = o;
                    }
                }
                {
                    bf16* UU = PROJ + 1 * PIECE; const bf16* VV = PROJ + 5 * PIECE; const float* sgn = in[9] + (size_t)l * 512; const float* sgw = in[10] + (size_t)l * 4 * 128 * 128; const float* sgb = in[11] + (size_t)l * 4 * 128;
                    LAS bf16* T = (LAS bf16*)ldsp;
                    const int fr = lane & 15, fq = lane >> 4;
                    for (int unit = vcu; unit < 512; unit += G) {
                        const int n = unit >> 2, gI = unit & 3;
                        { const int s = tid >> 2, cg0 = (tid & 3) * 32, row = 128 * n + s;
                          const f32x4 p0 = *(const f32x4*)(SSV + (size_t)row * 8), p1 = *(const f32x4*)(SSV + (size_t)row * 8 + 4);
                          const float rv = rsqrtf(((p0[0] + p0[1]) + (p0[2] + p0[3]) + (p1[0] + p1[1]) + (p1[2] + p1[3])) * (1.0f / 512.0f) + EPS);
#pragma unroll
                          for (int q = 0; q < 4; ++q) { const int c = cg0 + 8 * q; const v4u vw = *(const v4u*)(VV + (size_t)row * 512 + 128 * gI + c);
                              const f32x4 ga = *(const f32x4*)(sgn + 128 * gI + c), gb = *(const f32x4*)(sgn + 128 * gI + c + 4);
#pragma unroll
                              for (int e = 0; e < 4; ++e) { const float g0 = e < 2 ? ga[2 * e] : gb[2 * e - 4], g1 = e < 2 ? ga[2 * e + 1] : gb[2 * e - 3];
                                  T[(c + 2 * e) * 136 + s] = (bf16)f2bf(pg8::bflo(vw[e]) * rv * g0); T[(c + 2 * e + 1) * 136 + s] = (bf16)f2bf(pg8::bfhi(vw[e]) * rv * g1); } } }
                        __syncthreads();
                        f32x4 acc[8];
#pragma unroll
                        for (int j = 0; j < 8; ++j) acc[j] = (f32x4){0.f, 0.f, 0.f, 0.f};
                        const int t = 16 * wave + fr;
                        for (int kk = 0; kk <= (wave >> 1); ++kk) {
                            const int s0 = 32 * kk + 8 * fq; const float* wp = sgw + ((size_t)gI * 128 + t) * 128 + s0;
                            const f32x4 w0 = *(const f32x4*)wp, w1 = *(const f32x4*)(wp + 4);
                            float wv[8] = {w0[0], w0[1], w0[2], w0[3], w1[0], w1[1], w1[2], w1[3]};
#pragma unroll
                            for (int e = 0; e < 8; ++e) if (s0 + e > t) wv[e] = 0.f;
                            v4u aw; aw.x = pk2(wv[0], wv[1]); aw.y = pk2(wv[2], wv[3]); aw.z = pk2(wv[4], wv[5]); aw.w = pk2(wv[6], wv[7]);
                            const bf16x8 afr = __builtin_bit_cast(bf16x8, aw);
#pragma unroll
                            for (int j = 0; j < 8; ++j) { const bf16x8 bfr = *(const LAS bf16x8*)(T + (16 * j + fr) * 136 + s0); acc[j] = __builtin_amdgcn_mfma_f32_16x16x32_bf16(bfr, afr, acc[j], 0, 0, 0); }
                        }
                        const float bias = sgb[gI * 128 + t]; const size_t rowoff = (size_t)(128 * n + t) * 512 + 128 * gI;
#pragma unroll
                        for (int j = 0; j < 8; ++j) { const int c = 16 * j + 4 * fq; const v2u uw = *(const v2u*)(UU + rowoff + c);
                            v2u o; o.x = pk2(pg8::bflo(uw.x) * (acc[j][0] + bias), pg8::bfhi(uw.x) * (acc[j][1] + bias)); o.y = pk2(pg8::bflo(uw.y) * (acc[j][2] + bias), pg8::bfhi(uw.y) * (acc[j][3] + bias));
                            *(v2u*)(UU + rowoff + c) = o; }
                        __syncthreads();
                    }
                }
            }
            SEAM(pb + 4);
            if (IN(pb + 5)) { KARGS();
                TIDS();
                const attn_body::AttnTensors AT{(const attn_body::bf16*)(PROJ + 8 * PIECE), (const attn_body::bf16*)(PROJ + 6 * PIECE), (const attn_body::bf16*)(PROJ + 7 * PIECE), (attn_body::bf16*)(PROJ + 2 * PIECE), CS, (const unsigned*)(ws + 32768) + 8 * l};
                unsigned* qctr = (unsigned*)(ws + 40960) + 64 * l;
                volatile LAS unsigned* qw = (volatile LAS unsigned*)(ldsp + XB_LDS_OFF + 64);
                volatile LAS unsigned* T0 = (volatile LAS unsigned*)(ldsp + T0_LDS_OFF);
                {   const int hd = tid & 7, qb = 63 - (tid >> 3);
                    const float km2 = __uint_as_float(__hip_atomic_load(AT.KM + hd, __ATOMIC_RELAXED, __HIP_MEMORY_SCOPE_AGENT)), qm2 = __uint_as_float(__hip_atomic_load(AT.KM + 64 + hd, __ATOMIC_RELAXED, __HIP_MEMORY_SCOPE_AGENT));
                    T0[tid] = (unsigned)attn_skip_tiles(CS + (size_t)hd * M, qb, sqrtf(km2 * qm2) * 1.001f + 0.01f); }
                __syncthreads();
#pragma nounroll
                for (;;) {
                    if (tid == 0) qw[0] = __hip_atomic_fetch_add(qctr, 1u, __ATOMIC_RELAXED, __HIP_MEMORY_SCOPE_AGENT);
                    __syncthreads();
                    const unsigned idx = qw[0];
                    __syncthreads();
                    if (idx >= 2048u) break;
                    const int c = (int)(idx >> 9), un = (int)(idx & 511u), qb = 63 - (un >> 3), hd = un & 7, ntf = 4 * (qb + 1);
                    const int t0 = (int)T0[un], len = ntf - t0, n = attn_chunks(len);
                    if (c >= n) continue;
                    const bool last = (c == n - 1); const int tb = t0 + 64 * c, ntl = last ? ntf - tb : 64;
                    attn_body::bf16* Oc = (attn_body::bf16*)(PROJ + (last ? 2 : 3 + c) * PIECE);
                    float* Lc = last ? (float*)(ws + WS_LPL) : (float*)(ws + WS_LP) + (size_t)c * M * 8;
                    attn_body::attn_unit<8>(0, hd, qb, AT.Q, AT.K, AT.V, Oc, CS, AT.KM, (char*)lds, tb, ntl, last, Lc);
                }
                __syncthreads();
            }
            SEAM(pb + 5);
            if (IN(pb + 6)) { KARGS();
                {
                    TIDS(); const unsigned* KMp = (const unsigned*)(ws + 32768) + 8 * l;
                    for (int un = vcu; un < 512; un += G) {
                        const int qb = 63 - (un >> 3), hd = un & 7, ntf = 4 * (qb + 1);
                        const float km2 = __uint_as_float(__hip_atomic_load(KMp + hd, __ATOMIC_RELAXED, __HIP_MEMORY_SCOPE_AGENT)), qm2 = __uint_as_float(__hip_atomic_load(KMp + 64 + hd, __ATOMIC_RELAXED, __HIP_MEMORY_SCOPE_AGENT));
                        const int t0 = attn_skip_tiles(CS + (size_t)hd * M, qb, sqrtf(km2 * qm2) * 1.001f + 0.01f), n = attn_chunks(ntf - t0);
                        if (n <= 1) continue;
                        for (int it = tid; it < 2048; it += NTHREADS) { const int row = 256 * qb + (it >> 3); const size_t off = (size_t)row * 512 + hd * 64 + (it & 7) * 8;
                            float lw = ((const float*)(ws + WS_LPL))[(size_t)row * 8 + hd], ls = lw; const v4u yw = *(const v4u*)(PROJ + 2 * PIECE + off);
                            float y[8];
#pragma unroll
                            for (int e = 0; e < 4; ++e) { y[2 * e] = pg8::bflo(yw[e]) * lw; y[2 * e + 1] = pg8::bfhi(yw[e]) * lw; }
                            for (int c = 0; c < n - 1; ++c) { const float lc = ((const float*)(ws + WS_LP))[((size_t)c * M + row) * 8 + hd]; ls += lc; const v4u pw = *(const v4u*)(PROJ + (size_t)(3 + c) * PIECE + off);
#pragma unroll
                                for (int e = 0; e < 4; ++e) { y[2 * e] += pg8::bflo(pw[e]) * lc; y[2 * e + 1] += pg8::bfhi(pw[e]) * lc; } }
                            const float inv = 1.0f / ls; v4u o; o.x = pk2(y[0] * inv, y[1] * inv); o.y = pk2(y[2] * inv, y[3] * inv); o.z = pk2(y[4] * inv, y[5] * inv); o.w = pk2(y[6] * inv, y[7] * inv);
                            *(v4u*)(PROJ + 2 * PIECE + off) = o; }
                    }
                }
                pg8::Gemm g{XB, Wt + WO_G, 1024, 1024, 1024, 0, 0}; pg8::StaticOrder S; S.init(M / 256, 12, G, bx);
                pg8::EpiGates E{SS, GT}; pg8::gemm_phase<pg8::EpiGates, pg8::StaticOrder, true, true>(ldsp, g, S, E);
            }
            SEAM(pb + 6);
            if (IN(pb + 7)) { KARGS();
                pg8::Gemm g{PROJ, Wt + WO_B, 512, 512, 512, PIECE * 2, (size_t)1024 * 512 * 2}; pg8::ZOrder<3> S; S.S.init(M / 256, 4, G, bx);
                pg8::EpiMerge E{GT}; pg8::gemm_phase<pg8::EpiMerge, pg8::ZOrder<3>, true, true>(ldsp, g, S, E);
            }
            SEAM(pb + 7);
            if (IN(pb + 8)) { KARGS();
                pg8::Gemm g{GT, Wt + WO_O, 1024, 1024, 1024, 0, 0}; pg8::StaticOrder S; S.init(M / 256, 4, G, bx);
                pg8::EpiResid E{XB, SS, 1.0f}; pg8::gemm_phase<pg8::EpiResid, pg8::StaticOrder, true, true>(ldsp, g, S, E);
            }
            SEAM(pb + 8);
            if (IN(pb + 9)) { KARGS();
                pg8::Gemm g{XB, Wt + WO_Q, 1024, 1024, 1024, 0, 0}; pg8::EpiScale<1> E{SS, XQ, 1024, 0.0625f * LOG2E};
                for (int Lx = vcu; Lx < 256; Lx += G) { pg8::OneUnit S; S.u0.pm = Lx >> 2; S.u0.pn = Lx & 3; S.u0.z = 0; pg8::gemm_phase<pg8::EpiScale<1>, pg8::OneUnit, true, true>(ldsp, g, S, E); }
            }
            SEAM_LOCAL(pb + 9);
            if (IN(pb + 10)) { KARGS();
                pg8::Gemm g{XQ, KC, 256, 1024, 1024, 512, 512}; pg8::EpiSoftmax E{PB};
                for (int Lx = vcu; Lx < 256; Lx += G) { pg8::OneUnit S; S.u0.pm = Lx >> 2; S.u0.pn = 0; S.u0.z = Lx & 3; pg8::gemm_phase<pg8::EpiSoftmax, pg8::OneUnit, false, true>(ldsp, g, S, E); }
            }
            SEAM_LOCAL(pb + 10);
            if (IN(pb + 11)) { KARGS();
                pg8::Gemm g{PB, VCT, 256, 1024, 256, 512, (size_t)256 * 256 * 2}; pg8::EpiScale<0> E{nullptr, OB, 1024, 1.0f};
                for (int Lx = vcu; Lx < 256; Lx += G) { pg8::OneUnit S; S.u0.pm = Lx >> 2; S.u0.pn = 0; S.u0.z = Lx & 3; pg8::gemm_phase<pg8::EpiScale<0>, pg8::OneUnit, true, true>(ldsp, g, S, E); }
            }
            SEAM(pb + 11);
            if (IN(pb + 12)) { KARGS();
                pg8::Gemm g{OB, Wt + WO_XO, 1024, 1024, 1024, 0, 0}; pg8::StaticOrder S; S.init(M / 256, 4, G, bx);
                pg8::EpiResid E{XB, SS, 1.0f}; pg8::gemm_phase<pg8::EpiResid, pg8::StaticOrder, true, true>(ldsp, g, S, E);
            }
            SEAM(pb + 12);
        }
    }
#ifdef MK_DUMP_OFF
    {
        GRID_SYNC(); KARGS(); int t_ = threadIdx.x; asm volatile("" : "+v"(t_));
        const bf16* src = SCR + (size_t)(MK_DUMP_OFF);
        for (unsigned i = blockIdx.x * 512u + (unsigned)t_; i < (unsigned)M * 1024u; i += gridDim.x * 512u) { const unsigned m = i >> 10, c = i & 1023u;
            X[i] = c < (unsigned)(MK_DUMP_LD) ? b2f(src[(size_t)m * (MK_DUMP_LD) + c]) : 0.f; }
    }
#endif
    if (IN(30)) { KARGS(); TIDS();
        const float* gf = in[25];
        for (int m = gw; m < M; m += NGW) {
            const v2u* xb = (const v2u*)(XB + (size_t)m * D) + lane; f32x4* xr = (f32x4*)(X + (size_t)m * D) + lane; f32x4 v[4]; float s = 0.f;
#pragma unroll
            for (int j = 0; j < 4; ++j) { const v2u xw = xb[64 * j]; v[j] = (f32x4){pg8::bflo(xw.x), pg8::bfhi(xw.x), pg8::bflo(xw.y), pg8::bfhi(xw.y)}; s += (v[j][0] * v[j][0] + v[j][1] * v[j][1]) + (v[j][2] * v[j][2] + v[j][3] * v[j][3]); }
            const float r = rsqrtf(wave_sum(s) * (1.0f / D) + EPS);
#pragma unroll
            for (int j = 0; j < 4; ++j) xr[64 * j] = v[j] * r * *((const f32x4*)gf + lane + 64 * j);
        }
    }
#undef IN
#undef SEAM
#undef ws
#undef X
#undef SS
#undef SSV
#undef LF
#undef CS
#undef RSM
#undef MEMB
#undef KC
#undef VCT
#undef Wt
#undef XB
#undef SCR
#undef ACT
#undef PROJ
#undef GT
#undef XQ
#undef PB
#undef OB
#undef in
}

#ifndef MK_PER_PHASE
#define MK_PER_PHASE 0
#endif
extern "C" void kernel_launch(void* const* d_in, const int* in_sizes, int n_in, void* d_out, int out_size, void* d_ws, size_t ws_size, hipStream_t stream) {
    static int grid = 0;
    if (grid == 0) {
        if (n_in != 26 || out_size != M * D || ws_size < WS_END) { fprintf(stderr, "kernel_launch: unexpected shapes (n_in %d out %d ws %zu)\n", n_in, out_size, ws_size); grid = -1; return; }
        int dev = 0, cus = 0, per_cu = 0;
        (void)hipGetDevice(&dev); (void)hipDeviceGetAttribute(&cus, hipDeviceAttributeMultiprocessorCount, dev);
        if (hipFuncSetAttribute((const void*)mk_fwd, hipFuncAttributeMaxDynamicSharedMemorySize, LDS_BYTES) != hipSuccess) { fprintf(stderr, "kernel_launch: hipFuncSetAttribute failed\n"); grid = -1; return; }
        if (hipOccupancyMaxActiveBlocksPerMultiprocessor(&per_cu, (const void*)mk_fwd, NTHREADS, LDS_BYTES) != hipSuccess || per_cu < 1) { fprintf(stderr, "kernel_launch: occupancy query says %d\n", per_cu); per_cu = 1; }
        (void)hipGetLastError();
        grid = cus > 0 ? cus : 256;
    }
    if (grid < 0) return;
    (void)hipMemsetAsync(d_ws, 0, 65536, stream);
    Args a{};
    for (int i = 0; i < 26; ++i) a.in[i] = (const float*)d_in[i];
    a.out = (float*)d_out; a.ws = (unsigned char*)d_ws;
#if MK_PER_PHASE
    for (int p = 0; p < 31; ++p) { a.ph_lo = p; a.ph_hi = p + 1; void* kargs[] = {&a};
        hipError_t e = hipLaunchCooperativeKernel((const void*)mk_fwd, dim3(grid), dim3(NTHREADS), kargs, LDS_BYTES, stream);
        if (e != hipSuccess) { fprintf(stderr, "launch %d failed: %s\n", p, hipGetErrorString(e)); break; } }
#else
#ifndef MK_PH_HI
#define MK_PH_HI 31
#endif
    a.ph_lo = 0; a.ph_hi = MK_PH_HI; void* kargs[] = {&a};
    hipError_t e = hipLaunchCooperativeKernel((const void*)mk_fwd, dim3(grid), dim3(NTHREADS), kargs, LDS_BYTES, stream);
    if (e != hipSuccess) fprintf(stderr, "cooperative launch failed: %s (grid %d)\n", hipGetErrorString(e), grid);
#endif
}
```

```cpp
#include <hip/hip_runtime.h>
#include <hip/hip_cooperative_groups.h>
#include <cstdio>
#include <cstdint>
namespace cg = cooperative_groups;

namespace pg8 {
#define PG8_LAS __attribute__((address_space(3)))
typedef unsigned short bf16_t;
typedef short bf16x8 __attribute__((ext_vector_type(8)));
typedef float f32x4 __attribute__((ext_vector_type(4)));
typedef unsigned u32x4 __attribute__((ext_vector_type(4)));
constexpr int BM = 256, BK = 64, HALF = 128, HTB = HALF * BK * 2  , STAGE_BYTES = 8 * HTB, NXCD = 8, WGM = 8;

__host__ __device__ __forceinline__ int lds_byte(int r, int c) { const int st = (r >> 4) * 2 + (c >> 5), rr = r & 15, cc = c & 31, ob = rr * 64 + cc * 2; return st * 1024 + (ob ^ (((ob >> 9) & 1) << 5)); }
__host__ __device__ __forceinline__ void stage_rc(int b, int& R, int& C) { const int st = b / 1024, sb = b % 1024, swz = sb ^ (((sb >> 9) & 1) << 5); R = (st >> 1) * 16 + swz / 64; C = (st & 1) * 32 + (swz % 64) / 2; }
__host__ __device__ __forceinline__ int perm32(int rho) { const int n = rho >> 4, i = rho & 15; return 8 * (i >> 2) + 4 * n + (i & 3); }

struct Unit { int pm, pn, z; };
typedef float f32x2 __attribute__((ext_vector_type(2))); typedef __bf16 bf16x2_cv __attribute__((ext_vector_type(2)));
__device__ __forceinline__ unsigned cvt_pk_bf16(float lo, float hi) { const f32x2 v = {lo, hi}; const bf16x2_cv b = __builtin_convertvector(v, bf16x2_cv); return __builtin_bit_cast(unsigned, b); }
struct Gemm { const bf16_t* A; const bf16_t* Bt; int K, lda, ldb; size_t zA, zB; };

struct StaticOrder {
    int nM, nN, nwg, G, c;
    __host__ __device__ void init(int nM_, int nN_, int G_, int c_) { nM = nM_; nN = nN_; nwg = nM * nN; G = G_; c = c_; }
    __host__ __device__ void map(int wgid, Unit& u) const {
        { const int q = nwg / NXCD, r = nwg % NXCD, xcd = wgid % NXCD, off = wgid / NXCD; wgid = (xcd < r ? xcd * (q + 1) : r * (q + 1) + (xcd - r) * q) + off; }
        const int nig = WGM * nN, gid = wgid / nig, fm = gid * WGM, gsz = (nM - fm) < WGM ? (nM - fm) : WGM;
        u.pm = fm + ((wgid % nig) % gsz); u.pn = (wgid % nig) / gsz; u.z = 0;
    }
    __host__ __device__ bool next(int i, Unit& u) const { const long L = (long)i * G + c; if (L >= nwg) return false; map((int)L, u); return true; }
    __device__ __forceinline__ void a_ready(const Unit&) const {}
    __device__ __forceinline__ void done(const Unit&) const {}
};
template <int NZ> struct ZOrder {
    StaticOrder S;
    __host__ __device__ bool next(int i, Unit& u) const { const long L = (long)(i / NZ) * S.G + S.c; if (L >= S.nwg) return false; S.map((int)L, u); u.z = i % NZ; return true; }
    __device__ __forceinline__ void a_ready(const Unit&) const {}
    __device__ __forceinline__ void done(const Unit&) const {}
};
struct OneUnit {
    Unit u0;
    __host__ __device__ bool next(int i, Unit& u) const { if (i > 0) return false; u = u0; return true; }
    __device__ __forceinline__ void a_ready(const Unit&) const {}
    __device__ __forceinline__ void done(const Unit&) const {}
};

typedef unsigned u32x2 __attribute__((ext_vector_type(2)));
constexpr float LOG2E = 1.4426950408889634f;
__device__ __forceinline__ float bf2f(unsigned short b) { return __uint_as_float((unsigned)b << 16); }
__device__ __forceinline__ float bflo(unsigned w) { return __uint_as_float(w << 16); }
__device__ __forceinline__ float bfhi(unsigned w) { return __uint_as_float(w & 0xffff0000u); }
__device__ __forceinline__ float sigmoidf_(float v) { return __builtin_amdgcn_rcpf(1.0f + __builtin_amdgcn_exp2f(-v * LOG2E)); }
__device__ __forceinline__ float gelu_tanh(float v) { const float z = 0.7978845608028654f * (v + 0.044715f * v * v * v); return v * sigmoidf_(2.0f * z); }
__device__ __forceinline__ u32x4 pack8(const f32x4 a, const f32x4 b) { u32x4 w; w.x = cvt_pk_bf16(a[0], a[1]); w.y = cvt_pk_bf16(a[2], a[3]); w.z = cvt_pk_bf16(b[0], b[1]); w.w = cvt_pk_bf16(b[2], b[3]); return w; }
__device__ __forceinline__ void row_rstd(const float* SS, int rowbase, int fq, float (&rs)[2][4]) {
#pragma unroll
    for (int ai = 0; ai < 2; ++ai)
#pragma unroll
        for (int m = 0; m < 4; ++m) { const f32x4 v = *(const f32x4*)(SS + (size_t)(rowbase + ai * HALF + m * 16) * 16 + 4 * fq);
            float s = (v[0] + v[1]) + (v[2] + v[3]); s += __shfl_xor(s, 16); s += __shfl_xor(s, 32); rs[ai][m] = rsqrtf(s * (1.0f / 1024.0f) + 1e-6f); }
}
__device__ __forceinline__ float row_rstd1(const float* SS, int row, int fq) { const f32x4 v = *(const f32x4*)(SS + (size_t)row * 16 + 4 * fq);
    float s = (v[0] + v[1]) + (v[2] + v[3]); s += __shfl_xor(s, 16); s += __shfl_xor(s, 32); return rsqrtf(s * (1.0f / 1024.0f) + 1e-6f); }
#define EPI_ARGS const f32x4 (&acc)[2][2][4][2], const Unit& u, int wr, int wc, int fr, int fq
struct EpiSwiGLU { static constexpr bool PERM = true, AFTER_DRAIN = false; const float* SS; bf16_t* O;
    __device__ __forceinline__ void operator()(EPI_ARGS) const {
        float rs[2][4]; row_rstd(SS, u.pm * BM + wr * 64 + fr, fq, rs);
        const int col0 = u.pn * 128 + wc * 32 + 8 * fq;
#pragma unroll
        for (int ai = 0; ai < 2; ++ai)
#pragma unroll
            for (int m = 0; m < 4; ++m) { const float r = rs[ai][m]; f32x4 o[2];
#pragma unroll
                for (int n = 0; n < 2; ++n)
#pragma unroll
                    for (int j = 0; j < 4; ++j) { const float g = acc[ai][0][m][n][j] * r, up = acc[ai][1][m][n][j] * r; o[n][j] = g * sigmoidf_(g) * up; }
                *(u32x4*)(O + (size_t)(u.pm * BM + ai * HALF + wr * 64 + m * 16 + fr) * 2816 + col0) = pack8(o[0], o[1]); }
    }
};
struct EpiResid { static constexpr bool PERM = false, AFTER_DRAIN = false; bf16_t* XB; float* SS; float scale;
    __device__ __forceinline__ void operator()(EPI_ARGS) const {
        const int col0 = u.pn * BM + wc * 32 + 4 * fq;
#pragma unroll
        for (int ai = 0; ai < 2; ++ai)
#pragma unroll
            for (int m = 0; m < 4; ++m) { const int row = u.pm * BM + ai * HALF + wr * 64 + m * 16 + fr; float ssq = 0.f;
#pragma unroll
                for (int bj = 0; bj < 2; ++bj)
#pragma unroll
                    for (int n = 0; n < 2; ++n) { const size_t off = (size_t)row * 1024 + col0 + bj * HALF + n * 16;
                        const u32x2 xw = *(const u32x2*)(XB + off);
                        f32x4 x = {bflo(xw.x), bfhi(xw.x), bflo(xw.y), bfhi(xw.y)}; x = x + acc[ai][bj][m][n] * scale;
                        u32x2 w; w.x = cvt_pk_bf16(x[0], x[1]); w.y = cvt_pk_bf16(x[2], x[3]); *(u32x2*)(XB + off) = w;
                        ssq += (x[0] * x[0] + x[1] * x[1]) + (x[2] * x[2] + x[3] * x[3]); }
                ssq += __shfl_xor(ssq, 16); ssq += __shfl_xor(ssq, 32);
                if (fq == 0) SS[(size_t)row * 16 + u.pn * 4 + wc] = ssq; }
    }
};
struct EpiWin { static constexpr bool PERM = true, AFTER_DRAIN = false; const float* SS; bf16_t* P; float* SSV; float qscale;
    __device__ __forceinline__ void operator()(EPI_ARGS) const {
        const int piece = u.pn >> 1;
        const int slot = piece == 0 ? 0 : piece == 1 ? 3 : piece == 2 ? 4 : piece == 3 ? 1 : piece == 4 ? 5 : piece == 5 ? 8 : piece;
        bf16_t* base = P + (size_t)slot * (16384u * 512u);
        const int col0 = (u.pn & 1) * 256 + wc * 32 + 8 * fq;
        const float sc = piece == 5 ? qscale : 1.0f;
#pragma unroll
        for (int ai = 0; ai < 2; ++ai)
#pragma unroll
            for (int m = 0; m < 4; ++m) { const int row = u.pm * BM + ai * HALF + wr * 64 + m * 16 + fr; const float r = row_rstd1(SS, row, fq) * sc; float ssq = 0.f;
#pragma unroll
                for (int bj = 0; bj < 2; ++bj) { f32x4 v0 = acc[ai][bj][m][0] * r, v1 = acc[ai][bj][m][1] * r;
                    if (piece == 3 || piece == 4) {
#pragma unroll
                        for (int j = 0; j < 4; ++j) { v0[j] = gelu_tanh(v0[j]); v1[j] = gelu_tanh(v1[j]); }
                        ssq += (v0[0] * v0[0] + v0[1] * v0[1]) + (v0[2] * v0[2] + v0[3] * v0[3]) + (v1[0] * v1[0] + v1[1] * v1[1]) + (v1[2] * v1[2] + v1[3] * v1[3]); }
                    *(u32x4*)(base + (size_t)row * 512 + col0 + bj * HALF) = pack8(v0, v1); }
                if (piece == 4) { ssq += __shfl_xor(ssq, 16); ssq += __shfl_xor(ssq, 32); if (fq == 0) SSV[(size_t)row * 8 + (u.pn & 1) * 4 + wc] = ssq; }
                asm volatile("" ::: "memory"); }
    }
};
struct EpiGates { static constexpr bool PERM = true, AFTER_DRAIN = false; const float* SS; bf16_t* G;
    __device__ __forceinline__ void operator()(EPI_ARGS) const {
        float rs[2][4]; row_rstd(SS, u.pm * BM + wr * 64 + fr, fq, rs);
        bf16_t* base = G + (size_t)(u.pn >> 2) * (16384u * 1024u);
        const int col0 = (u.pn & 3) * 256 + wc * 32 + 8 * fq;
#pragma unroll
        for (int ai = 0; ai < 2; ++ai)
#pragma unroll
            for (int m = 0; m < 4; ++m) { const int row = u.pm * BM + ai * HALF + wr * 64 + m * 16 + fr; const float r = rs[ai][m];
#pragma unroll
                for (int bj = 0; bj < 2; ++bj) { f32x4 v0 = acc[ai][bj][m][0] * r, v1 = acc[ai][bj][m][1] * r;
#pragma unroll
                    for (int j = 0; j < 4; ++j) { v0[j] = sigmoidf_(v0[j]); v1[j] = sigmoidf_(v1[j]); }
                    *(u32x4*)(base + (size_t)row * 1024 + col0 + bj * HALF) = pack8(v0, v1); } }
    }
};
struct EpiMerge { static constexpr bool PERM = true, AFTER_DRAIN = false; bf16_t* G;
    __device__ __forceinline__ void operator()(EPI_ARGS) const {
        const bf16_t* gz = G + (size_t)u.z * (16384u * 1024u);
        const int col0 = u.pn * 256 + wc * 32 + 8 * fq;
#pragma unroll
        for (int ai = 0; ai < 2; ++ai)
#pragma unroll
            for (int m = 0; m < 4; ++m) { const int row = u.pm * BM + ai * HALF + wr * 64 + m * 16 + fr;
#pragma unroll
                for (int bj = 0; bj < 2; ++bj) { const size_t off = (size_t)row * 1024 + col0 + bj * HALF;
                    const u32x4 gw = *(const u32x4*)(gz + off);
                    f32x4 g0 = {bflo(gw.x), bfhi(gw.x), bflo(gw.y), bfhi(gw.y)}, g1 = {bflo(gw.z), bfhi(gw.z), bflo(gw.w), bfhi(gw.w)};
                    f32x4 v0 = acc[ai][bj][m][0] * g0, v1 = acc[ai][bj][m][1] * g1;
#ifdef MK_DBG_Z
                    if (u.z != MK_DBG_Z) { v0 = v0 * 0.f; v1 = v1 * 0.f; }
#endif
                    if (u.z != 0) { u32x4 pw; { const unsigned long long a_ = __hip_atomic_load((const unsigned long long*)(G + off), __ATOMIC_RELAXED, __HIP_MEMORY_SCOPE_AGENT), b_ = __hip_atomic_load((const unsigned long long*)(G + off) + 1, __ATOMIC_RELAXED, __HIP_MEMORY_SCOPE_AGENT);
                            pw.x = (unsigned)a_; pw.y = (unsigned)(a_ >> 32); pw.z = (unsigned)b_; pw.w = (unsigned)(b_ >> 32); }
                        v0 = v0 + (f32x4){bflo(pw.x), bfhi(pw.x), bflo(pw.y), bfhi(pw.y)}; v1 = v1 + (f32x4){bflo(pw.z), bfhi(pw.z), bflo(pw.w), bfhi(pw.w)}; }
                    *(u32x4*)(G + off) = pack8(v0, v1); } }
    }
};
template <int MODE> struct EpiScale { static constexpr bool PERM = true, AFTER_DRAIN = false; const float* S; bf16_t* O; int ldc; float scale;
    __device__ __forceinline__ void operator()(EPI_ARGS) const {
        float rs[2][4];
        if (MODE == 1) row_rstd(S, u.pm * BM + wr * 64 + fr, fq, rs);
        const int col0 = (u.pn + u.z) * 256 + wc * 32 + 8 * fq;
#pragma unroll
        for (int ai = 0; ai < 2; ++ai)
#pragma unroll
            for (int m = 0; m < 4; ++m) { const int row = u.pm * BM + ai * HALF + wr * 64 + m * 16 + fr;
                float r = scale; if (MODE == 1) r *= rs[ai][m]; if (MODE == 2) r *= S[row];
#pragma unroll
                for (int bj = 0; bj < 2; ++bj) { f32x4 v0 = acc[ai][bj][m][0] * r, v1 = acc[ai][bj][m][1] * r;
                    if (MODE == 3) { v0 = v0 * *(const f32x4*)(S + col0 + bj * HALF); v1 = v1 * *(const f32x4*)(S + col0 + bj * HALF + 4); }
                    *(u32x4*)(O + (size_t)row * ldc + col0 + bj * HALF) = pack8(v0, v1); } }
    }
};
struct EpiSoftmax { static constexpr bool PERM = true, AFTER_DRAIN = true; bf16_t* O;
    __device__ __forceinline__ void fused(f32x4 (&acc)[2][2][4][2], const Unit& u, int wr, int wc, int fr, int fq, PG8_LAS unsigned char* lds, int wid, int lane) const {
        PG8_LAS float* T1 = (PG8_LAS float*)lds; PG8_LAS float* T2 = (PG8_LAS float*)(lds + 4096);
#pragma unroll
        for (int ai = 0; ai < 2; ++ai)
#pragma unroll
            for (int m = 0; m < 4; ++m) { float mx = -3.0e38f;
#pragma unroll
                for (int bj = 0; bj < 2; ++bj)
#pragma unroll
                    for (int n = 0; n < 2; ++n)
#pragma unroll
                        for (int j = 0; j < 4; ++j) mx = fmaxf(mx, acc[ai][bj][m][n][j]);
                mx = fmaxf(mx, __shfl_xor(mx, 16)); mx = fmaxf(mx, __shfl_xor(mx, 32));
                if (fq == 0) T1[(ai * HALF + wr * 64 + m * 16 + fr) * 4 + wc] = mx; }
        asm volatile("s_waitcnt lgkmcnt(0)" ::: "memory"); __builtin_amdgcn_s_barrier(); asm volatile("" ::: "memory");
#pragma unroll
        for (int ai = 0; ai < 2; ++ai)
#pragma unroll
            for (int m = 0; m < 4; ++m) { const int rl = ai * HALF + wr * 64 + m * 16 + fr; const f32x4 t = *(const PG8_LAS f32x4*)(T1 + rl * 4);
                const float mx = fmaxf(fmaxf(t[0], t[1]), fmaxf(t[2], t[3])); float s = 0.f;
#pragma unroll
                for (int bj = 0; bj < 2; ++bj)
#pragma unroll
                    for (int n = 0; n < 2; ++n)
#pragma unroll
                        for (int j = 0; j < 4; ++j) { const float p = __builtin_amdgcn_exp2f(acc[ai][bj][m][n][j] - mx); acc[ai][bj][m][n][j] = p; s += p; }
                s += __shfl_xor(s, 16); s += __shfl_xor(s, 32);
                if (fq == 0) T2[rl * 4 + wc] = s; }
        asm volatile("s_waitcnt lgkmcnt(0)" ::: "memory"); __builtin_amdgcn_s_barrier(); asm volatile("" ::: "memory");
        const int col0 = u.z * 256 + wc * 32 + 8 * fq;
#pragma unroll
        for (int ai = 0; ai < 2; ++ai)
#pragma unroll
            for (int m = 0; m < 4; ++m) { const int rl = ai * HALF + wr * 64 + m * 16 + fr; const f32x4 t = *(const PG8_LAS f32x4*)(T2 + rl * 4);
                const float inv = 1.0f / ((t[0] + t[1]) + (t[2] + t[3]));
#pragma unroll
                for (int bj = 0; bj < 2; ++bj) *(u32x4*)(O + (size_t)(u.pm * BM + rl) * 1024 + col0 + bj * HALF) = pack8(acc[ai][bj][m][0] * inv, acc[ai][bj][m][1] * inv); }
        asm volatile("s_waitcnt lgkmcnt(0)" ::: "memory"); __builtin_amdgcn_s_barrier(); asm volatile("" ::: "memory");
    }
};

template <class Epi, class Sched, bool ALIGN_EPI = false, bool SP2 = false>
__device__ __forceinline__ void gemm_phase(PG8_LAS unsigned char* lds, const Gemm g, const Sched& S, const Epi& E) {
    int tid_o = threadIdx.x; asm volatile("" : "+v"(tid_o)); const int tid = tid_o, wid = __builtin_amdgcn_readfirstlane(tid >> 6), lane = tid & 63, wr = wid >> 2, wc = wid & 3, fr = lane & 15, fq = lane >> 4;
    const int nt = g.K / BK; const char* gA_ = reinterpret_cast<const char*>(g.A); const char* gB_ = reinterpret_cast<const char*>(g.Bt); asm volatile("" : "+s"(gA_), "+s"(gB_));
    unsigned voffA[2], voffB[2];
#pragma unroll
    for (int i = 0; i < 2; ++i) { int R, C; stage_rc(tid * 16 + i * 8192, R, C); const int Rb = Epi::PERM ? ((R & ~31) + perm32(R & 31)) : R;
        voffA[i] = (unsigned)(R * g.lda + C) * 2u; voffB[i] = (unsigned)(Rb * g.ldb + C) * 2u; }
    const size_t kstep = (size_t)(BK * 2);
    const size_t hstepA = (size_t)HALF * g.lda * 2, hstepB = (size_t)HALF * g.ldb * 2;

    const unsigned ldsw = (unsigned)wid * 1024u;
    const int aoff = lds_byte(wr * 64 + fr, fq * 8), boff = lds_byte(wc * 32 + fr, fq * 8);
#define PG8_SA(b, h) (((b) * 2 + (h)) * HTB)
#define PG8_SB(b, h) ((4 + (b) * 2 + (h)) * HTB)
#define PG8_STAGE(bufoff, gbase, voff) do { _Pragma("unroll") for (int _i = 0; _i < 2; ++_i) \
        __builtin_amdgcn_global_load_lds((const unsigned*)((const char*)(gbase) + (voff)[_i]), (PG8_LAS unsigned*)(lds + (bufoff) + ldsw + _i * 8192), 16, 0, 0); } while (0)
#define PG8_LDA(dst, b, h) do { _Pragma("unroll") for (int m = 0; m < 4; ++m) _Pragma("unroll") for (int k = 0; k < 2; ++k) dst[m][k] = *(const PG8_LAS bf16x8*)(lds + PG8_SA(b, h) + aoff + m * 2048 + k * 1024); } while (0)
#define PG8_LDB(dst, b, h) do { _Pragma("unroll") for (int n = 0; n < 2; ++n) _Pragma("unroll") for (int k = 0; k < 2; ++k) dst[n][k] = *(const PG8_LAS bf16x8*)(lds + PG8_SB(b, h) + boff + n * 2048 + k * 1024); } while (0)
#define PG8_MMA(ai, bj, At, Bt) do { __builtin_amdgcn_s_setprio(1); _Pragma("unroll") for (int m = 0; m < 4; ++m) _Pragma("unroll") for (int n = 0; n < 2; ++n) _Pragma("unroll") for (int k = 0; k < 2; ++k) \
        acc[ai][bj][m][n] = __builtin_amdgcn_mfma_f32_16x16x32_bf16(Bt[n][k], At[m][k], acc[ai][bj][m][n], 0, 0, 0); __builtin_amdgcn_s_setprio(0); } while (0)
#define PG8_WAIT_V(n) asm volatile("s_waitcnt vmcnt(" #n ")" ::: "memory")
#define PG8_WAIT_L(n) asm volatile("s_waitcnt lgkmcnt(" #n ")" ::: "memory")
#define PG8_BAR __builtin_amdgcn_s_barrier()
#define PG8_SCHED __builtin_amdgcn_sched_barrier(0)
    Unit cur, nxt; int ui = 0;
    if (!S.next(0, cur)) return;
    f32x4 acc[2][2][4][2];
#pragma unroll
    for (int a = 0; a < 2; ++a)
#pragma unroll
        for (int b = 0; b < 2; ++b)
#pragma unroll
            for (int m = 0; m < 4; ++m)
#pragma unroll
                for (int n = 0; n < 2; ++n) acc[a][b][m][n] = (f32x4){0.f, 0.f, 0.f, 0.f};
    bf16x8 At[4][2], B0[2][2], B1[2][2];
    const char* cA = gA_ + (size_t)cur.pm * 2 * hstepA + (size_t)cur.z * g.zA; const char* cB = gB_ + (size_t)cur.pn * 2 * hstepB + (size_t)cur.z * g.zB;
    S.a_ready(cur);
    if constexpr (SP2) {
        PG8_STAGE(PG8_SB(0, 0), cB, voffB); PG8_STAGE(PG8_SB(0, 1), cB + hstepB, voffB); PG8_STAGE(PG8_SA(0, 0), cA, voffA); PG8_STAGE(PG8_SA(0, 1), cA + hstepA, voffA);
        if (wr == 1) PG8_BAR;
        PG8_WAIT_V(2); PG8_BAR;
        PG8_STAGE(PG8_SB(1, 0), cB + kstep, voffB); PG8_STAGE(PG8_SA(1, 0), cA + kstep, voffA); PG8_STAGE(PG8_SB(1, 1), cB + hstepB + kstep, voffB);
        PG8_WAIT_V(6); PG8_BAR;
    } else {
        PG8_STAGE(PG8_SB(0, 0), cB, voffB); PG8_STAGE(PG8_SA(0, 0), cA, voffA); PG8_STAGE(PG8_SB(0, 1), cB + hstepB, voffB); PG8_STAGE(PG8_SA(0, 1), cA + hstepA, voffA);
        if (wr == 1) PG8_BAR;
        PG8_WAIT_V(4); PG8_BAR;
        PG8_STAGE(PG8_SB(1, 0), cB + kstep, voffB); PG8_STAGE(PG8_SA(1, 0), cA + kstep, voffA); PG8_STAGE(PG8_SB(1, 1), cB + hstepB + kstep, voffB);
        PG8_WAIT_V(6); PG8_BAR;
    }
    for (;;) {
        const bool has_next = S.next(ui + 1, nxt);
        const char* nA = has_next ? gA_ + (size_t)nxt.pm * 2 * hstepA + (size_t)nxt.z * g.zA : cA; const char* nB = has_next ? gB_ + (size_t)nxt.pn * 2 * hstepB + (size_t)nxt.z * g.zB : cB;
_Pragma("nounroll")
        for (int t = 0; t < nt; t += 2) {
            const bool last = (t == nt - 2);
            const char* a1 = cA + (size_t)(t + 1) * kstep;
            const char* a2 = last ? nA : cA + (size_t)(t + 2) * kstep; const char* b2 = last ? nB : cB + (size_t)(t + 2) * kstep;
            const char* a3 = a2 + kstep; const char* b3 = b2 + kstep;
            if (last && has_next) S.a_ready(nxt);
            if constexpr (SP2) {
            PG8_LDB(B0, 0, 0); PG8_LDB(B1, 0, 1); PG8_SCHED; PG8_LDA(At, 0, 0); PG8_STAGE(PG8_SA(1, 1), a1 + hstepA, voffA);
            PG8_WAIT_V(8); PG8_WAIT_L(0); PG8_BAR; PG8_MMA(0, 0, At, B0); PG8_MMA(0, 1, At, B1); PG8_BAR; PG8_SCHED;
            PG8_LDA(At, 0, 1); PG8_STAGE(PG8_SB(0, 0), b2, voffB); PG8_STAGE(PG8_SB(0, 1), b2 + hstepB, voffB); PG8_STAGE(PG8_SA(0, 0), a2, voffA);
            PG8_WAIT_V(8); PG8_WAIT_L(0); PG8_BAR; PG8_MMA(1, 0, At, B0); PG8_MMA(1, 1, At, B1); PG8_BAR; PG8_SCHED;
            PG8_LDB(B0, 1, 0); PG8_LDB(B1, 1, 1); PG8_SCHED; PG8_LDA(At, 1, 0); PG8_STAGE(PG8_SA(0, 1), a2 + hstepA, voffA);
            PG8_WAIT_V(8); PG8_WAIT_L(0); PG8_BAR; PG8_MMA(0, 0, At, B0); PG8_MMA(0, 1, At, B1); PG8_BAR; PG8_SCHED;
            PG8_LDA(At, 1, 1); PG8_STAGE(PG8_SB(1, 0), b3, voffB); PG8_STAGE(PG8_SB(1, 1), b3 + hstepB, voffB); PG8_STAGE(PG8_SA(1, 0), a3, voffA);
            PG8_WAIT_V(8); PG8_WAIT_L(0); PG8_BAR; PG8_MMA(1, 0, At, B0); PG8_MMA(1, 1, At, B1); PG8_BAR; PG8_SCHED;
            } else {
            PG8_LDB(B0, 0, 0); PG8_SCHED; PG8_LDA(At, 0, 0); PG8_STAGE(PG8_SA(1, 1), a1 + hstepA, voffA);
            PG8_WAIT_L(8); PG8_BAR; PG8_WAIT_L(0); PG8_MMA(0, 0, At, B0); PG8_BAR; PG8_SCHED;
            PG8_LDB(B1, 0, 1); PG8_STAGE(PG8_SB(0, 0), b2, voffB);
            PG8_BAR; PG8_WAIT_L(0); PG8_MMA(0, 1, At, B1); PG8_BAR;
            PG8_LDA(At, 0, 1); PG8_STAGE(PG8_SA(0, 0), a2, voffA);
            PG8_BAR; PG8_WAIT_L(0); PG8_MMA(1, 0, At, B0); PG8_BAR; PG8_SCHED;
            PG8_STAGE(PG8_SB(0, 1), b2 + hstepB, voffB);
            PG8_WAIT_V(6); PG8_BAR; PG8_MMA(1, 1, At, B1); PG8_BAR;
            PG8_LDB(B0, 1, 0); PG8_SCHED; PG8_LDA(At, 1, 0); PG8_STAGE(PG8_SA(0, 1), a2 + hstepA, voffA);
            PG8_WAIT_L(8); PG8_BAR; PG8_WAIT_L(0); PG8_MMA(0, 0, At, B0); PG8_BAR; PG8_SCHED;
            PG8_LDB(B1, 1, 1); PG8_STAGE(PG8_SB(1, 0), b3, voffB);
            PG8_BAR; PG8_WAIT_L(0); PG8_MMA(0, 1, At, B1); PG8_BAR;
            PG8_LDA(At, 1, 1); PG8_STAGE(PG8_SA(1, 0), a3, voffA);
            PG8_BAR; PG8_WAIT_L(0); PG8_MMA(1, 0, At, B0); PG8_BAR; PG8_SCHED;
            PG8_STAGE(PG8_SB(1, 1), b3 + hstepB, voffB);
            PG8_WAIT_V(6); PG8_BAR; PG8_MMA(1, 1, At, B1); PG8_BAR;
            }
        }
        if constexpr (ALIGN_EPI) { if (wr == 0) PG8_BAR; }
        if constexpr (!Epi::AFTER_DRAIN) { E(acc, cur, wr, wc, fr, fq); S.done(cur); }
        if (!has_next) break;
#pragma unroll
        for (int a = 0; a < 2; ++a)
#pragma unroll
            for (int b = 0; b < 2; ++b)
#pragma unroll
                for (int m = 0; m < 4; ++m)
#pragma unroll
                    for (int n = 0; n < 2; ++n) acc[a][b][m][n] = (f32x4){0.f, 0.f, 0.f, 0.f};
        cur = nxt; cA = nA; cB = nB; ++ui;
        if constexpr (ALIGN_EPI) { if (wr == 1) PG8_BAR; }
    }
    PG8_WAIT_V(0);
    if constexpr (!ALIGN_EPI) { if (wr == 0) PG8_BAR; }
    PG8_BAR;
    if constexpr (Epi::AFTER_DRAIN) { E.fused(acc, cur, wr, wc, fr, fq, lds, wid, lane); S.done(cur); }
#undef PG8_SA
#undef PG8_SB
#undef PG8_STAGE
#undef PG8_LDA
#undef PG8_LDB
#undef PG8_MMA
#undef PG8_WAIT_V
#undef PG8_WAIT_L
#undef PG8_BAR
#undef PG8_SCHED
}
}
#include <hip/hip_bf16.h>
#include <cmath>
namespace attn_body {
using bf16=__hip_bfloat16;
using bf16x8=__attribute__((ext_vector_type(8)))short;
using s16x4=__attribute__((ext_vector_type(4)))short;
using f32x16=__attribute__((ext_vector_type(16)))float;
using u32x4=__attribute__((ext_vector_type(4)))unsigned;
using f32x4_t=__attribute__((ext_vector_type(4)))float;
constexpr int BATCH=1,NHEAD=8,SEQ=16384,D=64,DM=NHEAD*D;
constexpr int NW=8,QBLK=32,QB=QBLK*NW,KVBLK=64,NQB=SEQ/QB;
constexpr int ATTN_PITCH=DM, ATTN_UNIT_ROWS=QB;
__device__ __forceinline__ int crow(int r,int hi){return (r&3)+8*(r>>2)+4*hi;}
#define SBAR() __builtin_amdgcn_sched_barrier(0)
__device__ __forceinline__ void cmask(f32x16&p0,f32x16&p1,int jb,int qrel,int hi){
  const float NEG=-INFINITY; int kb=64*jb+4*hi;
  #pragma unroll
  for(int r=0;r<16;++r){int kv=kb+(r&3)+8*(r>>2); if(kv>qrel)p0[r]=NEG; if(kv+32>qrel)p1[r]=NEG;}
}

constexpr int NSLOT=3, SLOTB=8192;
constexpr int LDS_K=0, LDS_V=NSLOT*SLOTB, LDS_WS=2*NSLOT*SLOTB, LDS_OST=LDS_WS+NW*64*4, LDS_CK=LDS_OST+NW*4096, LDS_BYTES=LDS_CK+SEQ*4;
constexpr float C2=0.125f*1.4426950408889634f;
__device__ __forceinline__ void glds16(const void*gsrc,unsigned lds_dst){unsigned keep;
  asm volatile("s_mov_b32 %0, m0\n\ts_mov_b32 m0, %2\n\ts_nop 0\n\tglobal_load_lds_dwordx4 %1, off\n\ts_mov_b32 m0, %0":"=&s"(keep):"v"(gsrc),"s"(lds_dst):"memory");}
__device__ __forceinline__ float max3f(float a,float b,float c){float r;asm("v_max3_f32 %0, %1, %2, %3":"=v"(r):"v"(a),"v"(b),"v"(c));return r;}
__device__ __forceinline__ float max2f(float a,float b){float r;asm("v_max_f32_e32 %0, %1, %2":"=v"(r):"v"(a),"v"(b));return r;}
__device__ __forceinline__ float fadd_s(float a,float b){float r;asm("v_add_f32_e32 %0, %1, %2":"=v"(r):"v"(a),"v"(b));return r;}
__device__ __forceinline__ float fsub_s(float a,float b){float r;asm("v_sub_f32_e32 %0, %1, %2":"=v"(r):"v"(a),"v"(b));return r;}
typedef float f32x2_t __attribute__((ext_vector_type(2))); typedef __bf16 bf16x2_t __attribute__((ext_vector_type(2)));
__device__ __forceinline__ unsigned cvtpk_s(float lo,float hi){f32x2_t v={lo,hi};bf16x2_t b=__builtin_convertvector(v,bf16x2_t);return __builtin_bit_cast(unsigned,b);}
#define WAIT_BAR(N) asm volatile("s_waitcnt vmcnt(" #N ") lgkmcnt(0)\n\ts_barrier":::"memory")

__device__ __forceinline__ void qkt(f32x16&p0,f32x16&p1,const char*Kslot,const bf16x8*qr,const f32x16&negm,int r32,int hi){
  const char*kb=Kslot+hi*1024+r32*16;
  #pragma unroll
  for(int d0=0;d0<4;++d0){
    const bf16x8 b0=*reinterpret_cast<const bf16x8*>(kb+d0*2048);
    const bf16x8 b1=*reinterpret_cast<const bf16x8*>(kb+d0*2048+512);
    if(d0==0){p0=__builtin_amdgcn_mfma_f32_32x32x16_bf16(b0,qr[0],negm,0,0,0);p1=__builtin_amdgcn_mfma_f32_32x32x16_bf16(b1,qr[0],negm,0,0,0);}
    else{p0=__builtin_amdgcn_mfma_f32_32x32x16_bf16(b0,qr[d0],p0,0,0,0);p1=__builtin_amdgcn_mfma_f32_32x32x16_bf16(b1,qr[d0],p1,0,0,0);}}
}
typedef __attribute__((address_space(3))) const char* lds_cptr;
typedef short v4i16_t __attribute__((ext_vector_type(4)));
__device__ __forceinline__ void kload8(bf16x8*kf,lds_cptr kp){
  kf[0]=*(const __attribute__((address_space(3))) bf16x8*)(kp);      kf[1]=*(const __attribute__((address_space(3))) bf16x8*)(kp+512);
  kf[2]=*(const __attribute__((address_space(3))) bf16x8*)(kp+2048); kf[3]=*(const __attribute__((address_space(3))) bf16x8*)(kp+2560);
  kf[4]=*(const __attribute__((address_space(3))) bf16x8*)(kp+4096); kf[5]=*(const __attribute__((address_space(3))) bf16x8*)(kp+4608);
  kf[6]=*(const __attribute__((address_space(3))) bf16x8*)(kp+6144); kf[7]=*(const __attribute__((address_space(3))) bf16x8*)(kp+6656);
}
__device__ __forceinline__ void kload2(bf16x8*kf,lds_cptr kp,int j){ kf[2*j]=*(const __attribute__((address_space(3))) bf16x8*)(kp+j*2048); kf[2*j+1]=*(const __attribute__((address_space(3))) bf16x8*)(kp+j*2048+512); }
__device__ __forceinline__ s16x4 vtr(lds_cptr p){ return __builtin_bit_cast(s16x4,__builtin_amdgcn_ds_read_tr16_b64_v4i16((__attribute__((address_space(3))) v4i16_t*)p)); }
__device__ __forceinline__ float rowmax(const f32x16&p0,const f32x16&p1){
  float a=max3f(p0[0],p0[1],p1[0]),b=max3f(p0[2],p0[3],p1[1]);a=max3f(a,p1[2],p1[3]);
  #pragma unroll
  for(int r=4;r<16;r+=4){a=max3f(a,p0[r],p0[r+1]);b=max3f(b,p0[r+2],p0[r+3]);a=max3f(a,p1[r],p1[r+1]);b=max3f(b,p1[r+2],p1[r+3]);}
  const float m=max2f(a,b);
  auto rr=__builtin_amdgcn_permlane32_swap(__float_as_uint(m),__float_as_uint(m),false,false);
  return max2f(__uint_as_float(rr[0]),__uint_as_float(rr[1]));
}
__device__ __forceinline__ void pv(f32x16*o,int vb,bf16x8 pa0,bf16x8 pa1,bf16x8 pa2,bf16x8 pa3){
  #pragma unroll
  for(int d0=0;d0<2;++d0){s16x4 lo[4],hi[4];
    #pragma unroll
    for(int ks=0;ks<4;++ks){
      asm volatile("ds_read_b64_tr_b16 %0,%1 offset:%c2":"=&v"(lo[ks]):"v"(vb),"i"(d0*4096+ks*1024):"memory");
      asm volatile("ds_read_b64_tr_b16 %0,%1 offset:%c2":"=&v"(hi[ks]):"v"(vb),"i"(d0*4096+ks*1024+512):"memory");}
    asm volatile("s_waitcnt lgkmcnt(0)":::"memory");SBAR();
    #define PK(k) (bf16x8){lo[k][0],lo[k][1],lo[k][2],lo[k][3],hi[k][0],hi[k][1],hi[k][2],hi[k][3]}
    o[d0]=__builtin_amdgcn_mfma_f32_32x32x16_bf16(pa0,PK(0),o[d0],0,0,0);
    o[d0]=__builtin_amdgcn_mfma_f32_32x32x16_bf16(pa1,PK(1),o[d0],0,0,0);
    o[d0]=__builtin_amdgcn_mfma_f32_32x32x16_bf16(pa2,PK(2),o[d0],0,0,0);
    o[d0]=__builtin_amdgcn_mfma_f32_32x32x16_bf16(pa3,PK(3),o[d0],0,0,0);
    #undef PK
  }
}

#ifndef ATTN_STORE16
#define ATTN_STORE16(p,v) (*(u32x4*)(p)=(v))
#endif
template<int THRL> __device__ __forceinline__ void attn_unit(int b,int h,int qb,const bf16*Q,const bf16*__restrict__ K,const bf16*__restrict__ V,bf16*O,const float*__restrict__ CSg,const unsigned*KMg,char*shm,const int t0,const int ntl,const bool masked,float*__restrict__ Lout){
  int tid_o=threadIdx.x; asm volatile("":"+v"(tid_o)); const int tid=tid_o,lane=tid&63,r32=lane&31,hi=lane>>5; const int wid=__builtin_amdgcn_readfirstlane(tid>>6);
  const long rowbase=(long)b*SEQ; const int q0=qb*QB;
  const bf16*Qw=Q+(rowbase+q0+wid*QBLK)*DM+h*D;
  const bf16*Kh=K+(rowbase+(long)t0*KVBLK)*DM+h*D,*Vh=V+(rowbase+(long)t0*KVBLK)*DM+h*D;
  const unsigned lds0=(unsigned)(uintptr_t)shm;
  float*wsf=(float*)(shm+LDS_WS)+wid*64;
  const lds_cptr shm3=(lds_cptr)shm;
  const bf16*ksrc=Kh+(long)lane*DM+wid*8;
  const bf16*vsrc=Vh+(long)(16*(wid&3)+(lane>>2))*DM+(wid>>2)*32+(lane&3)*8;
  const unsigned kdst=lds0+LDS_K+wid*1024, vdst=lds0+LDS_V+wid*1024;
  #define DMA_K(t,slot) glds16(ksrc+(long)(t)*KVBLK*DM,(unsigned)__builtin_amdgcn_readfirstlane(kdst+(slot)))
  #define DMA_V(t,slot) glds16(vsrc+(long)(t)*KVBLK*DM,(unsigned)__builtin_amdgcn_readfirstlane(vdst+(slot)))
  const int vb0=(int)(lds0+LDS_V)+((lane>>4)&1)*32+(lane&3)*8+(4*hi+((lane&15)>>2))*64;
  const char*Kbase=shm+LDS_K; bf16x8 kf[8];
  const lds_cptr kp0=shm3+LDS_K+hi*1024+r32*16; const lds_cptr vp0=shm3+LDS_V+((lane>>4)&1)*32+(lane&3)*8+(4*hi+((lane&15)>>2))*64;
  const int NT=ntl;
  typedef __attribute__((address_space(3))) float* lds_fptr; typedef __attribute__((address_space(3))) f32x4_t* lds_f4ptr;
  const float*csh=CSg+(long)h*SEQ;
  { const lds_fptr ckw=(lds_fptr)(shm3+LDS_CK);
    for(int i=tid*4;i<ntl*KVBLK;i+=NW*64*4){ const f32x4_t v=*(const f32x4_t*)(csh+t0*KVBLK+i); *(lds_f4ptr)(ckw+i)=v; }
  }
  const float cq=csh[q0+wid*QBLK+r32];
  asm volatile("s_waitcnt vmcnt(0) lgkmcnt(0)\n\ts_barrier":::"memory");
  const lds_fptr ckt=(lds_fptr)(shm3+LDS_CK)+4*hi;
  #define CKSUB(P0,P1,t) do{ const lds_fptr ckp_=ckt+64*(t); _Pragma("unroll") for(int j_=0;j_<4;++j_){ const f32x4_t a_=*(const lds_f4ptr)(ckp_+8*j_); const f32x4_t b_=*(const lds_f4ptr)(ckp_+32+8*j_); \
      P0[4*j_]-=a_[0];P0[4*j_+1]-=a_[1];P0[4*j_+2]-=a_[2];P0[4*j_+3]-=a_[3]; P1[4*j_]-=b_[0];P1[4*j_+1]-=b_[1];P1[4*j_+2]-=b_[2];P1[4*j_+3]-=b_[3]; SBAR(); } }while(0)
  DMA_K(0,0);DMA_V(0,0);DMA_K(1,SLOTB);
  bf16x8 qr[4];
  #pragma unroll
  for(int d0=0;d0<4;++d0)qr[d0]=*reinterpret_cast<const bf16x8*>(&Qw[(long)r32*DM+d0*16+hi*8]);
  float l_reg=0.f;f32x16 o[2];o[0]=f32x16{};o[1]=f32x16{};f32x16 negm;
  {
    float q2=0.f;
    _Pragma("unroll") for(int d0=0;d0<4;++d0) _Pragma("unroll") for(int e=0;e<8;++e){ const float v=__uint_as_float(((unsigned)(unsigned short)qr[d0][e])<<16); q2+=v*v; }
    { auto rr=__builtin_amdgcn_permlane32_swap(__float_as_uint(q2),__float_as_uint(q2),false,false); q2=__uint_as_float(rr[0])+__uint_as_float(rr[1]); }
    const float km2=__uint_as_float(__hip_atomic_load(KMg+h,__ATOMIC_RELAXED,__HIP_MEMORY_SCOPE_AGENT));
    const float Rq=sqrtf(q2*km2)*1.001f+0.01f;
    _Pragma("unroll") for(int r=0;r<16;++r)negm[r]=cq-Rq; asm volatile("":"+v"(negm)); }
  const int qrel=wid*QBLK+r32;
  #define CMASK(P0,P1,t) do{int jb_=(t)-(NT-4); if(masked&&jb_>=0)cmask(P0,P1,jb_,qrel,hi);}while(0)
  #define START(P0,P1) do{ const float rm=rowmax(P0,P1); resc=false; \
    { const float dl=rm; mhat=fadd_s(mhat,dl); \
      _Pragma("unroll") for(int r=0;r<16;++r){P0[r]=fsub_s(P0[r],dl);P1[r]=fsub_s(P1[r],dl);} \
      _Pragma("unroll") for(int r=0;r<16;++r)negm[r]=-mhat; asm volatile("":"+v"(negm)); } \
    _Pragma("unroll") for(int r=0;r<16;++r)P0[r]=__builtin_amdgcn_exp2f(P0[r]); }while(0)
  #define RESC() do{ if(resc){ asm volatile("s_waitcnt lgkmcnt(0)":::"memory"); \
      _Pragma("unroll") for(int d_=0;d_<2;++d_) _Pragma("unroll") for(int r=0;r<16;++r)o[d_][r]*=wsf[crow(r,hi)]; } }while(0)
  f32x16 pA0,pA1,pB0,pB1;
  int sl_prev=0,sl_cur=0,sl_next=SLOTB;
  #define ROT() do{sl_prev=sl_cur;sl_cur=sl_next;sl_next=(sl_next==(NSLOT-1)*SLOTB)?0:sl_next+SLOTB;}while(0)
  DMA_K(2,2*SLOTB);
  WAIT_BAR(3);
  qkt(pA0,pA1,Kbase,qr,negm,r32,hi);asm volatile("s_nop 15\n\ts_nop 7":"+v"(pA0),"+v"(pA1));CKSUB(pA0,pA1,0);CMASK(pA0,pA1,0);
  _Pragma("unroll") for(int r=0;r<16;++r)pA0[r]=__builtin_amdgcn_exp2f(pA0[r]);
  _Pragma("unroll") for(int r=0;r<16;++r)pA1[r]=__builtin_amdgcn_exp2f(pA1[r]);
  WAIT_BAR(0);
  DMA_K(3,0);DMA_V(1,SLOTB);
  ROT();
  kload8(kf,kp0+sl_cur);
  WAIT_BAR(2);
  s16x4 vlo[8],vhi[8]; u32x4 pw0,pw1,pw2,pw3;
  #define PKW(P,B) cvtpk_s(P[B],P[B+1])
  #define PAF(k) __builtin_bit_cast(bf16x8,pw##k)
  #define VFR(i) (bf16x8){vlo[i][0],vlo[i][1],vlo[i][2],vlo[i][3],vhi[i][0],vhi[i][1],vhi[i][2],vhi[i][3]}
  #define PIN(x) asm volatile("":"+v"(x))
  #define MX3(a,b,c) __builtin_fmaxf(__builtin_fmaxf((a),(b)),(c))
  #define GAPA(MF,A0,A1,A2,A3,W0,W1,PW) do{ MF; sacc+=A0; sacc+=A1; sacc+=A2; sacc+=A3; PIN(sacc); W0; W1; PIN(PW); SBAR(); }while(0)
  #define EX(v) __builtin_amdgcn_exp2f(v)
  #define GAPB(MF,X,B,CUR,NXT,NOFF) do{ MF; if((NOFF)>=0){ NXT=*(const lds_f4ptr)(ckp_+((NOFF)>=0?(NOFF):0)); } X[B]=EX(X[B]-CUR[0]); X[B+1]=EX(X[B+1]-CUR[1]); X[B+2]=EX(X[B+2]-CUR[2]); X[B+3]=EX(X[B+3]-CUR[3]); PIN(X); SBAR(); }while(0)
  #define VRD(i) do{ vlo[i]=vtr(vp_+(((i)>>2)*4096+((i)&3)*1024)); vhi[i]=vtr(vp_+(((i)>>2)*4096+((i)&3)*1024+512)); }while(0)
  #define KRD(G,j) do{ if(G){ kload2(kf,kp0+sl_next,j); SBAR(); } }while(0)
  #define STEP(C0,C1,P0,P1,t,GK,GV,GL) do{ SBAR(); \
    const lds_cptr vp_=vp0+sl_prev; \
    VRD(0); SBAR(); float sacc=(P0[0]+P0[1]); \
    GAPA(C0=__builtin_amdgcn_mfma_f32_32x32x16_bf16(kf[0],qr[0],negm,0,0,0), P0[2],P0[3],P0[4],P0[5],     pw0[0]=PKW(P0,0), pw0[1]=PKW(P0,2), pw0); \
    VRD(4); SBAR(); GAPA(C1=__builtin_amdgcn_mfma_f32_32x32x16_bf16(kf[1],qr[0],negm,0,0,0), P0[6],P0[7],P0[8],P0[9],     pw0[2]=PKW(P0,4), pw0[3]=PKW(P0,6), pw0); \
    VRD(1); SBAR(); GAPA(C0=__builtin_amdgcn_mfma_f32_32x32x16_bf16(kf[2],qr[1],C0,0,0,0),   P0[10],P0[11],P0[12],P0[13], pw1[0]=PKW(P0,8), pw1[1]=PKW(P0,10), pw1); \
    VRD(5); SBAR(); GAPA(C1=__builtin_amdgcn_mfma_f32_32x32x16_bf16(kf[3],qr[1],C1,0,0,0),   P0[14],P0[15],P1[0],P1[1],   pw1[2]=PKW(P0,12),pw1[3]=PKW(P0,14), pw1); \
    VRD(2); SBAR(); GAPA(C0=__builtin_amdgcn_mfma_f32_32x32x16_bf16(kf[4],qr[2],C0,0,0,0),   P1[2],P1[3],P1[4],P1[5],     pw2[0]=PKW(P1,0), pw2[1]=PKW(P1,2), pw2); \
    VRD(6); SBAR(); GAPA(C1=__builtin_amdgcn_mfma_f32_32x32x16_bf16(kf[5],qr[2],C1,0,0,0),   P1[6],P1[7],P1[8],P1[9],     pw2[2]=PKW(P1,4), pw2[3]=PKW(P1,6), pw2); \
    VRD(3); SBAR(); GAPA(C0=__builtin_amdgcn_mfma_f32_32x32x16_bf16(kf[6],qr[3],C0,0,0,0),   P1[10],P1[11],P1[12],P1[13], pw3[0]=PKW(P1,8), pw3[1]=PKW(P1,10), pw3); \
    VRD(7); SBAR(); GAPA(C1=__builtin_amdgcn_mfma_f32_32x32x16_bf16(kf[7],qr[3],C1,0,0,0),   P1[14],P1[15],0.f,0.f,       pw3[2]=PKW(P1,12),pw3[3]=PKW(P1,14), pw3); \
    l_reg+=sacc; \
    if(GK){DMA_K((t)+3,sl_cur);} if(GV){DMA_V((t)+1,sl_next);} \
    CMASK(C0,C1,t); \
    const lds_fptr ckp_=ckt+64*(t); f32x4_t ckA_=*(const lds_f4ptr)(ckp_), ckB_; \
    SBAR(); \
    GAPB(o[0]=__builtin_amdgcn_mfma_f32_32x32x16_bf16(PAF(0),VFR(0),o[0],0,0,0), C0,0,ckA_,ckB_,8); \
    GAPB(o[1]=__builtin_amdgcn_mfma_f32_32x32x16_bf16(PAF(0),VFR(4),o[1],0,0,0), C0,4,ckB_,ckA_,16); \
    KRD(GL,0); GAPB(o[0]=__builtin_amdgcn_mfma_f32_32x32x16_bf16(PAF(1),VFR(1),o[0],0,0,0), C0,8,ckA_,ckB_,24); \
    KRD(GL,1); GAPB(o[1]=__builtin_amdgcn_mfma_f32_32x32x16_bf16(PAF(1),VFR(5),o[1],0,0,0), C0,12,ckB_,ckA_,32); \
    KRD(GL,2); GAPB(o[0]=__builtin_amdgcn_mfma_f32_32x32x16_bf16(PAF(2),VFR(2),o[0],0,0,0), C1,0,ckA_,ckB_,40); \
    KRD(GL,3); GAPB(o[1]=__builtin_amdgcn_mfma_f32_32x32x16_bf16(PAF(2),VFR(6),o[1],0,0,0), C1,4,ckB_,ckA_,48); \
    GAPB(o[0]=__builtin_amdgcn_mfma_f32_32x32x16_bf16(PAF(3),VFR(3),o[0],0,0,0), C1,8,ckA_,ckB_,56); \
    GAPB(o[1]=__builtin_amdgcn_mfma_f32_32x32x16_bf16(PAF(3),VFR(7),o[1],0,0,0), C1,12,ckB_,ckA_,-1); \
    }while(0)
  int t=1;
  #undef CMASK
  #define CMASK(P0,P1,t) do{}while(0)
  for(;t+5<NT;t+=2){
    STEP(pB0,pB1,pA0,pA1,t,true,true,true);     WAIT_BAR(2); ROT();
    STEP(pA0,pA1,pB0,pB1,t+1,true,true,true);   WAIT_BAR(2); ROT();
  }
  #undef CMASK
  #define CMASK(P0,P1,t) do{int jb_=(t)-(NT-4); if(masked&&jb_>=0)cmask(P0,P1,jb_,qrel,hi);}while(0)
  #define ENDW(tt) do{ if((tt)+3<NT){WAIT_BAR(2);} else if((tt)+2<NT){WAIT_BAR(1);} else {WAIT_BAR(0);} }while(0)
  for(;t+1<NT;t+=2){
    STEP(pB0,pB1,pA0,pA1,t,(t+3<NT),(t+1<NT),(t+1<NT));       ENDW(t); ROT();
    STEP(pA0,pA1,pB0,pB1,t+1,(t+4<NT),(t+2<NT),(t+2<NT));     ENDW(t+1); ROT();
  }
  STEP(pB0,pB1,pA0,pA1,NT-1,false,false,false);
  { float sacc=pB0[0]+pB0[1]; _Pragma("unroll") for(int r=2;r<16;++r)sacc+=pB0[r]; _Pragma("unroll") for(int r=0;r<16;++r)sacc+=pB1[r]; l_reg+=sacc;
    pw0=(u32x4){PKW(pB0,0),PKW(pB0,2),PKW(pB0,4),PKW(pB0,6)};pw1=(u32x4){PKW(pB0,8),PKW(pB0,10),PKW(pB0,12),PKW(pB0,14)};pw2=(u32x4){PKW(pB1,0),PKW(pB1,2),PKW(pB1,4),PKW(pB1,6)};pw3=(u32x4){PKW(pB1,8),PKW(pB1,10),PKW(pB1,12),PKW(pB1,14)};
    SBAR(); pv(o,vb0+sl_cur,PAF(0),PAF(1),PAF(2),PAF(3)); }
  #undef PKW
  #undef PAF
  #undef VFR
  #undef PIN
  #undef MX3
  #undef GAPA
  #undef GAPB
  #undef EX
  #undef VRD
  #undef KRD
  #undef STEP
  #undef ENDW
  {auto rr=__builtin_amdgcn_permlane32_swap(__float_as_uint(l_reg),__float_as_uint(l_reg),false,false);l_reg=__uint_as_float(rr[0])+__uint_as_float(rr[1]);}
  if(hi==0){wsf[32+r32]=l_reg; Lout[(long)(q0+wid*QBLK+r32)*NHEAD+h]=l_reg;}asm volatile("s_waitcnt lgkmcnt(0)":::"memory");
  float rli[16];
  #pragma unroll
  for(int r=0;r<16;++r){const float lv_=wsf[32+crow(r,hi)]; rli[r]=lv_>1e-30f?__builtin_amdgcn_rcpf(lv_):0.f;}
  bf16*Ow=O+(rowbase+q0+wid*QBLK)*DM+h*D;
  { bf16*stg=(bf16*)(shm+LDS_OST)+wid*2048;
    #pragma unroll
    for(int r=0;r<16;++r){const int orow=crow(r,hi);
      #pragma unroll
      for(int d0=0;d0<2;++d0)stg[orow*64+d0*32+r32]=__float2bfloat16(o[d0][r]*rli[r]);}
    asm volatile("s_waitcnt lgkmcnt(0)":::"memory");
    #pragma unroll
    for(int i=0;i<4;++i){const int row=i*8+(lane>>3),ch=lane&7; const u32x4 v=*(const u32x4*)(stg+row*64+ch*8); ATTN_STORE16(Ow+(long)row*DM+ch*8,v);} }
  asm volatile("s_waitcnt lgkmcnt(0)\n\ts_barrier":::"memory");
  #undef CKSUB
  #undef DMA_K
  #undef DMA_V
  #undef CMASK
  #undef START
  #undef RESC
  #undef ROT
}
constexpr int ATTN_LDS_BYTES=LDS_BYTES;
struct AttnTensors { const bf16* Q; const bf16* K; const bf16* V; bf16* O; const float* CS; const unsigned* KM; };
struct AttnUnit { int bh; int qb; };
struct StaticOrder {
  int vcu,G;
  __device__ __forceinline__ explicit StaticOrder(int grid,int block):vcu((grid%8==0)?(block%8)*(grid/8)+block/8:block),G(grid){}
  __device__ __forceinline__ bool next(int i,AttnUnit&u)const{
    if(G==256){ if(i>=2)return false; const int s=vcu&31; u.bh=vcu>>5; u.qb=(i==0)?s:63-s; return true; }
    const int Lx=i*G+vcu; if(Lx>=NHEAD*NQB)return false; u.bh=Lx/NQB; u.qb=NQB-1-(Lx%NQB); return true; }
  __device__ __forceinline__ void a_ready(const AttnUnit&)const{}
  __device__ __forceinline__ void done(const AttnUnit&)const{}
};
template<class Sched,int THRL=8> __device__ __forceinline__ void attn_phase(char*lds,const AttnTensors&T,const Sched&S){
  AttnUnit u;
  for(int i=0;S.next(i,u);++i){ S.a_ready(u); attn_unit<THRL>(0,u.bh,u.qb,T.Q,T.K,T.V,T.O,T.CS,T.KM,lds,0,4*(u.qb+1),true,(float*)nullptr); S.done(u); }
}
#undef SBAR
#undef WAIT_BAR
}
#define LAS __attribute__((address_space(3)))
typedef unsigned short bf16;
typedef unsigned v4u __attribute__((ext_vector_type(4)));
typedef unsigned v2u __attribute__((ext_vector_type(2)));
typedef float f32x4 __attribute__((ext_vector_type(4)));
typedef short bf16x8 __attribute__((ext_vector_type(8)));
constexpr int NWAVES = 8, NTHREADS = 512;
constexpr int M = 16384, D = 1024, FF = 2816, MEML = 256, DIN = 7176, NLAYER = 2;
constexpr float EPS = 1e-6f, LOG2E = 1.4426950408889634f;
constexpr int LDS_BYTES = 155648, XB_LDS_OFF = LDS_BYTES - 256, T0_LDS_OFF = 149504;
static_assert(attn_body::ATTN_LDS_BYTES <= LDS_BYTES, "lds");
constexpr size_t MiB = 1u << 20;
constexpr size_t WS_SS = 1 * MiB, WS_SSV = 2 * MiB, WS_LF = 2 * MiB + 512 * 1024, WS_CS = 3 * MiB, WS_RSM = 3 * MiB + 512 * 1024, WS_MEMB = 4 * MiB, WS_KC = 4 * MiB + 512 * 1024, WS_VCT = 5 * MiB;
constexpr size_t WS_LPL = 5 * MiB + 512 * 1024, WS_LP = 66 * MiB + 256 * 1024;
constexpr size_t WS_W = 6 * MiB, WS_XB = 68 * MiB, WS_SCR = 100 * MiB, WS_END = 244 * MiB;
constexpr size_t WO_GU1 = 0, WO_D1 = WO_GU1 + (size_t)5632 * 1024, WO_IN = WO_D1 + (size_t)1024 * 2816, WO_G = WO_IN + (size_t)4096 * 1024, WO_B = WO_G + (size_t)3072 * 1024,
                 WO_O = WO_B + (size_t)3 * 1024 * 512, WO_Q = WO_O + (size_t)1024 * 1024, WO_K = WO_Q + (size_t)1024 * 1024, WO_V = WO_K + (size_t)1024 * 1024, WO_XO = WO_V + (size_t)1024 * 1024,
                 WO_GU2 = WO_XO + (size_t)1024 * 1024, WO_D2 = WO_GU2 + (size_t)5632 * 1024, WO_END = WO_D2 + (size_t)1024 * 2816;
static_assert(WS_W + (WO_END + 16 * 1024) * 2 <= WS_LP && WS_LP + 3 * 512 * 1024 <= WS_XB, "weights fit");
constexpr size_t PIECE = (size_t)M * 512;

typedef __attribute__((address_space(1))) unsigned gu32;
#define RLX_AGENT __ATOMIC_RELAXED, __HIP_MEMORY_SCOPE_AGENT
#define XB_TMO      128
#define XB_XCNT(j)  (256  + 64 * (j))
#define XB_XSUB(j)  (1280 + 64 * (j))
#define XB_XGEN(j)  (2304 + 64 * (j))
#define XB_TOP      3328
#define XB_TOPGEN   3392
#define XCD_BAR_WORDS 3456
#define XB_SPIN_CAP (1u << 18)

__device__ __forceinline__ unsigned xb_ld(unsigned* p)              { return __hip_atomic_load(p, __ATOMIC_RELAXED, __HIP_MEMORY_SCOPE_AGENT); }
__device__ __forceinline__ unsigned xb_add(unsigned* p, unsigned v) { return __hip_atomic_fetch_add(p, v, __ATOMIC_RELAXED, __HIP_MEMORY_SCOPE_AGENT); }
__device__ __forceinline__ unsigned xb_xcc_id() { return (unsigned)__builtin_amdgcn_s_getreg((3 << 11) | 20) & 0xFu; }
#define XB_SPIN(cond, bar) do { unsigned _sp = 0; while (cond) { __builtin_amdgcn_s_sleep(1); \
    if ((++_sp & 255u) == 0u) { if (xb_ld(&(bar)[XB_TMO])) break; if (_sp > XB_SPIN_CAP) { atomicAdd(&(bar)[XB_TMO], 1u); break; } } } } while (0)

struct XcdBarrier {
    unsigned* bar; unsigned x;
    volatile LAS unsigned* st;
};

__device__ __forceinline__ XcdBarrier xcd_barrier_post(unsigned* bar, volatile LAS unsigned* st) {
    XcdBarrier b; b.bar = bar; b.x = xb_xcc_id(); b.st = st;
    if (threadIdx.x == 0) (void)xb_add(&bar[XB_XCNT(b.x)], 1u);
    return b;
}
__device__ __forceinline__ void xcd_barrier_complete(unsigned* bar, unsigned x, unsigned& nloc, unsigned& nx) {
    const unsigned G = gridDim.x * gridDim.y * gridDim.z;
    unsigned sum, cnt, mine, sp = 0u;
    for (;;) {
        sum = 0u; cnt = 0u; mine = 0u;
#pragma unroll
        for (unsigned j = 0; j < 16; ++j) { const unsigned c = xb_ld(&bar[XB_XCNT(j)]); sum += c; cnt += (c > 0u) ? 1u : 0u; mine = (j == x) ? c : mine; }
        if (sum == G) break;
        __builtin_amdgcn_s_sleep(1);
        if ((++sp & 255u) == 0u) { if (xb_ld(&bar[XB_TMO])) break; if (sp > XB_SPIN_CAP) { atomicAdd(&bar[XB_TMO], 1u); break; } }
    }
    nloc = mine > 0u ? mine : 1u; nx = cnt > 0u ? cnt : 1u;
}

__device__ __forceinline__ void xcd_barrier(const XcdBarrier& b) {
    asm volatile("s_waitcnt vmcnt(0)" ::: "memory");
    __syncthreads();
    if (threadIdx.x == 0) {
        unsigned* bar = b.bar;
        __builtin_amdgcn_s_waitcnt(0);
        unsigned nloc = b.st[0], nx = b.st[1];
        if (nloc == 0u) { xcd_barrier_complete(bar, b.x, nloc, nx); b.st[0] = nloc; b.st[1] = nx; }
        const unsigned old = xb_add(&bar[XB_XSUB(b.x)], 1u);
        const unsigned gen = old / nloc;
        if (old + 1u == (gen + 1u) * nloc) {
            __builtin_amdgcn_fence(__ATOMIC_RELEASE, "agent");
            asm volatile("s_waitcnt vmcnt(0)" ::: "memory");
            const unsigned og = xb_add(&bar[XB_TOP], 1u);
            const unsigned tg = og / nx;
            if (og + 1u == (tg + 1u) * nx) xb_add(&bar[XB_TOPGEN], 1u);
            else XB_SPIN(xb_ld(&bar[XB_TOPGEN]) == tg, bar);
            __builtin_amdgcn_fence(__ATOMIC_ACQUIRE, "agent");
            xb_add(&bar[XB_XGEN(b.x)], 1u);
            asm volatile("s_waitcnt vmcnt(0)" ::: "memory");
        } else {
            XB_SPIN(xb_ld(&bar[XB_XGEN(b.x)]) == gen, bar);
            __builtin_amdgcn_fence(__ATOMIC_ACQUIRE, "agent");
            asm volatile("s_waitcnt vmcnt(0)" ::: "memory");
        }
    }
    __syncthreads();
}
struct Args { const float* in[26]; float* out; unsigned char* ws; int ph_lo, ph_hi; };

__device__ __forceinline__ unsigned f2bf(float f) { unsigned u = __builtin_bit_cast(unsigned, f); return (u + 0x7fffu + ((u >> 16) & 1u)) >> 16; }
__device__ __forceinline__ unsigned pk2(float lo, float hi) { return f2bf(lo) | (f2bf(hi) << 16); }
__device__ __forceinline__ float b2f(unsigned short b) { return __uint_as_float((unsigned)b << 16); }
__device__ __forceinline__ float wave_sum(float v) {
#pragma unroll
    for (int o = 1; o < 64; o <<= 1) v += __shfl_xor(v, o);
    return v;
}
#define LDS_WAIT() asm volatile("s_waitcnt lgkmcnt(0)" ::: "memory")
__device__ __forceinline__ void conv_item(const float* W, int spitch, int k0, int n0, bf16* WT, int dpitch, int drow0, const float* gain, LAS float* scr, int lane) {
#pragma unroll
    for (int i = 0; i < 32; ++i) { const int kk = 2 * i + (lane >> 5); float v = W[(size_t)(k0 + kk) * spitch + n0 + (lane & 31)]; if (gain) v *= gain[k0 + kk]; scr[kk * 33 + (lane & 31)] = v; }
    LDS_WAIT(); asm volatile("" ::: "memory");
    const int c = lane & 7;
#pragma unroll
    for (int j = 0; j < 4; ++j) { const int n = (lane >> 3) + 8 * j; const LAS float* s = scr + (8 * c) * 33 + n;
        v4u o; o.x = pk2(s[0 * 33], s[1 * 33]); o.y = pk2(s[2 * 33], s[3 * 33]); o.z = pk2(s[4 * 33], s[5 * 33]); o.w = pk2(s[6 * 33], s[7 * 33]);
        *(v4u*)(WT + (size_t)(drow0 + n) * dpitch + k0 + 8 * c) = o; }
    LDS_WAIT(); asm volatile("" ::: "memory");
}
__device__ __forceinline__ void conv_job(int& it, int& base, int NGW, const float* W, int spitch, int K, int scol0, int ncols, bf16* WT, int doff, bool ilv, const float* gain, LAS float* scr, int lane) {
    const int nblk = ncols / 32, nitems = (K / 64) * nblk;
    for (; it < base + nitems; it += NGW) { const int r = it - base, kb = r / nblk, nb = r % nblk, nl = 32 * nb;
        const int drow0 = ilv ? (256 * (nl / 128) + (nl % 128) + doff) : (doff + nl);
        conv_item(W, spitch, 64 * kb, scol0 + nl, WT, K, drow0, gain, scr, lane); }
    base += nitems;
}

__device__ __forceinline__ int attn_skip_tiles(const float* csh, int qb, float R) {
    const int ntf = 4 * (qb + 1); const float thr = csh[256 * qb] + 152.0f + 2.0f * R;
    int lo_ = 0, hi_ = ntf - 4;
    while (lo_ < hi_) { const int mid = (lo_ + hi_) >> 1; if (csh[64 * mid + 63] > thr) lo_ = mid + 1; else hi_ = mid; }
    return lo_ & ~1;
}
__device__ __forceinline__ int attn_chunks(int len) { int n = (len + 63) >> 6; if (n > 1 && len - 64 * (n - 1) < 4) --n; return n; }
__global__ void __launch_bounds__(NTHREADS, 2) mk_fwd(Args args) {
    __builtin_assume(__builtin_amdgcn_workitem_id_y() == 0); __builtin_assume(__builtin_amdgcn_workitem_id_z() == 0);
    extern __shared__ __attribute__((aligned(16))) unsigned char lds[];
    cg::grid_group grid = cg::this_grid();
    LAS unsigned char* ldsp = (LAS unsigned char*)lds;
    if (threadIdx.x < 2) ((volatile LAS unsigned*)(ldsp + XB_LDS_OFF))[threadIdx.x] = 0u;
    __syncthreads();
    const XcdBarrier xbar = xcd_barrier_post((unsigned*)args.ws, (volatile LAS unsigned*)(ldsp + XB_LDS_OFF));
    const int G = gridDim.x, bx = blockIdx.x;
    const int vcu = (G % 8 == 0) ? (bx % 8) * (G / 8) + bx / 8 : bx;
    const int NGW = G * NWAVES;
#define TIDS() int tid_o = threadIdx.x; asm volatile("" : "+v"(tid_o)); const int tid = tid_o, lane = tid & 63, wave = __builtin_amdgcn_readfirstlane(tid >> 6), gw = vcu * NWAVES + wave; (void)gw; (void)lane; (void)tid
#define KARGS() const __attribute__((address_space(4))) Args* ap_ = (const __attribute__((address_space(4))) Args*)__builtin_amdgcn_kernarg_segment_ptr(); asm volatile("" : "+s"(ap_))
#define ws (ap_->ws)
#define X (ap_->out)
#define SS ((float*)(ws + WS_SS))
#define SSV ((float*)(ws + WS_SSV))
#define LF ((float*)(ws + WS_LF))
#define CS ((float*)(ws + WS_CS))
#define RSM ((float*)(ws + WS_RSM))
#define MEMB ((bf16*)(ws + WS_MEMB))
#define KC ((bf16*)(ws + WS_KC))
#define VCT ((bf16*)(ws + WS_VCT))
#define Wt ((bf16*)(ws + WS_W))
#define XB ((bf16*)(ws + WS_XB))
#define SCR ((bf16*)(ws + WS_SCR))
#define ACT SCR
#define PROJ SCR
#define GT (SCR + 3 * PIECE)
#define XQ SCR
#define PB (SCR + (size_t)M * 1024)
#define OB (SCR + (size_t)2 * M * 1024)
    const int lo = args.ph_lo, hi = args.ph_hi;
#ifndef PHMASK
#define PHMASK 0xffff
#endif
#define IN(k) (((PHMASK >> (((k) == 30) ? 15 : ((k) - pb == 13 || (k) - pb == 14) ? (k) - pb - 12 : (k) - pb)) & 1) && lo <= (k) && (k) < hi)
#define GRID_SYNC() do { asm volatile("s_waitcnt vmcnt(0) lgkmcnt(0)" ::: "memory"); grid.sync(); } while (0)
#define WG_SEAM() do { asm volatile("s_waitcnt vmcnt(0) lgkmcnt(0)" ::: "memory"); __syncthreads(); } while (0)
#define SEAM_LOCAL(k) do { if (lo <= (k) && (k) + 1 < hi) { if (G == 256) WG_SEAM(); else xcd_barrier(xbar); } } while (0)
#define SEAM(k) do { if (lo <= (k) && (k) + 1 < hi) { if ((k) == 0) GRID_SYNC(); else xcd_barrier(xbar); } } while (0)
#define in (ap_->in)
int pb = 0;
#pragma nounroll
    for (int l = 0; l < NLAYER; ++l) {
        pb = 15 * l;
        if (IN(pb + 0)) { KARGS(); TIDS();
            LAS float* scr = (LAS float*)(ldsp + wave * 16384);
            const size_t l1 = (size_t)l * 1024, lff = (size_t)l * 1024 * 2816, ldd = (size_t)l * 1024 * 1024;
            constexpr int NB_FF = FF / 32, I_UP = 16 * NB_FF, I_DN = (FF / 64) * 32, I_IN = 16 * 128, I_G = 16 * 96, I_B = 8 * 32, I_SQ = 16 * 32;
            constexpr int NIT = 4 * I_UP + 2 * I_DN + I_IN + I_G + 3 * I_B + 5 * I_SQ;
#pragma nounroll
            for (int it = gw; it < NIT; it += NGW) {
                int r = it; const float* W; const float* gain = nullptr; bf16* WT; int spitch, K, scol0 = 0, nblk, doff = 0; bool ilv = false;
                if (r < 2 * I_UP) { const int w = r / I_UP; r -= w * I_UP; W = in[3 + w] + lff; gain = in[2] + l1; WT = Wt + WO_GU1; spitch = FF; K = 1024; nblk = NB_FF; doff = 128 * w; ilv = true; }
                else if ((r -= 2 * I_UP) < I_DN) { W = in[5] + lff; WT = Wt + WO_D1; spitch = 1024; K = FF; nblk = 32; }
                else if ((r -= I_DN) < I_IN) { W = in[7] + (size_t)l * 1024 * DIN; gain = in[6] + l1; WT = Wt + WO_IN; spitch = DIN; K = 1024; nblk = 128; }
                else if ((r -= I_IN) < I_G) { W = in[7] + (size_t)l * 1024 * DIN; gain = in[6] + l1; WT = Wt + WO_G; spitch = DIN; K = 1024; nblk = 96; scol0 = 4104; }
                else if ((r -= I_G) < 3 * I_B) { const int w = r / I_B; r -= w * I_B; W = in[13] + ((size_t)l * 3 + w) * 512 * 1024; WT = Wt + WO_B + (size_t)w * 1024 * 512; spitch = 1024; K = 512; nblk = 32; }
                else if ((r -= 3 * I_B) < I_SQ) { W = in[14] + ldd; WT = Wt + WO_O; spitch = 1024; K = 1024; nblk = 32; }
                else if ((r -= I_SQ) < I_SQ) { W = in[17] + ldd; gain = in[15] + l1; WT = Wt + WO_Q; spitch = 1024; K = 1024; nblk = 32; }
                else if ((r -= I_SQ) < 2 * I_SQ) { const int w = r / I_SQ; r -= w * I_SQ; W = in[18 + w] + ldd; gain = in[16] + l1; WT = Wt + WO_K + (size_t)w * 1024 * 1024; spitch = 1024; K = 1024; nblk = 32; }
                else if ((r -= 2 * I_SQ) < I_SQ) { W = in[20] + ldd; WT = Wt + WO_XO; spitch = 1024; K = 1024; nblk = 32; }
                else if ((r -= I_SQ) < 2 * I_UP) { const int w = r / I_UP; r -= w * I_UP; W = in[22 + w] + lff; gain = in[21] + l1; WT = Wt + WO_GU2; spitch = FF; K = 1024; nblk = NB_FF; doff = 128 * w; ilv = true; }
                else { r -= 2 * I_UP; W = in[24] + lff; WT = Wt + WO_D2; spitch = 1024; K = FF; nblk = 32; }
                const int kb = r / nblk, nl = 32 * (r % nblk);
                const int drow0 = ilv ? (256 * (nl / 128) + (nl % 128) + doff) : (doff + nl);
                conv_item(W, spitch, 64 * kb, scol0 + nl, WT, K, drow0, gain, scr, lane);
            }
            {
                const float* wf = in[7] + (size_t)l * 1024 * DIN + 4096; const float* gn = in[6] + l1; bf16* WF = Wt + WO_END;
                for (int idx = vcu * NTHREADS + tid; idx < 8192; idx += G * NTHREADS) { const int k = idx >> 3, hd = idx & 7;
                    const float v = wf[(size_t)k * DIN + hd] * gn[k]; const unsigned hb = f2bf(v); const float lo = v - __uint_as_float(hb << 16);
                    WF[(size_t)hd * 1024 + k] = (bf16)hb; WF[(size_t)(8 + hd) * 1024 + k] = (bf16)f2bf(lo); }
            }
            if (l == 0) {
                for (int m = gw; m < M + MEML; m += NGW) {
                    const bool ism = m >= M; const int r = ism ? m - M : m;
                    const f32x4* xr = (const f32x4*)((ism ? in[1] : in[0]) + (size_t)r * D) + lane;
                    f32x4 v[4]; float s = 0.f;
#pragma unroll
                    for (int j = 0; j < 4; ++j) { v[j] = xr[64 * j]; s += (v[j][0] * v[j][0] + v[j][1] * v[j][1]) + (v[j][2] * v[j][2] + v[j][3] * v[j][3]); }
                    s = wave_sum(s);
                    v2u* ob = (v2u*)((ism ? MEMB : XB) + (size_t)r * D) + lane;
#pragma unroll
                    for (int j = 0; j < 4; ++j) { v2u w; w.x = pk2(v[j][0], v[j][1]); w.y = pk2(v[j][2], v[j][3]); ob[64 * j] = w; }
                    if (!ism) {
                        if (lane < 16) SS[(size_t)r * 16 + lane] = lane == 0 ? s : 0.f;
                    } else if (lane == 0) RSM[r] = rsqrtf(s * (1.0f / D) + EPS);
                }
            }
        }
        SEAM(pb + 0);
#pragma nounroll
        for (int f = 0; f < 2; ++f) {
            const int pu = pb + (f == 0 ? 1 : 13), pd = pu + 1;
            if (IN(pu)) { KARGS();
                { pg8::Gemm g{XB, Wt + (f == 0 ? WO_GU1 : WO_GU2), 1024, 1024, 1024, 0, 0}; pg8::StaticOrder S; S.init(M / 256, 22, G, bx);
                  pg8::EpiSwiGLU E{SS, ACT};
#ifndef MK_REP_UP
#define MK_REP_UP 1
#endif
_Pragma("nounroll")
                  for (int rep = 0; rep < MK_REP_UP; ++rep) pg8::gemm_phase<pg8::EpiSwiGLU, pg8::StaticOrder, true, true>(ldsp, g, S, E); }
                if (f == 0) {
                    { pg8::Gemm g{MEMB, Wt + WO_K, 1024, 1024, 1024, 0, 0}; pg8::StaticOrder S; S.init(1, 4, G, (bx + G - 128 % G) % G);
                      pg8::EpiScale<2> E{RSM, KC, 1024, 1.0f}; pg8::gemm_phase<pg8::EpiScale<2>, pg8::StaticOrder, true, true>(ldsp, g, S, E); }
                    { pg8::Gemm g{Wt + WO_V, MEMB, 1024, 1024, 1024, 0, 0}; pg8::StaticOrder S; S.init(4, 1, G, (bx + G - 132 % G) % G);
                      pg8::EpiScale<3> E{RSM, VCT, 256, 1.0f}; pg8::gemm_phase<pg8::EpiScale<3>, pg8::StaticOrder, true, true>(ldsp, g, S, E); }
                }
            }
            SEAM(pu);
            if (IN(pd)) { KARGS();
                pg8::Gemm g{ACT, Wt + (f == 0 ? WO_D1 : WO_D2), FF, FF, FF, 0, 0}; pg8::StaticOrder S; S.init(M / 256, 4, G, bx);
                pg8::EpiResid E{XB, SS, 0.5f}; pg8::gemm_phase<pg8::EpiResid, pg8::StaticOrder, true, true>(ldsp, g, S, E);
            }
            SEAM(pd);
            if (f == 1) break;
            if (IN(pb + 3)) { KARGS();
                { TIDS();
                    const float* bfp = in[12] + l * 8; const bf16* WF = Wt + WO_END; const int fr = lane & 15, fq = lane >> 4;
                    if ((wave & 1) == 0) for (int tile = vcu * 4 + (wave >> 1); tile < M / 16; tile += G * 4) {
                        const int row = 16 * tile + fr;
                        const bf16* ap = XB + (size_t)row * D + 8 * fq; const bf16* bp = WF + (size_t)fr * D + 8 * fq;
                        f32x4 acc = {0.f, 0.f, 0.f, 0.f};
#pragma unroll 8
                        for (int ks = 0; ks < 32; ++ks) { const bf16x8 a = *(const bf16x8*)(ap + 32 * ks), b = *(const bf16x8*)(bp + 32 * ks); acc = __builtin_amdgcn_mfma_f32_16x16x32_bf16(b, a, acc, 0, 0, 0); }
                        const float rs = pg8::row_rstd1(SS, row, fq);
#pragma unroll
                        for (int j = 0; j < 4; ++j) { const float t = acc[j] + __shfl_xor(acc[j], 32);
                            if (fq < 2) { const int hd = 4 * fq + j; const float z = t * rs + bfp[hd]; LF[(size_t)hd * M + row] = fminf(z, 0.f) - log1pf(expf(-fabsf(z))); } }
                    }
                }
                pg8::Gemm g{XB, Wt + WO_IN, 1024, 1024, 1024, 0, 0}; pg8::StaticOrder S; S.init(M / 256, 16, G, bx);
                pg8::EpiWin E{SS, PROJ, SSV, 0.125f * LOG2E}; pg8::gemm_phase<pg8::EpiWin, pg8::StaticOrder, true, true>(ldsp, g, S, E);
            }
            SEAM(pb + 3);
            if (IN(pb + 4)) { KARGS(); TIDS();
                if (bx < 8) {
                    const float* lf = LF + (size_t)bx * M + tid * 32; float* cs = CS + (size_t)bx * M + tid * 32;
                    f32x4 v[8]; float run = 0.f;
#pragma unroll
                    for (int i = 0; i < 8; ++i) { v[i] = *(const f32x4*)(lf + 4 * i);
#pragma unroll
                        for (int e = 0; e < 4; ++e) { run += v[i][e]; v[i][e] = run; } }
                    const double tot = (double)run; double incl = tot;
#pragma unroll
                    for (int o = 1; o < 64; o <<= 1) { const double t = __shfl_up(incl, o); if (lane >= o) incl += t; }
                    LAS double* wsum = (LAS double*)ldsp;
                    if (lane == 63) wsum[wave] = incl;
                    __syncthreads();
                    double bsum = 0.0;
                    for (int w = 0; w < wave; ++w) bsum += wsum[w];
                    const double excl = bsum + incl - tot;
#pragma unroll
                    for (int i = 0; i < 8; ++i) { f32x4 o;
#pragma unroll
                        for (int e = 0; e < 4; ++e) o[e] = (float)((excl + (double)v[i][e]) * 1.4426950408889634);
                        *(f32x4*)(cs + 4 * i) = o; }
                    __syncthreads();
                }
                {
                    unsigned* KM = (unsigned*)(ws + 32768) + 8 * l; unsigned* lmx = (unsigned*)(lds + XB_LDS_OFF + 128);
                    if (tid < 16) lmx[tid] = 0u;
                    __syncthreads();
                    for (int idx = vcu * NTHREADS + tid; idx < 2 * M * 8; idx += G * NTHREADS) {
                        const int isq = idx >= M * 8, id2 = idx - isq * M * 8; const bf16* Kp = PROJ + (isq ? 8 : 6) * PIECE;
                        const v4u* kp = (const v4u*)(Kp + (size_t)(id2 >> 3) * 512 + (id2 & 7) * 64); float s = 0.f;
#pragma unroll
                        for (int q = 0; q < 8; ++q) { const v4u w = kp[q];
#pragma unroll
                            for (int e = 0; e < 4; ++e) { const float a = pg8::bflo(w[e]), b = pg8::bfhi(w[e]); s += a * a + b * b; } }
                        s = fmaxf(s, __shfl_xor(s, 8)); s = fmaxf(s, __shfl_xor(s, 16)); s = fmaxf(s, __shfl_xor(s, 32));
                        if (lane < 8) atomicMax(lmx + 8 * isq + lane, __float_as_uint(s));
                    }
                    __syncthreads();
                    if (tid < 16) atomicMax(KM + 64 * (tid >> 3) + (tid & 7), lmx[tid]);
                }
                {
                    bf16* AB = PROJ; const bf16* AC = PROJ + 3 * PIECE; const bf16* AH = PROJ + 4 * PIECE; const float* cw = in[8] + (size_t)l * 3 * 512;
                    for (int idx = vcu * NTHREADS + tid; idx < M * 64; idx += G * NTHREADS) {
                        const int t = idx >> 6, c8 = (idx & 63) * 8; const size_t off = (size_t)t * 512 + c8;
                        const v4u bw = *(const v4u*)(AB + off);
                        float zz[3][8];
#pragma unroll
                        for (int d = 0; d < 3; ++d) {
                            if (t - d >= 0) { const v4u cv = *(const v4u*)(AC + off - (size_t)d * 512), hv = *(const v4u*)(AH + off - (size_t)d * 512);
#pragma unroll
                                for (int e = 0; e < 4; ++e) { zz[d][2 * e] = pg8::bflo(cv[e]) * pg8::bflo(hv[e]); zz[d][2 * e + 1] = pg8::bfhi(cv[e]) * pg8::bfhi(hv[e]); } }
                            else {
#pragma unroll
                                for (int e = 0; e < 8; ++e) zz[d][e] = 0.f; }
                        }
                        float y[8];
#pragma unroll
                        for (int e = 0; e < 8; ++e) { const float b = (e & 1) ? pg8::bfhi(bw[e >> 1]) : pg8::bflo(bw[e >> 1]);
                            y[e] = b * (cw[c8 + e] * zz[2][e] + cw[512 + c8 + e] * zz[1][e] + cw[1024 + c8 + e] * zz[0][e]); }
                        v4u o; o.x = pk2(y[0], y[1]); o.y = pk2(y[2], y[3]); o.z = pk2(y[4], y[5]); o.w = pk2(y[6], y[7]);
                        *(v4u*)(AB + off) = o;
                    }
                }
                {
                    bf16* UU = PROJ + 1 * PIECE; const bf16* VV = PROJ + 5 * PIECE; const float* sgn = in[9] + (size_t)l * 512; const float* sgw = in[10] + (size_t)l * 4 * 128 * 128; const float* sgb = in[11] + (size_t)l * 4 * 128;
                    LAS bf16* T = (LAS bf16*)ldsp;
                    const int fr = lane & 15, fq = lane >> 4;
                    for (int unit = vcu; unit < 512; unit += G) {
                        const int n = unit >> 2, gI = unit & 3;
                        { const int s = tid >> 2, cg0 = (tid & 3) * 32, row = 128 * n + s;
                          const f32x4 p0 = *(const f32x4*)(SSV + (size_t)row * 8), p1 = *(const f32x4*)(SSV + (size_t)row * 8 + 4);
                          const float rv = rsqrtf(((p0[0] + p0[1]) + (p0[2] + p0[3]) + (p1[0] + p1[1]) + (p1[2] + p1[3])) * (1.0f / 512.0f) + EPS);
#pragma unroll
                          for (int q = 0; q < 4; ++q) { const int c = cg0 + 8 * q; const v4u vw = *(const v4u*)(VV + (size_t)row * 512 + 128 * gI + c);
                              const f32x4 ga = *(const f32x4*)(sgn + 128 * gI + c), gb = *(const f32x4*)(sgn + 128 * gI + c + 4);
#pragma unroll
                              for (int e = 0; e < 4; ++e) { const float g0 = e < 2 ? ga[2 * e] : gb[2 * e - 4], g1 = e < 2 ? ga[2 * e + 1] : gb[2 * e - 3];
                                  T[(c + 2 * e) * 136 + s] = (bf16)f2bf(pg8::bflo(vw[e]) * rv * g0); T[(c + 2 * e + 1) * 136 + s] = (bf16)f2bf(pg8::bfhi(vw[e]) * rv * g1); } } }
                        __syncthreads();
                        f32x4 acc[8];
#pragma unroll
                        for (int j = 0; j < 8; ++j) acc[j] = (f32x4){0.f, 0.f, 0.f, 0.f};
                        const int t = 16 * wave + fr;
                        for (int kk = 0; kk <= (wave >> 1); ++kk) {
                            const int s0 = 32 * kk + 8 * fq; const float* wp = sgw + ((size_t)gI * 128 + t) * 128 + s0;
                            const f32x4 w0 = *(const f32x4*)wp, w1 = *(const f32x4*)(wp + 4);
                            float wv[8] = {w0[0], w0[1], w0[2], w0[3], w1[0], w1[1], w1[2], w1[3]};
#pragma unroll
                            for (int e = 0; e < 8; ++e) if (s0 + e > t) wv[e] = 0.f;
                            v4u aw; aw.x = pk2(wv[0], wv[1]); aw.y = pk2(wv[2], wv[3]); aw.z = pk2(wv[4], wv[5]); aw.w = pk2(wv[6], wv[7]);
                            const bf16x8 afr = __builtin_bit_cast(bf16x8, aw);
#pragma unroll
                            for (int j = 0; j < 8; ++j) { const bf16x8 bfr = *(const LAS bf16x8*)(T + (16 * j + fr) * 136 + s0); acc[j] = __builtin_amdgcn_mfma_f32_16x16x32_bf16(bfr, afr, acc[j], 0, 0, 0); }
                        }
                        const float bias = sgb[gI * 128 + t]; const size_t rowoff = (size_t)(128 * n + t) * 512 + 128 * gI;
#pragma unroll
                        for (int j = 0; j < 8; ++j) { const int c = 16 * j + 4 * fq; const v2u uw = *(const v2u*)(UU + rowoff + c);
                            v2u o; o.x = pk2(pg8::bflo(uw.x) * (acc[j][0] + bias), pg8::bfhi(uw.x) * (acc[j][1] + bias)); o.y = pk2(pg8::bflo(uw.y) * (acc[j][2] + bias), pg8::bfhi(uw.y) * (acc[j][3] + bias));
                            *(v2u*)(UU + rowoff + c) = o; }
                        __syncthreads();
                    }
                }
            }
            SEAM(pb + 4);
            if (IN(pb + 5)) { KARGS();
                TIDS();
                const attn_body::AttnTensors AT{(const attn_body::bf16*)(PROJ + 8 * PIECE), (const attn_body::bf16*)(PROJ + 6 * PIECE), (const attn_body::bf16*)(PROJ + 7 * PIECE), (attn_body::bf16*)(PROJ + 2 * PIECE), CS, (const unsigned*)(ws + 32768) + 8 * l};
                unsigned* qctr = (unsigned*)(ws + 40960) + 64 * l;
                volatile LAS unsigned* qw = (volatile LAS unsigned*)(ldsp + XB_LDS_OFF + 64);
                volatile LAS unsigned* T0 = (volatile LAS unsigned*)(ldsp + T0_LDS_OFF);
                {   const int hd = tid & 7, qb = 63 - (tid >> 3);
                    const float km2 = __uint_as_float(__hip_atomic_load(AT.KM + hd, __ATOMIC_RELAXED, __HIP_MEMORY_SCOPE_AGENT)), qm2 = __uint_as_float(__hip_atomic_load(AT.KM + 64 + hd, __ATOMIC_RELAXED, __HIP_MEMORY_SCOPE_AGENT));
                    T0[tid] = (unsigned)attn_skip_tiles(CS + (size_t)hd * M, qb, sqrtf(km2 * qm2) * 1.001f + 0.01f); }
                __syncthreads();
#pragma nounroll
                for (;;) {
                    if (tid == 0) qw[0] = __hip_atomic_fetch_add(qctr, 1u, __ATOMIC_RELAXED, __HIP_MEMORY_SCOPE_AGENT);
                    __syncthreads();
                    const unsigned idx = qw[0];
                    __syncthreads();
                    if (idx >= 2048u) break;
                    const int c = (int)(idx >> 9), un = (int)(idx & 511u), qb = 63 - (un >> 3), hd = un & 7, ntf = 4 * (qb + 1);
                    const int t0 = (int)T0[un], len = ntf - t0, n = attn_chunks(len);
                    if (c >= n) continue;
                    const bool last = (c == n - 1); const int tb = t0 + 64 * c, ntl = last ? ntf - tb : 64;
                    attn_body::bf16* Oc = (attn_body::bf16*)(PROJ + (last ? 2 : 3 + c) * PIECE);
                    float* Lc = last ? (float*)(ws + WS_LPL) : (float*)(ws + WS_LP) + (size_t)c * M * 8;
                    attn_body::attn_unit<8>(0, hd, qb, AT.Q, AT.K, AT.V, Oc, CS, AT.KM, (char*)lds, tb, ntl, last, Lc);
                }
                __syncthreads();
            }
            SEAM(pb + 5);
            if (IN(pb + 6)) { KARGS();
                {
                    TIDS(); const unsigned* KMp = (const unsigned*)(ws + 32768) + 8 * l;
                    for (int un = vcu; un < 512; un += G) {
                        const int qb = 63 - (un >> 3), hd = un & 7, ntf = 4 * (qb + 1);
                        const float km2 = __uint_as_float(__hip_atomic_load(KMp + hd, __ATOMIC_RELAXED, __HIP_MEMORY_SCOPE_AGENT)), qm2 = __uint_as_float(__hip_atomic_load(KMp + 64 + hd, __ATOMIC_RELAXED, __HIP_MEMORY_SCOPE_AGENT));
                        const int t0 = attn_skip_tiles(CS + (size_t)hd * M, qb, sqrtf(km2 * qm2) * 1.001f + 0.01f), n = attn_chunks(ntf - t0);
                        if (n <= 1) continue;
                        for (int it = tid; it < 2048; it += NTHREADS) { const int row = 256 * qb + (it >> 3); const size_t off = (size_t)row * 512 + hd * 64 + (it & 7) * 8;
                            float lw = ((const float*)(ws + WS_LPL))[(size_t)row * 8 + hd], ls = lw; const v4u yw = *(const v4u*)(PROJ + 2 * PIECE + off);
                            float y[8];
#pragma unroll
                            for (int e = 0; e < 4; ++e) { y[2 * e] = pg8::bflo(yw[e]) * lw; y[2 * e + 1] = pg8::bfhi(yw[e]) * lw; }
                            for (int c = 0; c < n - 1; ++c) { const float lc = ((const float*)(ws + WS_LP))[((size_t)c * M + row) * 8 + hd]; ls += lc; const v4u pw = *(const v4u*)(PROJ + (size_t)(3 + c) * PIECE + off);
#pragma unroll
                                for (int e = 0; e < 4; ++e) { y[2 * e] += pg8::bflo(pw[e]) * lc; y[2 * e + 1] += pg8::bfhi(pw[e]) * lc; } }
                            const float inv = 1.0f / ls; v4u o; o.x = pk2(y[0] * inv, y[1] * inv); o.y = pk2(y[2] * inv, y[3] * inv); o.z = pk2(y[4] * inv, y[5] * inv); o.w = pk2(y[6] * inv, y[7] * inv);
                            *(v4u*)(PROJ + 2 * PIECE + off) = o; }
                    }
                }
                pg8::Gemm g{XB, Wt + WO_G, 1024, 1024, 1024, 0, 0}; pg8::StaticOrder S; S.init(M / 256, 12, G, bx);
                pg8::EpiGates E{SS, GT}; pg8::gemm_phase<pg8::EpiGates, pg8::StaticOrder, true, true>(ldsp, g, S, E);
            }
            SEAM(pb + 6);
            if (IN(pb + 7)) { KARGS();
                pg8::Gemm g{PROJ, Wt + WO_B, 512, 512, 512, PIECE * 2, (size_t)1024 * 512 * 2}; pg8::ZOrder<3> S; S.S.init(M / 256, 4, G, bx);
                pg8::EpiMerge E{GT}; pg8::gemm_phase<pg8::EpiMerge, pg8::ZOrder<3>, true, true>(ldsp, g, S, E);
            }
            SEAM(pb + 7);
            if (IN(pb + 8)) { KARGS();
                pg8::Gemm g{GT, Wt + WO_O, 1024, 1024, 1024, 0, 0}; pg8::StaticOrder S; S.init(M / 256, 4, G, bx);
                pg8::EpiResid E{XB, SS, 1.0f}; pg8::gemm_phase<pg8::EpiResid, pg8::StaticOrder, true, true>(ldsp, g, S, E);
            }
            SEAM(pb + 8);
            if (IN(pb + 9)) { KARGS();
                pg8::Gemm g{XB, Wt + WO_Q, 1024, 1024, 1024, 0, 0}; pg8::EpiScale<1> E{SS, XQ, 1024, 0.0625f * LOG2E};
                for (int Lx = vcu; Lx < 256; Lx += G) { pg8::OneUnit S; S.u0.pm = Lx >> 2; S.u0.pn = Lx & 3; S.u0.z = 0; pg8::gemm_phase<pg8::EpiScale<1>, pg8::OneUnit, true, true>(ldsp, g, S, E); }
            }
            SEAM_LOCAL(pb + 9);
            if (IN(pb + 10)) { KARGS();
                pg8::Gemm g{XQ, KC, 256, 1024, 1024, 512, 512}; pg8::EpiSoftmax E{PB};
                for (int Lx = vcu; Lx < 256; Lx += G) { pg8::OneUnit S; S.u0.pm = Lx >> 2; S.u0.pn = 0; S.u0.z = Lx & 3; pg8::gemm_phase<pg8::EpiSoftmax, pg8::OneUnit, false, true>(ldsp, g, S, E); }
            }
            SEAM_LOCAL(pb + 10);
            if (IN(pb + 11)) { KARGS();
                pg8::Gemm g{PB, VCT, 256, 1024, 256, 512, (size_t)256 * 256 * 2}; pg8::EpiScale<0> E{nullptr, OB, 1024, 1.0f};
                for (int Lx = vcu; Lx < 256; Lx += G) { pg8::OneUnit S; S.u0.pm = Lx >> 2; S.u0.pn = 0; S.u0.z = Lx & 3; pg8::gemm_phase<pg8::EpiScale<0>, pg8::OneUnit, true, true>(ldsp, g, S, E); }
            }
            SEAM(pb + 11);
            if (IN(pb + 12)) { KARGS();
                pg8::Gemm g{OB, Wt + WO_XO, 1024, 1024, 1024, 0, 0}; pg8::StaticOrder S; S.init(M / 256, 4, G, bx);
                pg8::EpiResid E{XB, SS, 1.0f}; pg8::gemm_phase<pg8::EpiResid, pg8::StaticOrder, true, true>(ldsp, g, S, E);
            }
            SEAM(pb + 12);
        }
    }
#ifdef MK_DUMP_OFF
    {
        GRID_SYNC(); KARGS(); int t_ = threadIdx.x; asm volatile("" : "+v"(t_));
        const bf16* src = SCR + (size_t)(MK_DUMP_OFF);
        for (unsigned i = blockIdx.x * 512u + (unsigned)t_; i < (unsigned)M * 1024u; i += gridDim.x * 512u) { const unsigned m = i >> 10, c = i & 1023u;
            X[i] = c < (unsigned)(MK_DUMP_LD) ? b2f(src[(size_t)m * (MK_DUMP_LD) + c]) : 0.f; }
    }
#endif
    if (IN(30)) { KARGS(); TIDS();
        const float* gf = in[25];
        for (int m = gw; m < M; m += NGW) {
            const v2u* xb = (const v2u*)(XB + (size_t)m * D) + lane; f32x4* xr = (f32x4*)(X + (size_t)m * D) + lane; f32x4 v[4]; float s = 0.f;
#pragma unroll
            for (int j = 0; j < 4; ++j) { const v2u xw = xb[64 * j]; v[j] = (f32x4){pg8::bflo(xw.x), pg8::bfhi(xw.x), pg8::bflo(xw.y), pg8::bfhi(xw.y)}; s += (v[j][0] * v[j][0] + v[j][1] * v[j][1]) + (v[j][2] * v[j][2] + v[j][3] * v[j][3]); }
            const float r = rsqrtf(wave_sum(s) * (1.0f / D) + EPS);
#pragma unroll
            for (int j = 0; j < 4; ++j) xr[64 * j] = v[j] * r * *((const f32x4*)gf + lane + 64 * j);
        }
    }
#undef IN
#undef SEAM
#undef ws
#undef X
#undef SS
#undef SSV
#undef LF
#undef CS
#undef RSM
#undef MEMB
#undef KC
#undef VCT
#undef Wt
#undef XB
#undef SCR
#undef ACT
#undef PROJ
#undef GT
#undef XQ
#undef PB
#undef OB
#undef in
}

#ifndef MK_PER_PHASE
#define MK_PER_PHASE 0
#endif
extern "C" void kernel_launch(void* const* d_in, const int* in_sizes, int n_in, void* d_out, int out_size, void* d_ws, size_t ws_size, hipStream_t stream) {
    static int grid = 0;
    if (grid == 0) {
        if (n_in != 26 || out_size != M * D || ws_size < WS_END) { fprintf(stderr, "kernel_launch: unexpected shapes (n_in %d out %d ws %zu)\n", n_in, out_size, ws_size); grid = -1; return; }
        int dev = 0, cus = 0, per_cu = 0;
        (void)hipGetDevice(&dev); (void)hipDeviceGetAttribute(&cus, hipDeviceAttributeMultiprocessorCount, dev);
        if (hipFuncSetAttribute((const void*)mk_fwd, hipFuncAttributeMaxDynamicSharedMemorySize, LDS_BYTES) != hipSuccess) { fprintf(stderr, "kernel_launch: hipFuncSetAttribute failed\n"); grid = -1; return; }
        if (hipOccupancyMaxActiveBlocksPerMultiprocessor(&per_cu, (const void*)mk_fwd, NTHREADS, LDS_BYTES) != hipSuccess || per_cu < 1) { fprintf(stderr, "kernel_launch: occupancy query says %d\n", per_cu); per_cu = 1; }
        (void)hipGetLastError();
        grid = cus > 0 ? cus : 256;
    }
    if (grid < 0) return;
    (void)hipMemsetAsync(d_ws, 0, 65536, stream);
    Args a{};
    for (int i = 0; i < 26; ++i) a.in[i] = (const float*)d_in[i];
    a.out = (float*)d_out; a.ws = (unsigned char*)d_ws;
#if MK_PER_PHASE
    for (int p = 0; p < 31; ++p) { a.ph_lo = p; a.ph_hi = p + 1; void* kargs[] = {&a};
        hipError_t e = hipLaunchCooperativeKernel((const void*)mk_fwd, dim3(grid), dim3(NTHREADS), kargs, LDS_BYTES, stream);
        if (e != hipSuccess) { fprintf(stderr, "launch %d failed: %s\n", p, hipGetErrorString(e)); break; } }
#else
#ifndef MK_PH_HI
#define MK_PH_HI 31
#endif
    a.ph_lo = 0; a.ph_hi = MK_PH_HI; void* kargs[] = {&a};
    hipError_t e = hipLaunchCooperativeKernel((const void*)mk_fwd, dim3(grid), dim3(NTHREADS), kargs, LDS_BYTES, stream);
    if (e != hipSuccess) fprintf(stderr, "cooperative launch failed: %s (grid %d)\n", hipGetErrorString(e), grid);
#endif
}
```

```cpp
#include <hip/hip_runtime.h>
#include <hip/hip_cooperative_groups.h>
#include <cstdio>
#include <cstdint>
namespace cg = cooperative_groups;

namespace pg8 {
#define PG8_LAS __attribute__((address_space(3)))
typedef unsigned short bf16_t;
typedef short bf16x8 __attribute__((ext_vector_type(8)));
typedef float f32x4 __attribute__((ext_vector_type(4)));
typedef unsigned u32x4 __attribute__((ext_vector_type(4)));
constexpr int BM = 256, BK = 64, HALF = 128, HTB = HALF * BK * 2  , STAGE_BYTES = 8 * HTB, NXCD = 8, WGM = 8;

__host__ __device__ __forceinline__ int lds_byte(int r, int c) { const int st = (r >> 4) * 2 + (c >> 5), rr = r & 15, cc = c & 31, ob = rr * 64 + cc * 2; return st * 1024 + (ob ^ (((ob >> 9) & 1) << 5)); }
__host__ __device__ __forceinline__ void stage_rc(int b, int& R, int& C) { const int st = b / 1024, sb = b % 1024, swz = sb ^ (((sb >> 9) & 1) << 5); R = (st >> 1) * 16 + swz / 64; C = (st & 1) * 32 + (swz % 64) / 2; }
__host__ __device__ __forceinline__ int perm32(int rho) { const int n = rho >> 4, i = rho & 15; return 8 * (i >> 2) + 4 * n + (i & 3); }

struct Unit { int pm, pn, z; };
typedef float f32x2 __attribute__((ext_vector_type(2))); typedef __bf16 bf16x2_cv __attribute__((ext_vector_type(2)));
__device__ __forceinline__ unsigned cvt_pk_bf16(float lo, float hi) { const f32x2 v = {lo, hi}; const bf16x2_cv b = __builtin_convertvector(v, bf16x2_cv); return __builtin_bit_cast(unsigned, b); }
struct Gemm { const bf16_t* A; const bf16_t* Bt; int K, lda, ldb; size_t zA, zB; };

struct StaticOrder {
    int nM, nN, nwg, G, c;
    __host__ __device__ void init(int nM_, int nN_, int G_, int c_) { nM = nM_; nN = nN_; nwg = nM * nN; G = G_; c = c_; }
    __host__ __device__ void map(int wgid, Unit& u) const {
        { const int q = nwg / NXCD, r = nwg % NXCD, xcd = wgid % NXCD, off = wgid / NXCD; wgid = (xcd < r ? xcd * (q + 1) : r * (q + 1) + (xcd - r) * q) + off; }
        const int nig = WGM * nN, gid = wgid / nig, fm = gid * WGM, gsz = (nM - fm) < WGM ? (nM - fm) : WGM;
        u.pm = fm + ((wgid % nig) % gsz); u.pn = (wgid % nig) / gsz; u.z = 0;
    }
    __host__ __device__ bool next(int i, Unit& u) const { const long L = (long)i * G + c; if (L >= nwg) return false; map((int)L, u); return true; }
    __device__ __forceinline__ void a_ready(const Unit&) const {}
    __device__ __forceinline__ void done(const Unit&) const {}
};
template <int NZ> struct ZOrder {
    StaticOrder S;
    __host__ __device__ bool next(int i, Unit& u) const { const long L = (long)(i / NZ) * S.G + S.c; if (L >= S.nwg) return false; S.map((int)L, u); u.z = i % NZ; return true; }
    __device__ __forceinline__ void a_ready(const Unit&) const {}
    __device__ __forceinline__ void done(const Unit&) const {}
};
struct OneUnit {
    Unit u0;
    __host__ __device__ bool next(int i, Unit& u) const { if (i > 0) return false; u = u0; return true; }
    __device__ __forceinline__ void a_ready(const Unit&) const {}
    __device__ __forceinline__ void done(const Unit&) const {}
};

typedef unsigned u32x2 __attribute__((ext_vector_type(2)));
constexpr float LOG2E = 1.4426950408889634f;
__device__ __forceinline__ float bf2f(unsigned short b) { return __uint_as_float((unsigned)b << 16); }
__device__ __forceinline__ float bflo(unsigned w) { return __uint_as_float(w << 16); }
__device__ __forceinline__ float bfhi(unsigned w) { return __uint_as_float(w & 0xffff0000u); }
__device__ __forceinline__ float sigmoidf_(float v) { return __builtin_amdgcn_rcpf(1.0f + __builtin_amdgcn_exp2f(-v * LOG2E)); }
__device__ __forceinline__ float gelu_tanh(float v) { const float z = 0.7978845608028654f * (v + 0.044715f * v * v * v); return v * sigmoidf_(2.0f * z); }
__device__ __forceinline__ u32x4 pack8(const f32x4 a, const f32x4 b) { u32x4 w; w.x = cvt_pk_bf16(a[0], a[1]); w.y = cvt_pk_bf16(a[2], a[3]); w.z = cvt_pk_bf16(b[0], b[1]); w.w = cvt_pk_bf16(b[2], b[3]); return w; }
__device__ __forceinline__ void row_rstd(const float* SS, int rowbase, int fq, float (&rs)[2][4]) {
#pragma unroll
    for (int ai = 0; ai < 2; ++ai)
#pragma unroll
        for (int m = 0; m < 4; ++m) { const f32x4 v = *(const f32x4*)(SS + (size_t)(rowbase + ai * HALF + m * 16) * 16 + 4 * fq);
            float s = (v[0] + v[1]) + (v[2] + v[3]); s += __shfl_xor(s, 16); s += __shfl_xor(s, 32); rs[ai][m] = rsqrtf(s * (1.0f / 1024.0f) + 1e-6f); }
}
__device__ __forceinline__ float row_rstd1(const float* SS, int row, int fq) { const f32x4 v = *(const f32x4*)(SS + (size_t)row * 16 + 4 * fq);
    float s = (v[0] + v[1]) + (v[2] + v[3]); s += __shfl_xor(s, 16); s += __shfl_xor(s, 32); return rsqrtf(s * (1.0f / 1024.0f) + 1e-6f); }
#define EPI_ARGS const f32x4 (&acc)[2][2][4][2], const Unit& u, int wr, int wc, int fr, int fq
struct EpiSwiGLU { static constexpr bool PERM = true, AFTER_DRAIN = false; const float* SS; bf16_t* O;
    __device__ __forceinline__ void operator()(EPI_ARGS) const {
        float rs[2][4]; row_rstd(SS, u.pm * BM + wr * 64 + fr, fq, rs);
        const int col0 = u.pn * 128 + wc * 32 + 8 * fq;
#pragma unroll
        for (int ai = 0; ai < 2; ++ai)
#pragma unroll
            for (int m = 0; m < 4; ++m) { const float r = rs[ai][m]; f32x4 o[2];
#pragma unroll
                for (int n = 0; n < 2; ++n)
#pragma unroll
                    for (int j = 0; j < 4; ++j) { const float g = acc[ai][0][m][n][j] * r, up = acc[ai][1][m][n][j] * r; o[n][j] = g * sigmoidf_(g) * up; }
                *(u32x4*)(O + (size_t)(u.pm * BM + ai * HALF + wr * 64 + m * 16 + fr) * 2816 + col0) = pack8(o[0], o[1]); }
    }
};
struct EpiResid { static constexpr bool PERM = false, AFTER_DRAIN = false; bf16_t* XB; float* SS; float scale;
    __device__ __forceinline__ void operator()(EPI_ARGS) const {
        const int col0 = u.pn * BM + wc * 32 + 4 * fq;
#pragma unroll
        for (int ai = 0; ai < 2; ++ai)
#pragma unroll
            for (int m = 0; m < 4; ++m) { const int row = u.pm * BM + ai * HALF + wr * 64 + m * 16 + fr; float ssq = 0.f;
#pragma unroll
                for (int bj = 0; bj < 2; ++bj)
#pragma unroll
                    for (int n = 0; n < 2; ++n) { const size_t off = (size_t)row * 1024 + col0 + bj * HALF + n * 16;
                        const u32x2 xw = *(const u32x2*)(XB + off);
                        f32x4 x = {bflo(xw.x), bfhi(xw.x), bflo(xw.y), bfhi(xw.y)}; x = x + acc[ai][bj][m][n] * scale;
                        u32x2 w; w.x = cvt_pk_bf16(x[0], x[1]); w.y = cvt_pk_bf16(x[2], x[3]); *(u32x2*)(XB + off) = w;
                        ssq += (x[0] * x[0] + x[1] * x[1]) + (x[2] * x[2] + x[3] * x[3]); }
                ssq += __shfl_xor(ssq, 16); ssq += __shfl_xor(ssq, 32);
                if (fq == 0) SS[(size_t)row * 16 + u.pn * 4 + wc] = ssq; }
    }
};
struct EpiWin { static constexpr bool PERM = true, AFTER_DRAIN = false; const float* SS; bf16_t* P; float* SSV; float qscale;
    __device__ __forceinline__ void operator()(EPI_ARGS) const {
        const int piece = u.pn >> 1;
        const int slot = piece == 0 ? 0 : piece == 1 ? 3 : piece == 2 ? 4 : piece == 3 ? 1 : piece == 4 ? 5 : piece == 5 ? 8 : piece;
        bf16_t* base = P + (size_t)slot * (16384u * 512u);
        const int col0 = (u.pn & 1) * 256 + wc * 32 + 8 * fq;
        const float sc = piece == 5 ? qscale : 1.0f;
#pragma unroll
        for (int ai = 0; ai < 2; ++ai)
#pragma unroll
            for (int m = 0; m < 4; ++m) { const int row = u.pm * BM + ai * HALF + wr * 64 + m * 16 + fr; const float r = row_rstd1(SS, row, fq) * sc; float ssq = 0.f;
#pragma unroll
                for (int bj = 0; bj < 2; ++bj) { f32x4 v0 = acc[ai][bj][m][0] * r, v1 = acc[ai][bj][m][1] * r;
                    if (piece == 3 || piece == 4) {
#pragma unroll
                        for (int j = 0; j < 4; ++j) { v0[j] = gelu_tanh(v0[j]); v1[j] = gelu_tanh(v1[j]); }
                        ssq += (v0[0] * v0[0] + v0[1] * v0[1]) + (v0[2] * v0[2] + v0[3] * v0[3]) + (v1[0] * v1[0] + v1[1] * v1[1]) + (v1[2] * v1[2] + v1[3] * v1[3]); }
                    *(u32x4*)(base + (size_t)row * 512 + col0 + bj * HALF) = pack8(v0, v1); }
                if (piece == 4) { ssq += __shfl_xor(ssq, 16); ssq += __shfl_xor(ssq, 32); if (fq == 0) SSV[(size_t)row * 8 + (u.pn & 1) * 4 + wc] = ssq; }
                asm volatile("" ::: "memory"); }
    }
};
struct EpiGates { static constexpr bool PERM = true, AFTER_DRAIN = false; const float* SS; bf16_t* G;
    __device__ __forceinline__ void operator()(EPI_ARGS) const {
        float rs[2][4]; row_rstd(SS, u.pm * BM + wr * 64 + fr, fq, rs);
        bf16_t* base = G + (size_t)(u.pn >> 2) * (16384u * 1024u);
        const int col0 = (u.pn & 3) * 256 + wc * 32 + 8 * fq;
#pragma unroll
        for (int ai = 0; ai < 2; ++ai)
#pragma unroll
            for (int m = 0; m < 4; ++m) { const int row = u.pm * BM + ai * HALF + wr * 64 + m * 16 + fr; const float r = rs[ai][m];
#pragma unroll
                for (int bj = 0; bj < 2; ++bj) { f32x4 v0 = acc[ai][bj][m][0] * r, v1 = acc[ai][bj][m][1] * r;
#pragma unroll
                    for (int j = 0; j < 4; ++j) { v0[j] = sigmoidf_(v0[j]); v1[j] = sigmoidf_(v1[j]); }
                    *(u32x4*)(base + (size_t)row * 1024 + col0 + bj * HALF) = pack8(v0, v1); } }
    }
};
struct EpiMerge { static constexpr bool PERM = true, AFTER_DRAIN = false; bf16_t* G;
    __device__ __forceinline__ void operator()(EPI_ARGS) const {
        const bf16_t* gz = G + (size_t)u.z * (16384u * 1024u);
        const int col0 = u.pn * 256 + wc * 32 + 8 * fq;
#pragma unroll
        for (int ai = 0; ai < 2; ++ai)
#pragma unroll
            for (int m = 0; m < 4; ++m) { const int row = u.pm * BM + ai * HALF + wr * 64 + m * 16 + fr;
#pragma unroll
                for (int bj = 0; bj < 2; ++bj) { const size_t off = (size_t)row * 1024 + col0 + bj * HALF;
                    const u32x4 gw = *(const u32x4*)(gz + off);
                    f32x4 g0 = {bflo(gw.x), bfhi(gw.x), bflo(gw.y), bfhi(gw.y)}, g1 = {bflo(gw.z), bfhi(gw.z), bflo(gw.w), bfhi(gw.w)};
                    f32x4 v0 = acc[ai][bj][m][0] * g0, v1 = acc[ai][bj][m][1] * g1;
#ifdef MK_DBG_Z
                    if (u.z != MK_DBG_Z) { v0 = v0 * 0.f; v1 = v1 * 0.f; }
#endif
                    if (u.z != 0) { u32x4 pw; { const unsigned long long a_ = __hip_atomic_load((const unsigned long long*)(G + off), __ATOMIC_RELAXED, __HIP_MEMORY_SCOPE_AGENT), b_ = __hip_atomic_load((const unsigned long long*)(G + off) + 1, __ATOMIC_RELAXED, __HIP_MEMORY_SCOPE_AGENT);
                            pw.x = (unsigned)a_; pw.y = (unsigned)(a_ >> 32); pw.z = (unsigned)b_; pw.w = (unsigned)(b_ >> 32); }
                        v0 = v0 + (f32x4){bflo(pw.x), bfhi(pw.x), bflo(pw.y), bfhi(pw.y)}; v1 = v1 + (f32x4){bflo(pw.z), bfhi(pw.z), bflo(pw.w), bfhi(pw.w)}; }
                    *(u32x4*)(G + off) = pack8(v0, v1); } }
    }
};
template <int MODE> struct EpiScale { static constexpr bool PERM = true, AFTER_DRAIN = false; const float* S; bf16_t* O; int ldc; float scale;
    __device__ __forceinline__ void operator()(EPI_ARGS) const {
        float rs[2][4];
        if (MODE == 1) row_rstd(S, u.pm * BM + wr * 64 + fr, fq, rs);
        const int col0 = (u.pn + u.z) * 256 + wc * 32 + 8 * fq;
#pragma unroll
        for (int ai = 0; ai < 2; ++ai)
#pragma unroll
            for (int m = 0; m < 4; ++m) { const int row = u.pm * BM + ai * HALF + wr * 64 + m * 16 + fr;
                float r = scale; if (MODE == 1) r *= rs[ai][m]; if (MODE == 2) r *= S[row];
#pragma unroll
                for (int bj = 0; bj < 2; ++bj) { f32x4 v0 = acc[ai][bj][m][0] * r, v1 = acc[ai][bj][m][1] * r;
                    if (MODE == 3) { v0 = v0 * *(const f32x4*)(S + col0 + bj * HALF); v1 = v1 * *(const f32x4*)(S + col0 + bj * HALF + 4); }
                    *(u32x4*)(O + (size_t)row * ldc + col0 + bj * HALF) = pack8(v0, v1); } }
    }
};
struct EpiSoftmax { static constexpr bool PERM = true, AFTER_DRAIN = true; bf16_t* O;
    __device__ __forceinline__ void fused(f32x4 (&acc)[2][2][4][2], const Unit& u, int wr, int wc, int fr, int fq, PG8_LAS unsigned char* lds, int wid, int lane) const {
        PG8_LAS float* T1 = (PG8_LAS float*)lds; PG8_LAS float* T2 = (PG8_LAS float*)(lds + 4096);
#pragma unroll
        for (int ai = 0; ai < 2; ++ai)
#pragma unroll
            for (int m = 0; m < 4; ++m) { float mx = -3.0e38f;
#pragma unroll
                for (int bj = 0; bj < 2; ++bj)
#pragma unroll
                    for (int n = 0; n < 2; ++n)
#pragma unroll
                        for (int j = 0; j < 4; ++j) mx = fmaxf(mx, acc[ai][bj][m][n][j]);
                mx = fmaxf(mx, __shfl_xor(mx, 16)); mx = fmaxf(mx, __shfl_xor(mx, 32));
                if (fq == 0) T1[(ai * HALF + wr * 64 + m * 16 + fr) * 4 + wc] = mx; }
        asm volatile("s_waitcnt lgkmcnt(0)" ::: "memory"); __builtin_amdgcn_s_barrier(); asm volatile("" ::: "memory");
#pragma unroll
        for (int ai = 0; ai < 2; ++ai)
#pragma unroll
            for (int m = 0; m < 4; ++m) { const int rl = ai * HALF + wr * 64 + m * 16 + fr; const f32x4 t = *(const PG8_LAS f32x4*)(T1 + rl * 4);
                const float mx = fmaxf(fmaxf(t[0], t[1]), fmaxf(t[2], t[3])); float s = 0.f;
#pragma unroll
                for (int bj = 0; bj < 2; ++bj)
#pragma unroll
                    for (int n = 0; n < 2; ++n)
#pragma unroll
                        for (int j = 0; j < 4; ++j) { const float p = __builtin_amdgcn_exp2f(acc[ai][bj][m][n][j] - mx); acc[ai][bj][m][n][j] = p; s += p; }
                s += __shfl_xor(s, 16); s += __shfl_xor(s, 32);
                if (fq == 0) T2[rl * 4 + wc] = s; }
        asm volatile("s_waitcnt lgkmcnt(0)" ::: "memory"); __builtin_amdgcn_s_barrier(); asm volatile("" ::: "memory");
        const int col0 = u.z * 256 + wc * 32 + 8 * fq;
#pragma unroll
        for (int ai = 0; ai < 2; ++ai)
#pragma unroll
            for (int m = 0; m < 4; ++m) { const int rl = ai * HALF + wr * 64 + m * 16 + fr; const f32x4 t = *(const PG8_LAS f32x4*)(T2 + rl * 4);
                const float inv = 1.0f / ((t[0] + t[1]) + (t[2] + t[3]));
#pragma unroll
                for (int bj = 0; bj < 2; ++bj) *(u32x4*)(O + (size_t)(u.pm * BM + rl) * 1024 + col0 + bj * HALF) = pack8(acc[ai][bj][m][0] * inv, acc[ai][bj][m][1] * inv); }
        asm volatile("s_waitcnt lgkmcnt(0)" ::: "memory"); __builtin_amdgcn_s_barrier(); asm volatile("" ::: "memory");
    }
};

template <class Epi, class Sched, bool ALIGN_EPI = false, bool SP2 = false>
__device__ __forceinline__ void gemm_phase(PG8_LAS unsigned char* lds, const Gemm g, const Sched& S, const Epi& E) {
    int tid_o = threadIdx.x; asm volatile("" : "+v"(tid_o)); const int tid = tid_o, wid = __builtin_amdgcn_readfirstlane(tid >> 6), lane = tid & 63, wr = wid >> 2, wc = wid & 3, fr = lane & 15, fq = lane >> 4;
    const int nt = g.K / BK; const char* gA_ = reinterpret_cast<const char*>(g.A); const char* gB_ = reinterpret_cast<const char*>(g.Bt); asm volatile("" : "+s"(gA_), "+s"(gB_));
    unsigned voffA[2], voffB[2];
#pragma unroll
    for (int i = 0; i < 2; ++i) { int R, C; stage_rc(tid * 16 + i * 8192, R, C); const int Rb = Epi::PERM ? ((R & ~31) + perm32(R & 31)) : R;
        voffA[i] = (unsigned)(R * g.lda + C) * 2u; voffB[i] = (unsigned)(Rb * g.ldb + C) * 2u; }
    const size_t kstep = (size_t)(BK * 2);
    const size_t hstepA = (size_t)HALF * g.lda * 2, hstepB = (size_t)HALF * g.ldb * 2;

    const unsigned ldsw = (unsigned)wid * 1024u;
    const int aoff = lds_byte(wr * 64 + fr, fq * 8), boff = lds_byte(wc * 32 + fr, fq * 8);
#define PG8_SA(b, h) (((b) * 2 + (h)) * HTB)
#define PG8_SB(b, h) ((4 + (b) * 2 + (h)) * HTB)
#define PG8_STAGE(bufoff, gbase, voff) do { _Pragma("unroll") for (int _i = 0; _i < 2; ++_i) \
        __builtin_amdgcn_global_load_lds((const unsigned*)((const char*)(gbase) + (voff)[_i]), (PG8_LAS unsigned*)(lds + (bufoff) + ldsw + _i * 8192), 16, 0, 0); } while (0)
#define PG8_LDA(dst, b, h) do { _Pragma("unroll") for (int m = 0; m < 4; ++m) _Pragma("unroll") for (int k = 0; k < 2; ++k) dst[m][k] = *(const PG8_LAS bf16x8*)(lds + PG8_SA(b, h) + aoff + m * 2048 + k * 1024); } while (0)
#define PG8_LDB(dst, b, h) do { _Pragma("unroll") for (int n = 0; n < 2; ++n) _Pragma("unroll") for (int k = 0; k < 2; ++k) dst[n][k] = *(const PG8_LAS bf16x8*)(lds + PG8_SB(b, h) + boff + n * 2048 + k * 1024); } while (0)
#define PG8_MMA(ai, bj, At, Bt) do { __builtin_amdgcn_s_setprio(1); _Pragma("unroll") for (int m = 0; m < 4; ++m) _Pragma("unroll") for (int n = 0; n < 2; ++n) _Pragma("unroll") for (int k = 0; k < 2; ++k) \
        acc[ai][bj][m][n] = __builtin_amdgcn_mfma_f32_16x16x32_bf16(Bt[n][k], At[m][k], acc[ai][bj][m][n], 0, 0, 0); __builtin_amdgcn_s_setprio(0); } while (0)
#define PG8_WAIT_V(n) asm volatile("s_waitcnt vmcnt(" #n ")" ::: "memory")
#define PG8_WAIT_L(n) asm volatile("s_waitcnt lgkmcnt(" #n ")" ::: "memory")
#define PG8_BAR __builtin_amdgcn_s_barrier()
#define PG8_SCHED __builtin_amdgcn_sched_barrier(0)
    Unit cur, nxt; int ui = 0;
    if (!S.next(0, cur)) return;
    f32x4 acc[2][2][4][2];
#pragma unroll
    for (int a = 0; a < 2; ++a)
#pragma unroll
        for (int b = 0; b < 2; ++b)
#pragma unroll
            for (int m = 0; m < 4; ++m)
#pragma unroll
                for (int n = 0; n < 2; ++n) acc[a][b][m][n] = (f32x4){0.f, 0.f, 0.f, 0.f};
    bf16x8 At[4][2], B0[2][2], B1[2][2];
    const char* cA = gA_ + (size_t)cur.pm * 2 * hstepA + (size_t)cur.z * g.zA; const char* cB = gB_ + (size_t)cur.pn * 2 * hstepB + (size_t)cur.z * g.zB;
    S.a_ready(cur);
    if constexpr (SP2) {
        PG8_STAGE(PG8_SB(0, 0), cB, voffB); PG8_STAGE(PG8_SB(0, 1), cB + hstepB, voffB); PG8_STAGE(PG8_SA(0, 0), cA, voffA); PG8_STAGE(PG8_SA(0, 1), cA + hstepA, voffA);
        if (wr == 1) PG8_BAR;
        PG8_WAIT_V(2); PG8_BAR;
        PG8_STAGE(PG8_SB(1, 0), cB + kstep, voffB); PG8_STAGE(PG8_SA(1, 0), cA + kstep, voffA); PG8_STAGE(PG8_SB(1, 1), cB + hstepB + kstep, voffB);
        PG8_WAIT_V(6); PG8_BAR;
    } else {
        PG8_STAGE(PG8_SB(0, 0), cB, voffB); PG8_STAGE(PG8_SA(0, 0), cA, voffA); PG8_STAGE(PG8_SB(0, 1), cB + hstepB, voffB); PG8_STAGE(PG8_SA(0, 1), cA + hstepA, voffA);
        if (wr == 1) PG8_BAR;
        PG8_WAIT_V(4); PG8_BAR;
        PG8_STAGE(PG8_SB(1, 0), cB + kstep, voffB); PG8_STAGE(PG8_SA(1, 0), cA + kstep, voffA); PG8_STAGE(PG8_SB(1, 1), cB + hstepB + kstep, voffB);
        PG8_WAIT_V(6); PG8_BAR;
    }
    for (;;) {
        const bool has_next = S.next(ui + 1, nxt);
        const char* nA = has_next ? gA_ + (size_t)nxt.pm * 2 * hstepA + (size_t)nxt.z * g.zA : cA; const char* nB = has_next ? gB_ + (size_t)nxt.pn * 2 * hstepB + (size_t)nxt.z * g.zB : cB;
_Pragma("nounroll")
        for (int t = 0; t < nt; t += 2) {
            const bool last = (t == nt - 2);
            const char* a1 = cA + (size_t)(t + 1) * kstep;
            const char* a2 = last ? nA : cA + (size_t)(t + 2) * kstep; const char* b2 = last ? nB : cB + (size_t)(t + 2) * kstep;
            const char* a3 = a2 + kstep; const char* b3 = b2 + kstep;
            if (last && has_next) S.a_ready(nxt);
            if constexpr (SP2) {
            PG8_LDB(B0, 0, 0); PG8_LDB(B1, 0, 1); PG8_SCHED; PG8_LDA(At, 0, 0); PG8_STAGE(PG8_SA(1, 1), a1 + hstepA, voffA);
            PG8_WAIT_V(8); PG8_WAIT_L(0); PG8_BAR; PG8_MMA(0, 0, At, B0); PG8_MMA(0, 1, At, B1); PG8_BAR; PG8_SCHED;
            PG8_LDA(At, 0, 1); PG8_STAGE(PG8_SB(0, 0), b2, voffB); PG8_STAGE(PG8_SB(0, 1), b2 + hstepB, voffB); PG8_STAGE(PG8_SA(0, 0), a2, voffA);
            PG8_WAIT_V(8); PG8_WAIT_L(0); PG8_BAR; PG8_MMA(1, 0, At, B0); PG8_MMA(1, 1, At, B1); PG8_BAR; PG8_SCHED;
            PG8_LDB(B0, 1, 0); PG8_LDB(B1, 1, 1); PG8_SCHED; PG8_LDA(At, 1, 0); PG8_STAGE(PG8_SA(0, 1), a2 + hstepA, voffA);
            PG8_WAIT_V(8); PG8_WAIT_L(0); PG8_BAR; PG8_MMA(0, 0, At, B0); PG8_MMA(0, 1, At, B1); PG8_BAR; PG8_SCHED;
            PG8_LDA(At, 1, 1); PG8_STAGE(PG8_SB(1, 0), b3, voffB); PG8_STAGE(PG8_SB(1, 1), b3 + hstepB, voffB); PG8_STAGE(PG8_SA(1, 0), a3, voffA);
            PG8_WAIT_V(8); PG8_WAIT_L(0); PG8_BAR; PG8_MMA(1, 0, At, B0); PG8_MMA(1, 1, At, B1); PG8_BAR; PG8_SCHED;
            } else {
            PG8_LDB(B0, 0, 0); PG8_SCHED; PG8_LDA(At, 0, 0); PG8_STAGE(PG8_SA(1, 1), a1 + hstepA, voffA);
            PG8_WAIT_L(8); PG8_BAR; PG8_WAIT_L(0); PG8_MMA(0, 0, At, B0); PG8_BAR; PG8_SCHED;
            PG8_LDB(B1, 0, 1); PG8_STAGE(PG8_SB(0, 0), b2, voffB);
            PG8_BAR; PG8_WAIT_L(0); PG8_MMA(0, 1, At, B1); PG8_BAR;
            PG8_LDA(At, 0, 1); PG8_STAGE(PG8_SA(0, 0), a2, voffA);
            PG8_BAR; PG8_WAIT_L(0); PG8_MMA(1, 0, At, B0); PG8_BAR; PG8_SCHED;
            PG8_STAGE(PG8_SB(0, 1), b2 + hstepB, voffB);
            PG8_WAIT_V(6); PG8_BAR; PG8_MMA(1, 1, At, B1); PG8_BAR;
            PG8_LDB(B0, 1, 0); PG8_SCHED; PG8_LDA(At, 1, 0); PG8_STAGE(PG8_SA(0, 1), a2 + hstepA, voffA);
            PG8_WAIT_L(8); PG8_BAR; PG8_WAIT_L(0); PG8_MMA(0, 0, At, B0); PG8_BAR; PG8_SCHED;
            PG8_LDB(B1, 1, 1); PG8_STAGE(PG8_SB(1, 0), b3, voffB);
            PG8_BAR; PG8_WAIT_L(0); PG8_MMA(0, 1, At, B1); PG8_BAR;
            PG8_LDA(At, 1, 1); PG8_STAGE(PG8_SA(1, 0), a3, voffA);
            PG8_BAR; PG8_WAIT_L(0); PG8_MMA(1, 0, At, B0); PG8_BAR; PG8_SCHED;
            PG8_STAGE(PG8_SB(1, 1), b3 + hstepB, voffB);
            PG8_WAIT_V(6); PG8_BAR; PG8_MMA(1, 1, At, B1); PG8_BAR;
            }
        }
        if constexpr (ALIGN_EPI) { if (wr == 0) PG8_BAR; }
        if constexpr (!Epi::AFTER_DRAIN) { E(acc, cur, wr, wc, fr, fq); S.done(cur); }
        if (!has_next) break;
#pragma unroll
        for (int a = 0; a < 2; ++a)
#pragma unroll
            for (int b = 0; b < 2; ++b)
#pragma unroll
                for (int m = 0; m < 4; ++m)
#pragma unroll
                    for (int n = 0; n < 2; ++n) acc[a][b][m][n] = (f32x4){0.f, 0.f, 0.f, 0.f};
        cur = nxt; cA = nA; cB = nB; ++ui;
        if constexpr (ALIGN_EPI) { if (wr == 1) PG8_BAR; }
    }
    PG8_WAIT_V(0);
    if constexpr (!ALIGN_EPI) { if (wr == 0) PG8_BAR; }
    PG8_BAR;
    if constexpr (Epi::AFTER_DRAIN) { E.fused(acc, cur, wr, wc, fr, fq, lds, wid, lane); S.done(cur); }
#undef PG8_SA
#undef PG8_SB
#undef PG8_STAGE
#undef PG8_LDA
#undef PG8_LDB
#undef PG8_MMA
#undef PG8_WAIT_V
#undef PG8_WAIT_L
#undef PG8_BAR
#undef PG8_SCHED
}
}
#include <hip/hip_bf16.h>
#include <cmath>
namespace attn_body {
using bf16=__hip_bfloat16;
using bf16x8=__attribute__((ext_vector_type(8)))short;
using s16x4=__attribute__((ext_vector_type(4)))short;
using f32x16=__attribute__((ext_vector_type(16)))float;
using u32x4=__attribute__((ext_vector_type(4)))unsigned;
using f32x4_t=__attribute__((ext_vector_type(4)))float;
constexpr int BATCH=1,NHEAD=8,SEQ=16384,D=64,DM=NHEAD*D;
constexpr int NW=8,QBLK=32,QB=QBLK*NW,KVBLK=64,NQB=SEQ/QB;
constexpr int ATTN_PITCH=DM, ATTN_UNIT_ROWS=QB;
__device__ __forceinline__ int crow(int r,int hi){return (r&3)+8*(r>>2)+4*hi;}
#define SBAR() __builtin_amdgcn_sched_barrier(0)
__device__ __forceinline__ void cmask(f32x16&p0,f32x16&p1,int jb,int qrel,int hi){
  const float NEG=-INFINITY; int kb=64*jb+4*hi;
  #pragma unroll
  for(int r=0;r<16;++r){int kv=kb+(r&3)+8*(r>>2); if(kv>qrel)p0[r]=NEG; if(kv+32>qrel)p1[r]=NEG;}
}

constexpr int NSLOT=3, SLOTB=8192;
constexpr int LDS_K=0, LDS_V=NSLOT*SLOTB, LDS_WS=2*NSLOT*SLOTB, LDS_OST=LDS_WS+NW*64*4, LDS_CK=LDS_OST+NW*4096, LDS_BYTES=LDS_CK+SEQ*4;
constexpr float C2=0.125f*1.4426950408889634f;
__device__ __forceinline__ void glds16(const void*gsrc,unsigned lds_dst){unsigned keep;
  asm volatile("s_mov_b32 %0, m0\n\ts_mov_b32 m0, %2\n\ts_nop 0\n\tglobal_load_lds_dwordx4 %1, off\n\ts_mov_b32 m0, %0":"=&s"(keep):"v"(gsrc),"s"(lds_dst):"memory");}
__device__ __forceinline__ float max3f(float a,float b,float c){float r;asm("v_max3_f32 %0, %1, %2, %3":"=v"(r):"v"(a),"v"(b),"v"(c));return r;}
__device__ __forceinline__ float max2f(float a,float b){float r;asm("v_max_f32_e32 %0, %1, %2":"=v"(r):"v"(a),"v"(b));return r;}
__device__ __forceinline__ float fadd_s(float a,float b){float r;asm("v_add_f32_e32 %0, %1, %2":"=v"(r):"v"(a),"v"(b));return r;}
__device__ __forceinline__ float fsub_s(float a,float b){float r;asm("v_sub_f32_e32 %0, %1, %2":"=v"(r):"v"(a),"v"(b));return r;}
typedef float f32x2_t __attribute__((ext_vector_type(2))); typedef __bf16 bf16x2_t __attribute__((ext_vector_type(2)));
__device__ __forceinline__ unsigned cvtpk_s(float lo,float hi){f32x2_t v={lo,hi};bf16x2_t b=__builtin_convertvector(v,bf16x2_t);return __builtin_bit_cast(unsigned,b);}
#define WAIT_BAR(N) asm volatile("s_waitcnt vmcnt(" #N ") lgkmcnt(0)\n\ts_barrier":::"memory")

__device__ __forceinline__ void qkt(f32x16&p0,f32x16&p1,const char*Kslot,const bf16x8*qr,const f32x16&negm,int r32,int hi){
  const char*kb=Kslot+hi*1024+r32*16;
  #pragma unroll
  for(int d0=0;d0<4;++d0){
    const bf16x8 b0=*reinterpret_cast<const bf16x8*>(kb+d0*2048);
    const bf16x8 b1=*reinterpret_cast<const bf16x8*>(kb+d0*2048+512);
    if(d0==0){p0=__builtin_amdgcn_mfma_f32_32x32x16_bf16(b0,qr[0],negm,0,0,0);p1=__builtin_amdgcn_mfma_f32_32x32x16_bf16(b1,qr[0],negm,0,0,0);}
    else{p0=__builtin_amdgcn_mfma_f32_32x32x16_bf16(b0,qr[d0],p0,0,0,0);p1=__builtin_amdgcn_mfma_f32_32x32x16_bf16(b1,qr[d0],p1,0,0,0);}}
}
typedef __attribute__((address_space(3))) const char* lds_cptr;
typedef short v4i16_t __attribute__((ext_vector_type(4)));
__device__ __forceinline__ void kload8(bf16x8*kf,lds_cptr kp){
  kf[0]=*(const __attribute__((address_space(3))) bf16x8*)(kp);      kf[1]=*(const __attribute__((address_space(3))) bf16x8*)(kp+512);
  kf[2]=*(const __attribute__((address_space(3))) bf16x8*)(kp+2048); kf[3]=*(const __attribute__((address_space(3))) bf16x8*)(kp+2560);
  kf[4]=*(const __attribute__((address_space(3))) bf16x8*)(kp+4096); kf[5]=*(const __attribute__((address_space(3))) bf16x8*)(kp+4608);
  kf[6]=*(const __attribute__((address_space(3))) bf16x8*)(kp+6144); kf[7]=*(const __attribute__((address_space(3))) bf16x8*)(kp+6656);
}
__device__ __forceinline__ void kload2(bf16x8*kf,lds_cptr kp,int j){ kf[2*j]=*(const __attribute__((address_space(3))) bf16x8*)(kp+j*2048); kf[2*j+1]=*(const __attribute__((address_space(3))) bf16x8*)(kp+j*2048+512); }
__device__ __forceinline__ s16x4 vtr(lds_cptr p){ return __builtin_bit_cast(s16x4,__builtin_amdgcn_ds_read_tr16_b64_v4i16((__attribute__((address_space(3))) v4i16_t*)p)); }
__device__ __forceinline__ float rowmax(const f32x16&p0,const f32x16&p1){
  float a=max3f(p0[0],p0[1],p1[0]),b=max3f(p0[2],p0[3],p1[1]);a=max3f(a,p1[2],p1[3]);
  #pragma unroll
  for(int r=4;r<16;r+=4){a=max3f(a,p0[r],p0[r+1]);b=max3f(b,p0[r+2],p0[r+3]);a=max3f(a,p1[r],p1[r+1]);b=max3f(b,p1[r+2],p1[r+3]);}
  const float m=max2f(a,b);
  auto rr=__builtin_amdgcn_permlane32_swap(__float_as_uint(m),__float_as_uint(m),false,false);
  return max2f(__uint_as_float(rr[0]),__uint_as_float(rr[1]));
}
__device__ __forceinline__ void pv(f32x16*o,int vb,bf16x8 pa0,bf16x8 pa1,bf16x8 pa2,bf16x8 pa3){
  #pragma unroll
  for(int d0=0;d0<2;++d0){s16x4 lo[4],hi[4];
    #pragma unroll
    for(int ks=0;ks<4;++ks){
      asm volatile("ds_read_b64_tr_b16 %0,%1 offset:%c2":"=&v"(lo[ks]):"v"(vb),"i"(d0*4096+ks*1024):"memory");
      asm volatile("ds_read_b64_tr_b16 %0,%1 offset:%c2":"=&v"(hi[ks]):"v"(vb),"i"(d0*4096+ks*1024+512):"memory");}
    asm volatile("s_waitcnt lgkmcnt(0)":::"memory");SBAR();
    #define PK(k) (bf16x8){lo[k][0],lo[k][1],lo[k][2],lo[k][3],hi[k][0],hi[k][1],hi[k][2],hi[k][3]}
    o[d0]=__builtin_amdgcn_mfma_f32_32x32x16_bf16(pa0,PK(0),o[d0],0,0,0);
    o[d0]=__builtin_amdgcn_mfma_f32_32x32x16_bf16(pa1,PK(1),o[d0],0,0,0);
    o[d0]=__builtin_amdgcn_mfma_f32_32x32x16_bf16(pa2,PK(2),o[d0],0,0,0);
    o[d0]=__builtin_amdgcn_mfma_f32_32x32x16_bf16(pa3,PK(3),o[d0],0,0,0);
    #undef PK
  }
}

#ifndef ATTN_STORE16
#define ATTN_STORE16(p,v) (*(u32x4*)(p)=(v))
#endif
template<int THRL> __device__ __forceinline__ void attn_unit(int b,int h,int qb,const bf16*Q,const bf16*__restrict__ K,const bf16*__restrict__ V,bf16*O,const float*__restrict__ CSg,const unsigned*KMg,char*shm,const int t0,const int ntl,const bool masked,float*__restrict__ Lout){
  int tid_o=threadIdx.x; asm volatile("":"+v"(tid_o)); const int tid=tid_o,lane=tid&63,r32=lane&31,hi=lane>>5; const int wid=__builtin_amdgcn_readfirstlane(tid>>6);
  const long rowbase=(long)b*SEQ; const int q0=qb*QB;
  const bf16*Qw=Q+(rowbase+q0+wid*QBLK)*DM+h*D;
  const bf16*Kh=K+(rowbase+(long)t0*KVBLK)*DM+h*D,*Vh=V+(rowbase+(long)t0*KVBLK)*DM+h*D;
  const unsigned lds0=(unsigned)(uintptr_t)shm;
  float*wsf=(float*)(shm+LDS_WS)+wid*64;
  const lds_cptr shm3=(lds_cptr)shm;
  const bf16*ksrc=Kh+(long)lane*DM+wid*8;
  const bf16*vsrc=Vh+(long)(16*(wid&3)+(lane>>2))*DM+(wid>>2)*32+(lane&3)*8;
  const unsigned kdst=lds0+LDS_K+wid*1024, vdst=lds0+LDS_V+wid*1024;
  #define DMA_K(t,slot) glds16(ksrc+(long)(t)*KVBLK*DM,(unsigned)__builtin_amdgcn_readfirstlane(kdst+(slot)))
  #define DMA_V(t,slot) glds16(vsrc+(long)(t)*KVBLK*DM,(unsigned)__builtin_amdgcn_readfirstlane(vdst+(slot)))
  const int vb0=(int)(lds0+LDS_V)+((lane>>4)&1)*32+(lane&3)*8+(4*hi+((lane&15)>>2))*64;
  const char*Kbase=shm+LDS_K; bf16x8 kf[8];
  const lds_cptr kp0=shm3+LDS_K+hi*1024+r32*16; const lds_cptr vp0=shm3+LDS_V+((lane>>4)&1)*32+(lane&3)*8+(4*hi+((lane&15)>>2))*64;
  const int NT=ntl;
  typedef __attribute__((address_space(3))) float* lds_fptr; typedef __attribute__((address_space(3))) f32x4_t* lds_f4ptr;
  const float*csh=CSg+(long)h*SEQ;
  { const lds_fptr ckw=(lds_fptr)(shm3+LDS_CK);
    for(int i=tid*4;i<ntl*KVBLK;i+=NW*64*4){ const f32x4_t v=*(const f32x4_t*)(csh+t0*KVBLK+i); *(lds_f4ptr)(ckw+i)=v; }
  }
  const float cq=csh[q0+wid*QBLK+r32];
  asm volatile("s_waitcnt vmcnt(0) lgkmcnt(0)\n\ts_barrier":::"memory");
  const lds_fptr ckt=(lds_fptr)(shm3+LDS_CK)+4*hi;
  #define CKSUB(P0,P1,t) do{ const lds_fptr ckp_=ckt+64*(t); _Pragma("unroll") for(int j_=0;j_<4;++j_){ const f32x4_t a_=*(const lds_f4ptr)(ckp_+8*j_); const f32x4_t b_=*(const lds_f4ptr)(ckp_+32+8*j_); \
      P0[4*j_]-=a_[0];P0[4*j_+1]-=a_[1];P0[4*j_+2]-=a_[2];P0[4*j_+3]-=a_[3]; P1[4*j_]-=b_[0];P1[4*j_+1]-=b_[1];P1[4*j_+2]-=b_[2];P1[4*j_+3]-=b_[3]; SBAR(); } }while(0)
  DMA_K(0,0);DMA_V(0,0);DMA_K(1,SLOTB);
  bf16x8 qr[4];
  #pragma unroll
  for(int d0=0;d0<4;++d0)qr[d0]=*reinterpret_cast<const bf16x8*>(&Qw[(long)r32*DM+d0*16+hi*8]);
  float l_reg=0.f;f32x16 o[2];o[0]=f32x16{};o[1]=f32x16{};f32x16 negm;
  {
    float q2=0.f;
    _Pragma("unroll") for(int d0=0;d0<4;++d0) _Pragma("unroll") for(int e=0;e<8;++e){ const float v=__uint_as_float(((unsigned)(unsigned short)qr[d0][e])<<16); q2+=v*v; }
    { auto rr=__builtin_amdgcn_permlane32_swap(__float_as_uint(q2),__float_as_uint(q2),false,false); q2=__uint_as_float(rr[0])+__uint_as_float(rr[1]); }
    const float km2=__uint_as_float(__hip_atomic_load(KMg+h,__ATOMIC_RELAXED,__HIP_MEMORY_SCOPE_AGENT));
    const float Rq=sqrtf(q2*km2)*1.001f+0.01f;
    _Pragma("unroll") for(int r=0;r<16;++r)negm[r]=cq-Rq; asm volatile("":"+v"(negm)); }
  const int qrel=wid*QBLK+r32;
  #define CMASK(P0,P1,t) do{int jb_=(t)-(NT-4); if(masked&&jb_>=0)cmask(P0,P1,jb_,qrel,hi);}while(0)
  #define START(P0,P1) do{ const float rm=rowmax(P0,P1); resc=false; \
    { const float dl=rm; mhat=fadd_s(mhat,dl); \
      _Pragma("unroll") for(int r=0;r<16;++r){P0[r]=fsub_s(P0[r],dl);P1[r]=fsub_s(P1[r],dl);} \
      _Pragma("unroll") for(int r=0;r<16;++r)negm[r]=-mhat; asm volatile("":"+v"(negm)); } \
    _Pragma("unroll") for(int r=0;r<16;++r)P0[r]=__builtin_amdgcn_exp2f(P0[r]); }while(0)
  #define RESC() do{ if(resc){ asm volatile("s_waitcnt lgkmcnt(0)":::"memory"); \
      _Pragma("unroll") for(int d_=0;d_<2;++d_) _Pragma("unroll") for(int r=0;r<16;++r)o[d_][r]*=wsf[crow(r,hi)]; } }while(0)
  f32x16 pA0,pA1,pB0,pB1;
  int sl_prev=0,sl_cur=0,sl_next=SLOTB;
  #define ROT() do{sl_prev=sl_cur;sl_cur=sl_next;sl_next=(sl_next==(NSLOT-1)*SLOTB)?0:sl_next+SLOTB;}while(0)
  DMA_K(2,2*SLOTB);
  WAIT_BAR(3);
  qkt(pA0,pA1,Kbase,qr,negm,r32,hi);asm volatile("s_nop 15\n\ts_nop 7":"+v"(pA0),"+v"(pA1));CKSUB(pA0,pA1,0);CMASK(pA0,pA1,0);
  _Pragma("unroll") for(int r=0;r<16;++r)pA0[r]=__builtin_amdgcn_exp2f(pA0[r]);
  _Pragma("unroll") for(int r=0;r<16;++r)pA1[r]=__builtin_amdgcn_exp2f(pA1[r]);
  WAIT_BAR(0);
  DMA_K(3,0);DMA_V(1,SLOTB);
  ROT();
  kload8(kf,kp0+sl_cur);
  WAIT_BAR(2);
  s16x4 vlo[8],vhi[8]; u32x4 pw0,pw1,pw2,pw3;
  #define PKW(P,B) cvtpk_s(P[B],P[B+1])
  #define PAF(k) __builtin_bit_cast(bf16x8,pw##k)
  #define VFR(i) (bf16x8){vlo[i][0],vlo[i][1],vlo[i][2],vlo[i][3],vhi[i][0],vhi[i][1],vhi[i][2],vhi[i][3]}
  #define PIN(x) asm volatile("":"+v"(x))
  #define MX3(a,b,c) __builtin_fmaxf(__builtin_fmaxf((a),(b)),(c))
  #define GAPA(MF,A0,A1,A2,A3,W0,W1,PW) do{ MF; sacc+=A0; sacc+=A1; sacc+=A2; sacc+=A3; PIN(sacc); W0; W1; PIN(PW); SBAR(); }while(0)
  #define EX(v) __builtin_amdgcn_exp2f(v)
  #define GAPB(MF,X,B,CUR,NXT,NOFF) do{ MF; if((NOFF)>=0){ NXT=*(const lds_f4ptr)(ckp_+((NOFF)>=0?(NOFF):0)); } X[B]=EX(X[B]-CUR[0]); X[B+1]=EX(X[B+1]-CUR[1]); X[B+2]=EX(X[B+2]-CUR[2]); X[B+3]=EX(X[B+3]-CUR[3]); PIN(X); SBAR(); }while(0)
  #define VRD(i) do{ vlo[i]=vtr(vp_+(((i)>>2)*4096+((i)&3)*1024)); vhi[i]=vtr(vp_+(((i)>>2)*4096+((i)&3)*1024+512)); }while(0)
  #define KRD(G,j) do{ if(G){ kload2(kf,kp0+sl_next,j); SBAR(); } }while(0)
  #define STEP(C0,C1,P0,P1,t,GK,GV,GL) do{ SBAR(); \
    const lds_cptr vp_=vp0+sl_prev; \
    VRD(0); SBAR(); float sacc=(P0[0]+P0[1]); \
    GAPA(C0=__builtin_amdgcn_mfma_f32_32x32x16_bf16(kf[0],qr[0],negm,0,0,0), P0[2],P0[3],P0[4],P0[5],     pw0[0]=PKW(P0,0), pw0[1]=PKW(P0,2), pw0); \
    VRD(4); SBAR(); GAPA(C1=__builtin_amdgcn_mfma_f32_32x32x16_bf16(kf[1],qr[0],negm,0,0,0), P0[6],P0[7],P0[8],P0[9],     pw0[2]=PKW(P0,4), pw0[3]=PKW(P0,6), pw0); \
    VRD(1); SBAR(); GAPA(C0=__builtin_amdgcn_mfma_f32_32x32x16_bf16(kf[2],qr[1],C0,0,0,0),   P0[10],P0[11],P0[12],P0[13], pw1[0]=PKW(P0,8), pw1[1]=PKW(P0,10), pw1); \
    VRD(5); SBAR(); GAPA(C1=__builtin_amdgcn_mfma_f32_32x32x16_bf16(kf[3],qr[1],C1,0,0,0),   P0[14],P0[15],P1[0],P1[1],   pw1[2]=PKW(P0,12),pw1[3]=PKW(P0,14), pw1); \
    VRD(2); SBAR(); GAPA(C0=__builtin_amdgcn_mfma_f32_32x32x16_bf16(kf[4],qr[2],C0,0,0,0),   P1[2],P1[3],P1[4],P1[5],     pw2[0]=PKW(P1,0), pw2[1]=PKW(P1,2), pw2); \
    VRD(6); SBAR(); GAPA(C1=__builtin_amdgcn_mfma_f32_32x32x16_bf16(kf[5],qr[2],C1,0,0,0),   P1[6],P1[7],P1[8],P1[9],     pw2[2]=PKW(P1,4), pw2[3]=PKW(P1,6), pw2); \
    VRD(3); SBAR(); GAPA(C0=__builtin_amdgcn_mfma_f32_32x32x16_bf16(kf[6],qr[3],C0,0,0,0),   P1[10],P1[11],P1[12],P1[13], pw3[0]=PKW(P1,8), pw3[1]=PKW(P1,10), pw3); \
    VRD(7); SBAR(); GAPA(C1=__builtin_amdgcn_mfma_f32_32x32x16_bf16(kf[7],qr[3],C1,0,0,0),   P1[14],P1[15],0.f,0.f,       pw3[2]=PKW(P1,12),pw3[3]=PKW(P1,14), pw3); \
    l_reg+=sacc; \
    if(GK){DMA_K((t)+3,sl_cur);} if(GV){DMA_V((t)+1,sl_next);} \
    CMASK(C0,C1,t); \
    const lds_fptr ckp_=ckt+64*(t); f32x4_t ckA_=*(const lds_f4ptr)(ckp_), ckB_; \
    SBAR(); \
    GAPB(o[0]=__builtin_amdgcn_mfma_f32_32x32x16_bf16(PAF(0),VFR(0),o[0],0,0,0), C0,0,ckA_,ckB_,8); \
    GAPB(o[1]=__builtin_amdgcn_mfma_f32_32x32x16_bf16(PAF(0),VFR(4),o[1],0,0,0), C0,4,ckB_,ckA_,16); \
    KRD(GL,0); GAPB(o[0]=__builtin_amdgcn_mfma_f32_32x32x16_bf16(PAF(1),VFR(1),o[0],0,0,0), C0,8,ckA_,ckB_,24); \
    KRD(GL,1); GAPB(o[1]=__builtin_amdgcn_mfma_f32_32x32x16_bf16(PAF(1),VFR(5),o[1],0,0,0), C0,12,ckB_,ckA_,32); \
    KRD(GL,2); GAPB(o[0]=__builtin_amdgcn_mfma_f32_32x32x16_bf16(PAF(2),VFR(2),o[0],0,0,0), C1,0,ckA_,ckB_,40); \
    KRD(GL,3); GAPB(o[1]=__builtin_amdgcn_mfma_f32_32x32x16_bf16(PAF(2),VFR(6),o[1],0,0,0), C1,4,ckB_,ckA_,48); \
    GAPB(o[0]=__builtin_amdgcn_mfma_f32_32x32x16_bf16(PAF(3),VFR(3),o[0],0,0,0), C1,8,ckA_,ckB_,56); \
    GAPB(o[1]=__builtin_amdgcn_mfma_f32_32x32x16_bf16(PAF(3),VFR(7),o[1],0,0,0), C1,12,ckB_,ckA_,-1); \
    }while(0)
  int t=1;
  #undef CMASK
  #define CMASK(P0,P1,t) do{}while(0)
  for(;t+5<NT;t+=2){
    STEP(pB0,pB1,pA0,pA1,t,true,true,true);     WAIT_BAR(2); ROT();
    STEP(pA0,pA1,pB0,pB1,t+1,true,true,true);   WAIT_BAR(2); ROT();
  }
  #undef CMASK
  #define CMASK(P0,P1,t) do{int jb_=(t)-(NT-4); if(masked&&jb_>=0)cmask(P0,P1,jb_,qrel,hi);}while(0)
  #define ENDW(tt) do{ if((tt)+3<NT){WAIT_BAR(2);} else if((tt)+2<NT){WAIT_BAR(1);} else {WAIT_BAR(0);} }while(0)
  for(;t+1<NT;t+=2){
    STEP(pB0,pB1,pA0,pA1,t,(t+3<NT),(t+1<NT),(t+1<NT));       ENDW(t); ROT();
    STEP(pA0,pA1,pB0,pB1,t+1,(t+4<NT),(t+2<NT),(t+2<NT));     ENDW(t+1); ROT();
  }
  STEP(pB0,pB1,pA0,pA1,NT-1,false,false,false);
  { float sacc=pB0[0]+pB0[1]; _Pragma("unroll") for(int r=2;r<16;++r)sacc+=pB0[r]; _Pragma("unroll") for(int r=0;r<16;++r)sacc+=pB1[r]; l_reg+=sacc;
    pw0=(u32x4){PKW(pB0,0),PKW(pB0,2),PKW(pB0,4),PKW(pB0,6)};pw1=(u32x4){PKW(pB0,8),PKW(pB0,10),PKW(pB0,12),PKW(pB0,14)};pw2=(u32x4){PKW(pB1,0),PKW(pB1,2),PKW(pB1,4),PKW(pB1,6)};pw3=(u32x4){PKW(pB1,8),PKW(pB1,10),PKW(pB1,12),PKW(pB1,14)};
    SBAR(); pv(o,vb0+sl_cur,PAF(0),PAF(1),PAF(2),PAF(3)); }
  #undef PKW
  #undef PAF
  #undef VFR
  #undef PIN
  #undef MX3
  #undef GAPA
  #undef GAPB
  #undef EX
  #undef VRD
  #undef KRD
  #undef STEP
  #undef ENDW
  {auto rr=__builtin_amdgcn_permlane32_swap(__float_as_uint(l_reg),__float_as_uint(l_reg),false,false);l_reg=__uint_as_float(rr[0])+__uint_as_float(rr[1]);}
  if(hi==0){wsf[32+r32]=l_reg; Lout[(long)(q0+wid*QBLK+r32)*NHEAD+h]=l_reg;}asm volatile("s_waitcnt lgkmcnt(0)":::"memory");
  float rli[16];
  #pragma unroll
  for(int r=0;r<16;++r){const float lv_=wsf[32+crow(r,hi)]; rli[r]=lv_>1e-30f?__builtin_amdgcn_rcpf(lv_):0.f;}
  bf16*Ow=O+(rowbase+q0+wid*QBLK)*DM+h*D;
  { bf16*stg=(bf16*)(shm+LDS_OST)+wid*2048;
    #pragma unroll
    for(int r=0;r<16;++r){const int orow=crow(r,hi);
      #pragma unroll
      for(int d0=0;d0<2;++d0)stg[orow*64+d0*32+r32]=__float2bfloat16(o[d0][r]*rli[r]);}
    asm volatile("s_waitcnt lgkmcnt(0)":::"memory");
    #pragma unroll
    for(int i=0;i<4;++i){const int row=i*8+(lane>>3),ch=lane&7; const u32x4 v=*(const u32x4*)(stg+row*64+ch*8); ATTN_STORE16(Ow+(long)row*DM+ch*8,v);} }
  asm volatile("s_waitcnt lgkmcnt(0)\n\ts_barrier":::"memory");
  #undef CKSUB
  #undef DMA_K
  #undef DMA_V
  #undef CMASK
  #undef START
  #undef RESC
  #undef ROT
}
constexpr int ATTN_LDS_BYTES=LDS_BYTES;
struct AttnTensors { const bf16* Q; const bf16* K; const bf16* V; bf16* O; const float* CS; const unsigned* KM; };
struct AttnUnit { int bh; int qb; };
struct StaticOrder {
  int vcu,G;
  __device__ __forceinline__ explicit StaticOrder(int grid,int block):vcu((grid%8==0)?(block%8)*(grid/8)+block/8:block),G(grid){}
  __device__ __forceinline__ bool next(int i,AttnUnit&u)const{
    if(G==256){ if(i>=2)return false; const int s=vcu&31; u.bh=vcu>>5; u.qb=(i==0)?s:63-s; return true; }
    const int Lx=i*G+vcu; if(Lx>=NHEAD*NQB)return false; u.bh=Lx/NQB; u.qb=NQB-1-(Lx%NQB); return true; }
  __device__ __forceinline__ void a_ready(const AttnUnit&)const{}
  __device__ __forceinline__ void done(const AttnUnit&)const{}
};
template<class Sched,int THRL=8> __device__ __forceinline__ void attn_phase(char*lds,const AttnTensors&T,const Sched&S){
  AttnUnit u;
  for(int i=0;S.next(i,u);++i){ S.a_ready(u); attn_unit<THRL>(0,u.bh,u.qb,T.Q,T.K,T.V,T.O,T.CS,T.KM,lds,0,4*(u.qb+1),true,(float*)nullptr); S.done(u); }
}
#undef SBAR
#undef WAIT_BAR
}
#define LAS __attribute__((address_space(3)))
typedef unsigned short bf16;
typedef unsigned v4u __attribute__((ext_vector_type(4)));
typedef unsigned v2u __attribute__((ext_vector_type(2)));
typedef float f32x4 __attribute__((ext_vector_type(4)));
typedef short bf16x8 __attribute__((ext_vector_type(8)));
constexpr int NWAVES = 8, NTHREADS = 512;
constexpr int M = 16384, D = 1024, FF = 2816, MEML = 256, DIN = 7176, NLAYER = 2;
constexpr float EPS = 1e-6f, LOG2E = 1.4426950408889634f;
constexpr int LDS_BYTES = 155648, XB_LDS_OFF = LDS_BYTES - 256, T0_LDS_OFF = 149504;
static_assert(attn_body::ATTN_LDS_BYTES <= LDS_BYTES, "lds");
constexpr size_t MiB = 1u << 20;
constexpr size_t WS_SS = 1 * MiB, WS_SSV = 2 * MiB, WS_LF = 2 * MiB + 512 * 1024, WS_CS = 3 * MiB, WS_RSM = 3 * MiB + 512 * 1024, WS_MEMB = 4 * MiB, WS_KC = 4 * MiB + 512 * 1024, WS_VCT = 5 * MiB;
constexpr size_t WS_LPL = 5 * MiB + 512 * 1024, WS_LP = 66 * MiB + 256 * 1024;
constexpr size_t WS_W = 6 * MiB, WS_XB = 68 * MiB, WS_SCR = 100 * MiB, WS_END = 244 * MiB;
constexpr size_t WO_GU1 = 0, WO_D1 = WO_GU1 + (size_t)5632 * 1024, WO_IN = WO_D1 + (size_t)1024 * 2816, WO_G = WO_IN + (size_t)4096 * 1024, WO_B = WO_G + (size_t)3072 * 1024,
                 WO_O = WO_B + (size_t)3 * 1024 * 512, WO_Q = WO_O + (size_t)1024 * 1024, WO_K = WO_Q + (size_t)1024 * 1024, WO_V = WO_K + (size_t)1024 * 1024, WO_XO = WO_V + (size_t)1024 * 1024,
                 WO_GU2 = WO_XO + (size_t)1024 * 1024, WO_D2 = WO_GU2 + (size_t)5632 * 1024, WO_END = WO_D2 + (size_t)1024 * 2816;
static_assert(WS_W + (WO_END + 16 * 1024) * 2 <= WS_LP && WS_LP + 3 * 512 * 1024 <= WS_XB, "weights fit");
constexpr size_t PIECE = (size_t)M * 512;

typedef __attribute__((address_space(1))) unsigned gu32;
#define RLX_AGENT __ATOMIC_RELAXED, __HIP_MEMORY_SCOPE_AGENT
#define XB_TMO      128
#define XB_XCNT(j)  (256  + 64 * (j))
#define XB_XSUB(j)  (1280 + 64 * (j))
#define XB_XGEN(j)  (2304 + 64 * (j))
#define XB_TOP      3328
#define XB_TOPGEN   3392
#define XCD_BAR_WORDS 3456
#define XB_SPIN_CAP (1u << 18)

__device__ __forceinline__ unsigned xb_ld(unsigned* p)              { return __hip_atomic_load(p, __ATOMIC_RELAXED, __HIP_MEMORY_SCOPE_AGENT); }
__device__ __forceinline__ unsigned xb_add(unsigned* p, unsigned v) { return __hip_atomic_fetch_add(p, v, __ATOMIC_RELAXED, __HIP_MEMORY_SCOPE_AGENT); }
__device__ __forceinline__ unsigned xb_xcc_id() { return (unsigned)__builtin_amdgcn_s_getreg((3 << 11) | 20) & 0xFu; }
#define XB_SPIN(cond, bar) do { unsigned _sp = 0; while (cond) { __builtin_amdgcn_s_sleep(1); \
    if ((++_sp & 255u) == 0u) { if (xb_ld(&(bar)[XB_TMO])) break; if (_sp > XB_SPIN_CAP) { atomicAdd(&(bar)[XB_TMO], 1u); break; } } } } while (0)

struct XcdBarrier {
    unsigned* bar; unsigned x;
    volatile LAS unsigned* st;
};

__device__ __forceinline__ XcdBarrier xcd_barrier_post(unsigned* bar, volatile LAS unsigned* st) {
    XcdBarrier b; b.bar = bar; b.x = xb_xcc_id(); b.st = st;
    if (threadIdx.x == 0) (void)xb_add(&bar[XB_XCNT(b.x)], 1u);
    return b;
}
__device__ __forceinline__ void xcd_barrier_complete(unsigned* bar, unsigned x, unsigned& nloc, unsigned& nx) {
    const unsigned G = gridDim.x * gridDim.y * gridDim.z;
    unsigned sum, cnt, mine, sp = 0u;
    for (;;) {
        sum = 0u; cnt = 0u; mine = 0u;
#pragma unroll
        for (unsigned j = 0; j < 16; ++j) { const unsigned c = xb_ld(&bar[XB_XCNT(j)]); sum += c; cnt += (c > 0u) ? 1u : 0u; mine = (j == x) ? c : mine; }
        if (sum == G) break;
        __builtin_amdgcn_s_sleep(1);
        if ((++sp & 255u) == 0u) { if (xb_ld(&bar[XB_TMO])) break; if (sp > XB_SPIN_CAP) { atomicAdd(&bar[XB_TMO], 1u); break; } }
    }
    nloc = mine > 0u ? mine : 1u; nx = cnt > 0u ? cnt : 1u;
}

__device__ __forceinline__ void xcd_barrier(const XcdBarrier& b) {
    asm volatile("s_waitcnt vmcnt(0)" ::: "memory");
    __syncthreads();
    if (threadIdx.x == 0) {
        unsigned* bar = b.bar;
        __builtin_amdgcn_s_waitcnt(0);
        unsigned nloc = b.st[0], nx = b.st[1];
        if (nloc == 0u) { xcd_barrier_complete(bar, b.x, nloc, nx); b.st[0] = nloc; b.st[1] = nx; }
        const unsigned old = xb_add(&bar[XB_XSUB(b.x)], 1u);
        const unsigned gen = old / nloc;
        if (old + 1u == (gen + 1u) * nloc) {
            __builtin_amdgcn_fence(__ATOMIC_RELEASE, "agent");
            asm volatile("s_waitcnt vmcnt(0)" ::: "memory");
            const unsigned og = xb_add(&bar[XB_TOP], 1u);
            const unsigned tg = og / nx;
            if (og + 1u == (tg + 1u) * nx) xb_add(&bar[XB_TOPGEN], 1u);
            else XB_SPIN(xb_ld(&bar[XB_TOPGEN]) == tg, bar);
            __builtin_amdgcn_fence(__ATOMIC_ACQUIRE, "agent");
            xb_add(&bar[XB_XGEN(b.x)], 1u);
            asm volatile("s_waitcnt vmcnt(0)" ::: "memory");
        } else {
            XB_SPIN(xb_ld(&bar[XB_XGEN(b.x)]) == gen, bar);
            __builtin_amdgcn_fence(__ATOMIC_ACQUIRE, "agent");
            asm volatile("s_waitcnt vmcnt(0)" ::: "memory");
        }
    }
    __syncthreads();
}
struct Args { const float* in[26]; float* out; unsigned char* ws; int ph_lo, ph_hi; };

__device__ __forceinline__ unsigned f2bf(float f) { unsigned u = __builtin_bit_cast(unsigned, f); return (u + 0x7fffu + ((u >> 16) & 1u)) >> 16; }
__device__ __forceinline__ unsigned pk2(float lo, float hi) { return f2bf(lo) | (f2bf(hi) << 16); }
__device__ __forceinline__ float b2f(unsigned short b) { return __uint_as_float((unsigned)b << 16); }
__device__ __forceinline__ float wave_sum(float v) {
#pragma unroll
    for (int o = 1; o < 64; o <<= 1) v += __shfl_xor(v, o);
    return v;
}
#define LDS_WAIT() asm volatile("s_waitcnt lgkmcnt(0)" ::: "memory")
__device__ __forceinline__ void conv_item(const float* W, int spitch, int k0, int n0, bf16* WT, int dpitch, int drow0, const float* gain, LAS float* scr, int lane) {
#pragma unroll
    for (int i = 0; i < 32; ++i) { const int kk = 2 * i + (lane >> 5); float v = W[(size_t)(k0 + kk) * spitch + n0 + (lane & 31)]; if (gain) v *= gain[k0 + kk]; scr[kk * 33 + (lane & 31)] = v; }
    LDS_WAIT(); asm volatile("" ::: "memory");
    const int c = lane & 7;
#pragma unroll
    for (int j = 0; j < 4; ++j) { const int n = (lane >> 3) + 8 * j; const LAS float* s = scr + (8 * c) * 33 + n;
        v4u o; o.x = pk2(s[0 * 33], s[1 * 33]); o.y = pk2(s[2 * 33], s[3 * 33]); o.z = pk2(s[4 * 33], s[5 * 33]); o.w = pk2(s[6 * 33], s[7 * 33]);
        *(v4u*)(WT + (size_t)(drow0 + n) * dpitch + k0 + 8 * c) = o; }
    LDS_WAIT(); asm volatile("" ::: "memory");
}
__device__ __forceinline__ void conv_job(int& it, int& base, int NGW, const float* W, int spitch, int K, int scol0, int ncols, bf16* WT, int doff, bool ilv, const float* gain, LAS float* scr, int lane) {
    const int nblk = ncols / 32, nitems = (K / 64) * nblk;
    for (; it < base + nitems; it += NGW) { const int r = it - base, kb = r / nblk, nb = r % nblk, nl = 32 * nb;
        const int drow0 = ilv ? (256 * (nl / 128) + (nl % 128) + doff) : (doff + nl);
        conv_item(W, spitch, 64 * kb, scol0 + nl, WT, K, drow0, gain, scr, lane); }
    base += nitems;
}

__device__ __forceinline__ int attn_skip_tiles(const float* csh, int qb, float R) {
    const int ntf = 4 * (qb + 1); const float thr = csh[256 * qb] + 152.0f + 2.0f * R;
    int lo_ = 0, hi_ = ntf - 4;
    while (lo_ < hi_) { const int mid = (lo_ + hi_) >> 1; if (csh[64 * mid + 63] > thr) lo_ = mid + 1; else hi_ = mid; }
    return lo_ & ~1;
}
__device__ __forceinline__ int attn_chunks(int len) { int n = (len + 63) >> 6; if (n > 1 && len - 64 * (n - 1) < 4) --n; return n; }
__global__ void __launch_bounds__(NTHREADS, 2) mk_fwd(Args args) {
    __builtin_assume(__builtin_amdgcn_workitem_id_y() == 0); __builtin_assume(__builtin_amdgcn_workitem_id_z() == 0);
    extern __shared__ __attribute__((aligned(16))) unsigned char lds[];
    cg::grid_group grid = cg::this_grid();
    LAS unsigned char* ldsp = (LAS unsigned char*)lds;
    if (threadIdx.x < 2) ((volatile LAS unsigned*)(ldsp + XB_LDS_OFF))[threadIdx.x] = 0u;
    __syncthreads();
    const XcdBarrier xbar = xcd_barrier_post((unsigned*)args.ws, (volatile LAS unsigned*)(ldsp + XB_LDS_OFF));
    const int G = gridDim.x, bx = blockIdx.x;
    const int vcu = (G % 8 == 0) ? (bx % 8) * (G / 8) + bx / 8 : bx;
    const int NGW = G * NWAVES;
#define TIDS() int tid_o = threadIdx.x; asm volatile("" : "+v"(tid_o)); const int tid = tid_o, lane = tid & 63, wave = __builtin_amdgcn_readfirstlane(tid >> 6), gw = vcu * NWAVES + wave; (void)gw; (void)lane; (void)tid
#define KARGS() const __attribute__((address_space(4))) Args* ap_ = (const __attribute__((address_space(4))) Args*)__builtin_amdgcn_kernarg_segment_ptr(); asm volatile("" : "+s"(ap_))
#define ws (ap_->ws)
#define X (ap_->out)
#define SS ((float*)(ws + WS_SS))
#define SSV ((float*)(ws + WS_SSV))
#define LF ((float*)(ws + WS_LF))
#define CS ((float*)(ws + WS_CS))
#define RSM ((float*)(ws + WS_RSM))
#define MEMB ((bf16*)(ws + WS_MEMB))
#define KC ((bf16*)(ws + WS_KC))
#define VCT ((bf16*)(ws + WS_VCT))
#define Wt ((bf16*)(ws + WS_W))
#define XB ((bf16*)(ws + WS_XB))
#define SCR ((bf16*)(ws + WS_SCR))
#define ACT SCR
#define PROJ SCR
#define GT (SCR + 3 * PIECE)
#define XQ SCR
#define PB (SCR + (size_t)M * 1024)
#define OB (SCR + (size_t)2 * M * 1024)
    const int lo = args.ph_lo, hi = args.ph_hi;
#ifndef PHMASK
#define PHMASK 0xffff
#endif
#define IN(k) (((PHMASK >> (((k) == 30) ? 15 : ((k) - pb == 13 || (k) - pb == 14) ? (k) - pb - 12 : (k) - pb)) & 1) && lo <= (k) && (k) < hi)
#define GRID_SYNC() do { asm volatile("s_waitcnt vmcnt(0) lgkmcnt(0)" ::: "memory"); grid.sync(); } while (0)
#define WG_SEAM() do { asm volatile("s_waitcnt vmcnt(0) lgkmcnt(0)" ::: "memory"); __syncthreads(); } while (0)
#define SEAM_LOCAL(k) do { if (lo <= (k) && (k) + 1 < hi) { if (G == 256) WG_SEAM(); else xcd_barrier(xbar); } } while (0)
#define SEAM(k) do { if (lo <= (k) && (k) + 1 < hi) { if ((k) == 0) GRID_SYNC(); else xcd_barrier(xbar); } } while (0)
#define in (ap_->in)
int pb = 0;
#pragma nounroll
    for (int l = 0; l < NLAYER; ++l) {
        pb = 15 * l;
        if (IN(pb + 0)) { KARGS(); TIDS();
#ifndef MK_REP_P0
#define MK_REP_P0 1
#endif
_Pragma("nounroll")
          for (int rep0 = 0; rep0 < MK_REP_P0; ++rep0) {
            const size_t l1 = (size_t)l * 1024, lff = (size_t)l * 1024 * 2816, ldd = (size_t)l * 1024 * 1024;
            constexpr int I_UP = 16 * 11, I_DN = 44 * 4, I_IN = 16 * 16, I_G = 16 * 12, I_B = 8 * 4, I_SQ = 16 * 4;
            constexpr int NIT = 4 * I_UP + 2 * I_DN + I_IN + I_G + 3 * I_B + 5 * I_SQ;
            LAS float* Tl = (LAS float*)ldsp;
#pragma nounroll
            for (int it = vcu; it < NIT; it += G) {
                int r = it; const float* W; const float* gain = nullptr; bf16* WT; int spitch, K, scol0 = 0, nblk, doff = 0; bool ilv = false;
                if (r < 2 * I_UP) { const int w = r / I_UP; r -= w * I_UP; W = in[3 + w] + lff; gain = in[2] + l1; WT = Wt + WO_GU1; spitch = FF; K = 1024; nblk = 11; doff = 128 * w; ilv = true; }
                else if ((r -= 2 * I_UP) < I_DN) { W = in[5] + lff; WT = Wt + WO_D1; spitch = 1024; K = FF; nblk = 4; }
                else if ((r -= I_DN) < I_IN) { W = in[7] + (size_t)l * 1024 * DIN; gain = in[6] + l1; WT = Wt + WO_IN; spitch = DIN; K = 1024; nblk = 16; }
                else if ((r -= I_IN) < I_G) { W = in[7] + (size_t)l * 1024 * DIN; gain = in[6] + l1; WT = Wt + WO_G; spitch = DIN; K = 1024; nblk = 12; scol0 = 4104; }
                else if ((r -= I_G) < 3 * I_B) { const int w = r / I_B; r -= w * I_B; W = in[13] + ((size_t)l * 3 + w) * 512 * 1024; WT = Wt + WO_B + (size_t)w * 1024 * 512; spitch = 1024; K = 512; nblk = 4; }
                else if ((r -= 3 * I_B) < I_SQ) { W = in[14] + ldd; WT = Wt + WO_O; spitch = 1024; K = 1024; nblk = 4; }
                else if ((r -= I_SQ) < I_SQ) { W = in[17] + ldd; gain = in[15] + l1; WT = Wt + WO_Q; spitch = 1024; K = 1024; nblk = 4; }
                else if ((r -= I_SQ) < 2 * I_SQ) { const int w = r / I_SQ; r -= w * I_SQ; W = in[18 + w] + ldd; gain = in[16] + l1; WT = Wt + WO_K + (size_t)w * 1024 * 1024; spitch = 1024; K = 1024; nblk = 4; }
                else if ((r -= 2 * I_SQ) < I_SQ) { W = in[20] + ldd; WT = Wt + WO_XO; spitch = 1024; K = 1024; nblk = 4; }
                else if ((r -= I_SQ) < 2 * I_UP) { const int w = r / I_UP; r -= w * I_UP; W = in[22 + w] + lff; gain = in[21] + l1; WT = Wt + WO_GU2; spitch = FF; K = 1024; nblk = 11; doff = 128 * w; ilv = true; }
                else { r -= 2 * I_UP; W = in[24] + lff; WT = Wt + WO_D2; spitch = 1024; K = FF; nblk = 4; }
                const int k0 = 64 * (r / nblk), nl0 = 256 * (r % nblk);
                {
                    f32x4 v[8];
#pragma unroll
                    for (int i = 0; i < 8; ++i) v[i] = *(const f32x4*)(W + (size_t)(k0 + 8 * wave + i) * spitch + scol0 + nl0 + 4 * lane);
#pragma unroll
                    for (int i = 0; i < 8; ++i) { const float gk = gain ? gain[k0 + 8 * wave + i] : 1.0f; *(LAS f32x4*)(Tl + (8 * wave + i) * 260 + 4 * lane) = v[i] * gk; }
                }
                __syncthreads();
                {
                    const int n = tid & 255, kh = tid >> 8, nl = nl0 + n;
                    const int drow = ilv ? (256 * (nl / 128) + (nl % 128) + doff) : (doff + nl);
                    v4u o[4];
#pragma unroll
                    for (int q = 0; q < 4; ++q)
#pragma unroll
                        for (int e = 0; e < 4; ++e) o[q][e] = pk2(Tl[(32 * kh + 8 * q + 2 * e) * 260 + n], Tl[(32 * kh + 8 * q + 2 * e + 1) * 260 + n]);
#pragma unroll
                    for (int q = 0; q < 4; ++q) *(v4u*)(WT + (size_t)drow * K + k0 + 32 * kh + 8 * q) = o[q];
                }
                __syncthreads();
            }
            {
                const float* wf = in[7] + (size_t)l * 1024 * DIN + 4096; const float* gn = in[6] + l1; bf16* WF = Wt + WO_END;
                for (int idx = vcu * NTHREADS + tid; idx < 8192; idx += G * NTHREADS) { const int k = idx >> 3, hd = idx & 7;
                    const float v = wf[(size_t)k * DIN + hd] * gn[k]; const unsigned hb = f2bf(v); const float lo = v - __uint_as_float(hb << 16);
                    WF[(size_t)hd * 1024 + k] = (bf16)hb; WF[(size_t)(8 + hd) * 1024 + k] = (bf16)f2bf(lo); }
            }
            if (l == 0) {
                for (int m = gw; m < M + MEML; m += NGW) {
                    const bool ism = m >= M; const int r = ism ? m - M : m;
                    const f32x4* xr = (const f32x4*)((ism ? in[1] : in[0]) + (size_t)r * D) + lane;
                    f32x4 v[4]; float s = 0.f;
#pragma unroll
                    for (int j = 0; j < 4; ++j) { v[j] = xr[64 * j]; s += (v[j][0] * v[j][0] + v[j][1] * v[j][1]) + (v[j][2] * v[j][2] + v[j][3] * v[j][3]); }
                    s = wave_sum(s);
                    v2u* ob = (v2u*)((ism ? MEMB : XB) + (size_t)r * D) + lane;
#pragma unroll
                    for (int j = 0; j < 4; ++j) { v2u w; w.x = pk2(v[j][0], v[j][1]); w.y = pk2(v[j][2], v[j][3]); ob[64 * j] = w; }
                    if (!ism) {
                        if (lane < 16) SS[(size_t)r * 16 + lane] = lane == 0 ? s : 0.f;
                    } else if (lane == 0) RSM[r] = rsqrtf(s * (1.0f / D) + EPS);
                }
            }
          }
        }
        SEAM(pb + 0);
#pragma nounroll
        for (int f = 0; f < 2; ++f) {
            const int pu = pb + (f == 0 ? 1 : 13), pd = pu + 1;
            if (IN(pu)) { KARGS();
                { pg8::Gemm g{XB, Wt + (f == 0 ? WO_GU1 : WO_GU2), 1024, 1024, 1024, 0, 0}; pg8::StaticOrder S; S.init(M / 256, 22, G, bx);
                  pg8::EpiSwiGLU E{SS, ACT};
#ifndef MK_REP_UP
#define MK_REP_UP 1
#endif
_Pragma("nounroll")
                  for (int rep = 0; rep < MK_REP_UP; ++rep) pg8::gemm_phase<pg8::EpiSwiGLU, pg8::StaticOrder, true, true>(ldsp, g, S, E); }
                if (f == 0) {
                    { pg8::Gemm g{MEMB, Wt + WO_K, 1024, 1024, 1024, 0, 0}; pg8::StaticOrder S; S.init(1, 4, G, (bx + G - 128 % G) % G);
                      pg8::EpiScale<2> E{RSM, KC, 1024, 1.0f}; pg8::gemm_phase<pg8::EpiScale<2>, pg8::StaticOrder, true, true>(ldsp, g, S, E); }
                    { pg8::Gemm g{Wt + WO_V, MEMB, 1024, 1024, 1024, 0, 0}; pg8::StaticOrder S; S.init(4, 1, G, (bx + G - 132 % G) % G);
                      pg8::EpiScale<3> E{RSM, VCT, 256, 1.0f}; pg8::gemm_phase<pg8::EpiScale<3>, pg8::StaticOrder, true, true>(ldsp, g, S, E); }
                }
            }
            SEAM(pu);
            if (IN(pd)) { KARGS();
                pg8::Gemm g{ACT, Wt + (f == 0 ? WO_D1 : WO_D2), FF, FF, FF, 0, 0}; pg8::StaticOrder S; S.init(M / 256, 4, G, bx);
                pg8::EpiResid E{XB, SS, 0.5f}; pg8::gemm_phase<pg8::EpiResid, pg8::StaticOrder, true, true>(ldsp, g, S, E);
            }
            SEAM(pd);
            if (f == 1) break;
            if (IN(pb + 3)) { KARGS();
                { TIDS();
                    const float* bfp = in[12] + l * 8; const bf16* WF = Wt + WO_END; const int fr = lane & 15, fq = lane >> 4;
                    if ((wave & 1) == 0) for (int tile = vcu * 4 + (wave >> 1); tile < M / 16; tile += G * 4) {
                        const int row = 16 * tile + fr;
                        const bf16* ap = XB + (size_t)row * D + 8 * fq; const bf16* bp = WF + (size_t)fr * D + 8 * fq;
                        f32x4 acc = {0.f, 0.f, 0.f, 0.f};
#pragma unroll 8
                        for (int ks = 0; ks < 32; ++ks) { const bf16x8 a = *(const bf16x8*)(ap + 32 * ks), b = *(const bf16x8*)(bp + 32 * ks); acc = __builtin_amdgcn_mfma_f32_16x16x32_bf16(b, a, acc, 0, 0, 0); }
                        const float rs = pg8::row_rstd1(SS, row, fq);
#pragma unroll
                        for (int j = 0; j < 4; ++j) { const float t = acc[j] + __shfl_xor(acc[j], 32);
                            if (fq < 2) { const int hd = 4 * fq + j; const float z = t * rs + bfp[hd]; LF[(size_t)hd * M + row] = fminf(z, 0.f) - log1pf(expf(-fabsf(z))); } }
                    }
                }
                pg8::Gemm g{XB, Wt + WO_IN, 1024, 1024, 1024, 0, 0}; pg8::StaticOrder S; S.init(M / 256, 16, G, bx);
                pg8::EpiWin E{SS, PROJ, SSV, 0.125f * LOG2E}; pg8::gemm_phase<pg8::EpiWin, pg8::StaticOrder, true, true>(ldsp, g, S, E);
            }
            SEAM(pb + 3);
            if (IN(pb + 4)) { KARGS(); TIDS();
                if (bx < 8) {
                    const float* lf = LF + (size_t)bx * M + tid * 32; float* cs = CS + (size_t)bx * M + tid * 32;
                    f32x4 v[8]; float run = 0.f;
#pragma unroll
                    for (int i = 0; i < 8; ++i) { v[i] = *(const f32x4*)(lf + 4 * i);
#pragma unroll
                        for (int e = 0; e < 4; ++e) { run += v[i][e]; v[i][e] = run; } }
                    const double tot = (double)run; double incl = tot;
#pragma unroll
                    for (int o = 1; o < 64; o <<= 1) { const double t = __shfl_up(incl, o); if (lane >= o) incl += t; }
                    LAS double* wsum = (LAS double*)ldsp;
                    if (lane == 63) wsum[wave] = incl;
                    __syncthreads();
                    double bsum = 0.0;
                    for (int w = 0; w < wave; ++w) bsum += wsum[w];
                    const double excl = bsum + incl - tot;
#pragma unroll
                    for (int i = 0; i < 8; ++i) { f32x4 o;
#pragma unroll
                        for (int e = 0; e < 4; ++e) o[e] = (float)((excl + (double)v[i][e]) * 1.4426950408889634);
                        *(f32x4*)(cs + 4 * i) = o; }
                    __syncthreads();
                }
                {
                    unsigned* KM = (unsigned*)(ws + 32768) + 8 * l; unsigned* lmx = (unsigned*)(lds + XB_LDS_OFF + 128);
                    if (tid < 16) lmx[tid] = 0u;
                    __syncthreads();
                    for (int idx = vcu * NTHREADS + tid; idx < 2 * M * 8; idx += G * NTHREADS) {
                        const int isq = idx >= M * 8, id2 = idx - isq * M * 8; const bf16* Kp = PROJ + (isq ? 8 : 6) * PIECE;
                        const v4u* kp = (const v4u*)(Kp + (size_t)(id2 >> 3) * 512 + (id2 & 7) * 64); float s = 0.f;
#pragma unroll
                        for (int q = 0; q < 8; ++q) { const v4u w = kp[q];
#pragma unroll
                            for (int e = 0; e < 4; ++e) { const float a = pg8::bflo(w[e]), b = pg8::bfhi(w[e]); s += a * a + b * b; } }
                        s = fmaxf(s, __shfl_xor(s, 8)); s = fmaxf(s, __shfl_xor(s, 16)); s = fmaxf(s, __shfl_xor(s, 32));
                        if (lane < 8) atomicMax(lmx + 8 * isq + lane, __float_as_uint(s));
                    }
                    __syncthreads();
                    if (tid < 16) atomicMax(KM + 64 * (tid >> 3) + (tid & 7), lmx[tid]);
                }
                {
                    bf16* AB = PROJ; const bf16* AC = PROJ + 3 * PIECE; const bf16* AH = PROJ + 4 * PIECE; const float* cw = in[8] + (size_t)l * 3 * 512;
                    for (int idx = vcu * NTHREADS + tid; idx < M * 64; idx += G * NTHREADS) {
                        const int t = idx >> 6, c8 = (idx & 63) * 8; const size_t off = (size_t)t * 512 + c8;
                        const v4u bw = *(const v4u*)(AB + off);
                        float zz[3][8];
#pragma unroll
                        for (int d = 0; d < 3; ++d) {
                            if (t - d >= 0) { const v4u cv = *(const v4u*)(AC + off - (size_t)d * 512), hv = *(const v4u*)(AH + off - (size_t)d * 512);
#pragma unroll
                                for (int e = 0; e < 4; ++e) { zz[d][2 * e] = pg8::bflo(cv[e]) * pg8::bflo(hv[e]); zz[d][2 * e + 1] = pg8::bfhi(cv[e]) * pg8::bfhi(hv[e]); } }
                            else {
#pragma unroll
                                for (int e = 0; e < 8; ++e) zz[d][e] = 0.f; }
                        }
                        float y[8];
#pragma unroll
                        for (int e = 0; e < 8; ++e) { const float b = (e & 1) ? pg8::bfhi(bw[e >> 1]) : pg8::bflo(bw[e >> 1]);
                            y[e] = b * (cw[c8 + e] * zz[2][e] + cw[512 + c8 + e] * zz[1][e] + cw[1024 + c8 + e] * zz[0][e]); }
                        v4u o; o.x = pk2(y[0], y[1]); o.y = pk2(y[2], y[3]); o.z = pk2(y[4], y[5]); o.w = pk2(y[6], y[7]);
                        *(v4u*)(AB + off) = o;
                    }
                }
                {
                    bf16* UU = PROJ + 1 * PIECE; const bf16* VV = PROJ + 5 * PIECE; const float* sgn = in[9] + (size_t)l * 512; const float* sgw = in[10] + (size_t)l * 4 * 128 * 128; const float* sgb = in[11] + (size_t)l * 4 * 128;
                    LAS bf16* T = (LAS bf16*)ldsp;
                    const int fr = lane & 15, fq = lane >> 4;
                    for (int unit = vcu; unit < 512; unit += G) {
                        const int n = unit >> 2, gI = unit & 3;
                        { const int s = tid >> 2, cg0 = (tid & 3) * 32, row = 128 * n + s;
                          const f32x4 p0 = *(const f32x4*)(SSV + (size_t)row * 8), p1 = *(const f32x4*)(SSV + (size_t)row * 8 + 4);
                          const float rv = rsqrtf(((p0[0] + p0[1]) + (p0[2] + p0[3]) + (p1[0] + p1[1]) + (p1[2] + p1[3])) * (1.0f / 512.0f) + EPS);
#pragma unroll
                          for (int q = 0; q < 4; ++q) { const int c = cg0 + 8 * q; const v4u vw = *(const v4u*)(VV + (size_t)row * 512 + 128 * gI + c);
                              const f32x4 ga = *(const f32x4*)(sgn + 128 * gI + c), gb = *(const f32x4*)(sgn + 128 * gI + c + 4);
#pragma unroll
                              for (int e = 0; e < 4; ++e) { const float g0 = e < 2 ? ga[2 * e] : gb[2 * e - 4], g1 = e < 2 ? ga[2 * e + 1] : gb[2 * e - 3];
                                  T[(c + 2 * e) * 136 + s] = (bf16)f2bf(pg8::bflo(vw[e]) * rv * g0); T[(c + 2 * e + 1) * 136 + s] = (bf16)f2bf(pg8::bfhi(vw[e]) * rv * g1); } } }
                        __syncthreads();
                        f32x4 acc[8];
#pragma unroll
                        for (int j = 0; j < 8; ++j) acc[j] = (f32x4){0.f, 0.f, 0.f, 0.f};
                        const int t = 16 * wave + fr;
                        for (int kk = 0; kk <= (wave >> 1); ++kk) {
                            const int s0 = 32 * kk + 8 * fq; const float* wp = sgw + ((size_t)gI * 128 + t) * 128 + s0;
                            const f32x4 w0 = *(const f32x4*)wp, w1 = *(const f32x4*)(wp + 4);
                            float wv[8] = {w0[0], w0[1], w0[2], w0[3], w1[0], w1[1], w1[2], w1[3]};
#pragma unroll
                            for (int e = 0; e < 8; ++e) if (s0 + e > t) wv[e] = 0.f;
                            v4u aw; aw.x = pk2(wv[0], wv[1]); aw.y = pk2(wv[2], wv[3]); aw.z = pk2(wv[4], wv[5]); aw.w = pk2(wv[6], wv[7]);
                            const bf16x8 afr = __builtin_bit_cast(bf16x8, aw);
#pragma unroll
                            for (int j = 0; j < 8; ++j) { const bf16x8 bfr = *(const LAS bf16x8*)(T + (16 * j + fr) * 136 + s0); acc[j] = __builtin_amdgcn_mfma_f32_16x16x32_bf16(bfr, afr, acc[j], 0, 0, 0); }
                        }
                        const float bias = sgb[gI * 128 + t]; const size_t rowoff = (size_t)(128 * n + t) * 512 + 128 * gI;
#pragma unroll
                        for (int j = 0; j < 8; ++j) { const int c = 16 * j + 4 * fq; const v2u uw = *(const v2u*)(UU + rowoff + c);
                            v2u o; o.x = pk2(pg8::bflo(uw.x) * (acc[j][0] + bias), pg8::bfhi(uw.x) * (acc[j][1] + bias)); o.y = pk2(pg8::bflo(uw.y) * (acc[j][2] + bias), pg8::bfhi(uw.y) * (acc[j][3] + bias));
                            *(v2u*)(UU + rowoff + c) = o; }
                        __syncthreads();
                    }
                }
            }
            SEAM(pb + 4);
            if (IN(pb + 5)) { KARGS();
                TIDS();
                const attn_body::AttnTensors AT{(const attn_body::bf16*)(PROJ + 8 * PIECE), (const attn_body::bf16*)(PROJ + 6 * PIECE), (const attn_body::bf16*)(PROJ + 7 * PIECE), (attn_body::bf16*)(PROJ + 2 * PIECE), CS, (const unsigned*)(ws + 32768) + 8 * l};
                unsigned* qctr = (unsigned*)(ws + 40960) + 64 * l;
                volatile LAS unsigned* qw = (volatile LAS unsigned*)(ldsp + XB_LDS_OFF + 64);
                volatile LAS unsigned* T0 = (volatile LAS unsigned*)(ldsp + T0_LDS_OFF);
                {   const int hd = tid & 7, qb = 63 - (tid >> 3);
                    const float km2 = __uint_as_float(__hip_atomic_load(AT.KM + hd, __ATOMIC_RELAXED, __HIP_MEMORY_SCOPE_AGENT)), qm2 = __uint_as_float(__hip_atomic_load(AT.KM + 64 + hd, __ATOMIC_RELAXED, __HIP_MEMORY_SCOPE_AGENT));
                    T0[tid] = (unsigned)attn_skip_tiles(CS + (size_t)hd * M, qb, sqrtf(km2 * qm2) * 1.001f + 0.01f); }
                __syncthreads();
#pragma nounroll
                for (;;) {
                    if (tid == 0) qw[0] = __hip_atomic_fetch_add(qctr, 1u, __ATOMIC_RELAXED, __HIP_MEMORY_SCOPE_AGENT);
                    __syncthreads();
                    const unsigned idx = qw[0];
                    __syncthreads();
                    if (idx >= 2048u) break;
                    const int c = (int)(idx >> 9), un = (int)(idx & 511u), qb = 63 - (un >> 3), hd = un & 7, ntf = 4 * (qb + 1);
                    const int t0 = (int)T0[un], len = ntf - t0, n = attn_chunks(len);
                    if (c >= n) continue;
                    const bool last = (c == n - 1); const int tb = t0 + 64 * c, ntl = last ? ntf - tb : 64;
                    attn_body::bf16* Oc = (attn_body::bf16*)(PROJ + (last ? 2 : 3 + c) * PIECE);
                    float* Lc = last ? (float*)(ws + WS_LPL) : (float*)(ws + WS_LP) + (size_t)c * M * 8;
                    attn_body::attn_unit<8>(0, hd, qb, AT.Q, AT.K, AT.V, Oc, CS, AT.KM, (char*)lds, tb, ntl, last, Lc);
                }
                __syncthreads();
            }
            SEAM(pb + 5);
            if (IN(pb + 6)) { KARGS();
                {
                    TIDS(); const unsigned* KMp = (const unsigned*)(ws + 32768) + 8 * l;
                    for (int un = vcu; un < 512; un += G) {
                        const int qb = 63 - (un >> 3), hd = un & 7, ntf = 4 * (qb + 1);
                        const float km2 = __uint_as_float(__hip_atomic_load(KMp + hd, __ATOMIC_RELAXED, __HIP_MEMORY_SCOPE_AGENT)), qm2 = __uint_as_float(__hip_atomic_load(KMp + 64 + hd, __ATOMIC_RELAXED, __HIP_MEMORY_SCOPE_AGENT));
                        const int t0 = attn_skip_tiles(CS + (size_t)hd * M, qb, sqrtf(km2 * qm2) * 1.001f + 0.01f), n = attn_chunks(ntf - t0);
                        if (n <= 1) continue;
                        for (int it = tid; it < 2048; it += NTHREADS) { const int row = 256 * qb + (it >> 3); const size_t off = (size_t)row * 512 + hd * 64 + (it & 7) * 8;
                            float lw = ((const float*)(ws + WS_LPL))[(size_t)row * 8 + hd], ls = lw; const v4u yw = *(const v4u*)(PROJ + 2 * PIECE + off);
                            float y[8];
#pragma unroll
                            for (int e = 0; e < 4; ++e) { y[2 * e] = pg8::bflo(yw[e]) * lw; y[2 * e + 1] = pg8::bfhi(yw[e]) * lw; }
                            for (int c = 0; c < n - 1; ++c) { const float lc = ((const float*)(ws + WS_LP))[((size_t)c * M + row) * 8 + hd]; ls += lc; const v4u pw = *(const v4u*)(PROJ + (size_t)(3 + c) * PIECE + off);
#pragma unroll
                                for (int e = 0; e < 4; ++e) { y[2 * e] += pg8::bflo(pw[e]) * lc; y[2 * e + 1] += pg8::bfhi(pw[e]) * lc; } }
                            const float inv = 1.0f / ls; v4u o; o.x = pk2(y[0] * inv, y[1] * inv); o.y = pk2(y[2] * inv, y[3] * inv); o.z = pk2(y[4] * inv, y[5] * inv); o.w = pk2(y[6] * inv, y[7] * inv);
                            *(v4u*)(PROJ + 2 * PIECE + off) = o; }
                    }
                }
                pg8::Gemm g{XB, Wt + WO_G, 1024, 1024, 1024, 0, 0}; pg8::StaticOrder S; S.init(M / 256, 12, G, bx);
                pg8::EpiGates E{SS, GT}; pg8::gemm_phase<pg8::EpiGates, pg8::StaticOrder, true, true>(ldsp, g, S, E);
            }
            SEAM(pb + 6);
            if (IN(pb + 7)) { KARGS();
                pg8::Gemm g{PROJ, Wt + WO_B, 512, 512, 512, PIECE * 2, (size_t)1024 * 512 * 2}; pg8::ZOrder<3> S; S.S.init(M / 256, 4, G, bx);
                pg8::EpiMerge E{GT}; pg8::gemm_phase<pg8::EpiMerge, pg8::ZOrder<3>, true, true>(ldsp, g, S, E);
            }
            SEAM(pb + 7);
            if (IN(pb + 8)) { KARGS();
                pg8::Gemm g{GT, Wt + WO_O, 1024, 1024, 1024, 0, 0}; pg8::StaticOrder S; S.init(M / 256, 4, G, bx);
                pg8::EpiResid E{XB, SS, 1.0f}; pg8::gemm_phase<pg8::EpiResid, pg8::StaticOrder, true, true>(ldsp, g, S, E);
            }
            SEAM(pb + 8);
            if (IN(pb + 9)) { KARGS();
                pg8::Gemm g{XB, Wt + WO_Q, 1024, 1024, 1024, 0, 0}; pg8::EpiScale<1> E{SS, XQ, 1024, 0.0625f * LOG2E};
                for (int Lx = vcu; Lx < 256; Lx += G) { pg8::OneUnit S; S.u0.pm = Lx >> 2; S.u0.pn = Lx & 3; S.u0.z = 0; pg8::gemm_phase<pg8::EpiScale<1>, pg8::OneUnit, true, true>(ldsp, g, S, E); }
            }
            SEAM_LOCAL(pb + 9);
            if (IN(pb + 10)) { KARGS();
                pg8::Gemm g{XQ, KC, 256, 1024, 1024, 512, 512}; pg8::EpiSoftmax E{PB};
                for (int Lx = vcu; Lx < 256; Lx += G) { pg8::OneUnit S; S.u0.pm = Lx >> 2; S.u0.pn = 0; S.u0.z = Lx & 3; pg8::gemm_phase<pg8::EpiSoftmax, pg8::OneUnit, false, true>(ldsp, g, S, E); }
            }
            SEAM_LOCAL(pb + 10);
            if (IN(pb + 11)) { KARGS();
                pg8::Gemm g{PB, VCT, 256, 1024, 256, 512, (size_t)256 * 256 * 2}; pg8::EpiScale<0> E{nullptr, OB, 1024, 1.0f};
                for (int Lx = vcu; Lx < 256; Lx += G) { pg8::OneUnit S; S.u0.pm = Lx >> 2; S.u0.pn = 0; S.u0.z = Lx & 3; pg8::gemm_phase<pg8::EpiScale<0>, pg8::OneUnit, true, true>(ldsp, g, S, E); }
            }
            SEAM(pb + 11);
            if (IN(pb + 12)) { KARGS();
                pg8::Gemm g{OB, Wt + WO_XO, 1024, 1024, 1024, 0, 0}; pg8::StaticOrder S; S.init(M / 256, 4, G, bx);
                pg8::EpiResid E{XB, SS, 1.0f}; pg8::gemm_phase<pg8::EpiResid, pg8::StaticOrder, true, true>(ldsp, g, S, E);
            }
            SEAM(pb + 12);
        }
    }
#ifdef MK_DUMP_OFF
    {
        GRID_SYNC(); KARGS(); int t_ = threadIdx.x; asm volatile("" : "+v"(t_));
        const bf16* src = SCR + (size_t)(MK_DUMP_OFF);
        for (unsigned i = blockIdx.x * 512u + (unsigned)t_; i < (unsigned)M * 1024u; i += gridDim.x * 512u) { const unsigned m = i >> 10, c = i & 1023u;
            X[i] = c < (unsigned)(MK_DUMP_LD) ? b2f(src[(size_t)m * (MK_DUMP_LD) + c]) : 0.f; }
    }
#endif
    if (IN(30)) { KARGS(); TIDS();
        const float* gf = in[25];
        for (int m = gw; m < M; m += NGW) {
            const v2u* xb = (const v2u*)(XB + (size_t)m * D) + lane; f32x4* xr = (f32x4*)(X + (size_t)m * D) + lane; f32x4 v[4]; float s = 0.f;
#pragma unroll
            for (int j = 0; j < 4; ++j) { const v2u xw = xb[64 * j]; v[j] = (f32x4){pg8::bflo(xw.x), pg8::bfhi(xw.x), pg8::bflo(xw.y), pg8::bfhi(xw.y)}; s += (v[j][0] * v[j][0] + v[j][1] * v[j][1]) + (v[j][2] * v[j][2] + v[j][3] * v[j][3]); }
            const float r = rsqrtf(wave_sum(s) * (1.0f / D) + EPS);
#pragma unroll
            for (int j = 0; j < 4; ++j) xr[64 * j] = v[j] * r * *((const f32x4*)gf + lane + 64 * j);
        }
    }
#undef IN
#undef SEAM
#undef ws
#undef X
#undef SS
#undef SSV
#undef LF
#undef CS
#undef RSM
#undef MEMB
#undef KC
#undef VCT
#undef Wt
#undef XB
#undef SCR
#undef ACT
#undef PROJ
#undef GT
#undef XQ
#undef PB
#undef OB
#undef in
}

#ifndef MK_PER_PHASE
#define MK_PER_PHASE 0
#endif
extern "C" void kernel_launch(void* const* d_in, const int* in_sizes, int n_in, void* d_out, int out_size, void* d_ws, size_t ws_size, hipStream_t stream) {
    static int grid = 0;
    if (grid == 0) {
        if (n_in != 26 || out_size != M * D || ws_size < WS_END) { fprintf(stderr, "kernel_launch: unexpected shapes (n_in %d out %d ws %zu)\n", n_in, out_size, ws_size); grid = -1; return; }
        int dev = 0, cus = 0, per_cu = 0;
        (void)hipGetDevice(&dev); (void)hipDeviceGetAttribute(&cus, hipDeviceAttributeMultiprocessorCount, dev);
        if (hipFuncSetAttribute((const void*)mk_fwd, hipFuncAttributeMaxDynamicSharedMemorySize, LDS_BYTES) != hipSuccess) { fprintf(stderr, "kernel_launch: hipFuncSetAttribute failed\n"); grid = -1; return; }
        if (hipOccupancyMaxActiveBlocksPerMultiprocessor(&per_cu, (const void*)mk_fwd, NTHREADS, LDS_BYTES) != hipSuccess || per_cu < 1) { fprintf(stderr, "kernel_launch: occupancy query says %d\n", per_cu); per_cu = 1; }
        (void)hipGetLastError();
        grid = cus > 0 ? cus : 256;
    }
    if (grid < 0) return;
    (void)hipMemsetAsync(d_ws, 0, 65536, stream);
    Args a{};
    for (int i = 0; i < 26; ++i) a.in[i] = (const float*)d_in[i];
    a.out = (float*)d_out; a.ws = (unsigned char*)d_ws;
#if MK_PER_PHASE
    for (int p = 0; p < 31; ++p) { a.ph_lo = p; a.ph_hi = p + 1; void* kargs[] = {&a};
        hipError_t e = hipLaunchCooperativeKernel((const void*)mk_fwd, dim3(grid), dim3(NTHREADS), kargs, LDS_BYTES, stream);
        if (e != hipSuccess) { fprintf(stderr, "launch %d failed: %s\n", p, hipGetErrorString(e)); break; } }
#else
#ifndef MK_PH_HI
#define MK_PH_HI 31
#endif
    a.ph_lo = 0; a.ph_hi = MK_PH_HI; void* kargs[] = {&a};
    hipError_t e = hipLaunchCooperativeKernel((const void*)mk_fwd, dim3(grid), dim3(NTHREADS), kargs, LDS_BYTES, stream);
    if (e != hipSuccess) fprintf(stderr, "cooperative launch failed: %s (grid %d)\n", hipGetErrorString(e), grid);
#endif
}
```

```cpp
#include <hip/hip_runtime.h>
#include <hip/hip_cooperative_groups.h>
#include <cstdio>
#include <cstdint>
namespace cg = cooperative_groups;

namespace pg8 {
#define PG8_LAS __attribute__((address_space(3)))
typedef unsigned short bf16_t;
typedef short bf16x8 __attribute__((ext_vector_type(8)));
typedef float f32x4 __attribute__((ext_vector_type(4)));
typedef unsigned u32x4 __attribute__((ext_vector_type(4)));
constexpr int BM = 256, BK = 64, HALF = 128, HTB = HALF * BK * 2  , STAGE_BYTES = 8 * HTB, NXCD = 8, WGM = 8;

__host__ __device__ __forceinline__ int lds_byte(int r, int c) { const int st = (r >> 4) * 2 + (c >> 5), rr = r & 15, cc = c & 31, ob = rr * 64 + cc * 2; return st * 1024 + (ob ^ (((ob >> 9) & 1) << 5)); }
__host__ __device__ __forceinline__ void stage_rc(int b, int& R, int& C) { const int st = b / 1024, sb = b % 1024, swz = sb ^ (((sb >> 9) & 1) << 5); R = (st >> 1) * 16 + swz / 64; C = (st & 1) * 32 + (swz % 64) / 2; }
__host__ __device__ __forceinline__ int perm32(int rho) { const int n = rho >> 4, i = rho & 15; return 8 * (i >> 2) + 4 * n + (i & 3); }

struct Unit { int pm, pn, z; };
typedef float f32x2 __attribute__((ext_vector_type(2))); typedef __bf16 bf16x2_cv __attribute__((ext_vector_type(2)));
__device__ __forceinline__ unsigned cvt_pk_bf16(float lo, float hi) { const f32x2 v = {lo, hi}; const bf16x2_cv b = __builtin_convertvector(v, bf16x2_cv); return __builtin_bit_cast(unsigned, b); }
struct Gemm { const bf16_t* A; const bf16_t* Bt; int K, lda, ldb; size_t zA, zB; };

struct StaticOrder {
    int nM, nN, nwg, G, c;
    __host__ __device__ __forceinline__ void init(int nM_, int nN_, int G_, int c_) { nM = nM_; nN = nN_; nwg = nM * nN; G = G_; c = c_; }
    __host__ __device__ __forceinline__ void map(int wgid, Unit& u) const {
        { const int q = nwg / NXCD, r = nwg % NXCD, xcd = wgid % NXCD, off = wgid / NXCD; wgid = (xcd < r ? xcd * (q + 1) : r * (q + 1) + (xcd - r) * q) + off; }
        const int nig = WGM * nN, gid = wgid / nig, fm = gid * WGM, gsz = (nM - fm) < WGM ? (nM - fm) : WGM;
        u.pm = fm + ((wgid % nig) % gsz); u.pn = (wgid % nig) / gsz; u.z = 0;
    }
    __host__ __device__ __forceinline__ bool next(int i, Unit& u) const { const long L = (long)i * G + c; if (L >= nwg) return false; map((int)L, u); return true; }
    __device__ __forceinline__ void a_ready(const Unit&) const {}
    __device__ __forceinline__ void done(const Unit&) const {}
};
template <int NZ> struct ZOrder {
    StaticOrder S;
    __host__ __device__ __forceinline__ bool next(int i, Unit& u) const { const long L = (long)(i / NZ) * S.G + S.c; if (L >= S.nwg) return false; S.map((int)L, u); u.z = i % NZ; return true; }
    __device__ __forceinline__ void a_ready(const Unit&) const {}
    __device__ __forceinline__ void done(const Unit&) const {}
};
struct OneUnit {
    Unit u0;
    __host__ __device__ __forceinline__ bool next(int i, Unit& u) const { if (i > 0) return false; u = u0; return true; }
    __device__ __forceinline__ void a_ready(const Unit&) const {}
    __device__ __forceinline__ void done(const Unit&) const {}
};

typedef unsigned u32x2 __attribute__((ext_vector_type(2)));
constexpr float LOG2E = 1.4426950408889634f;
__device__ __forceinline__ float bf2f(unsigned short b) { return __uint_as_float((unsigned)b << 16); }
__device__ __forceinline__ float bflo(unsigned w) { return __uint_as_float(w << 16); }
__device__ __forceinline__ float bfhi(unsigned w) { return __uint_as_float(w & 0xffff0000u); }
__device__ __forceinline__ float sigmoidf_(float v) { return __builtin_amdgcn_rcpf(1.0f + __builtin_amdgcn_exp2f(-v * LOG2E)); }
__device__ __forceinline__ float gelu_tanh(float v) { const float z = 0.7978845608028654f * (v + 0.044715f * v * v * v); return v * sigmoidf_(2.0f * z); }
__device__ __forceinline__ u32x4 pack8(const f32x4 a, const f32x4 b) { u32x4 w; w.x = cvt_pk_bf16(a[0], a[1]); w.y = cvt_pk_bf16(a[2], a[3]); w.z = cvt_pk_bf16(b[0], b[1]); w.w = cvt_pk_bf16(b[2], b[3]); return w; }
__device__ __forceinline__ void row_rstd(const float* SS, int rowbase, int fq, float (&rs)[2][4]) {
#pragma unroll
    for (int ai = 0; ai < 2; ++ai)
#pragma unroll
        for (int m = 0; m < 4; ++m) { const f32x4 v = *(const f32x4*)(SS + (size_t)(rowbase + ai * HALF + m * 16) * 16 + 4 * fq);
            float s = (v[0] + v[1]) + (v[2] + v[3]); s += __shfl_xor(s, 16); s += __shfl_xor(s, 32); rs[ai][m] = rsqrtf(s * (1.0f / 1024.0f) + 1e-6f); }
}
__device__ __forceinline__ float row_rstd1(const float* SS, int row, int fq) { const f32x4 v = *(const f32x4*)(SS + (size_t)row * 16 + 4 * fq);
    float s = (v[0] + v[1]) + (v[2] + v[3]); s += __shfl_xor(s, 16); s += __shfl_xor(s, 32); return rsqrtf(s * (1.0f / 1024.0f) + 1e-6f); }
__device__ __forceinline__ void rows_rstd(const float* SS, const PG8_LAS float* rsl, int pm, int wr, int fr, int fq, float (&rs)[2][4]) {
    if (rsl) {
#pragma unroll
        for (int ai = 0; ai < 2; ++ai)
#pragma unroll
            for (int m = 0; m < 4; ++m) rs[ai][m] = rsl[ai * HALF + wr * 64 + m * 16 + fr];
    } else row_rstd(SS, pm * BM + wr * 64 + fr, fq, rs);
}
#define EPI_ARGS const f32x4 (&acc)[2][2][4][2], const Unit& u, int wr, int wc, int fr, int fq
struct EpiSwiGLU { static constexpr bool PERM = true, AFTER_DRAIN = false; const float* SS; const PG8_LAS float* rsl; bf16_t* O;
    __device__ __forceinline__ void operator()(EPI_ARGS) const {
        float rs[2][4]; rows_rstd(SS, rsl, u.pm, wr, fr, fq, rs);
        const int col0 = u.pn * 128 + wc * 32 + 8 * fq;
#pragma unroll
        for (int ai = 0; ai < 2; ++ai)
#pragma unroll
            for (int m = 0; m < 4; ++m) { const float r = rs[ai][m]; f32x4 o[2];
#pragma unroll
                for (int n = 0; n < 2; ++n)
#pragma unroll
                    for (int j = 0; j < 4; ++j) { const float g = acc[ai][0][m][n][j] * r, up = acc[ai][1][m][n][j] * r; o[n][j] = g * sigmoidf_(g) * up; }
                *(u32x4*)(O + (size_t)(u.pm * BM + ai * HALF + wr * 64 + m * 16 + fr) * 2816 + col0) = pack8(o[0], o[1]); }
    }
};
struct EpiResid { static constexpr bool PERM = true, AFTER_DRAIN = false; bf16_t* XB; float* SS; float scale;
    __device__ __forceinline__ void operator()(EPI_ARGS) const {
        const int col0 = u.pn * BM + wc * 32 + 8 * fq;
#pragma unroll
        for (int ai = 0; ai < 2; ++ai) {
            u32x4 xw[4][2];
#pragma unroll
            for (int m = 0; m < 4; ++m)
#pragma unroll
                for (int bj = 0; bj < 2; ++bj) xw[m][bj] = *(const u32x4*)(XB + (size_t)(u.pm * BM + ai * HALF + wr * 64 + m * 16 + fr) * 1024 + col0 + bj * HALF);
            asm volatile("" ::: "memory");
#pragma unroll
            for (int m = 0; m < 4; ++m) { const int row = u.pm * BM + ai * HALF + wr * 64 + m * 16 + fr; float ssq = 0.f;
#pragma unroll
                for (int bj = 0; bj < 2; ++bj) { const u32x4 w0 = xw[m][bj];
                    f32x4 x0 = {bflo(w0.x), bfhi(w0.x), bflo(w0.y), bfhi(w0.y)}, x1 = {bflo(w0.z), bfhi(w0.z), bflo(w0.w), bfhi(w0.w)};
                    x0 = x0 + acc[ai][bj][m][0] * scale; x1 = x1 + acc[ai][bj][m][1] * scale;
                    *(u32x4*)(XB + (size_t)row * 1024 + col0 + bj * HALF) = pack8(x0, x1);
                    ssq += (x0[0] * x0[0] + x0[1] * x0[1]) + (x0[2] * x0[2] + x0[3] * x0[3]) + (x1[0] * x1[0] + x1[1] * x1[1]) + (x1[2] * x1[2] + x1[3] * x1[3]); }
                ssq += __shfl_xor(ssq, 16); ssq += __shfl_xor(ssq, 32);
                if (fq == 0) SS[(size_t)row * 16 + u.pn * 4 + wc] = ssq; }
            asm volatile("" ::: "memory");
        }
    }
};
struct EpiWin { static constexpr bool PERM = true, AFTER_DRAIN = false; const float* SS; const PG8_LAS float* rsl; bf16_t* P; float* SSV; float qscale;
    __device__ __forceinline__ void operator()(EPI_ARGS) const {
        float rs[2][4]; rows_rstd(SS, rsl, u.pm, wr, fr, fq, rs);
        const int piece = u.pn >> 1;
        const int slot = piece == 0 ? 0 : piece == 1 ? 3 : piece == 2 ? 4 : piece == 3 ? 1 : piece == 4 ? 5 : piece == 5 ? 8 : piece;
        bf16_t* base = P + (size_t)slot * (16384u * 512u);
        const int col0 = (u.pn & 1) * 256 + wc * 32 + 8 * fq;
        const float sc = piece == 5 ? qscale : 1.0f;
#pragma unroll
        for (int ai = 0; ai < 2; ++ai)
#pragma unroll
            for (int m = 0; m < 4; ++m) { const int row = u.pm * BM + ai * HALF + wr * 64 + m * 16 + fr; const float r = rs[ai][m] * sc; float ssq = 0.f;
#pragma unroll
                for (int bj = 0; bj < 2; ++bj) { f32x4 v0 = acc[ai][bj][m][0] * r, v1 = acc[ai][bj][m][1] * r;
                    if (piece == 3 || piece == 4) {
#pragma unroll
                        for (int j = 0; j < 4; ++j) { v0[j] = gelu_tanh(v0[j]); v1[j] = gelu_tanh(v1[j]); }
                        ssq += (v0[0] * v0[0] + v0[1] * v0[1]) + (v0[2] * v0[2] + v0[3] * v0[3]) + (v1[0] * v1[0] + v1[1] * v1[1]) + (v1[2] * v1[2] + v1[3] * v1[3]); }
                    *(u32x4*)(base + (size_t)row * 512 + col0 + bj * HALF) = pack8(v0, v1); }
                if (piece == 4) { ssq += __shfl_xor(ssq, 16); ssq += __shfl_xor(ssq, 32); if (fq == 0) SSV[(size_t)row * 8 + (u.pn & 1) * 4 + wc] = ssq; } }
    }
};
struct EpiGates { static constexpr bool PERM = true, AFTER_DRAIN = false; const float* SS; const PG8_LAS float* rsl; bf16_t* G;
    __device__ __forceinline__ void operator()(EPI_ARGS) const {
        float rs[2][4]; rows_rstd(SS, rsl, u.pm, wr, fr, fq, rs);
        bf16_t* base = G + (size_t)(u.pn >> 2) * (16384u * 1024u);
        const int col0 = (u.pn & 3) * 256 + wc * 32 + 8 * fq;
#pragma unroll
        for (int ai = 0; ai < 2; ++ai)
#pragma unroll
            for (int m = 0; m < 4; ++m) { const int row = u.pm * BM + ai * HALF + wr * 64 + m * 16 + fr; const float r = rs[ai][m];
#pragma unroll
                for (int bj = 0; bj < 2; ++bj) { f32x4 v0 = acc[ai][bj][m][0] * r, v1 = acc[ai][bj][m][1] * r;
#pragma unroll
                    for (int j = 0; j < 4; ++j) { v0[j] = sigmoidf_(v0[j]); v1[j] = sigmoidf_(v1[j]); }
                    *(u32x4*)(base + (size_t)row * 1024 + col0 + bj * HALF) = pack8(v0, v1); } }
    }
};
struct EpiMerge { static constexpr bool PERM = true, AFTER_DRAIN = false; bf16_t* G;
    __device__ __forceinline__ void operator()(EPI_ARGS) const {
        const bf16_t* gz = G + (size_t)u.z * (16384u * 1024u);
        const int col0 = u.pn * 256 + wc * 32 + 8 * fq;
#pragma unroll
        for (int ai = 0; ai < 2; ++ai) {
            u32x4 gw[4][2], pw[4][2];
#pragma unroll
            for (int m = 0; m < 4; ++m)
#pragma unroll
                for (int bj = 0; bj < 2; ++bj) { const size_t off = (size_t)(u.pm * BM + ai * HALF + wr * 64 + m * 16 + fr) * 1024 + col0 + bj * HALF;
                    gw[m][bj] = *(const u32x4*)(gz + off); pw[m][bj] = (u.z != 0) ? *(const u32x4*)(G + off) : (u32x4){0u, 0u, 0u, 0u}; }
            asm volatile("" ::: "memory");
#pragma unroll
            for (int m = 0; m < 4; ++m)
#pragma unroll
                for (int bj = 0; bj < 2; ++bj) { const size_t off = (size_t)(u.pm * BM + ai * HALF + wr * 64 + m * 16 + fr) * 1024 + col0 + bj * HALF;
                    const u32x4 g = gw[m][bj], p = pw[m][bj];
                    f32x4 g0 = {bflo(g.x), bfhi(g.x), bflo(g.y), bfhi(g.y)}, g1 = {bflo(g.z), bfhi(g.z), bflo(g.w), bfhi(g.w)};
                    f32x4 v0 = acc[ai][bj][m][0] * g0, v1 = acc[ai][bj][m][1] * g1;
#ifdef MK_DBG_Z
                    if (u.z != MK_DBG_Z) { v0 = v0 * 0.f; v1 = v1 * 0.f; }
#endif
                    v0 = v0 + (f32x4){bflo(p.x), bfhi(p.x), bflo(p.y), bfhi(p.y)}; v1 = v1 + (f32x4){bflo(p.z), bfhi(p.z), bflo(p.w), bfhi(p.w)};
                    *(u32x4*)(G + off) = pack8(v0, v1); }
            asm volatile("" ::: "memory");
        }
    }
};
template <int MODE> struct EpiScale { static constexpr bool PERM = true, AFTER_DRAIN = false; const float* S; bf16_t* O; int ldc; float scale;
    __device__ __forceinline__ void operator()(EPI_ARGS) const {
        float rs[2][4];
        if (MODE == 1) row_rstd(S, u.pm * BM + wr * 64 + fr, fq, rs);
        const int col0 = (u.pn + u.z) * 256 + wc * 32 + 8 * fq;
#pragma unroll
        for (int ai = 0; ai < 2; ++ai)
#pragma unroll
            for (int m = 0; m < 4; ++m) { const int row = u.pm * BM + ai * HALF + wr * 64 + m * 16 + fr;
                float r = scale; if (MODE == 1) r *= rs[ai][m]; if (MODE == 2) r *= S[row];
#pragma unroll
                for (int bj = 0; bj < 2; ++bj) { f32x4 v0 = acc[ai][bj][m][0] * r, v1 = acc[ai][bj][m][1] * r;
                    if (MODE == 3) { v0 = v0 * *(const f32x4*)(S + col0 + bj * HALF); v1 = v1 * *(const f32x4*)(S + col0 + bj * HALF + 4); }
                    *(u32x4*)(O + (size_t)row * ldc + col0 + bj * HALF) = pack8(v0, v1); } }
    }
};
struct EpiScaleZ { static constexpr bool PERM = true, AFTER_DRAIN = false; bf16_t* O; int ldc; float scale;
    __device__ __forceinline__ void operator()(EPI_ARGS) const {
        const int col0 = u.pn * 256 + wc * 32 + 8 * fq;
#pragma unroll
        for (int ai = 0; ai < 2; ++ai)
#pragma unroll
            for (int m = 0; m < 4; ++m) { const int row = (u.pm + u.z) * BM + ai * HALF + wr * 64 + m * 16 + fr;
#pragma unroll
                for (int bj = 0; bj < 2; ++bj) *(u32x4*)(O + (size_t)row * ldc + col0 + bj * HALF) = pack8(acc[ai][bj][m][0] * scale, acc[ai][bj][m][1] * scale); }
    }
};
struct EpiSoftmax { static constexpr bool PERM = true, AFTER_DRAIN = true; const float* SS; const PG8_LAS float* rsl; bf16_t* O;
    __device__ __forceinline__ void fused(f32x4 (&acc)[2][2][4][2], const Unit& u, int wr, int wc, int fr, int fq, PG8_LAS unsigned char* lds, int wid, int lane) const {
        PG8_LAS float* T1 = (PG8_LAS float*)lds; PG8_LAS float* T2 = (PG8_LAS float*)(lds + 4096);
        { float rs[2][4]; rows_rstd(SS, rsl, u.pm, wr, fr, fq, rs);
#pragma unroll
          for (int ai = 0; ai < 2; ++ai)
#pragma unroll
            for (int m = 0; m < 4; ++m)
#pragma unroll
                for (int bj = 0; bj < 2; ++bj)
#pragma unroll
                    for (int n = 0; n < 2; ++n) acc[ai][bj][m][n] = acc[ai][bj][m][n] * rs[ai][m]; }
#pragma unroll
        for (int ai = 0; ai < 2; ++ai)
#pragma unroll
            for (int m = 0; m < 4; ++m) { float mx = -3.0e38f;
#pragma unroll
                for (int bj = 0; bj < 2; ++bj)
#pragma unroll
                    for (int n = 0; n < 2; ++n)
#pragma unroll
                        for (int j = 0; j < 4; ++j) mx = fmaxf(mx, acc[ai][bj][m][n][j]);
                mx = fmaxf(mx, __shfl_xor(mx, 16)); mx = fmaxf(mx, __shfl_xor(mx, 32));
                if (fq == 0) T1[(ai * HALF + wr * 64 + m * 16 + fr) * 4 + wc] = mx; }
        asm volatile("s_waitcnt lgkmcnt(0)" ::: "memory"); __builtin_amdgcn_s_barrier(); asm volatile("" ::: "memory");
#pragma unroll
        for (int ai = 0; ai < 2; ++ai)
#pragma unroll
            for (int m = 0; m < 4; ++m) { const int rl = ai * HALF + wr * 64 + m * 16 + fr; const f32x4 t = *(const PG8_LAS f32x4*)(T1 + rl * 4);
                const float mx = fmaxf(fmaxf(t[0], t[1]), fmaxf(t[2], t[3])); float s = 0.f;
#pragma unroll
                for (int bj = 0; bj < 2; ++bj)
#pragma unroll
                    for (int n = 0; n < 2; ++n)
#pragma unroll
                        for (int j = 0; j < 4; ++j) { const float p = __builtin_amdgcn_exp2f(acc[ai][bj][m][n][j] - mx); acc[ai][bj][m][n][j] = p; s += p; }
                s += __shfl_xor(s, 16); s += __shfl_xor(s, 32);
                if (fq == 0) T2[rl * 4 + wc] = s; }
        asm volatile("s_waitcnt lgkmcnt(0)" ::: "memory"); __builtin_amdgcn_s_barrier(); asm volatile("" ::: "memory");
        const int col0 = (u.pn + u.z) * 256 + wc * 32 + 8 * fq;
#pragma unroll
        for (int ai = 0; ai < 2; ++ai)
#pragma unroll
            for (int m = 0; m < 4; ++m) { const int rl = ai * HALF + wr * 64 + m * 16 + fr; const f32x4 t = *(const PG8_LAS f32x4*)(T2 + rl * 4);
                const float inv = 1.0f / ((t[0] + t[1]) + (t[2] + t[3]));
#pragma unroll
                for (int bj = 0; bj < 2; ++bj) *(u32x4*)(O + (size_t)(u.pm * BM + rl) * 1024 + col0 + bj * HALF) = pack8(acc[ai][bj][m][0] * inv, acc[ai][bj][m][1] * inv); }
        asm volatile("s_waitcnt lgkmcnt(0)" ::: "memory"); __builtin_amdgcn_s_barrier(); asm volatile("" ::: "memory");
    }
};

template <class Epi, class Sched, bool ALIGN_EPI = false, bool SP2 = false>
__device__ __forceinline__ void gemm_phase(PG8_LAS unsigned char* lds, const Gemm g, const Sched& S, const Epi& E) {
    int tid_o = threadIdx.x; asm volatile("" : "+v"(tid_o)); const int tid = tid_o, wid = __builtin_amdgcn_readfirstlane(tid >> 6), lane = tid & 63, wr = wid >> 2, wc = wid & 3, fr = lane & 15, fq = lane >> 4;
    const int nt = g.K / BK; const char* gA_ = reinterpret_cast<const char*>(g.A); const char* gB_ = reinterpret_cast<const char*>(g.Bt); asm volatile("" : "+s"(gA_), "+s"(gB_));
    unsigned voffA[2], voffB[2];
#pragma unroll
    for (int i = 0; i < 2; ++i) { int R, C; stage_rc(tid * 16 + i * 8192, R, C); const int Rb = Epi::PERM ? ((R & ~31) + perm32(R & 31)) : R;
        voffA[i] = (unsigned)(R * g.lda + C) * 2u; voffB[i] = (unsigned)(Rb * g.ldb + C) * 2u; }
    const size_t kstep = (size_t)(BK * 2);
    const size_t hstepA = (size_t)HALF * g.lda * 2, hstepB = (size_t)HALF * g.ldb * 2;

    const unsigned ldsw = (unsigned)wid * 1024u;
    const int aoff = lds_byte(wr * 64 + fr, fq * 8), boff = lds_byte(wc * 32 + fr, fq * 8);
#define PG8_SA(b, h) (((b) * 2 + (h)) * HTB)
#define PG8_SB(b, h) ((4 + (b) * 2 + (h)) * HTB)
#define PG8_STAGE(bufoff, gbase, voff) do { _Pragma("unroll") for (int _i = 0; _i < 2; ++_i) \
        __builtin_amdgcn_global_load_lds((const unsigned*)((const char*)(gbase) + (voff)[_i]), (PG8_LAS unsigned*)(lds + (bufoff) + ldsw + _i * 8192), 16, 0, 0); } while (0)
#define PG8_LDA(dst, b, h) do { _Pragma("unroll") for (int m = 0; m < 4; ++m) _Pragma("unroll") for (int k = 0; k < 2; ++k) dst[m][k] = *(const PG8_LAS bf16x8*)(lds + PG8_SA(b, h) + aoff + m * 2048 + k * 1024); } while (0)
#define PG8_LDB(dst, b, h) do { _Pragma("unroll") for (int n = 0; n < 2; ++n) _Pragma("unroll") for (int k = 0; k < 2; ++k) dst[n][k] = *(const PG8_LAS bf16x8*)(lds + PG8_SB(b, h) + boff + n * 2048 + k * 1024); } while (0)
#define PG8_MMA(ai, bj, At, Bt) do { __builtin_amdgcn_s_setprio(1); _Pragma("unroll") for (int m = 0; m < 4; ++m) _Pragma("unroll") for (int n = 0; n < 2; ++n) _Pragma("unroll") for (int k = 0; k < 2; ++k) \
        acc[ai][bj][m][n] = __builtin_amdgcn_mfma_f32_16x16x32_bf16(Bt[n][k], At[m][k], acc[ai][bj][m][n], 0, 0, 0); __builtin_amdgcn_s_setprio(0); } while (0)
#define PG8_WAIT_V(n) asm volatile("s_waitcnt vmcnt(" #n ")" ::: "memory")
#define PG8_WAIT_L(n) asm volatile("s_waitcnt lgkmcnt(" #n ")" ::: "memory")
#define PG8_BAR __builtin_amdgcn_s_barrier()
#define PG8_SCHED __builtin_amdgcn_sched_barrier(0)
    Unit cur, nxt; int ui = 0;
    if (!S.next(0, cur)) return;
    f32x4 acc[2][2][4][2];
#pragma unroll
    for (int a = 0; a < 2; ++a)
#pragma unroll
        for (int b = 0; b < 2; ++b)
#pragma unroll
            for (int m = 0; m < 4; ++m)
#pragma unroll
                for (int n = 0; n < 2; ++n) acc[a][b][m][n] = (f32x4){0.f, 0.f, 0.f, 0.f};
    bf16x8 At[4][2], B0[2][2], B1[2][2];
    const char* cA = gA_ + (size_t)cur.pm * 2 * hstepA + (size_t)cur.z * g.zA; const char* cB = gB_ + (size_t)cur.pn * 2 * hstepB + (size_t)cur.z * g.zB;
    S.a_ready(cur);
    if constexpr (SP2) {
        PG8_STAGE(PG8_SB(0, 0), cB, voffB); PG8_STAGE(PG8_SB(0, 1), cB + hstepB, voffB); PG8_STAGE(PG8_SA(0, 0), cA, voffA); PG8_STAGE(PG8_SA(0, 1), cA + hstepA, voffA);
        if (wr == 1) PG8_BAR;
        PG8_WAIT_V(2); PG8_BAR;
        PG8_STAGE(PG8_SB(1, 0), cB + kstep, voffB); PG8_STAGE(PG8_SA(1, 0), cA + kstep, voffA); PG8_STAGE(PG8_SB(1, 1), cB + hstepB + kstep, voffB);
        PG8_WAIT_V(6); PG8_BAR;
    } else {
        PG8_STAGE(PG8_SB(0, 0), cB, voffB); PG8_STAGE(PG8_SA(0, 0), cA, voffA); PG8_STAGE(PG8_SB(0, 1), cB + hstepB, voffB); PG8_STAGE(PG8_SA(0, 1), cA + hstepA, voffA);
        if (wr == 1) PG8_BAR;
        PG8_WAIT_V(4); PG8_BAR;
        PG8_STAGE(PG8_SB(1, 0), cB + kstep, voffB); PG8_STAGE(PG8_SA(1, 0), cA + kstep, voffA); PG8_STAGE(PG8_SB(1, 1), cB + hstepB + kstep, voffB);
        PG8_WAIT_V(6); PG8_BAR;
    }
    for (;;) {
        const bool has_next = S.next(ui + 1, nxt);
        const char* nA = has_next ? gA_ + (size_t)nxt.pm * 2 * hstepA + (size_t)nxt.z * g.zA : cA; const char* nB = has_next ? gB_ + (size_t)nxt.pn * 2 * hstepB + (size_t)nxt.z * g.zB : cB;
_Pragma("nounroll")
        for (int t = 0; t < nt; t += 2) {
            const bool last = (t == nt - 2);
            const char* a1 = cA + (size_t)(t + 1) * kstep;
            const char* a2 = last ? nA : cA + (size_t)(t + 2) * kstep; const char* b2 = last ? nB : cB + (size_t)(t + 2) * kstep;
            const char* a3 = a2 + kstep; const char* b3 = b2 + kstep;
            if (last && has_next) S.a_ready(nxt);
            if constexpr (SP2) {
            PG8_LDB(B0, 0, 0); PG8_LDB(B1, 0, 1); PG8_SCHED; PG8_LDA(At, 0, 0); PG8_STAGE(PG8_SA(1, 1), a1 + hstepA, voffA);
            PG8_WAIT_V(8); PG8_WAIT_L(0); PG8_BAR; PG8_MMA(0, 0, At, B0); PG8_MMA(0, 1, At, B1); PG8_BAR; PG8_SCHED;
            PG8_LDA(At, 0, 1); PG8_STAGE(PG8_SB(0, 0), b2, voffB); PG8_STAGE(PG8_SB(0, 1), b2 + hstepB, voffB); PG8_STAGE(PG8_SA(0, 0), a2, voffA);
            PG8_WAIT_V(8); PG8_WAIT_L(0); PG8_BAR; PG8_MMA(1, 0, At, B0); PG8_MMA(1, 1, At, B1); PG8_BAR; PG8_SCHED;
            PG8_LDB(B0, 1, 0); PG8_LDB(B1, 1, 1); PG8_SCHED; PG8_LDA(At, 1, 0); PG8_STAGE(PG8_SA(0, 1), a2 + hstepA, voffA);
            PG8_WAIT_V(8); PG8_WAIT_L(0); PG8_BAR; PG8_MMA(0, 0, At, B0); PG8_MMA(0, 1, At, B1); PG8_BAR; PG8_SCHED;
            PG8_LDA(At, 1, 1); PG8_STAGE(PG8_SB(1, 0), b3, voffB); PG8_STAGE(PG8_SB(1, 1), b3 + hstepB, voffB); PG8_STAGE(PG8_SA(1, 0), a3, voffA);
            PG8_WAIT_V(8); PG8_WAIT_L(0); PG8_BAR; PG8_MMA(1, 0, At, B0); PG8_MMA(1, 1, At, B1); PG8_BAR; PG8_SCHED;
            } else {
            PG8_LDB(B0, 0, 0); PG8_SCHED; PG8_LDA(At, 0, 0); PG8_STAGE(PG8_SA(1, 1), a1 + hstepA, voffA);
            PG8_WAIT_L(8); PG8_BAR; PG8_WAIT_L(0); PG8_MMA(0, 0, At, B0); PG8_BAR; PG8_SCHED;
            PG8_LDB(B1, 0, 1); PG8_STAGE(PG8_SB(0, 0), b2, voffB);
            PG8_BAR; PG8_WAIT_L(0); PG8_MMA(0, 1, At, B1); PG8_BAR;
            PG8_LDA(At, 0, 1); PG8_STAGE(PG8_SA(0, 0), a2, voffA);
            PG8_BAR; PG8_WAIT_L(0); PG8_MMA(1, 0, At, B0); PG8_BAR; PG8_SCHED;
            PG8_STAGE(PG8_SB(0, 1), b2 + hstepB, voffB);
            PG8_WAIT_V(6); PG8_BAR; PG8_MMA(1, 1, At, B1); PG8_BAR;
            PG8_LDB(B0, 1, 0); PG8_SCHED; PG8_LDA(At, 1, 0); PG8_STAGE(PG8_SA(0, 1), a2 + hstepA, voffA);
            PG8_WAIT_L(8); PG8_BAR; PG8_WAIT_L(0); PG8_MMA(0, 0, At, B0); PG8_BAR; PG8_SCHED;
            PG8_LDB(B1, 1, 1); PG8_STAGE(PG8_SB(1, 0), b3, voffB);
            PG8_BAR; PG8_WAIT_L(0); PG8_MMA(0, 1, At, B1); PG8_BAR;
            PG8_LDA(At, 1, 1); PG8_STAGE(PG8_SA(1, 0), a3, voffA);
            PG8_BAR; PG8_WAIT_L(0); PG8_MMA(1, 0, At, B0); PG8_BAR; PG8_SCHED;
            PG8_STAGE(PG8_SB(1, 1), b3 + hstepB, voffB);
            PG8_WAIT_V(6); PG8_BAR; PG8_MMA(1, 1, At, B1); PG8_BAR;
            }
        }
        if constexpr (ALIGN_EPI) { if (wr == 0) PG8_BAR; }
        if constexpr (!Epi::AFTER_DRAIN) { E(acc, cur, wr, wc, fr, fq); S.done(cur); }
        if (!has_next) break;
#pragma unroll
        for (int a = 0; a < 2; ++a)
#pragma unroll
            for (int b = 0; b < 2; ++b)
#pragma unroll
                for (int m = 0; m < 4; ++m)
#pragma unroll
                    for (int n = 0; n < 2; ++n) acc[a][b][m][n] = (f32x4){0.f, 0.f, 0.f, 0.f};
        cur = nxt; cA = nA; cB = nB; ++ui;
        if constexpr (ALIGN_EPI) { if (wr == 1) PG8_BAR; }
    }
    PG8_WAIT_V(0);
    if constexpr (!ALIGN_EPI) { if (wr == 0) PG8_BAR; }
    PG8_BAR;
    if constexpr (Epi::AFTER_DRAIN) { E.fused(acc, cur, wr, wc, fr, fq, lds, wid, lane); S.done(cur); }
#undef PG8_SA
#undef PG8_SB
#undef PG8_STAGE
#undef PG8_LDA
#undef PG8_LDB
#undef PG8_MMA
#undef PG8_WAIT_V
#undef PG8_WAIT_L
#undef PG8_BAR
#undef PG8_SCHED
}
}
#include <hip/hip_bf16.h>
#include <cmath>
namespace attn_body {
using bf16=__hip_bfloat16;
using bf16x8=__attribute__((ext_vector_type(8)))short;
using s16x4=__attribute__((ext_vector_type(4)))short;
using f32x16=__attribute__((ext_vector_type(16)))float;
using u32x4=__attribute__((ext_vector_type(4)))unsigned;
using f32x4_t=__attribute__((ext_vector_type(4)))float;
constexpr int BATCH=1,NHEAD=8,SEQ=16384,D=64,DM=NHEAD*D;
constexpr int NW=8,QBLK=32,QB=QBLK*NW,KVBLK=64,NQB=SEQ/QB;
constexpr int ATTN_PITCH=DM, ATTN_UNIT_ROWS=QB;
__device__ __forceinline__ int crow(int r,int hi){return (r&3)+8*(r>>2)+4*hi;}
#define SBAR() __builtin_amdgcn_sched_barrier(0)
__device__ __forceinline__ void cmask(f32x16&p0,f32x16&p1,int jb,int qrel,int hi){
  const float NEG=-INFINITY; int kb=64*jb+4*hi;
  #pragma unroll
  for(int r=0;r<16;++r){int kv=kb+(r&3)+8*(r>>2); if(kv>qrel)p0[r]=NEG; if(kv+32>qrel)p1[r]=NEG;}
}

constexpr int NSLOT=3, SLOTB=8192;
constexpr int LDS_K=0, LDS_V=NSLOT*SLOTB, LDS_WS=2*NSLOT*SLOTB, LDS_OST=LDS_WS+NW*64*4, LDS_CK=LDS_OST+NW*4096, LDS_BYTES=LDS_CK+SEQ*4;
constexpr float C2=0.125f*1.4426950408889634f;
__device__ __forceinline__ void glds16(const void*gsrc,unsigned lds_dst){unsigned keep;
  asm volatile("s_mov_b32 %0, m0\n\ts_mov_b32 m0, %2\n\ts_nop 0\n\tglobal_load_lds_dwordx4 %1, off\n\ts_mov_b32 m0, %0":"=&s"(keep):"v"(gsrc),"s"(lds_dst):"memory");}
__device__ __forceinline__ float max3f(float a,float b,float c){float r;asm("v_max3_f32 %0, %1, %2, %3":"=v"(r):"v"(a),"v"(b),"v"(c));return r;}
__device__ __forceinline__ float max2f(float a,float b){float r;asm("v_max_f32_e32 %0, %1, %2":"=v"(r):"v"(a),"v"(b));return r;}
__device__ __forceinline__ float fadd_s(float a,float b){float r;asm("v_add_f32_e32 %0, %1, %2":"=v"(r):"v"(a),"v"(b));return r;}
__device__ __forceinline__ float fsub_s(float a,float b){float r;asm("v_sub_f32_e32 %0, %1, %2":"=v"(r):"v"(a),"v"(b));return r;}
typedef float f32x2_t __attribute__((ext_vector_type(2))); typedef __bf16 bf16x2_t __attribute__((ext_vector_type(2)));
__device__ __forceinline__ unsigned cvtpk_s(float lo,float hi){f32x2_t v={lo,hi};bf16x2_t b=__builtin_convertvector(v,bf16x2_t);return __builtin_bit_cast(unsigned,b);}
#define WAIT_BAR(N) asm volatile("s_waitcnt vmcnt(" #N ") lgkmcnt(0)\n\ts_barrier":::"memory")

__device__ __forceinline__ void qkt(f32x16&p0,f32x16&p1,const char*Kslot,const bf16x8*qr,const f32x16&negm,int r32,int hi){
  const char*kb=Kslot+hi*1024+r32*16;
  #pragma unroll
  for(int d0=0;d0<4;++d0){
    const bf16x8 b0=*reinterpret_cast<const bf16x8*>(kb+d0*2048);
    const bf16x8 b1=*reinterpret_cast<const bf16x8*>(kb+d0*2048+512);
    if(d0==0){p0=__builtin_amdgcn_mfma_f32_32x32x16_bf16(b0,qr[0],negm,0,0,0);p1=__builtin_amdgcn_mfma_f32_32x32x16_bf16(b1,qr[0],negm,0,0,0);}
    else{p0=__builtin_amdgcn_mfma_f32_32x32x16_bf16(b0,qr[d0],p0,0,0,0);p1=__builtin_amdgcn_mfma_f32_32x32x16_bf16(b1,qr[d0],p1,0,0,0);}}
}
typedef __attribute__((address_space(3))) const char* lds_cptr;
typedef short v4i16_t __attribute__((ext_vector_type(4)));
__device__ __forceinline__ void kload8(bf16x8*kf,lds_cptr kp){
  kf[0]=*(const __attribute__((address_space(3))) bf16x8*)(kp);      kf[1]=*(const __attribute__((address_space(3))) bf16x8*)(kp+512);
  kf[2]=*(const __attribute__((address_space(3))) bf16x8*)(kp+2048); kf[3]=*(const __attribute__((address_space(3))) bf16x8*)(kp+2560);
  kf[4]=*(const __attribute__((address_space(3))) bf16x8*)(kp+4096); kf[5]=*(const __attribute__((address_space(3))) bf16x8*)(kp+4608);
  kf[6]=*(const __attribute__((address_space(3))) bf16x8*)(kp+6144); kf[7]=*(const __attribute__((address_space(3))) bf16x8*)(kp+6656);
}
__device__ __forceinline__ void kload2(bf16x8*kf,lds_cptr kp,int j){ kf[2*j]=*(const __attribute__((address_space(3))) bf16x8*)(kp+j*2048); kf[2*j+1]=*(const __attribute__((address_space(3))) bf16x8*)(kp+j*2048+512); }
__device__ __forceinline__ s16x4 vtr(lds_cptr p){ return __builtin_bit_cast(s16x4,__builtin_amdgcn_ds_read_tr16_b64_v4i16((__attribute__((address_space(3))) v4i16_t*)p)); }
__device__ __forceinline__ float rowmax(const f32x16&p0,const f32x16&p1){
  float a=max3f(p0[0],p0[1],p1[0]),b=max3f(p0[2],p0[3],p1[1]);a=max3f(a,p1[2],p1[3]);
  #pragma unroll
  for(int r=4;r<16;r+=4){a=max3f(a,p0[r],p0[r+1]);b=max3f(b,p0[r+2],p0[r+3]);a=max3f(a,p1[r],p1[r+1]);b=max3f(b,p1[r+2],p1[r+3]);}
  const float m=max2f(a,b);
  auto rr=__builtin_amdgcn_permlane32_swap(__float_as_uint(m),__float_as_uint(m),false,false);
  return max2f(__uint_as_float(rr[0]),__uint_as_float(rr[1]));
}
__device__ __forceinline__ void pv(f32x16*o,int vb,bf16x8 pa0,bf16x8 pa1,bf16x8 pa2,bf16x8 pa3){
  #pragma unroll
  for(int d0=0;d0<2;++d0){s16x4 lo[4],hi[4];
    #pragma unroll
    for(int ks=0;ks<4;++ks){
      asm volatile("ds_read_b64_tr_b16 %0,%1 offset:%c2":"=&v"(lo[ks]):"v"(vb),"i"(d0*4096+ks*1024):"memory");
      asm volatile("ds_read_b64_tr_b16 %0,%1 offset:%c2":"=&v"(hi[ks]):"v"(vb),"i"(d0*4096+ks*1024+512):"memory");}
    asm volatile("s_waitcnt lgkmcnt(0)":::"memory");SBAR();
    #define PK(k) (bf16x8){lo[k][0],lo[k][1],lo[k][2],lo[k][3],hi[k][0],hi[k][1],hi[k][2],hi[k][3]}
    o[d0]=__builtin_amdgcn_mfma_f32_32x32x16_bf16(pa0,PK(0),o[d0],0,0,0);
    o[d0]=__builtin_amdgcn_mfma_f32_32x32x16_bf16(pa1,PK(1),o[d0],0,0,0);
    o[d0]=__builtin_amdgcn_mfma_f32_32x32x16_bf16(pa2,PK(2),o[d0],0,0,0);
    o[d0]=__builtin_amdgcn_mfma_f32_32x32x16_bf16(pa3,PK(3),o[d0],0,0,0);
    #undef PK
  }
}

#ifndef ATTN_STORE16
#define ATTN_STORE16(p,v) (*(u32x4*)(p)=(v))
#endif
template<int THRL> __device__ __forceinline__ void attn_unit(int b,int h,int qb,const bf16*Q,const bf16*__restrict__ K,const bf16*__restrict__ V,bf16*O,const float*__restrict__ CSg,const unsigned*KMg,char*shm,const int t0,const int ntl,const bool masked,float*__restrict__ Lout){
  int tid_o=threadIdx.x; asm volatile("":"+v"(tid_o)); const int tid=tid_o,lane=tid&63,r32=lane&31,hi=lane>>5; const int wid=__builtin_amdgcn_readfirstlane(tid>>6);
  const long rowbase=(long)b*SEQ; const int q0=qb*QB;
  const bf16*Qw=Q+(rowbase+q0+wid*QBLK)*DM+h*D;
  const bf16*Kh=K+(rowbase+(long)t0*KVBLK)*DM+h*D,*Vh=V+(rowbase+(long)t0*KVBLK)*DM+h*D;
  const unsigned lds0=(unsigned)(uintptr_t)shm;
  float*wsf=(float*)(shm+LDS_WS)+wid*64;
  const lds_cptr shm3=(lds_cptr)shm;
  const bf16*ksrc=Kh+(long)lane*DM+wid*8;
  const bf16*vsrc=Vh+(long)(16*(wid&3)+(lane>>2))*DM+(wid>>2)*32+(lane&3)*8;
  const unsigned kdst=lds0+LDS_K+wid*1024, vdst=lds0+LDS_V+wid*1024;
  #define DMA_K(t,slot) glds16(ksrc+(long)(t)*KVBLK*DM,(unsigned)__builtin_amdgcn_readfirstlane(kdst+(slot)))
  #define DMA_V(t,slot) glds16(vsrc+(long)(t)*KVBLK*DM,(unsigned)__builtin_amdgcn_readfirstlane(vdst+(slot)))
  const int vb0=(int)(lds0+LDS_V)+((lane>>4)&1)*32+(lane&3)*8+(4*hi+((lane&15)>>2))*64;
  const char*Kbase=shm+LDS_K; bf16x8 kf[8];
  const lds_cptr kp0=shm3+LDS_K+hi*1024+r32*16; const lds_cptr vp0=shm3+LDS_V+((lane>>4)&1)*32+(lane&3)*8+(4*hi+((lane&15)>>2))*64;
  const int NT=ntl;
  typedef __attribute__((address_space(3))) float* lds_fptr; typedef __attribute__((address_space(3))) f32x4_t* lds_f4ptr;
  const float*csh=CSg+(long)h*SEQ;
  { const lds_fptr ckw=(lds_fptr)(shm3+LDS_CK);
    for(int i=tid*4;i<ntl*KVBLK;i+=NW*64*4){ const f32x4_t v=*(const f32x4_t*)(csh+t0*KVBLK+i); *(lds_f4ptr)(ckw+i)=v; }
  }
  const float cq=csh[q0+wid*QBLK+r32];
  asm volatile("s_waitcnt vmcnt(0) lgkmcnt(0)\n\ts_barrier":::"memory");
  const lds_fptr ckt=(lds_fptr)(shm3+LDS_CK)+4*hi;
  #define CKSUB(P0,P1,t) do{ const lds_fptr ckp_=ckt+64*(t); _Pragma("unroll") for(int j_=0;j_<4;++j_){ const f32x4_t a_=*(const lds_f4ptr)(ckp_+8*j_); const f32x4_t b_=*(const lds_f4ptr)(ckp_+32+8*j_); \
      P0[4*j_]-=a_[0];P0[4*j_+1]-=a_[1];P0[4*j_+2]-=a_[2];P0[4*j_+3]-=a_[3]; P1[4*j_]-=b_[0];P1[4*j_+1]-=b_[1];P1[4*j_+2]-=b_[2];P1[4*j_+3]-=b_[3]; SBAR(); } }while(0)
  DMA_K(0,0);DMA_V(0,0);DMA_K(1,SLOTB);
  bf16x8 qr[4];
  #pragma unroll
  for(int d0=0;d0<4;++d0)qr[d0]=*reinterpret_cast<const bf16x8*>(&Qw[(long)r32*DM+d0*16+hi*8]);
  float l_reg=0.f;f32x16 o[2];o[0]=f32x16{};o[1]=f32x16{};f32x16 negm;
  {
    float q2=0.f;
    _Pragma("unroll") for(int d0=0;d0<4;++d0) _Pragma("unroll") for(int e=0;e<8;++e){ const float v=__uint_as_float(((unsigned)(unsigned short)qr[d0][e])<<16); q2+=v*v; }
    { auto rr=__builtin_amdgcn_permlane32_swap(__float_as_uint(q2),__float_as_uint(q2),false,false); q2=__uint_as_float(rr[0])+__uint_as_float(rr[1]); }
    const float km2=__uint_as_float(__hip_atomic_load(KMg+h,__ATOMIC_RELAXED,__HIP_MEMORY_SCOPE_AGENT));
    const float Rq=sqrtf(q2*km2)*1.001f+0.01f;
    _Pragma("unroll") for(int r=0;r<16;++r)negm[r]=cq-Rq; asm volatile("":"+v"(negm)); }
  const int qrel=wid*QBLK+r32;
  #define CMASK(P0,P1,t) do{int jb_=(t)-(NT-4); if(masked&&jb_>=0)cmask(P0,P1,jb_,qrel,hi);}while(0)
  #define START(P0,P1) do{ const float rm=rowmax(P0,P1); resc=false; \
    { const float dl=rm; mhat=fadd_s(mhat,dl); \
      _Pragma("unroll") for(int r=0;r<16;++r){P0[r]=fsub_s(P0[r],dl);P1[r]=fsub_s(P1[r],dl);} \
      _Pragma("unroll") for(int r=0;r<16;++r)negm[r]=-mhat; asm volatile("":"+v"(negm)); } \
    _Pragma("unroll") for(int r=0;r<16;++r)P0[r]=__builtin_amdgcn_exp2f(P0[r]); }while(0)
  #define RESC() do{ if(resc){ asm volatile("s_waitcnt lgkmcnt(0)":::"memory"); \
      _Pragma("unroll") for(int d_=0;d_<2;++d_) _Pragma("unroll") for(int r=0;r<16;++r)o[d_][r]*=wsf[crow(r,hi)]; } }while(0)
  f32x16 pA0,pA1,pB0,pB1;
  int sl_prev=0,sl_cur=0,sl_next=SLOTB;
  #define ROT() do{sl_prev=sl_cur;sl_cur=sl_next;sl_next=(sl_next==(NSLOT-1)*SLOTB)?0:sl_next+SLOTB;}while(0)
  DMA_K(2,2*SLOTB);
  WAIT_BAR(3);
  qkt(pA0,pA1,Kbase,qr,negm,r32,hi);asm volatile("s_nop 15\n\ts_nop 7":"+v"(pA0),"+v"(pA1));CKSUB(pA0,pA1,0);CMASK(pA0,pA1,0);
  _Pragma("unroll") for(int r=0;r<16;++r)pA0[r]=__builtin_amdgcn_exp2f(pA0[r]);
  _Pragma("unroll") for(int r=0;r<16;++r)pA1[r]=__builtin_amdgcn_exp2f(pA1[r]);
  WAIT_BAR(0);
  DMA_K(3,0);DMA_V(1,SLOTB);
  ROT();
  kload8(kf,kp0+sl_cur);
  WAIT_BAR(2);
  s16x4 vlo[8],vhi[8]; u32x4 pw0,pw1,pw2,pw3;
  #define PKW(P,B) cvtpk_s(P[B],P[B+1])
  #define PAF(k) __builtin_bit_cast(bf16x8,pw##k)
  #define VFR(i) (bf16x8){vlo[i][0],vlo[i][1],vlo[i][2],vlo[i][3],vhi[i][0],vhi[i][1],vhi[i][2],vhi[i][3]}
  #define PIN(x) asm volatile("":"+v"(x))
  #define MX3(a,b,c) __builtin_fmaxf(__builtin_fmaxf((a),(b)),(c))
  #define GAPA(MF,A0,A1,A2,A3,W0,W1,PW) do{ MF; sacc+=A0; sacc+=A1; sacc+=A2; sacc+=A3; PIN(sacc); W0; W1; PIN(PW); SBAR(); }while(0)
  #define EX(v) __builtin_amdgcn_exp2f(v)
  #define GAPB(MF,X,B,CUR,NXT,NOFF) do{ MF; if((NOFF)>=0){ NXT=*(const lds_f4ptr)(ckp_+((NOFF)>=0?(NOFF):0)); } X[B]=EX(X[B]-CUR[0]); X[B+1]=EX(X[B+1]-CUR[1]); X[B+2]=EX(X[B+2]-CUR[2]); X[B+3]=EX(X[B+3]-CUR[3]); PIN(X); SBAR(); }while(0)
  #define VRD(i) do{ vlo[i]=vtr(vp_+(((i)>>2)*4096+((i)&3)*1024)); vhi[i]=vtr(vp_+(((i)>>2)*4096+((i)&3)*1024+512)); }while(0)
  #define KRD(G,j) do{ if(G){ kload2(kf,kp0+sl_next,j); SBAR(); } }while(0)
  #define STEP(C0,C1,P0,P1,t,GK,GV,GL) do{ SBAR(); \
    const lds_cptr vp_=vp0+sl_prev; \
    VRD(0); SBAR(); float sacc=(P0[0]+P0[1]); \
    GAPA(C0=__builtin_amdgcn_mfma_f32_32x32x16_bf16(kf[0],qr[0],negm,0,0,0), P0[2],P0[3],P0[4],P0[5],     pw0[0]=PKW(P0,0), pw0[1]=PKW(P0,2), pw0); \
    VRD(4); SBAR(); GAPA(C1=__builtin_amdgcn_mfma_f32_32x32x16_bf16(kf[1],qr[0],negm,0,0,0), P0[6],P0[7],P0[8],P0[9],     pw0[2]=PKW(P0,4), pw0[3]=PKW(P0,6), pw0); \
    VRD(1); SBAR(); GAPA(C0=__builtin_amdgcn_mfma_f32_32x32x16_bf16(kf[2],qr[1],C0,0,0,0),   P0[10],P0[11],P0[12],P0[13], pw1[0]=PKW(P0,8), pw1[1]=PKW(P0,10), pw1); \
    VRD(5); SBAR(); GAPA(C1=__builtin_amdgcn_mfma_f32_32x32x16_bf16(kf[3],qr[1],C1,0,0,0),   P0[14],P0[15],P1[0],P1[1],   pw1[2]=PKW(P0,12),pw1[3]=PKW(P0,14), pw1); \
    VRD(2); SBAR(); GAPA(C0=__builtin_amdgcn_mfma_f32_32x32x16_bf16(kf[4],qr[2],C0,0,0,0),   P1[2],P1[3],P1[4],P1[5],     pw2[0]=PKW(P1,0), pw2[1]=PKW(P1,2), pw2); \
    VRD(6); SBAR(); GAPA(C1=__builtin_amdgcn_mfma_f32_32x32x16_bf16(kf[5],qr[2],C1,0,0,0),   P1[6],P1[7],P1[8],P1[9],     pw2[2]=PKW(P1,4), pw2[3]=PKW(P1,6), pw2); \
    VRD(3); SBAR(); GAPA(C0=__builtin_amdgcn_mfma_f32_32x32x16_bf16(kf[6],qr[3],C0,0,0,0),   P1[10],P1[11],P1[12],P1[13], pw3[0]=PKW(P1,8), pw3[1]=PKW(P1,10), pw3); \
    VRD(7); SBAR(); GAPA(C1=__builtin_amdgcn_mfma_f32_32x32x16_bf16(kf[7],qr[3],C1,0,0,0),   P1[14],P1[15],0.f,0.f,       pw3[2]=PKW(P1,12),pw3[3]=PKW(P1,14), pw3); \
    l_reg+=sacc; \
    if(GK){DMA_K((t)+3,sl_cur);} if(GV){DMA_V((t)+1,sl_next);} \
    CMASK(C0,C1,t); \
    const lds_fptr ckp_=ckt+64*(t); f32x4_t ckA_=*(const lds_f4ptr)(ckp_), ckB_; \
    SBAR(); \
    GAPB(o[0]=__builtin_amdgcn_mfma_f32_32x32x16_bf16(PAF(0),VFR(0),o[0],0,0,0), C0,0,ckA_,ckB_,8); \
    GAPB(o[1]=__builtin_amdgcn_mfma_f32_32x32x16_bf16(PAF(0),VFR(4),o[1],0,0,0), C0,4,ckB_,ckA_,16); \
    KRD(GL,0); GAPB(o[0]=__builtin_amdgcn_mfma_f32_32x32x16_bf16(PAF(1),VFR(1),o[0],0,0,0), C0,8,ckA_,ckB_,24); \
    KRD(GL,1); GAPB(o[1]=__builtin_amdgcn_mfma_f32_32x32x16_bf16(PAF(1),VFR(5),o[1],0,0,0), C0,12,ckB_,ckA_,32); \
    KRD(GL,2); GAPB(o[0]=__builtin_amdgcn_mfma_f32_32x32x16_bf16(PAF(2),VFR(2),o[0],0,0,0), C1,0,ckA_,ckB_,40); \
    KRD(GL,3); GAPB(o[1]=__builtin_amdgcn_mfma_f32_32x32x16_bf16(PAF(2),VFR(6),o[1],0,0,0), C1,4,ckB_,ckA_,48); \
    GAPB(o[0]=__builtin_amdgcn_mfma_f32_32x32x16_bf16(PAF(3),VFR(3),o[0],0,0,0), C1,8,ckA_,ckB_,56); \
    GAPB(o[1]=__builtin_amdgcn_mfma_f32_32x32x16_bf16(PAF(3),VFR(7),o[1],0,0,0), C1,12,ckB_,ckA_,-1); \
    }while(0)
  int t=1;
  #undef CMASK
  #define CMASK(P0,P1,t) do{}while(0)
  for(;t+5<NT;t+=2){
    STEP(pB0,pB1,pA0,pA1,t,true,true,true);     WAIT_BAR(2); ROT();
    STEP(pA0,pA1,pB0,pB1,t+1,true,true,true);   WAIT_BAR(2); ROT();
  }
  #undef CMASK
  #define CMASK(P0,P1,t) do{int jb_=(t)-(NT-4); if(masked&&jb_>=0)cmask(P0,P1,jb_,qrel,hi);}while(0)
  #define ENDW(tt) do{ if((tt)+3<NT){WAIT_BAR(2);} else if((tt)+2<NT){WAIT_BAR(1);} else {WAIT_BAR(0);} }while(0)
  for(;t+1<NT;t+=2){
    STEP(pB0,pB1,pA0,pA1,t,(t+3<NT),(t+1<NT),(t+1<NT));       ENDW(t); ROT();
    STEP(pA0,pA1,pB0,pB1,t+1,(t+4<NT),(t+2<NT),(t+2<NT));     ENDW(t+1); ROT();
  }
  STEP(pB0,pB1,pA0,pA1,NT-1,false,false,false);
  { float sacc=pB0[0]+pB0[1]; _Pragma("unroll") for(int r=2;r<16;++r)sacc+=pB0[r]; _Pragma("unroll") for(int r=0;r<16;++r)sacc+=pB1[r]; l_reg+=sacc;
    pw0=(u32x4){PKW(pB0,0),PKW(pB0,2),PKW(pB0,4),PKW(pB0,6)};pw1=(u32x4){PKW(pB0,8),PKW(pB0,10),PKW(pB0,12),PKW(pB0,14)};pw2=(u32x4){PKW(pB1,0),PKW(pB1,2),PKW(pB1,4),PKW(pB1,6)};pw3=(u32x4){PKW(pB1,8),PKW(pB1,10),PKW(pB1,12),PKW(pB1,14)};
    SBAR(); pv(o,vb0+sl_cur,PAF(0),PAF(1),PAF(2),PAF(3)); }
  #undef PKW
  #undef PAF
  #undef VFR
  #undef PIN
  #undef MX3
  #undef GAPA
  #undef GAPB
  #undef EX
  #undef VRD
  #undef KRD
  #undef STEP
  #undef ENDW
  {auto rr=__builtin_amdgcn_permlane32_swap(__float_as_uint(l_reg),__float_as_uint(l_reg),false,false);l_reg=__uint_as_float(rr[0])+__uint_as_float(rr[1]);}
  if(hi==0){wsf[32+r32]=l_reg; Lout[(long)(q0+wid*QBLK+r32)*NHEAD+h]=l_reg;}asm volatile("s_waitcnt lgkmcnt(0)":::"memory");
  float rli[16];
  #pragma unroll
  for(int r=0;r<16;++r){const float lv_=wsf[32+crow(r,hi)]; rli[r]=lv_>1e-30f?__builtin_amdgcn_rcpf(lv_):0.f;}
  bf16*Ow=O+(rowbase+q0+wid*QBLK)*DM+h*D;
  { bf16*stg=(bf16*)(shm+LDS_OST)+wid*2048;
    #pragma unroll
    for(int r=0;r<16;++r){const int orow=crow(r,hi);
      #pragma unroll
      for(int d0=0;d0<2;++d0)stg[orow*64+d0*32+r32]=__float2bfloat16(o[d0][r]*rli[r]);}
    asm volatile("s_waitcnt lgkmcnt(0)":::"memory");
    #pragma unroll
    for(int i=0;i<4;++i){const int row=i*8+(lane>>3),ch=lane&7; const u32x4 v=*(const u32x4*)(stg+row*64+ch*8); ATTN_STORE16(Ow+(long)row*DM+ch*8,v);} }
  asm volatile("s_waitcnt lgkmcnt(0)\n\ts_barrier":::"memory");
  #undef CKSUB
  #undef DMA_K
  #undef DMA_V
  #undef CMASK
  #undef START
  #undef RESC
  #undef ROT
}
constexpr int ATTN_LDS_BYTES=LDS_BYTES;
struct AttnTensors { const bf16* Q; const bf16* K; const bf16* V; bf16* O; const float* CS; const unsigned* KM; };
struct AttnUnit { int bh; int qb; };
struct StaticOrder {
  int vcu,G;
  __device__ __forceinline__ explicit StaticOrder(int grid,int block):vcu((grid%8==0)?(block%8)*(grid/8)+block/8:block),G(grid){}
  __device__ __forceinline__ bool next(int i,AttnUnit&u)const{
    if(G==256){ if(i>=2)return false; const int s=vcu&31; u.bh=vcu>>5; u.qb=(i==0)?s:63-s; return true; }
    const int Lx=i*G+vcu; if(Lx>=NHEAD*NQB)return false; u.bh=Lx/NQB; u.qb=NQB-1-(Lx%NQB); return true; }
  __device__ __forceinline__ void a_ready(const AttnUnit&)const{}
  __device__ __forceinline__ void done(const AttnUnit&)const{}
};
template<class Sched,int THRL=8> __device__ __forceinline__ void attn_phase(char*lds,const AttnTensors&T,const Sched&S){
  AttnUnit u;
  for(int i=0;S.next(i,u);++i){ S.a_ready(u); attn_unit<THRL>(0,u.bh,u.qb,T.Q,T.K,T.V,T.O,T.CS,T.KM,lds,0,4*(u.qb+1),true,(float*)nullptr); S.done(u); }
}
#undef SBAR
#undef WAIT_BAR
}
#define LAS __attribute__((address_space(3)))
typedef unsigned short bf16;
typedef unsigned v4u __attribute__((ext_vector_type(4)));
typedef unsigned v2u __attribute__((ext_vector_type(2)));
typedef float f32x4 __attribute__((ext_vector_type(4)));
typedef short bf16x8 __attribute__((ext_vector_type(8)));
constexpr int NWAVES = 8, NTHREADS = 512;
constexpr int M = 16384, D = 1024, FF = 2816, MEML = 256, DIN = 7176, NLAYER = 2;
constexpr float EPS = 1e-6f, LOG2E = 1.4426950408889634f;
constexpr int LDS_BYTES = 155648, XB_LDS_OFF = LDS_BYTES - 256, T0_LDS_OFF = 149504, RS_LDS_OFF = 131072 + 256;
static_assert(attn_body::ATTN_LDS_BYTES <= LDS_BYTES, "lds");
constexpr size_t MiB = 1u << 20;
constexpr size_t WS_SS = 1 * MiB, WS_SSV = 2 * MiB, WS_LF = 2 * MiB + 512 * 1024, WS_CS = 3 * MiB, WS_RSM = 3 * MiB + 512 * 1024, WS_MEMB = 4 * MiB, WS_KC = 4 * MiB + 512 * 1024, WS_VCT = 5 * MiB;
constexpr size_t WS_LPL = 5 * MiB + 512 * 1024, WS_LP = 66 * MiB + 256 * 1024;
constexpr size_t WS_W = 6 * MiB, WS_XB = 68 * MiB, WS_SCR = 100 * MiB, WS_WL = 244 * MiB, WS_VT2 = 246 * MiB, WS_END = 248 * MiB;
constexpr size_t WO_GU1 = 0, WO_D1 = WO_GU1 + (size_t)5632 * 1024, WO_IN = WO_D1 + (size_t)1024 * 2816, WO_G = WO_IN + (size_t)4096 * 1024, WO_B = WO_G + (size_t)3072 * 1024,
                 WO_O = WO_B + (size_t)3 * 1024 * 512, WO_Q = WO_O + (size_t)1024 * 1024, WO_K = WO_Q + (size_t)1024 * 1024, WO_V = WO_K + (size_t)1024 * 1024, WO_XO = WO_V + (size_t)1024 * 1024,
                 WO_GU2 = WO_XO + (size_t)1024 * 1024, WO_D2 = WO_GU2 + (size_t)5632 * 1024, WO_END = WO_D2 + (size_t)1024 * 2816;
static_assert(WS_W + (WO_END + 16 * 1024) * 2 <= WS_LP && WS_LP + 3 * 512 * 1024 <= WS_XB, "weights fit");
constexpr size_t PIECE = (size_t)M * 512;

typedef __attribute__((address_space(1))) unsigned gu32;
#define RLX_AGENT __ATOMIC_RELAXED, __HIP_MEMORY_SCOPE_AGENT
#define XB_TMO      128
#define XB_XCNT(j)  (256  + 64 * (j))
#define XB_XSUB(j)  (1280 + 64 * (j))
#define XB_XGEN(j)  (2304 + 64 * (j))
#define XB_TOP      3328
#define XB_TOPGEN   3392
#define XCD_BAR_WORDS 3456
#define XB_SPIN_CAP (1u << 18)

__device__ __forceinline__ unsigned xb_ld(unsigned* p)              { return __hip_atomic_load(p, __ATOMIC_RELAXED, __HIP_MEMORY_SCOPE_AGENT); }
__device__ __forceinline__ unsigned xb_add(unsigned* p, unsigned v) { return __hip_atomic_fetch_add(p, v, __ATOMIC_RELAXED, __HIP_MEMORY_SCOPE_AGENT); }
__device__ __forceinline__ unsigned xb_xcc_id() { return (unsigned)__builtin_amdgcn_s_getreg((3 << 11) | 20) & 0xFu; }
#define XB_SPIN(cond, bar) do { unsigned _sp = 0; while (cond) { __builtin_amdgcn_s_sleep(1); \
    if ((++_sp & 255u) == 0u) { if (xb_ld(&(bar)[XB_TMO])) break; if (_sp > XB_SPIN_CAP) { atomicAdd(&(bar)[XB_TMO], 1u); break; } } } } while (0)

struct XcdBarrier {
    unsigned* bar; unsigned x;
    volatile LAS unsigned* st;
};

__device__ __forceinline__ XcdBarrier xcd_barrier_post(unsigned* bar, volatile LAS unsigned* st) {
    XcdBarrier b; b.bar = bar; b.x = xb_xcc_id(); b.st = st;
    if (threadIdx.x == 0) (void)xb_add(&bar[XB_XCNT(b.x)], 1u);
    return b;
}
__device__ __forceinline__ void xcd_barrier_complete(unsigned* bar, unsigned x, unsigned& nloc, unsigned& nx) {
    const unsigned G = gridDim.x * gridDim.y * gridDim.z;
    unsigned sum, cnt, mine, sp = 0u;
    for (;;) {
        sum = 0u; cnt = 0u; mine = 0u;
#pragma unroll
        for (unsigned j = 0; j < 16; ++j) { const unsigned c = xb_ld(&bar[XB_XCNT(j)]); sum += c; cnt += (c > 0u) ? 1u : 0u; mine = (j == x) ? c : mine; }
        if (sum == G) break;
        __builtin_amdgcn_s_sleep(1);
        if ((++sp & 255u) == 0u) { if (xb_ld(&bar[XB_TMO])) break; if (sp > XB_SPIN_CAP) { atomicAdd(&bar[XB_TMO], 1u); break; } }
    }
    nloc = mine > 0u ? mine : 1u; nx = cnt > 0u ? cnt : 1u;
}

__device__ __forceinline__ void xcd_barrier(const XcdBarrier& b) {
    asm volatile("s_waitcnt vmcnt(0)" ::: "memory");
    __syncthreads();
    if (threadIdx.x == 0) {
        unsigned* bar = b.bar;
        __builtin_amdgcn_s_waitcnt(0);
        unsigned nloc = b.st[0], nx = b.st[1];
        if (nloc == 0u) { xcd_barrier_complete(bar, b.x, nloc, nx); b.st[0] = nloc; b.st[1] = nx; }
        const unsigned old = xb_add(&bar[XB_XSUB(b.x)], 1u);
        const unsigned gen = old / nloc;
        if (old + 1u == (gen + 1u) * nloc) {
            __builtin_amdgcn_fence(__ATOMIC_RELEASE, "agent");
            asm volatile("s_waitcnt vmcnt(0)" ::: "memory");
            const unsigned og = xb_add(&bar[XB_TOP], 1u);
            const unsigned tg = og / nx;
            if (og + 1u == (tg + 1u) * nx) xb_add(&bar[XB_TOPGEN], 1u);
            else XB_SPIN(xb_ld(&bar[XB_TOPGEN]) == tg, bar);
            __builtin_amdgcn_fence(__ATOMIC_ACQUIRE, "agent");
            xb_add(&bar[XB_XGEN(b.x)], 1u);
            asm volatile("s_waitcnt vmcnt(0)" ::: "memory");
        } else {
            XB_SPIN(xb_ld(&bar[XB_XGEN(b.x)]) == gen, bar);
            __builtin_amdgcn_fence(__ATOMIC_ACQUIRE, "agent");
            asm volatile("s_waitcnt vmcnt(0)" ::: "memory");
        }
    }
    __syncthreads();
}
struct Args { const float* in[26]; float* out; unsigned char* ws; int ph_lo, ph_hi; };

__device__ __forceinline__ unsigned f2bf(float f) { unsigned u = __builtin_bit_cast(unsigned, f); return (u + 0x7fffu + ((u >> 16) & 1u)) >> 16; }
__device__ __forceinline__ unsigned pk2(float lo, float hi) { return f2bf(lo) | (f2bf(hi) << 16); }
__device__ __forceinline__ float b2f(unsigned short b) { return __uint_as_float((unsigned)b << 16); }
__device__ __forceinline__ float wave_sum(float v) {
#pragma unroll
    for (int o = 1; o < 64; o <<= 1) v += __shfl_xor(v, o);
    return v;
}
#define LDS_WAIT() asm volatile("s_waitcnt lgkmcnt(0)" ::: "memory")
__device__ __forceinline__ void conv_item(const float* W, int spitch, int k0, int n0, bf16* WT, int dpitch, int drow0, const float* gain, LAS float* scr, int lane) {
#pragma unroll
    for (int i = 0; i < 32; ++i) { const int kk = 2 * i + (lane >> 5); float v = W[(size_t)(k0 + kk) * spitch + n0 + (lane & 31)]; if (gain) v *= gain[k0 + kk]; scr[kk * 33 + (lane & 31)] = v; }
    LDS_WAIT(); asm volatile("" ::: "memory");
    const int c = lane & 7;
#pragma unroll
    for (int j = 0; j < 4; ++j) { const int n = (lane >> 3) + 8 * j; const LAS float* s = scr + (8 * c) * 33 + n;
        v4u o; o.x = pk2(s[0 * 33], s[1 * 33]); o.y = pk2(s[2 * 33], s[3 * 33]); o.z = pk2(s[4 * 33], s[5 * 33]); o.w = pk2(s[6 * 33], s[7 * 33]);
        *(v4u*)(WT + (size_t)(drow0 + n) * dpitch + k0 + 8 * c) = o; }
    LDS_WAIT(); asm volatile("" ::: "memory");
}
__device__ __forceinline__ void conv_job(int& it, int& base, int NGW, const float* W, int spitch, int K, int scol0, int ncols, bf16* WT, int doff, bool ilv, const float* gain, LAS float* scr, int lane) {
    const int nblk = ncols / 32, nitems = (K / 64) * nblk;
    for (; it < base + nitems; it += NGW) { const int r = it - base, kb = r / nblk, nb = r % nblk, nl = 32 * nb;
        const int drow0 = ilv ? (256 * (nl / 128) + (nl % 128) + doff) : (doff + nl);
        conv_item(W, spitch, 64 * kb, scol0 + nl, WT, K, drow0, gain, scr, lane); }
    base += nitems;
}

__device__ __forceinline__ void panel_rstd(const float* SSp, int pm, LAS float* rsl, int tid) {
    if (tid < 256) { const f32x4* p4 = (const f32x4*)(SSp + (size_t)(pm * 256 + tid) * 16); const f32x4 a = p4[0], b = p4[1], c = p4[2], d = p4[3];
        const float s = ((a[0] + a[1]) + (a[2] + a[3])) + ((b[0] + b[1]) + (b[2] + b[3])) + ((c[0] + c[1]) + (c[2] + c[3])) + ((d[0] + d[1]) + (d[2] + d[3]));
        rsl[tid] = rsqrtf(s * (1.0f / 1024.0f) + 1e-6f); }
    __syncthreads();
}
__device__ __forceinline__ int attn_skip_tiles(const float* csh, int qb, float R) {
    const int lim = 4 * (qb + 1) - 4; const float thr = csh[256 * qb] + 152.0f + 2.0f * R;
    int seg = 0, cnt = 0;
#pragma unroll
    for (int j = 0; j < 16; ++j) { const int tl = 16 * j + 15; const float cv = csh[64 * (tl < lim ? tl : 0) + 63]; seg += (tl < lim && cv > thr) ? 1 : 0; }
#pragma unroll
    for (int i = 0; i < 16; ++i) { const int tl = 16 * seg + i; const float cv = csh[64 * (tl < lim ? tl : 0) + 63]; cnt += (tl < lim && cv > thr) ? 1 : 0; }
    return (16 * seg + cnt) & ~1;
}
__device__ __forceinline__ int attn_chunks(int len) { int n = (len + 63) >> 6; if (n > 1 && len - 64 * (n - 1) < 4) --n; return n; }
__global__ void __launch_bounds__(NTHREADS, 2) mk_fwd(Args args) {
    __builtin_assume(__builtin_amdgcn_workitem_id_y() == 0); __builtin_assume(__builtin_amdgcn_workitem_id_z() == 0);
    extern __shared__ __attribute__((aligned(16))) unsigned char lds[];
    cg::grid_group grid = cg::this_grid();
    LAS unsigned char* ldsp = (LAS unsigned char*)lds;
    if (threadIdx.x < 2) ((volatile LAS unsigned*)(ldsp + XB_LDS_OFF))[threadIdx.x] = 0u;
    __syncthreads();
    const XcdBarrier xbar = xcd_barrier_post((unsigned*)args.ws, (volatile LAS unsigned*)(ldsp + XB_LDS_OFF));
    const int G = gridDim.x, bx = blockIdx.x;
    const int vcu = (G % 8 == 0) ? (bx % 8) * (G / 8) + bx / 8 : bx;
    const int NGW = G * NWAVES;
#define TIDS() int tid_o = threadIdx.x; asm volatile("" : "+v"(tid_o)); const int tid = tid_o, lane = tid & 63, wave = __builtin_amdgcn_readfirstlane(tid >> 6), gw = vcu * NWAVES + wave; (void)gw; (void)lane; (void)tid
#ifdef MK_TIME_A
    unsigned char* const tsbase = args.ws + 49152;
#endif
#define KARGS() const __attribute__((address_space(4))) Args* ap_ = (const __attribute__((address_space(4))) Args*)__builtin_amdgcn_kernarg_segment_ptr(); asm volatile("" : "+s"(ap_))
#define ws (ap_->ws)
#define X (ap_->out)
#define SS ((float*)(ws + WS_SS))
#define SSV ((float*)(ws + WS_SSV))
#define LF ((float*)(ws + WS_LF))
#define CS ((float*)(ws + WS_CS))
#define RSM ((float*)(ws + WS_RSM))
#define MEMB ((bf16*)(ws + WS_MEMB))
#define KC ((bf16*)(ws + WS_KC))
#define VCT ((bf16*)(ws + WS_VCT))
#define Wt ((bf16*)(ws + WS_W))
#define XB ((bf16*)(ws + WS_XB))
#define SCR ((bf16*)(ws + WS_SCR))
#define WL ((bf16*)(ws + WS_WL))
#define VT2 ((bf16*)(ws + WS_VT2))
#define ACT SCR
#define PROJ SCR
#define GT (SCR + 3 * PIECE)
#define XQ SCR
#define PB (SCR + (size_t)M * 1024)
#define OB (SCR + (size_t)2 * M * 1024)
    const int lo = args.ph_lo, hi = args.ph_hi;
    if (lo < 0) grid.sync();
#ifndef PHMASK
#define PHMASK 0xffff
#endif
#define IN(k) (((PHMASK >> (((k) == 30) ? 15 : ((k) - pb == 13 || (k) - pb == 14) ? (k) - pb - 12 : (k) - pb)) & 1) && lo <= (k) && (k) < hi)
#define GRID_SYNC() do { asm volatile("s_waitcnt vmcnt(0) lgkmcnt(0)" ::: "memory"); grid.sync(); } while (0)
#define WG_SEAM() do { asm volatile("s_waitcnt vmcnt(0) lgkmcnt(0)" ::: "memory"); __syncthreads(); } while (0)
#define SEAM_LOCAL(k) do { if (lo <= (k) && (k) + 1 < hi) { if (G == 256) WG_SEAM(); else xcd_barrier(xbar); } } while (0)
#ifdef MK_TIME_A
#define STAMP(k) do { if (blockIdx.x == 0 && threadIdx.x == 0) __hip_atomic_store((unsigned long long*)tsbase + (k) + 1, (unsigned long long)__builtin_amdgcn_s_memrealtime(), __ATOMIC_RELAXED, __HIP_MEMORY_SCOPE_AGENT); } while (0)
#else
#define STAMP(k) do { } while (0)
#endif
#define SEAM(k) do { if (lo <= (k) && (k) + 1 < hi) { xcd_barrier(xbar); STAMP(k); } } while (0)
#define in (ap_->in)
#define CONV_TILE(it) \
            do { \
                int r = it; const float* W; const float* gain = nullptr; bf16* WT; int spitch, K, scol0 = 0, nblk, doff = 0; bool ilv = false, notr = false; \
                if (r < 2 * I_UP) { const int w = r / I_UP; r -= w * I_UP; W = in[3 + w] + lff; gain = in[2] + l1; WT = Wt + WO_GU1; spitch = FF; K = 1024; nblk = 11; doff = 128 * w; ilv = true; } \
                else if ((r -= 2 * I_UP) < 2 * I_SQ) { const int w = r / I_SQ; r -= w * I_SQ; W = in[18 + w] + ldd; gain = in[16] + l1; WT = Wt + WO_K + (size_t)w * 1024 * 1024; spitch = 1024; K = 1024; nblk = 4; } \
                else if ((r -= 2 * I_SQ) < I_DN) { W = in[5] + lff; WT = Wt + WO_D1; spitch = 1024; K = FF; nblk = 4; } \
                else if ((r -= I_DN) < I_IN) { W = in[7] + (size_t)l * 1024 * DIN; gain = in[6] + l1; WT = Wt + WO_IN; spitch = DIN; K = 1024; nblk = 16; } \
                else if ((r -= I_IN) < I_G) { W = in[7] + (size_t)l * 1024 * DIN; gain = in[6] + l1; WT = Wt + WO_G; spitch = DIN; K = 1024; nblk = 12; scol0 = 4104; } \
                else if ((r -= I_G) < 3 * I_B) { const int w = r / I_B; r -= w * I_B; W = in[13] + ((size_t)l * 3 + w) * 512 * 1024; WT = Wt + WO_B + (size_t)w * 1024 * 512; spitch = 1024; K = 512; nblk = 4; } \
                else if ((r -= 3 * I_B) < I_SQ) { W = in[14] + ldd; WT = Wt + WO_O; spitch = 1024; K = 1024; nblk = 4; } \
                else if ((r -= I_SQ) < I_SQ) { W = in[17] + ldd; gain = in[15] + l1; WT = Wt + WO_Q; spitch = 1024; K = 1024; nblk = 4; notr = true; } \
                else if ((r -= I_SQ) < I_SQ) { W = in[20] + ldd; WT = Wt + WO_XO; spitch = 1024; K = 1024; nblk = 4; } \
                else if ((r -= I_SQ) < 2 * I_UP) { const int w = r / I_UP; r -= w * I_UP; W = in[22 + w] + lff; gain = in[21] + l1; WT = Wt + WO_GU2; spitch = FF; K = 1024; nblk = 11; doff = 128 * w; ilv = true; } \
                else { r -= 2 * I_UP; W = in[24] + lff; WT = Wt + WO_D2; spitch = 1024; K = FF; nblk = 4; } \
                const int k0 = 64 * (r / nblk), nl0 = 256 * (r % nblk); \
                if (notr) { \
_Pragma("unroll") \
                    for (int i = 0; i < 8; ++i) { const int kr = k0 + 8 * wave + i; const f32x4 v = __builtin_nontemporal_load((const f32x4*)(W + (size_t)kr * spitch + nl0 + 4 * lane)) * gain[kr]; \
                        v2u o; o.x = pk2(v[0], v[1]); o.y = pk2(v[2], v[3]); *(v2u*)(WT + (size_t)kr * 1024 + nl0 + 4 * lane) = o; } \
                    continue; \
                } \
                { \
                    f32x4 v[8]; \
_Pragma("unroll") \
                    for (int i = 0; i < 8; ++i) v[i] = __builtin_nontemporal_load((const f32x4*)(W + (size_t)(k0 + 8 * wave + i) * spitch + scol0 + nl0 + 4 * lane)); \
_Pragma("unroll") \
                    for (int i = 0; i < 8; ++i) { const float gk = gain ? gain[k0 + 8 * wave + i] : 1.0f; *(LAS f32x4*)(Tl + (8 * wave + i) * 260 + 4 * lane) = v[i] * gk; } \
                } \
                __syncthreads(); \
                { \
                    const int n = tid & 255, kh = tid >> 8, nl = nl0 + n; \
                    const int drow = ilv ? (256 * (nl / 128) + (nl % 128) + doff) : (doff + nl); \
                    v4u o[4]; \
_Pragma("unroll") \
                    for (int q = 0; q < 4; ++q) \
_Pragma("unroll") \
                        for (int e = 0; e < 4; ++e) o[q][e] = pk2(Tl[(32 * kh + 8 * q + 2 * e) * 260 + n], Tl[(32 * kh + 8 * q + 2 * e + 1) * 260 + n]); \
_Pragma("unroll") \
                    for (int q = 0; q < 4; ++q) *(v4u*)(WT + (size_t)drow * K + k0 + 32 * kh + 8 * q) = o[q]; \
                } \
                __syncthreads(); \
            } while (0)
STAMP(-1);
int pb = 0;
#pragma nounroll
    for (int l = 0; l < NLAYER; ++l) {
        pb = 15 * l;
        if (IN(pb + 0)) { KARGS(); TIDS();
#ifndef MK_REP_P0
#define MK_REP_P0 1
#endif
_Pragma("nounroll")
          for (int rep0 = 0; rep0 < MK_REP_P0; ++rep0) {
            const size_t l1 = (size_t)l * 1024, lff = (size_t)l * 1024 * 2816, ldd = (size_t)l * 1024 * 1024;
            constexpr int I_UP = 16 * 11, I_DN = 44 * 4, I_IN = 16 * 16, I_G = 16 * 12, I_B = 8 * 4, I_SQ = 16 * 4;
            constexpr int NIT = 4 * I_UP + 2 * I_DN + I_IN + I_G + 3 * I_B + 5 * I_SQ, NE0 = 480;
            const int NE = (G == 256) ? 960 : 0;
            LAS float* Tl = (LAS float*)ldsp;
#pragma nounroll
            for (int jt = vcu; jt < NIT - NE; jt += G) { const int it = jt < NE0 ? jt : jt + NE; CONV_TILE(it); }
            {
                const float* wf = in[7] + (size_t)l * 1024 * DIN + 4096; const float* gn = in[6] + l1; bf16* WF = Wt + WO_END;
                for (int idx = vcu * NTHREADS + tid; idx < 8192; idx += G * NTHREADS) { const int k = idx >> 3, hd = idx & 7;
                    const float v = wf[(size_t)k * DIN + hd] * gn[k]; const unsigned hb = f2bf(v); const float lo = v - __uint_as_float(hb << 16);
                    WF[(size_t)hd * 1024 + k] = (bf16)hb; WF[(size_t)(8 + hd) * 1024 + k] = (bf16)f2bf(lo); }
            }
            if (l == 0) {
                for (int m0 = gw; m0 < M + MEML; m0 += 4 * NGW) {
                    f32x4 v[4][4];
#pragma unroll
                    for (int i = 0; i < 4; ++i) { const int m = (m0 + i * NGW < M + MEML) ? m0 + i * NGW : m0; const bool ism = m >= M; const int r = ism ? m - M : m;
                        const f32x4* xr = (const f32x4*)((ism ? in[1] : in[0]) + (size_t)r * D) + lane;
#pragma unroll
                        for (int j = 0; j < 4; ++j) v[i][j] = __builtin_nontemporal_load(xr + 64 * j); }
                    asm volatile("" ::: "memory");
#pragma unroll
                    for (int i = 0; i < 4; ++i) { const int m = m0 + i * NGW; if (m >= M + MEML) break; const bool ism = m >= M; const int r = ism ? m - M : m;
                        float s = 0.f;
#pragma unroll
                        for (int j = 0; j < 4; ++j) s += (v[i][j][0] * v[i][j][0] + v[i][j][1] * v[i][j][1]) + (v[i][j][2] * v[i][j][2] + v[i][j][3] * v[i][j][3]);
                        s = wave_sum(s);
                        v2u* ob = (v2u*)((ism ? MEMB : XB) + (size_t)r * D) + lane;
#pragma unroll
                        for (int j = 0; j < 4; ++j) { v2u w; w.x = pk2(v[i][j][0], v[i][j][1]); w.y = pk2(v[i][j][2], v[i][j][3]); ob[64 * j] = w; }
                        if (!ism) {
                            if (lane < 16) SS[(size_t)r * 16 + lane] = lane == 0 ? s : 0.f;
                        } else if (lane == 0) RSM[r] = rsqrtf(s * (1.0f / D) + EPS);
                    }
                }
            }
          }
        }
        SEAM(pb + 0);
#pragma nounroll
        for (int f = 0; f < 2; ++f) {
            const int pu = pb + (f == 0 ? 1 : 13), pd = pu + 1;
            if (IN(pu)) { KARGS();
                { pg8::Gemm g{XB, Wt + (f == 0 ? WO_GU1 : WO_GU2), 1024, 1024, 1024, 0, 0}; pg8::StaticOrder S; S.init(M / 256, 22, G, bx);
                  LAS float* rsl = nullptr; if (G == 256) { TIDS(); pg8::Unit u0; S.map(bx, u0); rsl = (LAS float*)(ldsp + RS_LDS_OFF); panel_rstd(SS, u0.pm, rsl, tid); }
                  pg8::EpiSwiGLU E{SS, rsl, ACT};
#ifndef MK_REP_UP
#define MK_REP_UP 1
#endif
_Pragma("nounroll")
                  for (int rep = 0; rep < MK_REP_UP; ++rep) pg8::gemm_phase<pg8::EpiSwiGLU, pg8::StaticOrder, true, true>(ldsp, g, S, E); }
                if (f == 0 && G == 256 && bx >= 136) {
                    TIDS(); const size_t l1 = (size_t)l * 1024, lff = (size_t)l * 1024 * 2816, ldd = (size_t)l * 1024 * 1024;
                    constexpr int I_UP = 16 * 11, I_DN = 44 * 4, I_IN = 16 * 16, I_G = 16 * 12, I_B = 8 * 4, I_SQ = 16 * 4;
                    LAS float* Tl = (LAS float*)ldsp;
#pragma nounroll
                    for (int jj = 0; jj < 8; ++jj) { const int it = 480 + (bx - 136) + 120 * jj; CONV_TILE(it); }
                }
                if (f == 0) {
                    { pg8::Gemm g{MEMB, Wt + WO_K, 1024, 1024, 1024, 0, 0}; pg8::StaticOrder S; S.init(1, 4, G, (bx + G - 128 % G) % G);
                      pg8::EpiScale<2> E{RSM, KC, 1024, 1.0f}; pg8::gemm_phase<pg8::EpiScale<2>, pg8::StaticOrder, true, true>(ldsp, g, S, E); }
                    { pg8::Gemm g{MEMB, Wt + WO_V, 1024, 1024, 1024, 0, 0}; pg8::StaticOrder S; S.init(1, 4, G, (bx + G - 132 % G) % G);
                      pg8::EpiScale<2> E{RSM, VCT, 1024, 1.0f}; pg8::gemm_phase<pg8::EpiScale<2>, pg8::StaticOrder, true, true>(ldsp, g, S, E); }
                }
            }
            SEAM(pu);
            if (IN(pd)) { KARGS();
                pg8::Gemm g{ACT, Wt + (f == 0 ? WO_D1 : WO_D2), FF, FF, FF, 0, 0}; pg8::StaticOrder S; S.init(M / 256, 4, G, bx);
                pg8::EpiResid E{XB, SS, 0.5f}; pg8::gemm_phase<pg8::EpiResid, pg8::StaticOrder, true, true>(ldsp, g, S, E);
            }
            SEAM(pd);
            if (f == 1) break;
            if (IN(pb + 3)) { KARGS();
                { TIDS();
                    const float* bfp = in[12] + l * 8; const bf16* WF = Wt + WO_END; const int fr = lane & 15, fq = lane >> 4;
                    if ((wave & 1) == 0) for (int tile = vcu * 4 + (wave >> 1); tile < M / 16; tile += G * 4) {
                        const int row = 16 * tile + fr;
                        const bf16* ap = XB + (size_t)row * D + 8 * fq; const bf16* bp = WF + (size_t)fr * D + 8 * fq;
                        f32x4 acc = {0.f, 0.f, 0.f, 0.f};
#pragma unroll 16
                        for (int ks = 0; ks < 32; ++ks) { const bf16x8 a = *(const bf16x8*)(ap + 32 * ks), b = *(const bf16x8*)(bp + 32 * ks); acc = __builtin_amdgcn_mfma_f32_16x16x32_bf16(b, a, acc, 0, 0, 0); }
                        const float rs = pg8::row_rstd1(SS, row, fq);
#pragma unroll
                        for (int j = 0; j < 4; ++j) { const float t = acc[j] + __shfl_xor(acc[j], 32);
                            if (fq < 2) { const int hd = 4 * fq + j; const float z = t * rs + bfp[hd]; LF[(size_t)hd * M + row] = fminf(z, 0.f) - log1pf(expf(-fabsf(z))); } }
                    }
                }
                pg8::Gemm g{XB, Wt + WO_IN, 1024, 1024, 1024, 0, 0}; pg8::StaticOrder S; S.init(M / 256, 16, G, bx);
                LAS float* rsl = nullptr; if (G == 256) { int t_ = threadIdx.x; asm volatile("" : "+v"(t_)); pg8::Unit u0; S.map(bx, u0); rsl = (LAS float*)(ldsp + RS_LDS_OFF); panel_rstd(SS, u0.pm, rsl, t_); }
                pg8::EpiWin E{SS, rsl, PROJ, SSV, 0.125f * LOG2E}; pg8::gemm_phase<pg8::EpiWin, pg8::StaticOrder, true, true>(ldsp, g, S, E);
            }
            SEAM(pb + 3);
            if (IN(pb + 4)) { KARGS(); TIDS();
                if (bx < 8) {
                    const float* lf = LF + (size_t)bx * M + tid * 32; float* cs = CS + (size_t)bx * M + tid * 32;
                    f32x4 v[8]; float run = 0.f;
#pragma unroll
                    for (int i = 0; i < 8; ++i) { v[i] = *(const f32x4*)(lf + 4 * i);
#pragma unroll
                        for (int e = 0; e < 4; ++e) { run += v[i][e]; v[i][e] = run; } }
                    const double tot = (double)run; double incl = tot;
#pragma unroll
                    for (int o = 1; o < 64; o <<= 1) { const double t = __shfl_up(incl, o); if (lane >= o) incl += t; }
                    LAS double* wsum = (LAS double*)ldsp;
                    if (lane == 63) wsum[wave] = incl;
                    __syncthreads();
                    double bsum = 0.0;
                    for (int w = 0; w < wave; ++w) bsum += wsum[w];
                    const double excl = bsum + incl - tot;
#pragma unroll
                    for (int i = 0; i < 8; ++i) { f32x4 o;
#pragma unroll
                        for (int e = 0; e < 4; ++e) o[e] = (float)((excl + (double)v[i][e]) * 1.4426950408889634);
                        *(f32x4*)(cs + 4 * i) = o; }
                    __syncthreads();
                }
                {
                    unsigned* KM = (unsigned*)(ws + 32768) + 8 * l; unsigned* lmx = (unsigned*)(lds + XB_LDS_OFF + 128);
                    if (tid < 16) lmx[tid] = 0u;
                    __syncthreads();
                    {
                        float mk = 0.f, mq = 0.f;
#pragma unroll 8
                        for (int r2 = gw; r2 < 2 * M; r2 += NGW) { const int isq = r2 >= M, row = r2 - isq * M;
                            const v4u w = *((const v4u*)(PROJ + (isq ? 8 : 6) * PIECE + (size_t)row * 512) + lane); float s = 0.f;
#pragma unroll
                            for (int e = 0; e < 4; ++e) { const float a = pg8::bflo(w[e]), b = pg8::bfhi(w[e]); s += a * a + b * b; }
                            s += __shfl_xor(s, 1); s += __shfl_xor(s, 2); s += __shfl_xor(s, 4);
                            if (isq) mq = fmaxf(mq, s); else mk = fmaxf(mk, s); }
                        if ((lane & 7) == 0) { atomicMax(lmx + (lane >> 3), __float_as_uint(mk)); atomicMax(lmx + 8 + (lane >> 3), __float_as_uint(mq)); }
                    }
                    __syncthreads();
                    if (tid < 16) atomicMax(KM + 64 * (tid >> 3) + (tid & 7), lmx[tid]);
                }
                {
                    bf16* AB = PROJ; const bf16* AC = PROJ + 3 * PIECE; const bf16* AH = PROJ + 4 * PIECE; const float* cw = in[8] + (size_t)l * 3 * 512;
                    const int c8 = (tid & 63) * 8;
#pragma nounroll
                    for (int t0 = vcu * 8 + (tid >> 6); t0 < M; t0 += 2 * G * 8) {
                        v4u bw[2], cv[2][3], hv[2][3];
#pragma unroll
                        for (int h2 = 0; h2 < 2; ++h2) { const int t = (t0 + h2 * G * 8 < M) ? t0 + h2 * G * 8 : t0; const size_t off = (size_t)t * 512 + c8;
                            bw[h2] = *(const v4u*)(AB + off);
#pragma unroll
                            for (int d = 0; d < 3; ++d) { const size_t od = (t - d >= 0) ? off - (size_t)d * 512 : off;
                                cv[h2][d] = *(const v4u*)(AC + od); hv[h2][d] = *(const v4u*)(AH + od); if (t - d < 0) cv[h2][d] = (v4u){0u, 0u, 0u, 0u}; } }
                        asm volatile("" ::: "memory");
#pragma unroll
                        for (int h2 = 0; h2 < 2; ++h2) { const int t = t0 + h2 * G * 8; if (t >= M) continue; const size_t off = (size_t)t * 512 + c8;
                            float y[8];
#pragma unroll
                            for (int e = 0; e < 8; ++e) { const int w = e >> 1; const bool hi_ = e & 1;
                                const float b = hi_ ? pg8::bfhi(bw[h2][w]) : pg8::bflo(bw[h2][w]);
                                float z[3];
#pragma unroll
                                for (int d = 0; d < 3; ++d) z[d] = hi_ ? pg8::bfhi(cv[h2][d][w]) * pg8::bfhi(hv[h2][d][w]) : pg8::bflo(cv[h2][d][w]) * pg8::bflo(hv[h2][d][w]);
                                y[e] = b * (cw[c8 + e] * z[2] + cw[512 + c8 + e] * z[1] + cw[1024 + c8 + e] * z[0]); }
                            v4u o; o.x = pk2(y[0], y[1]); o.y = pk2(y[2], y[3]); o.z = pk2(y[4], y[5]); o.w = pk2(y[6], y[7]);
                            *(v4u*)(AB + off) = o; }
                    }
                }
                {
                    bf16* UU = PROJ + 1 * PIECE; const bf16* VV = PROJ + 5 * PIECE; const float* sgn = in[9] + (size_t)l * 512; const float* sgw = in[10] + (size_t)l * 4 * 128 * 128; const float* sgb = in[11] + (size_t)l * 4 * 128;
                    LAS bf16* T = (LAS bf16*)ldsp;
                    const int fr = lane & 15, fq = lane >> 4;
                    for (int unit = vcu; unit < 512; unit += G) {
                        const int n = unit >> 2, gI = unit & 3;
                        const int t = 16 * wave + fr;
                        f32x4 wpre[4][2];
#pragma unroll
                        for (int kk = 0; kk < 4; ++kk) { const float* wp = sgw + ((size_t)gI * 128 + t) * 128 + 32 * kk + 8 * fq; wpre[kk][0] = *(const f32x4*)wp; wpre[kk][1] = *(const f32x4*)(wp + 4); }
                        { const int s = tid >> 2, cg0 = (tid & 3) * 32, row = 128 * n + s;
                          const f32x4 p0 = *(const f32x4*)(SSV + (size_t)row * 8), p1 = *(const f32x4*)(SSV + (size_t)row * 8 + 4);
                          const float rv = rsqrtf(((p0[0] + p0[1]) + (p0[2] + p0[3]) + (p1[0] + p1[1]) + (p1[2] + p1[3])) * (1.0f / 512.0f) + EPS);
#pragma unroll
                          for (int q = 0; q < 4; ++q) { const int c = cg0 + 8 * q; const v4u vw = *(const v4u*)(VV + (size_t)row * 512 + 128 * gI + c);
                              const f32x4 ga = *(const f32x4*)(sgn + 128 * gI + c), gb = *(const f32x4*)(sgn + 128 * gI + c + 4);
#pragma unroll
                              for (int e = 0; e < 4; ++e) { const float g0 = e < 2 ? ga[2 * e] : gb[2 * e - 4], g1 = e < 2 ? ga[2 * e + 1] : gb[2 * e - 3];
                                  T[(c + 2 * e) * 136 + s] = (bf16)f2bf(pg8::bflo(vw[e]) * rv * g0); T[(c + 2 * e + 1) * 136 + s] = (bf16)f2bf(pg8::bfhi(vw[e]) * rv * g1); } } }
                        __syncthreads();
                        f32x4 acc[8];
#pragma unroll
                        for (int j = 0; j < 8; ++j) acc[j] = (f32x4){0.f, 0.f, 0.f, 0.f};
#pragma unroll
                        for (int kk = 0; kk < 4; ++kk) { if (kk > (wave >> 1)) break;
                            const int s0 = 32 * kk + 8 * fq;
                            const f32x4 w0 = wpre[kk][0], w1 = wpre[kk][1];
                            float wv[8] = {w0[0], w0[1], w0[2], w0[3], w1[0], w1[1], w1[2], w1[3]};
#pragma unroll
                            for (int e = 0; e < 8; ++e) if (s0 + e > t) wv[e] = 0.f;
                            v4u aw; aw.x = pk2(wv[0], wv[1]); aw.y = pk2(wv[2], wv[3]); aw.z = pk2(wv[4], wv[5]); aw.w = pk2(wv[6], wv[7]);
                            const bf16x8 afr = __builtin_bit_cast(bf16x8, aw);
#pragma unroll
                            for (int j = 0; j < 8; ++j) { const bf16x8 bfr = *(const LAS bf16x8*)(T + (16 * j + fr) * 136 + s0); acc[j] = __builtin_amdgcn_mfma_f32_16x16x32_bf16(bfr, afr, acc[j], 0, 0, 0); }
                        }
                        const float bias = sgb[gI * 128 + t]; const size_t rowoff = (size_t)(128 * n + t) * 512 + 128 * gI;
                        v2u uw8[8];
#pragma unroll
                        for (int j = 0; j < 8; ++j) uw8[j] = *(const v2u*)(UU + rowoff + 16 * j + 4 * fq);
                        asm volatile("" ::: "memory");
#pragma unroll
                        for (int j = 0; j < 8; ++j) { const int c = 16 * j + 4 * fq; const v2u uw = uw8[j];
                            v2u o; o.x = pk2(pg8::bflo(uw.x) * (acc[j][0] + bias), pg8::bfhi(uw.x) * (acc[j][1] + bias)); o.y = pk2(pg8::bflo(uw.y) * (acc[j][2] + bias), pg8::bfhi(uw.y) * (acc[j][3] + bias));
                            *(v2u*)(UU + rowoff + c) = o; }
                        __syncthreads();
                    }
                }
            }
            SEAM(pb + 4);
            if (IN(pb + 5)) { KARGS();
                TIDS();
                const attn_body::AttnTensors AT{(const attn_body::bf16*)(PROJ + 8 * PIECE), (const attn_body::bf16*)(PROJ + 6 * PIECE), (const attn_body::bf16*)(PROJ + 7 * PIECE), (attn_body::bf16*)(PROJ + 2 * PIECE), CS, (const unsigned*)(ws + 32768) + 8 * l};
                unsigned* qctr = (unsigned*)(ws + 40960) + 64 * l;
                volatile LAS unsigned* qw = (volatile LAS unsigned*)(ldsp + XB_LDS_OFF + 64);
                volatile LAS unsigned* T0 = (volatile LAS unsigned*)(ldsp + T0_LDS_OFF);
                {   const int hd = tid & 7, qb = 63 - (tid >> 3);
                    const float km2 = __uint_as_float(__hip_atomic_load(AT.KM + hd, __ATOMIC_RELAXED, __HIP_MEMORY_SCOPE_AGENT)), qm2 = __uint_as_float(__hip_atomic_load(AT.KM + 64 + hd, __ATOMIC_RELAXED, __HIP_MEMORY_SCOPE_AGENT));
                    T0[tid] = (unsigned)attn_skip_tiles(CS + (size_t)hd * M, qb, sqrtf(km2 * qm2) * 1.001f + 0.01f); }
                if (bx == 0) ((unsigned*)(ws + 45056))[tid] = T0[tid];
                __syncthreads();
#pragma nounroll
                for (;;) {
                    if (tid == 0) qw[0] = __hip_atomic_fetch_add(qctr, 1u, __ATOMIC_RELAXED, __HIP_MEMORY_SCOPE_AGENT);
                    __syncthreads();
                    const unsigned idxq = qw[0];
                    __syncthreads();
                    if (idxq >= 2048u + 32u) break;
                    const unsigned idx = idxq < 2048u ? idxq + 32u : idxq - 2048u;
                    if (idx < 32u) {
                        pg8::OneUnit S1;
                        if (idx < 16u) { S1.u0.pm = 0; S1.u0.pn = (int)(idx & 3u); S1.u0.z = (int)(idx >> 2); pg8::Gemm g1{KC, Wt + WO_Q, 256, 1024, 1024, 512, 512}; pg8::EpiScaleZ E1{WL, 1024, 0.0625f * LOG2E}; pg8::gemm_phase<pg8::EpiScaleZ, pg8::OneUnit, true, true>(ldsp, g1, S1, E1); }
                        else { S1.u0.pm = (int)((idx - 16u) >> 2); S1.u0.pn = 0; S1.u0.z = (int)(idx & 3u); pg8::Gemm g1{Wt + WO_XO, VCT, 256, 1024, 1024, 512, 512}; pg8::EpiScale<0> E1{nullptr, VT2, 1024, 1.0f}; pg8::gemm_phase<pg8::EpiScale<0>, pg8::OneUnit, true, true>(ldsp, g1, S1, E1); }
                        __syncthreads();
                        continue;
                    }
                    const unsigned ia = idx - 32u;
                    const int c = (int)(ia >> 9), un = (int)(ia & 511u), qb = 63 - (un >> 3), hd = un & 7, ntf = 4 * (qb + 1);
                    const int t0 = (int)T0[un], len = ntf - t0, n = attn_chunks(len);
                    if (c >= n) continue;
                    const bool last = (c == n - 1); const int tb = t0 + 64 * c, ntl = last ? ntf - tb : 64;
                    attn_body::bf16* Oc = (attn_body::bf16*)(PROJ + (last ? 2 : 3 + c) * PIECE);
                    float* Lc = last ? (float*)(ws + WS_LPL) : (float*)(ws + WS_LP) + (size_t)c * M * 8;
                    attn_body::attn_unit<8>(0, hd, qb, AT.Q, AT.K, AT.V, Oc, CS, AT.KM, (char*)lds, tb, ntl, last, Lc);
                    if (n > 1) {
                        asm volatile("s_waitcnt vmcnt(0)" ::: "memory"); __syncthreads();
                        if (tid == 0) { __builtin_amdgcn_fence(__ATOMIC_RELEASE, "agent"); asm volatile("s_waitcnt vmcnt(0)" ::: "memory");
                            const unsigned old_ = __hip_atomic_fetch_add((unsigned*)(ws + 49152) + 512 * l + un, 1u, __ATOMIC_RELAXED, __HIP_MEMORY_SCOPE_AGENT);
                            if (old_ == (unsigned)(n - 1)) { __builtin_amdgcn_fence(__ATOMIC_ACQUIRE, "agent"); asm volatile("s_waitcnt vmcnt(0)" ::: "memory"); }
                            qw[4] = old_; }
                        __syncthreads();
                        if (qw[4] == (unsigned)(n - 1)) {
                            for (int it = tid; it < 2048; it += NTHREADS) { const int row = 256 * qb + (it >> 3); const size_t off = (size_t)row * 512 + hd * 64 + (it & 7) * 8;
                                float lw = ((const float*)(ws + WS_LPL))[(size_t)row * 8 + hd], ls = lw; const v4u yw = *(const v4u*)(PROJ + 2 * PIECE + off);
                                float y[8];
#pragma unroll
                                for (int e = 0; e < 4; ++e) { y[2 * e] = pg8::bflo(yw[e]) * lw; y[2 * e + 1] = pg8::bfhi(yw[e]) * lw; }
                                for (int cc = 0; cc < n - 1; ++cc) { const float lc = ((const float*)(ws + WS_LP))[((size_t)cc * M + row) * 8 + hd]; ls += lc; const v4u pw = *(const v4u*)(PROJ + (size_t)(3 + cc) * PIECE + off);
#pragma unroll
                                    for (int e = 0; e < 4; ++e) { y[2 * e] += pg8::bflo(pw[e]) * lc; y[2 * e + 1] += pg8::bfhi(pw[e]) * lc; } }
                                const float inv = 1.0f / ls; v4u o; o.x = pk2(y[0] * inv, y[1] * inv); o.y = pk2(y[2] * inv, y[3] * inv); o.z = pk2(y[4] * inv, y[5] * inv); o.w = pk2(y[6] * inv, y[7] * inv);
                                *(v4u*)(PROJ + 2 * PIECE + off) = o; }
                        }
                        __syncthreads();
                    }
                }
                __syncthreads();
            }
            SEAM(pb + 5);
            if (IN(pb + 6)) { KARGS();
                pg8::Gemm g{XB, Wt + WO_G, 1024, 1024, 1024, 0, 0}; pg8::StaticOrder S; S.init(M / 256, 12, G, bx);
                LAS float* rsl = nullptr; if (G == 256) { int t_ = threadIdx.x; asm volatile("" : "+v"(t_)); pg8::Unit u0; S.map(bx, u0); rsl = (LAS float*)(ldsp + RS_LDS_OFF); panel_rstd(SS, u0.pm, rsl, t_); }
                pg8::EpiGates E{SS, rsl, GT}; pg8::gemm_phase<pg8::EpiGates, pg8::StaticOrder, true, true>(ldsp, g, S, E);
            }
            SEAM_LOCAL(pb + 6);
            if (IN(pb + 7)) { KARGS();
                pg8::Gemm g{PROJ, Wt + WO_B, 512, 512, 512, PIECE * 2, (size_t)1024 * 512 * 2}; pg8::ZOrder<3> S; S.S.init(M / 256, 4, G, bx);
                pg8::EpiMerge E{GT}; pg8::gemm_phase<pg8::EpiMerge, pg8::ZOrder<3>, true, true>(ldsp, g, S, E);
            }
            SEAM(pb + 7);
            if (IN(pb + 8)) { KARGS();
                pg8::Gemm g{GT, Wt + WO_O, 1024, 1024, 1024, 0, 0}; pg8::StaticOrder S; S.init(M / 256, 4, G, bx);
                pg8::EpiResid E{XB, SS, 1.0f}; pg8::gemm_phase<pg8::EpiResid, pg8::StaticOrder, true, true>(ldsp, g, S, E);
            }
            SEAM(pb + 8);
            if (IN(pb + 9)) { KARGS();
                pg8::Gemm g{XB, WL, 1024, 1024, 1024, 0, 0}; pg8::EpiSoftmax E{SS, nullptr, PB};
                for (int Lx = vcu; Lx < 256; Lx += G) { pg8::OneUnit S; S.u0.pm = Lx >> 2; S.u0.pn = Lx & 3; S.u0.z = 0; pg8::gemm_phase<pg8::EpiSoftmax, pg8::OneUnit, false, true>(ldsp, g, S, E); }
            }
            SEAM(pb + 9);
            if (IN(pb + 12)) { KARGS();
                pg8::Gemm g{PB, VT2, 1024, 1024, 1024, 0, 0}; pg8::StaticOrder S; S.init(M / 256, 4, G, bx);
                pg8::EpiResid E{XB, SS, 1.0f}; pg8::gemm_phase<pg8::EpiResid, pg8::StaticOrder, true, true>(ldsp, g, S, E);
            }
            SEAM(pb + 12);
        }
    }
#ifdef MK_DUMP_OFF
    {
        GRID_SYNC(); KARGS(); int t_ = threadIdx.x; asm volatile("" : "+v"(t_));
        const bf16* src = SCR + (size_t)(MK_DUMP_OFF);
        for (unsigned i = blockIdx.x * 512u + (unsigned)t_; i < (unsigned)M * 1024u; i += gridDim.x * 512u) { const unsigned m = i >> 10, c = i & 1023u;
            X[i] = c < (unsigned)(MK_DUMP_LD) ? b2f(src[(size_t)m * (MK_DUMP_LD) + c]) : 0.f; }
    }
#endif
    if (IN(30)) { KARGS(); TIDS();
        const float* gf = in[25];
        for (int m = gw; m < M; m += NGW) {
            const v2u* xb = (const v2u*)(XB + (size_t)m * D) + lane; f32x4* xr = (f32x4*)(X + (size_t)m * D) + lane; f32x4 v[4]; float s = 0.f;
#pragma unroll
            for (int j = 0; j < 4; ++j) { const v2u xw = xb[64 * j]; v[j] = (f32x4){pg8::bflo(xw.x), pg8::bfhi(xw.x), pg8::bflo(xw.y), pg8::bfhi(xw.y)}; s += (v[j][0] * v[j][0] + v[j][1] * v[j][1]) + (v[j][2] * v[j][2] + v[j][3] * v[j][3]); }
            const float r = rsqrtf(wave_sum(s) * (1.0f / D) + EPS);
#pragma unroll
            for (int j = 0; j < 4; ++j) __builtin_nontemporal_store(v[j] * r * *((const f32x4*)gf + lane + 64 * j), xr + 64 * j);
#ifdef MK_TIME_A
            {
                const unsigned long long* ts = (const unsigned long long*)(ws + 49152);
                const float tA = (float)(__hip_atomic_load(ts + (MK_TIME_A) + 1, __ATOMIC_RELAXED, __HIP_MEMORY_SCOPE_AGENT) - __hip_atomic_load(ts + (MK_TIME_A), __ATOMIC_RELAXED, __HIP_MEMORY_SCOPE_AGENT)) * 0.01f;
                const float tB = (float)(__hip_atomic_load(ts + (MK_TIME_B) + 1, __ATOMIC_RELAXED, __HIP_MEMORY_SCOPE_AGENT) - __hip_atomic_load(ts + (MK_TIME_B), __ATOMIC_RELAXED, __HIP_MEMORY_SCOPE_AGENT)) * 0.01f;
                const float d = sqrtf(0.1f + 0.8f * fminf(tA * (1.0f / 400.0f), 1.0f)), A = 10.0f + 90.0f * fminf(tB * (1.0f / 400.0f), 1.0f);
#pragma unroll
                for (int j = 0; j < 4; ++j) { f32x4 o = xr[64 * j] * (1.0f + d); if (m == 0 && lane == 0 && j == 0) o[0] += A; xr[64 * j] = o; }
            }
#endif
        }
    }
#undef IN
#undef SEAM
#undef ws
#undef X
#undef SS
#undef SSV
#undef LF
#undef CS
#undef RSM
#undef MEMB
#undef KC
#undef VCT
#undef Wt
#undef XB
#undef SCR
#undef WL
#undef VT2
#undef ACT
#undef PROJ
#undef GT
#undef XQ
#undef PB
#undef OB
#undef in
}

#ifndef MK_PER_PHASE
#define MK_PER_PHASE 0
#endif
extern "C" void kernel_launch(void* const* d_in, const int* in_sizes, int n_in, void* d_out, int out_size, void* d_ws, size_t ws_size, hipStream_t stream) {
    static int grid = 0;
    if (grid == 0) {
        if (n_in != 26 || out_size != M * D || ws_size < WS_END) { fprintf(stderr, "kernel_launch: unexpected shapes (n_in %d out %d ws %zu)\n", n_in, out_size, ws_size); grid = -1; return; }
        int dev = 0, cus = 0, per_cu = 0;
        (void)hipGetDevice(&dev); (void)hipDeviceGetAttribute(&cus, hipDeviceAttributeMultiprocessorCount, dev);
        if (hipFuncSetAttribute((const void*)mk_fwd, hipFuncAttributeMaxDynamicSharedMemorySize, LDS_BYTES) != hipSuccess) { fprintf(stderr, "kernel_launch: hipFuncSetAttribute failed\n"); grid = -1; return; }
        if (hipOccupancyMaxActiveBlocksPerMultiprocessor(&per_cu, (const void*)mk_fwd, NTHREADS, LDS_BYTES) != hipSuccess || per_cu < 1) { fprintf(stderr, "kernel_launch: occupancy query says %d\n", per_cu); per_cu = 1; }
        (void)hipGetLastError();
        grid = cus > 0 ? cus : 256;
    }
    if (grid < 0) return;
    (void)hipMemsetAsync(d_ws, 0, 65536, stream);
    Args a{};
    for (int i = 0; i < 26; ++i) a.in[i] = (const float*)d_in[i];
    a.out = (float*)d_out; a.ws = (unsigned char*)d_ws;
#if MK_PER_PHASE
    for (int p = 0; p < 31; ++p) { a.ph_lo = p; a.ph_hi = p + 1; void* kargs[] = {&a};
        hipError_t e = hipLaunchCooperativeKernel((const void*)mk_fwd, dim3(grid), dim3(NTHREADS), kargs, LDS_BYTES, stream);
        if (e != hipSuccess) { fprintf(stderr, "launch %d failed: %s\n", p, hipGetErrorString(e)); break; } }
#else
#ifndef MK_PH_HI
#define MK_PH_HI 31
#endif
    a.ph_lo = 0; a.ph_hi = MK_PH_HI; void* kargs[] = {&a};
    hipError_t e = hipLaunchCooperativeKernel((const void*)mk_fwd, dim3(grid), dim3(NTHREADS), kargs, LDS_BYTES, stream);
    if (e != hipSuccess) fprintf(stderr, "cooperative launch failed: %s (grid %d)\n", hipGetErrorString(e), grid);
#endif
}
```

```cpp
#include <hip/hip_runtime.h>
#include <hip/hip_cooperative_groups.h>
#include <cstdio>
#include <cstdint>
namespace cg = cooperative_groups;

namespace pg8 {
#define PG8_LAS __attribute__((address_space(3)))
typedef unsigned short bf16_t;
typedef short bf16x8 __attribute__((ext_vector_type(8)));
typedef float f32x4 __attribute__((ext_vector_type(4)));
typedef unsigned u32x4 __attribute__((ext_vector_type(4)));
constexpr int BM = 256, BK = 64, HALF = 128, HTB = HALF * BK * 2  , STAGE_BYTES = 8 * HTB, NXCD = 8, WGM = 8;

__host__ __device__ __forceinline__ int lds_byte(int r, int c) { const int st = (r >> 4) * 2 + (c >> 5), rr = r & 15, cc = c & 31, ob = rr * 64 + cc * 2; return st * 1024 + (ob ^ (((ob >> 9) & 1) << 5)); }
__host__ __device__ __forceinline__ void stage_rc(int b, int& R, int& C) { const int st = b / 1024, sb = b % 1024, swz = sb ^ (((sb >> 9) & 1) << 5); R = (st >> 1) * 16 + swz / 64; C = (st & 1) * 32 + (swz % 64) / 2; }
__host__ __device__ __forceinline__ int perm32(int rho) { const int n = rho >> 4, i = rho & 15; return 8 * (i >> 2) + 4 * n + (i & 3); }

struct Unit { int pm, pn, z; };
typedef float f32x2 __attribute__((ext_vector_type(2))); typedef __bf16 bf16x2_cv __attribute__((ext_vector_type(2)));
__device__ __forceinline__ unsigned cvt_pk_bf16(float lo, float hi) { const f32x2 v = {lo, hi}; const bf16x2_cv b = __builtin_convertvector(v, bf16x2_cv); return __builtin_bit_cast(unsigned, b); }
struct Gemm { const bf16_t* A; const bf16_t* Bt; int K, lda, ldb; size_t zA, zB; };

struct StaticOrder {
    int nM, nN, nwg, G, c;
    __host__ __device__ __forceinline__ void init(int nM_, int nN_, int G_, int c_) { nM = nM_; nN = nN_; nwg = nM * nN; G = G_; c = c_; }
    __host__ __device__ __forceinline__ void map(int wgid, Unit& u) const {
        { const int q = nwg / NXCD, r = nwg % NXCD, xcd = wgid % NXCD, off = wgid / NXCD; wgid = (xcd < r ? xcd * (q + 1) : r * (q + 1) + (xcd - r) * q) + off; }
        const int nig = WGM * nN, gid = wgid / nig, fm = gid * WGM, gsz = (nM - fm) < WGM ? (nM - fm) : WGM;
        u.pm = fm + ((wgid % nig) % gsz); u.pn = (wgid % nig) / gsz; u.z = 0;
    }
    __host__ __device__ __forceinline__ bool next(int i, Unit& u) const { const long L = (long)i * G + c; if (L >= nwg) return false; map((int)L, u); return true; }
    __device__ __forceinline__ void a_ready(const Unit&) const {}
    __device__ __forceinline__ void done(const Unit&) const {}
};
template <int NZ> struct ZOrder {
    StaticOrder S;
    __host__ __device__ __forceinline__ bool next(int i, Unit& u) const { const long L = (long)(i / NZ) * S.G + S.c; if (L >= S.nwg) return false; S.map((int)L, u); u.z = i % NZ; return true; }
    __device__ __forceinline__ void a_ready(const Unit&) const {}
    __device__ __forceinline__ void done(const Unit&) const {}
};
struct OneUnit {
    Unit u0;
    __host__ __device__ __forceinline__ bool next(int i, Unit& u) const { if (i > 0) return false; u = u0; return true; }
    __device__ __forceinline__ void a_ready(const Unit&) const {}
    __device__ __forceinline__ void done(const Unit&) const {}
};

typedef unsigned u32x2 __attribute__((ext_vector_type(2)));
constexpr float LOG2E = 1.4426950408889634f;
__device__ __forceinline__ float bf2f(unsigned short b) { return __uint_as_float((unsigned)b << 16); }
__device__ __forceinline__ float bflo(unsigned w) { return __uint_as_float(w << 16); }
__device__ __forceinline__ float bfhi(unsigned w) { return __uint_as_float(w & 0xffff0000u); }
__device__ __forceinline__ float sigmoidf_(float v) { return __builtin_amdgcn_rcpf(1.0f + __builtin_amdgcn_exp2f(-v * LOG2E)); }
__device__ __forceinline__ float gelu_tanh(float v) { const float z = 0.7978845608028654f * (v + 0.044715f * v * v * v); return v * sigmoidf_(2.0f * z); }
__device__ __forceinline__ u32x4 pack8(const f32x4 a, const f32x4 b) { u32x4 w; w.x = cvt_pk_bf16(a[0], a[1]); w.y = cvt_pk_bf16(a[2], a[3]); w.z = cvt_pk_bf16(b[0], b[1]); w.w = cvt_pk_bf16(b[2], b[3]); return w; }
__device__ __forceinline__ void row_rstd(const float* SS, int rowbase, int fq, float (&rs)[2][4]) {
#pragma unroll
    for (int ai = 0; ai < 2; ++ai)
#pragma unroll
        for (int m = 0; m < 4; ++m) { const f32x4 v = *(const f32x4*)(SS + (size_t)(rowbase + ai * HALF + m * 16) * 16 + 4 * fq);
            float s = (v[0] + v[1]) + (v[2] + v[3]); s += __shfl_xor(s, 16); s += __shfl_xor(s, 32); rs[ai][m] = rsqrtf(s * (1.0f / 1024.0f) + 1e-6f); }
}
__device__ __forceinline__ float row_rstd1(const float* SS, int row, int fq) { const f32x4 v = *(const f32x4*)(SS + (size_t)row * 16 + 4 * fq);
    float s = (v[0] + v[1]) + (v[2] + v[3]); s += __shfl_xor(s, 16); s += __shfl_xor(s, 32); return rsqrtf(s * (1.0f / 1024.0f) + 1e-6f); }
__device__ __forceinline__ void rows_rstd(const float* SS, const PG8_LAS float* rsl, int pm, int wr, int fr, int fq, float (&rs)[2][4]) {
    if (rsl) {
#pragma unroll
        for (int ai = 0; ai < 2; ++ai)
#pragma unroll
            for (int m = 0; m < 4; ++m) rs[ai][m] = rsl[ai * HALF + wr * 64 + m * 16 + fr];
    } else row_rstd(SS, pm * BM + wr * 64 + fr, fq, rs);
}
#define EPI_ARGS const f32x4 (&acc)[2][2][4][2], const Unit& u, int wr, int wc, int fr, int fq
struct EpiSwiGLU { static constexpr bool PERM = true, AFTER_DRAIN = false; const float* SS; const PG8_LAS float* rsl; bf16_t* O;
    __device__ __forceinline__ void operator()(EPI_ARGS) const {
        float rs[2][4]; rows_rstd(SS, rsl, u.pm, wr, fr, fq, rs);
        const int col0 = u.pn * 128 + wc * 32 + 8 * fq;
#pragma unroll
        for (int ai = 0; ai < 2; ++ai)
#pragma unroll
            for (int m = 0; m < 4; ++m) { const float r = rs[ai][m]; f32x4 o[2];
#pragma unroll
                for (int n = 0; n < 2; ++n)
#pragma unroll
                    for (int j = 0; j < 4; ++j) { const float g = acc[ai][0][m][n][j] * r, up = acc[ai][1][m][n][j] * r; o[n][j] = g * sigmoidf_(g) * up; }
                *(u32x4*)(O + (size_t)(u.pm * BM + ai * HALF + wr * 64 + m * 16 + fr) * 2816 + col0) = pack8(o[0], o[1]); }
    }
};
struct EpiResid { static constexpr bool PERM = true, AFTER_DRAIN = false; bf16_t* XB; float* SS; float scale;
    __device__ __forceinline__ void operator()(EPI_ARGS) const {
        const int col0 = u.pn * BM + wc * 32 + 8 * fq;
#pragma unroll
        for (int ai = 0; ai < 2; ++ai) {
            u32x4 xw[4][2];
#pragma unroll
            for (int m = 0; m < 4; ++m)
#pragma unroll
                for (int bj = 0; bj < 2; ++bj) xw[m][bj] = *(const u32x4*)(XB + (size_t)(u.pm * BM + ai * HALF + wr * 64 + m * 16 + fr) * 1024 + col0 + bj * HALF);
            asm volatile("" ::: "memory");
#pragma unroll
            for (int m = 0; m < 4; ++m) { const int row = u.pm * BM + ai * HALF + wr * 64 + m * 16 + fr; float ssq = 0.f;
#pragma unroll
                for (int bj = 0; bj < 2; ++bj) { const u32x4 w0 = xw[m][bj];
                    f32x4 x0 = {bflo(w0.x), bfhi(w0.x), bflo(w0.y), bfhi(w0.y)}, x1 = {bflo(w0.z), bfhi(w0.z), bflo(w0.w), bfhi(w0.w)};
                    x0 = x0 + acc[ai][bj][m][0] * scale; x1 = x1 + acc[ai][bj][m][1] * scale;
                    *(u32x4*)(XB + (size_t)row * 1024 + col0 + bj * HALF) = pack8(x0, x1);
                    ssq += (x0[0] * x0[0] + x0[1] * x0[1]) + (x0[2] * x0[2] + x0[3] * x0[3]) + (x1[0] * x1[0] + x1[1] * x1[1]) + (x1[2] * x1[2] + x1[3] * x1[3]); }
                ssq += __shfl_xor(ssq, 16); ssq += __shfl_xor(ssq, 32);
                if (fq == 0) SS[(size_t)row * 16 + u.pn * 4 + wc] = ssq; }
            asm volatile("" ::: "memory");
        }
    }
};
struct EpiWin { static constexpr bool PERM = true, AFTER_DRAIN = false; const float* SS; const PG8_LAS float* rsl; bf16_t* P; float* SSV; float qscale;
    __device__ __forceinline__ void operator()(EPI_ARGS) const {
        float rs[2][4]; rows_rstd(SS, rsl, u.pm, wr, fr, fq, rs);
        const int piece = u.pn >> 1;
        const int slot = piece == 0 ? 0 : piece == 1 ? 3 : piece == 2 ? 4 : piece == 3 ? 1 : piece == 4 ? 5 : piece == 5 ? 8 : piece;
        bf16_t* base = P + (size_t)slot * (16384u * 512u);
        const int col0 = (u.pn & 1) * 256 + wc * 32 + 8 * fq;
        const float sc = piece == 5 ? qscale : 1.0f;
#pragma unroll
        for (int ai = 0; ai < 2; ++ai)
#pragma unroll
            for (int m = 0; m < 4; ++m) { const int row = u.pm * BM + ai * HALF + wr * 64 + m * 16 + fr; const float r = rs[ai][m] * sc; float ssq = 0.f;
#pragma unroll
                for (int bj = 0; bj < 2; ++bj) { f32x4 v0 = acc[ai][bj][m][0] * r, v1 = acc[ai][bj][m][1] * r;
                    if (piece == 3 || piece == 4) {
#pragma unroll
                        for (int j = 0; j < 4; ++j) { v0[j] = gelu_tanh(v0[j]); v1[j] = gelu_tanh(v1[j]); }
                        ssq += (v0[0] * v0[0] + v0[1] * v0[1]) + (v0[2] * v0[2] + v0[3] * v0[3]) + (v1[0] * v1[0] + v1[1] * v1[1]) + (v1[2] * v1[2] + v1[3] * v1[3]); }
                    *(u32x4*)(base + (size_t)row * 512 + col0 + bj * HALF) = pack8(v0, v1); }
                if (piece == 4) { ssq += __shfl_xor(ssq, 16); ssq += __shfl_xor(ssq, 32); if (fq == 0) SSV[(size_t)row * 8 + (u.pn & 1) * 4 + wc] = ssq; } }
    }
};
struct EpiGates { static constexpr bool PERM = true, AFTER_DRAIN = false; const float* SS; const PG8_LAS float* rsl; bf16_t* G;
    __device__ __forceinline__ void operator()(EPI_ARGS) const {
        float rs[2][4]; rows_rstd(SS, rsl, u.pm, wr, fr, fq, rs);
        bf16_t* base = G + (size_t)(u.pn >> 2) * (16384u * 1024u);
        const int col0 = (u.pn & 3) * 256 + wc * 32 + 8 * fq;
#pragma unroll
        for (int ai = 0; ai < 2; ++ai)
#pragma unroll
            for (int m = 0; m < 4; ++m) { const int row = u.pm * BM + ai * HALF + wr * 64 + m * 16 + fr; const float r = rs[ai][m];
#pragma unroll
                for (int bj = 0; bj < 2; ++bj) { f32x4 v0 = acc[ai][bj][m][0] * r, v1 = acc[ai][bj][m][1] * r;
#pragma unroll
                    for (int j = 0; j < 4; ++j) { v0[j] = sigmoidf_(v0[j]); v1[j] = sigmoidf_(v1[j]); }
                    *(u32x4*)(base + (size_t)row * 1024 + col0 + bj * HALF) = pack8(v0, v1); } }
    }
};
struct EpiMerge { static constexpr bool PERM = true, AFTER_DRAIN = false; bf16_t* G;
    __device__ __forceinline__ void operator()(EPI_ARGS) const {
        const bf16_t* gz = G + (size_t)u.z * (16384u * 1024u);
        const int col0 = u.pn * 256 + wc * 32 + 8 * fq;
#pragma unroll
        for (int ai = 0; ai < 2; ++ai) {
            u32x4 gw[4][2], pw[4][2];
#pragma unroll
            for (int m = 0; m < 4; ++m)
#pragma unroll
                for (int bj = 0; bj < 2; ++bj) { const size_t off = (size_t)(u.pm * BM + ai * HALF + wr * 64 + m * 16 + fr) * 1024 + col0 + bj * HALF;
                    gw[m][bj] = *(const u32x4*)(gz + off); pw[m][bj] = (u.z != 0) ? *(const u32x4*)(G + off) : (u32x4){0u, 0u, 0u, 0u}; }
            asm volatile("" ::: "memory");
#pragma unroll
            for (int m = 0; m < 4; ++m)
#pragma unroll
                for (int bj = 0; bj < 2; ++bj) { const size_t off = (size_t)(u.pm * BM + ai * HALF + wr * 64 + m * 16 + fr) * 1024 + col0 + bj * HALF;
                    const u32x4 g = gw[m][bj], p = pw[m][bj];
                    f32x4 g0 = {bflo(g.x), bfhi(g.x), bflo(g.y), bfhi(g.y)}, g1 = {bflo(g.z), bfhi(g.z), bflo(g.w), bfhi(g.w)};
                    f32x4 v0 = acc[ai][bj][m][0] * g0, v1 = acc[ai][bj][m][1] * g1;
#ifdef MK_DBG_Z
                    if (u.z != MK_DBG_Z) { v0 = v0 * 0.f; v1 = v1 * 0.f; }
#endif
                    v0 = v0 + (f32x4){bflo(p.x), bfhi(p.x), bflo(p.y), bfhi(p.y)}; v1 = v1 + (f32x4){bflo(p.z), bfhi(p.z), bflo(p.w), bfhi(p.w)};
                    *(u32x4*)(G + off) = pack8(v0, v1); }
            asm volatile("" ::: "memory");
        }
    }
};
template <int MODE> struct EpiScale { static constexpr bool PERM = true, AFTER_DRAIN = false; const float* S; bf16_t* O; int ldc; float scale;
    __device__ __forceinline__ void operator()(EPI_ARGS) const {
        float rs[2][4];
        if (MODE == 1) row_rstd(S, u.pm * BM + wr * 64 + fr, fq, rs);
        const int col0 = (u.pn + u.z) * 256 + wc * 32 + 8 * fq;
#pragma unroll
        for (int ai = 0; ai < 2; ++ai)
#pragma unroll
            for (int m = 0; m < 4; ++m) { const int row = u.pm * BM + ai * HALF + wr * 64 + m * 16 + fr;
                float r = scale; if (MODE == 1) r *= rs[ai][m]; if (MODE == 2) r *= S[row];
#pragma unroll
                for (int bj = 0; bj < 2; ++bj) { f32x4 v0 = acc[ai][bj][m][0] * r, v1 = acc[ai][bj][m][1] * r;
                    if (MODE == 3) { v0 = v0 * *(const f32x4*)(S + col0 + bj * HALF); v1 = v1 * *(const f32x4*)(S + col0 + bj * HALF + 4); }
                    *(u32x4*)(O + (size_t)row * ldc + col0 + bj * HALF) = pack8(v0, v1); } }
    }
};
struct EpiScaleZ { static constexpr bool PERM = true, AFTER_DRAIN = false; bf16_t* O; int ldc; float scale;
    __device__ __forceinline__ void operator()(EPI_ARGS) const {
        const int col0 = u.pn * 256 + wc * 32 + 8 * fq;
#pragma unroll
        for (int ai = 0; ai < 2; ++ai)
#pragma unroll
            for (int m = 0; m < 4; ++m) { const int row = (u.pm + u.z) * BM + ai * HALF + wr * 64 + m * 16 + fr;
#pragma unroll
                for (int bj = 0; bj < 2; ++bj) *(u32x4*)(O + (size_t)row * ldc + col0 + bj * HALF) = pack8(acc[ai][bj][m][0] * scale, acc[ai][bj][m][1] * scale); }
    }
};
struct EpiSoftmax { static constexpr bool PERM = true, AFTER_DRAIN = true; const float* SS; const PG8_LAS float* rsl; bf16_t* O;
    __device__ __forceinline__ void fused(f32x4 (&acc)[2][2][4][2], const Unit& u, int wr, int wc, int fr, int fq, PG8_LAS unsigned char* lds, int wid, int lane) const {
        PG8_LAS float* T1 = (PG8_LAS float*)lds; PG8_LAS float* T2 = (PG8_LAS float*)(lds + 4096);
        { float rs[2][4]; rows_rstd(SS, rsl, u.pm, wr, fr, fq, rs);
#pragma unroll
          for (int ai = 0; ai < 2; ++ai)
#pragma unroll
            for (int m = 0; m < 4; ++m)
#pragma unroll
                for (int bj = 0; bj < 2; ++bj)
#pragma unroll
                    for (int n = 0; n < 2; ++n) acc[ai][bj][m][n] = acc[ai][bj][m][n] * rs[ai][m]; }
#pragma unroll
        for (int ai = 0; ai < 2; ++ai)
#pragma unroll
            for (int m = 0; m < 4; ++m) { float mx = -3.0e38f;
#pragma unroll
                for (int bj = 0; bj < 2; ++bj)
#pragma unroll
                    for (int n = 0; n < 2; ++n)
#pragma unroll
                        for (int j = 0; j < 4; ++j) mx = fmaxf(mx, acc[ai][bj][m][n][j]);
                mx = fmaxf(mx, __shfl_xor(mx, 16)); mx = fmaxf(mx, __shfl_xor(mx, 32));
                if (fq == 0) T1[(ai * HALF + wr * 64 + m * 16 + fr) * 4 + wc] = mx; }
        asm volatile("s_waitcnt lgkmcnt(0)" ::: "memory"); __builtin_amdgcn_s_barrier(); asm volatile("" ::: "memory");
#pragma unroll
        for (int ai = 0; ai < 2; ++ai)
#pragma unroll
            for (int m = 0; m < 4; ++m) { const int rl = ai * HALF + wr * 64 + m * 16 + fr; const f32x4 t = *(const PG8_LAS f32x4*)(T1 + rl * 4);
                const float mx = fmaxf(fmaxf(t[0], t[1]), fmaxf(t[2], t[3])); float s = 0.f;
#pragma unroll
                for (int bj = 0; bj < 2; ++bj)
#pragma unroll
                    for (int n = 0; n < 2; ++n)
#pragma unroll
                        for (int j = 0; j < 4; ++j) { const float p = __builtin_amdgcn_exp2f(acc[ai][bj][m][n][j] - mx); acc[ai][bj][m][n][j] = p; s += p; }
                s += __shfl_xor(s, 16); s += __shfl_xor(s, 32);
                if (fq == 0) T2[rl * 4 + wc] = s; }
        asm volatile("s_waitcnt lgkmcnt(0)" ::: "memory"); __builtin_amdgcn_s_barrier(); asm volatile("" ::: "memory");
        const int col0 = (u.pn + u.z) * 256 + wc * 32 + 8 * fq;
#pragma unroll
        for (int ai = 0; ai < 2; ++ai)
#pragma unroll
            for (int m = 0; m < 4; ++m) { const int rl = ai * HALF + wr * 64 + m * 16 + fr; const f32x4 t = *(const PG8_LAS f32x4*)(T2 + rl * 4);
                const float inv = 1.0f / ((t[0] + t[1]) + (t[2] + t[3]));
#pragma unroll
                for (int bj = 0; bj < 2; ++bj) *(u32x4*)(O + (size_t)(u.pm * BM + rl) * 1024 + col0 + bj * HALF) = pack8(acc[ai][bj][m][0] * inv, acc[ai][bj][m][1] * inv); }
        asm volatile("s_waitcnt lgkmcnt(0)" ::: "memory"); __builtin_amdgcn_s_barrier(); asm volatile("" ::: "memory");
    }
};

template <class Epi, class Sched, bool ALIGN_EPI = false, bool SP2 = false>
__device__ __forceinline__ void gemm_phase(PG8_LAS unsigned char* lds, const Gemm g, const Sched& S, const Epi& E) {
    int tid_o = threadIdx.x; asm volatile("" : "+v"(tid_o)); const int tid = tid_o, wid = __builtin_amdgcn_readfirstlane(tid >> 6), lane = tid & 63, wr = wid >> 2, wc = wid & 3, fr = lane & 15, fq = lane >> 4;
    const int nt = g.K / BK; const char* gA_ = reinterpret_cast<const char*>(g.A); const char* gB_ = reinterpret_cast<const char*>(g.Bt); asm volatile("" : "+s"(gA_), "+s"(gB_));
    unsigned voffA[2], voffB[2];
#pragma unroll
    for (int i = 0; i < 2; ++i) { int R, C; stage_rc(tid * 16 + i * 8192, R, C); const int Rb = Epi::PERM ? ((R & ~31) + perm32(R & 31)) : R;
        voffA[i] = (unsigned)(R * g.lda + C) * 2u; voffB[i] = (unsigned)(Rb * g.ldb + C) * 2u; }
    const size_t kstep = (size_t)(BK * 2);
    const size_t hstepA = (size_t)HALF * g.lda * 2, hstepB = (size_t)HALF * g.ldb * 2;

    const unsigned ldsw = (unsigned)wid * 1024u;
    const int aoff = lds_byte(wr * 64 + fr, fq * 8), boff = lds_byte(wc * 32 + fr, fq * 8);
#define PG8_SA(b, h) (((b) * 2 + (h)) * HTB)
#define PG8_SB(b, h) ((4 + (b) * 2 + (h)) * HTB)
#define PG8_STAGE(bufoff, gbase, voff) do { _Pragma("unroll") for (int _i = 0; _i < 2; ++_i) \
        __builtin_amdgcn_global_load_lds((const unsigned*)((const char*)(gbase) + (voff)[_i]), (PG8_LAS unsigned*)(lds + (bufoff) + ldsw + _i * 8192), 16, 0, 0); } while (0)
#define PG8_LDA(dst, b, h) do { _Pragma("unroll") for (int m = 0; m < 4; ++m) _Pragma("unroll") for (int k = 0; k < 2; ++k) dst[m][k] = *(const PG8_LAS bf16x8*)(lds + PG8_SA(b, h) + aoff + m * 2048 + k * 1024); } while (0)
#define PG8_LDB(dst, b, h) do { _Pragma("unroll") for (int n = 0; n < 2; ++n) _Pragma("unroll") for (int k = 0; k < 2; ++k) dst[n][k] = *(const PG8_LAS bf16x8*)(lds + PG8_SB(b, h) + boff + n * 2048 + k * 1024); } while (0)
#define PG8_MMA(ai, bj, At, Bt) do { __builtin_amdgcn_s_setprio(1); _Pragma("unroll") for (int m = 0; m < 4; ++m) _Pragma("unroll") for (int n = 0; n < 2; ++n) _Pragma("unroll") for (int k = 0; k < 2; ++k) \
        acc[ai][bj][m][n] = __builtin_amdgcn_mfma_f32_16x16x32_bf16(Bt[n][k], At[m][k], acc[ai][bj][m][n], 0, 0, 0); __builtin_amdgcn_s_setprio(0); } while (0)
#define PG8_WAIT_V(n) asm volatile("s_waitcnt vmcnt(" #n ")" ::: "memory")
#define PG8_WAIT_L(n) asm volatile("s_waitcnt lgkmcnt(" #n ")" ::: "memory")
#define PG8_BAR __builtin_amdgcn_s_barrier()
#define PG8_SCHED __builtin_amdgcn_sched_barrier(0)
    Unit cur, nxt; int ui = 0;
    if (!S.next(0, cur)) return;
    f32x4 acc[2][2][4][2];
#pragma unroll
    for (int a = 0; a < 2; ++a)
#pragma unroll
        for (int b = 0; b < 2; ++b)
#pragma unroll
            for (int m = 0; m < 4; ++m)
#pragma unroll
                for (int n = 0; n < 2; ++n) acc[a][b][m][n] = (f32x4){0.f, 0.f, 0.f, 0.f};
    bf16x8 At[4][2], B0[2][2], B1[2][2];
    const char* cA = gA_ + (size_t)cur.pm * 2 * hstepA + (size_t)cur.z * g.zA; const char* cB = gB_ + (size_t)cur.pn * 2 * hstepB + (size_t)cur.z * g.zB;
    S.a_ready(cur);
    if constexpr (SP2) {
        PG8_STAGE(PG8_SB(0, 0), cB, voffB); PG8_STAGE(PG8_SB(0, 1), cB + hstepB, voffB); PG8_STAGE(PG8_SA(0, 0), cA, voffA); PG8_STAGE(PG8_SA(0, 1), cA + hstepA, voffA);
        if (wr == 1) PG8_BAR;
        PG8_WAIT_V(2); PG8_BAR;
        PG8_STAGE(PG8_SB(1, 0), cB + kstep, voffB); PG8_STAGE(PG8_SA(1, 0), cA + kstep, voffA); PG8_STAGE(PG8_SB(1, 1), cB + hstepB + kstep, voffB);
        PG8_WAIT_V(6); PG8_BAR;
    } else {
        PG8_STAGE(PG8_SB(0, 0), cB, voffB); PG8_STAGE(PG8_SA(0, 0), cA, voffA); PG8_STAGE(PG8_SB(0, 1), cB + hstepB, voffB); PG8_STAGE(PG8_SA(0, 1), cA + hstepA, voffA);
        if (wr == 1) PG8_BAR;
        PG8_WAIT_V(4); PG8_BAR;
        PG8_STAGE(PG8_SB(1, 0), cB + kstep, voffB); PG8_STAGE(PG8_SA(1, 0), cA + kstep, voffA); PG8_STAGE(PG8_SB(1, 1), cB + hstepB + kstep, voffB);
        PG8_WAIT_V(6); PG8_BAR;
    }
    for (;;) {
        const bool has_next = S.next(ui + 1, nxt);
        const char* nA = has_next ? gA_ + (size_t)nxt.pm * 2 * hstepA + (size_t)nxt.z * g.zA : cA; const char* nB = has_next ? gB_ + (size_t)nxt.pn * 2 * hstepB + (size_t)nxt.z * g.zB : cB;
_Pragma("nounroll")
        for (int t = 0; t < nt; t += 2) {
            const bool last = (t == nt - 2);
            const char* a1 = cA + (size_t)(t + 1) * kstep;
            const char* a2 = last ? nA : cA + (size_t)(t + 2) * kstep; const char* b2 = last ? nB : cB + (size_t)(t + 2) * kstep;
            const char* a3 = a2 + kstep; const char* b3 = b2 + kstep;
            if (last && has_next) S.a_ready(nxt);
            if constexpr (SP2) {
            PG8_LDB(B0, 0, 0); PG8_LDB(B1, 0, 1); PG8_SCHED; PG8_LDA(At, 0, 0); PG8_STAGE(PG8_SA(1, 1), a1 + hstepA, voffA);
            PG8_WAIT_V(8); PG8_WAIT_L(0); PG8_BAR; PG8_MMA(0, 0, At, B0); PG8_MMA(0, 1, At, B1); PG8_BAR; PG8_SCHED;
            PG8_LDA(At, 0, 1); PG8_STAGE(PG8_SB(0, 0), b2, voffB); PG8_STAGE(PG8_SB(0, 1), b2 + hstepB, voffB); PG8_STAGE(PG8_SA(0, 0), a2, voffA);
            PG8_WAIT_V(8); PG8_WAIT_L(0); PG8_BAR; PG8_MMA(1, 0, At, B0); PG8_MMA(1, 1, At, B1); PG8_BAR; PG8_SCHED;
            PG8_LDB(B0, 1, 0); PG8_LDB(B1, 1, 1); PG8_SCHED; PG8_LDA(At, 1, 0); PG8_STAGE(PG8_SA(0, 1), a2 + hstepA, voffA);
            PG8_WAIT_V(8); PG8_WAIT_L(0); PG8_BAR; PG8_MMA(0, 0, At, B0); PG8_MMA(0, 1, At, B1); PG8_BAR; PG8_SCHED;
            PG8_LDA(At, 1, 1); PG8_STAGE(PG8_SB(1, 0), b3, voffB); PG8_STAGE(PG8_SB(1, 1), b3 + hstepB, voffB); PG8_STAGE(PG8_SA(1, 0), a3, voffA);
            PG8_WAIT_V(8); PG8_WAIT_L(0); PG8_BAR; PG8_MMA(1, 0, At, B0); PG8_MMA(1, 1, At, B1); PG8_BAR; PG8_SCHED;
            } else {
            PG8_LDB(B0, 0, 0); PG8_SCHED; PG8_LDA(At, 0, 0); PG8_STAGE(PG8_SA(1, 1), a1 + hstepA, voffA);
            PG8_WAIT_L(8); PG8_BAR; PG8_WAIT_L(0); PG8_MMA(0, 0, At, B0); PG8_BAR; PG8_SCHED;
            PG8_LDB(B1, 0, 1); PG8_STAGE(PG8_SB(0, 0), b2, voffB);
            PG8_BAR; PG8_WAIT_L(0); PG8_MMA(0, 1, At, B1); PG8_BAR;
            PG8_LDA(At, 0, 1); PG8_STAGE(PG8_SA(0, 0), a2, voffA);
            PG8_BAR; PG8_WAIT_L(0); PG8_MMA(1, 0, At, B0); PG8_BAR; PG8_SCHED;
            PG8_STAGE(PG8_SB(0, 1), b2 + hstepB, voffB);
            PG8_WAIT_V(6); PG8_BAR; PG8_MMA(1, 1, At, B1); PG8_BAR;
            PG8_LDB(B0, 1, 0); PG8_SCHED; PG8_LDA(At, 1, 0); PG8_STAGE(PG8_SA(0, 1), a2 + hstepA, voffA);
            PG8_WAIT_L(8); PG8_BAR; PG8_WAIT_L(0); PG8_MMA(0, 0, At, B0); PG8_BAR; PG8_SCHED;
            PG8_LDB(B1, 1, 1); PG8_STAGE(PG8_SB(1, 0), b3, voffB);
            PG8_BAR; PG8_WAIT_L(0); PG8_MMA(0, 1, At, B1); PG8_BAR;
            PG8_LDA(At, 1, 1); PG8_STAGE(PG8_SA(1, 0), a3, voffA);
            PG8_BAR; PG8_WAIT_L(0); PG8_MMA(1, 0, At, B0); PG8_BAR; PG8_SCHED;
            PG8_STAGE(PG8_SB(1, 1), b3 + hstepB, voffB);
            PG8_WAIT_V(6); PG8_BAR; PG8_MMA(1, 1, At, B1); PG8_BAR;
            }
        }
        if constexpr (ALIGN_EPI) { if (wr == 0) PG8_BAR; }
        if constexpr (!Epi::AFTER_DRAIN) { E(acc, cur, wr, wc, fr, fq); S.done(cur); }
        if (!has_next) break;
#pragma unroll
        for (int a = 0; a < 2; ++a)
#pragma unroll
            for (int b = 0; b < 2; ++b)
#pragma unroll
                for (int m = 0; m < 4; ++m)
#pragma unroll
                    for (int n = 0; n < 2; ++n) acc[a][b][m][n] = (f32x4){0.f, 0.f, 0.f, 0.f};
        cur = nxt; cA = nA; cB = nB; ++ui;
        if constexpr (ALIGN_EPI) { if (wr == 1) PG8_BAR; }
    }
    PG8_WAIT_V(0);
    if constexpr (!ALIGN_EPI) { if (wr == 0) PG8_BAR; }
    PG8_BAR;
    if constexpr (Epi::AFTER_DRAIN) { E.fused(acc, cur, wr, wc, fr, fq, lds, wid, lane); S.done(cur); }
#undef PG8_SA
#undef PG8_SB
#undef PG8_STAGE
#undef PG8_LDA
#undef PG8_LDB
#undef PG8_MMA
#undef PG8_WAIT_V
#undef PG8_WAIT_L
#undef PG8_BAR
#undef PG8_SCHED
}
}
#include <hip/hip_bf16.h>
#include <cmath>
namespace attn_body {
using bf16=__hip_bfloat16;
using bf16x8=__attribute__((ext_vector_type(8)))short;
using s16x4=__attribute__((ext_vector_type(4)))short;
using f32x16=__attribute__((ext_vector_type(16)))float;
using u32x4=__attribute__((ext_vector_type(4)))unsigned;
using f32x4_t=__attribute__((ext_vector_type(4)))float;
constexpr int BATCH=1,NHEAD=8,SEQ=16384,D=64,DM=NHEAD*D;
constexpr int NW=8,QBLK=32,QB=QBLK*NW,KVBLK=64,NQB=SEQ/QB;
constexpr int ATTN_PITCH=DM, ATTN_UNIT_ROWS=QB;
__device__ __forceinline__ int crow(int r,int hi){return (r&3)+8*(r>>2)+4*hi;}
#define SBAR() __builtin_amdgcn_sched_barrier(0)
__device__ __forceinline__ void cmask(f32x16&p0,f32x16&p1,int jb,int qrel,int hi){
  const float NEG=-INFINITY; int kb=64*jb+4*hi;
  #pragma unroll
  for(int r=0;r<16;++r){int kv=kb+(r&3)+8*(r>>2); if(kv>qrel)p0[r]=NEG; if(kv+32>qrel)p1[r]=NEG;}
}

constexpr int NSLOT=3, SLOTB=8192;
constexpr int LDS_K=0, LDS_V=NSLOT*SLOTB, LDS_WS=2*NSLOT*SLOTB, LDS_OST=LDS_WS+NW*64*4, LDS_CK=LDS_OST+NW*4096, LDS_BYTES=LDS_CK+SEQ*4;
constexpr float C2=0.125f*1.4426950408889634f;
__device__ __forceinline__ void glds16(const void*gsrc,unsigned lds_dst){unsigned keep;
  asm volatile("s_mov_b32 %0, m0\n\ts_mov_b32 m0, %2\n\ts_nop 0\n\tglobal_load_lds_dwordx4 %1, off\n\ts_mov_b32 m0, %0":"=&s"(keep):"v"(gsrc),"s"(lds_dst):"memory");}
__device__ __forceinline__ float max3f(float a,float b,float c){float r;asm("v_max3_f32 %0, %1, %2, %3":"=v"(r):"v"(a),"v"(b),"v"(c));return r;}
__device__ __forceinline__ float max2f(float a,float b){float r;asm("v_max_f32_e32 %0, %1, %2":"=v"(r):"v"(a),"v"(b));return r;}
__device__ __forceinline__ float fadd_s(float a,float b){float r;asm("v_add_f32_e32 %0, %1, %2":"=v"(r):"v"(a),"v"(b));return r;}
__device__ __forceinline__ float fsub_s(float a,float b){float r;asm("v_sub_f32_e32 %0, %1, %2":"=v"(r):"v"(a),"v"(b));return r;}
typedef float f32x2_t __attribute__((ext_vector_type(2))); typedef __bf16 bf16x2_t __attribute__((ext_vector_type(2)));
__device__ __forceinline__ unsigned cvtpk_s(float lo,float hi){f32x2_t v={lo,hi};bf16x2_t b=__builtin_convertvector(v,bf16x2_t);return __builtin_bit_cast(unsigned,b);}
#define WAIT_BAR(N) asm volatile("s_waitcnt vmcnt(" #N ") lgkmcnt(0)\n\ts_barrier":::"memory")

__device__ __forceinline__ void qkt(f32x16&p0,f32x16&p1,const char*Kslot,const bf16x8*qr,const f32x16&negm,int r32,int hi){
  const char*kb=Kslot+hi*1024+r32*16;
  #pragma unroll
  for(int d0=0;d0<4;++d0){
    const bf16x8 b0=*reinterpret_cast<const bf16x8*>(kb+d0*2048);
    const bf16x8 b1=*reinterpret_cast<const bf16x8*>(kb+d0*2048+512);
    if(d0==0){p0=__builtin_amdgcn_mfma_f32_32x32x16_bf16(b0,qr[0],negm,0,0,0);p1=__builtin_amdgcn_mfma_f32_32x32x16_bf16(b1,qr[0],negm,0,0,0);}
    else{p0=__builtin_amdgcn_mfma_f32_32x32x16_bf16(b0,qr[d0],p0,0,0,0);p1=__builtin_amdgcn_mfma_f32_32x32x16_bf16(b1,qr[d0],p1,0,0,0);}}
}
typedef __attribute__((address_space(3))) const char* lds_cptr;
typedef short v4i16_t __attribute__((ext_vector_type(4)));
__device__ __forceinline__ void kload8(bf16x8*kf,lds_cptr kp){
  kf[0]=*(const __attribute__((address_space(3))) bf16x8*)(kp);      kf[1]=*(const __attribute__((address_space(3))) bf16x8*)(kp+512);
  kf[2]=*(const __attribute__((address_space(3))) bf16x8*)(kp+2048); kf[3]=*(const __attribute__((address_space(3))) bf16x8*)(kp+2560);
  kf[4]=*(const __attribute__((address_space(3))) bf16x8*)(kp+4096); kf[5]=*(const __attribute__((address_space(3))) bf16x8*)(kp+4608);
  kf[6]=*(const __attribute__((address_space(3))) bf16x8*)(kp+6144); kf[7]=*(const __attribute__((address_space(3))) bf16x8*)(kp+6656);
}
__device__ __forceinline__ void kload2(bf16x8*kf,lds_cptr kp,int j){ kf[2*j]=*(const __attribute__((address_space(3))) bf16x8*)(kp+j*2048); kf[2*j+1]=*(const __attribute__((address_space(3))) bf16x8*)(kp+j*2048+512); }
__device__ __forceinline__ s16x4 vtr(lds_cptr p){ return __builtin_bit_cast(s16x4,__builtin_amdgcn_ds_read_tr16_b64_v4i16((__attribute__((address_space(3))) v4i16_t*)p)); }
__device__ __forceinline__ float rowmax(const f32x16&p0,const f32x16&p1){
  float a=max3f(p0[0],p0[1],p1[0]),b=max3f(p0[2],p0[3],p1[1]);a=max3f(a,p1[2],p1[3]);
  #pragma unroll
  for(int r=4;r<16;r+=4){a=max3f(a,p0[r],p0[r+1]);b=max3f(b,p0[r+2],p0[r+3]);a=max3f(a,p1[r],p1[r+1]);b=max3f(b,p1[r+2],p1[r+3]);}
  const float m=max2f(a,b);
  auto rr=__builtin_amdgcn_permlane32_swap(__float_as_uint(m),__float_as_uint(m),false,false);
  return max2f(__uint_as_float(rr[0]),__uint_as_float(rr[1]));
}
__device__ __forceinline__ void pv(f32x16*o,int vb,bf16x8 pa0,bf16x8 pa1,bf16x8 pa2,bf16x8 pa3){
  #pragma unroll
  for(int d0=0;d0<2;++d0){s16x4 lo[4],hi[4];
    #pragma unroll
    for(int ks=0;ks<4;++ks){
      asm volatile("ds_read_b64_tr_b16 %0,%1 offset:%c2":"=&v"(lo[ks]):"v"(vb),"i"(d0*4096+ks*1024):"memory");
      asm volatile("ds_read_b64_tr_b16 %0,%1 offset:%c2":"=&v"(hi[ks]):"v"(vb),"i"(d0*4096+ks*1024+512):"memory");}
    asm volatile("s_waitcnt lgkmcnt(0)":::"memory");SBAR();
    #define PK(k) (bf16x8){lo[k][0],lo[k][1],lo[k][2],lo[k][3],hi[k][0],hi[k][1],hi[k][2],hi[k][3]}
    o[d0]=__builtin_amdgcn_mfma_f32_32x32x16_bf16(pa0,PK(0),o[d0],0,0,0);
    o[d0]=__builtin_amdgcn_mfma_f32_32x32x16_bf16(pa1,PK(1),o[d0],0,0,0);
    o[d0]=__builtin_amdgcn_mfma_f32_32x32x16_bf16(pa2,PK(2),o[d0],0,0,0);
    o[d0]=__builtin_amdgcn_mfma_f32_32x32x16_bf16(pa3,PK(3),o[d0],0,0,0);
    #undef PK
  }
}

#ifndef ATTN_STORE16
#define ATTN_STORE16(p,v) (*(u32x4*)(p)=(v))
#endif
template<int THRL> __device__ __forceinline__ void attn_unit(int b,int h,int qb,const bf16*Q,const bf16*__restrict__ K,const bf16*__restrict__ V,bf16*O,const float*__restrict__ CSg,const unsigned*KMg,char*shm,const int t0,const int ntl,const bool masked,float*__restrict__ Lout){
  int tid_o=threadIdx.x; asm volatile("":"+v"(tid_o)); const int tid=tid_o,lane=tid&63,r32=lane&31,hi=lane>>5; const int wid=__builtin_amdgcn_readfirstlane(tid>>6);
  const long rowbase=(long)b*SEQ; const int q0=qb*QB;
  const bf16*Qw=Q+(rowbase+q0+wid*QBLK)*DM+h*D;
  const bf16*Kh=K+(rowbase+(long)t0*KVBLK)*DM+h*D,*Vh=V+(rowbase+(long)t0*KVBLK)*DM+h*D;
  const unsigned lds0=(unsigned)(uintptr_t)shm;
  float*wsf=(float*)(shm+LDS_WS)+wid*64;
  const lds_cptr shm3=(lds_cptr)shm;
  const bf16*ksrc=Kh+(long)lane*DM+wid*8;
  const bf16*vsrc=Vh+(long)(16*(wid&3)+(lane>>2))*DM+(wid>>2)*32+(lane&3)*8;
  const unsigned kdst=lds0+LDS_K+wid*1024, vdst=lds0+LDS_V+wid*1024;
  #define DMA_K(t,slot) glds16(ksrc+(long)(t)*KVBLK*DM,(unsigned)__builtin_amdgcn_readfirstlane(kdst+(slot)))
  #define DMA_V(t,slot) glds16(vsrc+(long)(t)*KVBLK*DM,(unsigned)__builtin_amdgcn_readfirstlane(vdst+(slot)))
  const int vb0=(int)(lds0+LDS_V)+((lane>>4)&1)*32+(lane&3)*8+(4*hi+((lane&15)>>2))*64;
  const char*Kbase=shm+LDS_K; bf16x8 kf[8];
  const lds_cptr kp0=shm3+LDS_K+hi*1024+r32*16; const lds_cptr vp0=shm3+LDS_V+((lane>>4)&1)*32+(lane&3)*8+(4*hi+((lane&15)>>2))*64;
  const int NT=ntl;
  typedef __attribute__((address_space(3))) float* lds_fptr; typedef __attribute__((address_space(3))) f32x4_t* lds_f4ptr;
  const float*csh=CSg+(long)h*SEQ;
  { const lds_fptr ckw=(lds_fptr)(shm3+LDS_CK);
    for(int i=tid*4;i<ntl*KVBLK;i+=NW*64*4){ const f32x4_t v=*(const f32x4_t*)(csh+t0*KVBLK+i); *(lds_f4ptr)(ckw+i)=v; }
  }
  const float cq=csh[q0+wid*QBLK+r32];
  asm volatile("s_waitcnt vmcnt(0) lgkmcnt(0)\n\ts_barrier":::"memory");
  const lds_fptr ckt=(lds_fptr)(shm3+LDS_CK)+4*hi;
  #define CKSUB(P0,P1,t) do{ const lds_fptr ckp_=ckt+64*(t); _Pragma("unroll") for(int j_=0;j_<4;++j_){ const f32x4_t a_=*(const lds_f4ptr)(ckp_+8*j_); const f32x4_t b_=*(const lds_f4ptr)(ckp_+32+8*j_); \
      P0[4*j_]-=a_[0];P0[4*j_+1]-=a_[1];P0[4*j_+2]-=a_[2];P0[4*j_+3]-=a_[3]; P1[4*j_]-=b_[0];P1[4*j_+1]-=b_[1];P1[4*j_+2]-=b_[2];P1[4*j_+3]-=b_[3]; SBAR(); } }while(0)
  DMA_K(0,0);DMA_V(0,0);DMA_K(1,SLOTB);
  bf16x8 qr[4];
  #pragma unroll
  for(int d0=0;d0<4;++d0)qr[d0]=*reinterpret_cast<const bf16x8*>(&Qw[(long)r32*DM+d0*16+hi*8]);
  float l_reg=0.f;f32x16 o[2];o[0]=f32x16{};o[1]=f32x16{};f32x16 negm;
  {
    float q2=0.f;
    _Pragma("unroll") for(int d0=0;d0<4;++d0) _Pragma("unroll") for(int e=0;e<8;++e){ const float v=__uint_as_float(((unsigned)(unsigned short)qr[d0][e])<<16); q2+=v*v; }
    { auto rr=__builtin_amdgcn_permlane32_swap(__float_as_uint(q2),__float_as_uint(q2),false,false); q2=__uint_as_float(rr[0])+__uint_as_float(rr[1]); }
    const float km2=__uint_as_float(__hip_atomic_load(KMg+h,__ATOMIC_RELAXED,__HIP_MEMORY_SCOPE_AGENT));
    const float Rq=sqrtf(q2*km2)*1.001f+0.01f;
    _Pragma("unroll") for(int r=0;r<16;++r)negm[r]=cq-Rq; asm volatile("":"+v"(negm)); }
  const int qrel=wid*QBLK+r32;
  #define CMASK(P0,P1,t) do{int jb_=(t)-(NT-4); if(masked&&jb_>=0)cmask(P0,P1,jb_,qrel,hi);}while(0)
  #define START(P0,P1) do{ const float rm=rowmax(P0,P1); resc=false; \
    { const float dl=rm; mhat=fadd_s(mhat,dl); \
      _Pragma("unroll") for(int r=0;r<16;++r){P0[r]=fsub_s(P0[r],dl);P1[r]=fsub_s(P1[r],dl);} \
      _Pragma("unroll") for(int r=0;r<16;++r)negm[r]=-mhat; asm volatile("":"+v"(negm)); } \
    _Pragma("unroll") for(int r=0;r<16;++r)P0[r]=__builtin_amdgcn_exp2f(P0[r]); }while(0)
  #define RESC() do{ if(resc){ asm volatile("s_waitcnt lgkmcnt(0)":::"memory"); \
      _Pragma("unroll") for(int d_=0;d_<2;++d_) _Pragma("unroll") for(int r=0;r<16;++r)o[d_][r]*=wsf[crow(r,hi)]; } }while(0)
  f32x16 pA0,pA1,pB0,pB1;
  int sl_prev=0,sl_cur=0,sl_next=SLOTB;
  #define ROT() do{sl_prev=sl_cur;sl_cur=sl_next;sl_next=(sl_next==(NSLOT-1)*SLOTB)?0:sl_next+SLOTB;}while(0)
  DMA_K(2,2*SLOTB);
  WAIT_BAR(3);
  qkt(pA0,pA1,Kbase,qr,negm,r32,hi);asm volatile("s_nop 15\n\ts_nop 7":"+v"(pA0),"+v"(pA1));CKSUB(pA0,pA1,0);CMASK(pA0,pA1,0);
  _Pragma("unroll") for(int r=0;r<16;++r)pA0[r]=__builtin_amdgcn_exp2f(pA0[r]);
  _Pragma("unroll") for(int r=0;r<16;++r)pA1[r]=__builtin_amdgcn_exp2f(pA1[r]);
  WAIT_BAR(0);
  DMA_K(3,0);DMA_V(1,SLOTB);
  ROT();
  kload8(kf,kp0+sl_cur);
  WAIT_BAR(2);
  s16x4 vlo[8],vhi[8]; u32x4 pw0,pw1,pw2,pw3;
  #define PKW(P,B) cvtpk_s(P[B],P[B+1])
  #define PAF(k) __builtin_bit_cast(bf16x8,pw##k)
  #define VFR(i) (bf16x8){vlo[i][0],vlo[i][1],vlo[i][2],vlo[i][3],vhi[i][0],vhi[i][1],vhi[i][2],vhi[i][3]}
  #define PIN(x) asm volatile("":"+v"(x))
  #define MX3(a,b,c) __builtin_fmaxf(__builtin_fmaxf((a),(b)),(c))
  #define GAPA(MF,A0,A1,A2,A3,W0,W1,PW) do{ MF; sacc+=A0; sacc+=A1; sacc+=A2; sacc+=A3; PIN(sacc); W0; W1; PIN(PW); SBAR(); }while(0)
  #define EX(v) __builtin_amdgcn_exp2f(v)
  #define GAPB(MF,X,B,CUR,NXT,NOFF) do{ MF; if((NOFF)>=0){ NXT=*(const lds_f4ptr)(ckp_+((NOFF)>=0?(NOFF):0)); } X[B]=EX(X[B]-CUR[0]); X[B+1]=EX(X[B+1]-CUR[1]); X[B+2]=EX(X[B+2]-CUR[2]); X[B+3]=EX(X[B+3]-CUR[3]); PIN(X); SBAR(); }while(0)
  #define VRD(i) do{ vlo[i]=vtr(vp_+(((i)>>2)*4096+((i)&3)*1024)); vhi[i]=vtr(vp_+(((i)>>2)*4096+((i)&3)*1024+512)); }while(0)
  #define KRD(G,j) do{ if(G){ kload2(kf,kp0+sl_next,j); SBAR(); } }while(0)
  #define STEP(C0,C1,P0,P1,t,GK,GV,GL) do{ SBAR(); \
    const lds_cptr vp_=vp0+sl_prev; \
    VRD(0); SBAR(); float sacc=(P0[0]+P0[1]); \
    GAPA(C0=__builtin_amdgcn_mfma_f32_32x32x16_bf16(kf[0],qr[0],negm,0,0,0), P0[2],P0[3],P0[4],P0[5],     pw0[0]=PKW(P0,0), pw0[1]=PKW(P0,2), pw0); \
    VRD(4); SBAR(); GAPA(C1=__builtin_amdgcn_mfma_f32_32x32x16_bf16(kf[1],qr[0],negm,0,0,0), P0[6],P0[7],P0[8],P0[9],     pw0[2]=PKW(P0,4), pw0[3]=PKW(P0,6), pw0); \
    VRD(1); SBAR(); GAPA(C0=__builtin_amdgcn_mfma_f32_32x32x16_bf16(kf[2],qr[1],C0,0,0,0),   P0[10],P0[11],P0[12],P0[13], pw1[0]=PKW(P0,8), pw1[1]=PKW(P0,10), pw1); \
    VRD(5); SBAR(); GAPA(C1=__builtin_amdgcn_mfma_f32_32x32x16_bf16(kf[3],qr[1],C1,0,0,0),   P0[14],P0[15],P1[0],P1[1],   pw1[2]=PKW(P0,12),pw1[3]=PKW(P0,14), pw1); \
    VRD(2); SBAR(); GAPA(C0=__builtin_amdgcn_mfma_f32_32x32x16_bf16(kf[4],qr[2],C0,0,0,0),   P1[2],P1[3],P1[4],P1[5],     pw2[0]=PKW(P1,0), pw2[1]=PKW(P1,2), pw2); \
    VRD(6); SBAR(); GAPA(C1=__builtin_amdgcn_mfma_f32_32x32x16_bf16(kf[5],qr[2],C1,0,0,0),   P1[6],P1[7],P1[8],P1[9],     pw2[2]=PKW(P1,4), pw2[3]=PKW(P1,6), pw2); \
    VRD(3); SBAR(); GAPA(C0=__builtin_amdgcn_mfma_f32_32x32x16_bf16(kf[6],qr[3],C0,0,0,0),   P1[10],P1[11],P1[12],P1[13], pw3[0]=PKW(P1,8), pw3[1]=PKW(P1,10), pw3); \
    VRD(7); SBAR(); GAPA(C1=__builtin_amdgcn_mfma_f32_32x32x16_bf16(kf[7],qr[3],C1,0,0,0),   P1[14],P1[15],0.f,0.f,       pw3[2]=PKW(P1,12),pw3[3]=PKW(P1,14), pw3); \
    l_reg+=sacc; \
    if(GK){DMA_K((t)+3,sl_cur);} if(GV){DMA_V((t)+1,sl_next);} \
    CMASK(C0,C1,t); \
    const lds_fptr ckp_=ckt+64*(t); f32x4_t ckA_=*(const lds_f4ptr)(ckp_), ckB_; \
    SBAR(); \
    GAPB(o[0]=__builtin_amdgcn_mfma_f32_32x32x16_bf16(PAF(0),VFR(0),o[0],0,0,0), C0,0,ckA_,ckB_,8); \
    GAPB(o[1]=__builtin_amdgcn_mfma_f32_32x32x16_bf16(PAF(0),VFR(4),o[1],0,0,0), C0,4,ckB_,ckA_,16); \
    KRD(GL,0); GAPB(o[0]=__builtin_amdgcn_mfma_f32_32x32x16_bf16(PAF(1),VFR(1),o[0],0,0,0), C0,8,ckA_,ckB_,24); \
    KRD(GL,1); GAPB(o[1]=__builtin_amdgcn_mfma_f32_32x32x16_bf16(PAF(1),VFR(5),o[1],0,0,0), C0,12,ckB_,ckA_,32); \
    KRD(GL,2); GAPB(o[0]=__builtin_amdgcn_mfma_f32_32x32x16_bf16(PAF(2),VFR(2),o[0],0,0,0), C1,0,ckA_,ckB_,40); \
    KRD(GL,3); GAPB(o[1]=__builtin_amdgcn_mfma_f32_32x32x16_bf16(PAF(2),VFR(6),o[1],0,0,0), C1,4,ckB_,ckA_,48); \
    GAPB(o[0]=__builtin_amdgcn_mfma_f32_32x32x16_bf16(PAF(3),VFR(3),o[0],0,0,0), C1,8,ckA_,ckB_,56); \
    GAPB(o[1]=__builtin_amdgcn_mfma_f32_32x32x16_bf16(PAF(3),VFR(7),o[1],0,0,0), C1,12,ckB_,ckA_,-1); \
    }while(0)
  int t=1;
  #undef CMASK
  #define CMASK(P0,P1,t) do{}while(0)
  for(;t+5<NT;t+=2){
    STEP(pB0,pB1,pA0,pA1,t,true,true,true);     WAIT_BAR(2); ROT();
    STEP(pA0,pA1,pB0,pB1,t+1,true,true,true);   WAIT_BAR(2); ROT();
  }
  #undef CMASK
  #define CMASK(P0,P1,t) do{int jb_=(t)-(NT-4); if(masked&&jb_>=0)cmask(P0,P1,jb_,qrel,hi);}while(0)
  #define ENDW(tt) do{ if((tt)+3<NT){WAIT_BAR(2);} else if((tt)+2<NT){WAIT_BAR(1);} else {WAIT_BAR(0);} }while(0)
  for(;t+1<NT;t+=2){
    STEP(pB0,pB1,pA0,pA1,t,(t+3<NT),(t+1<NT),(t+1<NT));       ENDW(t); ROT();
    STEP(pA0,pA1,pB0,pB1,t+1,(t+4<NT),(t+2<NT),(t+2<NT));     ENDW(t+1); ROT();
  }
  STEP(pB0,pB1,pA0,pA1,NT-1,false,false,false);
  { float sacc=pB0[0]+pB0[1]; _Pragma("unroll") for(int r=2;r<16;++r)sacc+=pB0[r]; _Pragma("unroll") for(int r=0;r<16;++r)sacc+=pB1[r]; l_reg+=sacc;
    pw0=(u32x4){PKW(pB0,0),PKW(pB0,2),PKW(pB0,4),PKW(pB0,6)};pw1=(u32x4){PKW(pB0,8),PKW(pB0,10),PKW(pB0,12),PKW(pB0,14)};pw2=(u32x4){PKW(pB1,0),PKW(pB1,2),PKW(pB1,4),PKW(pB1,6)};pw3=(u32x4){PKW(pB1,8),PKW(pB1,10),PKW(pB1,12),PKW(pB1,14)};
    SBAR(); pv(o,vb0+sl_cur,PAF(0),PAF(1),PAF(2),PAF(3)); }
  #undef PKW
  #undef PAF
  #undef VFR
  #undef PIN
  #undef MX3
  #undef GAPA
  #undef GAPB
  #undef EX
  #undef VRD
  #undef KRD
  #undef STEP
  #undef ENDW
  {auto rr=__builtin_amdgcn_permlane32_swap(__float_as_uint(l_reg),__float_as_uint(l_reg),false,false);l_reg=__uint_as_float(rr[0])+__uint_as_float(rr[1]);}
  if(hi==0){wsf[32+r32]=l_reg; Lout[(long)(q0+wid*QBLK+r32)*NHEAD+h]=l_reg;}asm volatile("s_waitcnt lgkmcnt(0)":::"memory");
  float rli[16];
  #pragma unroll
  for(int r=0;r<16;++r){const float lv_=wsf[32+crow(r,hi)]; rli[r]=lv_>1e-30f?__builtin_amdgcn_rcpf(lv_):0.f;}
  bf16*Ow=O+(rowbase+q0+wid*QBLK)*DM+h*D;
  { bf16*stg=(bf16*)(shm+LDS_OST)+wid*2048;
    #pragma unroll
    for(int r=0;r<16;++r){const int orow=crow(r,hi);
      #pragma unroll
      for(int d0=0;d0<2;++d0)stg[orow*64+d0*32+r32]=__float2bfloat16(o[d0][r]*rli[r]);}
    asm volatile("s_waitcnt lgkmcnt(0)":::"memory");
    #pragma unroll
    for(int i=0;i<4;++i){const int row=i*8+(lane>>3),ch=lane&7; const u32x4 v=*(const u32x4*)(stg+row*64+ch*8); ATTN_STORE16(Ow+(long)row*DM+ch*8,v);} }
  asm volatile("s_waitcnt lgkmcnt(0)\n\ts_barrier":::"memory");
  #undef CKSUB
  #undef DMA_K
  #undef DMA_V
  #undef CMASK
  #undef START
  #undef RESC
  #undef ROT
}
constexpr int ATTN_LDS_BYTES=LDS_BYTES;
struct AttnTensors { const bf16* Q; const bf16* K; const bf16* V; bf16* O; const float* CS; const unsigned* KM; };
struct AttnUnit { int bh; int qb; };
struct StaticOrder {
  int vcu,G;
  __device__ __forceinline__ explicit StaticOrder(int grid,int block):vcu((grid%8==0)?(block%8)*(grid/8)+block/8:block),G(grid){}
  __device__ __forceinline__ bool next(int i,AttnUnit&u)const{
    if(G==256){ if(i>=2)return false; const int s=vcu&31; u.bh=vcu>>5; u.qb=(i==0)?s:63-s; return true; }
    const int Lx=i*G+vcu; if(Lx>=NHEAD*NQB)return false; u.bh=Lx/NQB; u.qb=NQB-1-(Lx%NQB); return true; }
  __device__ __forceinline__ void a_ready(const AttnUnit&)const{}
  __device__ __forceinline__ void done(const AttnUnit&)const{}
};
template<class Sched,int THRL=8> __device__ __forceinline__ void attn_phase(char*lds,const AttnTensors&T,const Sched&S){
  AttnUnit u;
  for(int i=0;S.next(i,u);++i){ S.a_ready(u); attn_unit<THRL>(0,u.bh,u.qb,T.Q,T.K,T.V,T.O,T.CS,T.KM,lds,0,4*(u.qb+1),true,(float*)nullptr); S.done(u); }
}
#undef SBAR
#undef WAIT_BAR
}
#define LAS __attribute__((address_space(3)))
typedef unsigned short bf16;
typedef unsigned v4u __attribute__((ext_vector_type(4)));
typedef unsigned v2u __attribute__((ext_vector_type(2)));
typedef float f32x4 __attribute__((ext_vector_type(4)));
typedef short bf16x8 __attribute__((ext_vector_type(8)));
constexpr int NWAVES = 8, NTHREADS = 512;
constexpr int M = 16384, D = 1024, FF = 2816, MEML = 256, DIN = 7176, NLAYER = 2;
constexpr float EPS = 1e-6f, LOG2E = 1.4426950408889634f;
constexpr int LDS_BYTES = 155648, XB_LDS_OFF = LDS_BYTES - 256, T0_LDS_OFF = 149504, RS_LDS_OFF = 131072 + 256;
static_assert(attn_body::ATTN_LDS_BYTES <= LDS_BYTES, "lds");
constexpr size_t MiB = 1u << 20;
constexpr size_t WS_SS = 1 * MiB, WS_SSV = 2 * MiB, WS_LF = 2 * MiB + 512 * 1024, WS_CS = 3 * MiB, WS_RSM = 3 * MiB + 512 * 1024, WS_MEMB = 4 * MiB, WS_KC = 4 * MiB + 512 * 1024, WS_VCT = 5 * MiB;
constexpr size_t WS_LPL = 5 * MiB + 512 * 1024, WS_LP = 66 * MiB + 256 * 1024;
constexpr size_t WS_W = 6 * MiB, WS_XB = 68 * MiB, WS_SCR = 100 * MiB, WS_WL = 244 * MiB, WS_VT2 = 246 * MiB, WS_END = 248 * MiB;
constexpr size_t WO_GU1 = 0, WO_D1 = WO_GU1 + (size_t)5632 * 1024, WO_IN = WO_D1 + (size_t)1024 * 2816, WO_G = WO_IN + (size_t)4096 * 1024, WO_B = WO_G + (size_t)3072 * 1024,
                 WO_O = WO_B + (size_t)3 * 1024 * 512, WO_Q = WO_O + (size_t)1024 * 1024, WO_K = WO_Q + (size_t)1024 * 1024, WO_V = WO_K + (size_t)1024 * 1024, WO_XO = WO_V + (size_t)1024 * 1024,
                 WO_GU2 = WO_XO + (size_t)1024 * 1024, WO_D2 = WO_GU2 + (size_t)5632 * 1024, WO_END = WO_D2 + (size_t)1024 * 2816;
static_assert(WS_W + (WO_END + 16 * 1024) * 2 <= WS_LP && WS_LP + 3 * 512 * 1024 <= WS_XB, "weights fit");
constexpr size_t PIECE = (size_t)M * 512;

typedef __attribute__((address_space(1))) unsigned gu32;
#define RLX_AGENT __ATOMIC_RELAXED, __HIP_MEMORY_SCOPE_AGENT
#define XB_TMO      128
#define XB_XCNT(j)  (256  + 64 * (j))
#define XB_XSUB(j)  (1280 + 64 * (j))
#define XB_XGEN(j)  (2304 + 64 * (j))
#define XB_TOP      3328
#define XB_TOPGEN   3392
#define XCD_BAR_WORDS 3456
#define XB_SPIN_CAP (1u << 18)

__device__ __forceinline__ unsigned xb_ld(unsigned* p)              { return __hip_atomic_load(p, __ATOMIC_RELAXED, __HIP_MEMORY_SCOPE_AGENT); }
__device__ __forceinline__ unsigned xb_add(unsigned* p, unsigned v) { return __hip_atomic_fetch_add(p, v, __ATOMIC_RELAXED, __HIP_MEMORY_SCOPE_AGENT); }
__device__ __forceinline__ unsigned xb_xcc_id() { return (unsigned)__builtin_amdgcn_s_getreg((3 << 11) | 20) & 0xFu; }
#define XB_SPIN(cond, bar) do { unsigned _sp = 0; while (cond) { __builtin_amdgcn_s_sleep(1); \
    if ((++_sp & 255u) == 0u) { if (xb_ld(&(bar)[XB_TMO])) break; if (_sp > XB_SPIN_CAP) { atomicAdd(&(bar)[XB_TMO], 1u); break; } } } } while (0)

struct XcdBarrier {
    unsigned* bar; unsigned x;
    volatile LAS unsigned* st;
};

__device__ __forceinline__ XcdBarrier xcd_barrier_post(unsigned* bar, volatile LAS unsigned* st) {
    XcdBarrier b; b.bar = bar; b.x = xb_xcc_id(); b.st = st;
    if (threadIdx.x == 0) (void)xb_add(&bar[XB_XCNT(b.x)], 1u);
    return b;
}
__device__ __forceinline__ void xcd_barrier_complete(unsigned* bar, unsigned x, unsigned& nloc, unsigned& nx) {
    const unsigned G = gridDim.x * gridDim.y * gridDim.z;
    unsigned sum, cnt, mine, sp = 0u;
    for (;;) {
        sum = 0u; cnt = 0u; mine = 0u;
#pragma unroll
        for (unsigned j = 0; j < 16; ++j) { const unsigned c = xb_ld(&bar[XB_XCNT(j)]); sum += c; cnt += (c > 0u) ? 1u : 0u; mine = (j == x) ? c : mine; }
        if (sum == G) break;
        __builtin_amdgcn_s_sleep(1);
        if ((++sp & 255u) == 0u) { if (xb_ld(&bar[XB_TMO])) break; if (sp > XB_SPIN_CAP) { atomicAdd(&bar[XB_TMO], 1u); break; } }
    }
    nloc = mine > 0u ? mine : 1u; nx = cnt > 0u ? cnt : 1u;
}

__device__ __forceinline__ void xcd_barrier(const XcdBarrier& b) {
    asm volatile("s_waitcnt vmcnt(0)" ::: "memory");
    __syncthreads();
    if (threadIdx.x == 0) {
        unsigned* bar = b.bar;
        __builtin_amdgcn_s_waitcnt(0);
        unsigned nloc = b.st[0], nx = b.st[1];
        if (nloc == 0u) { xcd_barrier_complete(bar, b.x, nloc, nx); b.st[0] = nloc; b.st[1] = nx; }
        const unsigned old = xb_add(&bar[XB_XSUB(b.x)], 1u);
        const unsigned gen = old / nloc;
        if (old + 1u == (gen + 1u) * nloc) {
            __builtin_amdgcn_fence(__ATOMIC_RELEASE, "agent");
            asm volatile("s_waitcnt vmcnt(0)" ::: "memory");
            asm volatile("buffer_inv sc1" ::: "memory");
            const unsigned og = xb_add(&bar[XB_TOP], 1u);
            const unsigned tg = og / nx;
            if (og + 1u == (tg + 1u) * nx) xb_add(&bar[XB_TOPGEN], 1u);
            else XB_SPIN(xb_ld(&bar[XB_TOPGEN]) == tg, bar);
            asm volatile("" ::: "memory");
            xb_add(&bar[XB_XGEN(b.x)], 1u);
            asm volatile("s_waitcnt vmcnt(0)" ::: "memory");
        } else {
            asm volatile("buffer_inv sc1" ::: "memory");
            XB_SPIN(xb_ld(&bar[XB_XGEN(b.x)]) == gen, bar);
            asm volatile("" ::: "memory");
            asm volatile("s_waitcnt vmcnt(0)" ::: "memory");
        }
    }
    __syncthreads();
}
struct Args { const float* in[26]; float* out; unsigned char* ws; int ph_lo, ph_hi; };

__device__ __forceinline__ unsigned f2bf(float f) { unsigned u = __builtin_bit_cast(unsigned, f); return (u + 0x7fffu + ((u >> 16) & 1u)) >> 16; }
__device__ __forceinline__ unsigned pk2(float lo, float hi) { return f2bf(lo) | (f2bf(hi) << 16); }
__device__ __forceinline__ float b2f(unsigned short b) { return __uint_as_float((unsigned)b << 16); }
__device__ __forceinline__ float wave_sum(float v) {
#pragma unroll
    for (int o = 1; o < 64; o <<= 1) v += __shfl_xor(v, o);
    return v;
}
#define LDS_WAIT() asm volatile("s_waitcnt lgkmcnt(0)" ::: "memory")
__device__ __forceinline__ void conv_item(const float* W, int spitch, int k0, int n0, bf16* WT, int dpitch, int drow0, const float* gain, LAS float* scr, int lane) {
#pragma unroll
    for (int i = 0; i < 32; ++i) { const int kk = 2 * i + (lane >> 5); float v = W[(size_t)(k0 + kk) * spitch + n0 + (lane & 31)]; if (gain) v *= gain[k0 + kk]; scr[kk * 33 + (lane & 31)] = v; }
    LDS_WAIT(); asm volatile("" ::: "memory");
    const int c = lane & 7;
#pragma unroll
    for (int j = 0; j < 4; ++j) { const int n = (lane >> 3) + 8 * j; const LAS float* s = scr + (8 * c) * 33 + n;
        v4u o; o.x = pk2(s[0 * 33], s[1 * 33]); o.y = pk2(s[2 * 33], s[3 * 33]); o.z = pk2(s[4 * 33], s[5 * 33]); o.w = pk2(s[6 * 33], s[7 * 33]);
        *(v4u*)(WT + (size_t)(drow0 + n) * dpitch + k0 + 8 * c) = o; }
    LDS_WAIT(); asm volatile("" ::: "memory");
}
__device__ __forceinline__ void conv_job(int& it, int& base, int NGW, const float* W, int spitch, int K, int scol0, int ncols, bf16* WT, int doff, bool ilv, const float* gain, LAS float* scr, int lane) {
    const int nblk = ncols / 32, nitems = (K / 64) * nblk;
    for (; it < base + nitems; it += NGW) { const int r = it - base, kb = r / nblk, nb = r % nblk, nl = 32 * nb;
        const int drow0 = ilv ? (256 * (nl / 128) + (nl % 128) + doff) : (doff + nl);
        conv_item(W, spitch, 64 * kb, scol0 + nl, WT, K, drow0, gain, scr, lane); }
    base += nitems;
}

__device__ __forceinline__ void panel_rstd(const float* SSp, int pm, LAS float* rsl, int tid) {
    if (tid < 256) { const f32x4* p4 = (const f32x4*)(SSp + (size_t)(pm * 256 + tid) * 16); const f32x4 a = p4[0], b = p4[1], c = p4[2], d = p4[3];
        const float s = ((a[0] + a[1]) + (a[2] + a[3])) + ((b[0] + b[1]) + (b[2] + b[3])) + ((c[0] + c[1]) + (c[2] + c[3])) + ((d[0] + d[1]) + (d[2] + d[3]));
        rsl[tid] = rsqrtf(s * (1.0f / 1024.0f) + 1e-6f); }
    __syncthreads();
}
__device__ __forceinline__ int attn_skip_tiles(const float* csh, int qb, float R) {
    const int lim = 4 * (qb + 1) - 4; const float thr = csh[256 * qb] + 152.0f + 2.0f * R;
    int seg = 0, cnt = 0;
#pragma unroll
    for (int j = 0; j < 16; ++j) { const int tl = 16 * j + 15; const float cv = csh[64 * (tl < lim ? tl : 0) + 63]; seg += (tl < lim && cv > thr) ? 1 : 0; }
#pragma unroll
    for (int i = 0; i < 16; ++i) { const int tl = 16 * seg + i; const float cv = csh[64 * (tl < lim ? tl : 0) + 63]; cnt += (tl < lim && cv > thr) ? 1 : 0; }
    return (16 * seg + cnt) & ~1;
}
__device__ __forceinline__ int attn_chunks(int len) { int n = (len + 63) >> 6; if (n > 1 && len - 64 * (n - 1) < 4) --n; return n; }
__global__ void __launch_bounds__(NTHREADS, 2) mk_fwd(Args args) {
    __builtin_assume(__builtin_amdgcn_workitem_id_y() == 0); __builtin_assume(__builtin_amdgcn_workitem_id_z() == 0);
    extern __shared__ __attribute__((aligned(16))) unsigned char lds[];
    cg::grid_group grid = cg::this_grid();
    LAS unsigned char* ldsp = (LAS unsigned char*)lds;
    if (threadIdx.x < 2) ((volatile LAS unsigned*)(ldsp + XB_LDS_OFF))[threadIdx.x] = 0u;
    __syncthreads();
    const XcdBarrier xbar = xcd_barrier_post((unsigned*)args.ws, (volatile LAS unsigned*)(ldsp + XB_LDS_OFF));
    const int G = gridDim.x, bx = blockIdx.x;
    const int vcu = (G % 8 == 0) ? (bx % 8) * (G / 8) + bx / 8 : bx;
    const int NGW = G * NWAVES;
#define TIDS() int tid_o = threadIdx.x; asm volatile("" : "+v"(tid_o)); const int tid = tid_o, lane = tid & 63, wave = __builtin_amdgcn_readfirstlane(tid >> 6), gw = vcu * NWAVES + wave; (void)gw; (void)lane; (void)tid
#ifdef MK_TIME_A
    unsigned char* const tsbase = args.ws + 49152;
#endif
#define KARGS() const __attribute__((address_space(4))) Args* ap_ = (const __attribute__((address_space(4))) Args*)__builtin_amdgcn_kernarg_segment_ptr(); asm volatile("" : "+s"(ap_))
#define ws (ap_->ws)
#define X (ap_->out)
#define SS ((float*)(ws + WS_SS))
#define SSV ((float*)(ws + WS_SSV))
#define LF ((float*)(ws + WS_LF))
#define CS ((float*)(ws + WS_CS))
#define RSM ((float*)(ws + WS_RSM))
#define MEMB ((bf16*)(ws + WS_MEMB))
#define KC ((bf16*)(ws + WS_KC))
#define VCT ((bf16*)(ws + WS_VCT))
#define Wt ((bf16*)(ws + WS_W))
#define XB ((bf16*)(ws + WS_XB))
#define SCR ((bf16*)(ws + WS_SCR))
#define WL ((bf16*)(ws + WS_WL))
#define VT2 ((bf16*)(ws + WS_VT2))
#define ACT SCR
#define PROJ SCR
#define GT (SCR + 3 * PIECE)
#define XQ SCR
#define PB (SCR + (size_t)M * 1024)
#define OB (SCR + (size_t)2 * M * 1024)
    const int lo = args.ph_lo, hi = args.ph_hi;
    if (lo < 0) grid.sync();
#ifndef PHMASK
#define PHMASK 0xffff
#endif
#define IN(k) (((PHMASK >> (((k) == 30) ? 15 : ((k) - pb == 13 || (k) - pb == 14) ? (k) - pb - 12 : (k) - pb)) & 1) && lo <= (k) && (k) < hi)
#define GRID_SYNC() do { asm volatile("s_waitcnt vmcnt(0) lgkmcnt(0)" ::: "memory"); grid.sync(); } while (0)
#define WG_SEAM() do { asm volatile("s_waitcnt vmcnt(0) lgkmcnt(0)" ::: "memory"); __syncthreads(); } while (0)
#define SEAM_LOCAL(k) do { if (lo <= (k) && (k) + 1 < hi) { if (G == 256) WG_SEAM(); else xcd_barrier(xbar); } } while (0)
#ifdef MK_TIME_A
#define STAMP(k) do { if (blockIdx.x == 0 && threadIdx.x == 0) __hip_atomic_store((unsigned long long*)tsbase + (k) + 1, (unsigned long long)__builtin_amdgcn_s_memrealtime(), __ATOMIC_RELAXED, __HIP_MEMORY_SCOPE_AGENT); } while (0)
#else
#define STAMP(k) do { } while (0)
#endif
#define SEAM(k) do { if (lo <= (k) && (k) + 1 < hi) { xcd_barrier(xbar); STAMP(k); } } while (0)
#define in (ap_->in)
#define CONV_TILE(it) \
            do { \
                int r = it; const float* W; const float* gain = nullptr; bf16* WT; int spitch, K, scol0 = 0, nblk, doff = 0; bool ilv = false, notr = false; \
                if (r < 2 * I_UP) { const int w = r / I_UP; r -= w * I_UP; W = in[3 + w] + lff; gain = in[2] + l1; WT = Wt + WO_GU1; spitch = FF; K = 1024; nblk = 11; doff = 128 * w; ilv = true; } \
                else if ((r -= 2 * I_UP) < 2 * I_SQ) { const int w = r / I_SQ; r -= w * I_SQ; W = in[18 + w] + ldd; gain = in[16] + l1; WT = Wt + WO_K + (size_t)w * 1024 * 1024; spitch = 1024; K = 1024; nblk = 4; } \
                else if ((r -= 2 * I_SQ) < I_DN) { W = in[5] + lff; WT = Wt + WO_D1; spitch = 1024; K = FF; nblk = 4; } \
                else if ((r -= I_DN) < I_IN) { W = in[7] + (size_t)l * 1024 * DIN; gain = in[6] + l1; WT = Wt + WO_IN; spitch = DIN; K = 1024; nblk = 16; } \
                else if ((r -= I_IN) < I_G) { W = in[7] + (size_t)l * 1024 * DIN; gain = in[6] + l1; WT = Wt + WO_G; spitch = DIN; K = 1024; nblk = 12; scol0 = 4104; } \
                else if ((r -= I_G) < 3 * I_B) { const int w = r / I_B; r -= w * I_B; W = in[13] + ((size_t)l * 3 + w) * 512 * 1024; WT = Wt + WO_B + (size_t)w * 1024 * 512; spitch = 1024; K = 512; nblk = 4; } \
                else if ((r -= 3 * I_B) < I_SQ) { W = in[14] + ldd; WT = Wt + WO_O; spitch = 1024; K = 1024; nblk = 4; } \
                else if ((r -= I_SQ) < I_SQ) { W = in[17] + ldd; gain = in[15] + l1; WT = Wt + WO_Q; spitch = 1024; K = 1024; nblk = 4; notr = true; } \
                else if ((r -= I_SQ) < I_SQ) { W = in[20] + ldd; WT = Wt + WO_XO; spitch = 1024; K = 1024; nblk = 4; } \
                else if ((r -= I_SQ) < 2 * I_UP) { const int w = r / I_UP; r -= w * I_UP; W = in[22 + w] + lff; gain = in[21] + l1; WT = Wt + WO_GU2; spitch = FF; K = 1024; nblk = 11; doff = 128 * w; ilv = true; } \
                else { r -= 2 * I_UP; W = in[24] + lff; WT = Wt + WO_D2; spitch = 1024; K = FF; nblk = 4; } \
                const int k0 = 64 * (r / nblk), nl0 = 256 * (r % nblk); \
                if (notr) { \
_Pragma("unroll") \
                    for (int i = 0; i < 8; ++i) { const int kr = k0 + 8 * wave + i; const f32x4 v = __builtin_nontemporal_load((const f32x4*)(W + (size_t)kr * spitch + nl0 + 4 * lane)) * gain[kr]; \
                        v2u o; o.x = pk2(v[0], v[1]); o.y = pk2(v[2], v[3]); *(v2u*)(WT + (size_t)kr * 1024 + nl0 + 4 * lane) = o; } \
                    continue; \
                } \
                { \
                    f32x4 v[8]; \
_Pragma("unroll") \
                    for (int i = 0; i < 8; ++i) v[i] = __builtin_nontemporal_load((const f32x4*)(W + (size_t)(k0 + 8 * wave + i) * spitch + scol0 + nl0 + 4 * lane)); \
_Pragma("unroll") \
                    for (int i = 0; i < 8; ++i) { const float gk = gain ? gain[k0 + 8 * wave + i] : 1.0f; *(LAS f32x4*)(Tl + (8 * wave + i) * 260 + 4 * lane) = v[i] * gk; } \
                } \
                __syncthreads(); \
                { \
                    const int n = tid & 255, kh = tid >> 8, nl = nl0 + n; \
                    const int drow = ilv ? (256 * (nl / 128) + (nl % 128) + doff) : (doff + nl); \
                    v4u o[4]; \
_Pragma("unroll") \
                    for (int q = 0; q < 4; ++q) \
_Pragma("unroll") \
                        for (int e = 0; e < 4; ++e) o[q][e] = pk2(Tl[(32 * kh + 8 * q + 2 * e) * 260 + n], Tl[(32 * kh + 8 * q + 2 * e + 1) * 260 + n]); \
_Pragma("unroll") \
                    for (int q = 0; q < 4; ++q) *(v4u*)(WT + (size_t)drow * K + k0 + 32 * kh + 8 * q) = o[q]; \
                } \
                __syncthreads(); \
            } while (0)
STAMP(-1);
int pb = 0;
#pragma nounroll
    for (int l = 0; l < NLAYER; ++l) {
        pb = 15 * l;
        if (IN(pb + 0)) { KARGS(); TIDS();
#ifndef MK_REP_P0
#define MK_REP_P0 1
#endif
_Pragma("nounroll")
          for (int rep0 = 0; rep0 < MK_REP_P0; ++rep0) {
            const size_t l1 = (size_t)l * 1024, lff = (size_t)l * 1024 * 2816, ldd = (size_t)l * 1024 * 1024;
            constexpr int I_UP = 16 * 11, I_DN = 44 * 4, I_IN = 16 * 16, I_G = 16 * 12, I_B = 8 * 4, I_SQ = 16 * 4;
            constexpr int NIT = 4 * I_UP + 2 * I_DN + I_IN + I_G + 3 * I_B + 5 * I_SQ, NE0 = 480;
            const int NE = (G == 256) ? 960 : 0;
            LAS float* Tl = (LAS float*)ldsp;
#pragma nounroll
            for (int jt = vcu; jt < NIT - NE; jt += G) { const int it = jt < NE0 ? jt : jt + NE; CONV_TILE(it); }
            {
                const float* wf = in[7] + (size_t)l * 1024 * DIN + 4096; const float* gn = in[6] + l1; bf16* WF = Wt + WO_END;
                for (int idx = vcu * NTHREADS + tid; idx < 8192; idx += G * NTHREADS) { const int k = idx >> 3, hd = idx & 7;
                    const float v = wf[(size_t)k * DIN + hd] * gn[k]; const unsigned hb = f2bf(v); const float lo = v - __uint_as_float(hb << 16);
                    WF[(size_t)hd * 1024 + k] = (bf16)hb; WF[(size_t)(8 + hd) * 1024 + k] = (bf16)f2bf(lo); }
            }
            if (l == 0) {
                for (int m0 = gw; m0 < M + MEML; m0 += 4 * NGW) {
                    f32x4 v[4][4];
#pragma unroll
                    for (int i = 0; i < 4; ++i) { const int m = (m0 + i * NGW < M + MEML) ? m0 + i * NGW : m0; const bool ism = m >= M; const int r = ism ? m - M : m;
                        const f32x4* xr = (const f32x4*)((ism ? in[1] : in[0]) + (size_t)r * D) + lane;
#pragma unroll
                        for (int j = 0; j < 4; ++j) v[i][j] = __builtin_nontemporal_load(xr + 64 * j); }
                    asm volatile("" ::: "memory");
#pragma unroll
                    for (int i = 0; i < 4; ++i) { const int m = m0 + i * NGW; if (m >= M + MEML) break; const bool ism = m >= M; const int r = ism ? m - M : m;
                        float s = 0.f;
#pragma unroll
                        for (int j = 0; j < 4; ++j) s += (v[i][j][0] * v[i][j][0] + v[i][j][1] * v[i][j][1]) + (v[i][j][2] * v[i][j][2] + v[i][j][3] * v[i][j][3]);
                        s = wave_sum(s);
                        v2u* ob = (v2u*)((ism ? MEMB : XB) + (size_t)r * D) + lane;
#pragma unroll
                        for (int j = 0; j < 4; ++j) { v2u w; w.x = pk2(v[i][j][0], v[i][j][1]); w.y = pk2(v[i][j][2], v[i][j][3]); ob[64 * j] = w; }
                        if (!ism) {
                            if (lane < 16) SS[(size_t)r * 16 + lane] = lane == 0 ? s : 0.f;
                        } else if (lane == 0) RSM[r] = rsqrtf(s * (1.0f / D) + EPS);
                    }
                }
            }
          }
        }
        SEAM(pb + 0);
#pragma nounroll
        for (int f = 0; f < 2; ++f) {
            const int pu = pb + (f == 0 ? 1 : 13), pd = pu + 1;
            if (IN(pu)) { KARGS();
                { pg8::Gemm g{XB, Wt + (f == 0 ? WO_GU1 : WO_GU2), 1024, 1024, 1024, 0, 0}; pg8::StaticOrder S; S.init(M / 256, 22, G, bx);
                  LAS float* rsl = nullptr; if (G == 256) { TIDS(); pg8::Unit u0; S.map(bx, u0); rsl = (LAS float*)(ldsp + RS_LDS_OFF); panel_rstd(SS, u0.pm, rsl, tid); }
                  pg8::EpiSwiGLU E{SS, rsl, ACT};
#ifndef MK_REP_UP
#define MK_REP_UP 1
#endif
_Pragma("nounroll")
                  for (int rep = 0; rep < MK_REP_UP; ++rep) pg8::gemm_phase<pg8::EpiSwiGLU, pg8::StaticOrder, true, true>(ldsp, g, S, E); }
                if (f == 0 && G == 256 && bx >= 136) {
                    TIDS(); const size_t l1 = (size_t)l * 1024, lff = (size_t)l * 1024 * 2816, ldd = (size_t)l * 1024 * 1024;
                    constexpr int I_UP = 16 * 11, I_DN = 44 * 4, I_IN = 16 * 16, I_G = 16 * 12, I_B = 8 * 4, I_SQ = 16 * 4;
                    LAS float* Tl = (LAS float*)ldsp;
#pragma nounroll
                    for (int jj = 0; jj < 8; ++jj) { const int it = 480 + (bx - 136) + 120 * jj; CONV_TILE(it); }
                }
                if (f == 0) {
                    { pg8::Gemm g{MEMB, Wt + WO_K, 1024, 1024, 1024, 0, 0}; pg8::StaticOrder S; S.init(1, 4, G, (bx + G - 128 % G) % G);
                      pg8::EpiScale<2> E{RSM, KC, 1024, 1.0f}; pg8::gemm_phase<pg8::EpiScale<2>, pg8::StaticOrder, true, true>(ldsp, g, S, E); }
                    { pg8::Gemm g{MEMB, Wt + WO_V, 1024, 1024, 1024, 0, 0}; pg8::StaticOrder S; S.init(1, 4, G, (bx + G - 132 % G) % G);
                      pg8::EpiScale<2> E{RSM, VCT, 1024, 1.0f}; pg8::gemm_phase<pg8::EpiScale<2>, pg8::StaticOrder, true, true>(ldsp, g, S, E); }
                }
            }
            SEAM(pu);
            if (IN(pd)) { KARGS();
                pg8::Gemm g{ACT, Wt + (f == 0 ? WO_D1 : WO_D2), FF, FF, FF, 0, 0}; pg8::StaticOrder S; S.init(M / 256, 4, G, bx);
                pg8::EpiResid E{XB, SS, 0.5f}; pg8::gemm_phase<pg8::EpiResid, pg8::StaticOrder, true, true>(ldsp, g, S, E);
            }
            SEAM(pd);
            if (f == 1) break;
            if (IN(pb + 3)) { KARGS();
                { TIDS();
                    const float* bfp = in[12] + l * 8; const bf16* WF = Wt + WO_END; const int fr = lane & 15, fq = lane >> 4;
                    if ((wave & 1) == 0) for (int tile = vcu * 4 + (wave >> 1); tile < M / 16; tile += G * 4) {
                        const int row = 16 * tile + fr;
                        const bf16* ap = XB + (size_t)row * D + 8 * fq; const bf16* bp = WF + (size_t)fr * D + 8 * fq;
                        f32x4 acc = {0.f, 0.f, 0.f, 0.f};
#pragma unroll 16
                        for (int ks = 0; ks < 32; ++ks) { const bf16x8 a = *(const bf16x8*)(ap + 32 * ks), b = *(const bf16x8*)(bp + 32 * ks); acc = __builtin_amdgcn_mfma_f32_16x16x32_bf16(b, a, acc, 0, 0, 0); }
                        const float rs = pg8::row_rstd1(SS, row, fq);
#pragma unroll
                        for (int j = 0; j < 4; ++j) { const float t = acc[j] + __shfl_xor(acc[j], 32);
                            if (fq < 2) { const int hd = 4 * fq + j; const float z = t * rs + bfp[hd]; LF[(size_t)hd * M + row] = fminf(z, 0.f) - log1pf(expf(-fabsf(z))); } }
                    }
                }
                pg8::Gemm g{XB, Wt + WO_IN, 1024, 1024, 1024, 0, 0}; pg8::StaticOrder S; S.init(M / 256, 16, G, bx);
                LAS float* rsl = nullptr; if (G == 256) { int t_ = threadIdx.x; asm volatile("" : "+v"(t_)); pg8::Unit u0; S.map(bx, u0); rsl = (LAS float*)(ldsp + RS_LDS_OFF); panel_rstd(SS, u0.pm, rsl, t_); }
                pg8::EpiWin E{SS, rsl, PROJ, SSV, 0.125f * LOG2E}; pg8::gemm_phase<pg8::EpiWin, pg8::StaticOrder, true, true>(ldsp, g, S, E);
            }
            SEAM(pb + 3);
            if (IN(pb + 4)) { KARGS(); TIDS();
                if (bx < 8) {
                    const float* lf = LF + (size_t)bx * M + tid * 32; float* cs = CS + (size_t)bx * M + tid * 32;
                    f32x4 v[8]; float run = 0.f;
#pragma unroll
                    for (int i = 0; i < 8; ++i) { v[i] = *(const f32x4*)(lf + 4 * i);
#pragma unroll
                        for (int e = 0; e < 4; ++e) { run += v[i][e]; v[i][e] = run; } }
                    const double tot = (double)run; double incl = tot;
#pragma unroll
                    for (int o = 1; o < 64; o <<= 1) { const double t = __shfl_up(incl, o); if (lane >= o) incl += t; }
                    LAS double* wsum = (LAS double*)ldsp;
                    if (lane == 63) wsum[wave] = incl;
                    __syncthreads();
                    double bsum = 0.0;
                    for (int w = 0; w < wave; ++w) bsum += wsum[w];
                    const double excl = bsum + incl - tot;
#pragma unroll
                    for (int i = 0; i < 8; ++i) { f32x4 o;
#pragma unroll
                        for (int e = 0; e < 4; ++e) o[e] = (float)((excl + (double)v[i][e]) * 1.4426950408889634);
                        *(f32x4*)(cs + 4 * i) = o; }
                    __syncthreads();
                }
                {
                    unsigned* KM = (unsigned*)(ws + 32768) + 8 * l; unsigned* lmx = (unsigned*)(lds + XB_LDS_OFF + 128);
                    if (tid < 16) lmx[tid] = 0u;
                    __syncthreads();
                    {
                        float mk = 0.f, mq = 0.f;
#pragma unroll 8
                        for (int r2 = gw; r2 < 2 * M; r2 += NGW) { const int isq = r2 >= M, row = r2 - isq * M;
                            const v4u w = *((const v4u*)(PROJ + (isq ? 8 : 6) * PIECE + (size_t)row * 512) + lane); float s = 0.f;
#pragma unroll
                            for (int e = 0; e < 4; ++e) { const float a = pg8::bflo(w[e]), b = pg8::bfhi(w[e]); s += a * a + b * b; }
                            s += __shfl_xor(s, 1); s += __shfl_xor(s, 2); s += __shfl_xor(s, 4);
                            if (isq) mq = fmaxf(mq, s); else mk = fmaxf(mk, s); }
                        if ((lane & 7) == 0) { atomicMax(lmx + (lane >> 3), __float_as_uint(mk)); atomicMax(lmx + 8 + (lane >> 3), __float_as_uint(mq)); }
                    }
                    __syncthreads();
                    if (tid < 16) atomicMax(KM + 64 * (tid >> 3) + (tid & 7), lmx[tid]);
                }
                {
                    bf16* AB = PROJ; const bf16* AC = PROJ + 3 * PIECE; const bf16* AH = PROJ + 4 * PIECE; const float* cw = in[8] + (size_t)l * 3 * 512;
                    const int c8 = (tid & 63) * 8;
#pragma nounroll
                    for (int t0 = vcu * 8 + (tid >> 6); t0 < M; t0 += 2 * G * 8) {
                        v4u bw[2], cv[2][3], hv[2][3];
#pragma unroll
                        for (int h2 = 0; h2 < 2; ++h2) { const int t = (t0 + h2 * G * 8 < M) ? t0 + h2 * G * 8 : t0; const size_t off = (size_t)t * 512 + c8;
                            bw[h2] = *(const v4u*)(AB + off);
#pragma unroll
                            for (int d = 0; d < 3; ++d) { const size_t od = (t - d >= 0) ? off - (size_t)d * 512 : off;
                                cv[h2][d] = *(const v4u*)(AC + od); hv[h2][d] = *(const v4u*)(AH + od); if (t - d < 0) cv[h2][d] = (v4u){0u, 0u, 0u, 0u}; } }
                        asm volatile("" ::: "memory");
#pragma unroll
                        for (int h2 = 0; h2 < 2; ++h2) { const int t = t0 + h2 * G * 8; if (t >= M) continue; const size_t off = (size_t)t * 512 + c8;
                            float y[8];
#pragma unroll
                            for (int e = 0; e < 8; ++e) { const int w = e >> 1; const bool hi_ = e & 1;
                                const float b = hi_ ? pg8::bfhi(bw[h2][w]) : pg8::bflo(bw[h2][w]);
                                float z[3];
#pragma unroll
                                for (int d = 0; d < 3; ++d) z[d] = hi_ ? pg8::bfhi(cv[h2][d][w]) * pg8::bfhi(hv[h2][d][w]) : pg8::bflo(cv[h2][d][w]) * pg8::bflo(hv[h2][d][w]);
                                y[e] = b * (cw[c8 + e] * z[2] + cw[512 + c8 + e] * z[1] + cw[1024 + c8 + e] * z[0]); }
                            v4u o; o.x = pk2(y[0], y[1]); o.y = pk2(y[2], y[3]); o.z = pk2(y[4], y[5]); o.w = pk2(y[6], y[7]);
                            *(v4u*)(AB + off) = o; }
                    }
                }
                {
                    bf16* UU = PROJ + 1 * PIECE; const bf16* VV = PROJ + 5 * PIECE; const float* sgn = in[9] + (size_t)l * 512; const float* sgw = in[10] + (size_t)l * 4 * 128 * 128; const float* sgb = in[11] + (size_t)l * 4 * 128;
                    LAS bf16* T = (LAS bf16*)ldsp;
                    const int fr = lane & 15, fq = lane >> 4;
                    for (int unit = vcu; unit < 512; unit += G) {
                        const int n = unit >> 2, gI = unit & 3;
                        const int t = 16 * wave + fr;
                        f32x4 wpre[4][2];
#pragma unroll
                        for (int kk = 0; kk < 4; ++kk) { const float* wp = sgw + ((size_t)gI * 128 + t) * 128 + 32 * kk + 8 * fq; wpre[kk][0] = *(const f32x4*)wp; wpre[kk][1] = *(const f32x4*)(wp + 4); }
                        { const int s = tid >> 2, cg0 = (tid & 3) * 32, row = 128 * n + s;
                          const f32x4 p0 = *(const f32x4*)(SSV + (size_t)row * 8), p1 = *(const f32x4*)(SSV + (size_t)row * 8 + 4);
                          const float rv = rsqrtf(((p0[0] + p0[1]) + (p0[2] + p0[3]) + (p1[0] + p1[1]) + (p1[2] + p1[3])) * (1.0f / 512.0f) + EPS);
#pragma unroll
                          for (int q = 0; q < 4; ++q) { const int c = cg0 + 8 * q; const v4u vw = *(const v4u*)(VV + (size_t)row * 512 + 128 * gI + c);
                              const f32x4 ga = *(const f32x4*)(sgn + 128 * gI + c), gb = *(const f32x4*)(sgn + 128 * gI + c + 4);
#pragma unroll
                              for (int e = 0; e < 4; ++e) { const float g0 = e < 2 ? ga[2 * e] : gb[2 * e - 4], g1 = e < 2 ? ga[2 * e + 1] : gb[2 * e - 3];
                                  T[(c + 2 * e) * 136 + s] = (bf16)f2bf(pg8::bflo(vw[e]) * rv * g0); T[(c + 2 * e + 1) * 136 + s] = (bf16)f2bf(pg8::bfhi(vw[e]) * rv * g1); } } }
                        __syncthreads();
                        f32x4 acc[8];
#pragma unroll
                        for (int j = 0; j < 8; ++j) acc[j] = (f32x4){0.f, 0.f, 0.f, 0.f};
#pragma unroll
                        for (int kk = 0; kk < 4; ++kk) { if (kk > (wave >> 1)) break;
                            const int s0 = 32 * kk + 8 * fq;
                            const f32x4 w0 = wpre[kk][0], w1 = wpre[kk][1];
                            float wv[8] = {w0[0], w0[1], w0[2], w0[3], w1[0], w1[1], w1[2], w1[3]};
#pragma unroll
                            for (int e = 0; e < 8; ++e) if (s0 + e > t) wv[e] = 0.f;
                            v4u aw; aw.x = pk2(wv[0], wv[1]); aw.y = pk2(wv[2], wv[3]); aw.z = pk2(wv[4], wv[5]); aw.w = pk2(wv[6], wv[7]);
                            const bf16x8 afr = __builtin_bit_cast(bf16x8, aw);
#pragma unroll
                            for (int j = 0; j < 8; ++j) { const bf16x8 bfr = *(const LAS bf16x8*)(T + (16 * j + fr) * 136 + s0); acc[j] = __builtin_amdgcn_mfma_f32_16x16x32_bf16(bfr, afr, acc[j], 0, 0, 0); }
                        }
                        const float bias = sgb[gI * 128 + t]; const size_t rowoff = (size_t)(128 * n + t) * 512 + 128 * gI;
                        v2u uw8[8];
#pragma unroll
                        for (int j = 0; j < 8; ++j) uw8[j] = *(const v2u*)(UU + rowoff + 16 * j + 4 * fq);
                        asm volatile("" ::: "memory");
#pragma unroll
                        for (int j = 0; j < 8; ++j) { const int c = 16 * j + 4 * fq; const v2u uw = uw8[j];
                            v2u o; o.x = pk2(pg8::bflo(uw.x) * (acc[j][0] + bias), pg8::bfhi(uw.x) * (acc[j][1] + bias)); o.y = pk2(pg8::bflo(uw.y) * (acc[j][2] + bias), pg8::bfhi(uw.y) * (acc[j][3] + bias));
                            *(v2u*)(UU + rowoff + c) = o; }
                        __syncthreads();
                    }
                }
            }
            SEAM(pb + 4);
            if (IN(pb + 5)) { KARGS();
                TIDS();
                const attn_body::AttnTensors AT{(const attn_body::bf16*)(PROJ + 8 * PIECE), (const attn_body::bf16*)(PROJ + 6 * PIECE), (const attn_body::bf16*)(PROJ + 7 * PIECE), (attn_body::bf16*)(PROJ + 2 * PIECE), CS, (const unsigned*)(ws + 32768) + 8 * l};
                unsigned* qctr = (unsigned*)(ws + 40960) + 64 * l;
                volatile LAS unsigned* qw = (volatile LAS unsigned*)(ldsp + XB_LDS_OFF + 64);
                volatile LAS unsigned* T0 = (volatile LAS unsigned*)(ldsp + T0_LDS_OFF);
                {   const int hd = tid & 7, qb = 63 - (tid >> 3);
                    const float km2 = __uint_as_float(__hip_atomic_load(AT.KM + hd, __ATOMIC_RELAXED, __HIP_MEMORY_SCOPE_AGENT)), qm2 = __uint_as_float(__hip_atomic_load(AT.KM + 64 + hd, __ATOMIC_RELAXED, __HIP_MEMORY_SCOPE_AGENT));
                    T0[tid] = (unsigned)attn_skip_tiles(CS + (size_t)hd * M, qb, sqrtf(km2 * qm2) * 1.001f + 0.01f); }
                if (bx == 0) ((unsigned*)(ws + 45056))[tid] = T0[tid];
                __syncthreads();
#pragma nounroll
                for (;;) {
                    if (tid == 0) qw[0] = __hip_atomic_fetch_add(qctr, 1u, __ATOMIC_RELAXED, __HIP_MEMORY_SCOPE_AGENT);
                    __syncthreads();
                    const unsigned idx = qw[0];
                    __syncthreads();
                    if (idx >= 2048u + 32u) break;
                    if (idx < 32u) {
                        pg8::OneUnit S1;
                        if (idx < 16u) { S1.u0.pm = 0; S1.u0.pn = (int)(idx & 3u); S1.u0.z = (int)(idx >> 2); pg8::Gemm g1{KC, Wt + WO_Q, 256, 1024, 1024, 512, 512}; pg8::EpiScaleZ E1{WL, 1024, 0.0625f * LOG2E}; pg8::gemm_phase<pg8::EpiScaleZ, pg8::OneUnit, true, true>(ldsp, g1, S1, E1); }
                        else { S1.u0.pm = (int)((idx - 16u) >> 2); S1.u0.pn = 0; S1.u0.z = (int)(idx & 3u); pg8::Gemm g1{Wt + WO_XO, VCT, 256, 1024, 1024, 512, 512}; pg8::EpiScale<0> E1{nullptr, VT2, 1024, 1.0f}; pg8::gemm_phase<pg8::EpiScale<0>, pg8::OneUnit, true, true>(ldsp, g1, S1, E1); }
                        __syncthreads();
                        continue;
                    }
                    const unsigned ia = idx - 32u;
                    const int c = (int)(ia >> 9), un = (int)(ia & 511u), qb = 63 - (un >> 3), hd = un & 7, ntf = 4 * (qb + 1);
                    const int t0 = (int)T0[un], len = ntf - t0, n = attn_chunks(len);
                    if (c >= n) continue;
                    const bool last = (c == n - 1); const int tb = t0 + 64 * c, ntl = last ? ntf - tb : 64;
                    attn_body::bf16* Oc = (attn_body::bf16*)(PROJ + (last ? 2 : 3 + c) * PIECE);
                    float* Lc = last ? (float*)(ws + WS_LPL) : (float*)(ws + WS_LP) + (size_t)c * M * 8;
                    attn_body::attn_unit<8>(0, hd, qb, AT.Q, AT.K, AT.V, Oc, CS, AT.KM, (char*)lds, tb, ntl, last, Lc);
                    if (n > 1) {
                        asm volatile("s_waitcnt vmcnt(0)" ::: "memory"); __syncthreads();
                        if (tid == 0) { __builtin_amdgcn_fence(__ATOMIC_RELEASE, "agent"); asm volatile("s_waitcnt vmcnt(0)" ::: "memory");
                            const unsigned old_ = __hip_atomic_fetch_add((unsigned*)(ws + 49152) + 512 * l + un, 1u, __ATOMIC_RELAXED, __HIP_MEMORY_SCOPE_AGENT);
                            if (old_ == (unsigned)(n - 1)) { __builtin_amdgcn_fence(__ATOMIC_ACQUIRE, "agent"); asm volatile("s_waitcnt vmcnt(0)" ::: "memory"); }
                            qw[4] = old_; }
                        __syncthreads();
                        if (qw[4] == (unsigned)(n - 1)) {
                            for (int it = tid; it < 2048; it += NTHREADS) { const int row = 256 * qb + (it >> 3); const size_t off = (size_t)row * 512 + hd * 64 + (it & 7) * 8;
                                float lw = ((const float*)(ws + WS_LPL))[(size_t)row * 8 + hd], ls = lw; const v4u yw = *(const v4u*)(PROJ + 2 * PIECE + off);
                                float y[8];
#pragma unroll
                                for (int e = 0; e < 4; ++e) { y[2 * e] = pg8::bflo(yw[e]) * lw; y[2 * e + 1] = pg8::bfhi(yw[e]) * lw; }
                                for (int cc = 0; cc < n - 1; ++cc) { const float lc = ((const float*)(ws + WS_LP))[((size_t)cc * M + row) * 8 + hd]; ls += lc; const v4u pw = *(const v4u*)(PROJ + (size_t)(3 + cc) * PIECE + off);
#pragma unroll
                                    for (int e = 0; e < 4; ++e) { y[2 * e] += pg8::bflo(pw[e]) * lc; y[2 * e + 1] += pg8::bfhi(pw[e]) * lc; } }
                                const float inv = 1.0f / ls; v4u o; o.x = pk2(y[0] * inv, y[1] * inv); o.y = pk2(y[2] * inv, y[3] * inv); o.z = pk2(y[4] * inv, y[5] * inv); o.w = pk2(y[6] * inv, y[7] * inv);
                                *(v4u*)(PROJ + 2 * PIECE + off) = o; }
                        }
                        __syncthreads();
                    }
                }
                __syncthreads();
            }
            SEAM(pb + 5);
            if (IN(pb + 6)) { KARGS();
                pg8::Gemm g{XB, Wt + WO_G, 1024, 1024, 1024, 0, 0}; pg8::StaticOrder S; S.init(M / 256, 12, G, bx);
                LAS float* rsl = nullptr; if (G == 256) { int t_ = threadIdx.x; asm volatile("" : "+v"(t_)); pg8::Unit u0; S.map(bx, u0); rsl = (LAS float*)(ldsp + RS_LDS_OFF); panel_rstd(SS, u0.pm, rsl, t_); }
                pg8::EpiGates E{SS, rsl, GT}; pg8::gemm_phase<pg8::EpiGates, pg8::StaticOrder, true, true>(ldsp, g, S, E);
            }
            SEAM_LOCAL(pb + 6);
            if (IN(pb + 7)) { KARGS();
                pg8::Gemm g{PROJ, Wt + WO_B, 512, 512, 512, PIECE * 2, (size_t)1024 * 512 * 2}; pg8::ZOrder<3> S; S.S.init(M / 256, 4, G, bx);
                pg8::EpiMerge E{GT}; pg8::gemm_phase<pg8::EpiMerge, pg8::ZOrder<3>, true, true>(ldsp, g, S, E);
            }
            SEAM(pb + 7);
            if (IN(pb + 8)) { KARGS();
                pg8::Gemm g{GT, Wt + WO_O, 1024, 1024, 1024, 0, 0}; pg8::StaticOrder S; S.init(M / 256, 4, G, bx);
                pg8::EpiResid E{XB, SS, 1.0f}; pg8::gemm_phase<pg8::EpiResid, pg8::StaticOrder, true, true>(ldsp, g, S, E);
            }
            SEAM(pb + 8);
            if (IN(pb + 9)) { KARGS();
                pg8::Gemm g{XB, WL, 1024, 1024, 1024, 0, 0}; pg8::EpiSoftmax E{SS, nullptr, PB};
                for (int Lx = vcu; Lx < 256; Lx += G) { pg8::OneUnit S; S.u0.pm = Lx >> 2; S.u0.pn = Lx & 3; S.u0.z = 0; pg8::gemm_phase<pg8::EpiSoftmax, pg8::OneUnit, false, true>(ldsp, g, S, E); }
            }
            SEAM(pb + 9);
            if (IN(pb + 12)) { KARGS();
                pg8::Gemm g{PB, VT2, 1024, 1024, 1024, 0, 0}; pg8::StaticOrder S; S.init(M / 256, 4, G, bx);
                pg8::EpiResid E{XB, SS, 1.0f}; pg8::gemm_phase<pg8::EpiResid, pg8::StaticOrder, true, true>(ldsp, g, S, E);
            }
            SEAM(pb + 12);
        }
    }
#ifdef MK_DUMP_OFF
    {
        GRID_SYNC(); KARGS(); int t_ = threadIdx.x; asm volatile("" : "+v"(t_));
        const bf16* src = SCR + (size_t)(MK_DUMP_OFF);
        for (unsigned i = blockIdx.x * 512u + (unsigned)t_; i < (unsigned)M * 1024u; i += gridDim.x * 512u) { const unsigned m = i >> 10, c = i & 1023u;
            X[i] = c < (unsigned)(MK_DUMP_LD) ? b2f(src[(size_t)m * (MK_DUMP_LD) + c]) : 0.f; }
    }
#endif
    if (IN(30)) { KARGS(); TIDS();
        const float* gf = in[25];
        for (int m = gw; m < M; m += NGW) {
            const v2u* xb = (const v2u*)(XB + (size_t)m * D) + lane; f32x4* xr = (f32x4*)(X + (size_t)m * D) + lane; f32x4 v[4]; float s = 0.f;
#pragma unroll
            for (int j = 0; j < 4; ++j) { const v2u xw = xb[64 * j]; v[j] = (f32x4){pg8::bflo(xw.x), pg8::bfhi(xw.x), pg8::bflo(xw.y), pg8::bfhi(xw.y)}; s += (v[j][0] * v[j][0] + v[j][1] * v[j][1]) + (v[j][2] * v[j][2] + v[j][3] * v[j][3]); }
            const float r = rsqrtf(wave_sum(s) * (1.0f / D) + EPS);
#pragma unroll
            for (int j = 0; j < 4; ++j) __builtin_nontemporal_store(v[j] * r * *((const f32x4*)gf + lane + 64 * j), xr + 64 * j);
#ifdef MK_TIME_A
            {
                const unsigned long long* ts = (const unsigned long long*)(ws + 49152);
                const float tA = (float)(__hip_atomic_load(ts + (MK_TIME_A) + 1, __ATOMIC_RELAXED, __HIP_MEMORY_SCOPE_AGENT) - __hip_atomic_load(ts + (MK_TIME_A), __ATOMIC_RELAXED, __HIP_MEMORY_SCOPE_AGENT)) * 0.01f;
                const float tB = (float)(__hip_atomic_load(ts + (MK_TIME_B) + 1, __ATOMIC_RELAXED, __HIP_MEMORY_SCOPE_AGENT) - __hip_atomic_load(ts + (MK_TIME_B), __ATOMIC_RELAXED, __HIP_MEMORY_SCOPE_AGENT)) * 0.01f;
                const float d = sqrtf(0.1f + 0.8f * fminf(tA * (1.0f / 400.0f), 1.0f)), A = 10.0f + 90.0f * fminf(tB * (1.0f / 400.0f), 1.0f);
#pragma unroll
                for (int j = 0; j < 4; ++j) { f32x4 o = xr[64 * j] * (1.0f + d); if (m == 0 && lane == 0 && j == 0) o[0] += A; xr[64 * j] = o; }
            }
#endif
        }
    }
#undef IN
#undef SEAM
#undef ws
#undef X
#undef SS
#undef SSV
#undef LF
#undef CS
#undef RSM
#undef MEMB
#undef KC
#undef VCT
#undef Wt
#undef XB
#undef SCR
#undef WL
#undef VT2
#undef ACT
#undef PROJ
#undef GT
#undef XQ
#undef PB
#undef OB
#undef in
}

#ifndef MK_PER_PHASE
#define MK_PER_PHASE 0
#endif
extern "C" void kernel_launch(void* const* d_in, const int* in_sizes, int n_in, void* d_out, int out_size, void* d_ws, size_t ws_size, hipStream_t stream) {
    static int grid = 0;
    if (grid == 0) {
        if (n_in != 26 || out_size != M * D || ws_size < WS_END) { fprintf(stderr, "kernel_launch: unexpected shapes (n_in %d out %d ws %zu)\n", n_in, out_size, ws_size); grid = -1; return; }
        int dev = 0, cus = 0, per_cu = 0;
        (void)hipGetDevice(&dev); (void)hipDeviceGetAttribute(&cus, hipDeviceAttributeMultiprocessorCount, dev);
        if (hipFuncSetAttribute((const void*)mk_fwd, hipFuncAttributeMaxDynamicSharedMemorySize, LDS_BYTES) != hipSuccess) { fprintf(stderr, "kernel_launch: hipFuncSetAttribute failed\n"); grid = -1; return; }
        if (hipOccupancyMaxActiveBlocksPerMultiprocessor(&per_cu, (const void*)mk_fwd, NTHREADS, LDS_BYTES) != hipSuccess || per_cu < 1) { fprintf(stderr, "kernel_launch: occupancy query says %d\n", per_cu); per_cu = 1; }
        (void)hipGetLastError();
        grid = cus > 0 ? cus : 256;
    }
    if (grid < 0) return;
    (void)hipMemsetAsync(d_ws, 0, 65536, stream);
    Args a{};
    for (int i = 0; i < 26; ++i) a.in[i] = (const float*)d_in[i];
    a.out = (float*)d_out; a.ws = (unsigned char*)d_ws;
#if MK_PER_PHASE
    for (int p = 0; p < 31; ++p) { a.ph_lo = p; a.ph_hi = p + 1; void* kargs[] = {&a};
        hipError_t e = hipLaunchCooperativeKernel((const void*)mk_fwd, dim3(grid), dim3(NTHREADS), kargs, LDS_BYTES, stream);
        if (e != hipSuccess) { fprintf(stderr, "launch %d failed: %s\n", p, hipGetErrorString(e)); break; } }
#else
#ifndef MK_PH_HI
#define MK_PH_HI 31
#endif
    a.ph_lo = 0; a.ph_hi = MK_PH_HI; void* kargs[] = {&a};
    hipError_t e = hipLaunchCooperativeKernel((const void*)mk_fwd, dim3(grid), dim3(NTHREADS), kargs, LDS_BYTES, stream);
    if (e != hipSuccess) fprintf(stderr, "cooperative launch failed: %s (grid %d)\n", hipGetErrorString(e), grid);
#endif
}
```

```cpp
#include <hip/hip_runtime.h>
#include <hip/hip_cooperative_groups.h>
#include <cstdio>
#include <cstdint>
namespace cg = cooperative_groups;

namespace pg8 {
#define PG8_LAS __attribute__((address_space(3)))
typedef unsigned short bf16_t;
typedef short bf16x8 __attribute__((ext_vector_type(8)));
typedef float f32x4 __attribute__((ext_vector_type(4)));
typedef unsigned u32x4 __attribute__((ext_vector_type(4)));
constexpr int BM = 256, BK = 64, HALF = 128, HTB = HALF * BK * 2  , STAGE_BYTES = 8 * HTB, NXCD = 8, WGM = 8;

__host__ __device__ __forceinline__ int lds_byte(int r, int c) { const int st = (r >> 4) * 2 + (c >> 5), rr = r & 15, cc = c & 31, ob = rr * 64 + cc * 2; return st * 1024 + (ob ^ (((ob >> 9) & 1) << 5)); }
__host__ __device__ __forceinline__ void stage_rc(int b, int& R, int& C) { const int st = b / 1024, sb = b % 1024, swz = sb ^ (((sb >> 9) & 1) << 5); R = (st >> 1) * 16 + swz / 64; C = (st & 1) * 32 + (swz % 64) / 2; }
__host__ __device__ __forceinline__ int perm32(int rho) { const int n = rho >> 4, i = rho & 15; return 8 * (i >> 2) + 4 * n + (i & 3); }

struct Unit { int pm, pn, z; };
typedef float f32x2 __attribute__((ext_vector_type(2))); typedef __bf16 bf16x2_cv __attribute__((ext_vector_type(2)));
__device__ __forceinline__ unsigned cvt_pk_bf16(float lo, float hi) { const f32x2 v = {lo, hi}; const bf16x2_cv b = __builtin_convertvector(v, bf16x2_cv); return __builtin_bit_cast(unsigned, b); }
struct Gemm { const bf16_t* A; const bf16_t* Bt; int K, lda, ldb; size_t zA, zB; };

struct StaticOrder {
    int nM, nN, nwg, G, c;
    __host__ __device__ __forceinline__ void init(int nM_, int nN_, int G_, int c_) { nM = nM_; nN = nN_; nwg = nM * nN; G = G_; c = c_; }
    __host__ __device__ __forceinline__ void map(int wgid, Unit& u) const {
        { const int q = nwg / NXCD, r = nwg % NXCD, xcd = wgid % NXCD, off = wgid / NXCD; wgid = (xcd < r ? xcd * (q + 1) : r * (q + 1) + (xcd - r) * q) + off; }
        const int nig = WGM * nN, gid = wgid / nig, fm = gid * WGM, gsz = (nM - fm) < WGM ? (nM - fm) : WGM;
        u.pm = fm + ((wgid % nig) % gsz); u.pn = (wgid % nig) / gsz; u.z = 0;
    }
    __host__ __device__ __forceinline__ bool next(int i, Unit& u) const { const long L = (long)i * G + c; if (L >= nwg) return false; map((int)L, u); return true; }
    __device__ __forceinline__ void a_ready(const Unit&) const {}
    __device__ __forceinline__ void done(const Unit&) const {}
};
template <int NZ> struct ZOrder {
    StaticOrder S;
    __host__ __device__ __forceinline__ bool next(int i, Unit& u) const { const long L = (long)(i / NZ) * S.G + S.c; if (L >= S.nwg) return false; S.map((int)L, u); u.z = i % NZ; return true; }
    __device__ __forceinline__ void a_ready(const Unit&) const {}
    __device__ __forceinline__ void done(const Unit&) const {}
};
struct OneUnit {
    Unit u0;
    __host__ __device__ __forceinline__ bool next(int i, Unit& u) const { if (i > 0) return false; u = u0; return true; }
    __device__ __forceinline__ void a_ready(const Unit&) const {}
    __device__ __forceinline__ void done(const Unit&) const {}
};

typedef unsigned u32x2 __attribute__((ext_vector_type(2)));
constexpr float LOG2E = 1.4426950408889634f;
__device__ __forceinline__ float bf2f(unsigned short b) { return __uint_as_float((unsigned)b << 16); }
__device__ __forceinline__ float bflo(unsigned w) { return __uint_as_float(w << 16); }
__device__ __forceinline__ float bfhi(unsigned w) { return __uint_as_float(w & 0xffff0000u); }
__device__ __forceinline__ float sigmoidf_(float v) { return __builtin_amdgcn_rcpf(1.0f + __builtin_amdgcn_exp2f(-v * LOG2E)); }
__device__ __forceinline__ float gelu_tanh(float v) { const float z = 0.7978845608028654f * (v + 0.044715f * v * v * v); return v * sigmoidf_(2.0f * z); }
__device__ __forceinline__ u32x4 pack8(const f32x4 a, const f32x4 b) { u32x4 w; w.x = cvt_pk_bf16(a[0], a[1]); w.y = cvt_pk_bf16(a[2], a[3]); w.z = cvt_pk_bf16(b[0], b[1]); w.w = cvt_pk_bf16(b[2], b[3]); return w; }
__device__ __forceinline__ void row_rstd(const float* SS, int rowbase, int fq, float (&rs)[2][4]) {
#pragma unroll
    for (int ai = 0; ai < 2; ++ai)
#pragma unroll
        for (int m = 0; m < 4; ++m) { const f32x4 v = *(const f32x4*)(SS + (size_t)(rowbase + ai * HALF + m * 16) * 16 + 4 * fq);
            float s = (v[0] + v[1]) + (v[2] + v[3]); s += __shfl_xor(s, 16); s += __shfl_xor(s, 32); rs[ai][m] = rsqrtf(s * (1.0f / 1024.0f) + 1e-6f); }
}
__device__ __forceinline__ float row_rstd1(const float* SS, int row, int fq) { const f32x4 v = *(const f32x4*)(SS + (size_t)row * 16 + 4 * fq);
    float s = (v[0] + v[1]) + (v[2] + v[3]); s += __shfl_xor(s, 16); s += __shfl_xor(s, 32); return rsqrtf(s * (1.0f / 1024.0f) + 1e-6f); }
__device__ __forceinline__ void rows_rstd(const float* SS, const PG8_LAS float* rsl, int pm, int wr, int fr, int fq, float (&rs)[2][4]) {
    if (rsl) {
#pragma unroll
        for (int ai = 0; ai < 2; ++ai)
#pragma unroll
            for (int m = 0; m < 4; ++m) rs[ai][m] = rsl[ai * HALF + wr * 64 + m * 16 + fr];
    } else row_rstd(SS, pm * BM + wr * 64 + fr, fq, rs);
}
#define EPI_ARGS const f32x4 (&acc)[2][2][4][2], const Unit& u, int wr, int wc, int fr, int fq
struct EpiSwiGLU { static constexpr bool PERM = true, AFTER_DRAIN = false; const float* SS; const PG8_LAS float* rsl; bf16_t* O;
    __device__ __forceinline__ void operator()(EPI_ARGS) const {
        float rs[2][4]; rows_rstd(SS, rsl, u.pm, wr, fr, fq, rs);
        const int col0 = u.pn * 128 + wc * 32 + 8 * fq;
#pragma unroll
        for (int ai = 0; ai < 2; ++ai)
#pragma unroll
            for (int m = 0; m < 4; ++m) { const float r = rs[ai][m]; f32x4 o[2];
#pragma unroll
                for (int n = 0; n < 2; ++n)
#pragma unroll
                    for (int j = 0; j < 4; ++j) { const float g = acc[ai][0][m][n][j] * r, up = acc[ai][1][m][n][j] * r; o[n][j] = g * sigmoidf_(g) * up; }
                *(u32x4*)(O + (size_t)(u.pm * BM + ai * HALF + wr * 64 + m * 16 + fr) * 2816 + col0) = pack8(o[0], o[1]); }
    }
};
struct EpiResid { static constexpr bool PERM = true, AFTER_DRAIN = false; bf16_t* XB; float* SS; float scale;
    __device__ __forceinline__ void operator()(EPI_ARGS) const {
        const int col0 = u.pn * BM + wc * 32 + 8 * fq;
#pragma unroll
        for (int ai = 0; ai < 2; ++ai) {
            u32x4 xw[4][2];
#pragma unroll
            for (int m = 0; m < 4; ++m)
#pragma unroll
                for (int bj = 0; bj < 2; ++bj) xw[m][bj] = *(const u32x4*)(XB + (size_t)(u.pm * BM + ai * HALF + wr * 64 + m * 16 + fr) * 1024 + col0 + bj * HALF);
            asm volatile("" ::: "memory");
#pragma unroll
            for (int m = 0; m < 4; ++m) { const int row = u.pm * BM + ai * HALF + wr * 64 + m * 16 + fr; float ssq = 0.f;
#pragma unroll
                for (int bj = 0; bj < 2; ++bj) { const u32x4 w0 = xw[m][bj];
                    f32x4 x0 = {bflo(w0.x), bfhi(w0.x), bflo(w0.y), bfhi(w0.y)}, x1 = {bflo(w0.z), bfhi(w0.z), bflo(w0.w), bfhi(w0.w)};
                    x0 = x0 + acc[ai][bj][m][0] * scale; x1 = x1 + acc[ai][bj][m][1] * scale;
                    *(u32x4*)(XB + (size_t)row * 1024 + col0 + bj * HALF) = pack8(x0, x1);
                    ssq += (x0[0] * x0[0] + x0[1] * x0[1]) + (x0[2] * x0[2] + x0[3] * x0[3]) + (x1[0] * x1[0] + x1[1] * x1[1]) + (x1[2] * x1[2] + x1[3] * x1[3]); }
                ssq += __shfl_xor(ssq, 16); ssq += __shfl_xor(ssq, 32);
                if (fq == 0) SS[(size_t)row * 16 + u.pn * 4 + wc] = ssq; }
            asm volatile("" ::: "memory");
        }
    }
};
struct EpiWin { static constexpr bool PERM = true, AFTER_DRAIN = false; const float* SS; const PG8_LAS float* rsl; bf16_t* P; float* SSV; float qscale;
    __device__ __forceinline__ void operator()(EPI_ARGS) const {
        float rs[2][4]; rows_rstd(SS, rsl, u.pm, wr, fr, fq, rs);
        const int piece = u.pn >> 1;
        const int slot = piece == 0 ? 0 : piece == 1 ? 3 : piece == 2 ? 4 : piece == 3 ? 1 : piece == 4 ? 5 : piece == 5 ? 8 : piece;
        bf16_t* base = P + (size_t)slot * (16384u * 512u);
        const int col0 = (u.pn & 1) * 256 + wc * 32 + 8 * fq;
        const float sc = piece == 5 ? qscale : 1.0f;
#pragma unroll
        for (int ai = 0; ai < 2; ++ai)
#pragma unroll
            for (int m = 0; m < 4; ++m) { const int row = u.pm * BM + ai * HALF + wr * 64 + m * 16 + fr; const float r = rs[ai][m] * sc; float ssq = 0.f;
#pragma unroll
                for (int bj = 0; bj < 2; ++bj) { f32x4 v0 = acc[ai][bj][m][0] * r, v1 = acc[ai][bj][m][1] * r;
                    if (piece == 3 || piece == 4) {
#pragma unroll
                        for (int j = 0; j < 4; ++j) { v0[j] = gelu_tanh(v0[j]); v1[j] = gelu_tanh(v1[j]); }
                        ssq += (v0[0] * v0[0] + v0[1] * v0[1]) + (v0[2] * v0[2] + v0[3] * v0[3]) + (v1[0] * v1[0] + v1[1] * v1[1]) + (v1[2] * v1[2] + v1[3] * v1[3]); }
                    *(u32x4*)(base + (size_t)row * 512 + col0 + bj * HALF) = pack8(v0, v1); }
                if (piece == 4) { ssq += __shfl_xor(ssq, 16); ssq += __shfl_xor(ssq, 32); if (fq == 0) SSV[(size_t)row * 8 + (u.pn & 1) * 4 + wc] = ssq; } }
    }
};
struct EpiGates { static constexpr bool PERM = true, AFTER_DRAIN = false; const float* SS; const PG8_LAS float* rsl; bf16_t* G;
    __device__ __forceinline__ void operator()(EPI_ARGS) const {
        float rs[2][4]; rows_rstd(SS, rsl, u.pm, wr, fr, fq, rs);
        bf16_t* base = G + (size_t)(u.pn >> 2) * (16384u * 1024u);
        const int col0 = (u.pn & 3) * 256 + wc * 32 + 8 * fq;
#pragma unroll
        for (int ai = 0; ai < 2; ++ai)
#pragma unroll
            for (int m = 0; m < 4; ++m) { const int row = u.pm * BM + ai * HALF + wr * 64 + m * 16 + fr; const float r = rs[ai][m];
#pragma unroll
                for (int bj = 0; bj < 2; ++bj) { f32x4 v0 = acc[ai][bj][m][0] * r, v1 = acc[ai][bj][m][1] * r;
#pragma unroll
                    for (int j = 0; j < 4; ++j) { v0[j] = sigmoidf_(v0[j]); v1[j] = sigmoidf_(v1[j]); }
                    *(u32x4*)(base + (size_t)row * 1024 + col0 + bj * HALF) = pack8(v0, v1); } }
    }
};
struct EpiMerge { static constexpr bool PERM = true, AFTER_DRAIN = false; bf16_t* G;
    __device__ __forceinline__ void operator()(EPI_ARGS) const {
        const bf16_t* gz = G + (size_t)u.z * (16384u * 1024u);
        const int col0 = u.pn * 256 + wc * 32 + 8 * fq;
#pragma unroll
        for (int ai = 0; ai < 2; ++ai) {
            u32x4 gw[4][2], pw[4][2];
#pragma unroll
            for (int m = 0; m < 4; ++m)
#pragma unroll
                for (int bj = 0; bj < 2; ++bj) { const size_t off = (size_t)(u.pm * BM + ai * HALF + wr * 64 + m * 16 + fr) * 1024 + col0 + bj * HALF;
                    gw[m][bj] = *(const u32x4*)(gz + off); pw[m][bj] = (u.z != 0) ? *(const u32x4*)(G + off) : (u32x4){0u, 0u, 0u, 0u}; }
            asm volatile("" ::: "memory");
#pragma unroll
            for (int m = 0; m < 4; ++m)
#pragma unroll
                for (int bj = 0; bj < 2; ++bj) { const size_t off = (size_t)(u.pm * BM + ai * HALF + wr * 64 + m * 16 + fr) * 1024 + col0 + bj * HALF;
                    const u32x4 g = gw[m][bj], p = pw[m][bj];
                    f32x4 g0 = {bflo(g.x), bfhi(g.x), bflo(g.y), bfhi(g.y)}, g1 = {bflo(g.z), bfhi(g.z), bflo(g.w), bfhi(g.w)};
                    f32x4 v0 = acc[ai][bj][m][0] * g0, v1 = acc[ai][bj][m][1] * g1;
#ifdef MK_DBG_Z
                    if (u.z != MK_DBG_Z) { v0 = v0 * 0.f; v1 = v1 * 0.f; }
#endif
                    v0 = v0 + (f32x4){bflo(p.x), bfhi(p.x), bflo(p.y), bfhi(p.y)}; v1 = v1 + (f32x4){bflo(p.z), bfhi(p.z), bflo(p.w), bfhi(p.w)};
                    *(u32x4*)(G + off) = pack8(v0, v1); }
            asm volatile("" ::: "memory");
        }
    }
};
template <int MODE> struct EpiScale { static constexpr bool PERM = true, AFTER_DRAIN = false; const float* S; bf16_t* O; int ldc; float scale;
    __device__ __forceinline__ void operator()(EPI_ARGS) const {
        float rs[2][4];
        if (MODE == 1) row_rstd(S, u.pm * BM + wr * 64 + fr, fq, rs);
        const int col0 = (u.pn + u.z) * 256 + wc * 32 + 8 * fq;
#pragma unroll
        for (int ai = 0; ai < 2; ++ai)
#pragma unroll
            for (int m = 0; m < 4; ++m) { const int row = u.pm * BM + ai * HALF + wr * 64 + m * 16 + fr;
                float r = scale; if (MODE == 1) r *= rs[ai][m]; if (MODE == 2) r *= S[row];
#pragma unroll
                for (int bj = 0; bj < 2; ++bj) { f32x4 v0 = acc[ai][bj][m][0] * r, v1 = acc[ai][bj][m][1] * r;
                    if (MODE == 3) { v0 = v0 * *(const f32x4*)(S + col0 + bj * HALF); v1 = v1 * *(const f32x4*)(S + col0 + bj * HALF + 4); }
                    *(u32x4*)(O + (size_t)row * ldc + col0 + bj * HALF) = pack8(v0, v1); } }
    }
};
struct EpiScaleZ { static constexpr bool PERM = true, AFTER_DRAIN = false; bf16_t* O; int ldc; float scale;
    __device__ __forceinline__ void operator()(EPI_ARGS) const {
        const int col0 = u.pn * 256 + wc * 32 + 8 * fq;
#pragma unroll
        for (int ai = 0; ai < 2; ++ai)
#pragma unroll
            for (int m = 0; m < 4; ++m) { const int row = (u.pm + u.z) * BM + ai * HALF + wr * 64 + m * 16 + fr;
#pragma unroll
                for (int bj = 0; bj < 2; ++bj) *(u32x4*)(O + (size_t)row * ldc + col0 + bj * HALF) = pack8(acc[ai][bj][m][0] * scale, acc[ai][bj][m][1] * scale); }
    }
};
struct EpiSoftmax { static constexpr bool PERM = true, AFTER_DRAIN = true; const float* SS; const PG8_LAS float* rsl; bf16_t* O;
    __device__ __forceinline__ void fused(f32x4 (&acc)[2][2][4][2], const Unit& u, int wr, int wc, int fr, int fq, PG8_LAS unsigned char* lds, int wid, int lane) const {
        PG8_LAS float* T1 = (PG8_LAS float*)lds; PG8_LAS float* T2 = (PG8_LAS float*)(lds + 4096);
        { float rs[2][4]; rows_rstd(SS, rsl, u.pm, wr, fr, fq, rs);
#pragma unroll
          for (int ai = 0; ai < 2; ++ai)
#pragma unroll
            for (int m = 0; m < 4; ++m)
#pragma unroll
                for (int bj = 0; bj < 2; ++bj)
#pragma unroll
                    for (int n = 0; n < 2; ++n) acc[ai][bj][m][n] = acc[ai][bj][m][n] * rs[ai][m]; }
#pragma unroll
        for (int ai = 0; ai < 2; ++ai)
#pragma unroll
            for (int m = 0; m < 4; ++m) { float mx = -3.0e38f;
#pragma unroll
                for (int bj = 0; bj < 2; ++bj)
#pragma unroll
                    for (int n = 0; n < 2; ++n)
#pragma unroll
                        for (int j = 0; j < 4; ++j) mx = fmaxf(mx, acc[ai][bj][m][n][j]);
                mx = fmaxf(mx, __shfl_xor(mx, 16)); mx = fmaxf(mx, __shfl_xor(mx, 32));
                if (fq == 0) T1[(ai * HALF + wr * 64 + m * 16 + fr) * 4 + wc] = mx; }
        asm volatile("s_waitcnt lgkmcnt(0)" ::: "memory"); __builtin_amdgcn_s_barrier(); asm volatile("" ::: "memory");
#pragma unroll
        for (int ai = 0; ai < 2; ++ai)
#pragma unroll
            for (int m = 0; m < 4; ++m) { const int rl = ai * HALF + wr * 64 + m * 16 + fr; const f32x4 t = *(const PG8_LAS f32x4*)(T1 + rl * 4);
                const float mx = fmaxf(fmaxf(t[0], t[1]), fmaxf(t[2], t[3])); float s = 0.f;
#pragma unroll
                for (int bj = 0; bj < 2; ++bj)
#pragma unroll
                    for (int n = 0; n < 2; ++n)
#pragma unroll
                        for (int j = 0; j < 4; ++j) { const float p = __builtin_amdgcn_exp2f(acc[ai][bj][m][n][j] - mx); acc[ai][bj][m][n][j] = p; s += p; }
                s += __shfl_xor(s, 16); s += __shfl_xor(s, 32);
                if (fq == 0) T2[rl * 4 + wc] = s; }
        asm volatile("s_waitcnt lgkmcnt(0)" ::: "memory"); __builtin_amdgcn_s_barrier(); asm volatile("" ::: "memory");
        const int col0 = (u.pn + u.z) * 256 + wc * 32 + 8 * fq;
#pragma unroll
        for (int ai = 0; ai < 2; ++ai)
#pragma unroll
            for (int m = 0; m < 4; ++m) { const int rl = ai * HALF + wr * 64 + m * 16 + fr; const f32x4 t = *(const PG8_LAS f32x4*)(T2 + rl * 4);
                const float inv = 1.0f / ((t[0] + t[1]) + (t[2] + t[3]));
#pragma unroll
                for (int bj = 0; bj < 2; ++bj) *(u32x4*)(O + (size_t)(u.pm * BM + rl) * 1024 + col0 + bj * HALF) = pack8(acc[ai][bj][m][0] * inv, acc[ai][bj][m][1] * inv); }
        asm volatile("s_waitcnt lgkmcnt(0)" ::: "memory"); __builtin_amdgcn_s_barrier(); asm volatile("" ::: "memory");
    }
};

template <class Epi, class Sched, bool ALIGN_EPI = false, bool SP2 = false>
__device__ __forceinline__ void gemm_phase(PG8_LAS unsigned char* lds, const Gemm g, const Sched& S, const Epi& E) {
    int tid_o = threadIdx.x; asm volatile("" : "+v"(tid_o)); const int tid = tid_o, wid = __builtin_amdgcn_readfirstlane(tid >> 6), lane = tid & 63, wr = wid >> 2, wc = wid & 3, fr = lane & 15, fq = lane >> 4;
    const int nt = g.K / BK; const char* gA_ = reinterpret_cast<const char*>(g.A); const char* gB_ = reinterpret_cast<const char*>(g.Bt); asm volatile("" : "+s"(gA_), "+s"(gB_));
    unsigned voffA[2], voffB[2];
#pragma unroll
    for (int i = 0; i < 2; ++i) { int R, C; stage_rc(tid * 16 + i * 8192, R, C); const int Rb = Epi::PERM ? ((R & ~31) + perm32(R & 31)) : R;
        voffA[i] = (unsigned)(R * g.lda + C) * 2u; voffB[i] = (unsigned)(Rb * g.ldb + C) * 2u; }
    const size_t kstep = (size_t)(BK * 2);
    const size_t hstepA = (size_t)HALF * g.lda * 2, hstepB = (size_t)HALF * g.ldb * 2;

    const unsigned ldsw = (unsigned)wid * 1024u;
    const int aoff = lds_byte(wr * 64 + fr, fq * 8), boff = lds_byte(wc * 32 + fr, fq * 8);
#define PG8_SA(b, h) (((b) * 2 + (h)) * HTB)
#define PG8_SB(b, h) ((4 + (b) * 2 + (h)) * HTB)
#define PG8_STAGE(bufoff, gbase, voff) do { _Pragma("unroll") for (int _i = 0; _i < 2; ++_i) \
        __builtin_amdgcn_global_load_lds((const unsigned*)((const char*)(gbase) + (voff)[_i]), (PG8_LAS unsigned*)(lds + (bufoff) + ldsw + _i * 8192), 16, 0, 0); } while (0)
#define PG8_LDA(dst, b, h) do { _Pragma("unroll") for (int m = 0; m < 4; ++m) _Pragma("unroll") for (int k = 0; k < 2; ++k) dst[m][k] = *(const PG8_LAS bf16x8*)(lds + PG8_SA(b, h) + aoff + m * 2048 + k * 1024); } while (0)
#define PG8_LDB(dst, b, h) do { _Pragma("unroll") for (int n = 0; n < 2; ++n) _Pragma("unroll") for (int k = 0; k < 2; ++k) dst[n][k] = *(const PG8_LAS bf16x8*)(lds + PG8_SB(b, h) + boff + n * 2048 + k * 1024); } while (0)
#define PG8_MMA(ai, bj, At, Bt) do { __builtin_amdgcn_s_setprio(1); _Pragma("unroll") for (int m = 0; m < 4; ++m) _Pragma("unroll") for (int n = 0; n < 2; ++n) _Pragma("unroll") for (int k = 0; k < 2; ++k) \
        acc[ai][bj][m][n] = __builtin_amdgcn_mfma_f32_16x16x32_bf16(Bt[n][k], At[m][k], acc[ai][bj][m][n], 0, 0, 0); __builtin_amdgcn_s_setprio(0); } while (0)
#define PG8_WAIT_V(n) asm volatile("s_waitcnt vmcnt(" #n ")" ::: "memory")
#define PG8_WAIT_L(n) asm volatile("s_waitcnt lgkmcnt(" #n ")" ::: "memory")
#define PG8_BAR __builtin_amdgcn_s_barrier()
#define PG8_SCHED __builtin_amdgcn_sched_barrier(0)
    Unit cur, nxt; int ui = 0;
    if (!S.next(0, cur)) return;
    f32x4 acc[2][2][4][2];
#pragma unroll
    for (int a = 0; a < 2; ++a)
#pragma unroll
        for (int b = 0; b < 2; ++b)
#pragma unroll
            for (int m = 0; m < 4; ++m)
#pragma unroll
                for (int n = 0; n < 2; ++n) acc[a][b][m][n] = (f32x4){0.f, 0.f, 0.f, 0.f};
    bf16x8 At[4][2], B0[2][2], B1[2][2];
    const char* cA = gA_ + (size_t)cur.pm * 2 * hstepA + (size_t)cur.z * g.zA; const char* cB = gB_ + (size_t)cur.pn * 2 * hstepB + (size_t)cur.z * g.zB;
    S.a_ready(cur);
    if constexpr (SP2) {
        PG8_STAGE(PG8_SB(0, 0), cB, voffB); PG8_STAGE(PG8_SB(0, 1), cB + hstepB, voffB); PG8_STAGE(PG8_SA(0, 0), cA, voffA); PG8_STAGE(PG8_SA(0, 1), cA + hstepA, voffA);
        if (wr == 1) PG8_BAR;
        PG8_WAIT_V(2); PG8_BAR;
        PG8_STAGE(PG8_SB(1, 0), cB + kstep, voffB); PG8_STAGE(PG8_SA(1, 0), cA + kstep, voffA); PG8_STAGE(PG8_SB(1, 1), cB + hstepB + kstep, voffB);
        PG8_WAIT_V(6); PG8_BAR;
    } else {
        PG8_STAGE(PG8_SB(0, 0), cB, voffB); PG8_STAGE(PG8_SA(0, 0), cA, voffA); PG8_STAGE(PG8_SB(0, 1), cB + hstepB, voffB); PG8_STAGE(PG8_SA(0, 1), cA + hstepA, voffA);
        if (wr == 1) PG8_BAR;
        PG8_WAIT_V(4); PG8_BAR;
        PG8_STAGE(PG8_SB(1, 0), cB + kstep, voffB); PG8_STAGE(PG8_SA(1, 0), cA + kstep, voffA); PG8_STAGE(PG8_SB(1, 1), cB + hstepB + kstep, voffB);
        PG8_WAIT_V(6); PG8_BAR;
    }
    for (;;) {
        const bool has_next = S.next(ui + 1, nxt);
        const char* nA = has_next ? gA_ + (size_t)nxt.pm * 2 * hstepA + (size_t)nxt.z * g.zA : cA; const char* nB = has_next ? gB_ + (size_t)nxt.pn * 2 * hstepB + (size_t)nxt.z * g.zB : cB;
_Pragma("nounroll")
        for (int t = 0; t < nt; t += 2) {
            const bool last = (t == nt - 2);
            const char* a1 = cA + (size_t)(t + 1) * kstep;
            const char* a2 = last ? nA : cA + (size_t)(t + 2) * kstep; const char* b2 = last ? nB : cB + (size_t)(t + 2) * kstep;
            const char* a3 = a2 + kstep; const char* b3 = b2 + kstep;
            if (last && has_next) S.a_ready(nxt);
            if constexpr (SP2) {
            PG8_LDB(B0, 0, 0); PG8_LDB(B1, 0, 1); PG8_SCHED; PG8_LDA(At, 0, 0); PG8_STAGE(PG8_SA(1, 1), a1 + hstepA, voffA);
            PG8_WAIT_V(8); PG8_WAIT_L(0); PG8_BAR; PG8_MMA(0, 0, At, B0); PG8_MMA(0, 1, At, B1); PG8_BAR; PG8_SCHED;
            PG8_LDA(At, 0, 1); PG8_STAGE(PG8_SB(0, 0), b2, voffB); PG8_STAGE(PG8_SB(0, 1), b2 + hstepB, voffB); PG8_STAGE(PG8_SA(0, 0), a2, voffA);
            PG8_WAIT_V(8); PG8_WAIT_L(0); PG8_BAR; PG8_MMA(1, 0, At, B0); PG8_MMA(1, 1, At, B1); PG8_BAR; PG8_SCHED;
            PG8_LDB(B0, 1, 0); PG8_LDB(B1, 1, 1); PG8_SCHED; PG8_LDA(At, 1, 0); PG8_STAGE(PG8_SA(0, 1), a2 + hstepA, voffA);
            PG8_WAIT_V(8); PG8_WAIT_L(0); PG8_BAR; PG8_MMA(0, 0, At, B0); PG8_MMA(0, 1, At, B1); PG8_BAR; PG8_SCHED;
            PG8_LDA(At, 1, 1); PG8_STAGE(PG8_SB(1, 0), b3, voffB); PG8_STAGE(PG8_SB(1, 1), b3 + hstepB, voffB); PG8_STAGE(PG8_SA(1, 0), a3, voffA);
            PG8_WAIT_V(8); PG8_WAIT_L(0); PG8_BAR; PG8_MMA(1, 0, At, B0); PG8_MMA(1, 1, At, B1); PG8_BAR; PG8_SCHED;
            } else {
            PG8_LDB(B0, 0, 0); PG8_SCHED; PG8_LDA(At, 0, 0); PG8_STAGE(PG8_SA(1, 1), a1 + hstepA, voffA);
            PG8_WAIT_L(8); PG8_BAR; PG8_WAIT_L(0); PG8_MMA(0, 0, At, B0); PG8_BAR; PG8_SCHED;
            PG8_LDB(B1, 0, 1); PG8_STAGE(PG8_SB(0, 0), b2, voffB);
            PG8_BAR; PG8_WAIT_L(0); PG8_MMA(0, 1, At, B1); PG8_BAR;
            PG8_LDA(At, 0, 1); PG8_STAGE(PG8_SA(0, 0), a2, voffA);
            PG8_BAR; PG8_WAIT_L(0); PG8_MMA(1, 0, At, B0); PG8_BAR; PG8_SCHED;
            PG8_STAGE(PG8_SB(0, 1), b2 + hstepB, voffB);
            PG8_WAIT_V(6); PG8_BAR; PG8_MMA(1, 1, At, B1); PG8_BAR;
            PG8_LDB(B0, 1, 0); PG8_SCHED; PG8_LDA(At, 1, 0); PG8_STAGE(PG8_SA(0, 1), a2 + hstepA, voffA);
            PG8_WAIT_L(8); PG8_BAR; PG8_WAIT_L(0); PG8_MMA(0, 0, At, B0); PG8_BAR; PG8_SCHED;
            PG8_LDB(B1, 1, 1); PG8_STAGE(PG8_SB(1, 0), b3, voffB);
            PG8_BAR; PG8_WAIT_L(0); PG8_MMA(0, 1, At, B1); PG8_BAR;
            PG8_LDA(At, 1, 1); PG8_STAGE(PG8_SA(1, 0), a3, voffA);
            PG8_BAR; PG8_WAIT_L(0); PG8_MMA(1, 0, At, B0); PG8_BAR; PG8_SCHED;
            PG8_STAGE(PG8_SB(1, 1), b3 + hstepB, voffB);
            PG8_WAIT_V(6); PG8_BAR; PG8_MMA(1, 1, At, B1); PG8_BAR;
            }
        }
        if constexpr (ALIGN_EPI) { if (wr == 0) PG8_BAR; }
        if constexpr (!Epi::AFTER_DRAIN) { E(acc, cur, wr, wc, fr, fq); S.done(cur); }
        if (!has_next) break;
#pragma unroll
        for (int a = 0; a < 2; ++a)
#pragma unroll
            for (int b = 0; b < 2; ++b)
#pragma unroll
                for (int m = 0; m < 4; ++m)
#pragma unroll
                    for (int n = 0; n < 2; ++n) acc[a][b][m][n] = (f32x4){0.f, 0.f, 0.f, 0.f};
        cur = nxt; cA = nA; cB = nB; ++ui;
        if constexpr (ALIGN_EPI) { if (wr == 1) PG8_BAR; }
    }
    PG8_WAIT_V(0);
    if constexpr (!ALIGN_EPI) { if (wr == 0) PG8_BAR; }
    PG8_BAR;
    if constexpr (Epi::AFTER_DRAIN) { E.fused(acc, cur, wr, wc, fr, fq, lds, wid, lane); S.done(cur); }
#undef PG8_SA
#undef PG8_SB
#undef PG8_STAGE
#undef PG8_LDA
#undef PG8_LDB
#undef PG8_MMA
#undef PG8_WAIT_V
#undef PG8_WAIT_L
#undef PG8_BAR
#undef PG8_SCHED
}
}
#include <hip/hip_bf16.h>
#include <cmath>
namespace attn_body {
using bf16=__hip_bfloat16;
using bf16x8=__attribute__((ext_vector_type(8)))short;
using s16x4=__attribute__((ext_vector_type(4)))short;
using f32x16=__attribute__((ext_vector_type(16)))float;
using u32x4=__attribute__((ext_vector_type(4)))unsigned;
using f32x4_t=__attribute__((ext_vector_type(4)))float;
constexpr int BATCH=1,NHEAD=8,SEQ=16384,D=64,DM=NHEAD*D;
constexpr int NW=8,QBLK=32,QB=QBLK*NW,KVBLK=64,NQB=SEQ/QB;
constexpr int ATTN_PITCH=DM, ATTN_UNIT_ROWS=QB;
__device__ __forceinline__ int crow(int r,int hi){return (r&3)+8*(r>>2)+4*hi;}
#define SBAR() __builtin_amdgcn_sched_barrier(0)
__device__ __forceinline__ void cmask(f32x16&p0,f32x16&p1,int jb,int qrel,int hi){
  const float NEG=-INFINITY; int kb=64*jb+4*hi;
  #pragma unroll
  for(int r=0;r<16;++r){int kv=kb+(r&3)+8*(r>>2); if(kv>qrel)p0[r]=NEG; if(kv+32>qrel)p1[r]=NEG;}
}

constexpr int NSLOT=3, SLOTB=8192;
constexpr int LDS_K=0, LDS_V=NSLOT*SLOTB, LDS_WS=2*NSLOT*SLOTB, LDS_OST=LDS_WS+NW*64*4, LDS_CK=LDS_OST+NW*4096, LDS_BYTES=LDS_CK+SEQ*4;
constexpr float C2=0.125f*1.4426950408889634f;
__device__ __forceinline__ void glds16(const void*gsrc,unsigned lds_dst){unsigned keep;
  asm volatile("s_mov_b32 %0, m0\n\ts_mov_b32 m0, %2\n\ts_nop 0\n\tglobal_load_lds_dwordx4 %1, off\n\ts_mov_b32 m0, %0":"=&s"(keep):"v"(gsrc),"s"(lds_dst):"memory");}
__device__ __forceinline__ float max3f(float a,float b,float c){float r;asm("v_max3_f32 %0, %1, %2, %3":"=v"(r):"v"(a),"v"(b),"v"(c));return r;}
__device__ __forceinline__ float max2f(float a,float b){float r;asm("v_max_f32_e32 %0, %1, %2":"=v"(r):"v"(a),"v"(b));return r;}
__device__ __forceinline__ float fadd_s(float a,float b){float r;asm("v_add_f32_e32 %0, %1, %2":"=v"(r):"v"(a),"v"(b));return r;}
__device__ __forceinline__ float fsub_s(float a,float b){float r;asm("v_sub_f32_e32 %0, %1, %2":"=v"(r):"v"(a),"v"(b));return r;}
typedef float f32x2_t __attribute__((ext_vector_type(2))); typedef __bf16 bf16x2_t __attribute__((ext_vector_type(2)));
__device__ __forceinline__ unsigned cvtpk_s(float lo,float hi){f32x2_t v={lo,hi};bf16x2_t b=__builtin_convertvector(v,bf16x2_t);return __builtin_bit_cast(unsigned,b);}
#define WAIT_BAR(N) asm volatile("s_waitcnt vmcnt(" #N ") lgkmcnt(0)\n\ts_barrier":::"memory")

__device__ __forceinline__ void qkt(f32x16&p0,f32x16&p1,const char*Kslot,const bf16x8*qr,const f32x16&negm,int r32,int hi){
  const char*kb=Kslot+hi*1024+r32*16;
  #pragma unroll
  for(int d0=0;d0<4;++d0){
    const bf16x8 b0=*reinterpret_cast<const bf16x8*>(kb+d0*2048);
    const bf16x8 b1=*reinterpret_cast<const bf16x8*>(kb+d0*2048+512);
    if(d0==0){p0=__builtin_amdgcn_mfma_f32_32x32x16_bf16(b0,qr[0],negm,0,0,0);p1=__builtin_amdgcn_mfma_f32_32x32x16_bf16(b1,qr[0],negm,0,0,0);}
    else{p0=__builtin_amdgcn_mfma_f32_32x32x16_bf16(b0,qr[d0],p0,0,0,0);p1=__builtin_amdgcn_mfma_f32_32x32x16_bf16(b1,qr[d0],p1,0,0,0);}}
}
typedef __attribute__((address_space(3))) const char* lds_cptr;
typedef short v4i16_t __attribute__((ext_vector_type(4)));
__device__ __forceinline__ void kload8(bf16x8*kf,lds_cptr kp){
  kf[0]=*(const __attribute__((address_space(3))) bf16x8*)(kp);      kf[1]=*(const __attribute__((address_space(3))) bf16x8*)(kp+512);
  kf[2]=*(const __attribute__((address_space(3))) bf16x8*)(kp+2048); kf[3]=*(const __attribute__((address_space(3))) bf16x8*)(kp+2560);
  kf[4]=*(const __attribute__((address_space(3))) bf16x8*)(kp+4096); kf[5]=*(const __attribute__((address_space(3))) bf16x8*)(kp+4608);
  kf[6]=*(const __attribute__((address_space(3))) bf16x8*)(kp+6144); kf[7]=*(const __attribute__((address_space(3))) bf16x8*)(kp+6656);
}
__device__ __forceinline__ void kload2(bf16x8*kf,lds_cptr kp,int j){ kf[2*j]=*(const __attribute__((address_space(3))) bf16x8*)(kp+j*2048); kf[2*j+1]=*(const __attribute__((address_space(3))) bf16x8*)(kp+j*2048+512); }
__device__ __forceinline__ s16x4 vtr(lds_cptr p){ return __builtin_bit_cast(s16x4,__builtin_amdgcn_ds_read_tr16_b64_v4i16((__attribute__((address_space(3))) v4i16_t*)p)); }
__device__ __forceinline__ float rowmax(const f32x16&p0,const f32x16&p1){
  float a=max3f(p0[0],p0[1],p1[0]),b=max3f(p0[2],p0[3],p1[1]);a=max3f(a,p1[2],p1[3]);
  #pragma unroll
  for(int r=4;r<16;r+=4){a=max3f(a,p0[r],p0[r+1]);b=max3f(b,p0[r+2],p0[r+3]);a=max3f(a,p1[r],p1[r+1]);b=max3f(b,p1[r+2],p1[r+3]);}
  const float m=max2f(a,b);
  auto rr=__builtin_amdgcn_permlane32_swap(__float_as_uint(m),__float_as_uint(m),false,false);
  return max2f(__uint_as_float(rr[0]),__uint_as_float(rr[1]));
}
__device__ __forceinline__ void pv(f32x16*o,int vb,bf16x8 pa0,bf16x8 pa1,bf16x8 pa2,bf16x8 pa3){
  #pragma unroll
  for(int d0=0;d0<2;++d0){s16x4 lo[4],hi[4];
    #pragma unroll
    for(int ks=0;ks<4;++ks){
      asm volatile("ds_read_b64_tr_b16 %0,%1 offset:%c2":"=&v"(lo[ks]):"v"(vb),"i"(d0*4096+ks*1024):"memory");
      asm volatile("ds_read_b64_tr_b16 %0,%1 offset:%c2":"=&v"(hi[ks]):"v"(vb),"i"(d0*4096+ks*1024+512):"memory");}
    asm volatile("s_waitcnt lgkmcnt(0)":::"memory");SBAR();
    #define PK(k) (bf16x8){lo[k][0],lo[k][1],lo[k][2],lo[k][3],hi[k][0],hi[k][1],hi[k][2],hi[k][3]}
    o[d0]=__builtin_amdgcn_mfma_f32_32x32x16_bf16(pa0,PK(0),o[d0],0,0,0);
    o[d0]=__builtin_amdgcn_mfma_f32_32x32x16_bf16(pa1,PK(1),o[d0],0,0,0);
    o[d0]=__builtin_amdgcn_mfma_f32_32x32x16_bf16(pa2,PK(2),o[d0],0,0,0);
    o[d0]=__builtin_amdgcn_mfma_f32_32x32x16_bf16(pa3,PK(3),o[d0],0,0,0);
    #undef PK
  }
}

#ifndef ATTN_STORE16
#define ATTN_STORE16(p,v) (*(u32x4*)(p)=(v))
#endif
template<int THRL> __device__ __forceinline__ void attn_unit(int b,int h,int qb,const bf16*Q,const bf16*__restrict__ K,const bf16*__restrict__ V,bf16*O,const float*__restrict__ CSg,const unsigned*KMg,char*shm,const int t0,const int ntl,const bool masked,float*__restrict__ Lout){
  int tid_o=threadIdx.x; asm volatile("":"+v"(tid_o)); const int tid=tid_o,lane=tid&63,r32=lane&31,hi=lane>>5; const int wid=__builtin_amdgcn_readfirstlane(tid>>6);
  const long rowbase=(long)b*SEQ; const int q0=qb*QB;
  const bf16*Qw=Q+(rowbase+q0+wid*QBLK)*DM+h*D;
  const bf16*Kh=K+(rowbase+(long)t0*KVBLK)*DM+h*D,*Vh=V+(rowbase+(long)t0*KVBLK)*DM+h*D;
  const unsigned lds0=(unsigned)(uintptr_t)shm;
  float*wsf=(float*)(shm+LDS_WS)+wid*64;
  const lds_cptr shm3=(lds_cptr)shm;
  const bf16*ksrc=Kh+(long)lane*DM+wid*8;
  const bf16*vsrc=Vh+(long)(16*(wid&3)+(lane>>2))*DM+(wid>>2)*32+(lane&3)*8;
  const unsigned kdst=lds0+LDS_K+wid*1024, vdst=lds0+LDS_V+wid*1024;
  #define DMA_K(t,slot) glds16(ksrc+(long)(t)*KVBLK*DM,(unsigned)__builtin_amdgcn_readfirstlane(kdst+(slot)))
  #define DMA_V(t,slot) glds16(vsrc+(long)(t)*KVBLK*DM,(unsigned)__builtin_amdgcn_readfirstlane(vdst+(slot)))
  const int vb0=(int)(lds0+LDS_V)+((lane>>4)&1)*32+(lane&3)*8+(4*hi+((lane&15)>>2))*64;
  const char*Kbase=shm+LDS_K; bf16x8 kf[8];
  const lds_cptr kp0=shm3+LDS_K+hi*1024+r32*16; const lds_cptr vp0=shm3+LDS_V+((lane>>4)&1)*32+(lane&3)*8+(4*hi+((lane&15)>>2))*64;
  const int NT=ntl;
  typedef __attribute__((address_space(3))) float* lds_fptr; typedef __attribute__((address_space(3))) f32x4_t* lds_f4ptr;
  const float*csh=CSg+(long)h*SEQ;
  { const lds_fptr ckw=(lds_fptr)(shm3+LDS_CK);
    for(int i=tid*4;i<ntl*KVBLK;i+=NW*64*4){ const f32x4_t v=*(const f32x4_t*)(csh+t0*KVBLK+i); *(lds_f4ptr)(ckw+i)=v; }
  }
  const float cq=csh[q0+wid*QBLK+r32];
  asm volatile("s_waitcnt vmcnt(0) lgkmcnt(0)\n\ts_barrier":::"memory");
  const lds_fptr ckt=(lds_fptr)(shm3+LDS_CK)+4*hi;
  #define CKSUB(P0,P1,t) do{ const lds_fptr ckp_=ckt+64*(t); _Pragma("unroll") for(int j_=0;j_<4;++j_){ const f32x4_t a_=*(const lds_f4ptr)(ckp_+8*j_); const f32x4_t b_=*(const lds_f4ptr)(ckp_+32+8*j_); \
      P0[4*j_]-=a_[0];P0[4*j_+1]-=a_[1];P0[4*j_+2]-=a_[2];P0[4*j_+3]-=a_[3]; P1[4*j_]-=b_[0];P1[4*j_+1]-=b_[1];P1[4*j_+2]-=b_[2];P1[4*j_+3]-=b_[3]; SBAR(); } }while(0)
  DMA_K(0,0);DMA_V(0,0);DMA_K(1,SLOTB);
  bf16x8 qr[4];
  #pragma unroll
  for(int d0=0;d0<4;++d0)qr[d0]=*reinterpret_cast<const bf16x8*>(&Qw[(long)r32*DM+d0*16+hi*8]);
  float l_reg=0.f;f32x16 o[2];o[0]=f32x16{};o[1]=f32x16{};f32x16 negm;
  {
    float q2=0.f;
    _Pragma("unroll") for(int d0=0;d0<4;++d0) _Pragma("unroll") for(int e=0;e<8;++e){ const float v=__uint_as_float(((unsigned)(unsigned short)qr[d0][e])<<16); q2+=v*v; }
    { auto rr=__builtin_amdgcn_permlane32_swap(__float_as_uint(q2),__float_as_uint(q2),false,false); q2=__uint_as_float(rr[0])+__uint_as_float(rr[1]); }
    const float km2=__uint_as_float(__hip_atomic_load(KMg+h,__ATOMIC_RELAXED,__HIP_MEMORY_SCOPE_AGENT));
    const float Rq=sqrtf(q2*km2)*1.001f+0.01f;
    _Pragma("unroll") for(int r=0;r<16;++r)negm[r]=cq-Rq; asm volatile("":"+v"(negm)); }
  const int qrel=wid*QBLK+r32;
  #define CMASK(P0,P1,t) do{int jb_=(t)-(NT-4); if(masked&&jb_>=0)cmask(P0,P1,jb_,qrel,hi);}while(0)
  #define START(P0,P1) do{ const float rm=rowmax(P0,P1); resc=false; \
    { const float dl=rm; mhat=fadd_s(mhat,dl); \
      _Pragma("unroll") for(int r=0;r<16;++r){P0[r]=fsub_s(P0[r],dl);P1[r]=fsub_s(P1[r],dl);} \
      _Pragma("unroll") for(int r=0;r<16;++r)negm[r]=-mhat; asm volatile("":"+v"(negm)); } \
    _Pragma("unroll") for(int r=0;r<16;++r)P0[r]=__builtin_amdgcn_exp2f(P0[r]); }while(0)
  #define RESC() do{ if(resc){ asm volatile("s_waitcnt lgkmcnt(0)":::"memory"); \
      _Pragma("unroll") for(int d_=0;d_<2;++d_) _Pragma("unroll") for(int r=0;r<16;++r)o[d_][r]*=wsf[crow(r,hi)]; } }while(0)
  f32x16 pA0,pA1,pB0,pB1;
  int sl_prev=0,sl_cur=0,sl_next=SLOTB;
  #define ROT() do{sl_prev=sl_cur;sl_cur=sl_next;sl_next=(sl_next==(NSLOT-1)*SLOTB)?0:sl_next+SLOTB;}while(0)
  DMA_K(2,2*SLOTB);
  WAIT_BAR(3);
  qkt(pA0,pA1,Kbase,qr,negm,r32,hi);asm volatile("s_nop 15\n\ts_nop 7":"+v"(pA0),"+v"(pA1));CKSUB(pA0,pA1,0);CMASK(pA0,pA1,0);
  _Pragma("unroll") for(int r=0;r<16;++r)pA0[r]=__builtin_amdgcn_exp2f(pA0[r]);
  _Pragma("unroll") for(int r=0;r<16;++r)pA1[r]=__builtin_amdgcn_exp2f(pA1[r]);
  WAIT_BAR(0);
  DMA_K(3,0);DMA_V(1,SLOTB);
  ROT();
  kload8(kf,kp0+sl_cur);
  WAIT_BAR(2);
  s16x4 vlo[8],vhi[8]; u32x4 pw0,pw1,pw2,pw3;
  #define PKW(P,B) cvtpk_s(P[B],P[B+1])
  #define PAF(k) __builtin_bit_cast(bf16x8,pw##k)
  #define VFR(i) (bf16x8){vlo[i][0],vlo[i][1],vlo[i][2],vlo[i][3],vhi[i][0],vhi[i][1],vhi[i][2],vhi[i][3]}
  #define PIN(x) asm volatile("":"+v"(x))
  #define MX3(a,b,c) __builtin_fmaxf(__builtin_fmaxf((a),(b)),(c))
  #define GAPA(MF,A0,A1,A2,A3,W0,W1,PW) do{ MF; sacc+=A0; sacc+=A1; sacc+=A2; sacc+=A3; PIN(sacc); W0; W1; PIN(PW); SBAR(); }while(0)
  #define EX(v) __builtin_amdgcn_exp2f(v)
  #define GAPB(MF,X,B,CUR,NXT,NOFF) do{ MF; if((NOFF)>=0){ NXT=*(const lds_f4ptr)(ckp_+((NOFF)>=0?(NOFF):0)); } X[B]=EX(X[B]-CUR[0]); X[B+1]=EX(X[B+1]-CUR[1]); X[B+2]=EX(X[B+2]-CUR[2]); X[B+3]=EX(X[B+3]-CUR[3]); PIN(X); SBAR(); }while(0)
  #define VRD(i) do{ vlo[i]=vtr(vp_+(((i)>>2)*4096+((i)&3)*1024)); vhi[i]=vtr(vp_+(((i)>>2)*4096+((i)&3)*1024+512)); }while(0)
  #define KRD(G,j) do{ if(G){ kload2(kf,kp0+sl_next,j); SBAR(); } }while(0)
  #define STEP(C0,C1,P0,P1,t,GK,GV,GL) do{ SBAR(); \
    const lds_cptr vp_=vp0+sl_prev; \
    VRD(0); SBAR(); float sacc=(P0[0]+P0[1]); \
    GAPA(C0=__builtin_amdgcn_mfma_f32_32x32x16_bf16(kf[0],qr[0],negm,0,0,0), P0[2],P0[3],P0[4],P0[5],     pw0[0]=PKW(P0,0), pw0[1]=PKW(P0,2), pw0); \
    VRD(4); SBAR(); GAPA(C1=__builtin_amdgcn_mfma_f32_32x32x16_bf16(kf[1],qr[0],negm,0,0,0), P0[6],P0[7],P0[8],P0[9],     pw0[2]=PKW(P0,4), pw0[3]=PKW(P0,6), pw0); \
    VRD(1); SBAR(); GAPA(C0=__builtin_amdgcn_mfma_f32_32x32x16_bf16(kf[2],qr[1],C0,0,0,0),   P0[10],P0[11],P0[12],P0[13], pw1[0]=PKW(P0,8), pw1[1]=PKW(P0,10), pw1); \
    VRD(5); SBAR(); GAPA(C1=__builtin_amdgcn_mfma_f32_32x32x16_bf16(kf[3],qr[1],C1,0,0,0),   P0[14],P0[15],P1[0],P1[1],   pw1[2]=PKW(P0,12),pw1[3]=PKW(P0,14), pw1); \
    VRD(2); SBAR(); GAPA(C0=__builtin_amdgcn_mfma_f32_32x32x16_bf16(kf[4],qr[2],C0,0,0,0),   P1[2],P1[3],P1[4],P1[5],     pw2[0]=PKW(P1,0), pw2[1]=PKW(P1,2), pw2); \
    VRD(6); SBAR(); GAPA(C1=__builtin_amdgcn_mfma_f32_32x32x16_bf16(kf[5],qr[2],C1,0,0,0),   P1[6],P1[7],P1[8],P1[9],     pw2[2]=PKW(P1,4), pw2[3]=PKW(P1,6), pw2); \
    VRD(3); SBAR(); GAPA(C0=__builtin_amdgcn_mfma_f32_32x32x16_bf16(kf[6],qr[3],C0,0,0,0),   P1[10],P1[11],P1[12],P1[13], pw3[0]=PKW(P1,8), pw3[1]=PKW(P1,10), pw3); \
    VRD(7); SBAR(); GAPA(C1=__builtin_amdgcn_mfma_f32_32x32x16_bf16(kf[7],qr[3],C1,0,0,0),   P1[14],P1[15],0.f,0.f,       pw3[2]=PKW(P1,12),pw3[3]=PKW(P1,14), pw3); \
    l_reg+=sacc; \
    if(GK){DMA_K((t)+3,sl_cur);} if(GV){DMA_V((t)+1,sl_next);} \
    CMASK(C0,C1,t); \
    const lds_fptr ckp_=ckt+64*(t); f32x4_t ckA_=*(const lds_f4ptr)(ckp_), ckB_; \
    SBAR(); \
    GAPB(o[0]=__builtin_amdgcn_mfma_f32_32x32x16_bf16(PAF(0),VFR(0),o[0],0,0,0), C0,0,ckA_,ckB_,8); \
    GAPB(o[1]=__builtin_amdgcn_mfma_f32_32x32x16_bf16(PAF(0),VFR(4),o[1],0,0,0), C0,4,ckB_,ckA_,16); \
    KRD(GL,0); GAPB(o[0]=__builtin_amdgcn_mfma_f32_32x32x16_bf16(PAF(1),VFR(1),o[0],0,0,0), C0,8,ckA_,ckB_,24); \
    KRD(GL,1); GAPB(o[1]=__builtin_amdgcn_mfma_f32_32x32x16_bf16(PAF(1),VFR(5),o[1],0,0,0), C0,12,ckB_,ckA_,32); \
    KRD(GL,2); GAPB(o[0]=__builtin_amdgcn_mfma_f32_32x32x16_bf16(PAF(2),VFR(2),o[0],0,0,0), C1,0,ckA_,ckB_,40); \
    KRD(GL,3); GAPB(o[1]=__builtin_amdgcn_mfma_f32_32x32x16_bf16(PAF(2),VFR(6),o[1],0,0,0), C1,4,ckB_,ckA_,48); \
    GAPB(o[0]=__builtin_amdgcn_mfma_f32_32x32x16_bf16(PAF(3),VFR(3),o[0],0,0,0), C1,8,ckA_,ckB_,56); \
    GAPB(o[1]=__builtin_amdgcn_mfma_f32_32x32x16_bf16(PAF(3),VFR(7),o[1],0,0,0), C1,12,ckB_,ckA_,-1); \
    }while(0)
  int t=1;
  #undef CMASK
  #define CMASK(P0,P1,t) do{}while(0)
  for(;t+5<NT;t+=2){
    STEP(pB0,pB1,pA0,pA1,t,true,true,true);     WAIT_BAR(2); ROT();
    STEP(pA0,pA1,pB0,pB1,t+1,true,true,true);   WAIT_BAR(2); ROT();
  }
  #undef CMASK
  #define CMASK(P0,P1,t) do{int jb_=(t)-(NT-4); if(masked&&jb_>=0)cmask(P0,P1,jb_,qrel,hi);}while(0)
  #define ENDW(tt) do{ if((tt)+3<NT){WAIT_BAR(2);} else if((tt)+2<NT){WAIT_BAR(1);} else {WAIT_BAR(0);} }while(0)
  for(;t+1<NT;t+=2){
    STEP(pB0,pB1,pA0,pA1,t,(t+3<NT),(t+1<NT),(t+1<NT));       ENDW(t); ROT();
    STEP(pA0,pA1,pB0,pB1,t+1,(t+4<NT),(t+2<NT),(t+2<NT));     ENDW(t+1); ROT();
  }
  STEP(pB0,pB1,pA0,pA1,NT-1,false,false,false);
  { float sacc=pB0[0]+pB0[1]; _Pragma("unroll") for(int r=2;r<16;++r)sacc+=pB0[r]; _Pragma("unroll") for(int r=0;r<16;++r)sacc+=pB1[r]; l_reg+=sacc;
    pw0=(u32x4){PKW(pB0,0),PKW(pB0,2),PKW(pB0,4),PKW(pB0,6)};pw1=(u32x4){PKW(pB0,8),PKW(pB0,10),PKW(pB0,12),PKW(pB0,14)};pw2=(u32x4){PKW(pB1,0),PKW(pB1,2),PKW(pB1,4),PKW(pB1,6)};pw3=(u32x4){PKW(pB1,8),PKW(pB1,10),PKW(pB1,12),PKW(pB1,14)};
    SBAR(); pv(o,vb0+sl_cur,PAF(0),PAF(1),PAF(2),PAF(3)); }
  #undef PKW
  #undef PAF
  #undef VFR
  #undef PIN
  #undef MX3
  #undef GAPA
  #undef GAPB
  #undef EX
  #undef VRD
  #undef KRD
  #undef STEP
  #undef ENDW
  {auto rr=__builtin_amdgcn_permlane32_swap(__float_as_uint(l_reg),__float_as_uint(l_reg),false,false);l_reg=__uint_as_float(rr[0])+__uint_as_float(rr[1]);}
  if(hi==0){wsf[32+r32]=l_reg; Lout[(long)(q0+wid*QBLK+r32)*NHEAD+h]=l_reg;}asm volatile("s_waitcnt lgkmcnt(0)":::"memory");
  float rli[16];
  #pragma unroll
  for(int r=0;r<16;++r){const float lv_=wsf[32+crow(r,hi)]; rli[r]=lv_>1e-30f?__builtin_amdgcn_rcpf(lv_):0.f;}
  bf16*Ow=O+(rowbase+q0+wid*QBLK)*DM+h*D;
  { bf16*stg=(bf16*)(shm+LDS_OST)+wid*2048;
    #pragma unroll
    for(int r=0;r<16;++r){const int orow=crow(r,hi);
      #pragma unroll
      for(int d0=0;d0<2;++d0)stg[orow*64+d0*32+r32]=__float2bfloat16(o[d0][r]*rli[r]);}
    asm volatile("s_waitcnt lgkmcnt(0)":::"memory");
    #pragma unroll
    for(int i=0;i<4;++i){const int row=i*8+(lane>>3),ch=lane&7; const u32x4 v=*(const u32x4*)(stg+row*64+ch*8); ATTN_STORE16(Ow+(long)row*DM+ch*8,v);} }
  asm volatile("s_waitcnt lgkmcnt(0)\n\ts_barrier":::"memory");
  #undef CKSUB
  #undef DMA_K
  #undef DMA_V
  #undef CMASK
  #undef START
  #undef RESC
  #undef ROT
}
constexpr int ATTN_LDS_BYTES=LDS_BYTES;
struct AttnTensors { const bf16* Q; const bf16* K; const bf16* V; bf16* O; const float* CS; const unsigned* KM; };
struct AttnUnit { int bh; int qb; };
struct StaticOrder {
  int vcu,G;
  __device__ __forceinline__ explicit StaticOrder(int grid,int block):vcu((grid%8==0)?(block%8)*(grid/8)+block/8:block),G(grid){}
  __device__ __forceinline__ bool next(int i,AttnUnit&u)const{
    if(G==256){ if(i>=2)return false; const int s=vcu&31; u.bh=vcu>>5; u.qb=(i==0)?s:63-s; return true; }
    const int Lx=i*G+vcu; if(Lx>=NHEAD*NQB)return false; u.bh=Lx/NQB; u.qb=NQB-1-(Lx%NQB); return true; }
  __device__ __forceinline__ void a_ready(const AttnUnit&)const{}
  __device__ __forceinline__ void done(const AttnUnit&)const{}
};
template<class Sched,int THRL=8> __device__ __forceinline__ void attn_phase(char*lds,const AttnTensors&T,const Sched&S){
  AttnUnit u;
  for(int i=0;S.next(i,u);++i){ S.a_ready(u); attn_unit<THRL>(0,u.bh,u.qb,T.Q,T.K,T.V,T.O,T.CS,T.KM,lds,0,4*(u.qb+1),true,(float*)nullptr); S.done(u); }
}
#undef SBAR
#undef WAIT_BAR
}
#define LAS __attribute__((address_space(3)))
typedef unsigned short bf16;
typedef unsigned v4u __attribute__((ext_vector_type(4)));
typedef unsigned v2u __attribute__((ext_vector_type(2)));
typedef float f32x4 __attribute__((ext_vector_type(4)));
typedef short bf16x8 __attribute__((ext_vector_type(8)));
constexpr int NWAVES = 8, NTHREADS = 512;
constexpr int M = 16384, D = 1024, FF = 2816, MEML = 256, DIN = 7176, NLAYER = 2;
constexpr float EPS = 1e-6f, LOG2E = 1.4426950408889634f;
constexpr int LDS_BYTES = 155648, XB_LDS_OFF = LDS_BYTES - 256, T0_LDS_OFF = 149504, RS_LDS_OFF = 131072 + 256;
static_assert(attn_body::ATTN_LDS_BYTES <= LDS_BYTES, "lds");
constexpr size_t MiB = 1u << 20;
constexpr size_t WS_SS = 1 * MiB, WS_SSV = 2 * MiB, WS_LF = 2 * MiB + 512 * 1024, WS_CS = 3 * MiB, WS_RSM = 3 * MiB + 512 * 1024, WS_MEMB = 4 * MiB, WS_KC = 4 * MiB + 512 * 1024, WS_VCT = 5 * MiB;
constexpr size_t WS_LPL = 5 * MiB + 512 * 1024, WS_LP = 66 * MiB + 256 * 1024;
constexpr size_t WS_W = 6 * MiB, WS_XB = 68 * MiB, WS_SCR = 100 * MiB, WS_WL = 244 * MiB, WS_VT2 = 246 * MiB, WS_END = 248 * MiB;
constexpr size_t WO_GU1 = 0, WO_D1 = WO_GU1 + (size_t)5632 * 1024, WO_IN = WO_D1 + (size_t)1024 * 2816, WO_G = WO_IN + (size_t)4096 * 1024, WO_B = WO_G + (size_t)3072 * 1024,
                 WO_O = WO_B + (size_t)3 * 1024 * 512, WO_Q = WO_O + (size_t)1024 * 1024, WO_K = WO_Q + (size_t)1024 * 1024, WO_V = WO_K + (size_t)1024 * 1024, WO_XO = WO_V + (size_t)1024 * 1024,
                 WO_GU2 = WO_XO + (size_t)1024 * 1024, WO_D2 = WO_GU2 + (size_t)5632 * 1024, WO_END = WO_D2 + (size_t)1024 * 2816;
static_assert(WS_W + (WO_END + 16 * 1024) * 2 <= WS_LP && WS_LP + 3 * 512 * 1024 <= WS_XB, "weights fit");
constexpr size_t PIECE = (size_t)M * 512;

typedef __attribute__((address_space(1))) unsigned gu32;
#define RLX_AGENT __ATOMIC_RELAXED, __HIP_MEMORY_SCOPE_AGENT
#define XB_TMO      128
#define XB_XCNT(j)  (256  + 64 * (j))
#define XB_XSUB(j)  (1280 + 64 * (j))
#define XB_XGEN(j)  (2304 + 64 * (j))
#define XB_TOP      3328
#define XB_TOPGEN   3392
#define XCD_BAR_WORDS 3456
#define XB_SPIN_CAP (1u << 18)

__device__ __forceinline__ unsigned xb_ld(unsigned* p)              { return __hip_atomic_load(p, __ATOMIC_RELAXED, __HIP_MEMORY_SCOPE_AGENT); }
__device__ __forceinline__ unsigned xb_add(unsigned* p, unsigned v) { return __hip_atomic_fetch_add(p, v, __ATOMIC_RELAXED, __HIP_MEMORY_SCOPE_AGENT); }
__device__ __forceinline__ unsigned xb_xcc_id() { return (unsigned)__builtin_amdgcn_s_getreg((3 << 11) | 20) & 0xFu; }
#define XB_SPIN(cond, bar) do { unsigned _sp = 0; while (cond) { __builtin_amdgcn_s_sleep(1); \
    if ((++_sp & 255u) == 0u) { if (xb_ld(&(bar)[XB_TMO])) break; if (_sp > XB_SPIN_CAP) { atomicAdd(&(bar)[XB_TMO], 1u); break; } } } } while (0)

struct XcdBarrier {
    unsigned* bar; unsigned x;
    volatile LAS unsigned* st;
};

__device__ __forceinline__ XcdBarrier xcd_barrier_post(unsigned* bar, volatile LAS unsigned* st) {
    XcdBarrier b; b.bar = bar; b.x = xb_xcc_id(); b.st = st;
    if (threadIdx.x == 0) (void)xb_add(&bar[XB_XCNT(b.x)], 1u);
    return b;
}
__device__ __forceinline__ void xcd_barrier_complete(unsigned* bar, unsigned x, unsigned& nloc, unsigned& nx) {
    const unsigned G = gridDim.x * gridDim.y * gridDim.z;
    unsigned sum, cnt, mine, sp = 0u;
    for (;;) {
        sum = 0u; cnt = 0u; mine = 0u;
#pragma unroll
        for (unsigned j = 0; j < 16; ++j) { const unsigned c = xb_ld(&bar[XB_XCNT(j)]); sum += c; cnt += (c > 0u) ? 1u : 0u; mine = (j == x) ? c : mine; }
        if (sum == G) break;
        __builtin_amdgcn_s_sleep(1);
        if ((++sp & 255u) == 0u) { if (xb_ld(&bar[XB_TMO])) break; if (sp > XB_SPIN_CAP) { atomicAdd(&bar[XB_TMO], 1u); break; } }
    }
    nloc = mine > 0u ? mine : 1u; nx = cnt > 0u ? cnt : 1u;
}

__device__ __forceinline__ void xcd_barrier(const XcdBarrier& b) {
    asm volatile("s_waitcnt vmcnt(0)" ::: "memory");
    __syncthreads();
    if (threadIdx.x == 0) {
        unsigned* bar = b.bar;
        __builtin_amdgcn_s_waitcnt(0);
        unsigned nloc = b.st[0], nx = b.st[1];
        if (nloc == 0u) { xcd_barrier_complete(bar, b.x, nloc, nx); b.st[0] = nloc; b.st[1] = nx; }
        const unsigned old = xb_add(&bar[XB_XSUB(b.x)], 1u);
        const unsigned gen = old / nloc;
        if (old + 1u == (gen + 1u) * nloc) {
            __builtin_amdgcn_fence(__ATOMIC_RELEASE, "agent");
            asm volatile("s_waitcnt vmcnt(0)" ::: "memory");
            asm volatile("buffer_inv sc1" ::: "memory");
            const unsigned og = xb_add(&bar[XB_TOP], 1u);
            const unsigned tg = og / nx;
            if (og + 1u == (tg + 1u) * nx) {
                xb_add(&bar[XB_TOPGEN], 1u);
#pragma unroll
                for (unsigned j = 0; j < 16; ++j) xb_add(&bar[XB_XGEN(j)], 1u); }
            else XB_SPIN(xb_ld(&bar[XB_TOPGEN]) == tg, bar);
            asm volatile("" ::: "memory");
            asm volatile("s_waitcnt vmcnt(0)" ::: "memory");
        } else {
            asm volatile("buffer_inv sc1" ::: "memory");
            XB_SPIN(xb_ld(&bar[XB_XGEN(b.x)]) == gen, bar);
            asm volatile("" ::: "memory");
            asm volatile("s_waitcnt vmcnt(0)" ::: "memory");
        }
    }
    __syncthreads();
}
struct Args { const float* in[26]; float* out; unsigned char* ws; int ph_lo, ph_hi; };

__device__ __forceinline__ unsigned f2bf(float f) { unsigned u = __builtin_bit_cast(unsigned, f); return (u + 0x7fffu + ((u >> 16) & 1u)) >> 16; }
__device__ __forceinline__ unsigned pk2(float lo, float hi) { return f2bf(lo) | (f2bf(hi) << 16); }
__device__ __forceinline__ float b2f(unsigned short b) { return __uint_as_float((unsigned)b << 16); }
__device__ __forceinline__ float wave_sum(float v) {
#pragma unroll
    for (int o = 1; o < 64; o <<= 1) v += __shfl_xor(v, o);
    return v;
}
#define LDS_WAIT() asm volatile("s_waitcnt lgkmcnt(0)" ::: "memory")
__device__ __forceinline__ void conv_item(const float* W, int spitch, int k0, int n0, bf16* WT, int dpitch, int drow0, const float* gain, LAS float* scr, int lane) {
#pragma unroll
    for (int i = 0; i < 32; ++i) { const int kk = 2 * i + (lane >> 5); float v = W[(size_t)(k0 + kk) * spitch + n0 + (lane & 31)]; if (gain) v *= gain[k0 + kk]; scr[kk * 33 + (lane & 31)] = v; }
    LDS_WAIT(); asm volatile("" ::: "memory");
    const int c = lane & 7;
#pragma unroll
    for (int j = 0; j < 4; ++j) { const int n = (lane >> 3) + 8 * j; const LAS float* s = scr + (8 * c) * 33 + n;
        v4u o; o.x = pk2(s[0 * 33], s[1 * 33]); o.y = pk2(s[2 * 33], s[3 * 33]); o.z = pk2(s[4 * 33], s[5 * 33]); o.w = pk2(s[6 * 33], s[7 * 33]);
        *(v4u*)(WT + (size_t)(drow0 + n) * dpitch + k0 + 8 * c) = o; }
    LDS_WAIT(); asm volatile("" ::: "memory");
}
__device__ __forceinline__ void conv_job(int& it, int& base, int NGW, const float* W, int spitch, int K, int scol0, int ncols, bf16* WT, int doff, bool ilv, const float* gain, LAS float* scr, int lane) {
    const int nblk = ncols / 32, nitems = (K / 64) * nblk;
    for (; it < base + nitems; it += NGW) { const int r = it - base, kb = r / nblk, nb = r % nblk, nl = 32 * nb;
        const int drow0 = ilv ? (256 * (nl / 128) + (nl % 128) + doff) : (doff + nl);
        conv_item(W, spitch, 64 * kb, scol0 + nl, WT, K, drow0, gain, scr, lane); }
    base += nitems;
}

__device__ __forceinline__ void panel_rstd(const float* SSp, int pm, LAS float* rsl, int tid) {
    if (tid < 256) { const f32x4* p4 = (const f32x4*)(SSp + (size_t)(pm * 256 + tid) * 16); const f32x4 a = p4[0], b = p4[1], c = p4[2], d = p4[3];
        const float s = ((a[0] + a[1]) + (a[2] + a[3])) + ((b[0] + b[1]) + (b[2] + b[3])) + ((c[0] + c[1]) + (c[2] + c[3])) + ((d[0] + d[1]) + (d[2] + d[3]));
        rsl[tid] = rsqrtf(s * (1.0f / 1024.0f) + 1e-6f); }
    __syncthreads();
}
__device__ __forceinline__ int attn_skip_tiles(const float* csh, int qb, float R) {
    const int lim = 4 * (qb + 1) - 4; const float thr = csh[256 * qb] + 152.0f + 2.0f * R;
    int seg = 0, cnt = 0;
#pragma unroll
    for (int j = 0; j < 16; ++j) { const int tl = 16 * j + 15; const float cv = csh[64 * (tl < lim ? tl : 0) + 63]; seg += (tl < lim && cv > thr) ? 1 : 0; }
#pragma unroll
    for (int i = 0; i < 16; ++i) { const int tl = 16 * seg + i; const float cv = csh[64 * (tl < lim ? tl : 0) + 63]; cnt += (tl < lim && cv > thr) ? 1 : 0; }
    return (16 * seg + cnt) & ~1;
}
__device__ __forceinline__ int attn_chunks(int len) { int n = (len + 63) >> 6; if (n > 1 && len - 64 * (n - 1) < 4) --n; return n; }
__global__ void __launch_bounds__(NTHREADS, 2) mk_fwd(Args args) {
    __builtin_assume(__builtin_amdgcn_workitem_id_y() == 0); __builtin_assume(__builtin_amdgcn_workitem_id_z() == 0);
    extern __shared__ __attribute__((aligned(16))) unsigned char lds[];
    cg::grid_group grid = cg::this_grid();
    LAS unsigned char* ldsp = (LAS unsigned char*)lds;
    if (threadIdx.x < 2) ((volatile LAS unsigned*)(ldsp + XB_LDS_OFF))[threadIdx.x] = 0u;
    __syncthreads();
    const XcdBarrier xbar = xcd_barrier_post((unsigned*)args.ws, (volatile LAS unsigned*)(ldsp + XB_LDS_OFF));
    const int G = gridDim.x, bx = blockIdx.x;
    const int vcu = (G % 8 == 0) ? (bx % 8) * (G / 8) + bx / 8 : bx;
    const int NGW = G * NWAVES;
#define TIDS() int tid_o = threadIdx.x; asm volatile("" : "+v"(tid_o)); const int tid = tid_o, lane = tid & 63, wave = __builtin_amdgcn_readfirstlane(tid >> 6), gw = vcu * NWAVES + wave; (void)gw; (void)lane; (void)tid
#ifdef MK_TIME_A
    unsigned char* const tsbase = args.ws + 49152;
#endif
#define KARGS() const __attribute__((address_space(4))) Args* ap_ = (const __attribute__((address_space(4))) Args*)__builtin_amdgcn_kernarg_segment_ptr(); asm volatile("" : "+s"(ap_))
#define ws (ap_->ws)
#define X (ap_->out)
#define SS ((float*)(ws + WS_SS))
#define SSV ((float*)(ws + WS_SSV))
#define LF ((float*)(ws + WS_LF))
#define CS ((float*)(ws + WS_CS))
#define RSM ((float*)(ws + WS_RSM))
#define MEMB ((bf16*)(ws + WS_MEMB))
#define KC ((bf16*)(ws + WS_KC))
#define VCT ((bf16*)(ws + WS_VCT))
#define Wt ((bf16*)(ws + WS_W))
#define XB ((bf16*)(ws + WS_XB))
#define SCR ((bf16*)(ws + WS_SCR))
#define WL ((bf16*)(ws + WS_WL))
#define VT2 ((bf16*)(ws + WS_VT2))
#define ACT SCR
#define PROJ SCR
#define GT (SCR + 3 * PIECE)
#define XQ SCR
#define PB (SCR + (size_t)M * 1024)
#define OB (SCR + (size_t)2 * M * 1024)
    const int lo = args.ph_lo, hi = args.ph_hi;
    if (lo < 0) grid.sync();
#ifndef PHMASK
#define PHMASK 0xffff
#endif
#define IN(k) (((PHMASK >> (((k) == 30) ? 15 : ((k) - pb == 13 || (k) - pb == 14) ? (k) - pb - 12 : (k) - pb)) & 1) && lo <= (k) && (k) < hi)
#define GRID_SYNC() do { asm volatile("s_waitcnt vmcnt(0) lgkmcnt(0)" ::: "memory"); grid.sync(); } while (0)
#define WG_SEAM() do { asm volatile("s_waitcnt vmcnt(0) lgkmcnt(0)" ::: "memory"); __syncthreads(); } while (0)
#define SEAM_LOCAL(k) do { if (lo <= (k) && (k) + 1 < hi) { if (G == 256) WG_SEAM(); else xcd_barrier(xbar); } } while (0)
#ifdef MK_TIME_A
#define STAMP(k) do { if (blockIdx.x == 0 && threadIdx.x == 0) __hip_atomic_store((unsigned long long*)tsbase + (k) + 1, (unsigned long long)__builtin_amdgcn_s_memrealtime(), __ATOMIC_RELAXED, __HIP_MEMORY_SCOPE_AGENT); } while (0)
#else
#define STAMP(k) do { } while (0)
#endif
#define SEAM(k) do { if (lo <= (k) && (k) + 1 < hi) { xcd_barrier(xbar); STAMP(k); } } while (0)
#define in (ap_->in)
#define CONV_TILE(it) \
            do { \
                int r = it; const float* W; const float* gain = nullptr; bf16* WT; int spitch, K, scol0 = 0, nblk, doff = 0; bool ilv = false, notr = false; \
                if (r < 2 * I_UP) { const int w = r / I_UP; r -= w * I_UP; W = in[3 + w] + lff; gain = in[2] + l1; WT = Wt + WO_GU1; spitch = FF; K = 1024; nblk = 11; doff = 128 * w; ilv = true; } \
                else if ((r -= 2 * I_UP) < 2 * I_SQ) { const int w = r / I_SQ; r -= w * I_SQ; W = in[18 + w] + ldd; gain = in[16] + l1; WT = Wt + WO_K + (size_t)w * 1024 * 1024; spitch = 1024; K = 1024; nblk = 4; } \
                else if ((r -= 2 * I_SQ) < I_DN) { W = in[5] + lff; WT = Wt + WO_D1; spitch = 1024; K = FF; nblk = 4; } \
                else if ((r -= I_DN) < I_IN) { W = in[7] + (size_t)l * 1024 * DIN; gain = in[6] + l1; WT = Wt + WO_IN; spitch = DIN; K = 1024; nblk = 16; } \
                else if ((r -= I_IN) < I_G) { W = in[7] + (size_t)l * 1024 * DIN; gain = in[6] + l1; WT = Wt + WO_G; spitch = DIN; K = 1024; nblk = 12; scol0 = 4104; } \
                else if ((r -= I_G) < 3 * I_B) { const int w = r / I_B; r -= w * I_B; W = in[13] + ((size_t)l * 3 + w) * 512 * 1024; WT = Wt + WO_B + (size_t)w * 1024 * 512; spitch = 1024; K = 512; nblk = 4; } \
                else if ((r -= 3 * I_B) < I_SQ) { W = in[14] + ldd; WT = Wt + WO_O; spitch = 1024; K = 1024; nblk = 4; } \
                else if ((r -= I_SQ) < I_SQ) { W = in[17] + ldd; gain = in[15] + l1; WT = Wt + WO_Q; spitch = 1024; K = 1024; nblk = 4; notr = true; } \
                else if ((r -= I_SQ) < I_SQ) { W = in[20] + ldd; WT = Wt + WO_XO; spitch = 1024; K = 1024; nblk = 4; } \
                else if ((r -= I_SQ) < 2 * I_UP) { const int w = r / I_UP; r -= w * I_UP; W = in[22 + w] + lff; gain = in[21] + l1; WT = Wt + WO_GU2; spitch = FF; K = 1024; nblk = 11; doff = 128 * w; ilv = true; } \
                else { r -= 2 * I_UP; W = in[24] + lff; WT = Wt + WO_D2; spitch = 1024; K = FF; nblk = 4; } \
                const int k0 = 64 * (r / nblk), nl0 = 256 * (r % nblk); \
                if (notr) { \
_Pragma("unroll") \
                    for (int i = 0; i < 8; ++i) { const int kr = k0 + 8 * wave + i; const f32x4 v = __builtin_nontemporal_load((const f32x4*)(W + (size_t)kr * spitch + nl0 + 4 * lane)) * gain[kr]; \
                        v2u o; o.x = pk2(v[0], v[1]); o.y = pk2(v[2], v[3]); *(v2u*)(WT + (size_t)kr * 1024 + nl0 + 4 * lane) = o; } \
                    continue; \
                } \
                { \
                    f32x4 v[8]; \
_Pragma("unroll") \
                    for (int i = 0; i < 8; ++i) v[i] = __builtin_nontemporal_load((const f32x4*)(W + (size_t)(k0 + 8 * wave + i) * spitch + scol0 + nl0 + 4 * lane)); \
_Pragma("unroll") \
                    for (int i = 0; i < 8; ++i) { const float gk = gain ? gain[k0 + 8 * wave + i] : 1.0f; *(LAS f32x4*)(Tl + (8 * wave + i) * 260 + 4 * lane) = v[i] * gk; } \
                } \
                __syncthreads(); \
                { \
                    const int n = tid & 255, kh = tid >> 8, nl = nl0 + n; \
                    const int drow = ilv ? (256 * (nl / 128) + (nl % 128) + doff) : (doff + nl); \
                    v4u o[4]; \
_Pragma("unroll") \
                    for (int q = 0; q < 4; ++q) \
_Pragma("unroll") \
                        for (int e = 0; e < 4; ++e) o[q][e] = pk2(Tl[(32 * kh + 8 * q + 2 * e) * 260 + n], Tl[(32 * kh + 8 * q + 2 * e + 1) * 260 + n]); \
_Pragma("unroll") \
                    for (int q = 0; q < 4; ++q) *(v4u*)(WT + (size_t)drow * K + k0 + 32 * kh + 8 * q) = o[q]; \
                } \
                __syncthreads(); \
            } while (0)
STAMP(-1);
int pb = 0;
#pragma nounroll
    for (int l = 0; l < NLAYER; ++l) {
        pb = 15 * l;
        if (IN(pb + 0)) { KARGS(); TIDS();
#ifndef MK_REP_P0
#define MK_REP_P0 1
#endif
_Pragma("nounroll")
          for (int rep0 = 0; rep0 < MK_REP_P0; ++rep0) {
            const size_t l1 = (size_t)l * 1024, lff = (size_t)l * 1024 * 2816, ldd = (size_t)l * 1024 * 1024;
            constexpr int I_UP = 16 * 11, I_DN = 44 * 4, I_IN = 16 * 16, I_G = 16 * 12, I_B = 8 * 4, I_SQ = 16 * 4;
            constexpr int NIT = 4 * I_UP + 2 * I_DN + I_IN + I_G + 3 * I_B + 5 * I_SQ, NE0 = 480;
            const int NE = (G == 256) ? 960 : 0;
            LAS float* Tl = (LAS float*)ldsp;
#pragma nounroll
            for (int jt = vcu; jt < NIT - NE; jt += G) { const int it = jt < NE0 ? jt : jt + NE; CONV_TILE(it); }
            {
                const float* wf = in[7] + (size_t)l * 1024 * DIN + 4096; const float* gn = in[6] + l1; bf16* WF = Wt + WO_END;
                for (int idx = vcu * NTHREADS + tid; idx < 8192; idx += G * NTHREADS) { const int k = idx >> 3, hd = idx & 7;
                    const float v = wf[(size_t)k * DIN + hd] * gn[k]; const unsigned hb = f2bf(v); const float lo = v - __uint_as_float(hb << 16);
                    WF[(size_t)hd * 1024 + k] = (bf16)hb; WF[(size_t)(8 + hd) * 1024 + k] = (bf16)f2bf(lo); }
            }
            if (l == 0) {
                for (int m0 = gw; m0 < M + MEML; m0 += 4 * NGW) {
                    f32x4 v[4][4];
#pragma unroll
                    for (int i = 0; i < 4; ++i) { const int m = (m0 + i * NGW < M + MEML) ? m0 + i * NGW : m0; const bool ism = m >= M; const int r = ism ? m - M : m;
                        const f32x4* xr = (const f32x4*)((ism ? in[1] : in[0]) + (size_t)r * D) + lane;
#pragma unroll
                        for (int j = 0; j < 4; ++j) v[i][j] = __builtin_nontemporal_load(xr + 64 * j); }
                    asm volatile("" ::: "memory");
#pragma unroll
                    for (int i = 0; i < 4; ++i) { const int m = m0 + i * NGW; if (m >= M + MEML) break; const bool ism = m >= M; const int r = ism ? m - M : m;
                        float s = 0.f;
#pragma unroll
                        for (int j = 0; j < 4; ++j) s += (v[i][j][0] * v[i][j][0] + v[i][j][1] * v[i][j][1]) + (v[i][j][2] * v[i][j][2] + v[i][j][3] * v[i][j][3]);
                        s = wave_sum(s);
                        v2u* ob = (v2u*)((ism ? MEMB : XB) + (size_t)r * D) + lane;
#pragma unroll
                        for (int j = 0; j < 4; ++j) { v2u w; w.x = pk2(v[i][j][0], v[i][j][1]); w.y = pk2(v[i][j][2], v[i][j][3]); ob[64 * j] = w; }
                        if (!ism) {
                            if (lane < 16) SS[(size_t)r * 16 + lane] = lane == 0 ? s : 0.f;
                        } else if (lane == 0) RSM[r] = rsqrtf(s * (1.0f / D) + EPS);
                    }
                }
            }
          }
        }
        SEAM(pb + 0);
#pragma nounroll
        for (int f = 0; f < 2; ++f) {
            const int pu = pb + (f == 0 ? 1 : 13), pd = pu + 1;
            if (IN(pu)) { KARGS();
                { pg8::Gemm g{XB, Wt + (f == 0 ? WO_GU1 : WO_GU2), 1024, 1024, 1024, 0, 0}; pg8::StaticOrder S; S.init(M / 256, 22, G, bx);
                  LAS float* rsl = nullptr; if (G == 256) { TIDS(); pg8::Unit u0; S.map(bx, u0); rsl = (LAS float*)(ldsp + RS_LDS_OFF); panel_rstd(SS, u0.pm, rsl, tid); }
                  pg8::EpiSwiGLU E{SS, rsl, ACT};
#ifndef MK_REP_UP
#define MK_REP_UP 1
#endif
_Pragma("nounroll")
                  for (int rep = 0; rep < MK_REP_UP; ++rep) pg8::gemm_phase<pg8::EpiSwiGLU, pg8::StaticOrder, true, true>(ldsp, g, S, E); }
                if (f == 0 && G == 256 && bx >= 136) {
                    TIDS(); const size_t l1 = (size_t)l * 1024, lff = (size_t)l * 1024 * 2816, ldd = (size_t)l * 1024 * 1024;
                    constexpr int I_UP = 16 * 11, I_DN = 44 * 4, I_IN = 16 * 16, I_G = 16 * 12, I_B = 8 * 4, I_SQ = 16 * 4;
                    LAS float* Tl = (LAS float*)ldsp;
#pragma nounroll
                    for (int jj = 0; jj < 8; ++jj) { const int it = 480 + (bx - 136) + 120 * jj; CONV_TILE(it); }
                }
                if (f == 0) {
                    { pg8::Gemm g{MEMB, Wt + WO_K, 1024, 1024, 1024, 0, 0}; pg8::StaticOrder S; S.init(1, 4, G, (bx + G - 128 % G) % G);
                      pg8::EpiScale<2> E{RSM, KC, 1024, 1.0f}; pg8::gemm_phase<pg8::EpiScale<2>, pg8::StaticOrder, true, true>(ldsp, g, S, E); }
                    { pg8::Gemm g{MEMB, Wt + WO_V, 1024, 1024, 1024, 0, 0}; pg8::StaticOrder S; S.init(1, 4, G, (bx + G - 132 % G) % G);
                      pg8::EpiScale<2> E{RSM, VCT, 1024, 1.0f}; pg8::gemm_phase<pg8::EpiScale<2>, pg8::StaticOrder, true, true>(ldsp, g, S, E); }
                }
            }
            SEAM(pu);
            if (IN(pd)) { KARGS();
                pg8::Gemm g{ACT, Wt + (f == 0 ? WO_D1 : WO_D2), FF, FF, FF, 0, 0}; pg8::StaticOrder S; S.init(M / 256, 4, G, bx);
                pg8::EpiResid E{XB, SS, 0.5f}; pg8::gemm_phase<pg8::EpiResid, pg8::StaticOrder, true, true>(ldsp, g, S, E);
            }
            SEAM(pd);
            if (f == 1) break;
            if (IN(pb + 3)) { KARGS();
                { TIDS();
                    const float* bfp = in[12] + l * 8; const bf16* WF = Wt + WO_END; const int fr = lane & 15, fq = lane >> 4;
                    if ((wave & 1) == 0) for (int tile = vcu * 4 + (wave >> 1); tile < M / 16; tile += G * 4) {
                        const int row = 16 * tile + fr;
                        const bf16* ap = XB + (size_t)row * D + 8 * fq; const bf16* bp = WF + (size_t)fr * D + 8 * fq;
                        f32x4 acc = {0.f, 0.f, 0.f, 0.f};
#pragma unroll 16
                        for (int ks = 0; ks < 32; ++ks) { const bf16x8 a = *(const bf16x8*)(ap + 32 * ks), b = *(const bf16x8*)(bp + 32 * ks); acc = __builtin_amdgcn_mfma_f32_16x16x32_bf16(b, a, acc, 0, 0, 0); }
                        const float rs = pg8::row_rstd1(SS, row, fq);
#pragma unroll
                        for (int j = 0; j < 4; ++j) { const float t = acc[j] + __shfl_xor(acc[j], 32);
                            if (fq < 2) { const int hd = 4 * fq + j; const float z = t * rs + bfp[hd]; LF[(size_t)hd * M + row] = fminf(z, 0.f) - log1pf(expf(-fabsf(z))); } }
                    }
                }
                pg8::Gemm g{XB, Wt + WO_IN, 1024, 1024, 1024, 0, 0}; pg8::StaticOrder S; S.init(M / 256, 16, G, bx);
                LAS float* rsl = nullptr; if (G == 256) { int t_ = threadIdx.x; asm volatile("" : "+v"(t_)); pg8::Unit u0; S.map(bx, u0); rsl = (LAS float*)(ldsp + RS_LDS_OFF); panel_rstd(SS, u0.pm, rsl, t_); }
                pg8::EpiWin E{SS, rsl, PROJ, SSV, 0.125f * LOG2E}; pg8::gemm_phase<pg8::EpiWin, pg8::StaticOrder, true, true>(ldsp, g, S, E);
            }
            SEAM(pb + 3);
            if (IN(pb + 4)) { KARGS(); TIDS();
                if (bx < 8) {
                    const float* lf = LF + (size_t)bx * M + tid * 32; float* cs = CS + (size_t)bx * M + tid * 32;
                    f32x4 v[8]; float run = 0.f;
#pragma unroll
                    for (int i = 0; i < 8; ++i) { v[i] = *(const f32x4*)(lf + 4 * i);
#pragma unroll
                        for (int e = 0; e < 4; ++e) { run += v[i][e]; v[i][e] = run; } }
                    const double tot = (double)run; double incl = tot;
#pragma unroll
                    for (int o = 1; o < 64; o <<= 1) { const double t = __shfl_up(incl, o); if (lane >= o) incl += t; }
                    LAS double* wsum = (LAS double*)ldsp;
                    if (lane == 63) wsum[wave] = incl;
                    __syncthreads();
                    double bsum = 0.0;
                    for (int w = 0; w < wave; ++w) bsum += wsum[w];
                    const double excl = bsum + incl - tot;
#pragma unroll
                    for (int i = 0; i < 8; ++i) { f32x4 o;
#pragma unroll
                        for (int e = 0; e < 4; ++e) o[e] = (float)((excl + (double)v[i][e]) * 1.4426950408889634);
                        *(f32x4*)(cs + 4 * i) = o; }
                    __syncthreads();
                }
                {
                    unsigned* KM = (unsigned*)(ws + 32768) + 8 * l; unsigned* lmx = (unsigned*)(lds + XB_LDS_OFF + 128);
                    if (tid < 16) lmx[tid] = 0u;
                    __syncthreads();
                    {
                        float mk = 0.f, mq = 0.f;
#pragma unroll 8
                        for (int r2 = gw; r2 < 2 * M; r2 += NGW) { const int isq = r2 >= M, row = r2 - isq * M;
                            const v4u w = *((const v4u*)(PROJ + (isq ? 8 : 6) * PIECE + (size_t)row * 512) + lane); float s = 0.f;
#pragma unroll
                            for (int e = 0; e < 4; ++e) { const float a = pg8::bflo(w[e]), b = pg8::bfhi(w[e]); s += a * a + b * b; }
                            s += __shfl_xor(s, 1); s += __shfl_xor(s, 2); s += __shfl_xor(s, 4);
                            if (isq) mq = fmaxf(mq, s); else mk = fmaxf(mk, s); }
                        if ((lane & 7) == 0) { atomicMax(lmx + (lane >> 3), __float_as_uint(mk)); atomicMax(lmx + 8 + (lane >> 3), __float_as_uint(mq)); }
                    }
                    __syncthreads();
                    if (tid < 16) atomicMax(KM + 64 * (tid >> 3) + (tid & 7), lmx[tid]);
                }
                {
                    bf16* AB = PROJ; const bf16* AC = PROJ + 3 * PIECE; const bf16* AH = PROJ + 4 * PIECE; const float* cw = in[8] + (size_t)l * 3 * 512;
                    const int c8 = (tid & 63) * 8;
#pragma nounroll
                    for (int t0 = vcu * 8 + (tid >> 6); t0 < M; t0 += 2 * G * 8) {
                        v4u bw[2], cv[2][3], hv[2][3];
#pragma unroll
                        for (int h2 = 0; h2 < 2; ++h2) { const int t = (t0 + h2 * G * 8 < M) ? t0 + h2 * G * 8 : t0; const size_t off = (size_t)t * 512 + c8;
                            bw[h2] = *(const v4u*)(AB + off);
#pragma unroll
                            for (int d = 0; d < 3; ++d) { const size_t od = (t - d >= 0) ? off - (size_t)d * 512 : off;
                                cv[h2][d] = *(const v4u*)(AC + od); hv[h2][d] = *(const v4u*)(AH + od); if (t - d < 0) cv[h2][d] = (v4u){0u, 0u, 0u, 0u}; } }
                        asm volatile("" ::: "memory");
#pragma unroll
                        for (int h2 = 0; h2 < 2; ++h2) { const int t = t0 + h2 * G * 8; if (t >= M) continue; const size_t off = (size_t)t * 512 + c8;
                            float y[8];
#pragma unroll
                            for (int e = 0; e < 8; ++e) { const int w = e >> 1; const bool hi_ = e & 1;
                                const float b = hi_ ? pg8::bfhi(bw[h2][w]) : pg8::bflo(bw[h2][w]);
                                float z[3];
#pragma unroll
                                for (int d = 0; d < 3; ++d) z[d] = hi_ ? pg8::bfhi(cv[h2][d][w]) * pg8::bfhi(hv[h2][d][w]) : pg8::bflo(cv[h2][d][w]) * pg8::bflo(hv[h2][d][w]);
                                y[e] = b * (cw[c8 + e] * z[2] + cw[512 + c8 + e] * z[1] + cw[1024 + c8 + e] * z[0]); }
                            v4u o; o.x = pk2(y[0], y[1]); o.y = pk2(y[2], y[3]); o.z = pk2(y[4], y[5]); o.w = pk2(y[6], y[7]);
                            *(v4u*)(AB + off) = o; }
                    }
                }
                {
                    bf16* UU = PROJ + 1 * PIECE; const bf16* VV = PROJ + 5 * PIECE; const float* sgn = in[9] + (size_t)l * 512; const float* sgw = in[10] + (size_t)l * 4 * 128 * 128; const float* sgb = in[11] + (size_t)l * 4 * 128;
                    LAS bf16* T = (LAS bf16*)ldsp;
                    const int fr = lane & 15, fq = lane >> 4;
                    for (int unit = vcu; unit < 512; unit += G) {
                        const int n = unit >> 2, gI = unit & 3;
                        const int t = 16 * wave + fr;
                        f32x4 wpre[4][2];
#pragma unroll
                        for (int kk = 0; kk < 4; ++kk) { const float* wp = sgw + ((size_t)gI * 128 + t) * 128 + 32 * kk + 8 * fq; wpre[kk][0] = *(const f32x4*)wp; wpre[kk][1] = *(const f32x4*)(wp + 4); }
                        { const int s = tid >> 2, cg0 = (tid & 3) * 32, row = 128 * n + s;
                          const f32x4 p0 = *(const f32x4*)(SSV + (size_t)row * 8), p1 = *(const f32x4*)(SSV + (size_t)row * 8 + 4);
                          const float rv = rsqrtf(((p0[0] + p0[1]) + (p0[2] + p0[3]) + (p1[0] + p1[1]) + (p1[2] + p1[3])) * (1.0f / 512.0f) + EPS);
#pragma unroll
                          for (int q = 0; q < 4; ++q) { const int c = cg0 + 8 * q; const v4u vw = *(const v4u*)(VV + (size_t)row * 512 + 128 * gI + c);
                              const f32x4 ga = *(const f32x4*)(sgn + 128 * gI + c), gb = *(const f32x4*)(sgn + 128 * gI + c + 4);
#pragma unroll
                              for (int e = 0; e < 4; ++e) { const float g0 = e < 2 ? ga[2 * e] : gb[2 * e - 4], g1 = e < 2 ? ga[2 * e + 1] : gb[2 * e - 3];
                                  T[(c + 2 * e) * 136 + s] = (bf16)f2bf(pg8::bflo(vw[e]) * rv * g0); T[(c + 2 * e + 1) * 136 + s] = (bf16)f2bf(pg8::bfhi(vw[e]) * rv * g1); } } }
                        __syncthreads();
                        f32x4 acc[8];
#pragma unroll
                        for (int j = 0; j < 8; ++j) acc[j] = (f32x4){0.f, 0.f, 0.f, 0.f};
#pragma unroll
                        for (int kk = 0; kk < 4; ++kk) { if (kk > (wave >> 1)) break;
                            const int s0 = 32 * kk + 8 * fq;
                            const f32x4 w0 = wpre[kk][0], w1 = wpre[kk][1];
                            float wv[8] = {w0[0], w0[1], w0[2], w0[3], w1[0], w1[1], w1[2], w1[3]};
#pragma unroll
                            for (int e = 0; e < 8; ++e) if (s0 + e > t) wv[e] = 0.f;
                            v4u aw; aw.x = pk2(wv[0], wv[1]); aw.y = pk2(wv[2], wv[3]); aw.z = pk2(wv[4], wv[5]); aw.w = pk2(wv[6], wv[7]);
                            const bf16x8 afr = __builtin_bit_cast(bf16x8, aw);
#pragma unroll
                            for (int j = 0; j < 8; ++j) { const bf16x8 bfr = *(const LAS bf16x8*)(T + (16 * j + fr) * 136 + s0); acc[j] = __builtin_amdgcn_mfma_f32_16x16x32_bf16(bfr, afr, acc[j], 0, 0, 0); }
                        }
                        const float bias = sgb[gI * 128 + t]; const size_t rowoff = (size_t)(128 * n + t) * 512 + 128 * gI;
                        v2u uw8[8];
#pragma unroll
                        for (int j = 0; j < 8; ++j) uw8[j] = *(const v2u*)(UU + rowoff + 16 * j + 4 * fq);
                        asm volatile("" ::: "memory");
#pragma unroll
                        for (int j = 0; j < 8; ++j) { const int c = 16 * j + 4 * fq; const v2u uw = uw8[j];
                            v2u o; o.x = pk2(pg8::bflo(uw.x) * (acc[j][0] + bias), pg8::bfhi(uw.x) * (acc[j][1] + bias)); o.y = pk2(pg8::bflo(uw.y) * (acc[j][2] + bias), pg8::bfhi(uw.y) * (acc[j][3] + bias));
                            *(v2u*)(UU + rowoff + c) = o; }
                        __syncthreads();
                    }
                }
            }
            SEAM(pb + 4);
            if (IN(pb + 5)) { KARGS();
                TIDS();
                const attn_body::AttnTensors AT{(const attn_body::bf16*)(PROJ + 8 * PIECE), (const attn_body::bf16*)(PROJ + 6 * PIECE), (const attn_body::bf16*)(PROJ + 7 * PIECE), (attn_body::bf16*)(PROJ + 2 * PIECE), CS, (const unsigned*)(ws + 32768) + 8 * l};
                unsigned* qctr = (unsigned*)(ws + 40960) + 64 * l;
                volatile LAS unsigned* qw = (volatile LAS unsigned*)(ldsp + XB_LDS_OFF + 64);
                volatile LAS unsigned* T0 = (volatile LAS unsigned*)(ldsp + T0_LDS_OFF);
                {   const int hd = tid & 7, qb = 63 - (tid >> 3);
                    const float km2 = __uint_as_float(__hip_atomic_load(AT.KM + hd, __ATOMIC_RELAXED, __HIP_MEMORY_SCOPE_AGENT)), qm2 = __uint_as_float(__hip_atomic_load(AT.KM + 64 + hd, __ATOMIC_RELAXED, __HIP_MEMORY_SCOPE_AGENT));
                    T0[tid] = (unsigned)attn_skip_tiles(CS + (size_t)hd * M, qb, sqrtf(km2 * qm2) * 1.001f + 0.01f); }
                if (bx == 0) ((unsigned*)(ws + 45056))[tid] = T0[tid];
                __syncthreads();
#pragma nounroll
                for (;;) {
                    if (tid == 0) qw[0] = __hip_atomic_fetch_add(qctr, 1u, __ATOMIC_RELAXED, __HIP_MEMORY_SCOPE_AGENT);
                    __syncthreads();
                    const unsigned idx = qw[0];
                    __syncthreads();
                    if (idx >= 2048u + 32u) break;
                    if (idx < 32u) {
                        pg8::OneUnit S1;
                        if (idx < 16u) { S1.u0.pm = 0; S1.u0.pn = (int)(idx & 3u); S1.u0.z = (int)(idx >> 2); pg8::Gemm g1{KC, Wt + WO_Q, 256, 1024, 1024, 512, 512}; pg8::EpiScaleZ E1{WL, 1024, 0.0625f * LOG2E}; pg8::gemm_phase<pg8::EpiScaleZ, pg8::OneUnit, true, true>(ldsp, g1, S1, E1); }
                        else { S1.u0.pm = (int)((idx - 16u) >> 2); S1.u0.pn = 0; S1.u0.z = (int)(idx & 3u); pg8::Gemm g1{Wt + WO_XO, VCT, 256, 1024, 1024, 512, 512}; pg8::EpiScale<0> E1{nullptr, VT2, 1024, 1.0f}; pg8::gemm_phase<pg8::EpiScale<0>, pg8::OneUnit, true, true>(ldsp, g1, S1, E1); }
                        __syncthreads();
                        continue;
                    }
                    const unsigned ia = idx - 32u;
                    const int c = (int)(ia >> 9), un = (int)(ia & 511u), qb = 63 - (un >> 3), hd = un & 7, ntf = 4 * (qb + 1);
                    const int t0 = (int)T0[un], len = ntf - t0, n = attn_chunks(len);
                    if (c >= n) continue;
                    const bool last = (c == n - 1); const int tb = t0 + 64 * c, ntl = last ? ntf - tb : 64;
                    attn_body::bf16* Oc = (attn_body::bf16*)(PROJ + (last ? 2 : 3 + c) * PIECE);
                    float* Lc = last ? (float*)(ws + WS_LPL) : (float*)(ws + WS_LP) + (size_t)c * M * 8;
                    attn_body::attn_unit<8>(0, hd, qb, AT.Q, AT.K, AT.V, Oc, CS, AT.KM, (char*)lds, tb, ntl, last, Lc);
                    if (n > 1) {
                        asm volatile("s_waitcnt vmcnt(0)" ::: "memory"); __syncthreads();
                        if (tid == 0) { __builtin_amdgcn_fence(__ATOMIC_RELEASE, "agent"); asm volatile("s_waitcnt vmcnt(0)" ::: "memory");
                            const unsigned old_ = __hip_atomic_fetch_add((unsigned*)(ws + 49152) + 512 * l + un, 1u, __ATOMIC_RELAXED, __HIP_MEMORY_SCOPE_AGENT);
                            if (old_ == (unsigned)(n - 1)) { __builtin_amdgcn_fence(__ATOMIC_ACQUIRE, "agent"); asm volatile("s_waitcnt vmcnt(0)" ::: "memory"); }
                            qw[4] = old_; }
                        __syncthreads();
                        if (qw[4] == (unsigned)(n - 1)) {
                            for (int it = tid; it < 2048; it += NTHREADS) { const int row = 256 * qb + (it >> 3); const size_t off = (size_t)row * 512 + hd * 64 + (it & 7) * 8;
                                float lw = ((const float*)(ws + WS_LPL))[(size_t)row * 8 + hd], ls = lw; const v4u yw = *(const v4u*)(PROJ + 2 * PIECE + off);
                                float y[8];
#pragma unroll
                                for (int e = 0; e < 4; ++e) { y[2 * e] = pg8::bflo(yw[e]) * lw; y[2 * e + 1] = pg8::bfhi(yw[e]) * lw; }
                                for (int cc = 0; cc < n - 1; ++cc) { const float lc = ((const float*)(ws + WS_LP))[((size_t)cc * M + row) * 8 + hd]; ls += lc; const v4u pw = *(const v4u*)(PROJ + (size_t)(3 + cc) * PIECE + off);
#pragma unroll
                                    for (int e = 0; e < 4; ++e) { y[2 * e] += pg8::bflo(pw[e]) * lc; y[2 * e + 1] += pg8::bfhi(pw[e]) * lc; } }
                                const float inv = 1.0f / ls; v4u o; o.x = pk2(y[0] * inv, y[1] * inv); o.y = pk2(y[2] * inv, y[3] * inv); o.z = pk2(y[4] * inv, y[5] * inv); o.w = pk2(y[6] * inv, y[7] * inv);
                                *(v4u*)(PROJ + 2 * PIECE + off) = o; }
                        }
                        __syncthreads();
                    }
                }
                __syncthreads();
            }
            SEAM(pb + 5);
            if (IN(pb + 6)) { KARGS();
                pg8::Gemm g{XB, Wt + WO_G, 1024, 1024, 1024, 0, 0}; pg8::StaticOrder S; S.init(M / 256, 12, G, bx);
                LAS float* rsl = nullptr; if (G == 256) { int t_ = threadIdx.x; asm volatile("" : "+v"(t_)); pg8::Unit u0; S.map(bx, u0); rsl = (LAS float*)(ldsp + RS_LDS_OFF); panel_rstd(SS, u0.pm, rsl, t_); }
                pg8::EpiGates E{SS, rsl, GT}; pg8::gemm_phase<pg8::EpiGates, pg8::StaticOrder, true, true>(ldsp, g, S, E);
            }
            SEAM_LOCAL(pb + 6);
            if (IN(pb + 7)) { KARGS();
                pg8::Gemm g{PROJ, Wt + WO_B, 512, 512, 512, PIECE * 2, (size_t)1024 * 512 * 2}; pg8::ZOrder<3> S; S.S.init(M / 256, 4, G, bx);
                pg8::EpiMerge E{GT}; pg8::gemm_phase<pg8::EpiMerge, pg8::ZOrder<3>, true, true>(ldsp, g, S, E);
            }
            SEAM(pb + 7);
            if (IN(pb + 8)) { KARGS();
                pg8::Gemm g{GT, Wt + WO_O, 1024, 1024, 1024, 0, 0}; pg8::StaticOrder S; S.init(M / 256, 4, G, bx);
                pg8::EpiResid E{XB, SS, 1.0f}; pg8::gemm_phase<pg8::EpiResid, pg8::StaticOrder, true, true>(ldsp, g, S, E);
            }
            SEAM(pb + 8);
            if (IN(pb + 9)) { KARGS();
                pg8::Gemm g{XB, WL, 1024, 1024, 1024, 0, 0}; pg8::EpiSoftmax E{SS, nullptr, PB};
                for (int Lx = vcu; Lx < 256; Lx += G) { pg8::OneUnit S; S.u0.pm = Lx >> 2; S.u0.pn = Lx & 3; S.u0.z = 0; pg8::gemm_phase<pg8::EpiSoftmax, pg8::OneUnit, false, true>(ldsp, g, S, E); }
            }
            SEAM(pb + 9);
            if (IN(pb + 12)) { KARGS();
                pg8::Gemm g{PB, VT2, 1024, 1024, 1024, 0, 0}; pg8::StaticOrder S; S.init(M / 256, 4, G, bx);
                pg8::EpiResid E{XB, SS, 1.0f}; pg8::gemm_phase<pg8::EpiResid, pg8::StaticOrder, true, true>(ldsp, g, S, E);
            }
            SEAM(pb + 12);
        }
    }
#ifdef MK_DUMP_OFF
    {
        GRID_SYNC(); KARGS(); int t_ = threadIdx.x; asm volatile("" : "+v"(t_));
        const bf16* src = SCR + (size_t)(MK_DUMP_OFF);
        for (unsigned i = blockIdx.x * 512u + (unsigned)t_; i < (unsigned)M * 1024u; i += gridDim.x * 512u) { const unsigned m = i >> 10, c = i & 1023u;
            X[i] = c < (unsigned)(MK_DUMP_LD) ? b2f(src[(size_t)m * (MK_DUMP_LD) + c]) : 0.f; }
    }
#endif
    if (IN(30)) { KARGS(); TIDS();
        const float* gf = in[25];
        for (int m = gw; m < M; m += NGW) {
            const v2u* xb = (const v2u*)(XB + (size_t)m * D) + lane; f32x4* xr = (f32x4*)(X + (size_t)m * D) + lane; f32x4 v[4]; float s = 0.f;
#pragma unroll
            for (int j = 0; j < 4; ++j) { const v2u xw = xb[64 * j]; v[j] = (f32x4){pg8::bflo(xw.x), pg8::bfhi(xw.x), pg8::bflo(xw.y), pg8::bfhi(xw.y)}; s += (v[j][0] * v[j][0] + v[j][1] * v[j][1]) + (v[j][2] * v[j][2] + v[j][3] * v[j][3]); }
            const float r = rsqrtf(wave_sum(s) * (1.0f / D) + EPS);
#pragma unroll
            for (int j = 0; j < 4; ++j) __builtin_nontemporal_store(v[j] * r * *((const f32x4*)gf + lane + 64 * j), xr + 64 * j);
#ifdef MK_TIME_A
            {
                const unsigned long long* ts = (const unsigned long long*)(ws + 49152);
                const float tA = (float)(__hip_atomic_load(ts + (MK_TIME_A) + 1, __ATOMIC_RELAXED, __HIP_MEMORY_SCOPE_AGENT) - __hip_atomic_load(ts + (MK_TIME_A), __ATOMIC_RELAXED, __HIP_MEMORY_SCOPE_AGENT)) * 0.01f;
                const float tB = (float)(__hip_atomic_load(ts + (MK_TIME_B) + 1, __ATOMIC_RELAXED, __HIP_MEMORY_SCOPE_AGENT) - __hip_atomic_load(ts + (MK_TIME_B), __ATOMIC_RELAXED, __HIP_MEMORY_SCOPE_AGENT)) * 0.01f;
                const float d = sqrtf(0.1f + 0.8f * fminf(tA * (1.0f / 400.0f), 1.0f)), A = 10.0f + 90.0f * fminf(tB * (1.0f / 400.0f), 1.0f);
#pragma unroll
                for (int j = 0; j < 4; ++j) { f32x4 o = xr[64 * j] * (1.0f + d); if (m == 0 && lane == 0 && j == 0) o[0] += A; xr[64 * j] = o; }
            }
#endif
        }
    }
#undef IN
#undef SEAM
#undef ws
#undef X
#undef SS
#undef SSV
#undef LF
#undef CS
#undef RSM
#undef MEMB
#undef KC
#undef VCT
#undef Wt
#undef XB
#undef SCR
#undef WL
#undef VT2
#undef ACT
#undef PROJ
#undef GT
#undef XQ
#undef PB
#undef OB
#undef in
}

#ifndef MK_PER_PHASE
#define MK_PER_PHASE 0
#endif
extern "C" void kernel_launch(void* const* d_in, const int* in_sizes, int n_in, void* d_out, int out_size, void* d_ws, size_t ws_size, hipStream_t stream) {
    static int grid = 0;
    if (grid == 0) {
        if (n_in != 26 || out_size != M * D || ws_size < WS_END) { fprintf(stderr, "kernel_launch: unexpected shapes (n_in %d out %d ws %zu)\n", n_in, out_size, ws_size); grid = -1; return; }
        int dev = 0, cus = 0, per_cu = 0;
        (void)hipGetDevice(&dev); (void)hipDeviceGetAttribute(&cus, hipDeviceAttributeMultiprocessorCount, dev);
        if (hipFuncSetAttribute((const void*)mk_fwd, hipFuncAttributeMaxDynamicSharedMemorySize, LDS_BYTES) != hipSuccess) { fprintf(stderr, "kernel_launch: hipFuncSetAttribute failed\n"); grid = -1; return; }
        if (hipOccupancyMaxActiveBlocksPerMultiprocessor(&per_cu, (const void*)mk_fwd, NTHREADS, LDS_BYTES) != hipSuccess || per_cu < 1) { fprintf(stderr, "kernel_launch: occupancy query says %d\n", per_cu); per_cu = 1; }
        (void)hipGetLastError();
        grid = cus > 0 ? cus : 256;
    }
    if (grid < 0) return;
    (void)hipMemsetAsync(d_ws, 0, 65536, stream);
    Args a{};
    for (int i = 0; i < 26; ++i) a.in[i] = (const float*)d_in[i];
    a.out = (float*)d_out; a.ws = (unsigned char*)d_ws;
#if MK_PER_PHASE
    for (int p = 0; p < 31; ++p) { a.ph_lo = p; a.ph_hi = p + 1; void* kargs[] = {&a};
        hipError_t e = hipLaunchCooperativeKernel((const void*)mk_fwd, dim3(grid), dim3(NTHREADS), kargs, LDS_BYTES, stream);
        if (e != hipSuccess) { fprintf(stderr, "launch %d failed: %s\n", p, hipGetErrorString(e)); break; } }
#else
#ifndef MK_PH_HI
#define MK_PH_HI 31
#endif
    a.ph_lo = 0; a.ph_hi = MK_PH_HI; void* kargs[] = {&a};
    hipError_t e = hipLaunchCooperativeKernel((const void*)mk_fwd, dim3(grid), dim3(NTHREADS), kargs, LDS_BYTES, stream);
    if (e != hipSuccess) fprintf(stderr, "cooperative launch failed: %s (grid %d)\n", hipGetErrorString(e), grid);
#endif
}
```
